# Optimizing an MI355X kernel written in HIP

```python
import jax, jax.numpy as jnp
from jax import lax
import numpy as np

D_MODEL = 4096
BATCH = 1
SEQ = 16384
DEPTH = 4

MEM_LEN = 256
CHUNK = 64
EPS = 1e-6
MIX_V = D_MODEL // 4
GLA_HEADS = 4
GLA_DV = MIX_V // GLA_HEADS
GLA_DK = GLA_DV // 2
GLA_QK = GLA_HEADS * GLA_DK
GLA_V = GLA_HEADS * GLA_DV
GLA_RANK = 16
GLA_TAU = 16.0
ML_HEADS = 4
ML_DV = MIX_V // ML_HEADS
ML_DK = ML_DV // 2
ML_QK = ML_HEADS * ML_DK
ML_V = ML_HEADS * ML_DV
CONV_W = 4
X_HEADS = 4
X_DH = MIX_V // X_HEADS
X_W = X_HEADS * X_DH
N_BRANCH = 3
GATE_RANK = 256
D_FF = 4 * D_MODEL

IN_SPLITS = (GLA_QK, GLA_QK, GLA_V, GLA_V, GLA_RANK,
             2 * ML_QK, ML_V, ML_V, ML_HEADS, ML_HEADS,
             X_W, GATE_RANK)
IN_WIDTH = sum(IN_SPLITS)

kernel_name = "hybrid_gla_mlstm_memory_trunk"


def split_columns(z):
    idx, acc = [], 0
    for w in IN_SPLITS[:-1]:
        acc += w
        idx.append(acc)
    return jnp.split(z, idx, axis=-1)


def rmsnorm(x, g):
    xf = x.astype(jnp.float32)
    xf = xf * lax.rsqrt(jnp.mean(xf * xf, axis=-1, keepdims=True) + EPS)
    return xf.astype(x.dtype) * g


def head_rmsnorm(o, heads, g):
    B, S, W = o.shape
    of = o.astype(jnp.float32).reshape(B, S, heads, W // heads)
    of = of * lax.rsqrt(jnp.mean(of * of, axis=-1, keepdims=True) + EPS)
    return of.reshape(B, S, W).astype(o.dtype) * g


def to_chunks(t, heads):
    B, S, W = t.shape
    return t.reshape(B, S // CHUNK, CHUNK, heads, W // heads).transpose(0, 3, 1, 2, 4)


def gate_chunks(t):
    B, S, H = t.shape
    return t.reshape(B, S // CHUNK, CHUNK, H).transpose(0, 3, 1, 2)


def from_chunks(t):
    B, H, N, C, d = t.shape
    return t.transpose(0, 2, 3, 1, 4).reshape(B, N * C, H * d)


def causal_dwconv(u, w, b):
    y = lax.conv_general_dilated(
        u, w[:, None, :].astype(u.dtype), window_strides=(1,),
        padding=[(CONV_W - 1, 0)], dimension_numbers=("NWC", "WIO", "NWC"),
        feature_group_count=u.shape[-1])
    return y + b.astype(u.dtype)


def gla_mixer(q, k, v, log_a):
    q = to_chunks(q, GLA_HEADS) * (GLA_DK ** -0.5)
    k = to_chunks(k, GLA_HEADS)
    v = to_chunks(v, GLA_HEADS)
    b = jnp.cumsum(to_chunks(log_a, GLA_HEADS), axis=3)
    causal = jnp.tril(jnp.ones((CHUNK, CHUNK), dtype=bool))
    q_d = q * jnp.exp(b)
    att = jnp.einsum("bhnck,bhnsk->bhncs", q_d, k * jnp.exp(-b))
    att = jnp.where(causal, att, 0.0)
    o_intra = jnp.einsum("bhncs,bhnsv->bhncv", att, v)
    b_last = b[:, :, :, -1:, :]
    d_state = jnp.einsum("bhnck,bhncv->bhnkv", k * jnp.exp(b_last - b), v)
    decay = jnp.exp(b_last[:, :, :, 0, :])

    def step(S, inp):
        dec, ds = inp
        return dec[..., None] * S + ds, S

    B, H = q.shape[0], q.shape[1]
    S0 = jnp.zeros((B, H, GLA_DK, GLA_DV), jnp.float32)
    _, S_prev = lax.scan(step, S0, (jnp.moveaxis(decay, 2, 0), jnp.moveaxis(d_state, 2, 0)))
    S_prev = jnp.moveaxis(S_prev, 0, 2)
    o_inter = jnp.einsum("bhnck,bhnkv->bhncv", q_d, S_prev)
    return from_chunks(o_intra + o_inter)


def mlstm_mixer(q, k, v, i_pre, f_pre):
    q = to_chunks(q, ML_HEADS)
    k = to_chunks(k, ML_HEADS) * (ML_DK ** -0.5)
    v = to_chunks(v, ML_HEADS)
    log_i = gate_chunks(i_pre)
    F = jnp.cumsum(gate_chunks(jax.nn.log_sigmoid(f_pre)), axis=3)
    causal = jnp.tril(jnp.ones((CHUNK, CHUNK), dtype=bool))
    L = jnp.where(causal, F[..., :, None] - F[..., None, :] + log_i[..., None, :], -jnp.inf)
    F_last = F[..., -1]
    G = F_last[..., None] - F + log_i
    g = jnp.max(G, axis=-1)
    wG = jnp.exp(G - g[..., None])
    dC = jnp.einsum("bhnc,bhnck,bhncv->bhnkv", wG, k, v)
    dn = jnp.einsum("bhnc,bhnck->bhnk", wG, k)

    def step(carry, inp):
        C, n, m = carry
        fl, gl, dc, dnn = inp
        m_new = jnp.maximum(fl + m, gl)
        a = jnp.exp(fl + m - m_new)
        bb = jnp.exp(gl - m_new)
        C_new = a[..., None, None] * C + bb[..., None, None] * dc
        n_new = a[..., None] * n + bb[..., None] * dnn
        return (C_new, n_new, m_new), (C, n, m)

    B, H = q.shape[0], q.shape[1]
    init = (jnp.zeros((B, H, ML_DK, ML_DV), jnp.float32),
            jnp.zeros((B, H, ML_DK), jnp.float32),
            jnp.full((B, H), -1e30, jnp.float32))
    xs = (jnp.moveaxis(F_last, 2, 0), jnp.moveaxis(g, 2, 0),
          jnp.moveaxis(dC, 2, 0), jnp.moveaxis(dn, 2, 0))
    _, (C_prev, n_prev, m_prev) = lax.scan(step, init, xs)
    C_prev = jnp.moveaxis(C_prev, 0, 2)
    n_prev = jnp.moveaxis(n_prev, 0, 2)
    m_prev = jnp.moveaxis(m_prev, 0, 2)

    m_inter = F + m_prev[..., None]
    m = jnp.maximum(jnp.max(L, axis=-1), m_inter)
    s = jnp.einsum("bhnck,bhnsk->bhncs", q, k) * jnp.exp(L - m[..., None])
    w_inter = jnp.exp(m_inter - m)
    num = jnp.einsum("bhncs,bhnsv->bhncv", s, v) + \
        w_inter[..., None] * jnp.einsum("bhnck,bhnkv->bhncv", q, C_prev)
    den = jnp.sum(s, axis=-1) + w_inter * jnp.einsum("bhnck,bhnk->bhnc", q, n_prev)
    h = num / jnp.maximum(jnp.abs(den), jnp.exp(-m))[..., None]
    return from_chunks(h)


def memory_attention(q, km, vm):
    B, S, _ = q.shape
    M = km.shape[1]
    qh = q.reshape(B, S, X_HEADS, X_DH)
    kh = km.reshape(B, M, X_HEADS, X_DH)
    vh = vm.reshape(B, M, X_HEADS, X_DH)
    s = jnp.einsum("bshd,bmhd->bhsm", qh, kh).astype(jnp.float32) * (X_DH ** -0.5)
    p = jax.nn.softmax(s, axis=-1).astype(vh.dtype)
    return jnp.einsum("bhsm,bmhd->bshd", p, vh).reshape(B, S, X_W)


def setup_inputs(seed: int = 0) -> dict:
    key = jax.random.key(seed)
    ks = jax.random.split(key, 24)
    f32 = jnp.float32

    def nrm(k, shape, scale):
        return jax.random.normal(k, shape, f32) * scale

    res_scale = (2 * DEPTH) ** -0.5
    b_f = jnp.broadcast_to(jnp.linspace(3.0, 6.0, ML_HEADS, dtype=f32), (DEPTH, ML_HEADS))
    return {
        "x": nrm(ks[0], (BATCH, SEQ, D_MODEL), 1.0),
        "mem": nrm(ks[1], (BATCH, MEM_LEN, D_MODEL), 1.0),
        "norm_mix": 1.0 + nrm(ks[2], (DEPTH, D_MODEL), 0.01),
        "w_in": nrm(ks[3], (DEPTH, D_MODEL, IN_WIDTH), D_MODEL ** -0.5),
        "w_gla_a": nrm(ks[4], (DEPTH, GLA_RANK, GLA_QK), GLA_RANK ** -0.5),
        "b_gla_a": nrm(ks[5], (DEPTH, GLA_QK), 0.1),
        "gla_norm": 1.0 + nrm(ks[6], (DEPTH, GLA_V), 0.01),
        "conv_w": nrm(ks[7], (DEPTH, CONV_W, 2 * ML_QK), CONV_W ** -0.5),
        "conv_b": nrm(ks[8], (DEPTH, 2 * ML_QK), 0.01),
        "b_ml_i": nrm(ks[9], (DEPTH, ML_HEADS), 0.1),
        "b_ml_f": b_f + nrm(ks[10], (DEPTH, ML_HEADS), 0.1),
        "ml_norm": 1.0 + nrm(ks[11], (DEPTH, ML_V), 0.01),
        "mem_norm": 1.0 + nrm(ks[12], (D_MODEL,), 0.01),
        "w_mem_k": nrm(ks[13], (DEPTH, D_MODEL, X_W), D_MODEL ** -0.5),
        "w_mem_v": nrm(ks[14], (DEPTH, D_MODEL, X_W), D_MODEL ** -0.5),
        "w_branch": nrm(ks[15], (DEPTH, N_BRANCH, MIX_V, D_MODEL), MIX_V ** -0.5),
        "w_gate": nrm(ks[16], (DEPTH, N_BRANCH, GATE_RANK, D_MODEL), GATE_RANK ** -0.5),
        "b_gate": nrm(ks[17], (DEPTH, N_BRANCH, D_MODEL), 0.01),
        "w_out": nrm(ks[18], (DEPTH, D_MODEL, D_MODEL), D_MODEL ** -0.5 * res_scale),
        "norm_ffn": 1.0 + nrm(ks[19], (DEPTH, D_MODEL), 0.01),
        "w_ff1": nrm(ks[20], (DEPTH, D_MODEL, D_FF), D_MODEL ** -0.5),
        "w_ff2": nrm(ks[21], (DEPTH, D_FF, D_MODEL), D_FF ** -0.5 * res_scale),
        "final_norm": 1.0 + nrm(ks[22], (D_MODEL,), 0.01),
    }


def reference(x, mem, norm_mix, w_in, w_gla_a, b_gla_a, gla_norm, conv_w, conv_b,
              b_ml_i, b_ml_f, ml_norm, mem_norm, w_mem_k, w_mem_v, w_branch,
              w_gate, b_gate, w_out, norm_ffn, w_ff1, w_ff2, final_norm):
    f32 = jnp.float32
    memn = rmsnorm(mem, mem_norm)
    for l in range(DEPTH):
        h = rmsnorm(x, norm_mix[l])
        z = h @ w_in[l]
        (gq, gk, gv, gg, ga, mqk, mv, mo, mi, mf, xq, gate_lat) = split_columns(z)

        log_a = jax.nn.log_sigmoid((ga @ w_gla_a[l] + b_gla_a[l]).astype(f32)) / GLA_TAU
        o_gla = gla_mixer(gq.astype(f32), gk.astype(f32), gv.astype(f32), log_a).astype(x.dtype)
        o_gla = head_rmsnorm(o_gla, GLA_HEADS, gla_norm[l]) * jax.nn.silu(gg)

        mqk = jax.nn.silu(causal_dwconv(mqk, conv_w[l], conv_b[l]))
        mq, mk = jnp.split(mqk, 2, axis=-1)
        h_ml = mlstm_mixer(mq.astype(f32), mk.astype(f32), mv.astype(f32),
                           (mi + b_ml_i[l]).astype(f32), (mf + b_ml_f[l]).astype(f32))
        o_ml = jax.nn.sigmoid(mo) * h_ml.astype(x.dtype)
        o_ml = head_rmsnorm(o_ml, ML_HEADS, ml_norm[l])

        o_mem = memory_attention(xq, memn @ w_mem_k[l], memn @ w_mem_v[l])

        y = None
        for j, o_b in enumerate((o_gla, o_ml, o_mem)):
            gate = jax.nn.sigmoid(gate_lat @ w_gate[l, j] + b_gate[l, j])
            term = gate * (o_b @ w_branch[l, j])
            y = term if j == 0 else y + term
        x = x + y @ w_out[l]

        h = rmsnorm(x, norm_ffn[l])
        x = x + jnp.square(jax.nn.relu(h @ w_ff1[l])) @ w_ff2[l]
    return rmsnorm(x, final_norm)
```

```cpp
#include <hip/hip_runtime.h>
#include <cstdio>
#include <cstdint>

#define DI __device__ __forceinline__
#define GAS __attribute__((address_space(1)))
#define LAS __attribute__((address_space(3)))
typedef unsigned short bf16_t;
typedef short bf16x8 __attribute__((ext_vector_type(8)));
typedef float f32x4 __attribute__((ext_vector_type(4)));
typedef float f32x2 __attribute__((ext_vector_type(2)));
typedef unsigned u32x4 __attribute__((ext_vector_type(4)));
typedef unsigned u32x2 __attribute__((ext_vector_type(2)));

constexpr int SEQ = 16384, DM = 4096, DFF = 16384, NL = 4, MEML = 256, CH = 64, NCH = SEQ / CH;
constexpr int IN_W = 7448, ZW = 7680;
constexpr int ZC_GQ = 0, ZC_GK = 512, ZC_GV = 1024, ZC_GG = 2048, ZC_MQK = 3072, ZC_MV = 4096, ZC_MO = 5120, ZC_XQ = 6144, ZC_GATE = 7168, ZC_GA = 7424, ZC_MI = 7440, ZC_MF = 7444;
constexpr int OBW = 3072;
constexpr int GTW = 12288;
constexpr float EPS = 1e-6f;

constexpr size_t MiB = 1u << 20;
constexpr size_t WS_CTL = 0, CTL_ZERO_BYTES = 1 * MiB;
constexpr size_t WS_WIN = 1 * MiB, WS_WBR = 241 * MiB, WS_WG = 337 * MiB, WS_WOUT = 361 * MiB, WS_W1 = 489 * MiB, WS_W2 = 1001 * MiB;
constexpr size_t WS_WMK = 1513 * MiB, WS_WMV = 1545 * MiB, WS_MEMN = 1577 * MiB, WS_KM = 1579 * MiB, WS_VMT = 1581 * MiB;
constexpr size_t WS_X = 1583 * MiB, WS_H = 1839 * MiB, WS_Z = 1967 * MiB, WS_GT = 2207 * MiB, WS_U = WS_Z  ;
constexpr size_t WS_OB = 2591 * MiB, WS_Y = 2687 * MiB, WS_DS = 2815 * MiB, WS_SP = 2943 * MiB, WS_DC = 3007 * MiB, WS_CP = 3135 * MiB;
constexpr size_t WS_SMALL = 3199 * MiB, WS_END = 3201 * MiB;
constexpr size_t SM_DECAY = 0, SM_DN = 512 * 1024, SM_NP = 1024 * 1024, SM_GG = 1536 * 1024, SM_FL = 1536 * 1024 + 4096, SM_MP = 1536 * 1024 + 8192;
static_assert(WS_U + (size_t)SEQ * DFF * 2 <= WS_OB, "U overlay");
constexpr int CW_BAR = 4096;

constexpr int LDS_BYTES = 147456;
constexpr int L_ST = 0, L_VT = 69632, L_Q = 106496, L_K = 123904, L_MISC = 141312, L_BARW = 146432;
constexpr int ROW72 = 144, ROW136 = 272, ROW264 = 528;
constexpr int NWAVES = 8;

DI float bf2f(unsigned v) { return __uint_as_float(v << 16); }
DI float bflo(unsigned w) { return __uint_as_float(w << 16); }
DI float bfhi(unsigned w) { return __uint_as_float(w & 0xffff0000u); }
DI unsigned pk2(float lo, float hi) { unsigned r; asm volatile("v_cvt_pk_bf16_f32 %0, %1, %2" : "=v"(r) : "v"(lo), "v"(hi)); return r; }
DI float sigmoid_f(float x) { return 1.0f / (1.0f + __expf(-x)); }
DI float silu_f(float x) { return x * sigmoid_f(x); }
DI float log_sigmoid_f(float x) { return fminf(x, 0.f) - __logf(1.0f + __expf(-fabsf(x))); }
DI float shx(float v, int o, int lane) { return __int_as_float(__builtin_amdgcn_ds_bpermute((lane ^ o) << 2, __float_as_int(v))); }
DI float shi(float v, int src) { return __int_as_float(__builtin_amdgcn_ds_bpermute(src << 2, __float_as_int(v))); }
DI float wave_sum(float v, int lane) {
#pragma unroll
    for (int o = 1; o < 64; o <<= 1) v += shx(v, o, lane);
    return v;
}
DI float wave_max(float v, int lane) {
#pragma unroll
    for (int o = 1; o < 64; o <<= 1) v = fmaxf(v, shx(v, o, lane));
    return v;
}
DI float wave_scan_sum(float v, int lane) {
#pragma unroll
    for (int o = 1; o < 64; o <<= 1) { const float t = shi(v, lane >= o ? lane - o : lane); if (lane >= o) v += t; }
    return v;
}
DI float wave_scan_max(float v, int lane) {
#pragma unroll
    for (int o = 1; o < 64; o <<= 1) { const float t = shi(v, lane >= o ? lane - o : lane); if (lane >= o) v = fmaxf(v, t); }
    return v;
}
DI f32x4 mfma16(bf16x8 a, bf16x8 b, f32x4 c) { return __builtin_amdgcn_mfma_f32_16x16x32_bf16(a, b, c, 0, 0, 0); }
DI int opaque_tid() { int t = (int)threadIdx.x; asm volatile("" : "+v"(t)); return t; }
DI int opaque_bx() { int b = (int)blockIdx.x; asm volatile("" : "+s"(b)); return b; }
DI LAS unsigned char* opaque_lds(LAS unsigned char* p) { asm volatile("" : "+s"(p)); return p; }
DI int opq(int v) { asm volatile("" : "+s"(v)); return v; }
DI int opaque_g() { int g = (int)gridDim.x; asm volatile("" : "+s"(g)); return g; }

namespace pg8 {
#define PG8_LAS __attribute__((address_space(3)))
constexpr int BM = 256, BK = 64, HALF = 128, HTB = HALF * BK * 2  , STAGE_BYTES = 8 * HTB, NXCD = 8, WGM = 8;

__host__ __device__ __forceinline__ int lds_byte(int r, int c) { const int st = (r >> 4) * 2 + (c >> 5), rr = r & 15, cc = c & 31, ob = rr * 64 + cc * 2; return st * 1024 + (ob ^ (((ob >> 9) & 1) << 5)); }
__host__ __device__ __forceinline__ void stage_rc(int b, int& R, int& C) { const int st = b / 1024, sb = b % 1024, swz = sb ^ (((sb >> 9) & 1) << 5); R = (st >> 1) * 16 + swz / 64; C = (st & 1) * 32 + (swz % 64) / 2; }
__host__ __device__ __forceinline__ int perm32(int rho) { const int n = rho >> 4, i = rho & 15; return 8 * (i >> 2) + 4 * n + (i & 3); }

struct Unit { int pm, pn; };
struct Gemm { const bf16_t* A; const bf16_t* Bt; int M, N, K, lda, ldb; };

struct StaticOrder {
    int nM, nN, nwg, G, c;
    __host__ __device__ void init(int M, int N, int G_, int c_) { nM = M / BM; nN = N / BM; nwg = nM * nN; G = G_; c = c_; }
    __host__ __device__ bool next(int i, Unit& u) const {
        const long L = (long)i * G + c; if (L >= nwg) return false;
        int wgid = (int)L; { const int q = nwg / NXCD, r = nwg % NXCD, xcd = wgid % NXCD, off = wgid / NXCD; wgid = (xcd < r ? xcd * (q + 1) : r * (q + 1) + (xcd - r) * q) + off; }
        const int nig = WGM * nN, gid = wgid / nig, fm = gid * WGM, gsz = (nM - fm) < WGM ? (nM - fm) : WGM;
        u.pm = fm + ((wgid % nig) % gsz); u.pn = (wgid % nig) / gsz; return true;
    }
    __device__ __forceinline__ void a_ready(const Unit&) const {}
    __device__ __forceinline__ void done(const Unit&) const {}
};

template <int ACT  > struct EpiBf16 {
    static constexpr bool PERM = true, AFTER_DRAIN = false, HOOK = false;
    bf16_t* O; int ldc; const float* bias;
    __device__ __forceinline__ void operator()(const f32x4 (&acc)[2][2][4][2], const Unit& u, int wr, int wc, int fr, int fq) const {
        const int row0 = u.pm * BM + wr * 64 + fr, col0 = u.pn * BM + wc * 32 + 8 * fq;
        f32x4 bv[2][2];
#pragma unroll
        for (int bj = 0; bj < 2; ++bj)
#pragma unroll
            for (int n = 0; n < 2; ++n) bv[bj][n] = (ACT == 2) ? *(const f32x4*)(bias + col0 + bj * HALF + 4 * n) : (f32x4){0.f, 0.f, 0.f, 0.f};
#pragma unroll
        for (int ai = 0; ai < 2; ++ai)
#pragma unroll
            for (int m = 0; m < 4; ++m) { bf16_t* rowp = O + (size_t)(row0 + ai * HALF + m * 16) * ldc + col0;
#pragma unroll
                for (int bj = 0; bj < 2; ++bj) { f32x4 v0 = acc[ai][bj][m][0], v1 = acc[ai][bj][m][1];
                    if (ACT == 1) {
#pragma unroll
                        for (int j = 0; j < 4; ++j) { const float a = fmaxf(v0[j], 0.f), b = fmaxf(v1[j], 0.f); v0[j] = a * a; v1[j] = b * b; } }
                    if (ACT == 2) { v0 = v0 + bv[bj][0]; v1 = v1 + bv[bj][1];
#pragma unroll
                        for (int j = 0; j < 4; ++j) { v0[j] = sigmoid_f(fminf(fmaxf(v0[j], -30.f), 30.f)); v1[j] = sigmoid_f(fminf(fmaxf(v1[j], -30.f), 30.f)); } }
                    u32x4 w; w.x = pk2(v0[0], v0[1]); w.y = pk2(v0[2], v0[3]); w.z = pk2(v1[0], v1[1]); w.w = pk2(v1[2], v1[3]);
                    *(u32x4*)(rowp + bj * HALF) = w; } }
    }
    __device__ __forceinline__ bool hook_at(int) const { return false; }
    __device__ __forceinline__ void hook(f32x4 (&)[2][2][4][2], const Unit&, int, int, int, int, int) const {}
};
struct EpiResid {
    static constexpr bool PERM = false, AFTER_DRAIN = false, HOOK = false;
    const float* in; float* out; int ldc;
    __device__ __forceinline__ void operator()(const f32x4 (&acc)[2][2][4][2], const Unit& u, int wr, int wc, int fr, int fq) const {
        const int row0 = u.pm * BM + wr * 64 + fr, col0 = u.pn * BM + wc * 32 + 4 * fq;
#pragma unroll
        for (int ai = 0; ai < 2; ++ai)
#pragma unroll
            for (int m = 0; m < 4; ++m) { const size_t off = (size_t)(row0 + ai * HALF + m * 16) * ldc + col0;
                f32x4 r[2][2];
#pragma unroll
                for (int bj = 0; bj < 2; ++bj)
#pragma unroll
                    for (int n = 0; n < 2; ++n) r[bj][n] = *(const f32x4*)(in + off + bj * HALF + n * 16);
#pragma unroll
                for (int bj = 0; bj < 2; ++bj)
#pragma unroll
                    for (int n = 0; n < 2; ++n) *(f32x4*)(out + off + bj * HALF + n * 16) = r[bj][n] + acc[ai][bj][m][n];
                asm volatile("" ::: "memory"); }
    }
    __device__ __forceinline__ bool hook_at(int) const { return false; }
    __device__ __forceinline__ void hook(f32x4 (&)[2][2][4][2], const Unit&, int, int, int, int, int) const {}
};
struct EpiBranch {
    static constexpr bool PERM = true, AFTER_DRAIN = false, HOOK = true;
    bf16_t* O; int ldc; const bf16_t* GT;
    __device__ __forceinline__ bool hook_at(int t) const { return t == 16 || t == 32; }
    __device__ __forceinline__ void hook(f32x4 (&acc)[2][2][4][2], const Unit& u, int t, int, int, int, int) const {
        const int tid_ = opaque_tid(), wid_ = tid_ >> 6, wr = wid_ >> 2, wc = wid_ & 3, fr = tid_ & 15, fq = (tid_ >> 4) & 3;
        const int row0 = u.pm * BM + wr * 64 + fr, col0 = u.pn * BM + wc * 32 + 8 * fq;
        const bf16_t* ga = GT + (size_t)(t == 16 ? 0 : DM); const bf16_t* gb = ga + DM;
#pragma unroll
        for (int ai = 0; ai < 2; ++ai)
#pragma unroll
            for (int m = 0; m < 4; ++m) { const size_t off = (size_t)(row0 + ai * HALF + m * 16) * GTW + col0;
#pragma unroll
                for (int bj = 0; bj < 2; ++bj) { const u32x4 a = *(const u32x4*)(ga + off + bj * HALF), b = *(const u32x4*)(gb + off + bj * HALF);
                    f32x4 r0, r1;
                    r0[0] = bflo(a.x) * __builtin_amdgcn_rcpf(bflo(b.x)); r0[1] = bfhi(a.x) * __builtin_amdgcn_rcpf(bfhi(b.x));
                    r0[2] = bflo(a.y) * __builtin_amdgcn_rcpf(bflo(b.y)); r0[3] = bfhi(a.y) * __builtin_amdgcn_rcpf(bfhi(b.y));
                    r1[0] = bflo(a.z) * __builtin_amdgcn_rcpf(bflo(b.z)); r1[1] = bfhi(a.z) * __builtin_amdgcn_rcpf(bfhi(b.z));
                    r1[2] = bflo(a.w) * __builtin_amdgcn_rcpf(bflo(b.w)); r1[3] = bfhi(a.w) * __builtin_amdgcn_rcpf(bfhi(b.w));
                    acc[ai][bj][m][0] = acc[ai][bj][m][0] * r0; acc[ai][bj][m][1] = acc[ai][bj][m][1] * r1; }
                asm volatile("" ::: "memory"); }
    }
    __device__ __forceinline__ void operator()(const f32x4 (&acc)[2][2][4][2], const Unit& u, int wr, int wc, int fr, int fq) const {
        const int row0 = u.pm * BM + wr * 64 + fr, col0 = u.pn * BM + wc * 32 + 8 * fq;
        const bf16_t* gc = GT + 2 * DM;
#pragma unroll
        for (int ai = 0; ai < 2; ++ai)
#pragma unroll
            for (int m = 0; m < 4; ++m) { const size_t r = (size_t)(row0 + ai * HALF + m * 16);
#pragma unroll
                for (int bj = 0; bj < 2; ++bj) { const u32x4 g = *(const u32x4*)(gc + r * GTW + col0 + bj * HALF);
                    const f32x4 v0 = acc[ai][bj][m][0], v1 = acc[ai][bj][m][1];
                    u32x4 w; w.x = pk2(v0[0] * bflo(g.x), v0[1] * bfhi(g.x)); w.y = pk2(v0[2] * bflo(g.y), v0[3] * bfhi(g.y));
                    w.z = pk2(v1[0] * bflo(g.z), v1[1] * bfhi(g.z)); w.w = pk2(v1[2] * bflo(g.w), v1[3] * bfhi(g.w));
                    *(u32x4*)(O + r * ldc + col0 + bj * HALF) = w; }
                asm volatile("" ::: "memory"); }
    }
};

template <class Epi, class Sched, bool ALIGN_EPI = false, bool SP2 = false>
__device__ __forceinline__ void gemm_phase(PG8_LAS unsigned char* lds, const Gemm g, const Sched& S, const Epi& E) {
    const int tid = opaque_tid(), wid = __builtin_amdgcn_readfirstlane(tid >> 6), lane = tid & 63, wr = wid >> 2, wc = wid & 3, fr = lane & 15, fq = lane >> 4;
    const int K = g.K, nt = K / BK;
    unsigned voffA[2], voffB[2];
#pragma unroll
    for (int i = 0; i < 2; ++i) { int R, C; stage_rc(tid * 16 + i * 8192, R, C); const int Rb = Epi::PERM ? ((R & ~31) + perm32(R & 31)) : R;
        voffA[i] = (unsigned)(R * g.lda + C) * 2u; voffB[i] = (unsigned)(Rb * g.ldb + C) * 2u; }
    const size_t kstep = (size_t)(BK * 2);
    const size_t hstepA = (size_t)HALF * g.lda * 2, hstepB = (size_t)HALF * g.ldb * 2;
    const size_t tstepA = 2 * hstepA, tstepB = 2 * hstepB;
    const unsigned ldsw = (unsigned)wid * 1024u;
    const int aoff = lds_byte(wr * 64 + fr, fq * 8), boff = lds_byte(wc * 32 + fr, fq * 8);
#define PG8_SA(b, h) (((b) * 2 + (h)) * HTB)
#define PG8_SB(b, h) ((4 + (b) * 2 + (h)) * HTB)
#define PG8_STAGE(bufoff, gbase, voff) do { _Pragma("unroll") for (int _i = 0; _i < 2; ++_i) \
        __builtin_amdgcn_global_load_lds((const unsigned*)((const char*)(gbase) + (voff)[_i]), (PG8_LAS unsigned*)(lds + (bufoff) + ldsw + _i * 8192), 16, 0, 0); } while (0)
#define PG8_LDA(dst, b, h) do { _Pragma("unroll") for (int m = 0; m < 4; ++m) _Pragma("unroll") for (int k = 0; k < 2; ++k) dst[m][k] = *(const PG8_LAS bf16x8*)(lds + PG8_SA(b, h) + aoff + m * 2048 + k * 1024); } while (0)
#define PG8_LDB(dst, b, h) do { _Pragma("unroll") for (int n = 0; n < 2; ++n) _Pragma("unroll") for (int k = 0; k < 2; ++k) dst[n][k] = *(const PG8_LAS bf16x8*)(lds + PG8_SB(b, h) + boff + n * 2048 + k * 1024); } while (0)
#define PG8_MMA(ai, bj, At, Bt) do { __builtin_amdgcn_s_setprio(1); _Pragma("unroll") for (int m = 0; m < 4; ++m) _Pragma("unroll") for (int n = 0; n < 2; ++n) _Pragma("unroll") for (int k = 0; k < 2; ++k) \
        acc[ai][bj][m][n] = __builtin_amdgcn_mfma_f32_16x16x32_bf16(Bt[n][k], At[m][k], acc[ai][bj][m][n], 0, 0, 0); __builtin_amdgcn_s_setprio(0); } while (0)
#define PG8_WAIT_V(n) asm volatile("s_waitcnt vmcnt(" #n ")" ::: "memory")
#define PG8_WAIT_L(n) asm volatile("s_waitcnt lgkmcnt(" #n ")" ::: "memory")
#define PG8_BAR __builtin_amdgcn_s_barrier()
#define PG8_SCHED __builtin_amdgcn_sched_barrier(0)
    Unit cur, nxt; int ui = 0;
    if (!S.next(0, cur)) return;
    f32x4 acc[2][2][4][2];
#pragma unroll
    for (int a = 0; a < 2; ++a)
#pragma unroll
        for (int b = 0; b < 2; ++b)
#pragma unroll
            for (int m = 0; m < 4; ++m)
#pragma unroll
                for (int n = 0; n < 2; ++n) acc[a][b][m][n] = (f32x4){0.f, 0.f, 0.f, 0.f};
    bf16x8 At[4][2], B0[2][2], B1[2][2];
    const char* cA = (const char*)g.A + (size_t)cur.pm * tstepA; const char* cB = (const char*)g.Bt + (size_t)cur.pn * tstepB;
    S.a_ready(cur);
    if constexpr (SP2) {
        PG8_STAGE(PG8_SB(0, 0), cB, voffB); PG8_STAGE(PG8_SB(0, 1), cB + hstepB, voffB); PG8_STAGE(PG8_SA(0, 0), cA, voffA); PG8_STAGE(PG8_SA(0, 1), cA + hstepA, voffA);
        if (wr == 1) PG8_BAR;
        PG8_WAIT_V(2); PG8_BAR;
        PG8_STAGE(PG8_SB(1, 0), cB + kstep, voffB); PG8_STAGE(PG8_SA(1, 0), cA + kstep, voffA); PG8_STAGE(PG8_SB(1, 1), cB + hstepB + kstep, voffB);
        PG8_WAIT_V(6); PG8_BAR;
    } else {
        PG8_STAGE(PG8_SB(0, 0), cB, voffB); PG8_STAGE(PG8_SA(0, 0), cA, voffA); PG8_STAGE(PG8_SB(0, 1), cB + hstepB, voffB); PG8_STAGE(PG8_SA(0, 1), cA + hstepA, voffA);
        if (wr == 1) PG8_BAR;
        PG8_WAIT_V(4); PG8_BAR;
        PG8_STAGE(PG8_SB(1, 0), cB + kstep, voffB); PG8_STAGE(PG8_SA(1, 0), cA + kstep, voffA); PG8_STAGE(PG8_SB(1, 1), cB + hstepB + kstep, voffB);
        PG8_WAIT_V(6); PG8_BAR;
    }
    for (;;) {
        const bool has_next = S.next(ui + 1, nxt);
        const char* nA = has_next ? (const char*)g.A + (size_t)nxt.pm * tstepA : cA; const char* nB = has_next ? (const char*)g.Bt + (size_t)nxt.pn * tstepB : cB;
        for (int t = 0; t < nt; t += 2) {
            const bool last = (t == nt - 2);
            if constexpr (Epi::HOOK) { if (E.hook_at(t)) E.hook(acc, cur, t, wr, wc, fr, fq); }
            const char* a1 = cA + (size_t)(t + 1) * kstep;
            const char* a2 = last ? nA : cA + (size_t)(t + 2) * kstep; const char* b2 = last ? nB : cB + (size_t)(t + 2) * kstep;
            const char* a3 = a2 + kstep; const char* b3 = b2 + kstep;
            if (last && has_next) S.a_ready(nxt);
            if constexpr (SP2) {
            PG8_LDB(B0, 0, 0); PG8_LDB(B1, 0, 1); PG8_SCHED; PG8_LDA(At, 0, 0); PG8_STAGE(PG8_SA(1, 1), a1 + hstepA, voffA);
            PG8_WAIT_V(8); PG8_WAIT_L(0); PG8_BAR; PG8_MMA(0, 0, At, B0); PG8_MMA(0, 1, At, B1); PG8_BAR; PG8_SCHED;
            PG8_LDA(At, 0, 1); PG8_STAGE(PG8_SB(0, 0), b2, voffB); PG8_STAGE(PG8_SB(0, 1), b2 + hstepB, voffB); PG8_STAGE(PG8_SA(0, 0), a2, voffA);
            PG8_WAIT_V(8); PG8_WAIT_L(0); PG8_BAR; PG8_MMA(1, 0, At, B0); PG8_MMA(1, 1, At, B1); PG8_BAR; PG8_SCHED;
            PG8_LDB(B0, 1, 0); PG8_LDB(B1, 1, 1); PG8_SCHED; PG8_LDA(At, 1, 0); PG8_STAGE(PG8_SA(0, 1), a2 + hstepA, voffA);
            PG8_WAIT_V(8); PG8_WAIT_L(0); PG8_BAR; PG8_MMA(0, 0, At, B0); PG8_MMA(0, 1, At, B1); PG8_BAR; PG8_SCHED;
            PG8_LDA(At, 1, 1); PG8_STAGE(PG8_SB(1, 0), b3, voffB); PG8_STAGE(PG8_SB(1, 1), b3 + hstepB, voffB); PG8_STAGE(PG8_SA(1, 0), a3, voffA);
            PG8_WAIT_V(8); PG8_WAIT_L(0); PG8_BAR; PG8_MMA(1, 0, At, B0); PG8_MMA(1, 1, At, B1); PG8_BAR; PG8_SCHED;
            } else {
            PG8_LDB(B0, 0, 0); PG8_SCHED; PG8_LDA(At, 0, 0); PG8_STAGE(PG8_SA(1, 1), a1 + hstepA, voffA);
            PG8_WAIT_L(8); PG8_BAR; PG8_WAIT_L(0); PG8_MMA(0, 0, At, B0); PG8_BAR; PG8_SCHED;
            PG8_LDB(B1, 0, 1); PG8_STAGE(PG8_SB(0, 0), b2, voffB);
            PG8_BAR; PG8_WAIT_L(0); PG8_MMA(0, 1, At, B1); PG8_BAR;
            PG8_LDA(At, 0, 1); PG8_STAGE(PG8_SA(0, 0), a2, voffA);
            PG8_BAR; PG8_WAIT_L(0); PG8_MMA(1, 0, At, B0); PG8_BAR; PG8_SCHED;
            PG8_STAGE(PG8_SB(0, 1), b2 + hstepB, voffB);
            PG8_WAIT_V(6); PG8_BAR; PG8_MMA(1, 1, At, B1); PG8_BAR;
            PG8_LDB(B0, 1, 0); PG8_SCHED; PG8_LDA(At, 1, 0); PG8_STAGE(PG8_SA(0, 1), a2 + hstepA, voffA);
            PG8_WAIT_L(8); PG8_BAR; PG8_WAIT_L(0); PG8_MMA(0, 0, At, B0); PG8_BAR; PG8_SCHED;
            PG8_LDB(B1, 1, 1); PG8_STAGE(PG8_SB(1, 0), b3, voffB);
            PG8_BAR; PG8_WAIT_L(0); PG8_MMA(0, 1, At, B1); PG8_BAR;
            PG8_LDA(At, 1, 1); PG8_STAGE(PG8_SA(1, 0), a3, voffA);
            PG8_BAR; PG8_WAIT_L(0); PG8_MMA(1, 0, At, B0); PG8_BAR; PG8_SCHED;
            PG8_STAGE(PG8_SB(1, 1), b3 + hstepB, voffB);
            PG8_WAIT_V(6); PG8_BAR; PG8_MMA(1, 1, At, B1); PG8_BAR;
            }
        }
        if constexpr (ALIGN_EPI) { if (wr == 0) PG8_BAR; }
        E(acc, cur, wr, wc, fr, fq); S.done(cur);
        if (!has_next) break;
#pragma unroll
        for (int a = 0; a < 2; ++a)
#pragma unroll
            for (int b = 0; b < 2; ++b)
#pragma unroll
                for (int m = 0; m < 4; ++m)
#pragma unroll
                    for (int n = 0; n < 2; ++n) acc[a][b][m][n] = (f32x4){0.f, 0.f, 0.f, 0.f};
        cur = nxt; cA = nA; cB = nB; ++ui;
        if constexpr (ALIGN_EPI) { if (wr == 1) PG8_BAR; }
    }
    PG8_WAIT_V(0);
    if constexpr (!ALIGN_EPI) { if (wr == 0) PG8_BAR; }
    PG8_BAR;
#undef PG8_SA
#undef PG8_SB
#undef PG8_STAGE
#undef PG8_LDA
#undef PG8_LDB
#undef PG8_MMA
#undef PG8_WAIT_V
#undef PG8_WAIT_L
#undef PG8_BAR
#undef PG8_SCHED
}
}

#define XB_TMO      128
#define XB_XCNT(j)  (256  + 64 * (j))
#define XB_XSUB(j)  (1280 + 64 * (j))
#define XB_XGEN(j)  (2304 + 64 * (j))
#define XB_TOP      3328
#define XB_TOPGEN   3392
#define XCD_BAR_WORDS 3456
#define XB_SPIN_CAP (1u << 18)

__device__ __forceinline__ unsigned xb_ld(unsigned* p)              { return __hip_atomic_load(p, __ATOMIC_RELAXED, __HIP_MEMORY_SCOPE_AGENT); }
__device__ __forceinline__ unsigned xb_add(unsigned* p, unsigned v) { return __hip_atomic_fetch_add(p, v, __ATOMIC_RELAXED, __HIP_MEMORY_SCOPE_AGENT); }
__device__ __forceinline__ unsigned xb_xcc_id() { return (unsigned)__builtin_amdgcn_s_getreg((3 << 11) | 20) & 0xFu; }
#define XB_SPIN(cond, bar) do { unsigned _sp = 0; while (cond) { __builtin_amdgcn_s_sleep(1); \
    if ((++_sp & 255u) == 0u) { if (xb_ld(&(bar)[XB_TMO])) break; if (_sp > XB_SPIN_CAP) { atomicAdd(&(bar)[XB_TMO], 1u); break; } } } } while (0)

struct XcdBarrier {
    unsigned* bar; unsigned x;
    volatile LAS unsigned* st;
};
__device__ __forceinline__ XcdBarrier xcd_barrier_post(unsigned* bar, volatile LAS unsigned* st) {
    XcdBarrier b; b.bar = bar; b.x = xb_xcc_id(); b.st = st;
    if (threadIdx.x == 0) (void)xb_add(&bar[XB_XCNT(b.x)], 1u);
    return b;
}
__device__ __forceinline__ void xcd_barrier_complete(unsigned* bar, unsigned x, unsigned& nloc, unsigned& nx) {
    const unsigned G = gridDim.x * gridDim.y * gridDim.z;
    unsigned sum, cnt, mine, sp = 0u;
    for (;;) {
        sum = 0u; cnt = 0u; mine = 0u;
#pragma unroll
        for (unsigned j = 0; j < 16; ++j) { const unsigned c = xb_ld(&bar[XB_XCNT(j)]); sum += c; cnt += (c > 0u) ? 1u : 0u; mine = (j == x) ? c : mine; }
        if (sum == G) break;
        __builtin_amdgcn_s_sleep(1);
        if ((++sp & 255u) == 0u) { if (xb_ld(&bar[XB_TMO])) break; if (sp > XB_SPIN_CAP) { atomicAdd(&bar[XB_TMO], 1u); break; } }
    }
    nloc = mine > 0u ? mine : 1u; nx = cnt > 0u ? cnt : 1u;
}
__device__ __forceinline__ void xcd_barrier(const XcdBarrier& b) {
    asm volatile("s_waitcnt vmcnt(0)" ::: "memory");
    __syncthreads();
    if (threadIdx.x == 0) {
        unsigned* bar = b.bar;
        __builtin_amdgcn_s_waitcnt(0);
        unsigned nloc = b.st[0], nx = b.st[1];
        if (nloc == 0u) { xcd_barrier_complete(bar, b.x, nloc, nx); b.st[0] = nloc; b.st[1] = nx; }
        const unsigned old = xb_add(&bar[XB_XSUB(b.x)], 1u);
        const unsigned gen = old / nloc;
        if (old + 1u == (gen + 1u) * nloc) {
            __builtin_amdgcn_fence(__ATOMIC_RELEASE, "agent");
            asm volatile("s_waitcnt vmcnt(0)" ::: "memory");
            const unsigned og = xb_add(&bar[XB_TOP], 1u);
            const unsigned tg = og / nx;
            if (og + 1u == (tg + 1u) * nx) xb_add(&bar[XB_TOPGEN], 1u);
            else XB_SPIN(xb_ld(&bar[XB_TOPGEN]) == tg, bar);
            __builtin_amdgcn_fence(__ATOMIC_ACQUIRE, "agent");
            xb_add(&bar[XB_XGEN(b.x)], 1u);
            asm volatile("s_waitcnt vmcnt(0)" ::: "memory");
        } else {
            XB_SPIN(xb_ld(&bar[XB_XGEN(b.x)]) == gen, bar);
            __builtin_amdgcn_fence(__ATOMIC_ACQUIRE, "agent");
            asm volatile("s_waitcnt vmcnt(0)" ::: "memory");
        }
    }
    __syncthreads();
}

struct Params { const float* in[23]; float* out; unsigned char* ws; };
enum { I_X = 0, I_MEM, I_NORM_MIX, I_W_IN, I_W_GLA_A, I_B_GLA_A, I_GLA_NORM, I_CONV_W, I_CONV_B, I_B_ML_I, I_B_ML_F, I_ML_NORM, I_MEM_NORM, I_W_MEM_K, I_W_MEM_V, I_W_BRANCH, I_W_GATE, I_B_GATE, I_W_OUT, I_NORM_FFN, I_W_FF1, I_W_FF2, I_FINAL_NORM };

DI int win_row(int n) {
    if (n < 3072) return n;
    if (n < 3088) return ZC_GA + (n - 3072);
    if (n < 6160) return n - 16;
    if (n < 6168) return ZC_MI + (n - 6160);
    return n - 24;
}
DI void transpose_item(const float* __restrict__ W, int K, int N, bf16_t* __restrict__ WT, int ld_dst, int col_off, int row_off, bool remap, LAS float* scr, int item, int lane) {
    const int nblk = (N + 63) >> 6, kb = item / nblk, nb = item - kb * nblk, k0 = kb << 6, n0 = nb << 6;
    const int a = lane & 15, q = lane >> 4, n4 = 4 * a;
    const bool ok = (n0 + n4) < N;
    f32x4 v[16];
#pragma unroll
    for (int i = 0; i < 16; ++i) { const int kk = 4 * i + q; v[i] = ok ? *(const f32x4*)(W + (size_t)(k0 + kk) * N + n0 + n4) : (f32x4){0.f, 0.f, 0.f, 0.f}; }
#pragma unroll
    for (int i = 0; i < 16; ++i) { const int kk = 4 * i + q;
#pragma unroll
        for (int e = 0; e < 4; ++e) scr[(n4 + e) * 65 + kk] = v[i][e]; }
    asm volatile("s_waitcnt lgkmcnt(0)" ::: "memory");
    const int c = lane & 7;
#pragma unroll
    for (int jj = 0; jj < 8; ++jj) { const int n = (lane >> 3) + 8 * jj; const LAS float* s = scr + n * 65 + 8 * c;
        u32x4 o; o.x = pk2(s[0], s[1]); o.y = pk2(s[2], s[3]); o.z = pk2(s[4], s[5]); o.w = pk2(s[6], s[7]);
        const int ng = n0 + n;
        if (ng < N) { const int row = row_off + (remap ? win_row(ng) : ng); *(u32x4*)(WT + (size_t)row * ld_dst + col_off + k0 + 8 * c) = o; } }
    asm volatile("s_waitcnt lgkmcnt(0)" ::: "memory");
}

template <bool OUT_F32> DI void rmsnorm_row(const float* __restrict__ xrow, const float* __restrict__ g, void* orow, int lane) {
    const f32x4* xr = (const f32x4*)xrow + lane; const f32x4* gr = (const f32x4*)g + lane;
    f32x4 v[16]; float s = 0.f;
#pragma unroll
    for (int j = 0; j < 16; ++j) { v[j] = xr[64 * j]; s += (v[j].x * v[j].x + v[j].y * v[j].y) + (v[j].z * v[j].z + v[j].w * v[j].w); }
    const float rstd = 1.0f / sqrtf(wave_sum(s, lane) * (1.0f / DM) + EPS);
#pragma unroll
    for (int j = 0; j < 16; ++j) { const f32x4 gg = gr[64 * j]; const f32x4 o = v[j] * rstd * gg;
        if (OUT_F32) ((f32x4*)orow)[lane + 64 * j] = o;
        else { u32x2 w; w.x = pk2(o.x, o.y); w.y = pk2(o.z, o.w); ((u32x2*)orow)[lane + 64 * j] = w; } }
}

DI void fill_vT(const bf16_t* __restrict__ Zv, int n, int tg, int lane, LAS unsigned char* VT) {
#pragma unroll
    for (int i = 0; i < 2; ++i) { const int cp = lane + 64 * i; unsigned w[8];
#pragma unroll
        for (int j = 0; j < 8; ++j) w[j] = *(const unsigned*)(Zv + (size_t)(n * CH + 8 * tg + j) * ZW + 2 * cp);
        u32x4 lo, hi;
        lo.x = (w[0] & 0xffffu) | (w[1] << 16); lo.y = (w[2] & 0xffffu) | (w[3] << 16); lo.z = (w[4] & 0xffffu) | (w[5] << 16); lo.w = (w[6] & 0xffffu) | (w[7] << 16);
        hi.x = (w[0] >> 16) | (w[1] & 0xffff0000u); hi.y = (w[2] >> 16) | (w[3] & 0xffff0000u); hi.z = (w[4] >> 16) | (w[5] & 0xffff0000u); hi.w = (w[6] >> 16) | (w[7] & 0xffff0000u);
        *(LAS u32x4*)(VT + (2 * cp) * ROW72 + tg * 16) = lo; *(LAS u32x4*)(VT + (2 * cp + 1) * ROW72 + tg * 16) = hi; }
}
DI void state_mfma(const LAS unsigned char* VT, const LAS unsigned char* KT, float* __restrict__ OUT, int w, int lane) {
    const int fr = lane & 15, fq = lane >> 4;
    f32x4 acc[2][8];
#pragma unroll
    for (int mi = 0; mi < 2; ++mi)
#pragma unroll
        for (int ni = 0; ni < 8; ++ni) acc[mi][ni] = (f32x4){0.f, 0.f, 0.f, 0.f};
#pragma unroll
    for (int ks = 0; ks < 2; ++ks) {
        bf16x8 a[2];
#pragma unroll
        for (int mi = 0; mi < 2; ++mi) a[mi] = *(const LAS bf16x8*)(VT + (32 * w + 16 * mi + fr) * ROW72 + (32 * ks + 8 * fq) * 2);
#pragma unroll
        for (int ni = 0; ni < 8; ++ni) { const bf16x8 b = *(const LAS bf16x8*)(KT + (16 * ni + fr) * ROW72 + (32 * ks + 8 * fq) * 2);
#pragma unroll
            for (int mi = 0; mi < 2; ++mi) acc[mi][ni] = mfma16(b, a[mi], acc[mi][ni]); }
    }
#pragma unroll
    for (int mi = 0; mi < 2; ++mi)
#pragma unroll
        for (int ni = 0; ni < 8; ++ni) *(f32x4*)(OUT + (size_t)(32 * w + 16 * mi + fr) * 128 + 16 * ni + 4 * fq) = acc[mi][ni];
}
DI void copy_256x128(const bf16_t* __restrict__ src, int gp, LAS unsigned char* dst, int tid) {
#pragma unroll
    for (int i = 0; i < 8; ++i) { const int id = tid + 512 * i, row = id >> 4, cc = id & 15;
        *(LAS u32x4*)(dst + row * ROW136 + cc * 16) = *(const u32x4*)(src + (size_t)row * gp + cc * 8); }
}
DI void gla_b(const bf16_t* __restrict__ Z, const float* __restrict__ wa, const float* __restrict__ ba, int h, int n, int tg, int c2, LAS float* TOT, float (&b)[8][2], float (&blast)[2]) {
    const int col = h * 128 + 2 * c2;
    float w0[16], w1[16];
#pragma unroll
    for (int r = 0; r < 16; ++r) { const f32x2 w = *(const f32x2*)(wa + r * 512 + col); w0[r] = w.x; w1[r] = w.y; }
    const f32x2 bb = *(const f32x2*)(ba + col);
    float c0 = 0.f, c1 = 0.f;
#pragma unroll
    for (int j = 0; j < 8; ++j) {
        const bf16_t* gp = Z + (size_t)(n * CH + 8 * tg + j) * ZW + ZC_GA;
        const u32x4 g0 = *(const u32x4*)gp, g1 = *(const u32x4*)(gp + 8);
        const float gv[16] = {bflo(g0.x), bfhi(g0.x), bflo(g0.y), bfhi(g0.y), bflo(g0.z), bfhi(g0.z), bflo(g0.w), bfhi(g0.w),
                              bflo(g1.x), bfhi(g1.x), bflo(g1.y), bfhi(g1.y), bflo(g1.z), bfhi(g1.z), bflo(g1.w), bfhi(g1.w)};
        float p0 = bb.x, p1 = bb.y;
#pragma unroll
        for (int r = 0; r < 16; ++r) { p0 += gv[r] * w0[r]; p1 += gv[r] * w1[r]; }
        c0 += log_sigmoid_f(p0) * (1.0f / 16.0f); c1 += log_sigmoid_f(p1) * (1.0f / 16.0f);
        b[j][0] = c0; b[j][1] = c1;
    }
    *(LAS f32x2*)(TOT + tg * 128 + 2 * c2) = (f32x2){c0, c1};
    __syncthreads();
    float pre0 = 0.f, pre1 = 0.f, t0 = 0.f, t1 = 0.f;
#pragma unroll
    for (int g = 0; g < 8; ++g) { const f32x2 t = *(const LAS f32x2*)(TOT + g * 128 + 2 * c2); if (g < tg) { pre0 += t.x; pre1 += t.y; } t0 += t.x; t1 += t.y; }
#pragma unroll
    for (int j = 0; j < 8; ++j) { b[j][0] += pre0; b[j][1] += pre1; }
    blast[0] = t0; blast[1] = t1;
}
DI void conv_silu8(const bf16_t* __restrict__ Zc, const float* __restrict__ cw, const float* __restrict__ cb, int tok0, float (&o0)[8], float (&o1)[8]) {
    float x0[11], x1[11];
#pragma unroll
    for (int i = 0; i < 11; ++i) { const int tok = tok0 - 3 + i; unsigned w = 0u; if (tok >= 0) w = *(const unsigned*)(Zc + (size_t)tok * ZW); x0[i] = bflo(w); x1[i] = bfhi(w); }
    f32x2 wj[4];
#pragma unroll
    for (int j = 0; j < 4; ++j) wj[j] = *(const f32x2*)(cw + j * 1024);
    const f32x2 bias = *(const f32x2*)cb;
#pragma unroll
    for (int j = 0; j < 8; ++j) { float y0 = bias.x, y1 = bias.y;
#pragma unroll
        for (int jj = 0; jj < 4; ++jj) { y0 += wj[jj].x * x0[j + jj]; y1 += wj[jj].y * x1[j + jj]; }
        o0[j] = silu_f(y0); o1[j] = silu_f(y1); }
}
DI void score_mfma(const LAS unsigned char* QL, const LAS unsigned char* KL, int w, int lane, f32x4 (&sacc)[2]) {
    const int fr = lane & 15, fq = lane >> 4, mi = w >> 1, ni0 = 2 * (w & 1);
    sacc[0] = (f32x4){0.f, 0.f, 0.f, 0.f}; sacc[1] = sacc[0];
#pragma unroll
    for (int ks = 0; ks < 4; ++ks) { const bf16x8 a = *(const LAS bf16x8*)(QL + (16 * mi + fr) * ROW136 + (32 * ks + 8 * fq) * 2);
#pragma unroll
        for (int jn = 0; jn < 2; ++jn) { const bf16x8 b = *(const LAS bf16x8*)(KL + (16 * (ni0 + jn) + fr) * ROW136 + (32 * ks + 8 * fq) * 2); sacc[jn] = mfma16(b, a, sacc[jn]); } }
}

struct MixCtx {
    const bf16_t* Z; bf16_t* OB;
    const float *wa, *ba, *gla_norm, *conv_w, *conv_b, *b_i, *b_f, *ml_norm;
    float *DS, *DC, *DECAY, *DN, *NP, *GG, *FL, *MP; bf16_t *SP, *CP;
    const bf16_t *KM, *VMT;
};

DI void gla_A_unit(const MixCtx& C, LAS unsigned char* lds, int h, int n, int tid) {
    const int lane = tid & 63, tg = __builtin_amdgcn_readfirstlane(tid >> 6), c2 = lane;
    LAS float* TOT = (LAS float*)(lds + L_MISC);
    LAS unsigned char* KT = lds + L_ST; LAS unsigned char* VT = lds + L_VT;
    float b[8][2], blast[2];
    gla_b(C.Z, C.wa, C.ba, h, n, tg, c2, TOT, b, blast);
    float k0[8], k1[8];
#pragma unroll
    for (int j = 0; j < 8; ++j) { const unsigned w = *(const unsigned*)(C.Z + (size_t)(n * CH + 8 * tg + j) * ZW + ZC_GK + h * 128 + 2 * c2);
        k0[j] = bflo(w) * __expf(blast[0] - b[j][0]); k1[j] = bfhi(w) * __expf(blast[1] - b[j][1]); }
    u32x4 lo, hi;
    lo.x = pk2(k0[0], k0[1]); lo.y = pk2(k0[2], k0[3]); lo.z = pk2(k0[4], k0[5]); lo.w = pk2(k0[6], k0[7]);
    hi.x = pk2(k1[0], k1[1]); hi.y = pk2(k1[2], k1[3]); hi.z = pk2(k1[4], k1[5]); hi.w = pk2(k1[6], k1[7]);
    *(LAS u32x4*)(KT + (2 * c2) * ROW72 + tg * 16) = lo; *(LAS u32x4*)(KT + (2 * c2 + 1) * ROW72 + tg * 16) = hi;
    if (tg == 0) *(f32x2*)(C.DECAY + (size_t)(h * NCH + n) * 128 + 2 * c2) = (f32x2){__expf(blast[0]), __expf(blast[1])};
    fill_vT(C.Z + ZC_GV + h * 256, n, tg, lane, VT);
    __syncthreads();
    state_mfma(VT, KT, C.DS + (size_t)(h * NCH + n) * 32768, tg, lane);
    __syncthreads();
}

DI void gla_B_unit(const MixCtx& C, LAS unsigned char* lds, int h, int n, int tid) {
    const int lane = tid & 63, w = __builtin_amdgcn_readfirstlane(tid >> 6), tg = w, c2 = lane, fr = lane & 15, fq = lane >> 4;
    LAS float* TOT = (LAS float*)(lds + L_MISC); LAS float* RS = (LAS float*)(lds + L_MISC + 4096);
    LAS unsigned char* ST = lds + L_ST; LAS unsigned char* VT = lds + L_VT; LAS unsigned char* QL = lds + L_Q; LAS unsigned char* KL = lds + L_K;
    copy_256x128(C.SP + (size_t)(h * NCH + n) * 32768, 128, ST, tid);
    float b[8][2], blast[2];
    gla_b(C.Z, C.wa, C.ba, h, n, tg, c2, TOT, b, blast);
    const float qs = 0.08838834764831845f;
#pragma unroll
    for (int j = 0; j < 8; ++j) { const size_t zr = (size_t)(n * CH + 8 * tg + j) * ZW;
        const unsigned wq = *(const unsigned*)(C.Z + zr + ZC_GQ + h * 128 + 2 * c2), wk = *(const unsigned*)(C.Z + zr + ZC_GK + h * 128 + 2 * c2);
        const float e0 = __expf(b[j][0]), e1 = __expf(b[j][1]);
        *(LAS unsigned*)(QL + (8 * tg + j) * ROW136 + 4 * c2) = pk2(bflo(wq) * qs * e0, bfhi(wq) * qs * e1);
        *(LAS unsigned*)(KL + (8 * tg + j) * ROW136 + 4 * c2) = pk2(bflo(wk) * __builtin_amdgcn_rcpf(e0), bfhi(wk) * __builtin_amdgcn_rcpf(e1)); }
    fill_vT(C.Z + ZC_GV + h * 256, n, tg, lane, VT);
    __syncthreads();
    f32x4 sacc[2];
    score_mfma(QL, KL, w, lane, sacc);
    __syncthreads();
    { const int mi = w >> 1, ni0 = 2 * (w & 1), t = 16 * mi + fr;
#pragma unroll
      for (int jn = 0; jn < 2; ++jn) { const int s0 = 16 * (ni0 + jn) + 4 * fq; f32x4 v = sacc[jn];
#pragma unroll
          for (int r = 0; r < 4; ++r) if (s0 + r > t) v[r] = 0.f;
          *(LAS u32x2*)(KL + t * ROW72 + s0 * 2) = (u32x2){pk2(v[0], v[1]), pk2(v[2], v[3])}; } }
    __syncthreads();
    const int wr = w >> 1, wc = w & 1, t = 16 * wr + fr;
    f32x4 o[8];
#pragma unroll
    for (int ni = 0; ni < 8; ++ni) o[ni] = (f32x4){0.f, 0.f, 0.f, 0.f};
#pragma unroll
    for (int ks = 0; ks < 2; ++ks) { const bf16x8 a = *(const LAS bf16x8*)(KL + t * ROW72 + (32 * ks + 8 * fq) * 2);
#pragma unroll
        for (int ni = 0; ni < 8; ++ni) { const bf16x8 bb = *(const LAS bf16x8*)(VT + (128 * wc + 16 * ni + fr) * ROW72 + (32 * ks + 8 * fq) * 2); o[ni] = mfma16(bb, a, o[ni]); } }
#pragma unroll
    for (int ks = 0; ks < 4; ++ks) { const bf16x8 a = *(const LAS bf16x8*)(QL + t * ROW136 + (32 * ks + 8 * fq) * 2);
#pragma unroll
        for (int ni = 0; ni < 8; ++ni) { const bf16x8 bb = *(const LAS bf16x8*)(ST + (128 * wc + 16 * ni + fr) * ROW136 + (32 * ks + 8 * fq) * 2); o[ni] = mfma16(bb, a, o[ni]); } }
    float ss = 0.f;
#pragma unroll
    for (int ni = 0; ni < 8; ++ni) ss += (o[ni][0] * o[ni][0] + o[ni][1] * o[ni][1]) + (o[ni][2] * o[ni][2] + o[ni][3] * o[ni][3]);
    ss += shx(ss, 16, lane); ss += shx(ss, 32, lane);
    if (fq == 0) RS[wc * 64 + t] = ss;
    __syncthreads();
    const float rstd = 1.0f / sqrtf((RS[t] + RS[64 + t]) * (1.0f / 256.0f) + EPS);
    const size_t tok = (size_t)(n * CH + t);
#pragma unroll
    for (int ni = 0; ni < 8; ++ni) { const int dv = 128 * wc + 16 * ni + 4 * fq;
        const u32x2 gg = *(const u32x2*)(C.Z + tok * ZW + ZC_GG + h * 256 + dv); const f32x4 gn = *(const f32x4*)(C.gla_norm + h * 256 + dv);
        const f32x4 v = o[ni] * rstd * gn;
        *(u32x2*)(C.OB + tok * OBW + h * 256 + dv) = (u32x2){pk2(v[0] * silu_f(bflo(gg.x)), v[1] * silu_f(bfhi(gg.x))), pk2(v[2] * silu_f(bflo(gg.y)), v[3] * silu_f(bfhi(gg.y)))}; }
    __syncthreads();
}

DI void ml_A_unit(const MixCtx& C, LAS unsigned char* lds, int h, int n, int tid) {
    const int lane = tid & 63, tg = __builtin_amdgcn_readfirstlane(tid >> 6), c2 = lane;
    LAS float* PART = (LAS float*)(lds + L_MISC);
    LAS unsigned char* KT = lds + L_ST; LAS unsigned char* VT = lds + L_VT;
    const size_t ztok = (size_t)(n * CH + lane) * ZW;
    const float li = bf2f(C.Z[ztok + ZC_MI + h]) + C.b_i[h];
    const float lf = log_sigmoid_f(bf2f(C.Z[ztok + ZC_MF + h]) + C.b_f[h]);
    const float F = wave_scan_sum(lf, lane);
    const float Flast = shi(F, 63);
    const float Gv = Flast - F + li;
    const float g = wave_max(Gv, lane);
    const float wG = __expf(Gv - g);
    float k0[8], k1[8];
    conv_silu8(C.Z + ZC_MQK + 512 + h * 128 + 2 * c2, C.conv_w + 512 + h * 128 + 2 * c2, C.conv_b + 512 + h * 128 + 2 * c2, n * CH + 8 * tg, k0, k1);
    const float ks = 0.08838834764831845f;
    float p0 = 0.f, p1 = 0.f;
#pragma unroll
    for (int j = 0; j < 8; ++j) { const float wj = shi(wG, 8 * tg + j) * ks; k0[j] *= wj; k1[j] *= wj; p0 += k0[j]; p1 += k1[j]; }
    u32x4 lo, hi;
    lo.x = pk2(k0[0], k0[1]); lo.y = pk2(k0[2], k0[3]); lo.z = pk2(k0[4], k0[5]); lo.w = pk2(k0[6], k0[7]);
    hi.x = pk2(k1[0], k1[1]); hi.y = pk2(k1[2], k1[3]); hi.z = pk2(k1[4], k1[5]); hi.w = pk2(k1[6], k1[7]);
    *(LAS u32x4*)(KT + (2 * c2) * ROW72 + tg * 16) = lo; *(LAS u32x4*)(KT + (2 * c2 + 1) * ROW72 + tg * 16) = hi;
    *(LAS f32x2*)(PART + tg * 128 + 2 * c2) = (f32x2){p0, p1};
    fill_vT(C.Z + ZC_MV + h * 256, n, tg, lane, VT);
    if (tid == 0) { C.GG[h * NCH + n] = g; C.FL[h * NCH + n] = Flast; }
    __syncthreads();
    if (tid < 128) { float s = 0.f;
#pragma unroll
        for (int q = 0; q < 8; ++q) s += PART[q * 128 + tid];
        C.DN[(size_t)(h * NCH + n) * 128 + tid] = s; }
    state_mfma(VT, KT, C.DC + (size_t)(h * NCH + n) * 32768, tg, lane);
    __syncthreads();
}

DI void ml_B_unit(const MixCtx& C, LAS unsigned char* lds, int h, int n, int tid) {
    const int lane = tid & 63, w = __builtin_amdgcn_readfirstlane(tid >> 6), tg = w, c2 = lane, fr = lane & 15, fq = lane >> 4;
    LAS float* MF = (LAS float*)(lds + L_MISC); LAS float* MU = MF + 64; LAS float* MM = MF + 128; LAS float* MW = MF + 192;
    LAS float* DENP = MF + 256; LAS float* DQN = MF + 512; LAS float* NPV = MF + 576; LAS float* RS = (LAS float*)(lds + L_MISC + 4096);
    LAS unsigned char* CT = lds + L_ST; LAS unsigned char* VT = lds + L_VT; LAS unsigned char* QL = lds + L_Q; LAS unsigned char* KL = lds + L_K;
    copy_256x128(C.CP + (size_t)(h * NCH + n) * 32768, 128, CT, tid);
    if (w == 0) {
        const size_t ztok = (size_t)(n * CH + lane) * ZW;
        const float li = bf2f(C.Z[ztok + ZC_MI + h]) + C.b_i[h];
        const float lf = log_sigmoid_f(bf2f(C.Z[ztok + ZC_MF + h]) + C.b_f[h]);
        const float F = wave_scan_sum(lf, lane);
        const float u = li - F;
        const float pm = wave_scan_max(u, lane);
        const float mprev = C.MP[h * NCH + n];
        const float m = F + fmaxf(pm, mprev);
        MF[lane] = F; MU[lane] = u; MM[lane] = m; MW[lane] = __expf(F + mprev - m);
    }
    if (w == 1) { NPV[lane] = C.NP[(size_t)(h * NCH + n) * 128 + lane]; NPV[64 + lane] = C.NP[(size_t)(h * NCH + n) * 128 + 64 + lane]; }
    {
        float q0[8], q1[8], k0[8], k1[8];
        conv_silu8(C.Z + ZC_MQK + h * 128 + 2 * c2, C.conv_w + h * 128 + 2 * c2, C.conv_b + h * 128 + 2 * c2, n * CH + 8 * tg, q0, q1);
        conv_silu8(C.Z + ZC_MQK + 512 + h * 128 + 2 * c2, C.conv_w + 512 + h * 128 + 2 * c2, C.conv_b + 512 + h * 128 + 2 * c2, n * CH + 8 * tg, k0, k1);
        const float ks = 0.08838834764831845f;
#pragma unroll
        for (int j = 0; j < 8; ++j) { *(LAS unsigned*)(QL + (8 * tg + j) * ROW136 + 4 * c2) = pk2(q0[j], q1[j]); *(LAS unsigned*)(KL + (8 * tg + j) * ROW136 + 4 * c2) = pk2(k0[j] * ks, k1[j] * ks); }
    }
    fill_vT(C.Z + ZC_MV + h * 256, n, tg, lane, VT);
    __syncthreads();
    f32x4 sacc[2];
    score_mfma(QL, KL, w, lane, sacc);
    {
        const int t = tid >> 3, part = tid & 7; float s = 0.f;
#pragma unroll
        for (int e = 0; e < 8; ++e) { const unsigned qq = *(const LAS unsigned*)(QL + t * ROW136 + (16 * part + 2 * e) * 2); s += bflo(qq) * NPV[16 * part + 2 * e] + bfhi(qq) * NPV[16 * part + 2 * e + 1]; }
        s += shx(s, 1, lane); s += shx(s, 2, lane); s += shx(s, 4, lane);
        if (part == 0) DQN[t] = s;
    }
    __syncthreads();
    { const int mi = w >> 1, ni0 = 2 * (w & 1), t = 16 * mi + fr; const float ft = MF[t] - MM[t];
#pragma unroll
      for (int jn = 0; jn < 2; ++jn) { const int s0 = 16 * (ni0 + jn) + 4 * fq; f32x4 v = sacc[jn]; const f32x4 us = *(const LAS f32x4*)(MU + s0);
          float ps = 0.f;
#pragma unroll
          for (int r = 0; r < 4; ++r) { v[r] = (s0 + r > t) ? 0.f : v[r] * __expf(ft + us[r]); ps += v[r]; }
          ps += shx(ps, 16, lane); ps += shx(ps, 32, lane);
          if (fq == 0) DENP[t * 4 + ni0 + jn] = ps;
          *(LAS u32x2*)(KL + t * ROW72 + s0 * 2) = (u32x2){pk2(v[0], v[1]), pk2(v[2], v[3])}; } }
    __syncthreads();
    const int wr = w >> 1, wc = w & 1, t = 16 * wr + fr;
    f32x4 o1[8], o2[8];
#pragma unroll
    for (int ni = 0; ni < 8; ++ni) { o1[ni] = (f32x4){0.f, 0.f, 0.f, 0.f}; o2[ni] = o1[ni]; }
#pragma unroll
    for (int ks = 0; ks < 2; ++ks) { const bf16x8 a = *(const LAS bf16x8*)(KL + t * ROW72 + (32 * ks + 8 * fq) * 2);
#pragma unroll
        for (int ni = 0; ni < 8; ++ni) { const bf16x8 bb = *(const LAS bf16x8*)(VT + (128 * wc + 16 * ni + fr) * ROW72 + (32 * ks + 8 * fq) * 2); o1[ni] = mfma16(bb, a, o1[ni]); } }
#pragma unroll
    for (int ks = 0; ks < 4; ++ks) { const bf16x8 a = *(const LAS bf16x8*)(QL + t * ROW136 + (32 * ks + 8 * fq) * 2);
#pragma unroll
        for (int ni = 0; ni < 8; ++ni) { const bf16x8 bb = *(const LAS bf16x8*)(CT + (128 * wc + 16 * ni + fr) * ROW136 + (32 * ks + 8 * fq) * 2); o2[ni] = mfma16(bb, a, o2[ni]); } }
    const float wi = MW[t];
    const f32x4 dp = *(const LAS f32x4*)(DENP + t * 4);
    const float den = ((dp[0] + dp[1]) + (dp[2] + dp[3])) + wi * DQN[t];
    const float inv = 1.0f / fmaxf(fabsf(den), __expf(-MM[t]));
    const size_t tok = (size_t)(n * CH + t);
    float ss = 0.f;
#pragma unroll
    for (int ni = 0; ni < 8; ++ni) { const int dv = 128 * wc + 16 * ni + 4 * fq;
        const u32x2 mo = *(const u32x2*)(C.Z + tok * ZW + ZC_MO + h * 256 + dv);
        f32x4 v = (o1[ni] + o2[ni] * wi) * inv;
        v[0] *= sigmoid_f(bflo(mo.x)); v[1] *= sigmoid_f(bfhi(mo.x)); v[2] *= sigmoid_f(bflo(mo.y)); v[3] *= sigmoid_f(bfhi(mo.y));
        o1[ni] = v; ss += (v[0] * v[0] + v[1] * v[1]) + (v[2] * v[2] + v[3] * v[3]); }
    ss += shx(ss, 16, lane); ss += shx(ss, 32, lane);
    if (fq == 0) RS[wc * 64 + t] = ss;
    __syncthreads();
    const float rstd = 1.0f / sqrtf((RS[t] + RS[64 + t]) * (1.0f / 256.0f) + EPS);
#pragma unroll
    for (int ni = 0; ni < 8; ++ni) { const int dv = 128 * wc + 16 * ni + 4 * fq; const f32x4 gn = *(const f32x4*)(C.ml_norm + h * 256 + dv);
        const f32x4 v = o1[ni] * rstd * gn;
        *(u32x2*)(C.OB + tok * OBW + 1024 + h * 256 + dv) = (u32x2){pk2(v[0], v[1]), pk2(v[2], v[3])}; }
    __syncthreads();
}

DI void scan_phase(const MixCtx& C, int tid) {
    const int NS = 2 * 65536;
    for (int slot = opaque_bx() * 512 + tid; slot < NS; slot += opaque_g() * 512) {
        const int br = slot >> 16, s = slot & 65535, h = s >> 14, dv = (s >> 6) & 255, dkp = s & 63;
        const size_t e0 = (size_t)h * NCH * 32768 + (size_t)dv * 128 + 2 * dkp;
        if (br == 0) {
            float s0 = 0.f, s1 = 0.f;
            for (int n0 = 0; n0 < NCH; n0 += 8) {
                f32x2 d[8], dec[8];
#pragma unroll
                for (int u = 0; u < 8; ++u) { d[u] = *(const f32x2*)(C.DS + e0 + (size_t)(n0 + u) * 32768); dec[u] = *(const f32x2*)(C.DECAY + (size_t)(h * NCH + n0 + u) * 128 + 2 * dkp); }
#pragma unroll
                for (int u = 0; u < 8; ++u) { *(unsigned*)(C.SP + e0 + (size_t)(n0 + u) * 32768) = pk2(s0, s1); s0 = dec[u].x * s0 + d[u].x; s1 = dec[u].y * s1 + d[u].y; }
            }
        } else {
            float c0 = 0.f, c1 = 0.f, nn0 = 0.f, nn1 = 0.f, m = -1e30f;
            for (int n0 = 0; n0 < NCH; n0 += 8) {
                f32x2 d[8], dn[8]; float fl[8], gl[8];
#pragma unroll
                for (int u = 0; u < 8; ++u) { d[u] = *(const f32x2*)(C.DC + e0 + (size_t)(n0 + u) * 32768); fl[u] = C.FL[h * NCH + n0 + u]; gl[u] = C.GG[h * NCH + n0 + u];
                    dn[u] = (dv == 0) ? *(const f32x2*)(C.DN + (size_t)(h * NCH + n0 + u) * 128 + 2 * dkp) : (f32x2){0.f, 0.f}; }
#pragma unroll
                for (int u = 0; u < 8; ++u) { *(unsigned*)(C.CP + e0 + (size_t)(n0 + u) * 32768) = pk2(c0, c1);
                    if (dv == 0) { *(f32x2*)(C.NP + (size_t)(h * NCH + n0 + u) * 128 + 2 * dkp) = (f32x2){nn0, nn1}; if (dkp == 0) C.MP[h * NCH + n0 + u] = m; }
                    const float mn = fmaxf(fl[u] + m, gl[u]); const float a = __expf(fl[u] + m - mn), bb = __expf(gl[u] - mn);
                    c0 = a * c0 + bb * d[u].x; c1 = a * c1 + bb * d[u].y; nn0 = a * nn0 + bb * dn[u].x; nn1 = a * nn1 + bb * dn[u].y; m = mn; }
            }
        }
    }
}

DI void mem_unit(const MixCtx& C, LAS unsigned char* lds, int h, int rb, int tid) {
    const int lane = tid & 63, w = __builtin_amdgcn_readfirstlane(tid >> 6), fr = lane & 15, fq = lane >> 4, wr = w >> 1, wc = w & 1, t = 16 * wr + fr;
    LAS unsigned char* QL = lds; LAS unsigned char* PL = lds + 33792; LAS unsigned char* KV = lds + 67584;
    LAS float* RMX = (LAS float*)(lds + L_MISC); LAS float* RSM = RMX + 128;
#pragma unroll
    for (int i = 0; i < 4; ++i) { const int id = tid + 512 * i, row = id >> 5, cc = id & 31;
        *(LAS u32x4*)(QL + row * ROW264 + cc * 16) = *(const u32x4*)(C.Z + (size_t)(rb * 64 + row) * ZW + ZC_XQ + h * 256 + cc * 8); }
    f32x4 s[8];
#pragma unroll
    for (int ni = 0; ni < 8; ++ni) s[ni] = (f32x4){0.f, 0.f, 0.f, 0.f};
#pragma unroll
    for (int half = 0; half < 2; ++half) {
        copy_256x128(C.KM + h * 256 + half * 128, 4096, KV, tid);
        __syncthreads();
#pragma unroll
        for (int ks = 0; ks < 4; ++ks) { const bf16x8 a = *(const LAS bf16x8*)(QL + t * ROW264 + (128 * half + 32 * ks + 8 * fq) * 2);
#pragma unroll
            for (int ni = 0; ni < 8; ++ni) { const bf16x8 bb = *(const LAS bf16x8*)(KV + (128 * wc + 16 * ni + fr) * ROW136 + (32 * ks + 8 * fq) * 2); s[ni] = mfma16(bb, a, s[ni]); } }
        __syncthreads();
    }
    float mx = -3.0e38f;
#pragma unroll
    for (int ni = 0; ni < 8; ++ni) { s[ni] = s[ni] * 0.0625f; mx = fmaxf(mx, fmaxf(fmaxf(s[ni][0], s[ni][1]), fmaxf(s[ni][2], s[ni][3]))); }
    mx = fmaxf(mx, shx(mx, 16, lane)); mx = fmaxf(mx, shx(mx, 32, lane));
    if (fq == 0) RMX[wc * 64 + t] = mx;
    copy_256x128(C.VMT + (size_t)(h * 256) * 256, 256, KV, tid);
    __syncthreads();
    mx = fmaxf(RMX[t], RMX[64 + t]);
    float sm = 0.f;
#pragma unroll
    for (int ni = 0; ni < 8; ++ni) {
#pragma unroll
        for (int r = 0; r < 4; ++r) { s[ni][r] = __expf(s[ni][r] - mx); sm += s[ni][r]; } }
    sm += shx(sm, 16, lane); sm += shx(sm, 32, lane);
    if (fq == 0) RSM[wc * 64 + t] = sm;
    __syncthreads();
    const float inv = 1.0f / (RSM[t] + RSM[64 + t]);
#pragma unroll
    for (int ni = 0; ni < 8; ++ni) { const f32x4 p = s[ni] * inv; *(LAS u32x2*)(PL + t * ROW264 + (128 * wc + 16 * ni + 4 * fq) * 2) = (u32x2){pk2(p[0], p[1]), pk2(p[2], p[3])}; }
    f32x4 o[8];
#pragma unroll
    for (int ni = 0; ni < 8; ++ni) o[ni] = (f32x4){0.f, 0.f, 0.f, 0.f};
#pragma unroll
    for (int half = 0; half < 2; ++half) {
        if (half == 1) copy_256x128(C.VMT + (size_t)(h * 256) * 256 + 128, 256, KV, tid);
        __syncthreads();
#pragma unroll
        for (int ks = 0; ks < 4; ++ks) { const bf16x8 a = *(const LAS bf16x8*)(PL + t * ROW264 + (128 * half + 32 * ks + 8 * fq) * 2);
#pragma unroll
            for (int ni = 0; ni < 8; ++ni) { const bf16x8 bb = *(const LAS bf16x8*)(KV + (128 * wc + 16 * ni + fr) * ROW136 + (32 * ks + 8 * fq) * 2); o[ni] = mfma16(bb, a, o[ni]); } }
        __syncthreads();
    }
    const size_t tok = (size_t)(rb * 64 + t);
#pragma unroll
    for (int ni = 0; ni < 8; ++ni) { const int d = 128 * wc + 16 * ni + 4 * fq; *(u32x2*)(C.OB + tok * OBW + 2048 + h * 256 + d) = (u32x2){pk2(o[ni][0], o[ni][1]), pk2(o[ni][2], o[ni][3])}; }
}

#define GEMM_ALIGN true
#define GEMM_SP2 true
constexpr int L_PTR = L_BARW + 256;
DI unsigned long long tab_ld(LAS unsigned char* lds, int k) {
    const unsigned long long v = *(volatile LAS unsigned long long*)(lds + L_PTR + 8 * k);
    const unsigned lo = __builtin_amdgcn_readfirstlane((unsigned)v), hi = __builtin_amdgcn_readfirstlane((unsigned)(v >> 32));
    return ((unsigned long long)hi << 32) | lo;
}
DI const float* tab_in(LAS unsigned char* lds, int k) { return (const float*)tab_ld(lds, k); }
DI unsigned char* tab_ws(LAS unsigned char* lds) { return (unsigned char*)tab_ld(lds, 24); }
DI void grid_bar(LAS unsigned char* lds) {
    XcdBarrier b; b.bar = (unsigned*)(tab_ws(lds) + WS_CTL) + CW_BAR; b.x = xb_xcc_id(); b.st = (volatile LAS unsigned*)(lds + L_BARW);
    xcd_barrier(b);
}
DI void make_ctx(MixCtx& C, LAS unsigned char* lds, int l) {
    unsigned char* ws = tab_ws(lds);
    C.Z = (const bf16_t*)(ws + WS_Z); C.OB = (bf16_t*)(ws + WS_OB);
    C.wa = tab_in(lds, I_W_GLA_A) + (size_t)l * 16 * 512; C.ba = tab_in(lds, I_B_GLA_A) + l * 512; C.gla_norm = tab_in(lds, I_GLA_NORM) + l * 1024;
    C.conv_w = tab_in(lds, I_CONV_W) + (size_t)l * 4 * 1024; C.conv_b = tab_in(lds, I_CONV_B) + l * 1024; C.b_i = tab_in(lds, I_B_ML_I) + l * 4; C.b_f = tab_in(lds, I_B_ML_F) + l * 4; C.ml_norm = tab_in(lds, I_ML_NORM) + l * 1024;
    C.DS = (float*)(ws + WS_DS); C.DC = (float*)(ws + WS_DC); C.SP = (bf16_t*)(ws + WS_SP); C.CP = (bf16_t*)(ws + WS_CP);
    C.DECAY = (float*)(ws + WS_SMALL + SM_DECAY); C.DN = (float*)(ws + WS_SMALL + SM_DN); C.NP = (float*)(ws + WS_SMALL + SM_NP);
    C.GG = (float*)(ws + WS_SMALL + SM_GG); C.FL = (float*)(ws + WS_SMALL + SM_FL); C.MP = (float*)(ws + WS_SMALL + SM_MP);
    C.KM = (const bf16_t*)(ws + WS_KM) + l * 1024; C.VMT = (const bf16_t*)(ws + WS_VMT) + (size_t)l * 1024 * 256;
}

__global__ void __launch_bounds__(512, 2) trunk_fwd(Params p) {
    extern __shared__ __attribute__((aligned(16))) unsigned char lds_raw[];
    LAS unsigned char* lds0 = (LAS unsigned char*)lds_raw;
    {
        LAS unsigned char* lds = lds0;
        const int tid0 = threadIdx.x;
        if (tid0 < 64) ((LAS unsigned*)(lds + L_BARW))[tid0] = 0u;
        if (tid0 < 23) *(LAS unsigned long long*)(lds + L_PTR + 8 * tid0) = (unsigned long long)p.in[tid0];
        if (tid0 == 23) *(LAS unsigned long long*)(lds + L_PTR + 8 * 23) = (unsigned long long)p.out;
        if (tid0 == 24) *(LAS unsigned long long*)(lds + L_PTR + 8 * 24) = (unsigned long long)p.ws;
        __syncthreads();
        (void)xcd_barrier_post((unsigned*)(p.ws + WS_CTL) + CW_BAR, (volatile LAS unsigned*)(lds + L_BARW));
    }
#define TID (opaque_tid())
#define LANE (opaque_tid() & 63)
#define WAVE (__builtin_amdgcn_readfirstlane(opaque_tid() >> 6))
#define GW (opaque_bx() * NWAVES + WAVE)
#define NGW (opaque_g() * NWAVES)

    {
        LAS unsigned char* lds = opaque_lds(lds0); unsigned char* ws = tab_ws(lds);
        bf16_t* WIN = (bf16_t*)(ws + WS_WIN);
        const int lane = LANE, wave = WAVE;
        LAS float* scr = (LAS float*)(lds + wave * 16640);
        constexpr int IT_IN = 64 * 117, IT_BR = 16 * 64, IT_G = 4 * 64, IT_OUT = 64 * 64, IT_F1 = 64 * 256, IT_F2 = 256 * 64, IT_MK = 64 * 16;
        constexpr int E_IN = 4 * IT_IN, E_BR = E_IN + 12 * IT_BR, E_G = E_BR + 12 * IT_G, E_OUT = E_G + 4 * IT_OUT, E_F1 = E_OUT + 4 * IT_F1, E_F2 = E_F1 + 4 * IT_F2, E_MK = E_F2 + 4 * IT_MK, E_MV = E_MK + 4 * IT_MK;
        for (int it = GW; it < E_MV; it += NGW) {
            if (it < E_IN) { const int l = it / IT_IN, r = it - l * IT_IN; transpose_item(tab_in(lds, I_W_IN) + (size_t)l * DM * IN_W, DM, IN_W, WIN + (size_t)l * ZW * DM, DM, 0, 0, true, scr, r, lane); }
            else if (it < E_BR) { const int q = it - E_IN, lj = q / IT_BR, r = q - lj * IT_BR, l = lj / 3, j = lj - 3 * l; transpose_item(tab_in(lds, I_W_BRANCH) + (size_t)lj * 1024 * DM, 1024, DM, (bf16_t*)(ws + WS_WBR) + (size_t)l * DM * OBW, OBW, j * 1024, 0, false, scr, r, lane); }
            else if (it < E_G) { const int q = it - E_BR, lj = q / IT_G, r = q - lj * IT_G, l = lj / 3, j = lj - 3 * l; transpose_item(tab_in(lds, I_W_GATE) + (size_t)lj * 256 * DM, 256, DM, (bf16_t*)(ws + WS_WG) + (size_t)l * GTW * 256, 256, 0, j * DM, false, scr, r, lane); }
            else if (it < E_OUT) { const int q = it - E_G, l = q / IT_OUT, r = q - l * IT_OUT; transpose_item(tab_in(lds, I_W_OUT) + (size_t)l * DM * DM, DM, DM, (bf16_t*)(ws + WS_WOUT) + (size_t)l * DM * DM, DM, 0, 0, false, scr, r, lane); }
            else if (it < E_F1) { const int q = it - E_OUT, l = q / IT_F1, r = q - l * IT_F1; transpose_item(tab_in(lds, I_W_FF1) + (size_t)l * DM * DFF, DM, DFF, (bf16_t*)(ws + WS_W1) + (size_t)l * DFF * DM, DM, 0, 0, false, scr, r, lane); }
            else if (it < E_F2) { const int q = it - E_F1, l = q / IT_F2, r = q - l * IT_F2; transpose_item(tab_in(lds, I_W_FF2) + (size_t)l * DFF * DM, DFF, DM, (bf16_t*)(ws + WS_W2) + (size_t)l * DM * DFF, DFF, 0, 0, false, scr, r, lane); }
            else if (it < E_MK) { const int q = it - E_F2, l = q / IT_MK, r = q - l * IT_MK; transpose_item(tab_in(lds, I_W_MEM_K) + (size_t)l * DM * 1024, DM, 1024, (bf16_t*)(ws + WS_WMK), DM, 0, l * 1024, false, scr, r, lane); }
            else { const int q = it - E_MK, l = q / IT_MK, r = q - l * IT_MK; transpose_item(tab_in(lds, I_W_MEM_V) + (size_t)l * DM * 1024, DM, 1024, (bf16_t*)(ws + WS_WMV), DM, 0, l * 1024, false, scr, r, lane); }
        }
        constexpr int PADCH = (ZW - IN_W) * DM / 8;
        for (int i = opaque_bx() * 512 + TID; i < NL * PADCH; i += opaque_g() * 512) { const int l = i / PADCH, r = i - l * PADCH; *(u32x4*)(WIN + (size_t)l * ZW * DM + (size_t)IN_W * DM + (size_t)r * 8) = (u32x4){0u, 0u, 0u, 0u}; }
        for (int m = GW; m < MEML; m += NGW) rmsnorm_row<false>(tab_in(lds, I_MEM) + (size_t)m * DM, tab_in(lds, I_MEM_NORM), (bf16_t*)(ws + WS_MEMN) + (size_t)m * DM, lane);
    }
    grid_bar(opaque_lds(lds0));
    {
        LAS unsigned char* lds = opaque_lds(lds0); unsigned char* ws = tab_ws(lds);
        { pg8::Gemm g{(const bf16_t*)(ws + WS_MEMN), (const bf16_t*)(ws + WS_WMK), opq(MEML), opq(DM), opq(DM), opq(DM), opq(DM)}; pg8::StaticOrder S; S.init(opq(MEML), opq(DM), opaque_g(), opaque_bx()); pg8::EpiBf16<0> E{(bf16_t*)(ws + WS_KM), DM, nullptr};
          pg8::gemm_phase<pg8::EpiBf16<0>, pg8::StaticOrder, GEMM_ALIGN, GEMM_SP2>(lds, g, S, E); }
    }
    {
        LAS unsigned char* lds = opaque_lds(lds0); unsigned char* ws = tab_ws(lds);
        { pg8::Gemm g{(const bf16_t*)(ws + WS_WMV), (const bf16_t*)(ws + WS_MEMN), opq(DM), opq(MEML), opq(DM), opq(DM), opq(DM)}; pg8::StaticOrder S; S.init(opq(DM), opq(MEML), opaque_g(), (opaque_bx() + 16) % opaque_g()); pg8::EpiBf16<0> E{(bf16_t*)(ws + WS_VMT), MEML, nullptr};
          pg8::gemm_phase<pg8::EpiBf16<0>, pg8::StaticOrder, GEMM_ALIGN, GEMM_SP2>(lds, g, S, E); }
    }
    grid_bar(opaque_lds(lds0));

    for (int l = 0; l < NL; ++l) {
        {
            LAS unsigned char* lds = opaque_lds(lds0); unsigned char* ws = tab_ws(lds);
            const float* Xin = (l == 0) ? tab_in(lds, I_X) : (const float*)(ws + WS_X);
            const float* gain = tab_in(lds, I_NORM_MIX) + l * DM; bf16_t* H = (bf16_t*)(ws + WS_H); const int lane = LANE;
            for (int m = GW; m < SEQ; m += NGW) rmsnorm_row<false>(Xin + (size_t)m * DM, gain, H + (size_t)m * DM, lane);
        }
        grid_bar(opaque_lds(lds0));
        {
            LAS unsigned char* lds = opaque_lds(lds0); unsigned char* ws = tab_ws(lds);
            pg8::Gemm g{(const bf16_t*)(ws + WS_H), (const bf16_t*)(ws + WS_WIN) + (size_t)l * ZW * DM, opq(SEQ), opq(ZW), opq(DM), opq(DM), opq(DM)}; pg8::StaticOrder S; S.init(opq(SEQ), opq(ZW), opaque_g(), opaque_bx()); pg8::EpiBf16<0> E{(bf16_t*)(ws + WS_Z), ZW, nullptr};
            pg8::gemm_phase<pg8::EpiBf16<0>, pg8::StaticOrder, GEMM_ALIGN, GEMM_SP2>(lds, g, S, E);
        }
        grid_bar(opaque_lds(lds0));
        {
            LAS unsigned char* lds = opaque_lds(lds0); MixCtx C; make_ctx(C, lds, l); const int tid = TID;
            for (int i = opaque_bx(); i < 4 * NCH; i += opaque_g()) gla_A_unit(C, lds, i >> 8, i & 255, tid);
            for (int i = opaque_bx(); i < 4 * NCH; i += opaque_g()) ml_A_unit(C, lds, i >> 8, i & 255, tid);
            for (int i = opaque_bx(); i < 4 * NCH; i += opaque_g()) mem_unit(C, lds, i >> 8, i & 255, tid);
        }
        {
            LAS unsigned char* lds = opaque_lds(lds0); unsigned char* ws = tab_ws(lds);
            pg8::Gemm g{(const bf16_t*)(ws + WS_Z) + ZC_GATE, (const bf16_t*)(ws + WS_WG) + (size_t)l * GTW * 256, opq(SEQ), opq(GTW), opq(256), opq(ZW), opq(256)}; pg8::StaticOrder S; S.init(opq(SEQ), opq(GTW), opaque_g(), opaque_bx());
            pg8::EpiBf16<2> E{(bf16_t*)(ws + WS_GT), GTW, tab_in(lds, I_B_GATE) + (size_t)l * GTW};
            pg8::gemm_phase<pg8::EpiBf16<2>, pg8::StaticOrder, GEMM_ALIGN, GEMM_SP2>(lds, g, S, E);
        }
        grid_bar(opaque_lds(lds0));
        { LAS unsigned char* lds = opaque_lds(lds0); MixCtx C; make_ctx(C, lds, l); scan_phase(C, TID); }
        grid_bar(opaque_lds(lds0));
        {
            LAS unsigned char* lds = opaque_lds(lds0); MixCtx C; make_ctx(C, lds, l); const int tid = TID;
            for (int i = opaque_bx(); i < 4 * NCH; i += opaque_g()) gla_B_unit(C, lds, i >> 8, i & 255, tid);
            for (int i = opaque_bx(); i < 4 * NCH; i += opaque_g()) ml_B_unit(C, lds, i >> 8, i & 255, tid);
        }
        grid_bar(opaque_lds(lds0));
        {
            LAS unsigned char* lds = opaque_lds(lds0); unsigned char* ws = tab_ws(lds);
            pg8::Gemm g{(const bf16_t*)(ws + WS_OB), (const bf16_t*)(ws + WS_WBR) + (size_t)l * DM * OBW, opq(SEQ), opq(DM), opq(OBW), opq(OBW), opq(OBW)}; pg8::StaticOrder S; S.init(opq(SEQ), opq(DM), opaque_g(), opaque_bx()); pg8::EpiBranch E{(bf16_t*)(ws + WS_Y), DM, (const bf16_t*)(ws + WS_GT)};
            pg8::gemm_phase<pg8::EpiBranch, pg8::StaticOrder, GEMM_ALIGN, GEMM_SP2>(lds, g, S, E);
        }
        grid_bar(opaque_lds(lds0));
        {
            LAS unsigned char* lds = opaque_lds(lds0); unsigned char* ws = tab_ws(lds);
            const float* Xin = (l == 0) ? tab_in(lds, I_X) : (const float*)(ws + WS_X);
            pg8::Gemm g{(const bf16_t*)(ws + WS_Y), (const bf16_t*)(ws + WS_WOUT) + (size_t)l * DM * DM, opq(SEQ), opq(DM), opq(DM), opq(DM), opq(DM)}; pg8::StaticOrder S; S.init(opq(SEQ), opq(DM), opaque_g(), opaque_bx()); pg8::EpiResid E{Xin, (float*)(ws + WS_X), DM};
            pg8::gemm_phase<pg8::EpiResid, pg8::StaticOrder, GEMM_ALIGN, GEMM_SP2>(lds, g, S, E);
        }
        grid_bar(opaque_lds(lds0));
        {
            LAS unsigned char* lds = opaque_lds(lds0); unsigned char* ws = tab_ws(lds);
            const float* X = (const float*)(ws + WS_X); const float* gain = tab_in(lds, I_NORM_FFN) + l * DM; bf16_t* H = (bf16_t*)(ws + WS_H); const int lane = LANE;
            for (int m = GW; m < SEQ; m += NGW) rmsnorm_row<false>(X + (size_t)m * DM, gain, H + (size_t)m * DM, lane);
        }
        grid_bar(opaque_lds(lds0));
        {
            LAS unsigned char* lds = opaque_lds(lds0); unsigned char* ws = tab_ws(lds);
            pg8::Gemm g{(const bf16_t*)(ws + WS_H), (const bf16_t*)(ws + WS_W1) + (size_t)l * DFF * DM, opq(SEQ), opq(DFF), opq(DM), opq(DM), opq(DM)}; pg8::StaticOrder S; S.init(opq(SEQ), opq(DFF), opaque_g(), opaque_bx()); pg8::EpiBf16<1> E{(bf16_t*)(ws + WS_U), DFF, nullptr};
            pg8::gemm_phase<pg8::EpiBf16<1>, pg8::StaticOrder, GEMM_ALIGN, GEMM_SP2>(lds, g, S, E);
        }
        grid_bar(opaque_lds(lds0));
        {
            LAS unsigned char* lds = opaque_lds(lds0); unsigned char* ws = tab_ws(lds);
            pg8::Gemm g{(const bf16_t*)(ws + WS_U), (const bf16_t*)(ws + WS_W2) + (size_t)l * DM * DFF, opq(SEQ), opq(DM), opq(DFF), opq(DFF), opq(DFF)}; pg8::StaticOrder S; S.init(opq(SEQ), opq(DM), opaque_g(), opaque_bx()); pg8::EpiResid E{(const float*)(ws + WS_X), (float*)(ws + WS_X), DM};
            pg8::gemm_phase<pg8::EpiResid, pg8::StaticOrder, GEMM_ALIGN, GEMM_SP2>(lds, g, S, E);
        }
        grid_bar(opaque_lds(lds0));
    }
    {
        LAS unsigned char* lds = opaque_lds(lds0); unsigned char* ws = tab_ws(lds);
        const float* X = (const float*)(ws + WS_X); const float* gain = tab_in(lds, I_FINAL_NORM); float* out = (float*)tab_ld(lds, 23); const int lane = LANE;
        for (int m = GW; m < SEQ; m += NGW) rmsnorm_row<true>(X + (size_t)m * DM, gain, out + (size_t)m * DM, lane);
    }
}

extern "C" void kernel_launch(void* const* d_in, const int* in_sizes, int n_in, void* d_out, int out_size, void* d_ws, size_t ws_size, hipStream_t stream) {
    static int grid = 0;
    if (grid == 0) {
        if (n_in != 23 || out_size != SEQ * DM || ws_size < WS_END) { fprintf(stderr, "kernel_launch: unexpected shapes (n_in %d out %d ws %zu, need %zu)\n", n_in, out_size, ws_size, (size_t)WS_END); grid = -1; return; }
        int dev = 0, cus = 0, per_cu = 0;
        if (hipGetDevice(&dev) != hipSuccess || hipDeviceGetAttribute(&cus, hipDeviceAttributeMultiprocessorCount, dev) != hipSuccess) { grid = -1; return; }
        if (hipFuncSetAttribute((const void*)trunk_fwd, hipFuncAttributeMaxDynamicSharedMemorySize, LDS_BYTES) != hipSuccess) { fprintf(stderr, "kernel_launch: hipFuncSetAttribute failed\n"); grid = -1; return; }
        if (hipOccupancyMaxActiveBlocksPerMultiprocessor(&per_cu, (const void*)trunk_fwd, 512, LDS_BYTES) != hipSuccess || per_cu < 1) { fprintf(stderr, "kernel_launch: occupancy query says %d\n", per_cu); (void)hipGetLastError(); }
        grid = cus;
    }
    if (grid < 0) return;
    if (hipMemsetAsync((char*)d_ws + WS_CTL, 0, CTL_ZERO_BYTES, stream) != hipSuccess) return;
    Params p{};
    for (int i = 0; i < 23; ++i) p.in[i] = (const float*)d_in[i];
    p.out = (float*)d_out; p.ws = (unsigned char*)d_ws;
    hipLaunchKernelGGL(trunk_fwd, dim3(grid), dim3(512), LDS_BYTES, stream, p);
}
```

```cpp
#include <hip/hip_runtime.h>
#include <cstdio>
#include <cstdint>

#define DI __device__ __forceinline__
#define GAS __attribute__((address_space(1)))
#define LAS __attribute__((address_space(3)))
typedef unsigned short bf16_t;
typedef short bf16x8 __attribute__((ext_vector_type(8)));
typedef float f32x4 __attribute__((ext_vector_type(4)));
typedef float f32x2 __attribute__((ext_vector_type(2)));
typedef unsigned u32x4 __attribute__((ext_vector_type(4)));
typedef unsigned u32x2 __attribute__((ext_vector_type(2)));

constexpr int SEQ = 16384, DM = 4096, DFF = 16384, NL = 4, MEML = 256, CH = 64, NCH = SEQ / CH;
constexpr int IN_W = 7448, ZW = 7680;
constexpr int ZC_GQ = 0, ZC_GK = 512, ZC_GV = 1024, ZC_GG = 2048, ZC_MQK = 3072, ZC_MV = 4096, ZC_MO = 5120, ZC_XQ = 6144, ZC_GATE = 7168, ZC_GA = 7424, ZC_MI = 7440, ZC_MF = 7444;
constexpr int OBW = 3072;
constexpr int GTW = 12288;
constexpr float EPS = 1e-6f;

constexpr size_t MiB = 1u << 20;
constexpr size_t WS_CTL = 0, CTL_ZERO_BYTES = 1 * MiB;
constexpr size_t WS_WIN = 1 * MiB, WS_WBR = 241 * MiB, WS_WG = 337 * MiB, WS_WOUT = 361 * MiB, WS_W1 = 489 * MiB, WS_W2 = 1001 * MiB;
constexpr size_t WS_WMK = 1513 * MiB, WS_WMV = 1545 * MiB, WS_MEMN = 1577 * MiB, WS_KM = 1579 * MiB, WS_VMT = 1581 * MiB;
constexpr size_t WS_X = 1583 * MiB, WS_H = 1839 * MiB, WS_Z = 1967 * MiB, WS_GT = 2207 * MiB, WS_U = WS_Z  ;
constexpr size_t WS_OB = 2591 * MiB, WS_Y = 2687 * MiB, WS_DS = 2815 * MiB, WS_SP = 2943 * MiB, WS_DC = 3007 * MiB, WS_CP = 3135 * MiB;
constexpr size_t WS_SMALL = 3199 * MiB, WS_SS = 3201 * MiB, SS_ZERO_BYTES = 2 * MiB, WS_END = 3203 * MiB;
constexpr size_t SM_DECAY = 0, SM_DN = 512 * 1024, SM_NP = 1024 * 1024, SM_GG = 1536 * 1024, SM_FL = 1536 * 1024 + 4096, SM_MP = 1536 * 1024 + 8192;
static_assert(WS_U + (size_t)SEQ * DFF * 2 <= WS_OB, "U overlay");
constexpr int CW_BAR = 4096;
static_assert(9 * (size_t)SEQ * 8 <= SS_ZERO_BYTES, "SS region");
typedef unsigned long long u64_t;
DI float ss_to_f(u64_t v) { return (float)v * (1.0f / 16777216.0f); }

constexpr int LDS_BYTES = 147456;
constexpr int L_ST = 0, L_VT = 69632, L_Q = 106496, L_K = 123904, L_MISC = 141312, L_BARW = 146432;
constexpr int ROW72 = 144, ROW136 = 272, ROW264 = 528;
constexpr int NWAVES = 8;

DI float bf2f(unsigned v) { return __uint_as_float(v << 16); }
DI float bflo(unsigned w) { return __uint_as_float(w << 16); }
DI float bfhi(unsigned w) { return __uint_as_float(w & 0xffff0000u); }
typedef __bf16 bf16x2_t __attribute__((ext_vector_type(2)));
DI unsigned pk2(float lo, float hi) { const f32x2 v = {lo, hi}; const bf16x2_t b = __builtin_convertvector(v, bf16x2_t); return __builtin_bit_cast(unsigned, b); }
DI float sigmoid_f(float x) { return 1.0f / (1.0f + __expf(-x)); }
DI float silu_f(float x) { return x * sigmoid_f(x); }
DI float log_sigmoid_f(float x) { return fminf(x, 0.f) - __logf(1.0f + __expf(-fabsf(x))); }
DI float shx(float v, int o, int lane) { return __int_as_float(__builtin_amdgcn_ds_bpermute((lane ^ o) << 2, __float_as_int(v))); }
DI float shi(float v, int src) { return __int_as_float(__builtin_amdgcn_ds_bpermute(src << 2, __float_as_int(v))); }
DI float wave_sum(float v, int lane) {
#pragma unroll
    for (int o = 1; o < 64; o <<= 1) v += shx(v, o, lane);
    return v;
}
DI float wave_max(float v, int lane) {
#pragma unroll
    for (int o = 1; o < 64; o <<= 1) v = fmaxf(v, shx(v, o, lane));
    return v;
}
DI float wave_scan_sum(float v, int lane) {
#pragma unroll
    for (int o = 1; o < 64; o <<= 1) { const float t = shi(v, lane >= o ? lane - o : lane); if (lane >= o) v += t; }
    return v;
}
DI float wave_scan_max(float v, int lane) {
#pragma unroll
    for (int o = 1; o < 64; o <<= 1) { const float t = shi(v, lane >= o ? lane - o : lane); if (lane >= o) v = fmaxf(v, t); }
    return v;
}
DI f32x4 mfma16(bf16x8 a, bf16x8 b, f32x4 c) { return __builtin_amdgcn_mfma_f32_16x16x32_bf16(a, b, c, 0, 0, 0); }
DI int opaque_tid() { int t = (int)threadIdx.x; asm volatile("" : "+v"(t)); return t; }
DI int opaque_bx() { int b = (int)blockIdx.x; asm volatile("" : "+s"(b)); return b; }
DI LAS unsigned char* opaque_lds(LAS unsigned char* p) { asm volatile("" : "+s"(p)); return p; }
DI int opq(int v) { asm volatile("" : "+s"(v)); return v; }
DI int opaque_g() { int g = (int)gridDim.x; asm volatile("" : "+s"(g)); return g; }

namespace pg8 {
#define PG8_LAS __attribute__((address_space(3)))
constexpr int BM = 256, BK = 64, HALF = 128, HTB = HALF * BK * 2  , STAGE_BYTES = 8 * HTB, NXCD = 8, WGM = 8;

__host__ __device__ __forceinline__ int lds_byte(int r, int c) { const int st = (r >> 4) * 2 + (c >> 5), rr = r & 15, cc = c & 31, ob = rr * 64 + cc * 2; return st * 1024 + (ob ^ (((ob >> 9) & 1) << 5)); }
__host__ __device__ __forceinline__ void stage_rc(int b, int& R, int& C) { const int st = b / 1024, sb = b % 1024, swz = sb ^ (((sb >> 9) & 1) << 5); R = (st >> 1) * 16 + swz / 64; C = (st & 1) * 32 + (swz % 64) / 2; }
__host__ __device__ __forceinline__ int perm32(int rho) { const int n = rho >> 4, i = rho & 15; return 8 * (i >> 2) + 4 * n + (i & 3); }

struct Unit { int pm, pn; };
struct Gemm { const bf16_t* A; const bf16_t* Bt; int M, N, K, lda, ldb; };

struct StaticOrder {
    int nM, nN, nwg, G, c;
    __host__ __device__ void init(int M, int N, int G_, int c_) { nM = M / BM; nN = N / BM; nwg = nM * nN; G = G_; c = c_; }
    __host__ __device__ bool next(int i, Unit& u) const {
        const long L = (long)i * G + c; if (L >= nwg) return false;
        int wgid = (int)L; { const int q = nwg / NXCD, r = nwg % NXCD, xcd = wgid % NXCD, off = wgid / NXCD; wgid = (xcd < r ? xcd * (q + 1) : r * (q + 1) + (xcd - r) * q) + off; }
        const int nig = WGM * nN, gid = wgid / nig, fm = gid * WGM, gsz = (nM - fm) < WGM ? (nM - fm) : WGM;
        u.pm = fm + ((wgid % nig) % gsz); u.pn = (wgid % nig) / gsz; return true;
    }
    __device__ __forceinline__ void a_ready(const Unit&) const {}
    __device__ __forceinline__ void done(const Unit&) const {}
};

template <int ACT  > struct EpiBf16 {
    static constexpr bool PERM = true, AFTER_DRAIN = false, HOOK = false;
    bf16_t* O; int ldc; const float* bias; const unsigned long long* ss;
    __device__ __forceinline__ void operator()(const f32x4 (&acc)[2][2][4][2], const Unit& u, int wr, int wc, int fr, int fq) const {
        const int row0 = u.pm * BM + wr * 64 + fr, col0 = u.pn * BM + wc * 32 + 8 * fq;
        f32x4 bv[2][2];
#pragma unroll
        for (int bj = 0; bj < 2; ++bj)
#pragma unroll
            for (int n = 0; n < 2; ++n) bv[bj][n] = (ACT == 2) ? *(const f32x4*)(bias + col0 + bj * HALF + 4 * n) : (f32x4){0.f, 0.f, 0.f, 0.f};
#pragma unroll
        for (int ai = 0; ai < 2; ++ai)
#pragma unroll
            for (int m = 0; m < 4; ++m) { bf16_t* rowp = O + (size_t)(row0 + ai * HALF + m * 16) * ldc + col0;
                float rs = 1.f; if (ACT != 2) { if (ss) rs = 1.0f / sqrtf((float)ss[row0 + ai * HALF + m * 16] * (1.0f / 16777216.0f) * (1.0f / DM) + EPS); }
#pragma unroll
                for (int bj = 0; bj < 2; ++bj) { f32x4 v0 = acc[ai][bj][m][0], v1 = acc[ai][bj][m][1];
                    if (ACT != 2) { v0 = v0 * rs; v1 = v1 * rs; }
                    if (ACT == 1) {
#pragma unroll
                        for (int j = 0; j < 4; ++j) { const float a = fmaxf(v0[j], 0.f), b = fmaxf(v1[j], 0.f); v0[j] = a * a; v1[j] = b * b; } }
                    if (ACT == 2) { v0 = v0 + bv[bj][0]; v1 = v1 + bv[bj][1];
#pragma unroll
                        for (int j = 0; j < 4; ++j) { v0[j] = sigmoid_f(fminf(fmaxf(v0[j], -30.f), 30.f)); v1[j] = sigmoid_f(fminf(fmaxf(v1[j], -30.f), 30.f)); } }
                    u32x4 w; w.x = pk2(v0[0], v0[1]); w.y = pk2(v0[2], v0[3]); w.z = pk2(v1[0], v1[1]); w.w = pk2(v1[2], v1[3]);
                    *(u32x4*)(rowp + bj * HALF) = w; } }
    }
    __device__ __forceinline__ bool hook_at(int) const { return false; }
    __device__ __forceinline__ void hook(f32x4 (&)[2][2][4][2], const Unit&, int, int, int, int, int) const {}
};
struct EpiResid {
    static constexpr bool PERM = true, AFTER_DRAIN = false, HOOK = false;
    const float* in; float* out; int ldc; bf16_t* xb; unsigned long long* ss;
    __device__ __forceinline__ void operator()(const f32x4 (&acc)[2][2][4][2], const Unit& u, int wr, int wc, int fr, int fq) const {
        const int row0 = u.pm * BM + wr * 64 + fr, col0 = u.pn * BM + wc * 32 + 8 * fq, lane = fq * 16 + fr;
#pragma unroll
        for (int ai = 0; ai < 2; ++ai)
#pragma unroll
            for (int m = 0; m < 4; ++m) { const int row = row0 + ai * HALF + m * 16; const size_t off = (size_t)row * ldc + col0;
                f32x4 r[2][2];
#pragma unroll
                for (int bj = 0; bj < 2; ++bj)
#pragma unroll
                    for (int n = 0; n < 2; ++n) r[bj][n] = *(const f32x4*)(in + off + bj * HALF + n * 4);
                float sq = 0.f;
#pragma unroll
                for (int bj = 0; bj < 2; ++bj) { const f32x4 o0 = r[bj][0] + acc[ai][bj][m][0], o1 = r[bj][1] + acc[ai][bj][m][1];
                    *(f32x4*)(out + off + bj * HALF) = o0; *(f32x4*)(out + off + bj * HALF + 4) = o1;
                    sq += (o0[0] * o0[0] + o0[1] * o0[1]) + (o0[2] * o0[2] + o0[3] * o0[3]) + (o1[0] * o1[0] + o1[1] * o1[1]) + (o1[2] * o1[2] + o1[3] * o1[3]);
                    u32x4 w; w.x = pk2(o0[0], o0[1]); w.y = pk2(o0[2], o0[3]); w.z = pk2(o1[0], o1[1]); w.w = pk2(o1[2], o1[3]);
                    *(u32x4*)(xb + off + bj * HALF) = w; }
                sq += shx(sq, 16, lane); sq += shx(sq, 32, lane);
                if (fq == 0) (void)__hip_atomic_fetch_add(ss + row, (unsigned long long)(sq * 16777216.0f), __ATOMIC_RELAXED, __HIP_MEMORY_SCOPE_AGENT);
                asm volatile("" ::: "memory"); }
    }
    __device__ __forceinline__ bool hook_at(int) const { return false; }
    __device__ __forceinline__ void hook(f32x4 (&)[2][2][4][2], const Unit&, int, int, int, int, int) const {}
};
struct EpiBranch {
    static constexpr bool PERM = true, AFTER_DRAIN = false, HOOK = true;
    bf16_t* O; int ldc; const bf16_t* GT;
    __device__ __forceinline__ bool hook_at(int t) const { return t == 16 || t == 32; }
    __device__ __forceinline__ void hook(f32x4 (&acc)[2][2][4][2], const Unit& u, int t, int, int, int, int) const {
        const int tid_ = opaque_tid(), wid_ = tid_ >> 6, wr = wid_ >> 2, wc = wid_ & 3, fr = tid_ & 15, fq = (tid_ >> 4) & 3;
        const int row0 = u.pm * BM + wr * 64 + fr, col0 = u.pn * BM + wc * 32 + 8 * fq;
        const bf16_t* ga = GT + (size_t)(t == 16 ? 0 : DM); const bf16_t* gb = ga + DM;
#pragma unroll
        for (int ai = 0; ai < 2; ++ai)
#pragma unroll
            for (int m = 0; m < 4; ++m) { const size_t off = (size_t)(row0 + ai * HALF + m * 16) * GTW + col0;
#pragma unroll
                for (int bj = 0; bj < 2; ++bj) { const u32x4 a = *(const u32x4*)(ga + off + bj * HALF), b = *(const u32x4*)(gb + off + bj * HALF);
                    f32x4 r0, r1;
                    r0[0] = bflo(a.x) * __builtin_amdgcn_rcpf(bflo(b.x)); r0[1] = bfhi(a.x) * __builtin_amdgcn_rcpf(bfhi(b.x));
                    r0[2] = bflo(a.y) * __builtin_amdgcn_rcpf(bflo(b.y)); r0[3] = bfhi(a.y) * __builtin_amdgcn_rcpf(bfhi(b.y));
                    r1[0] = bflo(a.z) * __builtin_amdgcn_rcpf(bflo(b.z)); r1[1] = bfhi(a.z) * __builtin_amdgcn_rcpf(bfhi(b.z));
                    r1[2] = bflo(a.w) * __builtin_amdgcn_rcpf(bflo(b.w)); r1[3] = bfhi(a.w) * __builtin_amdgcn_rcpf(bfhi(b.w));
                    acc[ai][bj][m][0] = acc[ai][bj][m][0] * r0; acc[ai][bj][m][1] = acc[ai][bj][m][1] * r1; }
                asm volatile("" ::: "memory"); }
    }
    __device__ __forceinline__ void operator()(const f32x4 (&acc)[2][2][4][2], const Unit& u, int wr, int wc, int fr, int fq) const {
        const int row0 = u.pm * BM + wr * 64 + fr, col0 = u.pn * BM + wc * 32 + 8 * fq;
        const bf16_t* gc = GT + 2 * DM;
#pragma unroll
        for (int ai = 0; ai < 2; ++ai)
#pragma unroll
            for (int m = 0; m < 4; ++m) { const size_t r = (size_t)(row0 + ai * HALF + m * 16);
#pragma unroll
                for (int bj = 0; bj < 2; ++bj) { const u32x4 g = *(const u32x4*)(gc + r * GTW + col0 + bj * HALF);
                    const f32x4 v0 = acc[ai][bj][m][0], v1 = acc[ai][bj][m][1];
                    u32x4 w; w.x = pk2(v0[0] * bflo(g.x), v0[1] * bfhi(g.x)); w.y = pk2(v0[2] * bflo(g.y), v0[3] * bfhi(g.y));
                    w.z = pk2(v1[0] * bflo(g.z), v1[1] * bfhi(g.z)); w.w = pk2(v1[2] * bflo(g.w), v1[3] * bfhi(g.w));
                    *(u32x4*)(O + r * ldc + col0 + bj * HALF) = w; }
                asm volatile("" ::: "memory"); }
    }
};

template <class Epi, class Sched, bool ALIGN_EPI = false, bool SP2 = false>
__device__ __forceinline__ void gemm_phase(PG8_LAS unsigned char* lds, const Gemm g, const Sched& S, const Epi& E) {
    const int tid = opaque_tid(), wid = __builtin_amdgcn_readfirstlane(tid >> 6), lane = tid & 63, wr = wid >> 2, wc = wid & 3, fr = lane & 15, fq = lane >> 4;
    const int K = g.K, nt = K / BK;
    unsigned voffA[2], voffB[2];
#pragma unroll
    for (int i = 0; i < 2; ++i) { int R, C; stage_rc(tid * 16 + i * 8192, R, C); const int Rb = Epi::PERM ? ((R & ~31) + perm32(R & 31)) : R;
        voffA[i] = (unsigned)(R * g.lda + C) * 2u; voffB[i] = (unsigned)(Rb * g.ldb + C) * 2u; }
    const size_t kstep = (size_t)(BK * 2);
    const size_t hstepA = (size_t)HALF * g.lda * 2, hstepB = (size_t)HALF * g.ldb * 2;
    const size_t tstepA = 2 * hstepA, tstepB = 2 * hstepB;
    const unsigned ldsw = (unsigned)wid * 1024u;
    const int aoff = lds_byte(wr * 64 + fr, fq * 8), boff = lds_byte(wc * 32 + fr, fq * 8);
#define PG8_SA(b, h) (((b) * 2 + (h)) * HTB)
#define PG8_SB(b, h) ((4 + (b) * 2 + (h)) * HTB)
#define PG8_STAGE(bufoff, gbase, voff) do { _Pragma("unroll") for (int _i = 0; _i < 2; ++_i) \
        __builtin_amdgcn_global_load_lds((const unsigned*)((const char*)(gbase) + (voff)[_i]), (PG8_LAS unsigned*)(lds + (bufoff) + ldsw + _i * 8192), 16, 0, 0); } while (0)
#define PG8_LDA(dst, b, h) do { _Pragma("unroll") for (int m = 0; m < 4; ++m) _Pragma("unroll") for (int k = 0; k < 2; ++k) dst[m][k] = *(const PG8_LAS bf16x8*)(lds + PG8_SA(b, h) + aoff + m * 2048 + k * 1024); } while (0)
#define PG8_LDB(dst, b, h) do { _Pragma("unroll") for (int n = 0; n < 2; ++n) _Pragma("unroll") for (int k = 0; k < 2; ++k) dst[n][k] = *(const PG8_LAS bf16x8*)(lds + PG8_SB(b, h) + boff + n * 2048 + k * 1024); } while (0)
#define PG8_MMA(ai, bj, At, Bt) do { __builtin_amdgcn_s_setprio(1); _Pragma("unroll") for (int m = 0; m < 4; ++m) _Pragma("unroll") for (int n = 0; n < 2; ++n) _Pragma("unroll") for (int k = 0; k < 2; ++k) \
        acc[ai][bj][m][n] = __builtin_amdgcn_mfma_f32_16x16x32_bf16(Bt[n][k], At[m][k], acc[ai][bj][m][n], 0, 0, 0); __builtin_amdgcn_s_setprio(0); } while (0)
#define PG8_WAIT_V(n) asm volatile("s_waitcnt vmcnt(" #n ")" ::: "memory")
#define PG8_WAIT_L(n) asm volatile("s_waitcnt lgkmcnt(" #n ")" ::: "memory")
#define PG8_BAR __builtin_amdgcn_s_barrier()
#define PG8_SCHED __builtin_amdgcn_sched_barrier(0)
    Unit cur, nxt; int ui = 0;
    if (!S.next(0, cur)) return;
    f32x4 acc[2][2][4][2];
#pragma unroll
    for (int a = 0; a < 2; ++a)
#pragma unroll
        for (int b = 0; b < 2; ++b)
#pragma unroll
            for (int m = 0; m < 4; ++m)
#pragma unroll
                for (int n = 0; n < 2; ++n) acc[a][b][m][n] = (f32x4){0.f, 0.f, 0.f, 0.f};
    bf16x8 At[4][2], B0[2][2], B1[2][2];
    const char* cA = (const char*)g.A + (size_t)cur.pm * tstepA; const char* cB = (const char*)g.Bt + (size_t)cur.pn * tstepB;
    S.a_ready(cur);
    if constexpr (SP2) {
        PG8_STAGE(PG8_SB(0, 0), cB, voffB); PG8_STAGE(PG8_SB(0, 1), cB + hstepB, voffB); PG8_STAGE(PG8_SA(0, 0), cA, voffA); PG8_STAGE(PG8_SA(0, 1), cA + hstepA, voffA);
        if (wr == 1) PG8_BAR;
        PG8_WAIT_V(2); PG8_BAR;
        PG8_STAGE(PG8_SB(1, 0), cB + kstep, voffB); PG8_STAGE(PG8_SA(1, 0), cA + kstep, voffA); PG8_STAGE(PG8_SB(1, 1), cB + hstepB + kstep, voffB);
        PG8_WAIT_V(6); PG8_BAR;
    } else {
        PG8_STAGE(PG8_SB(0, 0), cB, voffB); PG8_STAGE(PG8_SA(0, 0), cA, voffA); PG8_STAGE(PG8_SB(0, 1), cB + hstepB, voffB); PG8_STAGE(PG8_SA(0, 1), cA + hstepA, voffA);
        if (wr == 1) PG8_BAR;
        PG8_WAIT_V(4); PG8_BAR;
        PG8_STAGE(PG8_SB(1, 0), cB + kstep, voffB); PG8_STAGE(PG8_SA(1, 0), cA + kstep, voffA); PG8_STAGE(PG8_SB(1, 1), cB + hstepB + kstep, voffB);
        PG8_WAIT_V(6); PG8_BAR;
    }
    for (;;) {
        const bool has_next = S.next(ui + 1, nxt);
        const char* nA = has_next ? (const char*)g.A + (size_t)nxt.pm * tstepA : cA; const char* nB = has_next ? (const char*)g.Bt + (size_t)nxt.pn * tstepB : cB;
        for (int t = 0; t < nt; t += 2) {
            const bool last = (t == nt - 2);
            if constexpr (Epi::HOOK) { if (E.hook_at(t)) E.hook(acc, cur, t, wr, wc, fr, fq); }
            const char* a1 = cA + (size_t)(t + 1) * kstep;
            const char* a2 = last ? nA : cA + (size_t)(t + 2) * kstep; const char* b2 = last ? nB : cB + (size_t)(t + 2) * kstep;
            const char* a3 = a2 + kstep; const char* b3 = b2 + kstep;
            if (last && has_next) S.a_ready(nxt);
            if constexpr (SP2) {
            PG8_LDB(B0, 0, 0); PG8_LDB(B1, 0, 1); PG8_SCHED; PG8_LDA(At, 0, 0); PG8_STAGE(PG8_SA(1, 1), a1 + hstepA, voffA);
            PG8_WAIT_V(8); PG8_WAIT_L(0); PG8_BAR; PG8_MMA(0, 0, At, B0); PG8_MMA(0, 1, At, B1); PG8_BAR; PG8_SCHED;
            PG8_LDA(At, 0, 1); PG8_STAGE(PG8_SB(0, 0), b2, voffB); PG8_STAGE(PG8_SB(0, 1), b2 + hstepB, voffB); PG8_STAGE(PG8_SA(0, 0), a2, voffA);
            PG8_WAIT_V(8); PG8_WAIT_L(0); PG8_BAR; PG8_MMA(1, 0, At, B0); PG8_MMA(1, 1, At, B1); PG8_BAR; PG8_SCHED;
            PG8_LDB(B0, 1, 0); PG8_LDB(B1, 1, 1); PG8_SCHED; PG8_LDA(At, 1, 0); PG8_STAGE(PG8_SA(0, 1), a2 + hstepA, voffA);
            PG8_WAIT_V(8); PG8_WAIT_L(0); PG8_BAR; PG8_MMA(0, 0, At, B0); PG8_MMA(0, 1, At, B1); PG8_BAR; PG8_SCHED;
            PG8_LDA(At, 1, 1); PG8_STAGE(PG8_SB(1, 0), b3, voffB); PG8_STAGE(PG8_SB(1, 1), b3 + hstepB, voffB); PG8_STAGE(PG8_SA(1, 0), a3, voffA);
            PG8_WAIT_V(8); PG8_WAIT_L(0); PG8_BAR; PG8_MMA(1, 0, At, B0); PG8_MMA(1, 1, At, B1); PG8_BAR; PG8_SCHED;
            } else {
            PG8_LDB(B0, 0, 0); PG8_SCHED; PG8_LDA(At, 0, 0); PG8_STAGE(PG8_SA(1, 1), a1 + hstepA, voffA);
            PG8_WAIT_L(8); PG8_BAR; PG8_WAIT_L(0); PG8_MMA(0, 0, At, B0); PG8_BAR; PG8_SCHED;
            PG8_LDB(B1, 0, 1); PG8_STAGE(PG8_SB(0, 0), b2, voffB);
            PG8_BAR; PG8_WAIT_L(0); PG8_MMA(0, 1, At, B1); PG8_BAR;
            PG8_LDA(At, 0, 1); PG8_STAGE(PG8_SA(0, 0), a2, voffA);
            PG8_BAR; PG8_WAIT_L(0); PG8_MMA(1, 0, At, B0); PG8_BAR; PG8_SCHED;
            PG8_STAGE(PG8_SB(0, 1), b2 + hstepB, voffB);
            PG8_WAIT_V(6); PG8_BAR; PG8_MMA(1, 1, At, B1); PG8_BAR;
            PG8_LDB(B0, 1, 0); PG8_SCHED; PG8_LDA(At, 1, 0); PG8_STAGE(PG8_SA(0, 1), a2 + hstepA, voffA);
            PG8_WAIT_L(8); PG8_BAR; PG8_WAIT_L(0); PG8_MMA(0, 0, At, B0); PG8_BAR; PG8_SCHED;
            PG8_LDB(B1, 1, 1); PG8_STAGE(PG8_SB(1, 0), b3, voffB);
            PG8_BAR; PG8_WAIT_L(0); PG8_MMA(0, 1, At, B1); PG8_BAR;
            PG8_LDA(At, 1, 1); PG8_STAGE(PG8_SA(1, 0), a3, voffA);
            PG8_BAR; PG8_WAIT_L(0); PG8_MMA(1, 0, At, B0); PG8_BAR; PG8_SCHED;
            PG8_STAGE(PG8_SB(1, 1), b3 + hstepB, voffB);
            PG8_WAIT_V(6); PG8_BAR; PG8_MMA(1, 1, At, B1); PG8_BAR;
            }
        }
        if constexpr (ALIGN_EPI) { if (wr == 0) PG8_BAR; }
        E(acc, cur, wr, wc, fr, fq); S.done(cur);
        if (!has_next) break;
#pragma unroll
        for (int a = 0; a < 2; ++a)
#pragma unroll
            for (int b = 0; b < 2; ++b)
#pragma unroll
                for (int m = 0; m < 4; ++m)
#pragma unroll
                    for (int n = 0; n < 2; ++n) acc[a][b][m][n] = (f32x4){0.f, 0.f, 0.f, 0.f};
        cur = nxt; cA = nA; cB = nB; ++ui;
        if constexpr (ALIGN_EPI) { if (wr == 1) PG8_BAR; }
    }
    PG8_WAIT_V(0);
    if constexpr (!ALIGN_EPI) { if (wr == 0) PG8_BAR; }
    PG8_BAR;
#undef PG8_SA
#undef PG8_SB
#undef PG8_STAGE
#undef PG8_LDA
#undef PG8_LDB
#undef PG8_MMA
#undef PG8_WAIT_V
#undef PG8_WAIT_L
#undef PG8_BAR
#undef PG8_SCHED
}
}

#define XB_TMO      128
#define XB_XCNT(j)  (256  + 64 * (j))
#define XB_XSUB(j)  (1280 + 64 * (j))
#define XB_XGEN(j)  (2304 + 64 * (j))
#define XB_TOP      3328
#define XB_TOPGEN   3392
#define XCD_BAR_WORDS 3456
#define XB_SPIN_CAP (1u << 18)

__device__ __forceinline__ unsigned xb_ld(unsigned* p)              { return __hip_atomic_load(p, __ATOMIC_RELAXED, __HIP_MEMORY_SCOPE_AGENT); }
__device__ __forceinline__ unsigned xb_add(unsigned* p, unsigned v) { return __hip_atomic_fetch_add(p, v, __ATOMIC_RELAXED, __HIP_MEMORY_SCOPE_AGENT); }
__device__ __forceinline__ unsigned xb_xcc_id() { return (unsigned)__builtin_amdgcn_s_getreg((3 << 11) | 20) & 0xFu; }
#define XB_SPIN(cond, bar) do { unsigned _sp = 0; while (cond) { __builtin_amdgcn_s_sleep(1); \
    if ((++_sp & 255u) == 0u) { if (xb_ld(&(bar)[XB_TMO])) break; if (_sp > XB_SPIN_CAP) { atomicAdd(&(bar)[XB_TMO], 1u); break; } } } } while (0)

struct XcdBarrier {
    unsigned* bar; unsigned x;
    volatile LAS unsigned* st;
};
__device__ __forceinline__ XcdBarrier xcd_barrier_post(unsigned* bar, volatile LAS unsigned* st) {
    XcdBarrier b; b.bar = bar; b.x = xb_xcc_id(); b.st = st;
    if (threadIdx.x == 0) (void)xb_add(&bar[XB_XCNT(b.x)], 1u);
    return b;
}
__device__ __forceinline__ void xcd_barrier_complete(unsigned* bar, unsigned x, unsigned& nloc, unsigned& nx) {
    const unsigned G = gridDim.x * gridDim.y * gridDim.z;
    unsigned sum, cnt, mine, sp = 0u;
    for (;;) {
        sum = 0u; cnt = 0u; mine = 0u;
#pragma unroll
        for (unsigned j = 0; j < 16; ++j) { const unsigned c = xb_ld(&bar[XB_XCNT(j)]); sum += c; cnt += (c > 0u) ? 1u : 0u; mine = (j == x) ? c : mine; }
        if (sum == G) break;
        __builtin_amdgcn_s_sleep(1);
        if ((++sp & 255u) == 0u) { if (xb_ld(&bar[XB_TMO])) break; if (sp > XB_SPIN_CAP) { atomicAdd(&bar[XB_TMO], 1u); break; } }
    }
    nloc = mine > 0u ? mine : 1u; nx = cnt > 0u ? cnt : 1u;
}
__device__ __forceinline__ void xcd_barrier(const XcdBarrier& b) {
    asm volatile("s_waitcnt vmcnt(0)" ::: "memory");
    __syncthreads();
    if (threadIdx.x == 0) {
        unsigned* bar = b.bar;
        __builtin_amdgcn_s_waitcnt(0);
        unsigned nloc = b.st[0], nx = b.st[1];
        if (nloc == 0u) { xcd_barrier_complete(bar, b.x, nloc, nx); b.st[0] = nloc; b.st[1] = nx; }
        const unsigned old = xb_add(&bar[XB_XSUB(b.x)], 1u);
        const unsigned gen = old / nloc;
        if (old + 1u == (gen + 1u) * nloc) {
            __builtin_amdgcn_fence(__ATOMIC_RELEASE, "agent");
            asm volatile("s_waitcnt vmcnt(0)" ::: "memory");
            const unsigned og = xb_add(&bar[XB_TOP], 1u);
            const unsigned tg = og / nx;
            if (og + 1u == (tg + 1u) * nx) xb_add(&bar[XB_TOPGEN], 1u);
            else XB_SPIN(xb_ld(&bar[XB_TOPGEN]) == tg, bar);
            __builtin_amdgcn_fence(__ATOMIC_ACQUIRE, "agent");
            xb_add(&bar[XB_XGEN(b.x)], 1u);
            asm volatile("s_waitcnt vmcnt(0)" ::: "memory");
        } else {
            XB_SPIN(xb_ld(&bar[XB_XGEN(b.x)]) == gen, bar);
            __builtin_amdgcn_fence(__ATOMIC_ACQUIRE, "agent");
            asm volatile("s_waitcnt vmcnt(0)" ::: "memory");
        }
    }
    __syncthreads();
}

struct Params { const float* in[23]; float* out; unsigned char* ws; };
enum { I_X = 0, I_MEM, I_NORM_MIX, I_W_IN, I_W_GLA_A, I_B_GLA_A, I_GLA_NORM, I_CONV_W, I_CONV_B, I_B_ML_I, I_B_ML_F, I_ML_NORM, I_MEM_NORM, I_W_MEM_K, I_W_MEM_V, I_W_BRANCH, I_W_GATE, I_B_GATE, I_W_OUT, I_NORM_FFN, I_W_FF1, I_W_FF2, I_FINAL_NORM };

DI int win_row(int n) {
    if (n < 3072) return n;
    if (n < 3088) return ZC_GA + (n - 3072);
    if (n < 6160) return n - 16;
    if (n < 6168) return ZC_MI + (n - 6160);
    return n - 24;
}
DI void transpose_item(const float* __restrict__ W, int K, int N, bf16_t* __restrict__ WT, int ld_dst, int col_off, int row_off, bool remap, LAS float* scr, int item, int lane, const float* __restrict__ gain = nullptr) {
    const int nblk = (N + 63) >> 6, kb = item / nblk, nb = item - kb * nblk, k0 = kb << 6, n0 = nb << 6;
    const int a = lane & 15, q = lane >> 4, n4 = 4 * a;
    const bool ok = (n0 + n4) < N;
    f32x4 v[16];
#pragma unroll
    for (int i = 0; i < 16; ++i) { const int kk = 4 * i + q; v[i] = ok ? *(const f32x4*)(W + (size_t)(k0 + kk) * N + n0 + n4) : (f32x4){0.f, 0.f, 0.f, 0.f}; }
#pragma unroll
    for (int i = 0; i < 16; ++i) { const int kk = 4 * i + q;
#pragma unroll
        for (int e = 0; e < 4; ++e) scr[(n4 + e) * 65 + kk] = v[i][e]; }
    asm volatile("s_waitcnt lgkmcnt(0)" ::: "memory");
    const int c = lane & 7;
    f32x4 g0 = (f32x4){1.f, 1.f, 1.f, 1.f}, g1 = g0;
    if (gain) { g0 = *(const f32x4*)(gain + k0 + 8 * c); g1 = *(const f32x4*)(gain + k0 + 8 * c + 4); }
#pragma unroll
    for (int jj = 0; jj < 8; ++jj) { const int n = (lane >> 3) + 8 * jj; const LAS float* s = scr + n * 65 + 8 * c;
        u32x4 o; o.x = pk2(s[0] * g0[0], s[1] * g0[1]); o.y = pk2(s[2] * g0[2], s[3] * g0[3]); o.z = pk2(s[4] * g1[0], s[5] * g1[1]); o.w = pk2(s[6] * g1[2], s[7] * g1[3]);
        const int ng = n0 + n;
        if (ng < N) { const int row = row_off + (remap ? win_row(ng) : ng); *(u32x4*)(WT + (size_t)row * ld_dst + col_off + k0 + 8 * c) = o; } }
    asm volatile("s_waitcnt lgkmcnt(0)" ::: "memory");
}

template <bool OUT_F32> DI void rmsnorm_row(const float* __restrict__ xrow, const float* __restrict__ g, void* orow, int lane) {
    const f32x4* xr = (const f32x4*)xrow + lane; const f32x4* gr = (const f32x4*)g + lane;
    f32x4 v[16]; float s = 0.f;
#pragma unroll
    for (int j = 0; j < 16; ++j) { v[j] = xr[64 * j]; s += (v[j].x * v[j].x + v[j].y * v[j].y) + (v[j].z * v[j].z + v[j].w * v[j].w); }
    const float rstd = 1.0f / sqrtf(wave_sum(s, lane) * (1.0f / DM) + EPS);
#pragma unroll
    for (int j = 0; j < 16; ++j) { const f32x4 gg = gr[64 * j]; const f32x4 o = v[j] * rstd * gg;
        if (OUT_F32) ((f32x4*)orow)[lane + 64 * j] = o;
        else { u32x2 w; w.x = pk2(o.x, o.y); w.y = pk2(o.z, o.w); ((u32x2*)orow)[lane + 64 * j] = w; } }
}

DI void row_bf16_ss(const float* __restrict__ xrow, bf16_t* orow, unsigned long long* ss, int lane) {
    const f32x4* xr = (const f32x4*)xrow + lane; float s = 0.f;
#pragma unroll
    for (int j = 0; j < 16; ++j) { const f32x4 v = xr[64 * j]; s += (v.x * v.x + v.y * v.y) + (v.z * v.z + v.w * v.w);
        u32x2 w; w.x = pk2(v.x, v.y); w.y = pk2(v.z, v.w); ((u32x2*)orow)[lane + 64 * j] = w; }
    s = wave_sum(s, lane);
    if (lane == 0) *ss = (unsigned long long)(s * 16777216.0f);
}
DI void row_scale_f32(const float* __restrict__ xrow, const float* __restrict__ g, float ssv, float* orow, int lane) {
    const f32x4* xr = (const f32x4*)xrow + lane; const f32x4* gr = (const f32x4*)g + lane;
    const float rstd = 1.0f / sqrtf(ssv * (1.0f / DM) + EPS);
#pragma unroll
    for (int j = 0; j < 16; ++j) ((f32x4*)orow)[lane + 64 * j] = xr[64 * j] * rstd * gr[64 * j];
}

DI void fill_vT(const bf16_t* __restrict__ Zv, int n, int tg, int lane, LAS unsigned char* VT) {
#pragma unroll
    for (int i = 0; i < 2; ++i) { const int cp = lane + 64 * i; unsigned w[8];
#pragma unroll
        for (int j = 0; j < 8; ++j) w[j] = *(const unsigned*)(Zv + (size_t)(n * CH + 8 * tg + j) * ZW + 2 * cp);
        u32x4 lo, hi;
        lo.x = (w[0] & 0xffffu) | (w[1] << 16); lo.y = (w[2] & 0xffffu) | (w[3] << 16); lo.z = (w[4] & 0xffffu) | (w[5] << 16); lo.w = (w[6] & 0xffffu) | (w[7] << 16);
        hi.x = (w[0] >> 16) | (w[1] & 0xffff0000u); hi.y = (w[2] >> 16) | (w[3] & 0xffff0000u); hi.z = (w[4] >> 16) | (w[5] & 0xffff0000u); hi.w = (w[6] >> 16) | (w[7] & 0xffff0000u);
        *(LAS u32x4*)(VT + (2 * cp) * ROW72 + tg * 16) = lo; *(LAS u32x4*)(VT + (2 * cp + 1) * ROW72 + tg * 16) = hi; }
}
DI void state_mfma(const LAS unsigned char* VT, const LAS unsigned char* KT, float* __restrict__ OUT, int w, int lane) {
    const int fr = lane & 15, fq = lane >> 4;
    f32x4 acc[2][8];
#pragma unroll
    for (int mi = 0; mi < 2; ++mi)
#pragma unroll
        for (int ni = 0; ni < 8; ++ni) acc[mi][ni] = (f32x4){0.f, 0.f, 0.f, 0.f};
#pragma unroll
    for (int ks = 0; ks < 2; ++ks) {
        bf16x8 a[2];
#pragma unroll
        for (int mi = 0; mi < 2; ++mi) a[mi] = *(const LAS bf16x8*)(VT + (32 * w + 16 * mi + fr) * ROW72 + (32 * ks + 8 * fq) * 2);
#pragma unroll
        for (int ni = 0; ni < 8; ++ni) { const bf16x8 b = *(const LAS bf16x8*)(KT + (16 * ni + fr) * ROW72 + (32 * ks + 8 * fq) * 2);
#pragma unroll
            for (int mi = 0; mi < 2; ++mi) acc[mi][ni] = mfma16(b, a[mi], acc[mi][ni]); }
    }
#pragma unroll
    for (int mi = 0; mi < 2; ++mi)
#pragma unroll
        for (int ni = 0; ni < 8; ++ni) *(f32x4*)(OUT + (size_t)(32 * w + 16 * mi + fr) * 128 + 16 * ni + 4 * fq) = acc[mi][ni];
}
DI void copy_256x128(const bf16_t* __restrict__ src, int gp, LAS unsigned char* dst, int tid) {
#pragma unroll
    for (int i = 0; i < 8; ++i) { const int id = tid + 512 * i, row = id >> 4, cc = id & 15;
        *(LAS u32x4*)(dst + row * ROW136 + cc * 16) = *(const u32x4*)(src + (size_t)row * gp + cc * 8); }
}
DI void gla_b(const bf16_t* __restrict__ Z, const float* __restrict__ wa, const float* __restrict__ ba, int h, int n, int tg, int c2, LAS float* TOT, float (&b)[8][2], float (&blast)[2]) {
    const int col = h * 128 + 2 * c2;
    float w0[16], w1[16];
#pragma unroll
    for (int r = 0; r < 16; ++r) { const f32x2 w = *(const f32x2*)(wa + r * 512 + col); w0[r] = w.x; w1[r] = w.y; }
    const f32x2 bb = *(const f32x2*)(ba + col);
    float c0 = 0.f, c1 = 0.f;
#pragma unroll
    for (int j = 0; j < 8; ++j) {
        const bf16_t* gp = Z + (size_t)(n * CH + 8 * tg + j) * ZW + ZC_GA;
        const u32x4 g0 = *(const u32x4*)gp, g1 = *(const u32x4*)(gp + 8);
        const float gv[16] = {bflo(g0.x), bfhi(g0.x), bflo(g0.y), bfhi(g0.y), bflo(g0.z), bfhi(g0.z), bflo(g0.w), bfhi(g0.w),
                              bflo(g1.x), bfhi(g1.x), bflo(g1.y), bfhi(g1.y), bflo(g1.z), bfhi(g1.z), bflo(g1.w), bfhi(g1.w)};
        float p0 = bb.x, p1 = bb.y;
#pragma unroll
        for (int r = 0; r < 16; ++r) { p0 += gv[r] * w0[r]; p1 += gv[r] * w1[r]; }
        c0 += log_sigmoid_f(p0) * (1.0f / 16.0f); c1 += log_sigmoid_f(p1) * (1.0f / 16.0f);
        b[j][0] = c0; b[j][1] = c1;
    }
    *(LAS f32x2*)(TOT + tg * 128 + 2 * c2) = (f32x2){c0, c1};
    __syncthreads();
    float pre0 = 0.f, pre1 = 0.f, t0 = 0.f, t1 = 0.f;
#pragma unroll
    for (int g = 0; g < 8; ++g) { const f32x2 t = *(const LAS f32x2*)(TOT + g * 128 + 2 * c2); if (g < tg) { pre0 += t.x; pre1 += t.y; } t0 += t.x; t1 += t.y; }
#pragma unroll
    for (int j = 0; j < 8; ++j) { b[j][0] += pre0; b[j][1] += pre1; }
    blast[0] = t0; blast[1] = t1;
}
DI void conv_silu8(const bf16_t* __restrict__ Zc, const float* __restrict__ cw, const float* __restrict__ cb, int tok0, float (&o0)[8], float (&o1)[8]) {
    float x0[11], x1[11];
#pragma unroll
    for (int i = 0; i < 11; ++i) { const int tok = tok0 - 3 + i; unsigned w = 0u; if (tok >= 0) w = *(const unsigned*)(Zc + (size_t)tok * ZW); x0[i] = bflo(w); x1[i] = bfhi(w); }
    f32x2 wj[4];
#pragma unroll
    for (int j = 0; j < 4; ++j) wj[j] = *(const f32x2*)(cw + j * 1024);
    const f32x2 bias = *(const f32x2*)cb;
#pragma unroll
    for (int j = 0; j < 8; ++j) { float y0 = bias.x, y1 = bias.y;
#pragma unroll
        for (int jj = 0; jj < 4; ++jj) { y0 += wj[jj].x * x0[j + jj]; y1 += wj[jj].y * x1[j + jj]; }
        o0[j] = silu_f(y0); o1[j] = silu_f(y1); }
}
DI void score_mfma(const LAS unsigned char* QL, const LAS unsigned char* KL, int w, int lane, f32x4 (&sacc)[2]) {
    const int fr = lane & 15, fq = lane >> 4, mi = w >> 1, ni0 = 2 * (w & 1);
    sacc[0] = (f32x4){0.f, 0.f, 0.f, 0.f}; sacc[1] = sacc[0];
#pragma unroll
    for (int ks = 0; ks < 4; ++ks) { const bf16x8 a = *(const LAS bf16x8*)(QL + (16 * mi + fr) * ROW136 + (32 * ks + 8 * fq) * 2);
#pragma unroll
        for (int jn = 0; jn < 2; ++jn) { const bf16x8 b = *(const LAS bf16x8*)(KL + (16 * (ni0 + jn) + fr) * ROW136 + (32 * ks + 8 * fq) * 2); sacc[jn] = mfma16(b, a, sacc[jn]); } }
}

struct MixCtx {
    const bf16_t* Z; bf16_t* OB;
    const float *wa, *ba, *gla_norm, *conv_w, *conv_b, *b_i, *b_f, *ml_norm;
    float *DS, *DC, *DECAY, *DN, *NP, *GG, *FL, *MP; bf16_t *SP, *CP;
    const bf16_t *KM, *VMT;
};

DI void gla_A_unit(const MixCtx& C, LAS unsigned char* lds, int h, int n, int tid) {
    const int lane = tid & 63, tg = __builtin_amdgcn_readfirstlane(tid >> 6), c2 = lane;
    LAS float* TOT = (LAS float*)(lds + L_MISC);
    LAS unsigned char* KT = lds + L_ST; LAS unsigned char* VT = lds + L_VT;
    float b[8][2], blast[2];
    gla_b(C.Z, C.wa, C.ba, h, n, tg, c2, TOT, b, blast);
    float k0[8], k1[8];
#pragma unroll
    for (int j = 0; j < 8; ++j) { const unsigned w = *(const unsigned*)(C.Z + (size_t)(n * CH + 8 * tg + j) * ZW + ZC_GK + h * 128 + 2 * c2);
        k0[j] = bflo(w) * __expf(blast[0] - b[j][0]); k1[j] = bfhi(w) * __expf(blast[1] - b[j][1]); }
    u32x4 lo, hi;
    lo.x = pk2(k0[0], k0[1]); lo.y = pk2(k0[2], k0[3]); lo.z = pk2(k0[4], k0[5]); lo.w = pk2(k0[6], k0[7]);
    hi.x = pk2(k1[0], k1[1]); hi.y = pk2(k1[2], k1[3]); hi.z = pk2(k1[4], k1[5]); hi.w = pk2(k1[6], k1[7]);
    *(LAS u32x4*)(KT + (2 * c2) * ROW72 + tg * 16) = lo; *(LAS u32x4*)(KT + (2 * c2 + 1) * ROW72 + tg * 16) = hi;
    if (tg == 0) *(f32x2*)(C.DECAY + (size_t)(h * NCH + n) * 128 + 2 * c2) = (f32x2){__expf(blast[0]), __expf(blast[1])};
    fill_vT(C.Z + ZC_GV + h * 256, n, tg, lane, VT);
    __syncthreads();
    state_mfma(VT, KT, C.DS + (size_t)(h * NCH + n) * 32768, tg, lane);
    __syncthreads();
}

DI void gla_B_unit(const MixCtx& C, LAS unsigned char* lds, int h, int n, int tid) {
    const int lane = tid & 63, w = __builtin_amdgcn_readfirstlane(tid >> 6), tg = w, c2 = lane, fr = lane & 15, fq = lane >> 4;
    LAS float* TOT = (LAS float*)(lds + L_MISC); LAS float* RS = (LAS float*)(lds + L_MISC + 4096);
    LAS unsigned char* ST = lds + L_ST; LAS unsigned char* VT = lds + L_VT; LAS unsigned char* QL = lds + L_Q; LAS unsigned char* KL = lds + L_K;
    copy_256x128(C.SP + (size_t)(h * NCH + n) * 32768, 128, ST, tid);
    float b[8][2], blast[2];
    gla_b(C.Z, C.wa, C.ba, h, n, tg, c2, TOT, b, blast);
    const float qs = 0.08838834764831845f;
#pragma unroll
    for (int j = 0; j < 8; ++j) { const size_t zr = (size_t)(n * CH + 8 * tg + j) * ZW;
        const unsigned wq = *(const unsigned*)(C.Z + zr + ZC_GQ + h * 128 + 2 * c2), wk = *(const unsigned*)(C.Z + zr + ZC_GK + h * 128 + 2 * c2);
        const float e0 = __expf(b[j][0]), e1 = __expf(b[j][1]);
        *(LAS unsigned*)(QL + (8 * tg + j) * ROW136 + 4 * c2) = pk2(bflo(wq) * qs * e0, bfhi(wq) * qs * e1);
        *(LAS unsigned*)(KL + (8 * tg + j) * ROW136 + 4 * c2) = pk2(bflo(wk) * __builtin_amdgcn_rcpf(e0), bfhi(wk) * __builtin_amdgcn_rcpf(e1)); }
    fill_vT(C.Z + ZC_GV + h * 256, n, tg, lane, VT);
    __syncthreads();
    f32x4 sacc[2];
    score_mfma(QL, KL, w, lane, sacc);
    __syncthreads();
    { const int mi = w >> 1, ni0 = 2 * (w & 1), t = 16 * mi + fr;
#pragma unroll
      for (int jn = 0; jn < 2; ++jn) { const int s0 = 16 * (ni0 + jn) + 4 * fq; f32x4 v = sacc[jn];
#pragma unroll
          for (int r = 0; r < 4; ++r) if (s0 + r > t) v[r] = 0.f;
          *(LAS u32x2*)(KL + t * ROW72 + s0 * 2) = (u32x2){pk2(v[0], v[1]), pk2(v[2], v[3])}; } }
    __syncthreads();
    const int wr = w >> 1, wc = w & 1, t = 16 * wr + fr;
    f32x4 o[8];
#pragma unroll
    for (int ni = 0; ni < 8; ++ni) o[ni] = (f32x4){0.f, 0.f, 0.f, 0.f};
#pragma unroll
    for (int ks = 0; ks < 2; ++ks) { const bf16x8 a = *(const LAS bf16x8*)(KL + t * ROW72 + (32 * ks + 8 * fq) * 2);
#pragma unroll
        for (int ni = 0; ni < 8; ++ni) { const bf16x8 bb = *(const LAS bf16x8*)(VT + (128 * wc + 16 * ni + fr) * ROW72 + (32 * ks + 8 * fq) * 2); o[ni] = mfma16(bb, a, o[ni]); } }
#pragma unroll
    for (int ks = 0; ks < 4; ++ks) { const bf16x8 a = *(const LAS bf16x8*)(QL + t * ROW136 + (32 * ks + 8 * fq) * 2);
#pragma unroll
        for (int ni = 0; ni < 8; ++ni) { const bf16x8 bb = *(const LAS bf16x8*)(ST + (128 * wc + 16 * ni + fr) * ROW136 + (32 * ks + 8 * fq) * 2); o[ni] = mfma16(bb, a, o[ni]); } }
    float ss = 0.f;
#pragma unroll
    for (int ni = 0; ni < 8; ++ni) ss += (o[ni][0] * o[ni][0] + o[ni][1] * o[ni][1]) + (o[ni][2] * o[ni][2] + o[ni][3] * o[ni][3]);
    ss += shx(ss, 16, lane); ss += shx(ss, 32, lane);
    if (fq == 0) RS[wc * 64 + t] = ss;
    __syncthreads();
    const float rstd = 1.0f / sqrtf((RS[t] + RS[64 + t]) * (1.0f / 256.0f) + EPS);
    const size_t tok = (size_t)(n * CH + t);
#pragma unroll
    for (int ni = 0; ni < 8; ++ni) { const int dv = 128 * wc + 16 * ni + 4 * fq;
        const u32x2 gg = *(const u32x2*)(C.Z + tok * ZW + ZC_GG + h * 256 + dv); const f32x4 gn = *(const f32x4*)(C.gla_norm + h * 256 + dv);
        const f32x4 v = o[ni] * rstd * gn;
        *(u32x2*)(C.OB + tok * OBW + h * 256 + dv) = (u32x2){pk2(v[0] * silu_f(bflo(gg.x)), v[1] * silu_f(bfhi(gg.x))), pk2(v[2] * silu_f(bflo(gg.y)), v[3] * silu_f(bfhi(gg.y)))}; }
    __syncthreads();
}

DI void ml_A_unit(const MixCtx& C, LAS unsigned char* lds, int h, int n, int tid) {
    const int lane = tid & 63, tg = __builtin_amdgcn_readfirstlane(tid >> 6), c2 = lane;
    LAS float* PART = (LAS float*)(lds + L_MISC);
    LAS unsigned char* KT = lds + L_ST; LAS unsigned char* VT = lds + L_VT;
    const size_t ztok = (size_t)(n * CH + lane) * ZW;
    const float li = bf2f(C.Z[ztok + ZC_MI + h]) + C.b_i[h];
    const float lf = log_sigmoid_f(bf2f(C.Z[ztok + ZC_MF + h]) + C.b_f[h]);
    const float F = wave_scan_sum(lf, lane);
    const float Flast = shi(F, 63);
    const float Gv = Flast - F + li;
    const float g = wave_max(Gv, lane);
    const float wG = __expf(Gv - g);
    float k0[8], k1[8];
    conv_silu8(C.Z + ZC_MQK + 512 + h * 128 + 2 * c2, C.conv_w + 512 + h * 128 + 2 * c2, C.conv_b + 512 + h * 128 + 2 * c2, n * CH + 8 * tg, k0, k1);
    const float ks = 0.08838834764831845f;
    float p0 = 0.f, p1 = 0.f;
#pragma unroll
    for (int j = 0; j < 8; ++j) { const float wj = shi(wG, 8 * tg + j) * ks; k0[j] *= wj; k1[j] *= wj; p0 += k0[j]; p1 += k1[j]; }
    u32x4 lo, hi;
    lo.x = pk2(k0[0], k0[1]); lo.y = pk2(k0[2], k0[3]); lo.z = pk2(k0[4], k0[5]); lo.w = pk2(k0[6], k0[7]);
    hi.x = pk2(k1[0], k1[1]); hi.y = pk2(k1[2], k1[3]); hi.z = pk2(k1[4], k1[5]); hi.w = pk2(k1[6], k1[7]);
    *(LAS u32x4*)(KT + (2 * c2) * ROW72 + tg * 16) = lo; *(LAS u32x4*)(KT + (2 * c2 + 1) * ROW72 + tg * 16) = hi;
    *(LAS f32x2*)(PART + tg * 128 + 2 * c2) = (f32x2){p0, p1};
    fill_vT(C.Z + ZC_MV + h * 256, n, tg, lane, VT);
    if (tid == 0) { C.GG[h * NCH + n] = g; C.FL[h * NCH + n] = Flast; }
    __syncthreads();
    if (tid < 128) { float s = 0.f;
#pragma unroll
        for (int q = 0; q < 8; ++q) s += PART[q * 128 + tid];
        C.DN[(size_t)(h * NCH + n) * 128 + tid] = s; }
    state_mfma(VT, KT, C.DC + (size_t)(h * NCH + n) * 32768, tg, lane);
    __syncthreads();
}

DI void ml_B_unit(const MixCtx& C, LAS unsigned char* lds, int h, int n, int tid) {
    const int lane = tid & 63, w = __builtin_amdgcn_readfirstlane(tid >> 6), tg = w, c2 = lane, fr = lane & 15, fq = lane >> 4;
    LAS float* MF = (LAS float*)(lds + L_MISC); LAS float* MU = MF + 64; LAS float* MM = MF + 128; LAS float* MW = MF + 192;
    LAS float* DENP = MF + 256; LAS float* DQN = MF + 512; LAS float* NPV = MF + 576; LAS float* RS = (LAS float*)(lds + L_MISC + 4096);
    LAS unsigned char* CT = lds + L_ST; LAS unsigned char* VT = lds + L_VT; LAS unsigned char* QL = lds + L_Q; LAS unsigned char* KL = lds + L_K;
    copy_256x128(C.CP + (size_t)(h * NCH + n) * 32768, 128, CT, tid);
    if (w == 0) {
        const size_t ztok = (size_t)(n * CH + lane) * ZW;
        const float li = bf2f(C.Z[ztok + ZC_MI + h]) + C.b_i[h];
        const float lf = log_sigmoid_f(bf2f(C.Z[ztok + ZC_MF + h]) + C.b_f[h]);
        const float F = wave_scan_sum(lf, lane);
        const float u = li - F;
        const float pm = wave_scan_max(u, lane);
        const float mprev = C.MP[h * NCH + n];
        const float m = F + fmaxf(pm, mprev);
        MF[lane] = F; MU[lane] = u; MM[lane] = m; MW[lane] = __expf(F + mprev - m);
    }
    if (w == 1) { NPV[lane] = C.NP[(size_t)(h * NCH + n) * 128 + lane]; NPV[64 + lane] = C.NP[(size_t)(h * NCH + n) * 128 + 64 + lane]; }
    {
        float q0[8], q1[8], k0[8], k1[8];
        conv_silu8(C.Z + ZC_MQK + h * 128 + 2 * c2, C.conv_w + h * 128 + 2 * c2, C.conv_b + h * 128 + 2 * c2, n * CH + 8 * tg, q0, q1);
        conv_silu8(C.Z + ZC_MQK + 512 + h * 128 + 2 * c2, C.conv_w + 512 + h * 128 + 2 * c2, C.conv_b + 512 + h * 128 + 2 * c2, n * CH + 8 * tg, k0, k1);
        const float ks = 0.08838834764831845f;
#pragma unroll
        for (int j = 0; j < 8; ++j) { *(LAS unsigned*)(QL + (8 * tg + j) * ROW136 + 4 * c2) = pk2(q0[j], q1[j]); *(LAS unsigned*)(KL + (8 * tg + j) * ROW136 + 4 * c2) = pk2(k0[j] * ks, k1[j] * ks); }
    }
    fill_vT(C.Z + ZC_MV + h * 256, n, tg, lane, VT);
    __syncthreads();
    f32x4 sacc[2];
    score_mfma(QL, KL, w, lane, sacc);
    {
        const int t = tid >> 3, part = tid & 7; float s = 0.f;
#pragma unroll
        for (int e = 0; e < 8; ++e) { const unsigned qq = *(const LAS unsigned*)(QL + t * ROW136 + (16 * part + 2 * e) * 2); s += bflo(qq) * NPV[16 * part + 2 * e] + bfhi(qq) * NPV[16 * part + 2 * e + 1]; }
        s += shx(s, 1, lane); s += shx(s, 2, lane); s += shx(s, 4, lane);
        if (part == 0) DQN[t] = s;
    }
    __syncthreads();
    { const int mi = w >> 1, ni0 = 2 * (w & 1), t = 16 * mi + fr; const float ft = MF[t] - MM[t];
#pragma unroll
      for (int jn = 0; jn < 2; ++jn) { const int s0 = 16 * (ni0 + jn) + 4 * fq; f32x4 v = sacc[jn]; const f32x4 us = *(const LAS f32x4*)(MU + s0);
          float ps = 0.f;
#pragma unroll
          for (int r = 0; r < 4; ++r) { v[r] = (s0 + r > t) ? 0.f : v[r] * __expf(ft + us[r]); ps += v[r]; }
          ps += shx(ps, 16, lane); ps += shx(ps, 32, lane);
          if (fq == 0) DENP[t * 4 + ni0 + jn] = ps;
          *(LAS u32x2*)(KL + t * ROW72 + s0 * 2) = (u32x2){pk2(v[0], v[1]), pk2(v[2], v[3])}; } }
    __syncthreads();
    const int wr = w >> 1, wc = w & 1, t = 16 * wr + fr;
    f32x4 o1[8], o2[8];
#pragma unroll
    for (int ni = 0; ni < 8; ++ni) { o1[ni] = (f32x4){0.f, 0.f, 0.f, 0.f}; o2[ni] = o1[ni]; }
#pragma unroll
    for (int ks = 0; ks < 2; ++ks) { const bf16x8 a = *(const LAS bf16x8*)(KL + t * ROW72 + (32 * ks + 8 * fq) * 2);
#pragma unroll
        for (int ni = 0; ni < 8; ++ni) { const bf16x8 bb = *(const LAS bf16x8*)(VT + (128 * wc + 16 * ni + fr) * ROW72 + (32 * ks + 8 * fq) * 2); o1[ni] = mfma16(bb, a, o1[ni]); } }
#pragma unroll
    for (int ks = 0; ks < 4; ++ks) { const bf16x8 a = *(const LAS bf16x8*)(QL + t * ROW136 + (32 * ks + 8 * fq) * 2);
#pragma unroll
        for (int ni = 0; ni < 8; ++ni) { const bf16x8 bb = *(const LAS bf16x8*)(CT + (128 * wc + 16 * ni + fr) * ROW136 + (32 * ks + 8 * fq) * 2); o2[ni] = mfma16(bb, a, o2[ni]); } }
    const float wi = MW[t];
    const f32x4 dp = *(const LAS f32x4*)(DENP + t * 4);
    const float den = ((dp[0] + dp[1]) + (dp[2] + dp[3])) + wi * DQN[t];
    const float inv = 1.0f / fmaxf(fabsf(den), __expf(-MM[t]));
    const size_t tok = (size_t)(n * CH + t);
    float ss = 0.f;
#pragma unroll
    for (int ni = 0; ni < 8; ++ni) { const int dv = 128 * wc + 16 * ni + 4 * fq;
        const u32x2 mo = *(const u32x2*)(C.Z + tok * ZW + ZC_MO + h * 256 + dv);
        f32x4 v = (o1[ni] + o2[ni] * wi) * inv;
        v[0] *= sigmoid_f(bflo(mo.x)); v[1] *= sigmoid_f(bfhi(mo.x)); v[2] *= sigmoid_f(bflo(mo.y)); v[3] *= sigmoid_f(bfhi(mo.y));
        o1[ni] = v; ss += (v[0] * v[0] + v[1] * v[1]) + (v[2] * v[2] + v[3] * v[3]); }
    ss += shx(ss, 16, lane); ss += shx(ss, 32, lane);
    if (fq == 0) RS[wc * 64 + t] = ss;
    __syncthreads();
    const float rstd = 1.0f / sqrtf((RS[t] + RS[64 + t]) * (1.0f / 256.0f) + EPS);
#pragma unroll
    for (int ni = 0; ni < 8; ++ni) { const int dv = 128 * wc + 16 * ni + 4 * fq; const f32x4 gn = *(const f32x4*)(C.ml_norm + h * 256 + dv);
        const f32x4 v = o1[ni] * rstd * gn;
        *(u32x2*)(C.OB + tok * OBW + 1024 + h * 256 + dv) = (u32x2){pk2(v[0], v[1]), pk2(v[2], v[3])}; }
    __syncthreads();
}

DI void scan_phase(const MixCtx& C, int tid) {
    const int NS = 2 * 65536;
    for (int slot = opaque_bx() * 512 + tid; slot < NS; slot += opaque_g() * 512) {
        const int br = slot >> 16, s = slot & 65535, h = s >> 14, dv = (s >> 6) & 255, dkp = s & 63;
        const size_t e0 = (size_t)h * NCH * 32768 + (size_t)dv * 128 + 2 * dkp;
        if (br == 0) {
            float s0 = 0.f, s1 = 0.f;
            for (int n0 = 0; n0 < NCH; n0 += 8) {
                f32x2 d[8], dec[8];
#pragma unroll
                for (int u = 0; u < 8; ++u) { d[u] = *(const f32x2*)(C.DS + e0 + (size_t)(n0 + u) * 32768); dec[u] = *(const f32x2*)(C.DECAY + (size_t)(h * NCH + n0 + u) * 128 + 2 * dkp); }
#pragma unroll
                for (int u = 0; u < 8; ++u) { *(unsigned*)(C.SP + e0 + (size_t)(n0 + u) * 32768) = pk2(s0, s1); s0 = dec[u].x * s0 + d[u].x; s1 = dec[u].y * s1 + d[u].y; }
            }
        } else {
            float c0 = 0.f, c1 = 0.f, nn0 = 0.f, nn1 = 0.f, m = -1e30f;
            for (int n0 = 0; n0 < NCH; n0 += 8) {
                f32x2 d[8], dn[8]; float fl[8], gl[8];
#pragma unroll
                for (int u = 0; u < 8; ++u) { d[u] = *(const f32x2*)(C.DC + e0 + (size_t)(n0 + u) * 32768); fl[u] = C.FL[h * NCH + n0 + u]; gl[u] = C.GG[h * NCH + n0 + u];
                    dn[u] = (dv == 0) ? *(const f32x2*)(C.DN + (size_t)(h * NCH + n0 + u) * 128 + 2 * dkp) : (f32x2){0.f, 0.f}; }
#pragma unroll
                for (int u = 0; u < 8; ++u) { *(unsigned*)(C.CP + e0 + (size_t)(n0 + u) * 32768) = pk2(c0, c1);
                    if (dv == 0) { *(f32x2*)(C.NP + (size_t)(h * NCH + n0 + u) * 128 + 2 * dkp) = (f32x2){nn0, nn1}; if (dkp == 0) C.MP[h * NCH + n0 + u] = m; }
                    const float mn = fmaxf(fl[u] + m, gl[u]); const float a = __expf(fl[u] + m - mn), bb = __expf(gl[u] - mn);
                    c0 = a * c0 + bb * d[u].x; c1 = a * c1 + bb * d[u].y; nn0 = a * nn0 + bb * dn[u].x; nn1 = a * nn1 + bb * dn[u].y; m = mn; }
            }
        }
    }
}

DI void mem_unit(const MixCtx& C, LAS unsigned char* lds, int h, int rb, int tid) {
    const int lane = tid & 63, w = __builtin_amdgcn_readfirstlane(tid >> 6), fr = lane & 15, fq = lane >> 4, wr = w >> 1, wc = w & 1, t = 16 * wr + fr;
    LAS unsigned char* QL = lds; LAS unsigned char* PL = lds + 33792; LAS unsigned char* KV = lds + 67584;
    LAS float* RMX = (LAS float*)(lds + L_MISC); LAS float* RSM = RMX + 128;
#pragma unroll
    for (int i = 0; i < 4; ++i) { const int id = tid + 512 * i, row = id >> 5, cc = id & 31;
        *(LAS u32x4*)(QL + row * ROW264 + cc * 16) = *(const u32x4*)(C.Z + (size_t)(rb * 64 + row) * ZW + ZC_XQ + h * 256 + cc * 8); }
    f32x4 s[8];
#pragma unroll
    for (int ni = 0; ni < 8; ++ni) s[ni] = (f32x4){0.f, 0.f, 0.f, 0.f};
#pragma unroll
    for (int half = 0; half < 2; ++half) {
        copy_256x128(C.KM + h * 256 + half * 128, 4096, KV, tid);
        __syncthreads();
#pragma unroll
        for (int ks = 0; ks < 4; ++ks) { const bf16x8 a = *(const LAS bf16x8*)(QL + t * ROW264 + (128 * half + 32 * ks + 8 * fq) * 2);
#pragma unroll
            for (int ni = 0; ni < 8; ++ni) { const bf16x8 bb = *(const LAS bf16x8*)(KV + (128 * wc + 16 * ni + fr) * ROW136 + (32 * ks + 8 * fq) * 2); s[ni] = mfma16(bb, a, s[ni]); } }
        __syncthreads();
    }
    float mx = -3.0e38f;
#pragma unroll
    for (int ni = 0; ni < 8; ++ni) { s[ni] = s[ni] * 0.0625f; mx = fmaxf(mx, fmaxf(fmaxf(s[ni][0], s[ni][1]), fmaxf(s[ni][2], s[ni][3]))); }
    mx = fmaxf(mx, shx(mx, 16, lane)); mx = fmaxf(mx, shx(mx, 32, lane));
    if (fq == 0) RMX[wc * 64 + t] = mx;
    copy_256x128(C.VMT + (size_t)(h * 256) * 256, 256, KV, tid);
    __syncthreads();
    mx = fmaxf(RMX[t], RMX[64 + t]);
    float sm = 0.f;
#pragma unroll
    for (int ni = 0; ni < 8; ++ni) {
#pragma unroll
        for (int r = 0; r < 4; ++r) { s[ni][r] = __expf(s[ni][r] - mx); sm += s[ni][r]; } }
    sm += shx(sm, 16, lane); sm += shx(sm, 32, lane);
    if (fq == 0) RSM[wc * 64 + t] = sm;
    __syncthreads();
    const float inv = 1.0f / (RSM[t] + RSM[64 + t]);
#pragma unroll
    for (int ni = 0; ni < 8; ++ni) { const f32x4 p = s[ni] * inv; *(LAS u32x2*)(PL + t * ROW264 + (128 * wc + 16 * ni + 4 * fq) * 2) = (u32x2){pk2(p[0], p[1]), pk2(p[2], p[3])}; }
    f32x4 o[8];
#pragma unroll
    for (int ni = 0; ni < 8; ++ni) o[ni] = (f32x4){0.f, 0.f, 0.f, 0.f};
#pragma unroll
    for (int half = 0; half < 2; ++half) {
        if (half == 1) copy_256x128(C.VMT + (size_t)(h * 256) * 256 + 128, 256, KV, tid);
        __syncthreads();
#pragma unroll
        for (int ks = 0; ks < 4; ++ks) { const bf16x8 a = *(const LAS bf16x8*)(PL + t * ROW264 + (128 * half + 32 * ks + 8 * fq) * 2);
#pragma unroll
            for (int ni = 0; ni < 8; ++ni) { const bf16x8 bb = *(const LAS bf16x8*)(KV + (128 * wc + 16 * ni + fr) * ROW136 + (32 * ks + 8 * fq) * 2); o[ni] = mfma16(bb, a, o[ni]); } }
        __syncthreads();
    }
    const size_t tok = (size_t)(rb * 64 + t);
#pragma unroll
    for (int ni = 0; ni < 8; ++ni) { const int d = 128 * wc + 16 * ni + 4 * fq; *(u32x2*)(C.OB + tok * OBW + 2048 + h * 256 + d) = (u32x2){pk2(o[ni][0], o[ni][1]), pk2(o[ni][2], o[ni][3])}; }
}

#ifndef GEMM_ALIGN
#define GEMM_ALIGN true
#endif
#ifndef REP_PRO
#define REP_PRO 1
#endif
#ifndef REP_MIXA
#define REP_MIXA 1
#endif
#ifndef REP_SCAN
#define REP_SCAN 1
#endif
#ifndef REP_MIXB
#define REP_MIXB 1
#endif
#ifndef REP_FF1
#define REP_FF1 1
#endif
#ifndef REP_NORM
#define REP_NORM 1
#endif
#ifndef GEMM_SP2
#define GEMM_SP2 true
#endif
constexpr int L_PTR = L_BARW + 256;
DI unsigned long long tab_ld(LAS unsigned char* lds, int k) {
    const unsigned long long v = *(volatile LAS unsigned long long*)(lds + L_PTR + 8 * k);
    const unsigned lo = __builtin_amdgcn_readfirstlane((unsigned)v), hi = __builtin_amdgcn_readfirstlane((unsigned)(v >> 32));
    return ((unsigned long long)hi << 32) | lo;
}
DI const float* tab_in(LAS unsigned char* lds, int k) { return (const float*)(const GAS float*)tab_ld(lds, k); }
DI unsigned char* tab_ws(LAS unsigned char* lds) { return (unsigned char*)(GAS unsigned char*)tab_ld(lds, 24); }
DI void grid_bar(LAS unsigned char* lds) {
    XcdBarrier b; b.bar = (unsigned*)(tab_ws(lds) + WS_CTL) + CW_BAR; b.x = xb_xcc_id(); b.st = (volatile LAS unsigned*)(lds + L_BARW);
    xcd_barrier(b);
}
DI void make_ctx(MixCtx& C, LAS unsigned char* lds, int l) {
    unsigned char* ws = tab_ws(lds);
    C.Z = (const bf16_t*)(ws + WS_Z); C.OB = (bf16_t*)(ws + WS_OB);
    C.wa = tab_in(lds, I_W_GLA_A) + (size_t)l * 16 * 512; C.ba = tab_in(lds, I_B_GLA_A) + l * 512; C.gla_norm = tab_in(lds, I_GLA_NORM) + l * 1024;
    C.conv_w = tab_in(lds, I_CONV_W) + (size_t)l * 4 * 1024; C.conv_b = tab_in(lds, I_CONV_B) + l * 1024; C.b_i = tab_in(lds, I_B_ML_I) + l * 4; C.b_f = tab_in(lds, I_B_ML_F) + l * 4; C.ml_norm = tab_in(lds, I_ML_NORM) + l * 1024;
    C.DS = (float*)(ws + WS_DS); C.DC = (float*)(ws + WS_DC); C.SP = (bf16_t*)(ws + WS_SP); C.CP = (bf16_t*)(ws + WS_CP);
    C.DECAY = (float*)(ws + WS_SMALL + SM_DECAY); C.DN = (float*)(ws + WS_SMALL + SM_DN); C.NP = (float*)(ws + WS_SMALL + SM_NP);
    C.GG = (float*)(ws + WS_SMALL + SM_GG); C.FL = (float*)(ws + WS_SMALL + SM_FL); C.MP = (float*)(ws + WS_SMALL + SM_MP);
    C.KM = (const bf16_t*)(ws + WS_KM) + l * 1024; C.VMT = (const bf16_t*)(ws + WS_VMT) + (size_t)l * 1024 * 256;
}

__global__ void __launch_bounds__(512, 2) trunk_fwd(Params p) {
    extern __shared__ __attribute__((aligned(16))) unsigned char lds_raw[];
    LAS unsigned char* lds0 = (LAS unsigned char*)lds_raw;
    {
        LAS unsigned char* lds = lds0;
        const int tid0 = threadIdx.x;
        if (tid0 < 64) ((LAS unsigned*)(lds + L_BARW))[tid0] = 0u;
        if (tid0 < 23) *(LAS unsigned long long*)(lds + L_PTR + 8 * tid0) = (unsigned long long)p.in[tid0];
        if (tid0 == 23) *(LAS unsigned long long*)(lds + L_PTR + 8 * 23) = (unsigned long long)p.out;
        if (tid0 == 24) *(LAS unsigned long long*)(lds + L_PTR + 8 * 24) = (unsigned long long)p.ws;
        __syncthreads();
        (void)xcd_barrier_post((unsigned*)(p.ws + WS_CTL) + CW_BAR, (volatile LAS unsigned*)(lds + L_BARW));
    }
#define TID (opaque_tid())
#define LANE (opaque_tid() & 63)
#define WAVE (__builtin_amdgcn_readfirstlane(opaque_tid() >> 6))
#define GW (opaque_bx() * NWAVES + WAVE)
#define NGW (opaque_g() * NWAVES)

    for (int rep = 0; rep < REP_PRO; ++rep) {
        LAS unsigned char* lds = opaque_lds(lds0); unsigned char* ws = tab_ws(lds);
        bf16_t* WIN = (bf16_t*)(ws + WS_WIN);
        const int lane = LANE, wave = WAVE;
        LAS float* scr = (LAS float*)(lds + wave * 16640);
        constexpr int IT_IN = 64 * 117, IT_BR = 16 * 64, IT_G = 4 * 64, IT_OUT = 64 * 64, IT_F1 = 64 * 256, IT_F2 = 256 * 64, IT_MK = 64 * 16;
        constexpr int E_IN = 4 * IT_IN, E_BR = E_IN + 12 * IT_BR, E_G = E_BR + 12 * IT_G, E_OUT = E_G + 4 * IT_OUT, E_F1 = E_OUT + 4 * IT_F1, E_F2 = E_F1 + 4 * IT_F2, E_MK = E_F2 + 4 * IT_MK, E_MV = E_MK + 4 * IT_MK;
        for (int it = GW; it < E_MV; it += NGW) {
            if (it < E_IN) { const int l = it / IT_IN, r = it - l * IT_IN; transpose_item(tab_in(lds, I_W_IN) + (size_t)l * DM * IN_W, DM, IN_W, WIN + (size_t)l * ZW * DM, DM, 0, 0, true, scr, r, lane, tab_in(lds, I_NORM_MIX) + l * DM); }
            else if (it < E_BR) { const int q = it - E_IN, lj = q / IT_BR, r = q - lj * IT_BR, l = lj / 3, j = lj - 3 * l; transpose_item(tab_in(lds, I_W_BRANCH) + (size_t)lj * 1024 * DM, 1024, DM, (bf16_t*)(ws + WS_WBR) + (size_t)l * DM * OBW, OBW, j * 1024, 0, false, scr, r, lane); }
            else if (it < E_G) { const int q = it - E_BR, lj = q / IT_G, r = q - lj * IT_G, l = lj / 3, j = lj - 3 * l; transpose_item(tab_in(lds, I_W_GATE) + (size_t)lj * 256 * DM, 256, DM, (bf16_t*)(ws + WS_WG) + (size_t)l * GTW * 256, 256, 0, j * DM, false, scr, r, lane); }
            else if (it < E_OUT) { const int q = it - E_G, l = q / IT_OUT, r = q - l * IT_OUT; transpose_item(tab_in(lds, I_W_OUT) + (size_t)l * DM * DM, DM, DM, (bf16_t*)(ws + WS_WOUT) + (size_t)l * DM * DM, DM, 0, 0, false, scr, r, lane); }
            else if (it < E_F1) { const int q = it - E_OUT, l = q / IT_F1, r = q - l * IT_F1; transpose_item(tab_in(lds, I_W_FF1) + (size_t)l * DM * DFF, DM, DFF, (bf16_t*)(ws + WS_W1) + (size_t)l * DFF * DM, DM, 0, 0, false, scr, r, lane, tab_in(lds, I_NORM_FFN) + l * DM); }
            else if (it < E_F2) { const int q = it - E_F1, l = q / IT_F2, r = q - l * IT_F2; transpose_item(tab_in(lds, I_W_FF2) + (size_t)l * DFF * DM, DFF, DM, (bf16_t*)(ws + WS_W2) + (size_t)l * DM * DFF, DFF, 0, 0, false, scr, r, lane); }
            else if (it < E_MK) { const int q = it - E_F2, l = q / IT_MK, r = q - l * IT_MK; transpose_item(tab_in(lds, I_W_MEM_K) + (size_t)l * DM * 1024, DM, 1024, (bf16_t*)(ws + WS_WMK), DM, 0, l * 1024, false, scr, r, lane); }
            else { const int q = it - E_MK, l = q / IT_MK, r = q - l * IT_MK; transpose_item(tab_in(lds, I_W_MEM_V) + (size_t)l * DM * 1024, DM, 1024, (bf16_t*)(ws + WS_WMV), DM, 0, l * 1024, false, scr, r, lane); }
        }
        constexpr int PADCH = (ZW - IN_W) * DM / 8;
        for (int i = opaque_bx() * 512 + TID; i < NL * PADCH; i += opaque_g() * 512) { const int l = i / PADCH, r = i - l * PADCH; *(u32x4*)(WIN + (size_t)l * ZW * DM + (size_t)IN_W * DM + (size_t)r * 8) = (u32x4){0u, 0u, 0u, 0u}; }
        for (int m = GW; m < SEQ; m += NGW) row_bf16_ss(tab_in(lds, I_X) + (size_t)m * DM, (bf16_t*)(ws + WS_H) + (size_t)m * DM, (u64_t*)(ws + WS_SS) + m, lane);
        for (int m = GW; m < MEML; m += NGW) rmsnorm_row<false>(tab_in(lds, I_MEM) + (size_t)m * DM, tab_in(lds, I_MEM_NORM), (bf16_t*)(ws + WS_MEMN) + (size_t)m * DM, lane);
    }
    grid_bar(opaque_lds(lds0));
    {
        LAS unsigned char* lds = opaque_lds(lds0); unsigned char* ws = tab_ws(lds);
        { pg8::Gemm g{(const bf16_t*)(ws + WS_MEMN), (const bf16_t*)(ws + WS_WMK), opq(MEML), opq(DM), opq(DM), opq(DM), opq(DM)}; pg8::StaticOrder S; S.init(opq(MEML), opq(DM), opaque_g(), opaque_bx()); pg8::EpiBf16<0> E{(bf16_t*)(ws + WS_KM), DM, nullptr, nullptr};
          pg8::gemm_phase<pg8::EpiBf16<0>, pg8::StaticOrder, GEMM_ALIGN, GEMM_SP2>(lds, g, S, E); }
    }
    {
        LAS unsigned char* lds = opaque_lds(lds0); unsigned char* ws = tab_ws(lds);
        { pg8::Gemm g{(const bf16_t*)(ws + WS_WMV), (const bf16_t*)(ws + WS_MEMN), opq(DM), opq(MEML), opq(DM), opq(DM), opq(DM)}; pg8::StaticOrder S; S.init(opq(DM), opq(MEML), opaque_g(), (opaque_bx() + 16) % opaque_g()); pg8::EpiBf16<0> E{(bf16_t*)(ws + WS_VMT), MEML, nullptr, nullptr};
          pg8::gemm_phase<pg8::EpiBf16<0>, pg8::StaticOrder, GEMM_ALIGN, GEMM_SP2>(lds, g, S, E); }
    }
    grid_bar(opaque_lds(lds0));

    for (int l = 0; l < NL; ++l) {
        {
            LAS unsigned char* lds = opaque_lds(lds0); unsigned char* ws = tab_ws(lds);
            pg8::Gemm g{(const bf16_t*)(ws + WS_H), (const bf16_t*)(ws + WS_WIN) + (size_t)l * ZW * DM, opq(SEQ), opq(ZW), opq(DM), opq(DM), opq(DM)}; pg8::StaticOrder S; S.init(opq(SEQ), opq(ZW), opaque_g(), opaque_bx()); pg8::EpiBf16<0> E{(bf16_t*)(ws + WS_Z), ZW, nullptr, (const u64_t*)(ws + WS_SS) + (size_t)(2 * l) * SEQ};
            pg8::gemm_phase<pg8::EpiBf16<0>, pg8::StaticOrder, GEMM_ALIGN, GEMM_SP2>(lds, g, S, E);
        }
        grid_bar(opaque_lds(lds0));
        {
            LAS unsigned char* lds = opaque_lds(lds0); MixCtx C; make_ctx(C, lds, l); const int tid = TID;
            for (int rep = 0; rep < REP_MIXA; ++rep) {
            for (int i = opaque_bx(); i < 4 * NCH; i += opaque_g()) gla_A_unit(C, lds, i >> 8, i & 255, tid);
            for (int i = opaque_bx(); i < 4 * NCH; i += opaque_g()) ml_A_unit(C, lds, i >> 8, i & 255, tid);
            for (int i = opaque_bx(); i < 4 * NCH; i += opaque_g()) mem_unit(C, lds, i >> 8, i & 255, tid);
            }
        }
        {
            LAS unsigned char* lds = opaque_lds(lds0); unsigned char* ws = tab_ws(lds);
            pg8::Gemm g{(const bf16_t*)(ws + WS_Z) + ZC_GATE, (const bf16_t*)(ws + WS_WG) + (size_t)l * GTW * 256, opq(SEQ), opq(GTW), opq(256), opq(ZW), opq(256)}; pg8::StaticOrder S; S.init(opq(SEQ), opq(GTW), opaque_g(), opaque_bx());
            pg8::EpiBf16<2> E{(bf16_t*)(ws + WS_GT), GTW, tab_in(lds, I_B_GATE) + (size_t)l * GTW, nullptr};
            pg8::gemm_phase<pg8::EpiBf16<2>, pg8::StaticOrder, GEMM_ALIGN, GEMM_SP2>(lds, g, S, E);
        }
        grid_bar(opaque_lds(lds0));
        { LAS unsigned char* lds = opaque_lds(lds0); MixCtx C; make_ctx(C, lds, l); for (int rep = 0; rep < REP_SCAN; ++rep) scan_phase(C, TID); }
        grid_bar(opaque_lds(lds0));
        {
            LAS unsigned char* lds = opaque_lds(lds0); MixCtx C; make_ctx(C, lds, l); const int tid = TID;
            for (int rep = 0; rep < REP_MIXB; ++rep) {
            for (int i = opaque_bx(); i < 4 * NCH; i += opaque_g()) gla_B_unit(C, lds, i >> 8, i & 255, tid);
            for (int i = opaque_bx(); i < 4 * NCH; i += opaque_g()) ml_B_unit(C, lds, i >> 8, i & 255, tid);
            }
        }
        grid_bar(opaque_lds(lds0));
        {
            LAS unsigned char* lds = opaque_lds(lds0); unsigned char* ws = tab_ws(lds);
            pg8::Gemm g{(const bf16_t*)(ws + WS_OB), (const bf16_t*)(ws + WS_WBR) + (size_t)l * DM * OBW, opq(SEQ), opq(DM), opq(OBW), opq(OBW), opq(OBW)}; pg8::StaticOrder S; S.init(opq(SEQ), opq(DM), opaque_g(), opaque_bx()); pg8::EpiBranch E{(bf16_t*)(ws + WS_Y), DM, (const bf16_t*)(ws + WS_GT)};
            pg8::gemm_phase<pg8::EpiBranch, pg8::StaticOrder, GEMM_ALIGN, GEMM_SP2>(lds, g, S, E);
        }
        grid_bar(opaque_lds(lds0));
        {
            LAS unsigned char* lds = opaque_lds(lds0); unsigned char* ws = tab_ws(lds);
            const float* Xin = (l == 0) ? tab_in(lds, I_X) : (const float*)(ws + WS_X);
            pg8::Gemm g{(const bf16_t*)(ws + WS_Y), (const bf16_t*)(ws + WS_WOUT) + (size_t)l * DM * DM, opq(SEQ), opq(DM), opq(DM), opq(DM), opq(DM)}; pg8::StaticOrder S; S.init(opq(SEQ), opq(DM), opaque_g(), opaque_bx()); pg8::EpiResid E{Xin, (float*)(ws + WS_X), DM, (bf16_t*)(ws + WS_H), (u64_t*)(ws + WS_SS) + (size_t)(2 * l + 1) * SEQ};
            pg8::gemm_phase<pg8::EpiResid, pg8::StaticOrder, GEMM_ALIGN, GEMM_SP2>(lds, g, S, E);
        }
        grid_bar(opaque_lds(lds0));
        for (int rep = 0; rep < REP_FF1; ++rep) {
            LAS unsigned char* lds = opaque_lds(lds0); unsigned char* ws = tab_ws(lds);
            pg8::Gemm g{(const bf16_t*)(ws + WS_H), (const bf16_t*)(ws + WS_W1) + (size_t)l * DFF * DM, opq(SEQ), opq(DFF), opq(DM), opq(DM), opq(DM)}; pg8::StaticOrder S; S.init(opq(SEQ), opq(DFF), opaque_g(), opaque_bx()); pg8::EpiBf16<1> E{(bf16_t*)(ws + WS_U), DFF, nullptr, (const u64_t*)(ws + WS_SS) + (size_t)(2 * l + 1) * SEQ};
            pg8::gemm_phase<pg8::EpiBf16<1>, pg8::StaticOrder, GEMM_ALIGN, GEMM_SP2>(lds, g, S, E);
        }
        grid_bar(opaque_lds(lds0));
        {
            LAS unsigned char* lds = opaque_lds(lds0); unsigned char* ws = tab_ws(lds);
            pg8::Gemm g{(const bf16_t*)(ws + WS_U), (const bf16_t*)(ws + WS_W2) + (size_t)l * DM * DFF, opq(SEQ), opq(DM), opq(DFF), opq(DFF), opq(DFF)}; pg8::StaticOrder S; S.init(opq(SEQ), opq(DM), opaque_g(), opaque_bx()); pg8::EpiResid E{(const float*)(ws + WS_X), (float*)(ws + WS_X), DM, (bf16_t*)(ws + WS_H), (u64_t*)(ws + WS_SS) + (size_t)(2 * l + 2) * SEQ};
            pg8::gemm_phase<pg8::EpiResid, pg8::StaticOrder, GEMM_ALIGN, GEMM_SP2>(lds, g, S, E);
        }
        grid_bar(opaque_lds(lds0));
    }
    {
        LAS unsigned char* lds = opaque_lds(lds0); unsigned char* ws = tab_ws(lds);
        const float* X = (const float*)(ws + WS_X); const float* gain = tab_in(lds, I_FINAL_NORM); float* out = (float*)(GAS float*)tab_ld(lds, 23); const int lane = LANE;
        const u64_t* ssf = (const u64_t*)(ws + WS_SS) + (size_t)8 * SEQ;
        for (int m = GW; m < SEQ; m += NGW) row_scale_f32(X + (size_t)m * DM, gain, ss_to_f(ssf[m]), out + (size_t)m * DM, lane);
    }
}

extern "C" void kernel_launch(void* const* d_in, const int* in_sizes, int n_in, void* d_out, int out_size, void* d_ws, size_t ws_size, hipStream_t stream) {
    static int grid = 0;
    if (grid == 0) {
        if (n_in != 23 || out_size != SEQ * DM || ws_size < WS_END) { fprintf(stderr, "kernel_launch: unexpected shapes (n_in %d out %d ws %zu, need %zu)\n", n_in, out_size, ws_size, (size_t)WS_END); grid = -1; return; }
        int dev = 0, cus = 0, per_cu = 0;
        if (hipGetDevice(&dev) != hipSuccess || hipDeviceGetAttribute(&cus, hipDeviceAttributeMultiprocessorCount, dev) != hipSuccess) { grid = -1; return; }
        if (hipFuncSetAttribute((const void*)trunk_fwd, hipFuncAttributeMaxDynamicSharedMemorySize, LDS_BYTES) != hipSuccess) { fprintf(stderr, "kernel_launch: hipFuncSetAttribute failed\n"); grid = -1; return; }
        if (hipOccupancyMaxActiveBlocksPerMultiprocessor(&per_cu, (const void*)trunk_fwd, 512, LDS_BYTES) != hipSuccess || per_cu < 1) { fprintf(stderr, "kernel_launch: occupancy query says %d\n", per_cu); (void)hipGetLastError(); }
        grid = cus;
    }
    if (grid < 0) return;
    if (hipMemsetAsync((char*)d_ws + WS_CTL, 0, CTL_ZERO_BYTES, stream) != hipSuccess) return;
    if (hipMemsetAsync((char*)d_ws + WS_SS, 0, SS_ZERO_BYTES, stream) != hipSuccess) return;
    Params p{};
    for (int i = 0; i < 23; ++i) p.in[i] = (const float*)d_in[i];
    p.out = (float*)d_out; p.ws = (unsigned char*)d_ws;
    hipLaunchKernelGGL(trunk_fwd, dim3(grid), dim3(512), LDS_BYTES, stream, p);
}
```

```cpp
#include <hip/hip_runtime.h>
#include <cstdio>
#include <cstdint>

#define DI __device__ __forceinline__
#define GAS __attribute__((address_space(1)))
#define LAS __attribute__((address_space(3)))
typedef unsigned short bf16_t;
typedef short bf16x8 __attribute__((ext_vector_type(8)));
typedef float f32x4 __attribute__((ext_vector_type(4)));
typedef float f32x2 __attribute__((ext_vector_type(2)));
typedef unsigned u32x4 __attribute__((ext_vector_type(4)));
typedef unsigned u32x2 __attribute__((ext_vector_type(2)));

constexpr int SEQ = 16384, DM = 4096, DFF = 16384, NL = 4, MEML = 256, CH = 64, NCH = SEQ / CH;
constexpr int IN_W = 7448, ZW = 7680;
constexpr int ZC_GQ = 0, ZC_GK = 512, ZC_GV = 1024, ZC_GG = 2048, ZC_MQK = 3072, ZC_MV = 4096, ZC_MO = 5120, ZC_XQ = 6144, ZC_GATE = 7168, ZC_GA = 7424, ZC_MI = 7440, ZC_MF = 7444;
constexpr int OBW = 3072;
constexpr int GTW = 12288;
constexpr float EPS = 1e-6f;

constexpr size_t MiB = 1u << 20;
constexpr size_t WS_CTL = 0, CTL_ZERO_BYTES = 1 * MiB;
constexpr size_t WS_WIN = 1 * MiB, WS_WBR = 241 * MiB, WS_WG = 337 * MiB, WS_WOUT = 361 * MiB, WS_W1 = 489 * MiB, WS_W2 = 1001 * MiB;
constexpr size_t WS_WMK = 1513 * MiB, WS_WMV = 1545 * MiB, WS_MEMN = 1577 * MiB, WS_KM = 1579 * MiB, WS_VMT = 1581 * MiB;
constexpr size_t WS_X = 1583 * MiB, WS_H = 1839 * MiB, WS_Z = 1967 * MiB, WS_GT = 2207 * MiB, WS_U = WS_Z  ;
constexpr size_t WS_OB = 2591 * MiB, WS_Y = 2687 * MiB, WS_DS = 2815 * MiB, WS_SP = 2943 * MiB, WS_DC = 3007 * MiB, WS_CP = 3135 * MiB;
constexpr size_t WS_SMALL = 3199 * MiB, WS_SS = 3201 * MiB, SS_ZERO_BYTES = 2 * MiB, WS_END = 3203 * MiB;
constexpr size_t SM_DECAY = 0, SM_DN = 512 * 1024, SM_NP = 1024 * 1024, SM_GG = 1536 * 1024, SM_FL = 1536 * 1024 + 4096, SM_MP = 1536 * 1024 + 8192;
static_assert(WS_U + (size_t)SEQ * DFF * 2 <= WS_OB, "U overlay");
constexpr int CW_BAR = 4096;
static_assert(9 * (size_t)SEQ * 8 <= SS_ZERO_BYTES, "SS region");
typedef unsigned long long u64_t;
DI float ss_to_f(u64_t v) { return (float)v * (1.0f / 16777216.0f); }

constexpr int LDS_BYTES = 147456;
constexpr int L_ST = 0, L_VT = 69632, L_Q = 106496, L_K = 123904, L_MISC = 141312, L_BARW = 146432;
constexpr int ROW72 = 144, ROW136 = 272, ROW264 = 528;
constexpr int NWAVES = 8;

DI float bf2f(unsigned v) { return __uint_as_float(v << 16); }
DI float bflo(unsigned w) { return __uint_as_float(w << 16); }
DI float bfhi(unsigned w) { return __uint_as_float(w & 0xffff0000u); }
typedef __bf16 bf16x2_t __attribute__((ext_vector_type(2)));
DI unsigned pk2(float lo, float hi) { const f32x2 v = {lo, hi}; const bf16x2_t b = __builtin_convertvector(v, bf16x2_t); return __builtin_bit_cast(unsigned, b); }
DI float sigmoid_f(float x) { return __builtin_amdgcn_rcpf(1.0f + __expf(-x)); }
DI float silu_f(float x) { return x * sigmoid_f(x); }
DI float log_sigmoid_f(float x) { return fminf(x, 0.f) - __logf(1.0f + __expf(-fabsf(x))); }
DI float shx(float v, int o, int lane) { return __int_as_float(__builtin_amdgcn_ds_bpermute((lane ^ o) << 2, __float_as_int(v))); }
DI float shi(float v, int src) { return __int_as_float(__builtin_amdgcn_ds_bpermute(src << 2, __float_as_int(v))); }
DI float wave_sum(float v, int lane) {
#pragma unroll
    for (int o = 1; o < 64; o <<= 1) v += shx(v, o, lane);
    return v;
}
DI float wave_max(float v, int lane) {
#pragma unroll
    for (int o = 1; o < 64; o <<= 1) v = fmaxf(v, shx(v, o, lane));
    return v;
}
DI float wave_scan_sum(float v, int lane) {
#pragma unroll
    for (int o = 1; o < 64; o <<= 1) { const float t = shi(v, lane >= o ? lane - o : lane); if (lane >= o) v += t; }
    return v;
}
DI float wave_scan_max(float v, int lane) {
#pragma unroll
    for (int o = 1; o < 64; o <<= 1) { const float t = shi(v, lane >= o ? lane - o : lane); if (lane >= o) v = fmaxf(v, t); }
    return v;
}
DI f32x4 mfma16(bf16x8 a, bf16x8 b, f32x4 c) { return __builtin_amdgcn_mfma_f32_16x16x32_bf16(a, b, c, 0, 0, 0); }
DI int opaque_tid() { int t = (int)threadIdx.x; asm volatile("" : "+v"(t)); return t; }
DI int opaque_bx() { int b = (int)blockIdx.x; asm volatile("" : "+s"(b)); return b; }
DI LAS unsigned char* opaque_lds(LAS unsigned char* p) { asm volatile("" : "+s"(p)); return p; }
DI int opq(int v) { asm volatile("" : "+s"(v)); return v; }
DI int opaque_g() { int g = (int)gridDim.x; asm volatile("" : "+s"(g)); return g; }

namespace pg8 {
#define PG8_LAS __attribute__((address_space(3)))
constexpr int BM = 256, BK = 64, HALF = 128, HTB = HALF * BK * 2  , STAGE_BYTES = 8 * HTB, NXCD = 8, WGM = 8;

__host__ __device__ __forceinline__ int lds_byte(int r, int c) { const int st = (r >> 4) * 2 + (c >> 5), rr = r & 15, cc = c & 31, ob = rr * 64 + cc * 2; return st * 1024 + (ob ^ (((ob >> 9) & 1) << 5)); }
__host__ __device__ __forceinline__ void stage_rc(int b, int& R, int& C) { const int st = b / 1024, sb = b % 1024, swz = sb ^ (((sb >> 9) & 1) << 5); R = (st >> 1) * 16 + swz / 64; C = (st & 1) * 32 + (swz % 64) / 2; }
__host__ __device__ __forceinline__ int perm32(int rho) { const int n = rho >> 4, i = rho & 15; return 8 * (i >> 2) + 4 * n + (i & 3); }

struct Unit { int pm, pn; };
struct Gemm { const bf16_t* A; const bf16_t* Bt; int M, N, K, lda, ldb; };

struct StaticOrder {
    int nM, nN, nwg, G, c;
    __host__ __device__ void init(int M, int N, int G_, int c_) { nM = M / BM; nN = N / BM; nwg = nM * nN; G = G_; c = c_; }
    __host__ __device__ bool next(int i, Unit& u) const {
        const long L = (long)i * G + c; if (L >= nwg) return false;
        int wgid = (int)L; { const int q = nwg / NXCD, r = nwg % NXCD, xcd = wgid % NXCD, off = wgid / NXCD; wgid = (xcd < r ? xcd * (q + 1) : r * (q + 1) + (xcd - r) * q) + off; }
        const int nig = WGM * nN, gid = wgid / nig, fm = gid * WGM, gsz = (nM - fm) < WGM ? (nM - fm) : WGM;
        u.pm = fm + ((wgid % nig) % gsz); u.pn = (wgid % nig) / gsz; return true;
    }
    __device__ __forceinline__ void a_ready(const Unit&) const {}
    __device__ __forceinline__ void done(const Unit&) const {}
};

template <int ACT  > struct EpiBf16 {
    static constexpr bool PERM = true, AFTER_DRAIN = false, HOOK = false;
    bf16_t* O; int ldc; const float* bias; const unsigned long long* ss;
    __device__ __forceinline__ void operator()(const f32x4 (&acc)[2][2][4][2], const Unit& u, int wr, int wc, int fr, int fq) const {
        const int row0 = u.pm * BM + wr * 64 + fr, col0 = u.pn * BM + wc * 32 + 8 * fq;
        f32x4 bv[2][2];
#pragma unroll
        for (int bj = 0; bj < 2; ++bj)
#pragma unroll
            for (int n = 0; n < 2; ++n) bv[bj][n] = (ACT == 2) ? *(const f32x4*)(bias + col0 + bj * HALF + 4 * n) : (f32x4){0.f, 0.f, 0.f, 0.f};
#pragma unroll
        for (int ai = 0; ai < 2; ++ai)
#pragma unroll
            for (int m = 0; m < 4; ++m) { bf16_t* rowp = O + (size_t)(row0 + ai * HALF + m * 16) * ldc + col0;
                float rs = 1.f; if (ACT != 2) { if (ss) rs = 1.0f / sqrtf((float)ss[row0 + ai * HALF + m * 16] * (1.0f / 16777216.0f) * (1.0f / DM) + EPS); }
#pragma unroll
                for (int bj = 0; bj < 2; ++bj) { f32x4 v0 = acc[ai][bj][m][0], v1 = acc[ai][bj][m][1];
                    if (ACT != 2) { v0 = v0 * rs; v1 = v1 * rs; }
                    if (ACT == 1) {
#pragma unroll
                        for (int j = 0; j < 4; ++j) { const float a = fmaxf(v0[j], 0.f), b = fmaxf(v1[j], 0.f); v0[j] = a * a; v1[j] = b * b; } }
                    if (ACT == 2) { v0 = v0 + bv[bj][0]; v1 = v1 + bv[bj][1];
#pragma unroll
                        for (int j = 0; j < 4; ++j) { v0[j] = sigmoid_f(fminf(fmaxf(v0[j], -30.f), 30.f)); v1[j] = sigmoid_f(fminf(fmaxf(v1[j], -30.f), 30.f)); } }
                    u32x4 w; w.x = pk2(v0[0], v0[1]); w.y = pk2(v0[2], v0[3]); w.z = pk2(v1[0], v1[1]); w.w = pk2(v1[2], v1[3]);
                    *(u32x4*)(rowp + bj * HALF) = w; } }
    }
    __device__ __forceinline__ bool hook_at(int) const { return false; }
    __device__ __forceinline__ void hook(f32x4 (&)[2][2][4][2], const Unit&, int, int, int, int, int) const {}
};
struct EpiResid {
    static constexpr bool PERM = true, AFTER_DRAIN = false, HOOK = false;
    const float* in; float* out; int ldc; bf16_t* xb; unsigned long long* ss;
    __device__ __forceinline__ void operator()(const f32x4 (&acc)[2][2][4][2], const Unit& u, int wr, int wc, int fr, int fq) const {
        const int row0 = u.pm * BM + wr * 64 + fr, col0 = u.pn * BM + wc * 32 + 8 * fq, lane = fq * 16 + fr;
#pragma unroll
        for (int ai = 0; ai < 2; ++ai) {
            f32x4 r[4][2][2];
#pragma unroll
            for (int m = 0; m < 4; ++m) { const size_t off = (size_t)(row0 + ai * HALF + m * 16) * ldc + col0;
#pragma unroll
                for (int bj = 0; bj < 2; ++bj)
#pragma unroll
                    for (int n = 0; n < 2; ++n) r[m][bj][n] = *(const f32x4*)(in + off + bj * HALF + n * 4); }
#pragma unroll
            for (int m = 0; m < 4; ++m) { const int row = row0 + ai * HALF + m * 16; const size_t off = (size_t)row * ldc + col0;
                float sq = 0.f;
#pragma unroll
                for (int bj = 0; bj < 2; ++bj) { const f32x4 o0 = r[m][bj][0] + acc[ai][bj][m][0], o1 = r[m][bj][1] + acc[ai][bj][m][1];
                    *(f32x4*)(out + off + bj * HALF) = o0; *(f32x4*)(out + off + bj * HALF + 4) = o1;
                    sq += (o0[0] * o0[0] + o0[1] * o0[1]) + (o0[2] * o0[2] + o0[3] * o0[3]) + (o1[0] * o1[0] + o1[1] * o1[1]) + (o1[2] * o1[2] + o1[3] * o1[3]);
                    u32x4 w; w.x = pk2(o0[0], o0[1]); w.y = pk2(o0[2], o0[3]); w.z = pk2(o1[0], o1[1]); w.w = pk2(o1[2], o1[3]);
                    *(u32x4*)(xb + off + bj * HALF) = w; }
                sq += shx(sq, 16, lane); sq += shx(sq, 32, lane);
                if (fq == 0) (void)__hip_atomic_fetch_add(ss + row, (unsigned long long)(sq * 16777216.0f), __ATOMIC_RELAXED, __HIP_MEMORY_SCOPE_AGENT); }
            asm volatile("" ::: "memory"); }
    }
    __device__ __forceinline__ bool hook_at(int) const { return false; }
    __device__ __forceinline__ void hook(f32x4 (&)[2][2][4][2], const Unit&, int, int, int, int, int) const {}
};
struct EpiBranch {
    static constexpr bool PERM = true, AFTER_DRAIN = false, HOOK = true;
    bf16_t* O; int ldc; const bf16_t* GT;
    __device__ __forceinline__ bool hook_at(int t) const { return t == 16 || t == 32; }
    __device__ __forceinline__ void hook(f32x4 (&acc)[2][2][4][2], const Unit& u, int t, int, int, int, int) const {
        const int tid_ = opaque_tid(), wid_ = tid_ >> 6, wr = wid_ >> 2, wc = wid_ & 3, fr = tid_ & 15, fq = (tid_ >> 4) & 3;
        const int row0 = u.pm * BM + wr * 64 + fr, col0 = u.pn * BM + wc * 32 + 8 * fq;
        const bf16_t* ga = GT + (size_t)(t == 16 ? 0 : DM); const bf16_t* gb = ga + DM;
#pragma unroll
        for (int ai = 0; ai < 2; ++ai) {
            u32x4 a[4][2], b[4][2];
#pragma unroll
            for (int m = 0; m < 4; ++m) { const size_t off = (size_t)(row0 + ai * HALF + m * 16) * GTW + col0;
#pragma unroll
                for (int bj = 0; bj < 2; ++bj) { a[m][bj] = *(const u32x4*)(ga + off + bj * HALF); b[m][bj] = *(const u32x4*)(gb + off + bj * HALF); } }
#pragma unroll
            for (int m = 0; m < 4; ++m)
#pragma unroll
                for (int bj = 0; bj < 2; ++bj) { const u32x4 x = a[m][bj], y = b[m][bj];
                    f32x4 r0, r1;
                    r0[0] = bflo(x.x) * __builtin_amdgcn_rcpf(bflo(y.x)); r0[1] = bfhi(x.x) * __builtin_amdgcn_rcpf(bfhi(y.x));
                    r0[2] = bflo(x.y) * __builtin_amdgcn_rcpf(bflo(y.y)); r0[3] = bfhi(x.y) * __builtin_amdgcn_rcpf(bfhi(y.y));
                    r1[0] = bflo(x.z) * __builtin_amdgcn_rcpf(bflo(y.z)); r1[1] = bfhi(x.z) * __builtin_amdgcn_rcpf(bfhi(y.z));
                    r1[2] = bflo(x.w) * __builtin_amdgcn_rcpf(bflo(y.w)); r1[3] = bfhi(x.w) * __builtin_amdgcn_rcpf(bfhi(y.w));
                    acc[ai][bj][m][0] = acc[ai][bj][m][0] * r0; acc[ai][bj][m][1] = acc[ai][bj][m][1] * r1; }
            asm volatile("" ::: "memory"); }
    }
    __device__ __forceinline__ void operator()(const f32x4 (&acc)[2][2][4][2], const Unit& u, int wr, int wc, int fr, int fq) const {
        const int row0 = u.pm * BM + wr * 64 + fr, col0 = u.pn * BM + wc * 32 + 8 * fq;
        const bf16_t* gc = GT + 2 * DM;
        u32x4 g[2][4][2];
#pragma unroll
        for (int ai = 0; ai < 2; ++ai)
#pragma unroll
            for (int m = 0; m < 4; ++m)
#pragma unroll
                for (int bj = 0; bj < 2; ++bj) g[ai][m][bj] = *(const u32x4*)(gc + (size_t)(row0 + ai * HALF + m * 16) * GTW + col0 + bj * HALF);
#pragma unroll
        for (int ai = 0; ai < 2; ++ai)
#pragma unroll
            for (int m = 0; m < 4; ++m) { const size_t r = (size_t)(row0 + ai * HALF + m * 16);
#pragma unroll
                for (int bj = 0; bj < 2; ++bj) { const u32x4 gg = g[ai][m][bj];
                    const f32x4 v0 = acc[ai][bj][m][0], v1 = acc[ai][bj][m][1];
                    u32x4 w; w.x = pk2(v0[0] * bflo(gg.x), v0[1] * bfhi(gg.x)); w.y = pk2(v0[2] * bflo(gg.y), v0[3] * bfhi(gg.y));
                    w.z = pk2(v1[0] * bflo(gg.z), v1[1] * bfhi(gg.z)); w.w = pk2(v1[2] * bflo(gg.w), v1[3] * bfhi(gg.w));
                    *(u32x4*)(O + r * ldc + col0 + bj * HALF) = w; } }
    }
};

template <class Epi, class Sched, bool ALIGN_EPI = false, bool SP2 = false>
__device__ __forceinline__ void gemm_phase(PG8_LAS unsigned char* lds, const Gemm g, const Sched& S, const Epi& E) {
    const int tid = opaque_tid(), wid = __builtin_amdgcn_readfirstlane(tid >> 6), lane = tid & 63, wr = wid >> 2, wc = wid & 3, fr = lane & 15, fq = lane >> 4;
    const int K = g.K, nt = K / BK;
    unsigned voffA[2], voffB[2];
#pragma unroll
    for (int i = 0; i < 2; ++i) { int R, C; stage_rc(tid * 16 + i * 8192, R, C); const int Rb = Epi::PERM ? ((R & ~31) + perm32(R & 31)) : R;
        voffA[i] = (unsigned)(R * g.lda + C) * 2u; voffB[i] = (unsigned)(Rb * g.ldb + C) * 2u; }
    const size_t kstep = (size_t)(BK * 2);
    const size_t hstepA = (size_t)HALF * g.lda * 2, hstepB = (size_t)HALF * g.ldb * 2;
    const size_t tstepA = 2 * hstepA, tstepB = 2 * hstepB;
    const unsigned ldsw = (unsigned)wid * 1024u;
    const int aoff = lds_byte(wr * 64 + fr, fq * 8), boff = lds_byte(wc * 32 + fr, fq * 8);
#define PG8_SA(b, h) (((b) * 2 + (h)) * HTB)
#define PG8_SB(b, h) ((4 + (b) * 2 + (h)) * HTB)
#define PG8_STAGE(bufoff, gbase, voff) do { _Pragma("unroll") for (int _i = 0; _i < 2; ++_i) \
        __builtin_amdgcn_global_load_lds((const unsigned*)((const char*)(gbase) + (voff)[_i]), (PG8_LAS unsigned*)(lds + (bufoff) + ldsw + _i * 8192), 16, 0, 0); } while (0)
#define PG8_LDA(dst, b, h) do { _Pragma("unroll") for (int m = 0; m < 4; ++m) _Pragma("unroll") for (int k = 0; k < 2; ++k) dst[m][k] = *(const PG8_LAS bf16x8*)(lds + PG8_SA(b, h) + aoff + m * 2048 + k * 1024); } while (0)
#define PG8_LDB(dst, b, h) do { _Pragma("unroll") for (int n = 0; n < 2; ++n) _Pragma("unroll") for (int k = 0; k < 2; ++k) dst[n][k] = *(const PG8_LAS bf16x8*)(lds + PG8_SB(b, h) + boff + n * 2048 + k * 1024); } while (0)
#define PG8_MMA(ai, bj, At, Bt) do { __builtin_amdgcn_s_setprio(1); _Pragma("unroll") for (int m = 0; m < 4; ++m) _Pragma("unroll") for (int n = 0; n < 2; ++n) _Pragma("unroll") for (int k = 0; k < 2; ++k) \
        acc[ai][bj][m][n] = __builtin_amdgcn_mfma_f32_16x16x32_bf16(Bt[n][k], At[m][k], acc[ai][bj][m][n], 0, 0, 0); __builtin_amdgcn_s_setprio(0); } while (0)
#define PG8_WAIT_V(n) asm volatile("s_waitcnt vmcnt(" #n ")" ::: "memory")
#define PG8_WAIT_L(n) asm volatile("s_waitcnt lgkmcnt(" #n ")" ::: "memory")
#define PG8_BAR __builtin_amdgcn_s_barrier()
#define PG8_SCHED __builtin_amdgcn_sched_barrier(0)
    Unit cur, nxt; int ui = 0;
    if (!S.next(0, cur)) return;
    f32x4 acc[2][2][4][2];
#pragma unroll
    for (int a = 0; a < 2; ++a)
#pragma unroll
        for (int b = 0; b < 2; ++b)
#pragma unroll
            for (int m = 0; m < 4; ++m)
#pragma unroll
                for (int n = 0; n < 2; ++n) acc[a][b][m][n] = (f32x4){0.f, 0.f, 0.f, 0.f};
    bf16x8 At[4][2], B0[2][2], B1[2][2];
    const char* cA = (const char*)g.A + (size_t)cur.pm * tstepA; const char* cB = (const char*)g.Bt + (size_t)cur.pn * tstepB;
    S.a_ready(cur);
    if constexpr (SP2) {
        PG8_STAGE(PG8_SB(0, 0), cB, voffB); PG8_STAGE(PG8_SB(0, 1), cB + hstepB, voffB); PG8_STAGE(PG8_SA(0, 0), cA, voffA); PG8_STAGE(PG8_SA(0, 1), cA + hstepA, voffA);
        if (wr == 1) PG8_BAR;
        PG8_WAIT_V(2); PG8_BAR;
        PG8_STAGE(PG8_SB(1, 0), cB + kstep, voffB); PG8_STAGE(PG8_SA(1, 0), cA + kstep, voffA); PG8_STAGE(PG8_SB(1, 1), cB + hstepB + kstep, voffB);
        PG8_WAIT_V(6); PG8_BAR;
    } else {
        PG8_STAGE(PG8_SB(0, 0), cB, voffB); PG8_STAGE(PG8_SA(0, 0), cA, voffA); PG8_STAGE(PG8_SB(0, 1), cB + hstepB, voffB); PG8_STAGE(PG8_SA(0, 1), cA + hstepA, voffA);
        if (wr == 1) PG8_BAR;
        PG8_WAIT_V(4); PG8_BAR;
        PG8_STAGE(PG8_SB(1, 0), cB + kstep, voffB); PG8_STAGE(PG8_SA(1, 0), cA + kstep, voffA); PG8_STAGE(PG8_SB(1, 1), cB + hstepB + kstep, voffB);
        PG8_WAIT_V(6); PG8_BAR;
    }
    for (;;) {
        const bool has_next = S.next(ui + 1, nxt);
        const char* nA = has_next ? (const char*)g.A + (size_t)nxt.pm * tstepA : cA; const char* nB = has_next ? (const char*)g.Bt + (size_t)nxt.pn * tstepB : cB;
        for (int t = 0; t < nt; t += 2) {
            const bool last = (t == nt - 2);
            if constexpr (Epi::HOOK) { if (E.hook_at(t)) E.hook(acc, cur, t, wr, wc, fr, fq); }
            const char* a1 = cA + (size_t)(t + 1) * kstep;
            const char* a2 = last ? nA : cA + (size_t)(t + 2) * kstep; const char* b2 = last ? nB : cB + (size_t)(t + 2) * kstep;
            const char* a3 = a2 + kstep; const char* b3 = b2 + kstep;
            if (last && has_next) S.a_ready(nxt);
            if constexpr (SP2) {
            PG8_LDB(B0, 0, 0); PG8_LDB(B1, 0, 1); PG8_SCHED; PG8_LDA(At, 0, 0); PG8_STAGE(PG8_SA(1, 1), a1 + hstepA, voffA);
            PG8_WAIT_V(8); PG8_WAIT_L(0); PG8_BAR; PG8_MMA(0, 0, At, B0); PG8_MMA(0, 1, At, B1); PG8_BAR; PG8_SCHED;
            PG8_LDA(At, 0, 1); PG8_STAGE(PG8_SB(0, 0), b2, voffB); PG8_STAGE(PG8_SB(0, 1), b2 + hstepB, voffB); PG8_STAGE(PG8_SA(0, 0), a2, voffA);
            PG8_WAIT_V(8); PG8_WAIT_L(0); PG8_BAR; PG8_MMA(1, 0, At, B0); PG8_MMA(1, 1, At, B1); PG8_BAR; PG8_SCHED;
            PG8_LDB(B0, 1, 0); PG8_LDB(B1, 1, 1); PG8_SCHED; PG8_LDA(At, 1, 0); PG8_STAGE(PG8_SA(0, 1), a2 + hstepA, voffA);
            PG8_WAIT_V(8); PG8_WAIT_L(0); PG8_BAR; PG8_MMA(0, 0, At, B0); PG8_MMA(0, 1, At, B1); PG8_BAR; PG8_SCHED;
            PG8_LDA(At, 1, 1); PG8_STAGE(PG8_SB(1, 0), b3, voffB); PG8_STAGE(PG8_SB(1, 1), b3 + hstepB, voffB); PG8_STAGE(PG8_SA(1, 0), a3, voffA);
            PG8_WAIT_V(8); PG8_WAIT_L(0); PG8_BAR; PG8_MMA(1, 0, At, B0); PG8_MMA(1, 1, At, B1); PG8_BAR; PG8_SCHED;
            } else {
            PG8_LDB(B0, 0, 0); PG8_SCHED; PG8_LDA(At, 0, 0); PG8_STAGE(PG8_SA(1, 1), a1 + hstepA, voffA);
            PG8_WAIT_L(8); PG8_BAR; PG8_WAIT_L(0); PG8_MMA(0, 0, At, B0); PG8_BAR; PG8_SCHED;
            PG8_LDB(B1, 0, 1); PG8_STAGE(PG8_SB(0, 0), b2, voffB);
            PG8_BAR; PG8_WAIT_L(0); PG8_MMA(0, 1, At, B1); PG8_BAR;
            PG8_LDA(At, 0, 1); PG8_STAGE(PG8_SA(0, 0), a2, voffA);
            PG8_BAR; PG8_WAIT_L(0); PG8_MMA(1, 0, At, B0); PG8_BAR; PG8_SCHED;
            PG8_STAGE(PG8_SB(0, 1), b2 + hstepB, voffB);
            PG8_WAIT_V(6); PG8_BAR; PG8_MMA(1, 1, At, B1); PG8_BAR;
            PG8_LDB(B0, 1, 0); PG8_SCHED; PG8_LDA(At, 1, 0); PG8_STAGE(PG8_SA(0, 1), a2 + hstepA, voffA);
            PG8_WAIT_L(8); PG8_BAR; PG8_WAIT_L(0); PG8_MMA(0, 0, At, B0); PG8_BAR; PG8_SCHED;
            PG8_LDB(B1, 1, 1); PG8_STAGE(PG8_SB(1, 0), b3, voffB);
            PG8_BAR; PG8_WAIT_L(0); PG8_MMA(0, 1, At, B1); PG8_BAR;
            PG8_LDA(At, 1, 1); PG8_STAGE(PG8_SA(1, 0), a3, voffA);
            PG8_BAR; PG8_WAIT_L(0); PG8_MMA(1, 0, At, B0); PG8_BAR; PG8_SCHED;
            PG8_STAGE(PG8_SB(1, 1), b3 + hstepB, voffB);
            PG8_WAIT_V(6); PG8_BAR; PG8_MMA(1, 1, At, B1); PG8_BAR;
            }
        }
        if constexpr (ALIGN_EPI) { if (wr == 0) PG8_BAR; }
        E(acc, cur, wr, wc, fr, fq); S.done(cur);
        if (!has_next) break;
#pragma unroll
        for (int a = 0; a < 2; ++a)
#pragma unroll
            for (int b = 0; b < 2; ++b)
#pragma unroll
                for (int m = 0; m < 4; ++m)
#pragma unroll
                    for (int n = 0; n < 2; ++n) acc[a][b][m][n] = (f32x4){0.f, 0.f, 0.f, 0.f};
        cur = nxt; cA = nA; cB = nB; ++ui;
        if constexpr (ALIGN_EPI) { if (wr == 1) PG8_BAR; }
    }
    PG8_WAIT_V(0);
    if constexpr (!ALIGN_EPI) { if (wr == 0) PG8_BAR; }
    PG8_BAR;
#undef PG8_SA
#undef PG8_SB
#undef PG8_STAGE
#undef PG8_LDA
#undef PG8_LDB
#undef PG8_MMA
#undef PG8_WAIT_V
#undef PG8_WAIT_L
#undef PG8_BAR
#undef PG8_SCHED
}
}

#define XB_TMO      128
#define XB_XCNT(j)  (256  + 64 * (j))
#define XB_XSUB(j)  (1280 + 64 * (j))
#define XB_XGEN(j)  (2304 + 64 * (j))
#define XB_TOP      3328
#define XB_TOPGEN   3392
#define XCD_BAR_WORDS 3456
#define XB_SPIN_CAP (1u << 18)

__device__ __forceinline__ unsigned xb_ld(unsigned* p)              { return __hip_atomic_load(p, __ATOMIC_RELAXED, __HIP_MEMORY_SCOPE_AGENT); }
__device__ __forceinline__ unsigned xb_add(unsigned* p, unsigned v) { return __hip_atomic_fetch_add(p, v, __ATOMIC_RELAXED, __HIP_MEMORY_SCOPE_AGENT); }
__device__ __forceinline__ unsigned xb_xcc_id() { return (unsigned)__builtin_amdgcn_s_getreg((3 << 11) | 20) & 0xFu; }
#define XB_SPIN(cond, bar) do { unsigned _sp = 0; while (cond) { __builtin_amdgcn_s_sleep(1); \
    if ((++_sp & 255u) == 0u) { if (xb_ld(&(bar)[XB_TMO])) break; if (_sp > XB_SPIN_CAP) { atomicAdd(&(bar)[XB_TMO], 1u); break; } } } } while (0)

struct XcdBarrier {
    unsigned* bar; unsigned x;
    volatile LAS unsigned* st;
};
__device__ __forceinline__ XcdBarrier xcd_barrier_post(unsigned* bar, volatile LAS unsigned* st) {
    XcdBarrier b; b.bar = bar; b.x = xb_xcc_id(); b.st = st;
    if (threadIdx.x == 0) (void)xb_add(&bar[XB_XCNT(b.x)], 1u);
    return b;
}
__device__ __forceinline__ void xcd_barrier_complete(unsigned* bar, unsigned x, unsigned& nloc, unsigned& nx) {
    const unsigned G = gridDim.x * gridDim.y * gridDim.z;
    unsigned sum, cnt, mine, sp = 0u;
    for (;;) {
        sum = 0u; cnt = 0u; mine = 0u;
#pragma unroll
        for (unsigned j = 0; j < 16; ++j) { const unsigned c = xb_ld(&bar[XB_XCNT(j)]); sum += c; cnt += (c > 0u) ? 1u : 0u; mine = (j == x) ? c : mine; }
        if (sum == G) break;
        __builtin_amdgcn_s_sleep(1);
        if ((++sp & 255u) == 0u) { if (xb_ld(&bar[XB_TMO])) break; if (sp > XB_SPIN_CAP) { atomicAdd(&bar[XB_TMO], 1u); break; } }
    }
    nloc = mine > 0u ? mine : 1u; nx = cnt > 0u ? cnt : 1u;
}
__device__ __forceinline__ void xcd_barrier(const XcdBarrier& b) {
    asm volatile("s_waitcnt vmcnt(0)" ::: "memory");
    __syncthreads();
    if (threadIdx.x == 0) {
        unsigned* bar = b.bar;
        __builtin_amdgcn_s_waitcnt(0);
        unsigned nloc = b.st[0], nx = b.st[1];
        if (nloc == 0u) { xcd_barrier_complete(bar, b.x, nloc, nx); b.st[0] = nloc; b.st[1] = nx; }
        const unsigned old = xb_add(&bar[XB_XSUB(b.x)], 1u);
        const unsigned gen = old / nloc;
        if (old + 1u == (gen + 1u) * nloc) {
            __builtin_amdgcn_fence(__ATOMIC_RELEASE, "agent");
            asm volatile("s_waitcnt vmcnt(0)" ::: "memory");
            const unsigned og = xb_add(&bar[XB_TOP], 1u);
            const unsigned tg = og / nx;
            if (og + 1u == (tg + 1u) * nx) xb_add(&bar[XB_TOPGEN], 1u);
            else XB_SPIN(xb_ld(&bar[XB_TOPGEN]) == tg, bar);
            __builtin_amdgcn_fence(__ATOMIC_ACQUIRE, "agent");
            xb_add(&bar[XB_XGEN(b.x)], 1u);
            asm volatile("s_waitcnt vmcnt(0)" ::: "memory");
        } else {
            XB_SPIN(xb_ld(&bar[XB_XGEN(b.x)]) == gen, bar);
            __builtin_amdgcn_fence(__ATOMIC_ACQUIRE, "agent");
            asm volatile("s_waitcnt vmcnt(0)" ::: "memory");
        }
    }
    __syncthreads();
}

struct Params { const float* in[23]; float* out; unsigned char* ws; };
enum { I_X = 0, I_MEM, I_NORM_MIX, I_W_IN, I_W_GLA_A, I_B_GLA_A, I_GLA_NORM, I_CONV_W, I_CONV_B, I_B_ML_I, I_B_ML_F, I_ML_NORM, I_MEM_NORM, I_W_MEM_K, I_W_MEM_V, I_W_BRANCH, I_W_GATE, I_B_GATE, I_W_OUT, I_NORM_FFN, I_W_FF1, I_W_FF2, I_FINAL_NORM };

DI int win_row(int n) {
    if (n < 3072) return n;
    if (n < 3088) return ZC_GA + (n - 3072);
    if (n < 6160) return n - 16;
    if (n < 6168) return ZC_MI + (n - 6160);
    return n - 24;
}
DI void transpose_item(const float* __restrict__ W, int K, int N, bf16_t* __restrict__ WT, int ld_dst, int col_off, int row_off, bool remap, LAS float* scr, int item, int lane, const float* __restrict__ gain = nullptr) {
    const int nblk = (N + 63) >> 6, kb = item / nblk, nb = item - kb * nblk, k0 = kb << 6, n0 = nb << 6;
    const int a = lane & 15, q = lane >> 4, n4 = 4 * a;
    const bool ok = (n0 + n4) < N;
    f32x4 v[16];
#pragma unroll
    for (int i = 0; i < 16; ++i) { const int kk = 4 * i + q; v[i] = ok ? *(const f32x4*)(W + (size_t)(k0 + kk) * N + n0 + n4) : (f32x4){0.f, 0.f, 0.f, 0.f}; }
#pragma unroll
    for (int i = 0; i < 16; ++i) { const int kk = 4 * i + q;
#pragma unroll
        for (int e = 0; e < 4; ++e) scr[(n4 + e) * 65 + kk] = v[i][e]; }
    asm volatile("s_waitcnt lgkmcnt(0)" ::: "memory");
    const int c = lane & 7;
    f32x4 g0 = (f32x4){1.f, 1.f, 1.f, 1.f}, g1 = g0;
    if (gain) { g0 = *(const f32x4*)(gain + k0 + 8 * c); g1 = *(const f32x4*)(gain + k0 + 8 * c + 4); }
#pragma unroll
    for (int jj = 0; jj < 8; ++jj) { const int n = (lane >> 3) + 8 * jj; const LAS float* s = scr + n * 65 + 8 * c;
        u32x4 o; o.x = pk2(s[0] * g0[0], s[1] * g0[1]); o.y = pk2(s[2] * g0[2], s[3] * g0[3]); o.z = pk2(s[4] * g1[0], s[5] * g1[1]); o.w = pk2(s[6] * g1[2], s[7] * g1[3]);
        const int ng = n0 + n;
        if (ng < N) { const int row = row_off + (remap ? win_row(ng) : ng); *(u32x4*)(WT + (size_t)row * ld_dst + col_off + k0 + 8 * c) = o; } }
    asm volatile("s_waitcnt lgkmcnt(0)" ::: "memory");
}

template <bool OUT_F32> DI void rmsnorm_row(const float* __restrict__ xrow, const float* __restrict__ g, void* orow, int lane) {
    const f32x4* xr = (const f32x4*)xrow + lane; const f32x4* gr = (const f32x4*)g + lane;
    f32x4 v[16]; float s = 0.f;
#pragma unroll
    for (int j = 0; j < 16; ++j) { v[j] = xr[64 * j]; s += (v[j].x * v[j].x + v[j].y * v[j].y) + (v[j].z * v[j].z + v[j].w * v[j].w); }
    const float rstd = 1.0f / sqrtf(wave_sum(s, lane) * (1.0f / DM) + EPS);
#pragma unroll
    for (int j = 0; j < 16; ++j) { const f32x4 gg = gr[64 * j]; const f32x4 o = v[j] * rstd * gg;
        if (OUT_F32) ((f32x4*)orow)[lane + 64 * j] = o;
        else { u32x2 w; w.x = pk2(o.x, o.y); w.y = pk2(o.z, o.w); ((u32x2*)orow)[lane + 64 * j] = w; } }
}

DI void row_bf16_ss(const float* __restrict__ xrow, bf16_t* orow, unsigned long long* ss, int lane) {
    const f32x4* xr = (const f32x4*)xrow + lane; float s = 0.f;
#pragma unroll
    for (int j = 0; j < 16; ++j) { const f32x4 v = xr[64 * j]; s += (v.x * v.x + v.y * v.y) + (v.z * v.z + v.w * v.w);
        u32x2 w; w.x = pk2(v.x, v.y); w.y = pk2(v.z, v.w); ((u32x2*)orow)[lane + 64 * j] = w; }
    s = wave_sum(s, lane);
    if (lane == 0) *ss = (unsigned long long)(s * 16777216.0f);
}
DI void row_scale_f32(const float* __restrict__ xrow, const float* __restrict__ g, float ssv, float* orow, int lane) {
    const f32x4* xr = (const f32x4*)xrow + lane; const f32x4* gr = (const f32x4*)g + lane;
    const float rstd = 1.0f / sqrtf(ssv * (1.0f / DM) + EPS);
#pragma unroll
    for (int j = 0; j < 16; ++j) ((f32x4*)orow)[lane + 64 * j] = xr[64 * j] * rstd * gr[64 * j];
}

DI void fill_vT(const bf16_t* __restrict__ Zv, int n, int tg, int lane, LAS unsigned char* VT) {
#pragma unroll
    for (int i = 0; i < 2; ++i) { const int cp = lane + 64 * i; unsigned w[8];
#pragma unroll
        for (int j = 0; j < 8; ++j) w[j] = *(const unsigned*)(Zv + (size_t)(n * CH + 8 * tg + j) * ZW + 2 * cp);
        u32x4 lo, hi;
        lo.x = (w[0] & 0xffffu) | (w[1] << 16); lo.y = (w[2] & 0xffffu) | (w[3] << 16); lo.z = (w[4] & 0xffffu) | (w[5] << 16); lo.w = (w[6] & 0xffffu) | (w[7] << 16);
        hi.x = (w[0] >> 16) | (w[1] & 0xffff0000u); hi.y = (w[2] >> 16) | (w[3] & 0xffff0000u); hi.z = (w[4] >> 16) | (w[5] & 0xffff0000u); hi.w = (w[6] >> 16) | (w[7] & 0xffff0000u);
        *(LAS u32x4*)(VT + (2 * cp) * ROW72 + tg * 16) = lo; *(LAS u32x4*)(VT + (2 * cp + 1) * ROW72 + tg * 16) = hi; }
}
DI void state_mfma(const LAS unsigned char* VT, const LAS unsigned char* KT, float* __restrict__ OUT, int w, int lane) {
    const int fr = lane & 15, fq = lane >> 4;
    f32x4 acc[2][8];
#pragma unroll
    for (int mi = 0; mi < 2; ++mi)
#pragma unroll
        for (int ni = 0; ni < 8; ++ni) acc[mi][ni] = (f32x4){0.f, 0.f, 0.f, 0.f};
#pragma unroll
    for (int ks = 0; ks < 2; ++ks) {
        bf16x8 a[2];
#pragma unroll
        for (int mi = 0; mi < 2; ++mi) a[mi] = *(const LAS bf16x8*)(VT + (32 * w + 16 * mi + fr) * ROW72 + (32 * ks + 8 * fq) * 2);
#pragma unroll
        for (int ni = 0; ni < 8; ++ni) { const bf16x8 b = *(const LAS bf16x8*)(KT + (16 * ni + fr) * ROW72 + (32 * ks + 8 * fq) * 2);
#pragma unroll
            for (int mi = 0; mi < 2; ++mi) acc[mi][ni] = mfma16(b, a[mi], acc[mi][ni]); }
    }
#pragma unroll
    for (int mi = 0; mi < 2; ++mi)
#pragma unroll
        for (int ni = 0; ni < 8; ++ni) *(f32x4*)(OUT + (size_t)(32 * w + 16 * mi + fr) * 128 + 16 * ni + 4 * fq) = acc[mi][ni];
}
DI void copy_256x128(const bf16_t* __restrict__ src, int gp, LAS unsigned char* dst, int tid) {
#pragma unroll
    for (int i = 0; i < 8; ++i) { const int id = tid + 512 * i, row = id >> 4, cc = id & 15;
        *(LAS u32x4*)(dst + row * ROW136 + cc * 16) = *(const u32x4*)(src + (size_t)row * gp + cc * 8); }
}
DI void gla_b(const bf16_t* __restrict__ Z, const float* __restrict__ wa, const float* __restrict__ ba, int h, int n, int tg, int c2, LAS float* TOT, float (&b)[8][2], float (&blast)[2]) {
    const int col = h * 128 + 2 * c2;
    float w0[16], w1[16];
#pragma unroll
    for (int r = 0; r < 16; ++r) { const f32x2 w = *(const f32x2*)(wa + r * 512 + col); w0[r] = w.x; w1[r] = w.y; }
    const f32x2 bb = *(const f32x2*)(ba + col);
    float c0 = 0.f, c1 = 0.f;
#pragma unroll
    for (int j = 0; j < 8; ++j) {
        const bf16_t* gp = Z + (size_t)(n * CH + 8 * tg + j) * ZW + ZC_GA;
        const u32x4 g0 = *(const u32x4*)gp, g1 = *(const u32x4*)(gp + 8);
        const float gv[16] = {bflo(g0.x), bfhi(g0.x), bflo(g0.y), bfhi(g0.y), bflo(g0.z), bfhi(g0.z), bflo(g0.w), bfhi(g0.w),
                              bflo(g1.x), bfhi(g1.x), bflo(g1.y), bfhi(g1.y), bflo(g1.z), bfhi(g1.z), bflo(g1.w), bfhi(g1.w)};
        float p0 = bb.x, p1 = bb.y;
#pragma unroll
        for (int r = 0; r < 16; ++r) { p0 += gv[r] * w0[r]; p1 += gv[r] * w1[r]; }
        c0 += log_sigmoid_f(p0) * (1.0f / 16.0f); c1 += log_sigmoid_f(p1) * (1.0f / 16.0f);
        b[j][0] = c0; b[j][1] = c1;
    }
    *(LAS f32x2*)(TOT + tg * 128 + 2 * c2) = (f32x2){c0, c1};
    __syncthreads();
    float pre0 = 0.f, pre1 = 0.f, t0 = 0.f, t1 = 0.f;
#pragma unroll
    for (int g = 0; g < 8; ++g) { const f32x2 t = *(const LAS f32x2*)(TOT + g * 128 + 2 * c2); if (g < tg) { pre0 += t.x; pre1 += t.y; } t0 += t.x; t1 += t.y; }
#pragma unroll
    for (int j = 0; j < 8; ++j) { b[j][0] += pre0; b[j][1] += pre1; }
    blast[0] = t0; blast[1] = t1;
}
DI void conv_silu8(const bf16_t* __restrict__ Zc, const float* __restrict__ cw, const float* __restrict__ cb, int tok0, float (&o0)[8], float (&o1)[8]) {
    float x0[11], x1[11];
#pragma unroll
    for (int i = 0; i < 11; ++i) { const int tok = tok0 - 3 + i; unsigned w = 0u; if (tok >= 0) w = *(const unsigned*)(Zc + (size_t)tok * ZW); x0[i] = bflo(w); x1[i] = bfhi(w); }
    f32x2 wj[4];
#pragma unroll
    for (int j = 0; j < 4; ++j) wj[j] = *(const f32x2*)(cw + j * 1024);
    const f32x2 bias = *(const f32x2*)cb;
#pragma unroll
    for (int j = 0; j < 8; ++j) { float y0 = bias.x, y1 = bias.y;
#pragma unroll
        for (int jj = 0; jj < 4; ++jj) { y0 += wj[jj].x * x0[j + jj]; y1 += wj[jj].y * x1[j + jj]; }
        o0[j] = silu_f(y0); o1[j] = silu_f(y1); }
}
DI void score_mfma(const LAS unsigned char* QL, const LAS unsigned char* KL, int w, int lane, f32x4 (&sacc)[2]) {
    const int fr = lane & 15, fq = lane >> 4, mi = w >> 1, ni0 = 2 * (w & 1);
    sacc[0] = (f32x4){0.f, 0.f, 0.f, 0.f}; sacc[1] = sacc[0];
#pragma unroll
    for (int ks = 0; ks < 4; ++ks) { const bf16x8 a = *(const LAS bf16x8*)(QL + (16 * mi + fr) * ROW136 + (32 * ks + 8 * fq) * 2);
#pragma unroll
        for (int jn = 0; jn < 2; ++jn) { const bf16x8 b = *(const LAS bf16x8*)(KL + (16 * (ni0 + jn) + fr) * ROW136 + (32 * ks + 8 * fq) * 2); sacc[jn] = mfma16(b, a, sacc[jn]); } }
}

struct MixCtx {
    const bf16_t* Z; bf16_t* OB;
    const float *wa, *ba, *gla_norm, *conv_w, *conv_b, *b_i, *b_f, *ml_norm;
    float *DS, *DC, *DECAY, *DN, *NP, *GG, *FL, *MP; bf16_t *SP, *CP;
    const bf16_t *KM, *VMT;
};

DI void gla_A_unit(const MixCtx& C, LAS unsigned char* lds, int h, int n, int tid) {
    const int lane = tid & 63, tg = __builtin_amdgcn_readfirstlane(tid >> 6), c2 = lane;
    LAS float* TOT = (LAS float*)(lds + L_MISC);
    LAS unsigned char* KT = lds + L_ST; LAS unsigned char* VT = lds + L_VT;
    float b[8][2], blast[2];
    gla_b(C.Z, C.wa, C.ba, h, n, tg, c2, TOT, b, blast);
    float k0[8], k1[8];
#pragma unroll
    for (int j = 0; j < 8; ++j) { const unsigned w = *(const unsigned*)(C.Z + (size_t)(n * CH + 8 * tg + j) * ZW + ZC_GK + h * 128 + 2 * c2);
        k0[j] = bflo(w) * __expf(blast[0] - b[j][0]); k1[j] = bfhi(w) * __expf(blast[1] - b[j][1]); }
    u32x4 lo, hi;
    lo.x = pk2(k0[0], k0[1]); lo.y = pk2(k0[2], k0[3]); lo.z = pk2(k0[4], k0[5]); lo.w = pk2(k0[6], k0[7]);
    hi.x = pk2(k1[0], k1[1]); hi.y = pk2(k1[2], k1[3]); hi.z = pk2(k1[4], k1[5]); hi.w = pk2(k1[6], k1[7]);
    *(LAS u32x4*)(KT + (2 * c2) * ROW72 + tg * 16) = lo; *(LAS u32x4*)(KT + (2 * c2 + 1) * ROW72 + tg * 16) = hi;
    if (tg == 0) *(f32x2*)(C.DECAY + (size_t)(h * NCH + n) * 128 + 2 * c2) = (f32x2){__expf(blast[0]), __expf(blast[1])};
    fill_vT(C.Z + ZC_GV + h * 256, n, tg, lane, VT);
    __syncthreads();
    state_mfma(VT, KT, C.DS + (size_t)(h * NCH + n) * 32768, tg, lane);
    __syncthreads();
}

DI void gla_B_unit(const MixCtx& C, LAS unsigned char* lds, int h, int n, int tid) {
    const int lane = tid & 63, w = __builtin_amdgcn_readfirstlane(tid >> 6), tg = w, c2 = lane, fr = lane & 15, fq = lane >> 4;
    LAS float* TOT = (LAS float*)(lds + L_MISC); LAS float* RS = (LAS float*)(lds + L_MISC + 4096);
    LAS unsigned char* ST = lds + L_ST; LAS unsigned char* VT = lds + L_VT; LAS unsigned char* QL = lds + L_Q; LAS unsigned char* KL = lds + L_K;
    copy_256x128(C.SP + (size_t)(h * NCH + n) * 32768, 128, ST, tid);
    float b[8][2], blast[2];
    gla_b(C.Z, C.wa, C.ba, h, n, tg, c2, TOT, b, blast);
    const float qs = 0.08838834764831845f;
#pragma unroll
    for (int j = 0; j < 8; ++j) { const size_t zr = (size_t)(n * CH + 8 * tg + j) * ZW;
        const unsigned wq = *(const unsigned*)(C.Z + zr + ZC_GQ + h * 128 + 2 * c2), wk = *(const unsigned*)(C.Z + zr + ZC_GK + h * 128 + 2 * c2);
        const float e0 = __expf(b[j][0]), e1 = __expf(b[j][1]);
        *(LAS unsigned*)(QL + (8 * tg + j) * ROW136 + 4 * c2) = pk2(bflo(wq) * qs * e0, bfhi(wq) * qs * e1);
        *(LAS unsigned*)(KL + (8 * tg + j) * ROW136 + 4 * c2) = pk2(bflo(wk) * __builtin_amdgcn_rcpf(e0), bfhi(wk) * __builtin_amdgcn_rcpf(e1)); }
    fill_vT(C.Z + ZC_GV + h * 256, n, tg, lane, VT);
    __syncthreads();
    f32x4 sacc[2];
    score_mfma(QL, KL, w, lane, sacc);
    __syncthreads();
    { const int mi = w >> 1, ni0 = 2 * (w & 1), t = 16 * mi + fr;
#pragma unroll
      for (int jn = 0; jn < 2; ++jn) { const int s0 = 16 * (ni0 + jn) + 4 * fq; f32x4 v = sacc[jn];
#pragma unroll
          for (int r = 0; r < 4; ++r) if (s0 + r > t) v[r] = 0.f;
          *(LAS u32x2*)(KL + t * ROW72 + s0 * 2) = (u32x2){pk2(v[0], v[1]), pk2(v[2], v[3])}; } }
    __syncthreads();
    const int wr = w >> 1, wc = w & 1, t = 16 * wr + fr;
    f32x4 o[8];
#pragma unroll
    for (int ni = 0; ni < 8; ++ni) o[ni] = (f32x4){0.f, 0.f, 0.f, 0.f};
#pragma unroll
    for (int ks = 0; ks < 2; ++ks) { const bf16x8 a = *(const LAS bf16x8*)(KL + t * ROW72 + (32 * ks + 8 * fq) * 2);
#pragma unroll
        for (int ni = 0; ni < 8; ++ni) { const bf16x8 bb = *(const LAS bf16x8*)(VT + (128 * wc + 16 * ni + fr) * ROW72 + (32 * ks + 8 * fq) * 2); o[ni] = mfma16(bb, a, o[ni]); } }
#pragma unroll
    for (int ks = 0; ks < 4; ++ks) { const bf16x8 a = *(const LAS bf16x8*)(QL + t * ROW136 + (32 * ks + 8 * fq) * 2);
#pragma unroll
        for (int ni = 0; ni < 8; ++ni) { const bf16x8 bb = *(const LAS bf16x8*)(ST + (128 * wc + 16 * ni + fr) * ROW136 + (32 * ks + 8 * fq) * 2); o[ni] = mfma16(bb, a, o[ni]); } }
    float ss = 0.f;
#pragma unroll
    for (int ni = 0; ni < 8; ++ni) ss += (o[ni][0] * o[ni][0] + o[ni][1] * o[ni][1]) + (o[ni][2] * o[ni][2] + o[ni][3] * o[ni][3]);
    ss += shx(ss, 16, lane); ss += shx(ss, 32, lane);
    if (fq == 0) RS[wc * 64 + t] = ss;
    __syncthreads();
    const float rstd = 1.0f / sqrtf((RS[t] + RS[64 + t]) * (1.0f / 256.0f) + EPS);
    const size_t tok = (size_t)(n * CH + t);
#pragma unroll
    for (int ni = 0; ni < 8; ++ni) { const int dv = 128 * wc + 16 * ni + 4 * fq;
        const u32x2 gg = *(const u32x2*)(C.Z + tok * ZW + ZC_GG + h * 256 + dv); const f32x4 gn = *(const f32x4*)(C.gla_norm + h * 256 + dv);
        const f32x4 v = o[ni] * rstd * gn;
        *(u32x2*)(C.OB + tok * OBW + h * 256 + dv) = (u32x2){pk2(v[0] * silu_f(bflo(gg.x)), v[1] * silu_f(bfhi(gg.x))), pk2(v[2] * silu_f(bflo(gg.y)), v[3] * silu_f(bfhi(gg.y)))}; }
    __syncthreads();
}

DI void ml_A_unit(const MixCtx& C, LAS unsigned char* lds, int h, int n, int tid) {
    const int lane = tid & 63, tg = __builtin_amdgcn_readfirstlane(tid >> 6), c2 = lane;
    LAS float* PART = (LAS float*)(lds + L_MISC);
    LAS unsigned char* KT = lds + L_ST; LAS unsigned char* VT = lds + L_VT;
    const size_t ztok = (size_t)(n * CH + lane) * ZW;
    const float li = bf2f(C.Z[ztok + ZC_MI + h]) + C.b_i[h];
    const float lf = log_sigmoid_f(bf2f(C.Z[ztok + ZC_MF + h]) + C.b_f[h]);
    const float F = wave_scan_sum(lf, lane);
    const float Flast = shi(F, 63);
    const float Gv = Flast - F + li;
    const float g = wave_max(Gv, lane);
    const float wG = __expf(Gv - g);
    float k0[8], k1[8];
    conv_silu8(C.Z + ZC_MQK + 512 + h * 128 + 2 * c2, C.conv_w + 512 + h * 128 + 2 * c2, C.conv_b + 512 + h * 128 + 2 * c2, n * CH + 8 * tg, k0, k1);
    const float ks = 0.08838834764831845f;
    float p0 = 0.f, p1 = 0.f;
#pragma unroll
    for (int j = 0; j < 8; ++j) { const float wj = shi(wG, 8 * tg + j) * ks; k0[j] *= wj; k1[j] *= wj; p0 += k0[j]; p1 += k1[j]; }
    u32x4 lo, hi;
    lo.x = pk2(k0[0], k0[1]); lo.y = pk2(k0[2], k0[3]); lo.z = pk2(k0[4], k0[5]); lo.w = pk2(k0[6], k0[7]);
    hi.x = pk2(k1[0], k1[1]); hi.y = pk2(k1[2], k1[3]); hi.z = pk2(k1[4], k1[5]); hi.w = pk2(k1[6], k1[7]);
    *(LAS u32x4*)(KT + (2 * c2) * ROW72 + tg * 16) = lo; *(LAS u32x4*)(KT + (2 * c2 + 1) * ROW72 + tg * 16) = hi;
    *(LAS f32x2*)(PART + tg * 128 + 2 * c2) = (f32x2){p0, p1};
    fill_vT(C.Z + ZC_MV + h * 256, n, tg, lane, VT);
    if (tid == 0) { C.GG[h * NCH + n] = g; C.FL[h * NCH + n] = Flast; }
    __syncthreads();
    if (tid < 128) { float s = 0.f;
#pragma unroll
        for (int q = 0; q < 8; ++q) s += PART[q * 128 + tid];
        C.DN[(size_t)(h * NCH + n) * 128 + tid] = s; }
    state_mfma(VT, KT, C.DC + (size_t)(h * NCH + n) * 32768, tg, lane);
    __syncthreads();
}

DI void ml_B_unit(const MixCtx& C, LAS unsigned char* lds, int h, int n, int tid) {
    const int lane = tid & 63, w = __builtin_amdgcn_readfirstlane(tid >> 6), tg = w, c2 = lane, fr = lane & 15, fq = lane >> 4;
    LAS float* MF = (LAS float*)(lds + L_MISC); LAS float* MU = MF + 64; LAS float* MM = MF + 128; LAS float* MW = MF + 192;
    LAS float* DENP = MF + 256; LAS float* DQN = MF + 512; LAS float* NPV = MF + 576; LAS float* RS = (LAS float*)(lds + L_MISC + 4096);
    LAS unsigned char* CT = lds + L_ST; LAS unsigned char* VT = lds + L_VT; LAS unsigned char* QL = lds + L_Q; LAS unsigned char* KL = lds + L_K;
    copy_256x128(C.CP + (size_t)(h * NCH + n) * 32768, 128, CT, tid);
    if (w == 0) {
        const size_t ztok = (size_t)(n * CH + lane) * ZW;
        const float li = bf2f(C.Z[ztok + ZC_MI + h]) + C.b_i[h];
        const float lf = log_sigmoid_f(bf2f(C.Z[ztok + ZC_MF + h]) + C.b_f[h]);
        const float F = wave_scan_sum(lf, lane);
        const float u = li - F;
        const float pm = wave_scan_max(u, lane);
        const float mprev = C.MP[h * NCH + n];
        const float m = F + fmaxf(pm, mprev);
        MF[lane] = F; MU[lane] = u; MM[lane] = m; MW[lane] = __expf(F + mprev - m);
    }
    if (w == 1) { NPV[lane] = C.NP[(size_t)(h * NCH + n) * 128 + lane]; NPV[64 + lane] = C.NP[(size_t)(h * NCH + n) * 128 + 64 + lane]; }
    {
        float q0[8], q1[8], k0[8], k1[8];
        conv_silu8(C.Z + ZC_MQK + h * 128 + 2 * c2, C.conv_w + h * 128 + 2 * c2, C.conv_b + h * 128 + 2 * c2, n * CH + 8 * tg, q0, q1);
        conv_silu8(C.Z + ZC_MQK + 512 + h * 128 + 2 * c2, C.conv_w + 512 + h * 128 + 2 * c2, C.conv_b + 512 + h * 128 + 2 * c2, n * CH + 8 * tg, k0, k1);
        const float ks = 0.08838834764831845f;
#pragma unroll
        for (int j = 0; j < 8; ++j) { *(LAS unsigned*)(QL + (8 * tg + j) * ROW136 + 4 * c2) = pk2(q0[j], q1[j]); *(LAS unsigned*)(KL + (8 * tg + j) * ROW136 + 4 * c2) = pk2(k0[j] * ks, k1[j] * ks); }
    }
    fill_vT(C.Z + ZC_MV + h * 256, n, tg, lane, VT);
    __syncthreads();
    f32x4 sacc[2];
    score_mfma(QL, KL, w, lane, sacc);
    {
        const int t = tid >> 3, part = tid & 7; float s = 0.f;
#pragma unroll
        for (int e = 0; e < 8; ++e) { const unsigned qq = *(const LAS unsigned*)(QL + t * ROW136 + (16 * part + 2 * e) * 2); s += bflo(qq) * NPV[16 * part + 2 * e] + bfhi(qq) * NPV[16 * part + 2 * e + 1]; }
        s += shx(s, 1, lane); s += shx(s, 2, lane); s += shx(s, 4, lane);
        if (part == 0) DQN[t] = s;
    }
    __syncthreads();
    { const int mi = w >> 1, ni0 = 2 * (w & 1), t = 16 * mi + fr; const float ft = MF[t] - MM[t];
#pragma unroll
      for (int jn = 0; jn < 2; ++jn) { const int s0 = 16 * (ni0 + jn) + 4 * fq; f32x4 v = sacc[jn]; const f32x4 us = *(const LAS f32x4*)(MU + s0);
          float ps = 0.f;
#pragma unroll
          for (int r = 0; r < 4; ++r) { v[r] = (s0 + r > t) ? 0.f : v[r] * __expf(ft + us[r]); ps += v[r]; }
          ps += shx(ps, 16, lane); ps += shx(ps, 32, lane);
          if (fq == 0) DENP[t * 4 + ni0 + jn] = ps;
          *(LAS u32x2*)(KL + t * ROW72 + s0 * 2) = (u32x2){pk2(v[0], v[1]), pk2(v[2], v[3])}; } }
    __syncthreads();
    const int wr = w >> 1, wc = w & 1, t = 16 * wr + fr;
    f32x4 o1[8], o2[8];
#pragma unroll
    for (int ni = 0; ni < 8; ++ni) { o1[ni] = (f32x4){0.f, 0.f, 0.f, 0.f}; o2[ni] = o1[ni]; }
#pragma unroll
    for (int ks = 0; ks < 2; ++ks) { const bf16x8 a = *(const LAS bf16x8*)(KL + t * ROW72 + (32 * ks + 8 * fq) * 2);
#pragma unroll
        for (int ni = 0; ni < 8; ++ni) { const bf16x8 bb = *(const LAS bf16x8*)(VT + (128 * wc + 16 * ni + fr) * ROW72 + (32 * ks + 8 * fq) * 2); o1[ni] = mfma16(bb, a, o1[ni]); } }
#pragma unroll
    for (int ks = 0; ks < 4; ++ks) { const bf16x8 a = *(const LAS bf16x8*)(QL + t * ROW136 + (32 * ks + 8 * fq) * 2);
#pragma unroll
        for (int ni = 0; ni < 8; ++ni) { const bf16x8 bb = *(const LAS bf16x8*)(CT + (128 * wc + 16 * ni + fr) * ROW136 + (32 * ks + 8 * fq) * 2); o2[ni] = mfma16(bb, a, o2[ni]); } }
    const float wi = MW[t];
    const f32x4 dp = *(const LAS f32x4*)(DENP + t * 4);
    const float den = ((dp[0] + dp[1]) + (dp[2] + dp[3])) + wi * DQN[t];
    const float inv = 1.0f / fmaxf(fabsf(den), __expf(-MM[t]));
    const size_t tok = (size_t)(n * CH + t);
    float ss = 0.f;
#pragma unroll
    for (int ni = 0; ni < 8; ++ni) { const int dv = 128 * wc + 16 * ni + 4 * fq;
        const u32x2 mo = *(const u32x2*)(C.Z + tok * ZW + ZC_MO + h * 256 + dv);
        f32x4 v = (o1[ni] + o2[ni] * wi) * inv;
        v[0] *= sigmoid_f(bflo(mo.x)); v[1] *= sigmoid_f(bfhi(mo.x)); v[2] *= sigmoid_f(bflo(mo.y)); v[3] *= sigmoid_f(bfhi(mo.y));
        o1[ni] = v; ss += (v[0] * v[0] + v[1] * v[1]) + (v[2] * v[2] + v[3] * v[3]); }
    ss += shx(ss, 16, lane); ss += shx(ss, 32, lane);
    if (fq == 0) RS[wc * 64 + t] = ss;
    __syncthreads();
    const float rstd = 1.0f / sqrtf((RS[t] + RS[64 + t]) * (1.0f / 256.0f) + EPS);
#pragma unroll
    for (int ni = 0; ni < 8; ++ni) { const int dv = 128 * wc + 16 * ni + 4 * fq; const f32x4 gn = *(const f32x4*)(C.ml_norm + h * 256 + dv);
        const f32x4 v = o1[ni] * rstd * gn;
        *(u32x2*)(C.OB + tok * OBW + 1024 + h * 256 + dv) = (u32x2){pk2(v[0], v[1]), pk2(v[2], v[3])}; }
    __syncthreads();
}

DI void scan_phase(const MixCtx& C, int tid) {
    const int NS = 2 * 65536;
    for (int slot = opaque_bx() * 512 + tid; slot < NS; slot += opaque_g() * 512) {
        const int br = slot >> 16, s = slot & 65535, h = s >> 14, dv = (s >> 6) & 255, dkp = s & 63;
        const size_t e0 = (size_t)h * NCH * 32768 + (size_t)dv * 128 + 2 * dkp;
        if (br == 0) {
            float s0 = 0.f, s1 = 0.f;
            for (int n0 = 0; n0 < NCH; n0 += 8) {
                f32x2 d[8], dec[8];
#pragma unroll
                for (int u = 0; u < 8; ++u) { d[u] = *(const f32x2*)(C.DS + e0 + (size_t)(n0 + u) * 32768); dec[u] = *(const f32x2*)(C.DECAY + (size_t)(h * NCH + n0 + u) * 128 + 2 * dkp); }
#pragma unroll
                for (int u = 0; u < 8; ++u) { *(unsigned*)(C.SP + e0 + (size_t)(n0 + u) * 32768) = pk2(s0, s1); s0 = dec[u].x * s0 + d[u].x; s1 = dec[u].y * s1 + d[u].y; }
            }
        } else {
            float c0 = 0.f, c1 = 0.f, nn0 = 0.f, nn1 = 0.f, m = -1e30f;
            for (int n0 = 0; n0 < NCH; n0 += 8) {
                f32x2 d[8], dn[8]; float fl[8], gl[8];
#pragma unroll
                for (int u = 0; u < 8; ++u) { d[u] = *(const f32x2*)(C.DC + e0 + (size_t)(n0 + u) * 32768); fl[u] = C.FL[h * NCH + n0 + u]; gl[u] = C.GG[h * NCH + n0 + u];
                    dn[u] = (dv == 0) ? *(const f32x2*)(C.DN + (size_t)(h * NCH + n0 + u) * 128 + 2 * dkp) : (f32x2){0.f, 0.f}; }
#pragma unroll
                for (int u = 0; u < 8; ++u) { *(unsigned*)(C.CP + e0 + (size_t)(n0 + u) * 32768) = pk2(c0, c1);
                    if (dv == 0) { *(f32x2*)(C.NP + (size_t)(h * NCH + n0 + u) * 128 + 2 * dkp) = (f32x2){nn0, nn1}; if (dkp == 0) C.MP[h * NCH + n0 + u] = m; }
                    const float mn = fmaxf(fl[u] + m, gl[u]); const float a = __expf(fl[u] + m - mn), bb = __expf(gl[u] - mn);
                    c0 = a * c0 + bb * d[u].x; c1 = a * c1 + bb * d[u].y; nn0 = a * nn0 + bb * dn[u].x; nn1 = a * nn1 + bb * dn[u].y; m = mn; }
            }
        }
    }
}

DI void mem_unit(const MixCtx& C, LAS unsigned char* lds, int h, int rb, int tid) {
    const int lane = tid & 63, w = __builtin_amdgcn_readfirstlane(tid >> 6), fr = lane & 15, fq = lane >> 4, wr = w >> 1, wc = w & 1, t = 16 * wr + fr;
    LAS unsigned char* QL = lds; LAS unsigned char* PL = lds + 33792; LAS unsigned char* KV = lds + 67584;
    LAS float* RMX = (LAS float*)(lds + L_MISC); LAS float* RSM = RMX + 128;
#pragma unroll
    for (int i = 0; i < 4; ++i) { const int id = tid + 512 * i, row = id >> 5, cc = id & 31;
        *(LAS u32x4*)(QL + row * ROW264 + cc * 16) = *(const u32x4*)(C.Z + (size_t)(rb * 64 + row) * ZW + ZC_XQ + h * 256 + cc * 8); }
    f32x4 s[8];
#pragma unroll
    for (int ni = 0; ni < 8; ++ni) s[ni] = (f32x4){0.f, 0.f, 0.f, 0.f};
#pragma unroll
    for (int half = 0; half < 2; ++half) {
        copy_256x128(C.KM + h * 256 + half * 128, 4096, KV, tid);
        __syncthreads();
#pragma unroll
        for (int ks = 0; ks < 4; ++ks) { const bf16x8 a = *(const LAS bf16x8*)(QL + t * ROW264 + (128 * half + 32 * ks + 8 * fq) * 2);
#pragma unroll
            for (int ni = 0; ni < 8; ++ni) { const bf16x8 bb = *(const LAS bf16x8*)(KV + (128 * wc + 16 * ni + fr) * ROW136 + (32 * ks + 8 * fq) * 2); s[ni] = mfma16(bb, a, s[ni]); } }
        __syncthreads();
    }
    float mx = -3.0e38f;
#pragma unroll
    for (int ni = 0; ni < 8; ++ni) { s[ni] = s[ni] * 0.0625f; mx = fmaxf(mx, fmaxf(fmaxf(s[ni][0], s[ni][1]), fmaxf(s[ni][2], s[ni][3]))); }
    mx = fmaxf(mx, shx(mx, 16, lane)); mx = fmaxf(mx, shx(mx, 32, lane));
    if (fq == 0) RMX[wc * 64 + t] = mx;
    copy_256x128(C.VMT + (size_t)(h * 256) * 256, 256, KV, tid);
    __syncthreads();
    mx = fmaxf(RMX[t], RMX[64 + t]);
    float sm = 0.f;
#pragma unroll
    for (int ni = 0; ni < 8; ++ni) {
#pragma unroll
        for (int r = 0; r < 4; ++r) { s[ni][r] = __expf(s[ni][r] - mx); sm += s[ni][r]; } }
    sm += shx(sm, 16, lane); sm += shx(sm, 32, lane);
    if (fq == 0) RSM[wc * 64 + t] = sm;
    __syncthreads();
    const float inv = 1.0f / (RSM[t] + RSM[64 + t]);
#pragma unroll
    for (int ni = 0; ni < 8; ++ni) { const f32x4 p = s[ni] * inv; *(LAS u32x2*)(PL + t * ROW264 + (128 * wc + 16 * ni + 4 * fq) * 2) = (u32x2){pk2(p[0], p[1]), pk2(p[2], p[3])}; }
    f32x4 o[8];
#pragma unroll
    for (int ni = 0; ni < 8; ++ni) o[ni] = (f32x4){0.f, 0.f, 0.f, 0.f};
#pragma unroll
    for (int half = 0; half < 2; ++half) {
        if (half == 1) copy_256x128(C.VMT + (size_t)(h * 256) * 256 + 128, 256, KV, tid);
        __syncthreads();
#pragma unroll
        for (int ks = 0; ks < 4; ++ks) { const bf16x8 a = *(const LAS bf16x8*)(PL + t * ROW264 + (128 * half + 32 * ks + 8 * fq) * 2);
#pragma unroll
            for (int ni = 0; ni < 8; ++ni) { const bf16x8 bb = *(const LAS bf16x8*)(KV + (128 * wc + 16 * ni + fr) * ROW136 + (32 * ks + 8 * fq) * 2); o[ni] = mfma16(bb, a, o[ni]); } }
        __syncthreads();
    }
    const size_t tok = (size_t)(rb * 64 + t);
#pragma unroll
    for (int ni = 0; ni < 8; ++ni) { const int d = 128 * wc + 16 * ni + 4 * fq; *(u32x2*)(C.OB + tok * OBW + 2048 + h * 256 + d) = (u32x2){pk2(o[ni][0], o[ni][1]), pk2(o[ni][2], o[ni][3])}; }
}

#ifndef GEMM_ALIGN
#define GEMM_ALIGN true
#endif
#ifndef REP_PRO
#define REP_PRO 1
#endif
#ifndef REP_MIXA
#define REP_MIXA 1
#endif
#ifndef REP_SCAN
#define REP_SCAN 1
#endif
#ifndef REP_MIXB
#define REP_MIXB 1
#endif
#ifndef REP_FF1
#define REP_FF1 1
#endif
#ifndef REP_NORM
#define REP_NORM 1
#endif
#ifndef REP_GATE
#define REP_GATE 1
#endif
#ifndef REP_BR
#define REP_BR 1
#endif
#ifndef GEMM_SP2
#define GEMM_SP2 true
#endif
constexpr int L_PTR = L_BARW + 256;
DI unsigned long long tab_ld(LAS unsigned char* lds, int k) {
    const unsigned long long v = *(volatile LAS unsigned long long*)(lds + L_PTR + 8 * k);
    const unsigned lo = __builtin_amdgcn_readfirstlane((unsigned)v), hi = __builtin_amdgcn_readfirstlane((unsigned)(v >> 32));
    return ((unsigned long long)hi << 32) | lo;
}
DI const float* tab_in(LAS unsigned char* lds, int k) { return (const float*)(const GAS float*)tab_ld(lds, k); }
DI unsigned char* tab_ws(LAS unsigned char* lds) { return (unsigned char*)(GAS unsigned char*)tab_ld(lds, 24); }
DI void grid_bar(LAS unsigned char* lds) {
    XcdBarrier b; b.bar = (unsigned*)(tab_ws(lds) + WS_CTL) + CW_BAR; b.x = xb_xcc_id(); b.st = (volatile LAS unsigned*)(lds + L_BARW);
    xcd_barrier(b);
}
DI void make_ctx(MixCtx& C, LAS unsigned char* lds, int l) {
    unsigned char* ws = tab_ws(lds);
    C.Z = (const bf16_t*)(ws + WS_Z); C.OB = (bf16_t*)(ws + WS_OB);
    C.wa = tab_in(lds, I_W_GLA_A) + (size_t)l * 16 * 512; C.ba = tab_in(lds, I_B_GLA_A) + l * 512; C.gla_norm = tab_in(lds, I_GLA_NORM) + l * 1024;
    C.conv_w = tab_in(lds, I_CONV_W) + (size_t)l * 4 * 1024; C.conv_b = tab_in(lds, I_CONV_B) + l * 1024; C.b_i = tab_in(lds, I_B_ML_I) + l * 4; C.b_f = tab_in(lds, I_B_ML_F) + l * 4; C.ml_norm = tab_in(lds, I_ML_NORM) + l * 1024;
    C.DS = (float*)(ws + WS_DS); C.DC = (float*)(ws + WS_DC); C.SP = (bf16_t*)(ws + WS_SP); C.CP = (bf16_t*)(ws + WS_CP);
    C.DECAY = (float*)(ws + WS_SMALL + SM_DECAY); C.DN = (float*)(ws + WS_SMALL + SM_DN); C.NP = (float*)(ws + WS_SMALL + SM_NP);
    C.GG = (float*)(ws + WS_SMALL + SM_GG); C.FL = (float*)(ws + WS_SMALL + SM_FL); C.MP = (float*)(ws + WS_SMALL + SM_MP);
    C.KM = (const bf16_t*)(ws + WS_KM) + l * 1024; C.VMT = (const bf16_t*)(ws + WS_VMT) + (size_t)l * 1024 * 256;
}

__global__ void __launch_bounds__(512, 2) trunk_fwd(Params p) {
    extern __shared__ __attribute__((aligned(16))) unsigned char lds_raw[];
    LAS unsigned char* lds0 = (LAS unsigned char*)lds_raw;
    {
        LAS unsigned char* lds = lds0;
        const int tid0 = threadIdx.x;
        if (tid0 < 64) ((LAS unsigned*)(lds + L_BARW))[tid0] = 0u;
        if (tid0 < 23) *(LAS unsigned long long*)(lds + L_PTR + 8 * tid0) = (unsigned long long)p.in[tid0];
        if (tid0 == 23) *(LAS unsigned long long*)(lds + L_PTR + 8 * 23) = (unsigned long long)p.out;
        if (tid0 == 24) *(LAS unsigned long long*)(lds + L_PTR + 8 * 24) = (unsigned long long)p.ws;
        __syncthreads();
        (void)xcd_barrier_post((unsigned*)(p.ws + WS_CTL) + CW_BAR, (volatile LAS unsigned*)(lds + L_BARW));
    }
#define TID (opaque_tid())
#define LANE (opaque_tid() & 63)
#define WAVE (__builtin_amdgcn_readfirstlane(opaque_tid() >> 6))
#define GW (opaque_bx() * NWAVES + WAVE)
#define NGW (opaque_g() * NWAVES)

    for (int rep = 0; rep < REP_PRO; ++rep) {
        LAS unsigned char* lds = opaque_lds(lds0); unsigned char* ws = tab_ws(lds);
        bf16_t* WIN = (bf16_t*)(ws + WS_WIN);
        const int lane = LANE, wave = WAVE;
        LAS float* scr = (LAS float*)(lds + wave * 16640);
        constexpr int IT_IN = 64 * 117, IT_BR = 16 * 64, IT_G = 4 * 64, IT_OUT = 64 * 64, IT_F1 = 64 * 256, IT_F2 = 256 * 64, IT_MK = 64 * 16;
        constexpr int E_IN = 4 * IT_IN, E_BR = E_IN + 12 * IT_BR, E_G = E_BR + 12 * IT_G, E_OUT = E_G + 4 * IT_OUT, E_F1 = E_OUT + 4 * IT_F1, E_F2 = E_F1 + 4 * IT_F2, E_MK = E_F2 + 4 * IT_MK, E_MV = E_MK + 4 * IT_MK;
        for (int it = GW; it < E_MV; it += NGW) {
            if (it < E_IN) { const int l = it / IT_IN, r = it - l * IT_IN; transpose_item(tab_in(lds, I_W_IN) + (size_t)l * DM * IN_W, DM, IN_W, WIN + (size_t)l * ZW * DM, DM, 0, 0, true, scr, r, lane, tab_in(lds, I_NORM_MIX) + l * DM); }
            else if (it < E_BR) { const int q = it - E_IN, lj = q / IT_BR, r = q - lj * IT_BR, l = lj / 3, j = lj - 3 * l; transpose_item(tab_in(lds, I_W_BRANCH) + (size_t)lj * 1024 * DM, 1024, DM, (bf16_t*)(ws + WS_WBR) + (size_t)l * DM * OBW, OBW, j * 1024, 0, false, scr, r, lane); }
            else if (it < E_G) { const int q = it - E_BR, lj = q / IT_G, r = q - lj * IT_G, l = lj / 3, j = lj - 3 * l; transpose_item(tab_in(lds, I_W_GATE) + (size_t)lj * 256 * DM, 256, DM, (bf16_t*)(ws + WS_WG) + (size_t)l * GTW * 256, 256, 0, j * DM, false, scr, r, lane); }
            else if (it < E_OUT) { const int q = it - E_G, l = q / IT_OUT, r = q - l * IT_OUT; transpose_item(tab_in(lds, I_W_OUT) + (size_t)l * DM * DM, DM, DM, (bf16_t*)(ws + WS_WOUT) + (size_t)l * DM * DM, DM, 0, 0, false, scr, r, lane); }
            else if (it < E_F1) { const int q = it - E_OUT, l = q / IT_F1, r = q - l * IT_F1; transpose_item(tab_in(lds, I_W_FF1) + (size_t)l * DM * DFF, DM, DFF, (bf16_t*)(ws + WS_W1) + (size_t)l * DFF * DM, DM, 0, 0, false, scr, r, lane, tab_in(lds, I_NORM_FFN) + l * DM); }
            else if (it < E_F2) { const int q = it - E_F1, l = q / IT_F2, r = q - l * IT_F2; transpose_item(tab_in(lds, I_W_FF2) + (size_t)l * DFF * DM, DFF, DM, (bf16_t*)(ws + WS_W2) + (size_t)l * DM * DFF, DFF, 0, 0, false, scr, r, lane); }
            else if (it < E_MK) { const int q = it - E_F2, l = q / IT_MK, r = q - l * IT_MK; transpose_item(tab_in(lds, I_W_MEM_K) + (size_t)l * DM * 1024, DM, 1024, (bf16_t*)(ws + WS_WMK), DM, 0, l * 1024, false, scr, r, lane); }
            else { const int q = it - E_MK, l = q / IT_MK, r = q - l * IT_MK; transpose_item(tab_in(lds, I_W_MEM_V) + (size_t)l * DM * 1024, DM, 1024, (bf16_t*)(ws + WS_WMV), DM, 0, l * 1024, false, scr, r, lane); }
        }
        constexpr int PADCH = (ZW - IN_W) * DM / 8;
        for (int i = opaque_bx() * 512 + TID; i < NL * PADCH; i += opaque_g() * 512) { const int l = i / PADCH, r = i - l * PADCH; *(u32x4*)(WIN + (size_t)l * ZW * DM + (size_t)IN_W * DM + (size_t)r * 8) = (u32x4){0u, 0u, 0u, 0u}; }
        for (int m = GW; m < SEQ; m += NGW) row_bf16_ss(tab_in(lds, I_X) + (size_t)m * DM, (bf16_t*)(ws + WS_H) + (size_t)m * DM, (u64_t*)(ws + WS_SS) + m, lane);
        for (int m = GW; m < MEML; m += NGW) rmsnorm_row<false>(tab_in(lds, I_MEM) + (size_t)m * DM, tab_in(lds, I_MEM_NORM), (bf16_t*)(ws + WS_MEMN) + (size_t)m * DM, lane);
    }
    grid_bar(opaque_lds(lds0));
    {
        LAS unsigned char* lds = opaque_lds(lds0); unsigned char* ws = tab_ws(lds);
        { pg8::Gemm g{(const bf16_t*)(ws + WS_MEMN), (const bf16_t*)(ws + WS_WMK), opq(MEML), opq(DM), opq(DM), opq(DM), opq(DM)}; pg8::StaticOrder S; S.init(opq(MEML), opq(DM), opaque_g(), opaque_bx()); pg8::EpiBf16<0> E{(bf16_t*)(ws + WS_KM), DM, nullptr, nullptr};
          pg8::gemm_phase<pg8::EpiBf16<0>, pg8::StaticOrder, GEMM_ALIGN, GEMM_SP2>(lds, g, S, E); }
    }
    {
        LAS unsigned char* lds = opaque_lds(lds0); unsigned char* ws = tab_ws(lds);
        { pg8::Gemm g{(const bf16_t*)(ws + WS_WMV), (const bf16_t*)(ws + WS_MEMN), opq(DM), opq(MEML), opq(DM), opq(DM), opq(DM)}; pg8::StaticOrder S; S.init(opq(DM), opq(MEML), opaque_g(), (opaque_bx() + 16) % opaque_g()); pg8::EpiBf16<0> E{(bf16_t*)(ws + WS_VMT), MEML, nullptr, nullptr};
          pg8::gemm_phase<pg8::EpiBf16<0>, pg8::StaticOrder, GEMM_ALIGN, GEMM_SP2>(lds, g, S, E); }
    }
    grid_bar(opaque_lds(lds0));

    for (int l = 0; l < NL; ++l) {
        {
            LAS unsigned char* lds = opaque_lds(lds0); unsigned char* ws = tab_ws(lds);
            pg8::Gemm g{(const bf16_t*)(ws + WS_H), (const bf16_t*)(ws + WS_WIN) + (size_t)l * ZW * DM, opq(SEQ), opq(ZW), opq(DM), opq(DM), opq(DM)}; pg8::StaticOrder S; S.init(opq(SEQ), opq(ZW), opaque_g(), opaque_bx()); pg8::EpiBf16<0> E{(bf16_t*)(ws + WS_Z), ZW, nullptr, (const u64_t*)(ws + WS_SS) + (size_t)(2 * l) * SEQ};
            pg8::gemm_phase<pg8::EpiBf16<0>, pg8::StaticOrder, GEMM_ALIGN, GEMM_SP2>(lds, g, S, E);
        }
        grid_bar(opaque_lds(lds0));
        {
            LAS unsigned char* lds = opaque_lds(lds0); MixCtx C; make_ctx(C, lds, l); const int tid = TID;
            for (int rep = 0; rep < REP_MIXA; ++rep) {
            for (int i = opaque_bx(); i < 4 * NCH; i += opaque_g()) gla_A_unit(C, lds, i >> 8, i & 255, tid);
            for (int i = opaque_bx(); i < 4 * NCH; i += opaque_g()) ml_A_unit(C, lds, i >> 8, i & 255, tid);
            for (int i = opaque_bx(); i < 4 * NCH; i += opaque_g()) mem_unit(C, lds, i >> 8, i & 255, tid);
            }
        }
        for (int rep = 0; rep < REP_GATE; ++rep) {
            LAS unsigned char* lds = opaque_lds(lds0); unsigned char* ws = tab_ws(lds);
            pg8::Gemm g{(const bf16_t*)(ws + WS_Z) + ZC_GATE, (const bf16_t*)(ws + WS_WG) + (size_t)l * GTW * 256, opq(SEQ), opq(GTW), opq(256), opq(ZW), opq(256)}; pg8::StaticOrder S; S.init(opq(SEQ), opq(GTW), opaque_g(), opaque_bx());
            pg8::EpiBf16<2> E{(bf16_t*)(ws + WS_GT), GTW, tab_in(lds, I_B_GATE) + (size_t)l * GTW, nullptr};
            pg8::gemm_phase<pg8::EpiBf16<2>, pg8::StaticOrder, GEMM_ALIGN, GEMM_SP2>(lds, g, S, E);
        }
        grid_bar(opaque_lds(lds0));
        { LAS unsigned char* lds = opaque_lds(lds0); MixCtx C; make_ctx(C, lds, l); for (int rep = 0; rep < REP_SCAN; ++rep) scan_phase(C, TID); }
        grid_bar(opaque_lds(lds0));
        {
            LAS unsigned char* lds = opaque_lds(lds0); MixCtx C; make_ctx(C, lds, l); const int tid = TID;
            for (int rep = 0; rep < REP_MIXB; ++rep) {
            for (int i = opaque_bx(); i < 4 * NCH; i += opaque_g()) gla_B_unit(C, lds, i >> 8, i & 255, tid);
            for (int i = opaque_bx(); i < 4 * NCH; i += opaque_g()) ml_B_unit(C, lds, i >> 8, i & 255, tid);
            }
        }
        grid_bar(opaque_lds(lds0));
        for (int rep = 0; rep < REP_BR; ++rep) {
            LAS unsigned char* lds = opaque_lds(lds0); unsigned char* ws = tab_ws(lds);
            pg8::Gemm g{(const bf16_t*)(ws + WS_OB), (const bf16_t*)(ws + WS_WBR) + (size_t)l * DM * OBW, opq(SEQ), opq(DM), opq(OBW), opq(OBW), opq(OBW)}; pg8::StaticOrder S; S.init(opq(SEQ), opq(DM), opaque_g(), opaque_bx()); pg8::EpiBranch E{(bf16_t*)(ws + WS_Y), DM, (const bf16_t*)(ws + WS_GT)};
            pg8::gemm_phase<pg8::EpiBranch, pg8::StaticOrder, GEMM_ALIGN, GEMM_SP2>(lds, g, S, E);
        }
        grid_bar(opaque_lds(lds0));
        {
            LAS unsigned char* lds = opaque_lds(lds0); unsigned char* ws = tab_ws(lds);
            const float* Xin = (l == 0) ? tab_in(lds, I_X) : (const float*)(ws + WS_X);
            pg8::Gemm g{(const bf16_t*)(ws + WS_Y), (const bf16_t*)(ws + WS_WOUT) + (size_t)l * DM * DM, opq(SEQ), opq(DM), opq(DM), opq(DM), opq(DM)}; pg8::StaticOrder S; S.init(opq(SEQ), opq(DM), opaque_g(), opaque_bx()); pg8::EpiResid E{Xin, (float*)(ws + WS_X), DM, (bf16_t*)(ws + WS_H), (u64_t*)(ws + WS_SS) + (size_t)(2 * l + 1) * SEQ};
            pg8::gemm_phase<pg8::EpiResid, pg8::StaticOrder, GEMM_ALIGN, GEMM_SP2>(lds, g, S, E);
        }
        grid_bar(opaque_lds(lds0));
        for (int rep = 0; rep < REP_FF1; ++rep) {
            LAS unsigned char* lds = opaque_lds(lds0); unsigned char* ws = tab_ws(lds);
            pg8::Gemm g{(const bf16_t*)(ws + WS_H), (const bf16_t*)(ws + WS_W1) + (size_t)l * DFF * DM, opq(SEQ), opq(DFF), opq(DM), opq(DM), opq(DM)}; pg8::StaticOrder S; S.init(opq(SEQ), opq(DFF), opaque_g(), opaque_bx()); pg8::EpiBf16<1> E{(bf16_t*)(ws + WS_U), DFF, nullptr, (const u64_t*)(ws + WS_SS) + (size_t)(2 * l + 1) * SEQ};
            pg8::gemm_phase<pg8::EpiBf16<1>, pg8::StaticOrder, GEMM_ALIGN, GEMM_SP2>(lds, g, S, E);
        }
        grid_bar(opaque_lds(lds0));
        {
            LAS unsigned char* lds = opaque_lds(lds0); unsigned char* ws = tab_ws(lds);
            pg8::Gemm g{(const bf16_t*)(ws + WS_U), (const bf16_t*)(ws + WS_W2) + (size_t)l * DM * DFF, opq(SEQ), opq(DM), opq(DFF), opq(DFF), opq(DFF)}; pg8::StaticOrder S; S.init(opq(SEQ), opq(DM), opaque_g(), opaque_bx()); pg8::EpiResid E{(const float*)(ws + WS_X), (float*)(ws + WS_X), DM, (bf16_t*)(ws + WS_H), (u64_t*)(ws + WS_SS) + (size_t)(2 * l + 2) * SEQ};
            pg8::gemm_phase<pg8::EpiResid, pg8::StaticOrder, GEMM_ALIGN, GEMM_SP2>(lds, g, S, E);
        }
        grid_bar(opaque_lds(lds0));
    }
    {
        LAS unsigned char* lds = opaque_lds(lds0); unsigned char* ws = tab_ws(lds);
        const float* X = (const float*)(ws + WS_X); const float* gain = tab_in(lds, I_FINAL_NORM); float* out = (float*)(GAS float*)tab_ld(lds, 23); const int lane = LANE;
        const u64_t* ssf = (const u64_t*)(ws + WS_SS) + (size_t)8 * SEQ;
        for (int m = GW; m < SEQ; m += NGW) row_scale_f32(X + (size_t)m * DM, gain, ss_to_f(ssf[m]), out + (size_t)m * DM, lane);
    }
}

extern "C" void kernel_launch(void* const* d_in, const int* in_sizes, int n_in, void* d_out, int out_size, void* d_ws, size_t ws_size, hipStream_t stream) {
    static int grid = 0;
    if (grid == 0) {
        if (n_in != 23 || out_size != SEQ * DM || ws_size < WS_END) { fprintf(stderr, "kernel_launch: unexpected shapes (n_in %d out %d ws %zu, need %zu)\n", n_in, out_size, ws_size, (size_t)WS_END); grid = -1; return; }
        int dev = 0, cus = 0, per_cu = 0;
        if (hipGetDevice(&dev) != hipSuccess || hipDeviceGetAttribute(&cus, hipDeviceAttributeMultiprocessorCount, dev) != hipSuccess) { grid = -1; return; }
        if (hipFuncSetAttribute((const void*)trunk_fwd, hipFuncAttributeMaxDynamicSharedMemorySize, LDS_BYTES) != hipSuccess) { fprintf(stderr, "kernel_launch: hipFuncSetAttribute failed\n"); grid = -1; return; }
        if (hipOccupancyMaxActiveBlocksPerMultiprocessor(&per_cu, (const void*)trunk_fwd, 512, LDS_BYTES) != hipSuccess || per_cu < 1) { fprintf(stderr, "kernel_launch: occupancy query says %d\n", per_cu); (void)hipGetLastError(); }
        grid = cus;
    }
    if (grid < 0) return;
    if (hipMemsetAsync((char*)d_ws + WS_CTL, 0, CTL_ZERO_BYTES, stream) != hipSuccess) return;
    if (hipMemsetAsync((char*)d_ws + WS_SS, 0, SS_ZERO_BYTES, stream) != hipSuccess) return;
    Params p{};
    for (int i = 0; i < 23; ++i) p.in[i] = (const float*)d_in[i];
    p.out = (float*)d_out; p.ws = (unsigned char*)d_ws;
    hipLaunchKernelGGL(trunk_fwd, dim3(grid), dim3(512), LDS_BYTES, stream, p);
}
```

```cpp
#include <hip/hip_runtime.h>
#include <cstdio>
#include <cstdint>

#define DI __device__ __forceinline__
#define GAS __attribute__((address_space(1)))
#define LAS __attribute__((address_space(3)))
typedef unsigned short bf16_t;
typedef short bf16x8 __attribute__((ext_vector_type(8)));
typedef float f32x4 __attribute__((ext_vector_type(4)));
typedef float f32x2 __attribute__((ext_vector_type(2)));
typedef unsigned u32x4 __attribute__((ext_vector_type(4)));
typedef unsigned u32x2 __attribute__((ext_vector_type(2)));

constexpr int SEQ = 16384, DM = 4096, DFF = 16384, NL = 4, MEML = 256, CH = 64, NCH = SEQ / CH;
constexpr int IN_W = 7448, ZW = 7680;
constexpr int ZC_GQ = 0, ZC_GK = 512, ZC_GV = 1024, ZC_GG = 2048, ZC_MQK = 3072, ZC_MV = 4096, ZC_MO = 5120, ZC_XQ = 6144, ZC_GATE = 7168, ZC_GA = 7424, ZC_MI = 7440, ZC_MF = 7444;
constexpr int OBW = 3840, OB_O = 768;
constexpr int GTW = 12288;
constexpr float EPS = 1e-6f;

constexpr size_t MiB = 1u << 20;
constexpr size_t WS_CTL = 0, CTL_ZERO_BYTES = 1 * MiB;
constexpr size_t WS_WIN = 1 * MiB, WS_WBR = 241 * MiB, WS_WG = 337 * MiB, WS_WOUT = 361 * MiB, WS_W1 = 489 * MiB, WS_W2 = 1001 * MiB;
constexpr size_t WS_WMK = 1513 * MiB, WS_WMV = 1545 * MiB, WS_MEMN = 1577 * MiB, WS_KM = 1579 * MiB, WS_VMT = 1581 * MiB;
constexpr size_t WS_X = 1583 * MiB, WS_H = 1839 * MiB, WS_Z = 1967 * MiB, WS_GT = 2207 * MiB, WS_U = WS_Z  ;
constexpr size_t WS_OB = 2591 * MiB, WS_Y = 2711 * MiB, WS_DS = 2839 * MiB, WS_SP = 2967 * MiB, WS_DC = 3031 * MiB, WS_CP = 3159 * MiB;
constexpr size_t WS_SMALL = 3223 * MiB, WS_SS = 3225 * MiB, SS_ZERO_BYTES = 2 * MiB, WS_BG = 3227 * MiB, WS_END = 3259 * MiB;
static_assert(WS_OB + (size_t)SEQ * OBW * 2 <= WS_Y, "OB size");
constexpr size_t SM_DECAY = 0, SM_DN = 512 * 1024, SM_NP = 1024 * 1024, SM_GG = 1536 * 1024, SM_FL = 1536 * 1024 + 4096, SM_MP = 1536 * 1024 + 8192;
static_assert(WS_U + (size_t)SEQ * DFF * 2 <= WS_OB, "U overlay");
constexpr int CW_BAR = 4096;
static_assert(9 * (size_t)SEQ * 8 <= SS_ZERO_BYTES, "SS region");
typedef unsigned long long u64_t;
DI float ss_to_f(u64_t v) { return (float)v * (1.0f / 16777216.0f); }

constexpr int LDS_BYTES = 147456;
constexpr int L_ST = 0, L_VT = 69632, L_Q = 106496, L_K = 123904, L_MISC = 141312, L_BARW = 146432;
constexpr int ROW72 = 144, ROW136 = 272, ROW264 = 528;
constexpr int NWAVES = 8;

DI float bf2f(unsigned v) { return __uint_as_float(v << 16); }
DI float bflo(unsigned w) { return __uint_as_float(w << 16); }
DI float bfhi(unsigned w) { return __uint_as_float(w & 0xffff0000u); }
typedef __bf16 bf16x2_t __attribute__((ext_vector_type(2)));
DI unsigned pk2(float lo, float hi) { const f32x2 v = {lo, hi}; const bf16x2_t b = __builtin_convertvector(v, bf16x2_t); return __builtin_bit_cast(unsigned, b); }
DI float sigmoid_f(float x) { return __builtin_amdgcn_rcpf(1.0f + __expf(-x)); }
DI float silu_f(float x) { return x * sigmoid_f(x); }
DI float log_sigmoid_f(float x) { return fminf(x, 0.f) - __logf(1.0f + __expf(-fabsf(x))); }
DI float shx(float v, int o, int lane) { return __int_as_float(__builtin_amdgcn_ds_bpermute((lane ^ o) << 2, __float_as_int(v))); }
DI float shi(float v, int src) { return __int_as_float(__builtin_amdgcn_ds_bpermute(src << 2, __float_as_int(v))); }
DI float wave_sum(float v, int lane) {
#pragma unroll
    for (int o = 1; o < 64; o <<= 1) v += shx(v, o, lane);
    return v;
}
DI float wave_max(float v, int lane) {
#pragma unroll
    for (int o = 1; o < 64; o <<= 1) v = fmaxf(v, shx(v, o, lane));
    return v;
}
DI float wave_scan_sum(float v, int lane) {
#pragma unroll
    for (int o = 1; o < 64; o <<= 1) { const float t = shi(v, lane >= o ? lane - o : lane); if (lane >= o) v += t; }
    return v;
}
DI float wave_scan_max(float v, int lane) {
#pragma unroll
    for (int o = 1; o < 64; o <<= 1) { const float t = shi(v, lane >= o ? lane - o : lane); if (lane >= o) v = fmaxf(v, t); }
    return v;
}
DI f32x4 mfma16(bf16x8 a, bf16x8 b, f32x4 c) { return __builtin_amdgcn_mfma_f32_16x16x32_bf16(a, b, c, 0, 0, 0); }
DI int opaque_tid() { int t = (int)threadIdx.x; asm volatile("" : "+v"(t)); return t; }
DI int opaque_bx() { int b = (int)blockIdx.x; asm volatile("" : "+s"(b)); return b; }
DI LAS unsigned char* opaque_lds(LAS unsigned char* p) { asm volatile("" : "+s"(p)); return p; }
DI int opq(int v) { asm volatile("" : "+s"(v)); return v; }
DI int opaque_g() { int g = (int)gridDim.x; asm volatile("" : "+s"(g)); return g; }

namespace pg8 {
#define PG8_LAS __attribute__((address_space(3)))
constexpr int BM = 256, BK = 64, HALF = 128, HTB = HALF * BK * 2  , STAGE_BYTES = 8 * HTB, NXCD = 8, WGM = 8;

__host__ __device__ __forceinline__ int lds_byte(int r, int c) { const int st = (r >> 4) * 2 + (c >> 5), rr = r & 15, cc = c & 31, ob = rr * 64 + cc * 2; return st * 1024 + (ob ^ (((ob >> 9) & 1) << 5)); }
__host__ __device__ __forceinline__ void stage_rc(int b, int& R, int& C) { const int st = b / 1024, sb = b % 1024, swz = sb ^ (((sb >> 9) & 1) << 5); R = (st >> 1) * 16 + swz / 64; C = (st & 1) * 32 + (swz % 64) / 2; }
__host__ __device__ __forceinline__ int perm32(int rho) { const int n = rho >> 4, i = rho & 15; return 8 * (i >> 2) + 4 * n + (i & 3); }

struct Unit { int pm, pn, kind; };
struct Gemm { const bf16_t* A; const bf16_t* Bt; int M, N, K, lda, ldb; };

struct StaticOrder {
    int nM, nN, nwg, G, c;
    __host__ __device__ void init(int M, int N, int G_, int c_) { nM = M / BM; nN = N / BM; nwg = nM * nN; G = G_; c = c_; }
    __host__ __device__ bool next(int i, Unit& u) const {
        const long L = (long)i * G + c; if (L >= nwg) return false;
        int wgid = (int)L; { const int q = nwg / NXCD, r = nwg % NXCD, xcd = wgid % NXCD, off = wgid / NXCD; wgid = (xcd < r ? xcd * (q + 1) : r * (q + 1) + (xcd - r) * q) + off; }
        const int nig = WGM * nN, gid = wgid / nig, fm = gid * WGM, gsz = (nM - fm) < WGM ? (nM - fm) : WGM;
        u.pm = fm + ((wgid % nig) % gsz); u.pn = (wgid % nig) / gsz; u.kind = 0; return true;
    }
    __device__ __forceinline__ void a_ready(const Unit&) const {}
    __device__ __forceinline__ void done(const Unit&) const {}
    __device__ __forceinline__ int nt(const Unit&, int nt_default) const { return nt_default; }
    __device__ __forceinline__ int koff(const Unit&) const { return 0; }
};
struct BranchOrder : StaticOrder {
    __host__ __device__ bool next(int i, Unit& u) const { if (!StaticOrder::next(i >> 2, u)) return false; u.kind = i & 3; return true; }
    __device__ __forceinline__ int nt(const Unit& u, int) const { return u.kind < 3 ? 4 : 48; }
    __device__ __forceinline__ int koff(const Unit& u) const { return u.kind < 3 ? 256 * u.kind : 768; }
};

template <int ACT  > struct EpiBf16 {
    static constexpr bool PERM = true, AFTER_DRAIN = false, HOOK = false;
    bf16_t* O; int ldc; const float* bias; const unsigned long long* ss; bf16_t* O2; int ld2, pn2;
    __device__ __forceinline__ void operator()(const f32x4 (&acc)[2][2][4][2], const Unit& u, int wr, int wc, int fr, int fq) const {
        const int row0 = u.pm * BM + wr * 64 + fr, col0 = u.pn * BM + wc * 32 + 8 * fq;
        f32x4 bv[2][2];
#pragma unroll
        for (int bj = 0; bj < 2; ++bj)
#pragma unroll
            for (int n = 0; n < 2; ++n) bv[bj][n] = (ACT == 2) ? *(const f32x4*)(bias + col0 + bj * HALF + 4 * n) : (f32x4){0.f, 0.f, 0.f, 0.f};
#pragma unroll
        for (int ai = 0; ai < 2; ++ai)
#pragma unroll
            for (int m = 0; m < 4; ++m) { bf16_t* rowp = O + (size_t)(row0 + ai * HALF + m * 16) * ldc + col0;
                const bool redir = (ACT == 0) && O2 != nullptr && u.pn == pn2;
                if (redir) rowp = O2 + (size_t)(row0 + ai * HALF + m * 16) * ld2 + (col0 - u.pn * BM);
                float rs = 1.f; if (ACT != 2) { if (ss) rs = 1.0f / sqrtf((float)ss[row0 + ai * HALF + m * 16] * (1.0f / 16777216.0f) * (1.0f / DM) + EPS); }
#pragma unroll
                for (int bj = 0; bj < 2; ++bj) { f32x4 v0 = acc[ai][bj][m][0], v1 = acc[ai][bj][m][1];
                    if (ACT != 2) { v0 = v0 * rs; v1 = v1 * rs; }
                    if (ACT == 1) {
#pragma unroll
                        for (int j = 0; j < 4; ++j) { const float a = fmaxf(v0[j], 0.f), b = fmaxf(v1[j], 0.f); v0[j] = a * a; v1[j] = b * b; } }
                    if (ACT == 2) { v0 = v0 + bv[bj][0]; v1 = v1 + bv[bj][1];
#pragma unroll
                        for (int j = 0; j < 4; ++j) { v0[j] = sigmoid_f(fminf(fmaxf(v0[j], -30.f), 30.f)); v1[j] = sigmoid_f(fminf(fmaxf(v1[j], -30.f), 30.f)); } }
                    u32x4 w; w.x = pk2(v0[0], v0[1]); w.y = pk2(v0[2], v0[3]); w.z = pk2(v1[0], v1[1]); w.w = pk2(v1[2], v1[3]);
                    *(u32x4*)(rowp + bj * HALF) = w;
                    if (redir) { *(u32x4*)(rowp + bj * HALF + 256) = w; *(u32x4*)(rowp + bj * HALF + 512) = w; } } }
    }
    __device__ __forceinline__ bool hook_at(const Unit&, int) const { return false; }
    __device__ __forceinline__ void hook(f32x4 (&)[2][2][4][2], const Unit&, int, int, int, int, int) const {}
};
struct EpiResid {
    static constexpr bool PERM = true, AFTER_DRAIN = false, HOOK = false;
    const float* in; float* out; int ldc; bf16_t* xb; unsigned long long* ss;
    __device__ __forceinline__ void operator()(const f32x4 (&acc)[2][2][4][2], const Unit& u, int wr, int wc, int fr, int fq) const {
        const int row0 = u.pm * BM + wr * 64 + fr, col0 = u.pn * BM + wc * 32 + 8 * fq, lane = fq * 16 + fr;
#pragma unroll
        for (int ai = 0; ai < 2; ++ai) {
            f32x4 r[4][2][2];
#pragma unroll
            for (int m = 0; m < 4; ++m) { const size_t off = (size_t)(row0 + ai * HALF + m * 16) * ldc + col0;
#pragma unroll
                for (int bj = 0; bj < 2; ++bj)
#pragma unroll
                    for (int n = 0; n < 2; ++n) r[m][bj][n] = *(const f32x4*)(in + off + bj * HALF + n * 4); }
#pragma unroll
            for (int m = 0; m < 4; ++m) { const int row = row0 + ai * HALF + m * 16; const size_t off = (size_t)row * ldc + col0;
                float sq = 0.f;
#pragma unroll
                for (int bj = 0; bj < 2; ++bj) { const f32x4 o0 = r[m][bj][0] + acc[ai][bj][m][0], o1 = r[m][bj][1] + acc[ai][bj][m][1];
                    *(f32x4*)(out + off + bj * HALF) = o0; *(f32x4*)(out + off + bj * HALF + 4) = o1;
                    sq += (o0[0] * o0[0] + o0[1] * o0[1]) + (o0[2] * o0[2] + o0[3] * o0[3]) + (o1[0] * o1[0] + o1[1] * o1[1]) + (o1[2] * o1[2] + o1[3] * o1[3]);
                    u32x4 w; w.x = pk2(o0[0], o0[1]); w.y = pk2(o0[2], o0[3]); w.z = pk2(o1[0], o1[1]); w.w = pk2(o1[2], o1[3]);
                    *(u32x4*)(xb + off + bj * HALF) = w; }
                sq += shx(sq, 16, lane); sq += shx(sq, 32, lane);
                if (fq == 0) (void)__hip_atomic_fetch_add(ss + row, (unsigned long long)(sq * 16777216.0f), __ATOMIC_RELAXED, __HIP_MEMORY_SCOPE_AGENT); }
            asm volatile("" ::: "memory"); }
    }
    __device__ __forceinline__ bool hook_at(const Unit&, int) const { return false; }
    __device__ __forceinline__ void hook(f32x4 (&)[2][2][4][2], const Unit&, int, int, int, int, int) const {}
};
struct EpiBranch {
    static constexpr bool PERM = true, AFTER_DRAIN = false, HOOK = true;
    bf16_t* O; int ldc; bf16_t* GT; const float* bias;
    __device__ __forceinline__ bool hook_at(const Unit& u, int t) const { return u.kind == 3 && (t == 16 || t == 32); }
    __device__ __forceinline__ void hook(f32x4 (&acc)[2][2][4][2], const Unit& u, int t, int, int, int, int) const {
        const int tid_ = opaque_tid(), wid_ = tid_ >> 6, wr = wid_ >> 2, wc = wid_ & 3, fr = tid_ & 15, fq = (tid_ >> 4) & 3;
        const int row0 = u.pm * BM + wr * 64 + fr, col0 = u.pn * BM + wc * 32 + 8 * fq;
        const bf16_t* ga = GT + (size_t)(t == 16 ? 0 : DM); const bf16_t* gb = ga + DM;
#pragma unroll
        for (int ai = 0; ai < 2; ++ai) {
            u32x4 a[4][2], b[4][2];
#pragma unroll
            for (int m = 0; m < 4; ++m) { const size_t off = (size_t)(row0 + ai * HALF + m * 16) * GTW + col0;
#pragma unroll
                for (int bj = 0; bj < 2; ++bj) { a[m][bj] = *(const u32x4*)(ga + off + bj * HALF); b[m][bj] = *(const u32x4*)(gb + off + bj * HALF); } }
#pragma unroll
            for (int m = 0; m < 4; ++m)
#pragma unroll
                for (int bj = 0; bj < 2; ++bj) { const u32x4 x = a[m][bj], y = b[m][bj];
                    f32x4 r0, r1;
                    r0[0] = bflo(y.x) * __builtin_amdgcn_rcpf(bflo(x.x)); r0[1] = bfhi(y.x) * __builtin_amdgcn_rcpf(bfhi(x.x));
                    r0[2] = bflo(y.y) * __builtin_amdgcn_rcpf(bflo(x.y)); r0[3] = bfhi(y.y) * __builtin_amdgcn_rcpf(bfhi(x.y));
                    r1[0] = bflo(y.z) * __builtin_amdgcn_rcpf(bflo(x.z)); r1[1] = bfhi(y.z) * __builtin_amdgcn_rcpf(bfhi(x.z));
                    r1[2] = bflo(y.w) * __builtin_amdgcn_rcpf(bflo(x.w)); r1[3] = bfhi(y.w) * __builtin_amdgcn_rcpf(bfhi(x.w));
                    acc[ai][bj][m][0] = acc[ai][bj][m][0] * r0; acc[ai][bj][m][1] = acc[ai][bj][m][1] * r1; }
            asm volatile("" ::: "memory"); }
    }
    __device__ __forceinline__ void operator()(const f32x4 (&acc)[2][2][4][2], const Unit& u, int wr, int wc, int fr, int fq) const {
        const int row0 = u.pm * BM + wr * 64 + fr, col0 = u.pn * BM + wc * 32 + 8 * fq;
        if (u.kind < 3) {
            bf16_t* gd = GT + (size_t)u.kind * DM; const float* bj_ = bias + (size_t)u.kind * DM + col0;
            f32x4 bv[2][2];
#pragma unroll
            for (int bj = 0; bj < 2; ++bj)
#pragma unroll
                for (int n = 0; n < 2; ++n) bv[bj][n] = *(const f32x4*)(bj_ + bj * HALF + 4 * n);
#pragma unroll
            for (int ai = 0; ai < 2; ++ai)
#pragma unroll
                for (int m = 0; m < 4; ++m) { const size_t off = (size_t)(row0 + ai * HALF + m * 16) * GTW + col0;
#pragma unroll
                    for (int bj = 0; bj < 2; ++bj) { f32x4 v0 = acc[ai][bj][m][0] + bv[bj][0], v1 = acc[ai][bj][m][1] + bv[bj][1];
#pragma unroll
                        for (int e = 0; e < 4; ++e) { v0[e] = 1.0f + __expf(-fminf(fmaxf(v0[e], -30.f), 30.f)); v1[e] = 1.0f + __expf(-fminf(fmaxf(v1[e], -30.f), 30.f)); }
                        u32x4 w; w.x = pk2(v0[0], v0[1]); w.y = pk2(v0[2], v0[3]); w.z = pk2(v1[0], v1[1]); w.w = pk2(v1[2], v1[3]);
                        *(u32x4*)(gd + off + bj * HALF) = w; } }
        } else {
            const bf16_t* gc = GT + 2 * DM;
            u32x4 g[2][4][2];
#pragma unroll
            for (int ai = 0; ai < 2; ++ai)
#pragma unroll
                for (int m = 0; m < 4; ++m)
#pragma unroll
                    for (int bj = 0; bj < 2; ++bj) g[ai][m][bj] = *(const u32x4*)(gc + (size_t)(row0 + ai * HALF + m * 16) * GTW + col0 + bj * HALF);
#pragma unroll
            for (int ai = 0; ai < 2; ++ai)
#pragma unroll
                for (int m = 0; m < 4; ++m) { const size_t r = (size_t)(row0 + ai * HALF + m * 16);
#pragma unroll
                    for (int bj = 0; bj < 2; ++bj) { const u32x4 gg = g[ai][m][bj];
                        const f32x4 v0 = acc[ai][bj][m][0], v1 = acc[ai][bj][m][1];
                        u32x4 w; w.x = pk2(v0[0] * __builtin_amdgcn_rcpf(bflo(gg.x)), v0[1] * __builtin_amdgcn_rcpf(bfhi(gg.x))); w.y = pk2(v0[2] * __builtin_amdgcn_rcpf(bflo(gg.y)), v0[3] * __builtin_amdgcn_rcpf(bfhi(gg.y)));
                        w.z = pk2(v1[0] * __builtin_amdgcn_rcpf(bflo(gg.z)), v1[1] * __builtin_amdgcn_rcpf(bfhi(gg.z))); w.w = pk2(v1[2] * __builtin_amdgcn_rcpf(bflo(gg.w)), v1[3] * __builtin_amdgcn_rcpf(bfhi(gg.w)));
                        *(u32x4*)(O + r * ldc + col0 + bj * HALF) = w; } }
        }
    }
};

template <class Epi, class Sched, bool ALIGN_EPI = false, bool SP2 = false>
__device__ __forceinline__ void gemm_phase(PG8_LAS unsigned char* lds, const Gemm g, const Sched& S, const Epi& E) {
    const int tid = opaque_tid(), wid = __builtin_amdgcn_readfirstlane(tid >> 6), lane = tid & 63, wr = wid >> 2, wc = wid & 3, fr = lane & 15, fq = lane >> 4;
    const int K = g.K, nt_default = K / BK;
    unsigned voffA[2], voffB[2];
#pragma unroll
    for (int i = 0; i < 2; ++i) { int R, C; stage_rc(tid * 16 + i * 8192, R, C); const int Rb = Epi::PERM ? ((R & ~31) + perm32(R & 31)) : R;
        voffA[i] = (unsigned)(R * g.lda + C) * 2u; voffB[i] = (unsigned)(Rb * g.ldb + C) * 2u; }
    const size_t kstep = (size_t)(BK * 2);
    const size_t hstepA = (size_t)HALF * g.lda * 2, hstepB = (size_t)HALF * g.ldb * 2;
    const size_t tstepA = 2 * hstepA, tstepB = 2 * hstepB;
    const unsigned ldsw = (unsigned)wid * 1024u;
    const int aoff = lds_byte(wr * 64 + fr, fq * 8), boff = lds_byte(wc * 32 + fr, fq * 8);
#define PG8_SA(b, h) (((b) * 2 + (h)) * HTB)
#define PG8_SB(b, h) ((4 + (b) * 2 + (h)) * HTB)
#define PG8_STAGE(bufoff, gbase, voff) do { _Pragma("unroll") for (int _i = 0; _i < 2; ++_i) \
        __builtin_amdgcn_global_load_lds((const unsigned*)((const char*)(gbase) + (voff)[_i]), (PG8_LAS unsigned*)(lds + (bufoff) + ldsw + _i * 8192), 16, 0, 0); } while (0)
#define PG8_LDA(dst, b, h) do { _Pragma("unroll") for (int m = 0; m < 4; ++m) _Pragma("unroll") for (int k = 0; k < 2; ++k) dst[m][k] = *(const PG8_LAS bf16x8*)(lds + PG8_SA(b, h) + aoff + m * 2048 + k * 1024); } while (0)
#define PG8_LDB(dst, b, h) do { _Pragma("unroll") for (int n = 0; n < 2; ++n) _Pragma("unroll") for (int k = 0; k < 2; ++k) dst[n][k] = *(const PG8_LAS bf16x8*)(lds + PG8_SB(b, h) + boff + n * 2048 + k * 1024); } while (0)
#define PG8_MMA(ai, bj, At, Bt) do { __builtin_amdgcn_s_setprio(1); _Pragma("unroll") for (int m = 0; m < 4; ++m) _Pragma("unroll") for (int n = 0; n < 2; ++n) _Pragma("unroll") for (int k = 0; k < 2; ++k) \
        acc[ai][bj][m][n] = __builtin_amdgcn_mfma_f32_16x16x32_bf16(Bt[n][k], At[m][k], acc[ai][bj][m][n], 0, 0, 0); __builtin_amdgcn_s_setprio(0); } while (0)
#define PG8_WAIT_V(n) asm volatile("s_waitcnt vmcnt(" #n ")" ::: "memory")
#define PG8_WAIT_L(n) asm volatile("s_waitcnt lgkmcnt(" #n ")" ::: "memory")
#define PG8_BAR __builtin_amdgcn_s_barrier()
#define PG8_SCHED __builtin_amdgcn_sched_barrier(0)
    Unit cur, nxt; int ui = 0;
    if (!S.next(0, cur)) return;
    f32x4 acc[2][2][4][2];
#pragma unroll
    for (int a = 0; a < 2; ++a)
#pragma unroll
        for (int b = 0; b < 2; ++b)
#pragma unroll
            for (int m = 0; m < 4; ++m)
#pragma unroll
                for (int n = 0; n < 2; ++n) acc[a][b][m][n] = (f32x4){0.f, 0.f, 0.f, 0.f};
    bf16x8 At[4][2], B0[2][2], B1[2][2];
    const char* cA = (const char*)g.A + (size_t)cur.pm * tstepA + (size_t)S.koff(cur) * 2; const char* cB = (const char*)g.Bt + (size_t)cur.pn * tstepB + (size_t)S.koff(cur) * 2;
    int nt = S.nt(cur, nt_default);
    S.a_ready(cur);
    if constexpr (SP2) {
        PG8_STAGE(PG8_SB(0, 0), cB, voffB); PG8_STAGE(PG8_SB(0, 1), cB + hstepB, voffB); PG8_STAGE(PG8_SA(0, 0), cA, voffA); PG8_STAGE(PG8_SA(0, 1), cA + hstepA, voffA);
        if (wr == 1) PG8_BAR;
        PG8_WAIT_V(2); PG8_BAR;
        PG8_STAGE(PG8_SB(1, 0), cB + kstep, voffB); PG8_STAGE(PG8_SA(1, 0), cA + kstep, voffA); PG8_STAGE(PG8_SB(1, 1), cB + hstepB + kstep, voffB);
        PG8_WAIT_V(6); PG8_BAR;
    } else {
        PG8_STAGE(PG8_SB(0, 0), cB, voffB); PG8_STAGE(PG8_SA(0, 0), cA, voffA); PG8_STAGE(PG8_SB(0, 1), cB + hstepB, voffB); PG8_STAGE(PG8_SA(0, 1), cA + hstepA, voffA);
        if (wr == 1) PG8_BAR;
        PG8_WAIT_V(4); PG8_BAR;
        PG8_STAGE(PG8_SB(1, 0), cB + kstep, voffB); PG8_STAGE(PG8_SA(1, 0), cA + kstep, voffA); PG8_STAGE(PG8_SB(1, 1), cB + hstepB + kstep, voffB);
        PG8_WAIT_V(6); PG8_BAR;
    }
    for (;;) {
        const bool has_next = S.next(ui + 1, nxt);
        const char* nA = has_next ? (const char*)g.A + (size_t)nxt.pm * tstepA + (size_t)S.koff(nxt) * 2 : cA; const char* nB = has_next ? (const char*)g.Bt + (size_t)nxt.pn * tstepB + (size_t)S.koff(nxt) * 2 : cB;
        for (int t = 0; t < nt; t += 2) {
            const bool last = (t == nt - 2);
            if constexpr (Epi::HOOK) { if (E.hook_at(cur, t)) E.hook(acc, cur, t, wr, wc, fr, fq); }
            const char* a1 = cA + (size_t)(t + 1) * kstep;
            const char* a2 = last ? nA : cA + (size_t)(t + 2) * kstep; const char* b2 = last ? nB : cB + (size_t)(t + 2) * kstep;
            const char* a3 = a2 + kstep; const char* b3 = b2 + kstep;
            if (last && has_next) S.a_ready(nxt);
            if constexpr (SP2) {
            PG8_LDB(B0, 0, 0); PG8_LDB(B1, 0, 1); PG8_SCHED; PG8_LDA(At, 0, 0); PG8_STAGE(PG8_SA(1, 1), a1 + hstepA, voffA);
            PG8_WAIT_V(8); PG8_WAIT_L(0); PG8_BAR; PG8_MMA(0, 0, At, B0); PG8_MMA(0, 1, At, B1); PG8_BAR; PG8_SCHED;
            PG8_LDA(At, 0, 1); PG8_STAGE(PG8_SB(0, 0), b2, voffB); PG8_STAGE(PG8_SB(0, 1), b2 + hstepB, voffB); PG8_STAGE(PG8_SA(0, 0), a2, voffA);
            PG8_WAIT_V(8); PG8_WAIT_L(0); PG8_BAR; PG8_MMA(1, 0, At, B0); PG8_MMA(1, 1, At, B1); PG8_BAR; PG8_SCHED;
            PG8_LDB(B0, 1, 0); PG8_LDB(B1, 1, 1); PG8_SCHED; PG8_LDA(At, 1, 0); PG8_STAGE(PG8_SA(0, 1), a2 + hstepA, voffA);
            PG8_WAIT_V(8); PG8_WAIT_L(0); PG8_BAR; PG8_MMA(0, 0, At, B0); PG8_MMA(0, 1, At, B1); PG8_BAR; PG8_SCHED;
            PG8_LDA(At, 1, 1); PG8_STAGE(PG8_SB(1, 0), b3, voffB); PG8_STAGE(PG8_SB(1, 1), b3 + hstepB, voffB); PG8_STAGE(PG8_SA(1, 0), a3, voffA);
            PG8_WAIT_V(8); PG8_WAIT_L(0); PG8_BAR; PG8_MMA(1, 0, At, B0); PG8_MMA(1, 1, At, B1); PG8_BAR; PG8_SCHED;
            } else {
            PG8_LDB(B0, 0, 0); PG8_SCHED; PG8_LDA(At, 0, 0); PG8_STAGE(PG8_SA(1, 1), a1 + hstepA, voffA);
            PG8_WAIT_L(8); PG8_BAR; PG8_WAIT_L(0); PG8_MMA(0, 0, At, B0); PG8_BAR; PG8_SCHED;
            PG8_LDB(B1, 0, 1); PG8_STAGE(PG8_SB(0, 0), b2, voffB);
            PG8_BAR; PG8_WAIT_L(0); PG8_MMA(0, 1, At, B1); PG8_BAR;
            PG8_LDA(At, 0, 1); PG8_STAGE(PG8_SA(0, 0), a2, voffA);
            PG8_BAR; PG8_WAIT_L(0); PG8_MMA(1, 0, At, B0); PG8_BAR; PG8_SCHED;
            PG8_STAGE(PG8_SB(0, 1), b2 + hstepB, voffB);
            PG8_WAIT_V(6); PG8_BAR; PG8_MMA(1, 1, At, B1); PG8_BAR;
            PG8_LDB(B0, 1, 0); PG8_SCHED; PG8_LDA(At, 1, 0); PG8_STAGE(PG8_SA(0, 1), a2 + hstepA, voffA);
            PG8_WAIT_L(8); PG8_BAR; PG8_WAIT_L(0); PG8_MMA(0, 0, At, B0); PG8_BAR; PG8_SCHED;
            PG8_LDB(B1, 1, 1); PG8_STAGE(PG8_SB(1, 0), b3, voffB);
            PG8_BAR; PG8_WAIT_L(0); PG8_MMA(0, 1, At, B1); PG8_BAR;
            PG8_LDA(At, 1, 1); PG8_STAGE(PG8_SA(1, 0), a3, voffA);
            PG8_BAR; PG8_WAIT_L(0); PG8_MMA(1, 0, At, B0); PG8_BAR; PG8_SCHED;
            PG8_STAGE(PG8_SB(1, 1), b3 + hstepB, voffB);
            PG8_WAIT_V(6); PG8_BAR; PG8_MMA(1, 1, At, B1); PG8_BAR;
            }
        }
        if constexpr (ALIGN_EPI) { if (wr == 0) PG8_BAR; }
        E(acc, cur, wr, wc, fr, fq); S.done(cur);
        if (!has_next) break;
#pragma unroll
        for (int a = 0; a < 2; ++a)
#pragma unroll
            for (int b = 0; b < 2; ++b)
#pragma unroll
                for (int m = 0; m < 4; ++m)
#pragma unroll
                    for (int n = 0; n < 2; ++n) acc[a][b][m][n] = (f32x4){0.f, 0.f, 0.f, 0.f};
        cur = nxt; cA = nA; cB = nB; ++ui; nt = S.nt(cur, nt_default);
        if constexpr (ALIGN_EPI) { if (wr == 1) PG8_BAR; }
    }
    PG8_WAIT_V(0);
    if constexpr (!ALIGN_EPI) { if (wr == 0) PG8_BAR; }
    PG8_BAR;
#undef PG8_SA
#undef PG8_SB
#undef PG8_STAGE
#undef PG8_LDA
#undef PG8_LDB
#undef PG8_MMA
#undef PG8_WAIT_V
#undef PG8_WAIT_L
#undef PG8_BAR
#undef PG8_SCHED
}
}

#define XB_TMO      128
#define XB_XCNT(j)  (256  + 64 * (j))
#define XB_XSUB(j)  (1280 + 64 * (j))
#define XB_XGEN(j)  (2304 + 64 * (j))
#define XB_TOP      3328
#define XB_TOPGEN   3392
#define XCD_BAR_WORDS 3456
#define XB_SPIN_CAP (1u << 18)

__device__ __forceinline__ unsigned xb_ld(unsigned* p)              { return __hip_atomic_load(p, __ATOMIC_RELAXED, __HIP_MEMORY_SCOPE_AGENT); }
__device__ __forceinline__ unsigned xb_add(unsigned* p, unsigned v) { return __hip_atomic_fetch_add(p, v, __ATOMIC_RELAXED, __HIP_MEMORY_SCOPE_AGENT); }
__device__ __forceinline__ unsigned xb_xcc_id() { return (unsigned)__builtin_amdgcn_s_getreg((3 << 11) | 20) & 0xFu; }
#define XB_SPIN(cond, bar) do { unsigned _sp = 0; while (cond) { __builtin_amdgcn_s_sleep(1); \
    if ((++_sp & 255u) == 0u) { if (xb_ld(&(bar)[XB_TMO])) break; if (_sp > XB_SPIN_CAP) { atomicAdd(&(bar)[XB_TMO], 1u); break; } } } } while (0)

struct XcdBarrier {
    unsigned* bar; unsigned x;
    volatile LAS unsigned* st;
};
__device__ __forceinline__ XcdBarrier xcd_barrier_post(unsigned* bar, volatile LAS unsigned* st) {
    XcdBarrier b; b.bar = bar; b.x = xb_xcc_id(); b.st = st;
    if (threadIdx.x == 0) (void)xb_add(&bar[XB_XCNT(b.x)], 1u);
    return b;
}
__device__ __forceinline__ void xcd_barrier_complete(unsigned* bar, unsigned x, unsigned& nloc, unsigned& nx) {
    const unsigned G = gridDim.x * gridDim.y * gridDim.z;
    unsigned sum, cnt, mine, sp = 0u;
    for (;;) {
        sum = 0u; cnt = 0u; mine = 0u;
#pragma unroll
        for (unsigned j = 0; j < 16; ++j) { const unsigned c = xb_ld(&bar[XB_XCNT(j)]); sum += c; cnt += (c > 0u) ? 1u : 0u; mine = (j == x) ? c : mine; }
        if (sum == G) break;
        __builtin_amdgcn_s_sleep(1);
        if ((++sp & 255u) == 0u) { if (xb_ld(&bar[XB_TMO])) break; if (sp > XB_SPIN_CAP) { atomicAdd(&bar[XB_TMO], 1u); break; } }
    }
    nloc = mine > 0u ? mine : 1u; nx = cnt > 0u ? cnt : 1u;
}
__device__ __forceinline__ void xcd_barrier(const XcdBarrier& b) {
    asm volatile("s_waitcnt vmcnt(0)" ::: "memory");
    __syncthreads();
    if (threadIdx.x == 0) {
        unsigned* bar = b.bar;
        __builtin_amdgcn_s_waitcnt(0);
        unsigned nloc = b.st[0], nx = b.st[1];
        if (nloc == 0u) { xcd_barrier_complete(bar, b.x, nloc, nx); b.st[0] = nloc; b.st[1] = nx; }
        const unsigned old = xb_add(&bar[XB_XSUB(b.x)], 1u);
        const unsigned gen = old / nloc;
        if (old + 1u == (gen + 1u) * nloc) {
            __builtin_amdgcn_fence(__ATOMIC_RELEASE, "agent");
            asm volatile("s_waitcnt vmcnt(0)" ::: "memory");
            const unsigned og = xb_add(&bar[XB_TOP], 1u);
            const unsigned tg = og / nx;
            if (og + 1u == (tg + 1u) * nx) xb_add(&bar[XB_TOPGEN], 1u);
            else XB_SPIN(xb_ld(&bar[XB_TOPGEN]) == tg, bar);
            __builtin_amdgcn_fence(__ATOMIC_ACQUIRE, "agent");
            xb_add(&bar[XB_XGEN(b.x)], 1u);
            asm volatile("s_waitcnt vmcnt(0)" ::: "memory");
        } else {
            XB_SPIN(xb_ld(&bar[XB_XGEN(b.x)]) == gen, bar);
            __builtin_amdgcn_fence(__ATOMIC_ACQUIRE, "agent");
            asm volatile("s_waitcnt vmcnt(0)" ::: "memory");
        }
    }
    __syncthreads();
}

struct Params { const float* in[23]; float* out; unsigned char* ws; };
enum { I_X = 0, I_MEM, I_NORM_MIX, I_W_IN, I_W_GLA_A, I_B_GLA_A, I_GLA_NORM, I_CONV_W, I_CONV_B, I_B_ML_I, I_B_ML_F, I_ML_NORM, I_MEM_NORM, I_W_MEM_K, I_W_MEM_V, I_W_BRANCH, I_W_GATE, I_B_GATE, I_W_OUT, I_NORM_FFN, I_W_FF1, I_W_FF2, I_FINAL_NORM };

DI int win_row(int n) {
    if (n < 3072) return n;
    if (n < 3088) return ZC_GA + (n - 3072);
    if (n < 6160) return n - 16;
    if (n < 6168) return ZC_MI + (n - 6160);
    return n - 24;
}
DI void transpose_item(const float* __restrict__ W, int K, int N, bf16_t* __restrict__ WT, int ld_dst, int col_off, int row_off, bool remap, LAS float* scr, int item, int lane, const float* __restrict__ gain = nullptr) {
    const int nblk = (N + 63) >> 6, kb = item / nblk, nb = item - kb * nblk, k0 = kb << 6, n0 = nb << 6;
    const int a = lane & 15, q = lane >> 4, n4 = 4 * a;
    const bool ok = (n0 + n4) < N;
    f32x4 v[16];
#pragma unroll
    for (int i = 0; i < 16; ++i) { const int kk = 4 * i + q; v[i] = ok ? *(const f32x4*)(W + (size_t)(k0 + kk) * N + n0 + n4) : (f32x4){0.f, 0.f, 0.f, 0.f}; }
#pragma unroll
    for (int i = 0; i < 16; ++i) { const int kk = 4 * i + q;
#pragma unroll
        for (int e = 0; e < 4; ++e) scr[(n4 + e) * 65 + kk] = v[i][e]; }
    asm volatile("s_waitcnt lgkmcnt(0)" ::: "memory");
    const int c = lane & 7;
    f32x4 g0 = (f32x4){1.f, 1.f, 1.f, 1.f}, g1 = g0;
    if (gain) { g0 = *(const f32x4*)(gain + k0 + 8 * c); g1 = *(const f32x4*)(gain + k0 + 8 * c + 4); }
#pragma unroll
    for (int jj = 0; jj < 8; ++jj) { const int n = (lane >> 3) + 8 * jj; const LAS float* s = scr + n * 65 + 8 * c;
        u32x4 o; o.x = pk2(s[0] * g0[0], s[1] * g0[1]); o.y = pk2(s[2] * g0[2], s[3] * g0[3]); o.z = pk2(s[4] * g1[0], s[5] * g1[1]); o.w = pk2(s[6] * g1[2], s[7] * g1[3]);
        const int ng = n0 + n;
        if (ng < N) { const int row = row_off + (remap ? win_row(ng) : ng); *(u32x4*)(WT + (size_t)row * ld_dst + col_off + k0 + 8 * c) = o; } }
    asm volatile("s_waitcnt lgkmcnt(0)" ::: "memory");
}

template <bool OUT_F32> DI void rmsnorm_row(const float* __restrict__ xrow, const float* __restrict__ g, void* orow, int lane) {
    const f32x4* xr = (const f32x4*)xrow + lane; const f32x4* gr = (const f32x4*)g + lane;
    f32x4 v[16]; float s = 0.f;
#pragma unroll
    for (int j = 0; j < 16; ++j) { v[j] = xr[64 * j]; s += (v[j].x * v[j].x + v[j].y * v[j].y) + (v[j].z * v[j].z + v[j].w * v[j].w); }
    const float rstd = 1.0f / sqrtf(wave_sum(s, lane) * (1.0f / DM) + EPS);
#pragma unroll
    for (int j = 0; j < 16; ++j) { const f32x4 gg = gr[64 * j]; const f32x4 o = v[j] * rstd * gg;
        if (OUT_F32) ((f32x4*)orow)[lane + 64 * j] = o;
        else { u32x2 w; w.x = pk2(o.x, o.y); w.y = pk2(o.z, o.w); ((u32x2*)orow)[lane + 64 * j] = w; } }
}

DI void row_bf16_ss(const float* __restrict__ xrow, bf16_t* orow, unsigned long long* ss, int lane) {
    const f32x4* xr = (const f32x4*)xrow + lane; float s = 0.f;
#pragma unroll
    for (int j = 0; j < 16; ++j) { const f32x4 v = xr[64 * j]; s += (v.x * v.x + v.y * v.y) + (v.z * v.z + v.w * v.w);
        u32x2 w; w.x = pk2(v.x, v.y); w.y = pk2(v.z, v.w); ((u32x2*)orow)[lane + 64 * j] = w; }
    s = wave_sum(s, lane);
    if (lane == 0) *ss = (unsigned long long)(s * 16777216.0f);
}
DI void row_scale_f32(const float* __restrict__ xrow, const float* __restrict__ g, float ssv, float* orow, int lane) {
    const f32x4* xr = (const f32x4*)xrow + lane; const f32x4* gr = (const f32x4*)g + lane;
    const float rstd = 1.0f / sqrtf(ssv * (1.0f / DM) + EPS);
#pragma unroll
    for (int j = 0; j < 16; ++j) ((f32x4*)orow)[lane + 64 * j] = xr[64 * j] * rstd * gr[64 * j];
}

DI void fill_vT(const bf16_t* __restrict__ Zv, int n, int tg, int lane, LAS unsigned char* VT) {
#pragma unroll
    for (int i = 0; i < 2; ++i) { const int cp = lane + 64 * i; unsigned w[8];
#pragma unroll
        for (int j = 0; j < 8; ++j) w[j] = *(const unsigned*)(Zv + (size_t)(n * CH + 8 * tg + j) * ZW + 2 * cp);
        u32x4 lo, hi;
        lo.x = (w[0] & 0xffffu) | (w[1] << 16); lo.y = (w[2] & 0xffffu) | (w[3] << 16); lo.z = (w[4] & 0xffffu) | (w[5] << 16); lo.w = (w[6] & 0xffffu) | (w[7] << 16);
        hi.x = (w[0] >> 16) | (w[1] & 0xffff0000u); hi.y = (w[2] >> 16) | (w[3] & 0xffff0000u); hi.z = (w[4] >> 16) | (w[5] & 0xffff0000u); hi.w = (w[6] >> 16) | (w[7] & 0xffff0000u);
        *(LAS u32x4*)(VT + (2 * cp) * ROW72 + tg * 16) = lo; *(LAS u32x4*)(VT + (2 * cp + 1) * ROW72 + tg * 16) = hi; }
}
DI void state_mfma(const LAS unsigned char* VT, const LAS unsigned char* KT, bf16_t* __restrict__ OUT, int w, int lane) {
    const int fr = lane & 15, fq = lane >> 4;
    f32x4 acc[2][8];
#pragma unroll
    for (int mi = 0; mi < 2; ++mi)
#pragma unroll
        for (int ni = 0; ni < 8; ++ni) acc[mi][ni] = (f32x4){0.f, 0.f, 0.f, 0.f};
#pragma unroll
    for (int ks = 0; ks < 2; ++ks) {
        bf16x8 a[2];
#pragma unroll
        for (int mi = 0; mi < 2; ++mi) a[mi] = *(const LAS bf16x8*)(VT + (32 * w + 16 * mi + fr) * ROW72 + (32 * ks + 8 * fq) * 2);
#pragma unroll
        for (int ni = 0; ni < 8; ++ni) { const bf16x8 b = *(const LAS bf16x8*)(KT + (16 * ni + fr) * ROW72 + (32 * ks + 8 * fq) * 2);
#pragma unroll
            for (int mi = 0; mi < 2; ++mi) acc[mi][ni] = mfma16(b, a[mi], acc[mi][ni]); }
    }
#pragma unroll
    for (int mi = 0; mi < 2; ++mi)
#pragma unroll
        for (int ni = 0; ni < 8; ++ni) *(u32x2*)(OUT + (size_t)(32 * w + 16 * mi + fr) * 128 + 16 * ni + 4 * fq) = (u32x2){pk2(acc[mi][ni][0], acc[mi][ni][1]), pk2(acc[mi][ni][2], acc[mi][ni][3])};
}
DI void copy_256x128(const bf16_t* __restrict__ src, int gp, LAS unsigned char* dst, int tid) {
#pragma unroll
    for (int i = 0; i < 8; ++i) { const int id = tid + 512 * i, row = id >> 4, cc = id & 15;
        *(LAS u32x4*)(dst + row * ROW136 + cc * 16) = *(const u32x4*)(src + (size_t)row * gp + cc * 8); }
}

DI void ld_v(const bf16_t* __restrict__ Zv, int n, int tg, int lane, unsigned (&w)[2][8]) {
#pragma unroll
    for (int i = 0; i < 2; ++i)
#pragma unroll
        for (int j = 0; j < 8; ++j) w[i][j] = *(const unsigned*)(Zv + (size_t)(n * CH + 8 * tg + j) * ZW + 2 * (lane + 64 * i));
}
DI void st_vT(const unsigned (&w)[2][8], int tg, int lane, LAS unsigned char* VT) {
#pragma unroll
    for (int i = 0; i < 2; ++i) { const int cp = lane + 64 * i; u32x4 lo, hi;
        lo.x = (w[i][0] & 0xffffu) | (w[i][1] << 16); lo.y = (w[i][2] & 0xffffu) | (w[i][3] << 16); lo.z = (w[i][4] & 0xffffu) | (w[i][5] << 16); lo.w = (w[i][6] & 0xffffu) | (w[i][7] << 16);
        hi.x = (w[i][0] >> 16) | (w[i][1] & 0xffff0000u); hi.y = (w[i][2] >> 16) | (w[i][3] & 0xffff0000u); hi.z = (w[i][4] >> 16) | (w[i][5] & 0xffff0000u); hi.w = (w[i][6] >> 16) | (w[i][7] & 0xffff0000u);
        *(LAS u32x4*)(VT + (2 * cp) * ROW72 + tg * 16) = lo; *(LAS u32x4*)(VT + (2 * cp + 1) * ROW72 + tg * 16) = hi; }
}
DI void ld_256x128(const bf16_t* __restrict__ src, int gp, int tid, u32x4 (&r)[8]) {
#pragma unroll
    for (int i = 0; i < 8; ++i) { const int id = tid + 512 * i, row = id >> 4, cc = id & 15; r[i] = *(const u32x4*)(src + (size_t)row * gp + cc * 8); }
}
DI void st_256x128(const u32x4 (&r)[8], LAS unsigned char* dst, int tid) {
#pragma unroll
    for (int i = 0; i < 8; ++i) { const int id = tid + 512 * i, row = id >> 4, cc = id & 15; *(LAS u32x4*)(dst + row * ROW136 + cc * 16) = r[i]; }
}
DI void conv_ld(const bf16_t* __restrict__ Zc, int tok0, unsigned (&x)[11]) {
#pragma unroll
    for (int i = 0; i < 11; ++i) { const int tok = tok0 - 3 + i; x[i] = 0u; if (tok >= 0) x[i] = *(const unsigned*)(Zc + (size_t)tok * ZW); }
}
DI void conv_apply(const unsigned (&x)[11], const float* __restrict__ cw, const float* __restrict__ cb, float (&o0)[8], float (&o1)[8]) {
    f32x2 wj[4];
#pragma unroll
    for (int j = 0; j < 4; ++j) wj[j] = *(const f32x2*)(cw + j * 1024);
    const f32x2 bias = *(const f32x2*)cb;
#pragma unroll
    for (int j = 0; j < 8; ++j) { float y0 = bias.x, y1 = bias.y;
#pragma unroll
        for (int jj = 0; jj < 4; ++jj) { y0 += wj[jj].x * bflo(x[j + jj]); y1 += wj[jj].y * bfhi(x[j + jj]); }
        o0[j] = silu_f(y0); o1[j] = silu_f(y1); }
}
DI void gla_b(const bf16_t* __restrict__ Z, const float* __restrict__ wa, const float* __restrict__ ba, int h, int n, int tg, int c2, LAS float* TOT, float (&b)[8][2], float (&blast)[2]) {
    const int col = h * 128 + 2 * c2;
    float w0[16], w1[16];
#pragma unroll
    for (int r = 0; r < 16; ++r) { const f32x2 w = *(const f32x2*)(wa + r * 512 + col); w0[r] = w.x; w1[r] = w.y; }
    const f32x2 bb = *(const f32x2*)(ba + col);
    float c0 = 0.f, c1 = 0.f;
#pragma unroll
    for (int j = 0; j < 8; ++j) {
        const bf16_t* gp = Z + (size_t)(n * CH + 8 * tg + j) * ZW + ZC_GA;
        const u32x4 g0 = *(const u32x4*)gp, g1 = *(const u32x4*)(gp + 8);
        const float gv[16] = {bflo(g0.x), bfhi(g0.x), bflo(g0.y), bfhi(g0.y), bflo(g0.z), bfhi(g0.z), bflo(g0.w), bfhi(g0.w),
                              bflo(g1.x), bfhi(g1.x), bflo(g1.y), bfhi(g1.y), bflo(g1.z), bfhi(g1.z), bflo(g1.w), bfhi(g1.w)};
        float p0 = bb.x, p1 = bb.y;
#pragma unroll
        for (int r = 0; r < 16; ++r) { p0 += gv[r] * w0[r]; p1 += gv[r] * w1[r]; }
        c0 += log_sigmoid_f(p0) * (1.0f / 16.0f); c1 += log_sigmoid_f(p1) * (1.0f / 16.0f);
        b[j][0] = c0; b[j][1] = c1;
    }
    *(LAS f32x2*)(TOT + tg * 128 + 2 * c2) = (f32x2){c0, c1};
    __syncthreads();
    float pre0 = 0.f, pre1 = 0.f, t0 = 0.f, t1 = 0.f;
#pragma unroll
    for (int g = 0; g < 8; ++g) { const f32x2 t = *(const LAS f32x2*)(TOT + g * 128 + 2 * c2); if (g < tg) { pre0 += t.x; pre1 += t.y; } t0 += t.x; t1 += t.y; }
#pragma unroll
    for (int j = 0; j < 8; ++j) { b[j][0] += pre0; b[j][1] += pre1; }
    blast[0] = t0; blast[1] = t1;
}
DI void conv_silu8(const bf16_t* __restrict__ Zc, const float* __restrict__ cw, const float* __restrict__ cb, int tok0, float (&o0)[8], float (&o1)[8]) {
    float x0[11], x1[11];
#pragma unroll
    for (int i = 0; i < 11; ++i) { const int tok = tok0 - 3 + i; unsigned w = 0u; if (tok >= 0) w = *(const unsigned*)(Zc + (size_t)tok * ZW); x0[i] = bflo(w); x1[i] = bfhi(w); }
    f32x2 wj[4];
#pragma unroll
    for (int j = 0; j < 4; ++j) wj[j] = *(const f32x2*)(cw + j * 1024);
    const f32x2 bias = *(const f32x2*)cb;
#pragma unroll
    for (int j = 0; j < 8; ++j) { float y0 = bias.x, y1 = bias.y;
#pragma unroll
        for (int jj = 0; jj < 4; ++jj) { y0 += wj[jj].x * x0[j + jj]; y1 += wj[jj].y * x1[j + jj]; }
        o0[j] = silu_f(y0); o1[j] = silu_f(y1); }
}
DI void score_mfma(const LAS unsigned char* QL, const LAS unsigned char* KL, int w, int lane, f32x4 (&sacc)[2]) {
    const int fr = lane & 15, fq = lane >> 4, mi = w >> 1, ni0 = 2 * (w & 1);
    sacc[0] = (f32x4){0.f, 0.f, 0.f, 0.f}; sacc[1] = sacc[0];
#pragma unroll
    for (int ks = 0; ks < 4; ++ks) { const bf16x8 a = *(const LAS bf16x8*)(QL + (16 * mi + fr) * ROW136 + (32 * ks + 8 * fq) * 2);
#pragma unroll
        for (int jn = 0; jn < 2; ++jn) { const bf16x8 b = *(const LAS bf16x8*)(KL + (16 * (ni0 + jn) + fr) * ROW136 + (32 * ks + 8 * fq) * 2); sacc[jn] = mfma16(b, a, sacc[jn]); } }
}

struct MixCtx {
    const bf16_t* Z; bf16_t* OB;
    const float *wa, *ba, *gla_norm, *conv_w, *conv_b, *b_i, *b_f, *ml_norm;
    float *DECAY, *DN, *NP, *GG, *FL, *MP, *BG; bf16_t *DS, *DC, *SP, *CP;
    const bf16_t *KM, *VMT;
};

DI void gla_A_unit(const MixCtx& C, LAS unsigned char* lds, int h, int n, int tid) {
    const int lane = tid & 63, tg = __builtin_amdgcn_readfirstlane(tid >> 6), c2 = lane;
    LAS float* TOT = (LAS float*)(lds + L_MISC);
    LAS unsigned char* KT = lds + L_ST; LAS unsigned char* VT = lds + L_VT;
    unsigned kw[8], vw[2][8];
#pragma unroll
    for (int j = 0; j < 8; ++j) kw[j] = *(const unsigned*)(C.Z + (size_t)(n * CH + 8 * tg + j) * ZW + ZC_GK + h * 128 + 2 * c2);
    ld_v(C.Z + ZC_GV + h * 256, n, tg, lane, vw);
    float b[8][2], blast[2];
    gla_b(C.Z, C.wa, C.ba, h, n, tg, c2, TOT, b, blast);
    float k0[8], k1[8];
#pragma unroll
    for (int j = 0; j < 8; ++j) { k0[j] = bflo(kw[j]) * __expf(blast[0] - b[j][0]); k1[j] = bfhi(kw[j]) * __expf(blast[1] - b[j][1]);
        *(f32x2*)(C.BG + ((size_t)(h * NCH + n) * CH + 8 * tg + j) * 128 + 2 * c2) = (f32x2){b[j][0], b[j][1]}; }
    u32x4 lo, hi;
    lo.x = pk2(k0[0], k0[1]); lo.y = pk2(k0[2], k0[3]); lo.z = pk2(k0[4], k0[5]); lo.w = pk2(k0[6], k0[7]);
    hi.x = pk2(k1[0], k1[1]); hi.y = pk2(k1[2], k1[3]); hi.z = pk2(k1[4], k1[5]); hi.w = pk2(k1[6], k1[7]);
    *(LAS u32x4*)(KT + (2 * c2) * ROW72 + tg * 16) = lo; *(LAS u32x4*)(KT + (2 * c2 + 1) * ROW72 + tg * 16) = hi;
    if (tg == 0) *(f32x2*)(C.DECAY + (size_t)(h * NCH + n) * 128 + 2 * c2) = (f32x2){__expf(blast[0]), __expf(blast[1])};
    st_vT(vw, tg, lane, VT);
    __syncthreads();
    state_mfma(VT, KT, C.DS + (size_t)(h * NCH + n) * 32768, tg, lane);
    __syncthreads();
}

DI void gla_B_unit(const MixCtx& C, LAS unsigned char* lds, int h, int n, int tid) {
    const int lane = tid & 63, w = __builtin_amdgcn_readfirstlane(tid >> 6), tg = w, c2 = lane, fr = lane & 15, fq = lane >> 4;
    LAS float* RS = (LAS float*)(lds + L_MISC + 4096);
    LAS unsigned char* ST = lds + L_ST; LAS unsigned char* VT = lds + L_VT; LAS unsigned char* QL = lds + L_Q; LAS unsigned char* KL = lds + L_K;
    const int wr = w >> 1, wc = w & 1, t = 16 * wr + fr;
    const size_t tok = (size_t)(n * CH + t);
    u32x4 st[8]; f32x2 bq[8]; unsigned wq[8], wk[8], vw[2][8]; u32x2 gg[8]; f32x4 gn[8];
    ld_256x128(C.SP + (size_t)(h * NCH + n) * 32768, 128, tid, st);
#pragma unroll
    for (int j = 0; j < 8; ++j) { const size_t zr = (size_t)(n * CH + 8 * tg + j) * ZW;
        bq[j] = *(const f32x2*)(C.BG + ((size_t)(h * NCH + n) * CH + 8 * tg + j) * 128 + 2 * c2);
        wq[j] = *(const unsigned*)(C.Z + zr + ZC_GQ + h * 128 + 2 * c2); wk[j] = *(const unsigned*)(C.Z + zr + ZC_GK + h * 128 + 2 * c2); }
    ld_v(C.Z + ZC_GV + h * 256, n, tg, lane, vw);
#pragma unroll
    for (int ni = 0; ni < 8; ++ni) { const int dv = 128 * wc + 16 * ni + 4 * fq; gg[ni] = *(const u32x2*)(C.Z + tok * ZW + ZC_GG + h * 256 + dv); gn[ni] = *(const f32x4*)(C.gla_norm + h * 256 + dv); }
    const float qs = 0.08838834764831845f;
#pragma unroll
    for (int j = 0; j < 8; ++j) { const float e0 = __expf(bq[j].x), e1 = __expf(bq[j].y);
        *(LAS unsigned*)(QL + (8 * tg + j) * ROW136 + 4 * c2) = pk2(bflo(wq[j]) * qs * e0, bfhi(wq[j]) * qs * e1);
        *(LAS unsigned*)(KL + (8 * tg + j) * ROW136 + 4 * c2) = pk2(bflo(wk[j]) * __builtin_amdgcn_rcpf(e0), bfhi(wk[j]) * __builtin_amdgcn_rcpf(e1)); }
    st_vT(vw, tg, lane, VT);
    st_256x128(st, ST, tid);
    __syncthreads();
    f32x4 sacc[2];
    score_mfma(QL, KL, w, lane, sacc);
    __syncthreads();
    { const int mi = w >> 1, ni0 = 2 * (w & 1), t2 = 16 * mi + fr;
#pragma unroll
      for (int jn = 0; jn < 2; ++jn) { const int s0 = 16 * (ni0 + jn) + 4 * fq; f32x4 v = sacc[jn];
#pragma unroll
          for (int r = 0; r < 4; ++r) if (s0 + r > t2) v[r] = 0.f;
          *(LAS u32x2*)(KL + t2 * ROW72 + s0 * 2) = (u32x2){pk2(v[0], v[1]), pk2(v[2], v[3])}; } }
    __syncthreads();
    f32x4 o[8];
#pragma unroll
    for (int ni = 0; ni < 8; ++ni) o[ni] = (f32x4){0.f, 0.f, 0.f, 0.f};
#pragma unroll
    for (int ks = 0; ks < 2; ++ks) { const bf16x8 a = *(const LAS bf16x8*)(KL + t * ROW72 + (32 * ks + 8 * fq) * 2);
#pragma unroll
        for (int ni = 0; ni < 8; ++ni) { const bf16x8 bb = *(const LAS bf16x8*)(VT + (128 * wc + 16 * ni + fr) * ROW72 + (32 * ks + 8 * fq) * 2); o[ni] = mfma16(bb, a, o[ni]); } }
#pragma unroll
    for (int ks = 0; ks < 4; ++ks) { const bf16x8 a = *(const LAS bf16x8*)(QL + t * ROW136 + (32 * ks + 8 * fq) * 2);
#pragma unroll
        for (int ni = 0; ni < 8; ++ni) { const bf16x8 bb = *(const LAS bf16x8*)(ST + (128 * wc + 16 * ni + fr) * ROW136 + (32 * ks + 8 * fq) * 2); o[ni] = mfma16(bb, a, o[ni]); } }
    float ss = 0.f;
#pragma unroll
    for (int ni = 0; ni < 8; ++ni) ss += (o[ni][0] * o[ni][0] + o[ni][1] * o[ni][1]) + (o[ni][2] * o[ni][2] + o[ni][3] * o[ni][3]);
    ss += shx(ss, 16, lane); ss += shx(ss, 32, lane);
    if (fq == 0) RS[wc * 64 + t] = ss;
    __syncthreads();
    const float rstd = 1.0f / sqrtf((RS[t] + RS[64 + t]) * (1.0f / 256.0f) + EPS);
#pragma unroll
    for (int ni = 0; ni < 8; ++ni) { const int dv = 128 * wc + 16 * ni + 4 * fq;
        const f32x4 v = o[ni] * rstd * gn[ni];
        *(u32x2*)(C.OB + tok * OBW + OB_O + h * 256 + dv) = (u32x2){pk2(v[0] * silu_f(bflo(gg[ni].x)), v[1] * silu_f(bfhi(gg[ni].x))), pk2(v[2] * silu_f(bflo(gg[ni].y)), v[3] * silu_f(bfhi(gg[ni].y)))}; }
    __syncthreads();
}

DI void ml_A_unit(const MixCtx& C, LAS unsigned char* lds, int h, int n, int tid) {
    const int lane = tid & 63, tg = __builtin_amdgcn_readfirstlane(tid >> 6), c2 = lane;
    LAS float* PART = (LAS float*)(lds + L_MISC);
    LAS unsigned char* KT = lds + L_ST; LAS unsigned char* VT = lds + L_VT;
    const size_t ztok = (size_t)(n * CH + lane) * ZW;
    const float li = bf2f(C.Z[ztok + ZC_MI + h]) + C.b_i[h];
    const float lf = log_sigmoid_f(bf2f(C.Z[ztok + ZC_MF + h]) + C.b_f[h]);
    const float F = wave_scan_sum(lf, lane);
    const float Flast = shi(F, 63);
    const float Gv = Flast - F + li;
    const float g = wave_max(Gv, lane);
    const float wG = __expf(Gv - g);
    float k0[8], k1[8];
    conv_silu8(C.Z + ZC_MQK + 512 + h * 128 + 2 * c2, C.conv_w + 512 + h * 128 + 2 * c2, C.conv_b + 512 + h * 128 + 2 * c2, n * CH + 8 * tg, k0, k1);
    const float ks = 0.08838834764831845f;
    float p0 = 0.f, p1 = 0.f;
#pragma unroll
    for (int j = 0; j < 8; ++j) { const float wj = shi(wG, 8 * tg + j) * ks; k0[j] *= wj; k1[j] *= wj; p0 += k0[j]; p1 += k1[j]; }
    u32x4 lo, hi;
    lo.x = pk2(k0[0], k0[1]); lo.y = pk2(k0[2], k0[3]); lo.z = pk2(k0[4], k0[5]); lo.w = pk2(k0[6], k0[7]);
    hi.x = pk2(k1[0], k1[1]); hi.y = pk2(k1[2], k1[3]); hi.z = pk2(k1[4], k1[5]); hi.w = pk2(k1[6], k1[7]);
    *(LAS u32x4*)(KT + (2 * c2) * ROW72 + tg * 16) = lo; *(LAS u32x4*)(KT + (2 * c2 + 1) * ROW72 + tg * 16) = hi;
    *(LAS f32x2*)(PART + tg * 128 + 2 * c2) = (f32x2){p0, p1};
    fill_vT(C.Z + ZC_MV + h * 256, n, tg, lane, VT);
    if (tid == 0) { C.GG[h * NCH + n] = g; C.FL[h * NCH + n] = Flast; }
    __syncthreads();
    if (tid < 128) { float s = 0.f;
#pragma unroll
        for (int q = 0; q < 8; ++q) s += PART[q * 128 + tid];
        C.DN[(size_t)(h * NCH + n) * 128 + tid] = s; }
    state_mfma(VT, KT, C.DC + (size_t)(h * NCH + n) * 32768, tg, lane);
    __syncthreads();
}

DI void ml_B_unit(const MixCtx& C, LAS unsigned char* lds, int h, int n, int tid) {
    const int lane = tid & 63, w = __builtin_amdgcn_readfirstlane(tid >> 6), tg = w, c2 = lane, fr = lane & 15, fq = lane >> 4;
    LAS float* MF = (LAS float*)(lds + L_MISC); LAS float* MU = MF + 64; LAS float* MM = MF + 128; LAS float* MW = MF + 192;
    LAS float* DENP = MF + 256; LAS float* DQN = MF + 512; LAS float* NPV = MF + 576; LAS float* RS = (LAS float*)(lds + L_MISC + 4096);
    LAS unsigned char* CT = lds + L_ST; LAS unsigned char* VT = lds + L_VT; LAS unsigned char* QL = lds + L_Q; LAS unsigned char* KL = lds + L_K;
    copy_256x128(C.CP + (size_t)(h * NCH + n) * 32768, 128, CT, tid);
    if (w == 0) {
        const size_t ztok = (size_t)(n * CH + lane) * ZW;
        const float li = bf2f(C.Z[ztok + ZC_MI + h]) + C.b_i[h];
        const float lf = log_sigmoid_f(bf2f(C.Z[ztok + ZC_MF + h]) + C.b_f[h]);
        const float F = wave_scan_sum(lf, lane);
        const float u = li - F;
        const float pm = wave_scan_max(u, lane);
        const float mprev = C.MP[h * NCH + n];
        const float m = F + fmaxf(pm, mprev);
        MF[lane] = F; MU[lane] = u; MM[lane] = m; MW[lane] = __expf(F + mprev - m);
    }
    if (w == 1) { NPV[lane] = C.NP[(size_t)(h * NCH + n) * 128 + lane]; NPV[64 + lane] = C.NP[(size_t)(h * NCH + n) * 128 + 64 + lane]; }
    {
        float q0[8], q1[8], k0[8], k1[8];
        conv_silu8(C.Z + ZC_MQK + h * 128 + 2 * c2, C.conv_w + h * 128 + 2 * c2, C.conv_b + h * 128 + 2 * c2, n * CH + 8 * tg, q0, q1);
        conv_silu8(C.Z + ZC_MQK + 512 + h * 128 + 2 * c2, C.conv_w + 512 + h * 128 + 2 * c2, C.conv_b + 512 + h * 128 + 2 * c2, n * CH + 8 * tg, k0, k1);
        const float ks = 0.08838834764831845f;
#pragma unroll
        for (int j = 0; j < 8; ++j) { *(LAS unsigned*)(QL + (8 * tg + j) * ROW136 + 4 * c2) = pk2(q0[j], q1[j]); *(LAS unsigned*)(KL + (8 * tg + j) * ROW136 + 4 * c2) = pk2(k0[j] * ks, k1[j] * ks); }
    }
    fill_vT(C.Z + ZC_MV + h * 256, n, tg, lane, VT);
    __syncthreads();
    f32x4 sacc[2];
    score_mfma(QL, KL, w, lane, sacc);
    {
        const int t = tid >> 3, part = tid & 7; float s = 0.f;
#pragma unroll
        for (int e = 0; e < 8; ++e) { const unsigned qq = *(const LAS unsigned*)(QL + t * ROW136 + (16 * part + 2 * e) * 2); s += bflo(qq) * NPV[16 * part + 2 * e] + bfhi(qq) * NPV[16 * part + 2 * e + 1]; }
        s += shx(s, 1, lane); s += shx(s, 2, lane); s += shx(s, 4, lane);
        if (part == 0) DQN[t] = s;
    }
    __syncthreads();
    { const int mi = w >> 1, ni0 = 2 * (w & 1), t = 16 * mi + fr; const float ft = MF[t] - MM[t];
#pragma unroll
      for (int jn = 0; jn < 2; ++jn) { const int s0 = 16 * (ni0 + jn) + 4 * fq; f32x4 v = sacc[jn]; const f32x4 us = *(const LAS f32x4*)(MU + s0);
          float ps = 0.f;
#pragma unroll
          for (int r = 0; r < 4; ++r) { v[r] = (s0 + r > t) ? 0.f : v[r] * __expf(ft + us[r]); ps += v[r]; }
          ps += shx(ps, 16, lane); ps += shx(ps, 32, lane);
          if (fq == 0) DENP[t * 4 + ni0 + jn] = ps;
          *(LAS u32x2*)(KL + t * ROW72 + s0 * 2) = (u32x2){pk2(v[0], v[1]), pk2(v[2], v[3])}; } }
    __syncthreads();
    const int wr = w >> 1, wc = w & 1, t = 16 * wr + fr;
    f32x4 o1[8], o2[8];
#pragma unroll
    for (int ni = 0; ni < 8; ++ni) { o1[ni] = (f32x4){0.f, 0.f, 0.f, 0.f}; o2[ni] = o1[ni]; }
#pragma unroll
    for (int ks = 0; ks < 2; ++ks) { const bf16x8 a = *(const LAS bf16x8*)(KL + t * ROW72 + (32 * ks + 8 * fq) * 2);
#pragma unroll
        for (int ni = 0; ni < 8; ++ni) { const bf16x8 bb = *(const LAS bf16x8*)(VT + (128 * wc + 16 * ni + fr) * ROW72 + (32 * ks + 8 * fq) * 2); o1[ni] = mfma16(bb, a, o1[ni]); } }
#pragma unroll
    for (int ks = 0; ks < 4; ++ks) { const bf16x8 a = *(const LAS bf16x8*)(QL + t * ROW136 + (32 * ks + 8 * fq) * 2);
#pragma unroll
        for (int ni = 0; ni < 8; ++ni) { const bf16x8 bb = *(const LAS bf16x8*)(CT + (128 * wc + 16 * ni + fr) * ROW136 + (32 * ks + 8 * fq) * 2); o2[ni] = mfma16(bb, a, o2[ni]); } }
    const float wi = MW[t];
    const f32x4 dp = *(const LAS f32x4*)(DENP + t * 4);
    const float den = ((dp[0] + dp[1]) + (dp[2] + dp[3])) + wi * DQN[t];
    const float inv = 1.0f / fmaxf(fabsf(den), __expf(-MM[t]));
    const size_t tok = (size_t)(n * CH + t);
    float ss = 0.f;
#pragma unroll
    for (int ni = 0; ni < 8; ++ni) { const int dv = 128 * wc + 16 * ni + 4 * fq;
        const u32x2 mo = *(const u32x2*)(C.Z + tok * ZW + ZC_MO + h * 256 + dv);
        f32x4 v = (o1[ni] + o2[ni] * wi) * inv;
        v[0] *= sigmoid_f(bflo(mo.x)); v[1] *= sigmoid_f(bfhi(mo.x)); v[2] *= sigmoid_f(bflo(mo.y)); v[3] *= sigmoid_f(bfhi(mo.y));
        o1[ni] = v; ss += (v[0] * v[0] + v[1] * v[1]) + (v[2] * v[2] + v[3] * v[3]); }
    ss += shx(ss, 16, lane); ss += shx(ss, 32, lane);
    if (fq == 0) RS[wc * 64 + t] = ss;
    __syncthreads();
    const float rstd = 1.0f / sqrtf((RS[t] + RS[64 + t]) * (1.0f / 256.0f) + EPS);
#pragma unroll
    for (int ni = 0; ni < 8; ++ni) { const int dv = 128 * wc + 16 * ni + 4 * fq; const f32x4 gn = *(const f32x4*)(C.ml_norm + h * 256 + dv);
        const f32x4 v = o1[ni] * rstd * gn;
        *(u32x2*)(C.OB + tok * OBW + OB_O + 1024 + h * 256 + dv) = (u32x2){pk2(v[0], v[1]), pk2(v[2], v[3])}; }
    __syncthreads();
}

DI void scan_phase(const MixCtx& C, int tid) {
    const int NS = 2 * 65536;
    for (int slot = opaque_bx() * 512 + tid; slot < NS; slot += opaque_g() * 512) {
        const int br = slot >> 16, s = slot & 65535, h = s >> 14, dv = (s >> 6) & 255, dkp = s & 63;
        const size_t e0 = (size_t)h * NCH * 32768 + (size_t)dv * 128 + 2 * dkp;
        if (br == 0) {
            float s0 = 0.f, s1 = 0.f;
            for (int n0 = 0; n0 < NCH; n0 += 8) {
                f32x2 d[8], dec[8];
#pragma unroll
                for (int u = 0; u < 8; ++u) { const unsigned dw = *(const unsigned*)(C.DS + e0 + (size_t)(n0 + u) * 32768); d[u] = (f32x2){bflo(dw), bfhi(dw)}; dec[u] = *(const f32x2*)(C.DECAY + (size_t)(h * NCH + n0 + u) * 128 + 2 * dkp); }
#pragma unroll
                for (int u = 0; u < 8; ++u) { *(unsigned*)(C.SP + e0 + (size_t)(n0 + u) * 32768) = pk2(s0, s1); s0 = dec[u].x * s0 + d[u].x; s1 = dec[u].y * s1 + d[u].y; }
            }
        } else {
            float c0 = 0.f, c1 = 0.f, nn0 = 0.f, nn1 = 0.f, m = -1e30f;
            for (int n0 = 0; n0 < NCH; n0 += 8) {
                f32x2 d[8], dn[8]; float fl[8], gl[8];
#pragma unroll
                for (int u = 0; u < 8; ++u) { const unsigned dw = *(const unsigned*)(C.DC + e0 + (size_t)(n0 + u) * 32768); d[u] = (f32x2){bflo(dw), bfhi(dw)}; fl[u] = C.FL[h * NCH + n0 + u]; gl[u] = C.GG[h * NCH + n0 + u];
                    dn[u] = (dv == 0) ? *(const f32x2*)(C.DN + (size_t)(h * NCH + n0 + u) * 128 + 2 * dkp) : (f32x2){0.f, 0.f}; }
#pragma unroll
                for (int u = 0; u < 8; ++u) { *(unsigned*)(C.CP + e0 + (size_t)(n0 + u) * 32768) = pk2(c0, c1);
                    if (dv == 0) { *(f32x2*)(C.NP + (size_t)(h * NCH + n0 + u) * 128 + 2 * dkp) = (f32x2){nn0, nn1}; if (dkp == 0) C.MP[h * NCH + n0 + u] = m; }
                    const float mn = fmaxf(fl[u] + m, gl[u]); const float a = __expf(fl[u] + m - mn), bb = __expf(gl[u] - mn);
                    c0 = a * c0 + bb * d[u].x; c1 = a * c1 + bb * d[u].y; nn0 = a * nn0 + bb * dn[u].x; nn1 = a * nn1 + bb * dn[u].y; m = mn; }
            }
        }
    }
}

DI void mem_unit(const MixCtx& C, LAS unsigned char* lds, int h, int rb, int tid) {
    const int lane = tid & 63, w = __builtin_amdgcn_readfirstlane(tid >> 6), fr = lane & 15, fq = lane >> 4, wr = w >> 1, wc = w & 1, t = 16 * wr + fr;
    LAS unsigned char* QL = lds; LAS unsigned char* PL = lds + 33792; LAS unsigned char* KV = lds + 67584;
    LAS float* RMX = (LAS float*)(lds + L_MISC); LAS float* RSM = RMX + 128;
#pragma unroll
    for (int i = 0; i < 4; ++i) { const int id = tid + 512 * i, row = id >> 5, cc = id & 31;
        *(LAS u32x4*)(QL + row * ROW264 + cc * 16) = *(const u32x4*)(C.Z + (size_t)(rb * 64 + row) * ZW + ZC_XQ + h * 256 + cc * 8); }
    f32x4 s[8];
#pragma unroll
    for (int ni = 0; ni < 8; ++ni) s[ni] = (f32x4){0.f, 0.f, 0.f, 0.f};
#pragma unroll
    for (int half = 0; half < 2; ++half) {
        copy_256x128(C.KM + h * 256 + half * 128, 4096, KV, tid);
        __syncthreads();
#pragma unroll
        for (int ks = 0; ks < 4; ++ks) { const bf16x8 a = *(const LAS bf16x8*)(QL + t * ROW264 + (128 * half + 32 * ks + 8 * fq) * 2);
#pragma unroll
            for (int ni = 0; ni < 8; ++ni) { const bf16x8 bb = *(const LAS bf16x8*)(KV + (128 * wc + 16 * ni + fr) * ROW136 + (32 * ks + 8 * fq) * 2); s[ni] = mfma16(bb, a, s[ni]); } }
        __syncthreads();
    }
    float mx = -3.0e38f;
#pragma unroll
    for (int ni = 0; ni < 8; ++ni) { s[ni] = s[ni] * 0.0625f; mx = fmaxf(mx, fmaxf(fmaxf(s[ni][0], s[ni][1]), fmaxf(s[ni][2], s[ni][3]))); }
    mx = fmaxf(mx, shx(mx, 16, lane)); mx = fmaxf(mx, shx(mx, 32, lane));
    if (fq == 0) RMX[wc * 64 + t] = mx;
    copy_256x128(C.VMT + (size_t)(h * 256) * 256, 256, KV, tid);
    __syncthreads();
    mx = fmaxf(RMX[t], RMX[64 + t]);
    float sm = 0.f;
#pragma unroll
    for (int ni = 0; ni < 8; ++ni) {
#pragma unroll
        for (int r = 0; r < 4; ++r) { s[ni][r] = __expf(s[ni][r] - mx); sm += s[ni][r]; } }
    sm += shx(sm, 16, lane); sm += shx(sm, 32, lane);
    if (fq == 0) RSM[wc * 64 + t] = sm;
    __syncthreads();
    const float inv = 1.0f / (RSM[t] + RSM[64 + t]);
#pragma unroll
    for (int ni = 0; ni < 8; ++ni) { const f32x4 p = s[ni] * inv; *(LAS u32x2*)(PL + t * ROW264 + (128 * wc + 16 * ni + 4 * fq) * 2) = (u32x2){pk2(p[0], p[1]), pk2(p[2], p[3])}; }
    f32x4 o[8];
#pragma unroll
    for (int ni = 0; ni < 8; ++ni) o[ni] = (f32x4){0.f, 0.f, 0.f, 0.f};
#pragma unroll
    for (int half = 0; half < 2; ++half) {
        if (half == 1) copy_256x128(C.VMT + (size_t)(h * 256) * 256 + 128, 256, KV, tid);
        __syncthreads();
#pragma unroll
        for (int ks = 0; ks < 4; ++ks) { const bf16x8 a = *(const LAS bf16x8*)(PL + t * ROW264 + (128 * half + 32 * ks + 8 * fq) * 2);
#pragma unroll
            for (int ni = 0; ni < 8; ++ni) { const bf16x8 bb = *(const LAS bf16x8*)(KV + (128 * wc + 16 * ni + fr) * ROW136 + (32 * ks + 8 * fq) * 2); o[ni] = mfma16(bb, a, o[ni]); } }
        __syncthreads();
    }
    const size_t tok = (size_t)(rb * 64 + t);
#pragma unroll
    for (int ni = 0; ni < 8; ++ni) { const int d = 128 * wc + 16 * ni + 4 * fq; *(u32x2*)(C.OB + tok * OBW + OB_O + 2048 + h * 256 + d) = (u32x2){pk2(o[ni][0], o[ni][1]), pk2(o[ni][2], o[ni][3])}; }
}

#ifndef GEMM_ALIGN
#define GEMM_ALIGN true
#endif
#ifndef REP_PRO
#define REP_PRO 1
#endif
#ifndef REP_MIXA
#define REP_MIXA 1
#endif
#ifndef REP_SCAN
#define REP_SCAN 1
#endif
#ifndef REP_MIXB
#define REP_MIXB 1
#endif
#ifndef REP_FF1
#define REP_FF1 1
#endif
#ifndef REP_NORM
#define REP_NORM 1
#endif
#ifndef REP_GLAA
#define REP_GLAA 1
#endif
#ifndef REP_MEM
#define REP_MEM 1
#endif
#ifndef REP_GLAB
#define REP_GLAB 1
#endif
#ifndef REP_GATE
#define REP_GATE 1
#endif
#ifndef REP_BR
#define REP_BR 1
#endif
#ifndef GEMM_SP2
#define GEMM_SP2 true
#endif
constexpr int L_PTR = L_BARW + 256;
DI unsigned long long tab_ld(LAS unsigned char* lds, int k) {
    const unsigned long long v = *(volatile LAS unsigned long long*)(lds + L_PTR + 8 * k);
    const unsigned lo = __builtin_amdgcn_readfirstlane((unsigned)v), hi = __builtin_amdgcn_readfirstlane((unsigned)(v >> 32));
    return ((unsigned long long)hi << 32) | lo;
}
DI const float* tab_in(LAS unsigned char* lds, int k) { return (const float*)(const GAS float*)tab_ld(lds, k); }
DI unsigned char* tab_ws(LAS unsigned char* lds) { return (unsigned char*)(GAS unsigned char*)tab_ld(lds, 24); }
DI void grid_bar(LAS unsigned char* lds) {
    XcdBarrier b; b.bar = (unsigned*)(tab_ws(lds) + WS_CTL) + CW_BAR; b.x = xb_xcc_id(); b.st = (volatile LAS unsigned*)(lds + L_BARW);
    xcd_barrier(b);
}
DI void make_ctx(MixCtx& C, LAS unsigned char* lds, int l) {
    unsigned char* ws = tab_ws(lds);
    C.Z = (const bf16_t*)(ws + WS_Z); C.OB = (bf16_t*)(ws + WS_OB);
    C.wa = tab_in(lds, I_W_GLA_A) + (size_t)l * 16 * 512; C.ba = tab_in(lds, I_B_GLA_A) + l * 512; C.gla_norm = tab_in(lds, I_GLA_NORM) + l * 1024;
    C.conv_w = tab_in(lds, I_CONV_W) + (size_t)l * 4 * 1024; C.conv_b = tab_in(lds, I_CONV_B) + l * 1024; C.b_i = tab_in(lds, I_B_ML_I) + l * 4; C.b_f = tab_in(lds, I_B_ML_F) + l * 4; C.ml_norm = tab_in(lds, I_ML_NORM) + l * 1024;
    C.BG = (float*)(ws + WS_BG); C.DS = (bf16_t*)(ws + WS_DS); C.DC = (bf16_t*)(ws + WS_DC); C.SP = (bf16_t*)(ws + WS_SP); C.CP = (bf16_t*)(ws + WS_CP);
    C.DECAY = (float*)(ws + WS_SMALL + SM_DECAY); C.DN = (float*)(ws + WS_SMALL + SM_DN); C.NP = (float*)(ws + WS_SMALL + SM_NP);
    C.GG = (float*)(ws + WS_SMALL + SM_GG); C.FL = (float*)(ws + WS_SMALL + SM_FL); C.MP = (float*)(ws + WS_SMALL + SM_MP);
    C.KM = (const bf16_t*)(ws + WS_KM) + l * 1024; C.VMT = (const bf16_t*)(ws + WS_VMT) + (size_t)l * 1024 * 256;
}

__global__ void __launch_bounds__(512, 2) trunk_fwd(Params p) {
    extern __shared__ __attribute__((aligned(16))) unsigned char lds_raw[];
    LAS unsigned char* lds0 = (LAS unsigned char*)lds_raw;
    {
        LAS unsigned char* lds = lds0;
        const int tid0 = threadIdx.x;
        if (tid0 < 64) ((LAS unsigned*)(lds + L_BARW))[tid0] = 0u;
        if (tid0 < 23) *(LAS unsigned long long*)(lds + L_PTR + 8 * tid0) = (unsigned long long)p.in[tid0];
        if (tid0 == 23) *(LAS unsigned long long*)(lds + L_PTR + 8 * 23) = (unsigned long long)p.out;
        if (tid0 == 24) *(LAS unsigned long long*)(lds + L_PTR + 8 * 24) = (unsigned long long)p.ws;
        __syncthreads();
        (void)xcd_barrier_post((unsigned*)(p.ws + WS_CTL) + CW_BAR, (volatile LAS unsigned*)(lds + L_BARW));
    }
#define TID (opaque_tid())
#define LANE (opaque_tid() & 63)
#define WAVE (__builtin_amdgcn_readfirstlane(opaque_tid() >> 6))
#define GW (opaque_bx() * NWAVES + WAVE)
#define NGW (opaque_g() * NWAVES)

    for (int rep = 0; rep < REP_PRO; ++rep) {
        LAS unsigned char* lds = opaque_lds(lds0); unsigned char* ws = tab_ws(lds);
        bf16_t* WIN = (bf16_t*)(ws + WS_WIN);
        const int lane = LANE, wave = WAVE;
        LAS float* scr = (LAS float*)(lds + wave * 16640);
        constexpr int IT_IN = 64 * 117, IT_BR = 16 * 64, IT_G = 4 * 64, IT_OUT = 64 * 64, IT_F1 = 64 * 256, IT_F2 = 256 * 64, IT_MK = 64 * 16;
        constexpr int E_IN = 4 * IT_IN, E_BR = E_IN + 12 * IT_BR, E_G = E_BR + 12 * IT_G, E_OUT = E_G + 4 * IT_OUT, E_F1 = E_OUT + 4 * IT_F1, E_F2 = E_F1 + 4 * IT_F2, E_MK = E_F2 + 4 * IT_MK, E_MV = E_MK + 4 * IT_MK;
        for (int it = GW; it < E_MV; it += NGW) {
            if (it < E_IN) { const int l = it / IT_IN, r = it - l * IT_IN; transpose_item(tab_in(lds, I_W_IN) + (size_t)l * DM * IN_W, DM, IN_W, WIN + (size_t)l * ZW * DM, DM, 0, 0, true, scr, r, lane, tab_in(lds, I_NORM_MIX) + l * DM); }
            else if (it < E_BR) { const int q = it - E_IN, lj = q / IT_BR, r = q - lj * IT_BR, l = lj / 3, j = lj - 3 * l; transpose_item(tab_in(lds, I_W_BRANCH) + (size_t)lj * 1024 * DM, 1024, DM, (bf16_t*)(ws + WS_WBR) + (size_t)l * DM * OBW, OBW, OB_O + j * 1024, 0, false, scr, r, lane); }
            else if (it < E_G) { const int q = it - E_BR, lj = q / IT_G, r = q - lj * IT_G, l = lj / 3, j = lj - 3 * l; transpose_item(tab_in(lds, I_W_GATE) + (size_t)lj * 256 * DM, 256, DM, (bf16_t*)(ws + WS_WBR) + (size_t)l * DM * OBW, OBW, j * 256, 0, false, scr, r, lane); }
            else if (it < E_OUT) { const int q = it - E_G, l = q / IT_OUT, r = q - l * IT_OUT; transpose_item(tab_in(lds, I_W_OUT) + (size_t)l * DM * DM, DM, DM, (bf16_t*)(ws + WS_WOUT) + (size_t)l * DM * DM, DM, 0, 0, false, scr, r, lane); }
            else if (it < E_F1) { const int q = it - E_OUT, l = q / IT_F1, r = q - l * IT_F1; transpose_item(tab_in(lds, I_W_FF1) + (size_t)l * DM * DFF, DM, DFF, (bf16_t*)(ws + WS_W1) + (size_t)l * DFF * DM, DM, 0, 0, false, scr, r, lane, tab_in(lds, I_NORM_FFN) + l * DM); }
            else if (it < E_F2) { const int q = it - E_F1, l = q / IT_F2, r = q - l * IT_F2; transpose_item(tab_in(lds, I_W_FF2) + (size_t)l * DFF * DM, DFF, DM, (bf16_t*)(ws + WS_W2) + (size_t)l * DM * DFF, DFF, 0, 0, false, scr, r, lane); }
            else if (it < E_MK) { const int q = it - E_F2, l = q / IT_MK, r = q - l * IT_MK; transpose_item(tab_in(lds, I_W_MEM_K) + (size_t)l * DM * 1024, DM, 1024, (bf16_t*)(ws + WS_WMK), DM, 0, l * 1024, false, scr, r, lane); }
            else { const int q = it - E_MK, l = q / IT_MK, r = q - l * IT_MK; transpose_item(tab_in(lds, I_W_MEM_V) + (size_t)l * DM * 1024, DM, 1024, (bf16_t*)(ws + WS_WMV), DM, 0, l * 1024, false, scr, r, lane); }
        }
        constexpr int PADCH = (ZW - IN_W) * DM / 8;
        for (int i = opaque_bx() * 512 + TID; i < NL * PADCH; i += opaque_g() * 512) { const int l = i / PADCH, r = i - l * PADCH; *(u32x4*)(WIN + (size_t)l * ZW * DM + (size_t)IN_W * DM + (size_t)r * 8) = (u32x4){0u, 0u, 0u, 0u}; }
        for (int m = GW; m < SEQ; m += NGW) row_bf16_ss(tab_in(lds, I_X) + (size_t)m * DM, (bf16_t*)(ws + WS_H) + (size_t)m * DM, (u64_t*)(ws + WS_SS) + m, lane);
        for (int m = GW; m < MEML; m += NGW) rmsnorm_row<false>(tab_in(lds, I_MEM) + (size_t)m * DM, tab_in(lds, I_MEM_NORM), (bf16_t*)(ws + WS_MEMN) + (size_t)m * DM, lane);
    }
    grid_bar(opaque_lds(lds0));
    {
        LAS unsigned char* lds = opaque_lds(lds0); unsigned char* ws = tab_ws(lds);
        { pg8::Gemm g{(const bf16_t*)(ws + WS_MEMN), (const bf16_t*)(ws + WS_WMK), opq(MEML), opq(DM), opq(DM), opq(DM), opq(DM)}; pg8::StaticOrder S; S.init(opq(MEML), opq(DM), opaque_g(), opaque_bx()); pg8::EpiBf16<0> E{(bf16_t*)(ws + WS_KM), DM, nullptr, nullptr, nullptr, 0, -1};
          pg8::gemm_phase<pg8::EpiBf16<0>, pg8::StaticOrder, GEMM_ALIGN, GEMM_SP2>(lds, g, S, E); }
    }
    {
        LAS unsigned char* lds = opaque_lds(lds0); unsigned char* ws = tab_ws(lds);
        { pg8::Gemm g{(const bf16_t*)(ws + WS_WMV), (const bf16_t*)(ws + WS_MEMN), opq(DM), opq(MEML), opq(DM), opq(DM), opq(DM)}; pg8::StaticOrder S; S.init(opq(DM), opq(MEML), opaque_g(), (opaque_bx() + 16) % opaque_g()); pg8::EpiBf16<0> E{(bf16_t*)(ws + WS_VMT), MEML, nullptr, nullptr, nullptr, 0, -1};
          pg8::gemm_phase<pg8::EpiBf16<0>, pg8::StaticOrder, GEMM_ALIGN, GEMM_SP2>(lds, g, S, E); }
    }
    grid_bar(opaque_lds(lds0));

    for (int l = 0; l < NL; ++l) {
        {
            LAS unsigned char* lds = opaque_lds(lds0); unsigned char* ws = tab_ws(lds);
            pg8::Gemm g{(const bf16_t*)(ws + WS_H), (const bf16_t*)(ws + WS_WIN) + (size_t)l * ZW * DM, opq(SEQ), opq(ZW), opq(DM), opq(DM), opq(DM)}; pg8::StaticOrder S; S.init(opq(SEQ), opq(ZW), opaque_g(), opaque_bx()); pg8::EpiBf16<0> E{(bf16_t*)(ws + WS_Z), ZW, nullptr, (const u64_t*)(ws + WS_SS) + (size_t)(2 * l) * SEQ, (bf16_t*)(ws + WS_OB), OBW, ZC_GATE / 256};
            pg8::gemm_phase<pg8::EpiBf16<0>, pg8::StaticOrder, GEMM_ALIGN, GEMM_SP2>(lds, g, S, E);
        }
        grid_bar(opaque_lds(lds0));
        {
            LAS unsigned char* lds = opaque_lds(lds0); MixCtx C; make_ctx(C, lds, l); const int tid = TID;
            for (int rep = 0; rep < REP_MIXA; ++rep) {
            for (int r2 = 0; r2 < REP_GLAA; ++r2) for (int i = opaque_bx(); i < 4 * NCH; i += opaque_g()) gla_A_unit(C, lds, i >> 8, i & 255, tid);
            for (int i = opaque_bx(); i < 4 * NCH; i += opaque_g()) ml_A_unit(C, lds, i >> 8, i & 255, tid);
            for (int r2 = 0; r2 < REP_MEM; ++r2) for (int i = opaque_bx(); i < 4 * NCH; i += opaque_g()) mem_unit(C, lds, i >> 8, i & 255, tid);
            }
        }
        grid_bar(opaque_lds(lds0));
        { LAS unsigned char* lds = opaque_lds(lds0); MixCtx C; make_ctx(C, lds, l); for (int rep = 0; rep < REP_SCAN; ++rep) scan_phase(C, TID); }
        grid_bar(opaque_lds(lds0));
        {
            LAS unsigned char* lds = opaque_lds(lds0); MixCtx C; make_ctx(C, lds, l); const int tid = TID;
            for (int rep = 0; rep < REP_MIXB; ++rep) {
            for (int r2 = 0; r2 < REP_GLAB; ++r2) for (int i = opaque_bx(); i < 4 * NCH; i += opaque_g()) gla_B_unit(C, lds, i >> 8, i & 255, tid);
            for (int i = opaque_bx(); i < 4 * NCH; i += opaque_g()) ml_B_unit(C, lds, i >> 8, i & 255, tid);
            }
        }
        grid_bar(opaque_lds(lds0));
        for (int rep = 0; rep < REP_BR; ++rep) {
            LAS unsigned char* lds = opaque_lds(lds0); unsigned char* ws = tab_ws(lds);
            pg8::Gemm g{(const bf16_t*)(ws + WS_OB), (const bf16_t*)(ws + WS_WBR) + (size_t)l * DM * OBW, opq(SEQ), opq(DM), opq(OBW), opq(OBW), opq(OBW)}; pg8::BranchOrder S; S.init(opq(SEQ), opq(DM), opaque_g(), opaque_bx()); pg8::EpiBranch E{(bf16_t*)(ws + WS_Y), DM, (bf16_t*)(ws + WS_GT), tab_in(lds, I_B_GATE) + (size_t)l * GTW};
            pg8::gemm_phase<pg8::EpiBranch, pg8::BranchOrder, GEMM_ALIGN, GEMM_SP2>(lds, g, S, E);
        }
        grid_bar(opaque_lds(lds0));
        {
            LAS unsigned char* lds = opaque_lds(lds0); unsigned char* ws = tab_ws(lds);
            const float* Xin = (l == 0) ? tab_in(lds, I_X) : (const float*)(ws + WS_X);
            pg8::Gemm g{(const bf16_t*)(ws + WS_Y), (const bf16_t*)(ws + WS_WOUT) + (size_t)l * DM * DM, opq(SEQ), opq(DM), opq(DM), opq(DM), opq(DM)}; pg8::StaticOrder S; S.init(opq(SEQ), opq(DM), opaque_g(), opaque_bx()); pg8::EpiResid E{Xin, (float*)(ws + WS_X), DM, (bf16_t*)(ws + WS_H), (u64_t*)(ws + WS_SS) + (size_t)(2 * l + 1) * SEQ};
            pg8::gemm_phase<pg8::EpiResid, pg8::StaticOrder, GEMM_ALIGN, GEMM_SP2>(lds, g, S, E);
        }
        grid_bar(opaque_lds(lds0));
        for (int rep = 0; rep < REP_FF1; ++rep) {
            LAS unsigned char* lds = opaque_lds(lds0); unsigned char* ws = tab_ws(lds);
            pg8::Gemm g{(const bf16_t*)(ws + WS_H), (const bf16_t*)(ws + WS_W1) + (size_t)l * DFF * DM, opq(SEQ), opq(DFF), opq(DM), opq(DM), opq(DM)}; pg8::StaticOrder S; S.init(opq(SEQ), opq(DFF), opaque_g(), opaque_bx()); pg8::EpiBf16<1> E{(bf16_t*)(ws + WS_U), DFF, nullptr, (const u64_t*)(ws + WS_SS) + (size_t)(2 * l + 1) * SEQ, nullptr, 0, -1};
            pg8::gemm_phase<pg8::EpiBf16<1>, pg8::StaticOrder, GEMM_ALIGN, GEMM_SP2>(lds, g, S, E);
        }
        grid_bar(opaque_lds(lds0));
        {
            LAS unsigned char* lds = opaque_lds(lds0); unsigned char* ws = tab_ws(lds);
            pg8::Gemm g{(const bf16_t*)(ws + WS_U), (const bf16_t*)(ws + WS_W2) + (size_t)l * DM * DFF, opq(SEQ), opq(DM), opq(DFF), opq(DFF), opq(DFF)}; pg8::StaticOrder S; S.init(opq(SEQ), opq(DM), opaque_g(), opaque_bx()); pg8::EpiResid E{(const float*)(ws + WS_X), (float*)(ws + WS_X), DM, (bf16_t*)(ws + WS_H), (u64_t*)(ws + WS_SS) + (size_t)(2 * l + 2) * SEQ};
            pg8::gemm_phase<pg8::EpiResid, pg8::StaticOrder, GEMM_ALIGN, GEMM_SP2>(lds, g, S, E);
        }
        grid_bar(opaque_lds(lds0));
    }
    {
        LAS unsigned char* lds = opaque_lds(lds0); unsigned char* ws = tab_ws(lds);
        const float* X = (const float*)(ws + WS_X); const float* gain = tab_in(lds, I_FINAL_NORM); float* out = (float*)(GAS float*)tab_ld(lds, 23); const int lane = LANE;
        const u64_t* ssf = (const u64_t*)(ws + WS_SS) + (size_t)8 * SEQ;
        for (int m = GW; m < SEQ; m += NGW) row_scale_f32(X + (size_t)m * DM, gain, ss_to_f(ssf[m]), out + (size_t)m * DM, lane);
    }
}

extern "C" void kernel_launch(void* const* d_in, const int* in_sizes, int n_in, void* d_out, int out_size, void* d_ws, size_t ws_size, hipStream_t stream) {
    static int grid = 0;
    if (grid == 0) {
        if (n_in != 23 || out_size != SEQ * DM || ws_size < WS_END) { fprintf(stderr, "kernel_launch: unexpected shapes (n_in %d out %d ws %zu, need %zu)\n", n_in, out_size, ws_size, (size_t)WS_END); grid = -1; return; }
        int dev = 0, cus = 0, per_cu = 0;
        if (hipGetDevice(&dev) != hipSuccess || hipDeviceGetAttribute(&cus, hipDeviceAttributeMultiprocessorCount, dev) != hipSuccess) { grid = -1; return; }
        if (hipFuncSetAttribute((const void*)trunk_fwd, hipFuncAttributeMaxDynamicSharedMemorySize, LDS_BYTES) != hipSuccess) { fprintf(stderr, "kernel_launch: hipFuncSetAttribute failed\n"); grid = -1; return; }
        if (hipOccupancyMaxActiveBlocksPerMultiprocessor(&per_cu, (const void*)trunk_fwd, 512, LDS_BYTES) != hipSuccess || per_cu < 1) { fprintf(stderr, "kernel_launch: occupancy query says %d\n", per_cu); (void)hipGetLastError(); }
        grid = cus;
    }
    if (grid < 0) return;
    if (hipMemsetAsync((char*)d_ws + WS_CTL, 0, CTL_ZERO_BYTES, stream) != hipSuccess) return;
    if (hipMemsetAsync((char*)d_ws + WS_SS, 0, SS_ZERO_BYTES, stream) != hipSuccess) return;
    Params p{};
    for (int i = 0; i < 23; ++i) p.in[i] = (const float*)d_in[i];
    p.out = (float*)d_out; p.ws = (unsigned char*)d_ws;
    hipLaunchKernelGGL(trunk_fwd, dim3(grid), dim3(512), LDS_BYTES, stream, p);
}
```

```cpp
#include <hip/hip_runtime.h>
#include <cstdio>
#include <cstdint>

#define DI __device__ __forceinline__
#define GAS __attribute__((address_space(1)))
#define LAS __attribute__((address_space(3)))
typedef unsigned short bf16_t;
typedef short bf16x8 __attribute__((ext_vector_type(8)));
typedef float f32x4 __attribute__((ext_vector_type(4)));
typedef float f32x2 __attribute__((ext_vector_type(2)));
typedef unsigned u32x4 __attribute__((ext_vector_type(4)));
typedef unsigned u32x2 __attribute__((ext_vector_type(2)));

constexpr int SEQ = 16384, DM = 4096, DFF = 16384, NL = 4, MEML = 256, CH = 64, NCH = SEQ / CH;
constexpr int IN_W = 7448, ZW = 7680;
constexpr int ZC_GQ = 0, ZC_GK = 512, ZC_GV = 1024, ZC_GG = 2048, ZC_MQK = 3072, ZC_MV = 4096, ZC_MO = 5120, ZC_XQ = 6144, ZC_GATE = 7168, ZC_GA = 7424, ZC_MI = 7440, ZC_MF = 7444;
constexpr int OBW = 3840, OB_O = 768;
constexpr int GTW = 12288;
constexpr float EPS = 1e-6f;

constexpr size_t MiB = 1u << 20;
constexpr size_t WS_CTL = 0, CTL_ZERO_BYTES = 1 * MiB;
constexpr size_t WS_WIN = 1 * MiB, WS_WBR = 241 * MiB, WS_WG = 337 * MiB, WS_WOUT = 361 * MiB, WS_W1 = 489 * MiB, WS_W2 = 1001 * MiB;
constexpr size_t WS_WMK = 1513 * MiB, WS_WMV = 1545 * MiB, WS_MEMN = 1577 * MiB, WS_KM = 1579 * MiB, WS_VMT = 1581 * MiB;
constexpr size_t WS_X = 1583 * MiB, WS_H = 1839 * MiB, WS_Z = 1967 * MiB, WS_GT = 2207 * MiB, WS_U = WS_Z  ;
constexpr size_t WS_OB = 2591 * MiB, WS_Y = 2711 * MiB, WS_DS = 2839 * MiB, WS_SP = 2967 * MiB, WS_DC = 3031 * MiB, WS_CP = 3159 * MiB;
constexpr size_t WS_SMALL = 3223 * MiB, WS_SS = 3225 * MiB, SS_ZERO_BYTES = 2 * MiB, WS_BG = 3227 * MiB, WS_END = 3259 * MiB;
static_assert(WS_OB + (size_t)SEQ * OBW * 2 <= WS_Y, "OB size");
constexpr size_t SM_DECAY = 0, SM_DN = 512 * 1024, SM_NP = 1024 * 1024, SM_GG = 1536 * 1024, SM_FL = 1536 * 1024 + 4096, SM_MP = 1536 * 1024 + 8192;
static_assert(WS_U + (size_t)SEQ * DFF * 2 <= WS_OB, "U overlay");
constexpr int CW_BAR = 4096;
static_assert(9 * (size_t)SEQ * 8 <= SS_ZERO_BYTES, "SS region");
typedef unsigned long long u64_t;
DI float ss_to_f(u64_t v) { return (float)v * (1.0f / 16777216.0f); }

constexpr int LDS_BYTES = 147456;
constexpr int L_ST = 0, L_VT = 69632, L_Q = 106496, L_K = 123904, L_MISC = 141312, L_BARW = 146432;
constexpr int ROW72 = 144, ROW136 = 272, ROW264 = 528;
constexpr int NWAVES = 8;

DI float bf2f(unsigned v) { return __uint_as_float(v << 16); }
DI float bflo(unsigned w) { return __uint_as_float(w << 16); }
DI float bfhi(unsigned w) { return __uint_as_float(w & 0xffff0000u); }
typedef __bf16 bf16x2_t __attribute__((ext_vector_type(2)));
DI unsigned pk2(float lo, float hi) { const f32x2 v = {lo, hi}; const bf16x2_t b = __builtin_convertvector(v, bf16x2_t); return __builtin_bit_cast(unsigned, b); }
DI float sigmoid_f(float x) { return __builtin_amdgcn_rcpf(1.0f + __expf(-x)); }
DI float silu_f(float x) { return x * sigmoid_f(x); }
DI float log_sigmoid_f(float x) { return fminf(x, 0.f) - __logf(1.0f + __expf(-fabsf(x))); }
DI float shx(float v, int o, int lane) { return __int_as_float(__builtin_amdgcn_ds_bpermute((lane ^ o) << 2, __float_as_int(v))); }
DI float shi(float v, int src) { return __int_as_float(__builtin_amdgcn_ds_bpermute(src << 2, __float_as_int(v))); }
DI float wave_sum(float v, int lane) {
#pragma unroll
    for (int o = 1; o < 64; o <<= 1) v += shx(v, o, lane);
    return v;
}
DI float wave_max(float v, int lane) {
#pragma unroll
    for (int o = 1; o < 64; o <<= 1) v = fmaxf(v, shx(v, o, lane));
    return v;
}
DI float wave_scan_sum(float v, int lane) {
#pragma unroll
    for (int o = 1; o < 64; o <<= 1) { const float t = shi(v, lane >= o ? lane - o : lane); if (lane >= o) v += t; }
    return v;
}
DI float wave_scan_max(float v, int lane) {
#pragma unroll
    for (int o = 1; o < 64; o <<= 1) { const float t = shi(v, lane >= o ? lane - o : lane); if (lane >= o) v = fmaxf(v, t); }
    return v;
}
DI f32x4 mfma16(bf16x8 a, bf16x8 b, f32x4 c) { return __builtin_amdgcn_mfma_f32_16x16x32_bf16(a, b, c, 0, 0, 0); }
DI int opaque_tid() { int t = (int)threadIdx.x; asm volatile("" : "+v"(t)); return t; }
DI int opaque_bx() { int b = (int)blockIdx.x; asm volatile("" : "+s"(b)); return b; }
DI LAS unsigned char* opaque_lds(LAS unsigned char* p) { asm volatile("" : "+s"(p)); return p; }
DI int opq(int v) { asm volatile("" : "+s"(v)); return v; }
DI int opaque_g() { int g = (int)gridDim.x; asm volatile("" : "+s"(g)); return g; }

namespace pg8 {
#define PG8_LAS __attribute__((address_space(3)))
constexpr int BM = 256, BK = 64, HALF = 128, HTB = HALF * BK * 2  , STAGE_BYTES = 8 * HTB, NXCD = 8;
#ifndef PG8_WGM
#define PG8_WGM 4
#endif
constexpr int WGM = PG8_WGM;

__host__ __device__ __forceinline__ int lds_byte(int r, int c) { const int st = (r >> 4) * 2 + (c >> 5), rr = r & 15, cc = c & 31, ob = rr * 64 + cc * 2; return st * 1024 + (ob ^ (((ob >> 9) & 1) << 5)); }
__host__ __device__ __forceinline__ void stage_rc(int b, int& R, int& C) { const int st = b / 1024, sb = b % 1024, swz = sb ^ (((sb >> 9) & 1) << 5); R = (st >> 1) * 16 + swz / 64; C = (st & 1) * 32 + (swz % 64) / 2; }
__host__ __device__ __forceinline__ int perm32(int rho) { const int n = rho >> 4, i = rho & 15; return 8 * (i >> 2) + 4 * n + (i & 3); }

struct Unit { int pm, pn, kind; };
struct Gemm { const bf16_t* A; const bf16_t* Bt; int M, N, K, lda, ldb; };

struct StaticOrder {
    int nM, nN, nwg, G, c, wgm;
    __host__ __device__ void init(int M, int N, int G_, int c_, int wgm_ = WGM) { nM = M / BM; nN = N / BM; nwg = nM * nN; G = G_; c = c_; wgm = wgm_; }
    __host__ __device__ bool next(int i, Unit& u) const {
        const long L = (long)i * G + c; if (L >= nwg) return false;
        int wgid = (int)L; { const int q = nwg / NXCD, r = nwg % NXCD, xcd = wgid % NXCD, off = wgid / NXCD; wgid = (xcd < r ? xcd * (q + 1) : r * (q + 1) + (xcd - r) * q) + off; }
        const int nig = wgm * nN, gid = wgid / nig, fm = gid * wgm, gsz = (nM - fm) < wgm ? (nM - fm) : wgm;
        u.pm = fm + ((wgid % nig) % gsz); u.pn = (wgid % nig) / gsz; u.kind = 0; return true;
    }
    __device__ __forceinline__ void a_ready(const Unit&) const {}
    __device__ __forceinline__ void done(const Unit&) const {}
    __device__ __forceinline__ int nt(const Unit&, int nt_default) const { return nt_default; }
    __device__ __forceinline__ int koff(const Unit&) const { return 0; }
};
struct BranchOrder : StaticOrder {
    __host__ __device__ bool next(int i, Unit& u) const { if (!StaticOrder::next(i >> 2, u)) return false; u.kind = i & 3; return true; }
    __device__ __forceinline__ int nt(const Unit& u, int) const { return u.kind < 3 ? 4 : 48; }
    __device__ __forceinline__ int koff(const Unit& u) const { return u.kind < 3 ? 256 * u.kind : 768; }
};

template <int ACT  > struct EpiBf16 {
    static constexpr bool PERM = true, AFTER_DRAIN = false, HOOK = false;
    bf16_t* O; int ldc; const float* bias; const unsigned long long* ss; bf16_t* O2; int ld2, pn2;
    __device__ __forceinline__ void operator()(const f32x4 (&acc)[2][2][4][2], const Unit& u, int wr, int wc, int fr, int fq) const {
        const int row0 = u.pm * BM + wr * 64 + fr, col0 = u.pn * BM + wc * 32 + 8 * fq;
        f32x4 bv[2][2];
#pragma unroll
        for (int bj = 0; bj < 2; ++bj)
#pragma unroll
            for (int n = 0; n < 2; ++n) bv[bj][n] = (ACT == 2) ? *(const f32x4*)(bias + col0 + bj * HALF + 4 * n) : (f32x4){0.f, 0.f, 0.f, 0.f};
#pragma unroll
        for (int ai = 0; ai < 2; ++ai)
#pragma unroll
            for (int m = 0; m < 4; ++m) { bf16_t* rowp = O + (size_t)(row0 + ai * HALF + m * 16) * ldc + col0;
                const bool redir = (ACT == 0) && O2 != nullptr && u.pn == pn2;
                if (redir) rowp = O2 + (size_t)(row0 + ai * HALF + m * 16) * ld2 + (col0 - u.pn * BM);
                float rs = 1.f; if (ACT != 2) { if (ss) rs = 1.0f / sqrtf((float)ss[row0 + ai * HALF + m * 16] * (1.0f / 16777216.0f) * (1.0f / DM) + EPS); }
#pragma unroll
                for (int bj = 0; bj < 2; ++bj) { f32x4 v0 = acc[ai][bj][m][0], v1 = acc[ai][bj][m][1];
                    if (ACT != 2) { v0 = v0 * rs; v1 = v1 * rs; }
                    if (ACT == 1) {
#pragma unroll
                        for (int j = 0; j < 4; ++j) { const float a = fmaxf(v0[j], 0.f), b = fmaxf(v1[j], 0.f); v0[j] = a * a; v1[j] = b * b; } }
                    if (ACT == 2) { v0 = v0 + bv[bj][0]; v1 = v1 + bv[bj][1];
#pragma unroll
                        for (int j = 0; j < 4; ++j) { v0[j] = sigmoid_f(fminf(fmaxf(v0[j], -30.f), 30.f)); v1[j] = sigmoid_f(fminf(fmaxf(v1[j], -30.f), 30.f)); } }
                    u32x4 w; w.x = pk2(v0[0], v0[1]); w.y = pk2(v0[2], v0[3]); w.z = pk2(v1[0], v1[1]); w.w = pk2(v1[2], v1[3]);
                    *(u32x4*)(rowp + bj * HALF) = w;
                    if (redir) { *(u32x4*)(rowp + bj * HALF + 256) = w; *(u32x4*)(rowp + bj * HALF + 512) = w; } } }
    }
    __device__ __forceinline__ bool hook_at(const Unit&, int) const { return false; }
    __device__ __forceinline__ void hook(f32x4 (&)[2][2][4][2], const Unit&, int, int, int, int, int) const {}
};
struct EpiResid {
    static constexpr bool PERM = true, AFTER_DRAIN = false, HOOK = false;
    const float* in; float* out; int ldc; bf16_t* xb; unsigned long long* ss;
    __device__ __forceinline__ void operator()(const f32x4 (&acc)[2][2][4][2], const Unit& u, int wr, int wc, int fr, int fq) const {
        const int row0 = u.pm * BM + wr * 64 + fr, col0 = u.pn * BM + wc * 32 + 8 * fq, lane = fq * 16 + fr;
#pragma unroll
        for (int ai = 0; ai < 2; ++ai) {
            f32x4 r[4][2][2];
#pragma unroll
            for (int m = 0; m < 4; ++m) { const size_t off = (size_t)(row0 + ai * HALF + m * 16) * ldc + col0;
#pragma unroll
                for (int bj = 0; bj < 2; ++bj)
#pragma unroll
                    for (int n = 0; n < 2; ++n) r[m][bj][n] = *(const f32x4*)(in + off + bj * HALF + n * 4); }
#pragma unroll
            for (int m = 0; m < 4; ++m) { const int row = row0 + ai * HALF + m * 16; const size_t off = (size_t)row * ldc + col0;
                float sq = 0.f;
#pragma unroll
                for (int bj = 0; bj < 2; ++bj) { const f32x4 o0 = r[m][bj][0] + acc[ai][bj][m][0], o1 = r[m][bj][1] + acc[ai][bj][m][1];
                    *(f32x4*)(out + off + bj * HALF) = o0; *(f32x4*)(out + off + bj * HALF + 4) = o1;
                    sq += (o0[0] * o0[0] + o0[1] * o0[1]) + (o0[2] * o0[2] + o0[3] * o0[3]) + (o1[0] * o1[0] + o1[1] * o1[1]) + (o1[2] * o1[2] + o1[3] * o1[3]);
                    u32x4 w; w.x = pk2(o0[0], o0[1]); w.y = pk2(o0[2], o0[3]); w.z = pk2(o1[0], o1[1]); w.w = pk2(o1[2], o1[3]);
                    *(u32x4*)(xb + off + bj * HALF) = w; }
                sq += shx(sq, 16, lane); sq += shx(sq, 32, lane);
                if (fq == 0) (void)__hip_atomic_fetch_add(ss + row, (unsigned long long)(sq * 16777216.0f), __ATOMIC_RELAXED, __HIP_MEMORY_SCOPE_AGENT); }
            asm volatile("" ::: "memory"); }
    }
    __device__ __forceinline__ bool hook_at(const Unit&, int) const { return false; }
    __device__ __forceinline__ void hook(f32x4 (&)[2][2][4][2], const Unit&, int, int, int, int, int) const {}
};
struct EpiBranch {
    static constexpr bool PERM = true, AFTER_DRAIN = false, HOOK = true;
    bf16_t* O; int ldc; bf16_t* GT; const float* bias;
    __device__ __forceinline__ bool hook_at(const Unit& u, int t) const { return u.kind == 3 && (t == 16 || t == 32); }
    __device__ __forceinline__ void hook(f32x4 (&acc)[2][2][4][2], const Unit& u, int t, int, int, int, int) const {
        const int tid_ = opaque_tid(), wid_ = tid_ >> 6, wr = wid_ >> 2, wc = wid_ & 3, fr = tid_ & 15, fq = (tid_ >> 4) & 3;
        const int row0 = u.pm * BM + wr * 64 + fr, col0 = u.pn * BM + wc * 32 + 8 * fq;
        const bf16_t* ga = GT + (size_t)(t == 16 ? 0 : DM); const bf16_t* gb = ga + DM;
#pragma unroll
        for (int ai = 0; ai < 2; ++ai) {
            u32x4 a[4][2], b[4][2];
#pragma unroll
            for (int m = 0; m < 4; ++m) { const size_t off = (size_t)(row0 + ai * HALF + m * 16) * GTW + col0;
#pragma unroll
                for (int bj = 0; bj < 2; ++bj) { a[m][bj] = *(const u32x4*)(ga + off + bj * HALF); b[m][bj] = *(const u32x4*)(gb + off + bj * HALF); } }
#pragma unroll
            for (int m = 0; m < 4; ++m)
#pragma unroll
                for (int bj = 0; bj < 2; ++bj) { const u32x4 x = a[m][bj], y = b[m][bj];
                    f32x4 r0, r1;
                    r0[0] = bflo(y.x) * __builtin_amdgcn_rcpf(bflo(x.x)); r0[1] = bfhi(y.x) * __builtin_amdgcn_rcpf(bfhi(x.x));
                    r0[2] = bflo(y.y) * __builtin_amdgcn_rcpf(bflo(x.y)); r0[3] = bfhi(y.y) * __builtin_amdgcn_rcpf(bfhi(x.y));
                    r1[0] = bflo(y.z) * __builtin_amdgcn_rcpf(bflo(x.z)); r1[1] = bfhi(y.z) * __builtin_amdgcn_rcpf(bfhi(x.z));
                    r1[2] = bflo(y.w) * __builtin_amdgcn_rcpf(bflo(x.w)); r1[3] = bfhi(y.w) * __builtin_amdgcn_rcpf(bfhi(x.w));
                    acc[ai][bj][m][0] = acc[ai][bj][m][0] * r0; acc[ai][bj][m][1] = acc[ai][bj][m][1] * r1; }
            asm volatile("" ::: "memory"); }
    }
    __device__ __forceinline__ void operator()(const f32x4 (&acc)[2][2][4][2], const Unit& u, int wr, int wc, int fr, int fq) const {
        const int row0 = u.pm * BM + wr * 64 + fr, col0 = u.pn * BM + wc * 32 + 8 * fq;
        if (u.kind < 3) {
            bf16_t* gd = GT + (size_t)u.kind * DM; const float* bj_ = bias + (size_t)u.kind * DM + col0;
            f32x4 bv[2][2];
#pragma unroll
            for (int bj = 0; bj < 2; ++bj)
#pragma unroll
                for (int n = 0; n < 2; ++n) bv[bj][n] = *(const f32x4*)(bj_ + bj * HALF + 4 * n);
#pragma unroll
            for (int ai = 0; ai < 2; ++ai)
#pragma unroll
                for (int m = 0; m < 4; ++m) { const size_t off = (size_t)(row0 + ai * HALF + m * 16) * GTW + col0;
#pragma unroll
                    for (int bj = 0; bj < 2; ++bj) { f32x4 v0 = acc[ai][bj][m][0] + bv[bj][0], v1 = acc[ai][bj][m][1] + bv[bj][1];
#pragma unroll
                        for (int e = 0; e < 4; ++e) { v0[e] = 1.0f + __expf(-fminf(fmaxf(v0[e], -30.f), 30.f)); v1[e] = 1.0f + __expf(-fminf(fmaxf(v1[e], -30.f), 30.f)); }
                        u32x4 w; w.x = pk2(v0[0], v0[1]); w.y = pk2(v0[2], v0[3]); w.z = pk2(v1[0], v1[1]); w.w = pk2(v1[2], v1[3]);
                        *(u32x4*)(gd + off + bj * HALF) = w; } }
        } else {
            const bf16_t* gc = GT + 2 * DM;
            u32x4 g[2][4][2];
#pragma unroll
            for (int ai = 0; ai < 2; ++ai)
#pragma unroll
                for (int m = 0; m < 4; ++m)
#pragma unroll
                    for (int bj = 0; bj < 2; ++bj) g[ai][m][bj] = *(const u32x4*)(gc + (size_t)(row0 + ai * HALF + m * 16) * GTW + col0 + bj * HALF);
#pragma unroll
            for (int ai = 0; ai < 2; ++ai)
#pragma unroll
                for (int m = 0; m < 4; ++m) { const size_t r = (size_t)(row0 + ai * HALF + m * 16);
#pragma unroll
                    for (int bj = 0; bj < 2; ++bj) { const u32x4 gg = g[ai][m][bj];
                        const f32x4 v0 = acc[ai][bj][m][0], v1 = acc[ai][bj][m][1];
                        u32x4 w; w.x = pk2(v0[0] * __builtin_amdgcn_rcpf(bflo(gg.x)), v0[1] * __builtin_amdgcn_rcpf(bfhi(gg.x))); w.y = pk2(v0[2] * __builtin_amdgcn_rcpf(bflo(gg.y)), v0[3] * __builtin_amdgcn_rcpf(bfhi(gg.y)));
                        w.z = pk2(v1[0] * __builtin_amdgcn_rcpf(bflo(gg.z)), v1[1] * __builtin_amdgcn_rcpf(bfhi(gg.z))); w.w = pk2(v1[2] * __builtin_amdgcn_rcpf(bflo(gg.w)), v1[3] * __builtin_amdgcn_rcpf(bfhi(gg.w)));
                        *(u32x4*)(O + r * ldc + col0 + bj * HALF) = w; } }
        }
    }
};

template <class Epi, class Sched, bool ALIGN_EPI = false, bool SP2 = false>
__device__ __forceinline__ void gemm_phase(PG8_LAS unsigned char* lds, const Gemm g, const Sched& S, const Epi& E) {
    const int tid = opaque_tid(), wid = __builtin_amdgcn_readfirstlane(tid >> 6), lane = tid & 63, wr = wid >> 2, wc = wid & 3, fr = lane & 15, fq = lane >> 4;
    const int K = g.K, nt_default = K / BK;
    unsigned voffA[2], voffB[2];
#pragma unroll
    for (int i = 0; i < 2; ++i) { int R, C; stage_rc(tid * 16 + i * 8192, R, C); const int Rb = Epi::PERM ? ((R & ~31) + perm32(R & 31)) : R;
        voffA[i] = (unsigned)(R * g.lda + C) * 2u; voffB[i] = (unsigned)(Rb * g.ldb + C) * 2u; }
    const size_t kstep = (size_t)(BK * 2);
    const size_t hstepA = (size_t)HALF * g.lda * 2, hstepB = (size_t)HALF * g.ldb * 2;
    const size_t tstepA = 2 * hstepA, tstepB = 2 * hstepB;
    const unsigned ldsw = (unsigned)wid * 1024u;
    const int aoff = lds_byte(wr * 64 + fr, fq * 8), boff = lds_byte(wc * 32 + fr, fq * 8);
#define PG8_SA(b, h) (((b) * 2 + (h)) * HTB)
#define PG8_SB(b, h) ((4 + (b) * 2 + (h)) * HTB)
#define PG8_STAGE(bufoff, gbase, voff) do { _Pragma("unroll") for (int _i = 0; _i < 2; ++_i) \
        __builtin_amdgcn_global_load_lds((const unsigned*)((const char*)(gbase) + (voff)[_i]), (PG8_LAS unsigned*)(lds + (bufoff) + ldsw + _i * 8192), 16, 0, 0); } while (0)
#define PG8_LDA(dst, b, h) do { _Pragma("unroll") for (int m = 0; m < 4; ++m) _Pragma("unroll") for (int k = 0; k < 2; ++k) dst[m][k] = *(const PG8_LAS bf16x8*)(lds + PG8_SA(b, h) + aoff + m * 2048 + k * 1024); } while (0)
#define PG8_LDB(dst, b, h) do { _Pragma("unroll") for (int n = 0; n < 2; ++n) _Pragma("unroll") for (int k = 0; k < 2; ++k) dst[n][k] = *(const PG8_LAS bf16x8*)(lds + PG8_SB(b, h) + boff + n * 2048 + k * 1024); } while (0)
#ifndef PG8_PRIO
#define PG8_PRIO 1
#endif
#define PG8_MMA(ai, bj, At, Bt) do { if (PG8_PRIO) __builtin_amdgcn_s_setprio(PG8_PRIO); _Pragma("unroll") for (int m = 0; m < 4; ++m) _Pragma("unroll") for (int n = 0; n < 2; ++n) _Pragma("unroll") for (int k = 0; k < 2; ++k) \
        acc[ai][bj][m][n] = __builtin_amdgcn_mfma_f32_16x16x32_bf16(Bt[n][k], At[m][k], acc[ai][bj][m][n], 0, 0, 0); if (PG8_PRIO) __builtin_amdgcn_s_setprio(0); } while (0)
#define PG8_WAIT_V(n) asm volatile("s_waitcnt vmcnt(" #n ")" ::: "memory")
#define PG8_WAIT_L(n) asm volatile("s_waitcnt lgkmcnt(" #n ")" ::: "memory")
#define PG8_BAR __builtin_amdgcn_s_barrier()
#define PG8_SCHED __builtin_amdgcn_sched_barrier(0)
    Unit cur, nxt; int ui = 0;
    if (!S.next(0, cur)) return;
    f32x4 acc[2][2][4][2];
#pragma unroll
    for (int a = 0; a < 2; ++a)
#pragma unroll
        for (int b = 0; b < 2; ++b)
#pragma unroll
            for (int m = 0; m < 4; ++m)
#pragma unroll
                for (int n = 0; n < 2; ++n) acc[a][b][m][n] = (f32x4){0.f, 0.f, 0.f, 0.f};
    bf16x8 At[4][2], B0[2][2], B1[2][2];
    const char* cA = (const char*)g.A + (size_t)cur.pm * tstepA + (size_t)S.koff(cur) * 2; const char* cB = (const char*)g.Bt + (size_t)cur.pn * tstepB + (size_t)S.koff(cur) * 2;
    int nt = S.nt(cur, nt_default);
    S.a_ready(cur);
    if constexpr (SP2) {
        PG8_STAGE(PG8_SB(0, 0), cB, voffB); PG8_STAGE(PG8_SB(0, 1), cB + hstepB, voffB); PG8_STAGE(PG8_SA(0, 0), cA, voffA); PG8_STAGE(PG8_SA(0, 1), cA + hstepA, voffA);
        if (wr == 1) PG8_BAR;
        PG8_WAIT_V(2); PG8_BAR;
        PG8_STAGE(PG8_SB(1, 0), cB + kstep, voffB); PG8_STAGE(PG8_SA(1, 0), cA + kstep, voffA); PG8_STAGE(PG8_SB(1, 1), cB + hstepB + kstep, voffB);
        PG8_WAIT_V(6); PG8_BAR;
    } else {
        PG8_STAGE(PG8_SB(0, 0), cB, voffB); PG8_STAGE(PG8_SA(0, 0), cA, voffA); PG8_STAGE(PG8_SB(0, 1), cB + hstepB, voffB); PG8_STAGE(PG8_SA(0, 1), cA + hstepA, voffA);
        if (wr == 1) PG8_BAR;
        PG8_WAIT_V(4); PG8_BAR;
        PG8_STAGE(PG8_SB(1, 0), cB + kstep, voffB); PG8_STAGE(PG8_SA(1, 0), cA + kstep, voffA); PG8_STAGE(PG8_SB(1, 1), cB + hstepB + kstep, voffB);
        PG8_WAIT_V(6); PG8_BAR;
    }
    for (;;) {
        const bool has_next = S.next(ui + 1, nxt);
        const char* nA = has_next ? (const char*)g.A + (size_t)nxt.pm * tstepA + (size_t)S.koff(nxt) * 2 : cA; const char* nB = has_next ? (const char*)g.Bt + (size_t)nxt.pn * tstepB + (size_t)S.koff(nxt) * 2 : cB;
        for (int t = 0; t < nt; t += 2) {
            const bool last = (t == nt - 2);
            if constexpr (Epi::HOOK) { if (E.hook_at(cur, t)) E.hook(acc, cur, t, wr, wc, fr, fq); }
            const char* a1 = cA + (size_t)(t + 1) * kstep;
            const char* a2 = last ? nA : cA + (size_t)(t + 2) * kstep; const char* b2 = last ? nB : cB + (size_t)(t + 2) * kstep;
            const char* a3 = a2 + kstep; const char* b3 = b2 + kstep;
            if (last && has_next) S.a_ready(nxt);
            if constexpr (SP2) {
            PG8_LDB(B0, 0, 0); PG8_LDB(B1, 0, 1); PG8_SCHED; PG8_LDA(At, 0, 0); PG8_STAGE(PG8_SA(1, 1), a1 + hstepA, voffA);
            PG8_WAIT_V(8); PG8_WAIT_L(0); PG8_BAR; PG8_MMA(0, 0, At, B0); PG8_MMA(0, 1, At, B1); PG8_BAR; PG8_SCHED;
            PG8_LDA(At, 0, 1); PG8_STAGE(PG8_SB(0, 0), b2, voffB); PG8_STAGE(PG8_SB(0, 1), b2 + hstepB, voffB); PG8_STAGE(PG8_SA(0, 0), a2, voffA);
            PG8_WAIT_V(8); PG8_WAIT_L(0); PG8_BAR; PG8_MMA(1, 0, At, B0); PG8_MMA(1, 1, At, B1); PG8_BAR; PG8_SCHED;
            PG8_LDB(B0, 1, 0); PG8_LDB(B1, 1, 1); PG8_SCHED; PG8_LDA(At, 1, 0); PG8_STAGE(PG8_SA(0, 1), a2 + hstepA, voffA);
            PG8_WAIT_V(8); PG8_WAIT_L(0); PG8_BAR; PG8_MMA(0, 0, At, B0); PG8_MMA(0, 1, At, B1); PG8_BAR; PG8_SCHED;
            PG8_LDA(At, 1, 1); PG8_STAGE(PG8_SB(1, 0), b3, voffB); PG8_STAGE(PG8_SB(1, 1), b3 + hstepB, voffB); PG8_STAGE(PG8_SA(1, 0), a3, voffA);
            PG8_WAIT_V(8); PG8_WAIT_L(0); PG8_BAR; PG8_MMA(1, 0, At, B0); PG8_MMA(1, 1, At, B1); PG8_BAR; PG8_SCHED;
            } else {
            PG8_LDB(B0, 0, 0); PG8_SCHED; PG8_LDA(At, 0, 0); PG8_STAGE(PG8_SA(1, 1), a1 + hstepA, voffA);
            PG8_WAIT_L(8); PG8_BAR; PG8_WAIT_L(0); PG8_MMA(0, 0, At, B0); PG8_BAR; PG8_SCHED;
            PG8_LDB(B1, 0, 1); PG8_STAGE(PG8_SB(0, 0), b2, voffB);
            PG8_BAR; PG8_WAIT_L(0); PG8_MMA(0, 1, At, B1); PG8_BAR;
            PG8_LDA(At, 0, 1); PG8_STAGE(PG8_SA(0, 0), a2, voffA);
            PG8_BAR; PG8_WAIT_L(0); PG8_MMA(1, 0, At, B0); PG8_BAR; PG8_SCHED;
            PG8_STAGE(PG8_SB(0, 1), b2 + hstepB, voffB);
            PG8_WAIT_V(6); PG8_BAR; PG8_MMA(1, 1, At, B1); PG8_BAR;
            PG8_LDB(B0, 1, 0); PG8_SCHED; PG8_LDA(At, 1, 0); PG8_STAGE(PG8_SA(0, 1), a2 + hstepA, voffA);
            PG8_WAIT_L(8); PG8_BAR; PG8_WAIT_L(0); PG8_MMA(0, 0, At, B0); PG8_BAR; PG8_SCHED;
            PG8_LDB(B1, 1, 1); PG8_STAGE(PG8_SB(1, 0), b3, voffB);
            PG8_BAR; PG8_WAIT_L(0); PG8_MMA(0, 1, At, B1); PG8_BAR;
            PG8_LDA(At, 1, 1); PG8_STAGE(PG8_SA(1, 0), a3, voffA);
            PG8_BAR; PG8_WAIT_L(0); PG8_MMA(1, 0, At, B0); PG8_BAR; PG8_SCHED;
            PG8_STAGE(PG8_SB(1, 1), b3 + hstepB, voffB);
            PG8_WAIT_V(6); PG8_BAR; PG8_MMA(1, 1, At, B1); PG8_BAR;
            }
        }
        if constexpr (ALIGN_EPI) { if (wr == 0) PG8_BAR; }
        E(acc, cur, wr, wc, fr, fq); S.done(cur);
        if (!has_next) break;
#pragma unroll
        for (int a = 0; a < 2; ++a)
#pragma unroll
            for (int b = 0; b < 2; ++b)
#pragma unroll
                for (int m = 0; m < 4; ++m)
#pragma unroll
                    for (int n = 0; n < 2; ++n) acc[a][b][m][n] = (f32x4){0.f, 0.f, 0.f, 0.f};
        cur = nxt; cA = nA; cB = nB; ++ui; nt = S.nt(cur, nt_default);
        if constexpr (ALIGN_EPI) { if (wr == 1) PG8_BAR; }
    }
    PG8_WAIT_V(0);
    if constexpr (!ALIGN_EPI) { if (wr == 0) PG8_BAR; }
    PG8_BAR;
#undef PG8_SA
#undef PG8_SB
#undef PG8_STAGE
#undef PG8_LDA
#undef PG8_LDB
#undef PG8_MMA
#undef PG8_WAIT_V
#undef PG8_WAIT_L
#undef PG8_BAR
#undef PG8_SCHED
}
}

#define XB_TMO      128
#define XB_XCNT(j)  (256  + 64 * (j))
#define XB_XSUB(j)  (1280 + 64 * (j))
#define XB_XGEN(j)  (2304 + 64 * (j))
#define XB_TOP      3328
#define XB_TOPGEN   3392
#define XCD_BAR_WORDS 3456
#define XB_SPIN_CAP (1u << 18)

__device__ __forceinline__ unsigned xb_ld(unsigned* p)              { return __hip_atomic_load(p, __ATOMIC_RELAXED, __HIP_MEMORY_SCOPE_AGENT); }
__device__ __forceinline__ unsigned xb_add(unsigned* p, unsigned v) { return __hip_atomic_fetch_add(p, v, __ATOMIC_RELAXED, __HIP_MEMORY_SCOPE_AGENT); }
__device__ __forceinline__ unsigned xb_xcc_id() { return (unsigned)__builtin_amdgcn_s_getreg((3 << 11) | 20) & 0xFu; }
#define XB_SPIN(cond, bar) do { unsigned _sp = 0; while (cond) { __builtin_amdgcn_s_sleep(1); \
    if ((++_sp & 255u) == 0u) { if (xb_ld(&(bar)[XB_TMO])) break; if (_sp > XB_SPIN_CAP) { atomicAdd(&(bar)[XB_TMO], 1u); break; } } } } while (0)

struct XcdBarrier {
    unsigned* bar; unsigned x;
    volatile LAS unsigned* st;
};
__device__ __forceinline__ XcdBarrier xcd_barrier_post(unsigned* bar, volatile LAS unsigned* st) {
    XcdBarrier b; b.bar = bar; b.x = xb_xcc_id(); b.st = st;
    if (threadIdx.x == 0) (void)xb_add(&bar[XB_XCNT(b.x)], 1u);
    return b;
}
__device__ __forceinline__ void xcd_barrier_complete(unsigned* bar, unsigned x, unsigned& nloc, unsigned& nx) {
    const unsigned G = gridDim.x * gridDim.y * gridDim.z;
    unsigned sum, cnt, mine, sp = 0u;
    for (;;) {
        sum = 0u; cnt = 0u; mine = 0u;
#pragma unroll
        for (unsigned j = 0; j < 16; ++j) { const unsigned c = xb_ld(&bar[XB_XCNT(j)]); sum += c; cnt += (c > 0u) ? 1u : 0u; mine = (j == x) ? c : mine; }
        if (sum == G) break;
        __builtin_amdgcn_s_sleep(1);
        if ((++sp & 255u) == 0u) { if (xb_ld(&bar[XB_TMO])) break; if (sp > XB_SPIN_CAP) { atomicAdd(&bar[XB_TMO], 1u); break; } }
    }
    nloc = mine > 0u ? mine : 1u; nx = cnt > 0u ? cnt : 1u;
}
__device__ __forceinline__ void xcd_barrier(const XcdBarrier& b) {
    asm volatile("s_waitcnt vmcnt(0)" ::: "memory");
    __syncthreads();
    if (threadIdx.x == 0) {
        unsigned* bar = b.bar;
        __builtin_amdgcn_s_waitcnt(0);
        unsigned nloc = b.st[0], nx = b.st[1];
        if (nloc == 0u) { xcd_barrier_complete(bar, b.x, nloc, nx); b.st[0] = nloc; b.st[1] = nx; }
        const unsigned old = xb_add(&bar[XB_XSUB(b.x)], 1u);
        const unsigned gen = old / nloc;
        if (old + 1u == (gen + 1u) * nloc) {
            __builtin_amdgcn_fence(__ATOMIC_RELEASE, "agent");
            asm volatile("s_waitcnt vmcnt(0)" ::: "memory");
            const unsigned og = xb_add(&bar[XB_TOP], 1u);
            const unsigned tg = og / nx;
            if (og + 1u == (tg + 1u) * nx) xb_add(&bar[XB_TOPGEN], 1u);
            else XB_SPIN(xb_ld(&bar[XB_TOPGEN]) == tg, bar);
            __builtin_amdgcn_fence(__ATOMIC_ACQUIRE, "agent");
            xb_add(&bar[XB_XGEN(b.x)], 1u);
            asm volatile("s_waitcnt vmcnt(0)" ::: "memory");
        } else {
            XB_SPIN(xb_ld(&bar[XB_XGEN(b.x)]) == gen, bar);
            __builtin_amdgcn_fence(__ATOMIC_ACQUIRE, "agent");
            asm volatile("s_waitcnt vmcnt(0)" ::: "memory");
        }
    }
    __syncthreads();
}

struct Params { const float* in[23]; float* out; unsigned char* ws; };
enum { I_X = 0, I_MEM, I_NORM_MIX, I_W_IN, I_W_GLA_A, I_B_GLA_A, I_GLA_NORM, I_CONV_W, I_CONV_B, I_B_ML_I, I_B_ML_F, I_ML_NORM, I_MEM_NORM, I_W_MEM_K, I_W_MEM_V, I_W_BRANCH, I_W_GATE, I_B_GATE, I_W_OUT, I_NORM_FFN, I_W_FF1, I_W_FF2, I_FINAL_NORM };

DI int win_row(int n) {
    if (n < 3072) return n;
    if (n < 3088) return ZC_GA + (n - 3072);
    if (n < 6160) return n - 16;
    if (n < 6168) return ZC_MI + (n - 6160);
    return n - 24;
}
DI void transpose_item(const float* __restrict__ W, int K, int N, bf16_t* __restrict__ WT, int ld_dst, int col_off, int row_off, bool remap, LAS float* scr, int item, int lane, const float* __restrict__ gain = nullptr) {
    const int nblk = (N + 63) >> 6, kb = item / nblk, nb = item - kb * nblk, k0 = kb << 6, n0 = nb << 6;
    const int a = lane & 15, q = lane >> 4, n4 = 4 * a;
    const bool ok = (n0 + n4) < N;
    f32x4 v[16];
#pragma unroll
    for (int i = 0; i < 16; ++i) { const int kk = 4 * i + q; v[i] = ok ? *(const f32x4*)(W + (size_t)(k0 + kk) * N + n0 + n4) : (f32x4){0.f, 0.f, 0.f, 0.f}; }
#pragma unroll
    for (int i = 0; i < 16; ++i) { const int kk = 4 * i + q;
#pragma unroll
        for (int e = 0; e < 4; ++e) scr[(n4 + e) * 65 + kk] = v[i][e]; }
    asm volatile("s_waitcnt lgkmcnt(0)" ::: "memory");
    const int c = lane & 7;
    f32x4 g0 = (f32x4){1.f, 1.f, 1.f, 1.f}, g1 = g0;
    if (gain) { g0 = *(const f32x4*)(gain + k0 + 8 * c); g1 = *(const f32x4*)(gain + k0 + 8 * c + 4); }
#pragma unroll
    for (int jj = 0; jj < 8; ++jj) { const int n = (lane >> 3) + 8 * jj; const LAS float* s = scr + n * 65 + 8 * c;
        u32x4 o; o.x = pk2(s[0] * g0[0], s[1] * g0[1]); o.y = pk2(s[2] * g0[2], s[3] * g0[3]); o.z = pk2(s[4] * g1[0], s[5] * g1[1]); o.w = pk2(s[6] * g1[2], s[7] * g1[3]);
        const int ng = n0 + n;
        if (ng < N) { const int row = row_off + (remap ? win_row(ng) : ng); *(u32x4*)(WT + (size_t)row * ld_dst + col_off + k0 + 8 * c) = o; } }
    asm volatile("s_waitcnt lgkmcnt(0)" ::: "memory");
}

template <bool OUT_F32> DI void rmsnorm_row(const float* __restrict__ xrow, const float* __restrict__ g, void* orow, int lane) {
    const f32x4* xr = (const f32x4*)xrow + lane; const f32x4* gr = (const f32x4*)g + lane;
    f32x4 v[16]; float s = 0.f;
#pragma unroll
    for (int j = 0; j < 16; ++j) { v[j] = xr[64 * j]; s += (v[j].x * v[j].x + v[j].y * v[j].y) + (v[j].z * v[j].z + v[j].w * v[j].w); }
    const float rstd = 1.0f / sqrtf(wave_sum(s, lane) * (1.0f / DM) + EPS);
#pragma unroll
    for (int j = 0; j < 16; ++j) { const f32x4 gg = gr[64 * j]; const f32x4 o = v[j] * rstd * gg;
        if (OUT_F32) ((f32x4*)orow)[lane + 64 * j] = o;
        else { u32x2 w; w.x = pk2(o.x, o.y); w.y = pk2(o.z, o.w); ((u32x2*)orow)[lane + 64 * j] = w; } }
}

DI void row_bf16_ss(const float* __restrict__ xrow, bf16_t* orow, unsigned long long* ss, int lane) {
    const f32x4* xr = (const f32x4*)xrow + lane; float s = 0.f;
#pragma unroll
    for (int j = 0; j < 16; ++j) { const f32x4 v = xr[64 * j]; s += (v.x * v.x + v.y * v.y) + (v.z * v.z + v.w * v.w);
        u32x2 w; w.x = pk2(v.x, v.y); w.y = pk2(v.z, v.w); ((u32x2*)orow)[lane + 64 * j] = w; }
    s = wave_sum(s, lane);
    if (lane == 0) *ss = (unsigned long long)(s * 16777216.0f);
}
DI void row_scale_f32(const float* __restrict__ xrow, const float* __restrict__ g, float ssv, float* orow, int lane) {
    const f32x4* xr = (const f32x4*)xrow + lane; const f32x4* gr = (const f32x4*)g + lane;
    const float rstd = 1.0f / sqrtf(ssv * (1.0f / DM) + EPS);
#pragma unroll
    for (int j = 0; j < 16; ++j) ((f32x4*)orow)[lane + 64 * j] = xr[64 * j] * rstd * gr[64 * j];
}

DI void fill_vT(const bf16_t* __restrict__ Zv, int n, int tg, int lane, LAS unsigned char* VT) {
#pragma unroll
    for (int i = 0; i < 2; ++i) { const int cp = lane + 64 * i; unsigned w[8];
#pragma unroll
        for (int j = 0; j < 8; ++j) w[j] = *(const unsigned*)(Zv + (size_t)(n * CH + 8 * tg + j) * ZW + 2 * cp);
        u32x4 lo, hi;
        lo.x = (w[0] & 0xffffu) | (w[1] << 16); lo.y = (w[2] & 0xffffu) | (w[3] << 16); lo.z = (w[4] & 0xffffu) | (w[5] << 16); lo.w = (w[6] & 0xffffu) | (w[7] << 16);
        hi.x = (w[0] >> 16) | (w[1] & 0xffff0000u); hi.y = (w[2] >> 16) | (w[3] & 0xffff0000u); hi.z = (w[4] >> 16) | (w[5] & 0xffff0000u); hi.w = (w[6] >> 16) | (w[7] & 0xffff0000u);
        *(LAS u32x4*)(VT + (2 * cp) * ROW72 + tg * 16) = lo; *(LAS u32x4*)(VT + (2 * cp + 1) * ROW72 + tg * 16) = hi; }
}
DI void state_mfma(const LAS unsigned char* VT, const LAS unsigned char* KT, bf16_t* __restrict__ OUT, int w, int lane) {
    const int fr = lane & 15, fq = lane >> 4;
    f32x4 acc[2][8];
#pragma unroll
    for (int mi = 0; mi < 2; ++mi)
#pragma unroll
        for (int ni = 0; ni < 8; ++ni) acc[mi][ni] = (f32x4){0.f, 0.f, 0.f, 0.f};
#pragma unroll
    for (int ks = 0; ks < 2; ++ks) {
        bf16x8 a[2];
#pragma unroll
        for (int mi = 0; mi < 2; ++mi) a[mi] = *(const LAS bf16x8*)(VT + (32 * w + 16 * mi + fr) * ROW72 + (32 * ks + 8 * fq) * 2);
#pragma unroll
        for (int ni = 0; ni < 8; ++ni) { const bf16x8 b = *(const LAS bf16x8*)(KT + (16 * ni + fr) * ROW72 + (32 * ks + 8 * fq) * 2);
#pragma unroll
            for (int mi = 0; mi < 2; ++mi) acc[mi][ni] = mfma16(b, a[mi], acc[mi][ni]); }
    }
#pragma unroll
    for (int mi = 0; mi < 2; ++mi)
#pragma unroll
        for (int ni = 0; ni < 8; ++ni) *(u32x2*)(OUT + (size_t)(32 * w + 16 * mi + fr) * 128 + 16 * ni + 4 * fq) = (u32x2){pk2(acc[mi][ni][0], acc[mi][ni][1]), pk2(acc[mi][ni][2], acc[mi][ni][3])};
}
DI void copy_256x128(const bf16_t* __restrict__ src, int gp, LAS unsigned char* dst, int tid) {
#pragma unroll
    for (int i = 0; i < 8; ++i) { const int id = tid + 512 * i, row = id >> 4, cc = id & 15;
        *(LAS u32x4*)(dst + row * ROW136 + cc * 16) = *(const u32x4*)(src + (size_t)row * gp + cc * 8); }
}

DI void ld_v(const bf16_t* __restrict__ Zv, int n, int tg, int lane, unsigned (&w)[2][8]) {
#pragma unroll
    for (int i = 0; i < 2; ++i)
#pragma unroll
        for (int j = 0; j < 8; ++j) w[i][j] = *(const unsigned*)(Zv + (size_t)(n * CH + 8 * tg + j) * ZW + 2 * (lane + 64 * i));
}
DI void st_vT(const unsigned (&w)[2][8], int tg, int lane, LAS unsigned char* VT) {
#pragma unroll
    for (int i = 0; i < 2; ++i) { const int cp = lane + 64 * i; u32x4 lo, hi;
        lo.x = (w[i][0] & 0xffffu) | (w[i][1] << 16); lo.y = (w[i][2] & 0xffffu) | (w[i][3] << 16); lo.z = (w[i][4] & 0xffffu) | (w[i][5] << 16); lo.w = (w[i][6] & 0xffffu) | (w[i][7] << 16);
        hi.x = (w[i][0] >> 16) | (w[i][1] & 0xffff0000u); hi.y = (w[i][2] >> 16) | (w[i][3] & 0xffff0000u); hi.z = (w[i][4] >> 16) | (w[i][5] & 0xffff0000u); hi.w = (w[i][6] >> 16) | (w[i][7] & 0xffff0000u);
        *(LAS u32x4*)(VT + (2 * cp) * ROW72 + tg * 16) = lo; *(LAS u32x4*)(VT + (2 * cp + 1) * ROW72 + tg * 16) = hi; }
}
DI void ld_256x128(const bf16_t* __restrict__ src, int gp, int tid, u32x4 (&r)[8]) {
#pragma unroll
    for (int i = 0; i < 8; ++i) { const int id = tid + 512 * i, row = id >> 4, cc = id & 15; r[i] = *(const u32x4*)(src + (size_t)row * gp + cc * 8); }
}
DI void st_256x128(const u32x4 (&r)[8], LAS unsigned char* dst, int tid) {
#pragma unroll
    for (int i = 0; i < 8; ++i) { const int id = tid + 512 * i, row = id >> 4, cc = id & 15; *(LAS u32x4*)(dst + row * ROW136 + cc * 16) = r[i]; }
}
DI void conv_ld(const bf16_t* __restrict__ Zc, int tok0, unsigned (&x)[11]) {
#pragma unroll
    for (int i = 0; i < 11; ++i) { const int tok = tok0 - 3 + i; x[i] = 0u; if (tok >= 0) x[i] = *(const unsigned*)(Zc + (size_t)tok * ZW); }
}
DI void conv_apply(const unsigned (&x)[11], const float* __restrict__ cw, const float* __restrict__ cb, float (&o0)[8], float (&o1)[8]) {
    f32x2 wj[4];
#pragma unroll
    for (int j = 0; j < 4; ++j) wj[j] = *(const f32x2*)(cw + j * 1024);
    const f32x2 bias = *(const f32x2*)cb;
#pragma unroll
    for (int j = 0; j < 8; ++j) { float y0 = bias.x, y1 = bias.y;
#pragma unroll
        for (int jj = 0; jj < 4; ++jj) { y0 += wj[jj].x * bflo(x[j + jj]); y1 += wj[jj].y * bfhi(x[j + jj]); }
        o0[j] = silu_f(y0); o1[j] = silu_f(y1); }
}
DI void gla_b(const bf16_t* __restrict__ Z, const float* __restrict__ wa, const float* __restrict__ ba, int h, int n, int tg, int c2, LAS float* TOT, float (&b)[8][2], float (&blast)[2]) {
    const int col = h * 128 + 2 * c2;
    float w0[16], w1[16];
#pragma unroll
    for (int r = 0; r < 16; ++r) { const f32x2 w = *(const f32x2*)(wa + r * 512 + col); w0[r] = w.x; w1[r] = w.y; }
    const f32x2 bb = *(const f32x2*)(ba + col);
    float c0 = 0.f, c1 = 0.f;
#pragma unroll
    for (int j = 0; j < 8; ++j) {
        const bf16_t* gp = Z + (size_t)(n * CH + 8 * tg + j) * ZW + ZC_GA;
        const u32x4 g0 = *(const u32x4*)gp, g1 = *(const u32x4*)(gp + 8);
        const float gv[16] = {bflo(g0.x), bfhi(g0.x), bflo(g0.y), bfhi(g0.y), bflo(g0.z), bfhi(g0.z), bflo(g0.w), bfhi(g0.w),
                              bflo(g1.x), bfhi(g1.x), bflo(g1.y), bfhi(g1.y), bflo(g1.z), bfhi(g1.z), bflo(g1.w), bfhi(g1.w)};
        float p0 = bb.x, p1 = bb.y;
#pragma unroll
        for (int r = 0; r < 16; ++r) { p0 += gv[r] * w0[r]; p1 += gv[r] * w1[r]; }
        c0 += log_sigmoid_f(p0) * (1.0f / 16.0f); c1 += log_sigmoid_f(p1) * (1.0f / 16.0f);
        b[j][0] = c0; b[j][1] = c1;
    }
    *(LAS f32x2*)(TOT + tg * 128 + 2 * c2) = (f32x2){c0, c1};
    __syncthreads();
    float pre0 = 0.f, pre1 = 0.f, t0 = 0.f, t1 = 0.f;
#pragma unroll
    for (int g = 0; g < 8; ++g) { const f32x2 t = *(const LAS f32x2*)(TOT + g * 128 + 2 * c2); if (g < tg) { pre0 += t.x; pre1 += t.y; } t0 += t.x; t1 += t.y; }
#pragma unroll
    for (int j = 0; j < 8; ++j) { b[j][0] += pre0; b[j][1] += pre1; }
    blast[0] = t0; blast[1] = t1;
}
DI void conv_silu8(const bf16_t* __restrict__ Zc, const float* __restrict__ cw, const float* __restrict__ cb, int tok0, float (&o0)[8], float (&o1)[8]) {
    float x0[11], x1[11];
#pragma unroll
    for (int i = 0; i < 11; ++i) { const int tok = tok0 - 3 + i; unsigned w = 0u; if (tok >= 0) w = *(const unsigned*)(Zc + (size_t)tok * ZW); x0[i] = bflo(w); x1[i] = bfhi(w); }
    f32x2 wj[4];
#pragma unroll
    for (int j = 0; j < 4; ++j) wj[j] = *(const f32x2*)(cw + j * 1024);
    const f32x2 bias = *(const f32x2*)cb;
#pragma unroll
    for (int j = 0; j < 8; ++j) { float y0 = bias.x, y1 = bias.y;
#pragma unroll
        for (int jj = 0; jj < 4; ++jj) { y0 += wj[jj].x * x0[j + jj]; y1 += wj[jj].y * x1[j + jj]; }
        o0[j] = silu_f(y0); o1[j] = silu_f(y1); }
}
DI void score_mfma(const LAS unsigned char* QL, const LAS unsigned char* KL, int w, int lane, f32x4 (&sacc)[2]) {
    const int fr = lane & 15, fq = lane >> 4, mi = w >> 1, ni0 = 2 * (w & 1);
    sacc[0] = (f32x4){0.f, 0.f, 0.f, 0.f}; sacc[1] = sacc[0];
#pragma unroll
    for (int ks = 0; ks < 4; ++ks) { const bf16x8 a = *(const LAS bf16x8*)(QL + (16 * mi + fr) * ROW136 + (32 * ks + 8 * fq) * 2);
#pragma unroll
        for (int jn = 0; jn < 2; ++jn) { const bf16x8 b = *(const LAS bf16x8*)(KL + (16 * (ni0 + jn) + fr) * ROW136 + (32 * ks + 8 * fq) * 2); sacc[jn] = mfma16(b, a, sacc[jn]); } }
}

struct MixCtx {
    const bf16_t* Z; bf16_t* OB;
    const float *wa, *ba, *gla_norm, *conv_w, *conv_b, *b_i, *b_f, *ml_norm;
    float *DECAY, *DN, *NP, *GG, *FL, *MP, *BG; bf16_t *DS, *DC, *SP, *CP;
    const bf16_t *KM, *VMT;
};

DI void gla_A_unit(const MixCtx& C, LAS unsigned char* lds, int h, int n, int tid) {
    const int lane = tid & 63, tg = __builtin_amdgcn_readfirstlane(tid >> 6), c2 = lane;
    LAS float* TOT = (LAS float*)(lds + L_MISC);
    LAS unsigned char* KT = lds + L_ST; LAS unsigned char* VT = lds + L_VT;
    unsigned kw[8], vw[2][8];
#pragma unroll
    for (int j = 0; j < 8; ++j) kw[j] = *(const unsigned*)(C.Z + (size_t)(n * CH + 8 * tg + j) * ZW + ZC_GK + h * 128 + 2 * c2);
    ld_v(C.Z + ZC_GV + h * 256, n, tg, lane, vw);
    float b[8][2], blast[2];
    gla_b(C.Z, C.wa, C.ba, h, n, tg, c2, TOT, b, blast);
    float k0[8], k1[8];
#pragma unroll
    for (int j = 0; j < 8; ++j) { k0[j] = bflo(kw[j]) * __expf(blast[0] - b[j][0]); k1[j] = bfhi(kw[j]) * __expf(blast[1] - b[j][1]);
        *(f32x2*)(C.BG + ((size_t)(h * NCH + n) * CH + 8 * tg + j) * 128 + 2 * c2) = (f32x2){b[j][0], b[j][1]}; }
    u32x4 lo, hi;
    lo.x = pk2(k0[0], k0[1]); lo.y = pk2(k0[2], k0[3]); lo.z = pk2(k0[4], k0[5]); lo.w = pk2(k0[6], k0[7]);
    hi.x = pk2(k1[0], k1[1]); hi.y = pk2(k1[2], k1[3]); hi.z = pk2(k1[4], k1[5]); hi.w = pk2(k1[6], k1[7]);
    *(LAS u32x4*)(KT + (2 * c2) * ROW72 + tg * 16) = lo; *(LAS u32x4*)(KT + (2 * c2 + 1) * ROW72 + tg * 16) = hi;
    if (tg == 0) *(f32x2*)(C.DECAY + (size_t)(h * NCH + n) * 128 + 2 * c2) = (f32x2){__expf(blast[0]), __expf(blast[1])};
    st_vT(vw, tg, lane, VT);
    __syncthreads();
    state_mfma(VT, KT, C.DS + (size_t)(h * NCH + n) * 32768, tg, lane);
    __syncthreads();
}

DI void gla_B_unit(const MixCtx& C, LAS unsigned char* lds, int h, int n, int tid) {
    const int lane = tid & 63, w = __builtin_amdgcn_readfirstlane(tid >> 6), tg = w, c2 = lane, fr = lane & 15, fq = lane >> 4;
    LAS float* RS = (LAS float*)(lds + L_MISC + 4096);
    LAS unsigned char* ST = lds + L_ST; LAS unsigned char* VT = lds + L_VT; LAS unsigned char* QL = lds + L_Q; LAS unsigned char* KL = lds + L_K;
    const int wr = w >> 1, wc = w & 1, t = 16 * wr + fr;
    const size_t tok = (size_t)(n * CH + t);
    u32x4 st[8]; f32x2 bq[8]; unsigned wq[8], wk[8], vw[2][8]; u32x2 gg[8]; f32x4 gn[8];
    ld_256x128(C.SP + (size_t)(h * NCH + n) * 32768, 128, tid, st);
#pragma unroll
    for (int j = 0; j < 8; ++j) { const size_t zr = (size_t)(n * CH + 8 * tg + j) * ZW;
        bq[j] = *(const f32x2*)(C.BG + ((size_t)(h * NCH + n) * CH + 8 * tg + j) * 128 + 2 * c2);
        wq[j] = *(const unsigned*)(C.Z + zr + ZC_GQ + h * 128 + 2 * c2); wk[j] = *(const unsigned*)(C.Z + zr + ZC_GK + h * 128 + 2 * c2); }
    ld_v(C.Z + ZC_GV + h * 256, n, tg, lane, vw);
#pragma unroll
    for (int ni = 0; ni < 8; ++ni) { const int dv = 128 * wc + 16 * ni + 4 * fq; gg[ni] = *(const u32x2*)(C.Z + tok * ZW + ZC_GG + h * 256 + dv); gn[ni] = *(const f32x4*)(C.gla_norm + h * 256 + dv); }
    const float qs = 0.08838834764831845f;
#pragma unroll
    for (int j = 0; j < 8; ++j) { const float e0 = __expf(bq[j].x), e1 = __expf(bq[j].y);
        *(LAS unsigned*)(QL + (8 * tg + j) * ROW136 + 4 * c2) = pk2(bflo(wq[j]) * qs * e0, bfhi(wq[j]) * qs * e1);
        *(LAS unsigned*)(KL + (8 * tg + j) * ROW136 + 4 * c2) = pk2(bflo(wk[j]) * __builtin_amdgcn_rcpf(e0), bfhi(wk[j]) * __builtin_amdgcn_rcpf(e1)); }
    st_vT(vw, tg, lane, VT);
    st_256x128(st, ST, tid);
    __syncthreads();
    f32x4 sacc[2];
    score_mfma(QL, KL, w, lane, sacc);
    __syncthreads();
    { const int mi = w >> 1, ni0 = 2 * (w & 1), t2 = 16 * mi + fr;
#pragma unroll
      for (int jn = 0; jn < 2; ++jn) { const int s0 = 16 * (ni0 + jn) + 4 * fq; f32x4 v = sacc[jn];
#pragma unroll
          for (int r = 0; r < 4; ++r) if (s0 + r > t2) v[r] = 0.f;
          *(LAS u32x2*)(KL + t2 * ROW72 + s0 * 2) = (u32x2){pk2(v[0], v[1]), pk2(v[2], v[3])}; } }
    __syncthreads();
    f32x4 o[8];
#pragma unroll
    for (int ni = 0; ni < 8; ++ni) o[ni] = (f32x4){0.f, 0.f, 0.f, 0.f};
#pragma unroll
    for (int ks = 0; ks < 2; ++ks) { const bf16x8 a = *(const LAS bf16x8*)(KL + t * ROW72 + (32 * ks + 8 * fq) * 2);
#pragma unroll
        for (int ni = 0; ni < 8; ++ni) { const bf16x8 bb = *(const LAS bf16x8*)(VT + (128 * wc + 16 * ni + fr) * ROW72 + (32 * ks + 8 * fq) * 2); o[ni] = mfma16(bb, a, o[ni]); } }
#pragma unroll
    for (int ks = 0; ks < 4; ++ks) { const bf16x8 a = *(const LAS bf16x8*)(QL + t * ROW136 + (32 * ks + 8 * fq) * 2);
#pragma unroll
        for (int ni = 0; ni < 8; ++ni) { const bf16x8 bb = *(const LAS bf16x8*)(ST + (128 * wc + 16 * ni + fr) * ROW136 + (32 * ks + 8 * fq) * 2); o[ni] = mfma16(bb, a, o[ni]); } }
    float ss = 0.f;
#pragma unroll
    for (int ni = 0; ni < 8; ++ni) ss += (o[ni][0] * o[ni][0] + o[ni][1] * o[ni][1]) + (o[ni][2] * o[ni][2] + o[ni][3] * o[ni][3]);
    ss += shx(ss, 16, lane); ss += shx(ss, 32, lane);
    if (fq == 0) RS[wc * 64 + t] = ss;
    __syncthreads();
    const float rstd = 1.0f / sqrtf((RS[t] + RS[64 + t]) * (1.0f / 256.0f) + EPS);
#pragma unroll
    for (int ni = 0; ni < 8; ++ni) { const int dv = 128 * wc + 16 * ni + 4 * fq;
        const f32x4 v = o[ni] * rstd * gn[ni];
        *(u32x2*)(C.OB + tok * OBW + OB_O + h * 256 + dv) = (u32x2){pk2(v[0] * silu_f(bflo(gg[ni].x)), v[1] * silu_f(bfhi(gg[ni].x))), pk2(v[2] * silu_f(bflo(gg[ni].y)), v[3] * silu_f(bfhi(gg[ni].y)))}; }
    __syncthreads();
}

DI void ml_A_unit(const MixCtx& C, LAS unsigned char* lds, int h, int n, int tid) {
    const int lane = tid & 63, tg = __builtin_amdgcn_readfirstlane(tid >> 6), c2 = lane;
    LAS float* PART = (LAS float*)(lds + L_MISC);
    LAS unsigned char* KT = lds + L_ST; LAS unsigned char* VT = lds + L_VT;
    const size_t ztok = (size_t)(n * CH + lane) * ZW;
    const float li = bf2f(C.Z[ztok + ZC_MI + h]) + C.b_i[h];
    const float lf = log_sigmoid_f(bf2f(C.Z[ztok + ZC_MF + h]) + C.b_f[h]);
    const float F = wave_scan_sum(lf, lane);
    const float Flast = shi(F, 63);
    const float Gv = Flast - F + li;
    const float g = wave_max(Gv, lane);
    const float wG = __expf(Gv - g);
    float k0[8], k1[8];
    conv_silu8(C.Z + ZC_MQK + 512 + h * 128 + 2 * c2, C.conv_w + 512 + h * 128 + 2 * c2, C.conv_b + 512 + h * 128 + 2 * c2, n * CH + 8 * tg, k0, k1);
    const float ks = 0.08838834764831845f;
    float p0 = 0.f, p1 = 0.f;
#pragma unroll
    for (int j = 0; j < 8; ++j) { const float wj = shi(wG, 8 * tg + j) * ks; k0[j] *= wj; k1[j] *= wj; p0 += k0[j]; p1 += k1[j]; }
    u32x4 lo, hi;
    lo.x = pk2(k0[0], k0[1]); lo.y = pk2(k0[2], k0[3]); lo.z = pk2(k0[4], k0[5]); lo.w = pk2(k0[6], k0[7]);
    hi.x = pk2(k1[0], k1[1]); hi.y = pk2(k1[2], k1[3]); hi.z = pk2(k1[4], k1[5]); hi.w = pk2(k1[6], k1[7]);
    *(LAS u32x4*)(KT + (2 * c2) * ROW72 + tg * 16) = lo; *(LAS u32x4*)(KT + (2 * c2 + 1) * ROW72 + tg * 16) = hi;
    *(LAS f32x2*)(PART + tg * 128 + 2 * c2) = (f32x2){p0, p1};
    fill_vT(C.Z + ZC_MV + h * 256, n, tg, lane, VT);
    if (tid == 0) { C.GG[h * NCH + n] = g; C.FL[h * NCH + n] = Flast; }
    __syncthreads();
    if (tid < 128) { float s = 0.f;
#pragma unroll
        for (int q = 0; q < 8; ++q) s += PART[q * 128 + tid];
        C.DN[(size_t)(h * NCH + n) * 128 + tid] = s; }
    state_mfma(VT, KT, C.DC + (size_t)(h * NCH + n) * 32768, tg, lane);
    __syncthreads();
}

DI void ml_B_unit(const MixCtx& C, LAS unsigned char* lds, int h, int n, int tid) {
    const int lane = tid & 63, w = __builtin_amdgcn_readfirstlane(tid >> 6), tg = w, c2 = lane, fr = lane & 15, fq = lane >> 4;
    LAS float* MF = (LAS float*)(lds + L_MISC); LAS float* MU = MF + 64; LAS float* MM = MF + 128; LAS float* MW = MF + 192;
    LAS float* DENP = MF + 256; LAS float* DQN = MF + 512; LAS float* NPV = MF + 576; LAS float* RS = (LAS float*)(lds + L_MISC + 4096);
    LAS unsigned char* CT = lds + L_ST; LAS unsigned char* VT = lds + L_VT; LAS unsigned char* QL = lds + L_Q; LAS unsigned char* KL = lds + L_K;
    copy_256x128(C.CP + (size_t)(h * NCH + n) * 32768, 128, CT, tid);
    if (w == 0) {
        const size_t ztok = (size_t)(n * CH + lane) * ZW;
        const float li = bf2f(C.Z[ztok + ZC_MI + h]) + C.b_i[h];
        const float lf = log_sigmoid_f(bf2f(C.Z[ztok + ZC_MF + h]) + C.b_f[h]);
        const float F = wave_scan_sum(lf, lane);
        const float u = li - F;
        const float pm = wave_scan_max(u, lane);
        const float mprev = C.MP[h * NCH + n];
        const float m = F + fmaxf(pm, mprev);
        MF[lane] = F; MU[lane] = u; MM[lane] = m; MW[lane] = __expf(F + mprev - m);
    }
    if (w == 1) { NPV[lane] = C.NP[(size_t)(h * NCH + n) * 128 + lane]; NPV[64 + lane] = C.NP[(size_t)(h * NCH + n) * 128 + 64 + lane]; }
    {
        float q0[8], q1[8], k0[8], k1[8];
        conv_silu8(C.Z + ZC_MQK + h * 128 + 2 * c2, C.conv_w + h * 128 + 2 * c2, C.conv_b + h * 128 + 2 * c2, n * CH + 8 * tg, q0, q1);
        conv_silu8(C.Z + ZC_MQK + 512 + h * 128 + 2 * c2, C.conv_w + 512 + h * 128 + 2 * c2, C.conv_b + 512 + h * 128 + 2 * c2, n * CH + 8 * tg, k0, k1);
        const float ks = 0.08838834764831845f;
#pragma unroll
        for (int j = 0; j < 8; ++j) { *(LAS unsigned*)(QL + (8 * tg + j) * ROW136 + 4 * c2) = pk2(q0[j], q1[j]); *(LAS unsigned*)(KL + (8 * tg + j) * ROW136 + 4 * c2) = pk2(k0[j] * ks, k1[j] * ks); }
    }
    fill_vT(C.Z + ZC_MV + h * 256, n, tg, lane, VT);
    __syncthreads();
    f32x4 sacc[2];
    score_mfma(QL, KL, w, lane, sacc);
    {
        const int t = tid >> 3, part = tid & 7; float s = 0.f;
#pragma unroll
        for (int e = 0; e < 8; ++e) { const unsigned qq = *(const LAS unsigned*)(QL + t * ROW136 + (16 * part + 2 * e) * 2); s += bflo(qq) * NPV[16 * part + 2 * e] + bfhi(qq) * NPV[16 * part + 2 * e + 1]; }
        s += shx(s, 1, lane); s += shx(s, 2, lane); s += shx(s, 4, lane);
        if (part == 0) DQN[t] = s;
    }
    __syncthreads();
    { const int mi = w >> 1, ni0 = 2 * (w & 1), t = 16 * mi + fr; const float ft = MF[t] - MM[t];
#pragma unroll
      for (int jn = 0; jn < 2; ++jn) { const int s0 = 16 * (ni0 + jn) + 4 * fq; f32x4 v = sacc[jn]; const f32x4 us = *(const LAS f32x4*)(MU + s0);
          float ps = 0.f;
#pragma unroll
          for (int r = 0; r < 4; ++r) { v[r] = (s0 + r > t) ? 0.f : v[r] * __expf(ft + us[r]); ps += v[r]; }
          ps += shx(ps, 16, lane); ps += shx(ps, 32, lane);
          if (fq == 0) DENP[t * 4 + ni0 + jn] = ps;
          *(LAS u32x2*)(KL + t * ROW72 + s0 * 2) = (u32x2){pk2(v[0], v[1]), pk2(v[2], v[3])}; } }
    __syncthreads();
    const int wr = w >> 1, wc = w & 1, t = 16 * wr + fr;
    f32x4 o1[8], o2[8];
#pragma unroll
    for (int ni = 0; ni < 8; ++ni) { o1[ni] = (f32x4){0.f, 0.f, 0.f, 0.f}; o2[ni] = o1[ni]; }
#pragma unroll
    for (int ks = 0; ks < 2; ++ks) { const bf16x8 a = *(const LAS bf16x8*)(KL + t * ROW72 + (32 * ks + 8 * fq) * 2);
#pragma unroll
        for (int ni = 0; ni < 8; ++ni) { const bf16x8 bb = *(const LAS bf16x8*)(VT + (128 * wc + 16 * ni + fr) * ROW72 + (32 * ks + 8 * fq) * 2); o1[ni] = mfma16(bb, a, o1[ni]); } }
#pragma unroll
    for (int ks = 0; ks < 4; ++ks) { const bf16x8 a = *(const LAS bf16x8*)(QL + t * ROW136 + (32 * ks + 8 * fq) * 2);
#pragma unroll
        for (int ni = 0; ni < 8; ++ni) { const bf16x8 bb = *(const LAS bf16x8*)(CT + (128 * wc + 16 * ni + fr) * ROW136 + (32 * ks + 8 * fq) * 2); o2[ni] = mfma16(bb, a, o2[ni]); } }
    const float wi = MW[t];
    const f32x4 dp = *(const LAS f32x4*)(DENP + t * 4);
    const float den = ((dp[0] + dp[1]) + (dp[2] + dp[3])) + wi * DQN[t];
    const float inv = 1.0f / fmaxf(fabsf(den), __expf(-MM[t]));
    const size_t tok = (size_t)(n * CH + t);
    float ss = 0.f;
#pragma unroll
    for (int ni = 0; ni < 8; ++ni) { const int dv = 128 * wc + 16 * ni + 4 * fq;
        const u32x2 mo = *(const u32x2*)(C.Z + tok * ZW + ZC_MO + h * 256 + dv);
        f32x4 v = (o1[ni] + o2[ni] * wi) * inv;
        v[0] *= sigmoid_f(bflo(mo.x)); v[1] *= sigmoid_f(bfhi(mo.x)); v[2] *= sigmoid_f(bflo(mo.y)); v[3] *= sigmoid_f(bfhi(mo.y));
        o1[ni] = v; ss += (v[0] * v[0] + v[1] * v[1]) + (v[2] * v[2] + v[3] * v[3]); }
    ss += shx(ss, 16, lane); ss += shx(ss, 32, lane);
    if (fq == 0) RS[wc * 64 + t] = ss;
    __syncthreads();
    const float rstd = 1.0f / sqrtf((RS[t] + RS[64 + t]) * (1.0f / 256.0f) + EPS);
#pragma unroll
    for (int ni = 0; ni < 8; ++ni) { const int dv = 128 * wc + 16 * ni + 4 * fq; const f32x4 gn = *(const f32x4*)(C.ml_norm + h * 256 + dv);
        const f32x4 v = o1[ni] * rstd * gn;
        *(u32x2*)(C.OB + tok * OBW + OB_O + 1024 + h * 256 + dv) = (u32x2){pk2(v[0], v[1]), pk2(v[2], v[3])}; }
    __syncthreads();
}

DI void scan_phase(const MixCtx& C, int tid) {
    const int NS = 2 * 65536;
    for (int slot = opaque_bx() * 512 + tid; slot < NS; slot += opaque_g() * 512) {
        const int br = slot >> 16, s = slot & 65535, h = s >> 14, dv = (s >> 6) & 255, dkp = s & 63;
        const size_t e0 = (size_t)h * NCH * 32768 + (size_t)dv * 128 + 2 * dkp;
        if (br == 0) {
            float s0 = 0.f, s1 = 0.f;
            for (int n0 = 0; n0 < NCH; n0 += 8) {
                f32x2 d[8], dec[8];
#pragma unroll
                for (int u = 0; u < 8; ++u) { const unsigned dw = *(const unsigned*)(C.DS + e0 + (size_t)(n0 + u) * 32768); d[u] = (f32x2){bflo(dw), bfhi(dw)}; dec[u] = *(const f32x2*)(C.DECAY + (size_t)(h * NCH + n0 + u) * 128 + 2 * dkp); }
#pragma unroll
                for (int u = 0; u < 8; ++u) { *(unsigned*)(C.SP + e0 + (size_t)(n0 + u) * 32768) = pk2(s0, s1); s0 = dec[u].x * s0 + d[u].x; s1 = dec[u].y * s1 + d[u].y; }
            }
        } else {
            float c0 = 0.f, c1 = 0.f, nn0 = 0.f, nn1 = 0.f, m = -1e30f;
            for (int n0 = 0; n0 < NCH; n0 += 8) {
                f32x2 d[8], dn[8]; float fl[8], gl[8];
#pragma unroll
                for (int u = 0; u < 8; ++u) { const unsigned dw = *(const unsigned*)(C.DC + e0 + (size_t)(n0 + u) * 32768); d[u] = (f32x2){bflo(dw), bfhi(dw)}; fl[u] = C.FL[h * NCH + n0 + u]; gl[u] = C.GG[h * NCH + n0 + u];
                    dn[u] = (dv == 0) ? *(const f32x2*)(C.DN + (size_t)(h * NCH + n0 + u) * 128 + 2 * dkp) : (f32x2){0.f, 0.f}; }
#pragma unroll
                for (int u = 0; u < 8; ++u) { *(unsigned*)(C.CP + e0 + (size_t)(n0 + u) * 32768) = pk2(c0, c1);
                    if (dv == 0) { *(f32x2*)(C.NP + (size_t)(h * NCH + n0 + u) * 128 + 2 * dkp) = (f32x2){nn0, nn1}; if (dkp == 0) C.MP[h * NCH + n0 + u] = m; }
                    const float mn = fmaxf(fl[u] + m, gl[u]); const float a = __expf(fl[u] + m - mn), bb = __expf(gl[u] - mn);
                    c0 = a * c0 + bb * d[u].x; c1 = a * c1 + bb * d[u].y; nn0 = a * nn0 + bb * dn[u].x; nn1 = a * nn1 + bb * dn[u].y; m = mn; }
            }
        }
    }
}

DI void mem_unit(const MixCtx& C, LAS unsigned char* lds, int h, int rb, int tid) {
    const int lane = tid & 63, w = __builtin_amdgcn_readfirstlane(tid >> 6), fr = lane & 15, fq = lane >> 4, wr = w >> 1, wc = w & 1, t = 16 * wr + fr;
    LAS unsigned char* QL = lds; LAS unsigned char* PL = lds + 33792; LAS unsigned char* KV = lds + 67584;
    LAS float* RMX = (LAS float*)(lds + L_MISC); LAS float* RSM = RMX + 128;
#pragma unroll
    for (int i = 0; i < 4; ++i) { const int id = tid + 512 * i, row = id >> 5, cc = id & 31;
        *(LAS u32x4*)(QL + row * ROW264 + cc * 16) = *(const u32x4*)(C.Z + (size_t)(rb * 64 + row) * ZW + ZC_XQ + h * 256 + cc * 8); }
    f32x4 s[8];
#pragma unroll
    for (int ni = 0; ni < 8; ++ni) s[ni] = (f32x4){0.f, 0.f, 0.f, 0.f};
#pragma unroll
    for (int half = 0; half < 2; ++half) {
        copy_256x128(C.KM + h * 256 + half * 128, 4096, KV, tid);
        __syncthreads();
#pragma unroll
        for (int ks = 0; ks < 4; ++ks) { const bf16x8 a = *(const LAS bf16x8*)(QL + t * ROW264 + (128 * half + 32 * ks + 8 * fq) * 2);
#pragma unroll
            for (int ni = 0; ni < 8; ++ni) { const bf16x8 bb = *(const LAS bf16x8*)(KV + (128 * wc + 16 * ni + fr) * ROW136 + (32 * ks + 8 * fq) * 2); s[ni] = mfma16(bb, a, s[ni]); } }
        __syncthreads();
    }
    float mx = -3.0e38f;
#pragma unroll
    for (int ni = 0; ni < 8; ++ni) { s[ni] = s[ni] * 0.0625f; mx = fmaxf(mx, fmaxf(fmaxf(s[ni][0], s[ni][1]), fmaxf(s[ni][2], s[ni][3]))); }
    mx = fmaxf(mx, shx(mx, 16, lane)); mx = fmaxf(mx, shx(mx, 32, lane));
    if (fq == 0) RMX[wc * 64 + t] = mx;
    copy_256x128(C.VMT + (size_t)(h * 256) * 256, 256, KV, tid);
    __syncthreads();
    mx = fmaxf(RMX[t], RMX[64 + t]);
    float sm = 0.f;
#pragma unroll
    for (int ni = 0; ni < 8; ++ni) {
#pragma unroll
        for (int r = 0; r < 4; ++r) { s[ni][r] = __expf(s[ni][r] - mx); sm += s[ni][r]; } }
    sm += shx(sm, 16, lane); sm += shx(sm, 32, lane);
    if (fq == 0) RSM[wc * 64 + t] = sm;
    __syncthreads();
    const float inv = 1.0f / (RSM[t] + RSM[64 + t]);
#pragma unroll
    for (int ni = 0; ni < 8; ++ni) { const f32x4 p = s[ni] * inv; *(LAS u32x2*)(PL + t * ROW264 + (128 * wc + 16 * ni + 4 * fq) * 2) = (u32x2){pk2(p[0], p[1]), pk2(p[2], p[3])}; }
    f32x4 o[8];
#pragma unroll
    for (int ni = 0; ni < 8; ++ni) o[ni] = (f32x4){0.f, 0.f, 0.f, 0.f};
#pragma unroll
    for (int half = 0; half < 2; ++half) {
        if (half == 1) copy_256x128(C.VMT + (size_t)(h * 256) * 256 + 128, 256, KV, tid);
        __syncthreads();
#pragma unroll
        for (int ks = 0; ks < 4; ++ks) { const bf16x8 a = *(const LAS bf16x8*)(PL + t * ROW264 + (128 * half + 32 * ks + 8 * fq) * 2);
#pragma unroll
            for (int ni = 0; ni < 8; ++ni) { const bf16x8 bb = *(const LAS bf16x8*)(KV + (128 * wc + 16 * ni + fr) * ROW136 + (32 * ks + 8 * fq) * 2); o[ni] = mfma16(bb, a, o[ni]); } }
        __syncthreads();
    }
    const size_t tok = (size_t)(rb * 64 + t);
#pragma unroll
    for (int ni = 0; ni < 8; ++ni) { const int d = 128 * wc + 16 * ni + 4 * fq; *(u32x2*)(C.OB + tok * OBW + OB_O + 2048 + h * 256 + d) = (u32x2){pk2(o[ni][0], o[ni][1]), pk2(o[ni][2], o[ni][3])}; }
}

#ifndef GEMM_ALIGN
#define GEMM_ALIGN true
#endif
#ifndef REP_PRO
#define REP_PRO 1
#endif
#ifndef REP_MIXA
#define REP_MIXA 1
#endif
#ifndef REP_SCAN
#define REP_SCAN 1
#endif
#ifndef REP_MIXB
#define REP_MIXB 1
#endif
#ifndef REP_FF1
#define REP_FF1 1
#endif
#ifndef REP_NORM
#define REP_NORM 1
#endif
#ifndef WGM_IN
#define WGM_IN PG8_WGM
#endif
#ifndef WGM_BR
#define WGM_BR PG8_WGM
#endif
#ifndef WGM_OUT
#define WGM_OUT PG8_WGM
#endif
#ifndef WGM_F1
#define WGM_F1 8
#endif
#ifndef WGM_F2
#define WGM_F2 PG8_WGM
#endif
#ifndef REP_GLAA
#define REP_GLAA 1
#endif
#ifndef REP_MEM
#define REP_MEM 1
#endif
#ifndef REP_GLAB
#define REP_GLAB 1
#endif
#ifndef REP_GATE
#define REP_GATE 1
#endif
#ifndef REP_BR
#define REP_BR 1
#endif
#ifndef GEMM_SP2
#define GEMM_SP2 true
#endif
constexpr int L_PTR = L_BARW + 256;
DI unsigned long long tab_ld(LAS unsigned char* lds, int k) {
    const unsigned long long v = *(volatile LAS unsigned long long*)(lds + L_PTR + 8 * k);
    const unsigned lo = __builtin_amdgcn_readfirstlane((unsigned)v), hi = __builtin_amdgcn_readfirstlane((unsigned)(v >> 32));
    return ((unsigned long long)hi << 32) | lo;
}
DI const float* tab_in(LAS unsigned char* lds, int k) { return (const float*)(const GAS float*)tab_ld(lds, k); }
DI unsigned char* tab_ws(LAS unsigned char* lds) { return (unsigned char*)(GAS unsigned char*)tab_ld(lds, 24); }
DI void grid_bar(LAS unsigned char* lds) {
    XcdBarrier b; b.bar = (unsigned*)(tab_ws(lds) + WS_CTL) + CW_BAR; b.x = xb_xcc_id(); b.st = (volatile LAS unsigned*)(lds + L_BARW);
    xcd_barrier(b);
}
DI void make_ctx(MixCtx& C, LAS unsigned char* lds, int l) {
    unsigned char* ws = tab_ws(lds);
    C.Z = (const bf16_t*)(ws + WS_Z); C.OB = (bf16_t*)(ws + WS_OB);
    C.wa = tab_in(lds, I_W_GLA_A) + (size_t)l * 16 * 512; C.ba = tab_in(lds, I_B_GLA_A) + l * 512; C.gla_norm = tab_in(lds, I_GLA_NORM) + l * 1024;
    C.conv_w = tab_in(lds, I_CONV_W) + (size_t)l * 4 * 1024; C.conv_b = tab_in(lds, I_CONV_B) + l * 1024; C.b_i = tab_in(lds, I_B_ML_I) + l * 4; C.b_f = tab_in(lds, I_B_ML_F) + l * 4; C.ml_norm = tab_in(lds, I_ML_NORM) + l * 1024;
    C.BG = (float*)(ws + WS_BG); C.DS = (bf16_t*)(ws + WS_DS); C.DC = (bf16_t*)(ws + WS_DC); C.SP = (bf16_t*)(ws + WS_SP); C.CP = (bf16_t*)(ws + WS_CP);
    C.DECAY = (float*)(ws + WS_SMALL + SM_DECAY); C.DN = (float*)(ws + WS_SMALL + SM_DN); C.NP = (float*)(ws + WS_SMALL + SM_NP);
    C.GG = (float*)(ws + WS_SMALL + SM_GG); C.FL = (float*)(ws + WS_SMALL + SM_FL); C.MP = (float*)(ws + WS_SMALL + SM_MP);
    C.KM = (const bf16_t*)(ws + WS_KM) + l * 1024; C.VMT = (const bf16_t*)(ws + WS_VMT) + (size_t)l * 1024 * 256;
}

__global__ void __launch_bounds__(512, 2) trunk_fwd(Params p) {
    extern __shared__ __attribute__((aligned(16))) unsigned char lds_raw[];
    LAS unsigned char* lds0 = (LAS unsigned char*)lds_raw;
    {
        LAS unsigned char* lds = lds0;
        const int tid0 = threadIdx.x;
        if (tid0 < 64) ((LAS unsigned*)(lds + L_BARW))[tid0] = 0u;
        if (tid0 < 23) *(LAS unsigned long long*)(lds + L_PTR + 8 * tid0) = (unsigned long long)p.in[tid0];
        if (tid0 == 23) *(LAS unsigned long long*)(lds + L_PTR + 8 * 23) = (unsigned long long)p.out;
        if (tid0 == 24) *(LAS unsigned long long*)(lds + L_PTR + 8 * 24) = (unsigned long long)p.ws;
        __syncthreads();
        (void)xcd_barrier_post((unsigned*)(p.ws + WS_CTL) + CW_BAR, (volatile LAS unsigned*)(lds + L_BARW));
    }
#define TID (opaque_tid())
#define LANE (opaque_tid() & 63)
#define WAVE (__builtin_amdgcn_readfirstlane(opaque_tid() >> 6))
#define GW (opaque_bx() * NWAVES + WAVE)
#define NGW (opaque_g() * NWAVES)

    for (int rep = 0; rep < REP_PRO; ++rep) {
        LAS unsigned char* lds = opaque_lds(lds0); unsigned char* ws = tab_ws(lds);
        bf16_t* WIN = (bf16_t*)(ws + WS_WIN);
        const int lane = LANE, wave = WAVE;
        LAS float* scr = (LAS float*)(lds + wave * 16640);
        constexpr int IT_IN = 64 * 117, IT_BR = 16 * 64, IT_G = 4 * 64, IT_OUT = 64 * 64, IT_F1 = 64 * 256, IT_F2 = 256 * 64, IT_MK = 64 * 16;
        constexpr int E_IN = 4 * IT_IN, E_BR = E_IN + 12 * IT_BR, E_G = E_BR + 12 * IT_G, E_OUT = E_G + 4 * IT_OUT, E_F1 = E_OUT + 4 * IT_F1, E_F2 = E_F1 + 4 * IT_F2, E_MK = E_F2 + 4 * IT_MK, E_MV = E_MK + 4 * IT_MK;
        for (int it = GW; it < E_MV; it += NGW) {
            if (it < E_IN) { const int l = it / IT_IN, r = it - l * IT_IN; transpose_item(tab_in(lds, I_W_IN) + (size_t)l * DM * IN_W, DM, IN_W, WIN + (size_t)l * ZW * DM, DM, 0, 0, true, scr, r, lane, tab_in(lds, I_NORM_MIX) + l * DM); }
            else if (it < E_BR) { const int q = it - E_IN, lj = q / IT_BR, r = q - lj * IT_BR, l = lj / 3, j = lj - 3 * l; transpose_item(tab_in(lds, I_W_BRANCH) + (size_t)lj * 1024 * DM, 1024, DM, (bf16_t*)(ws + WS_WBR) + (size_t)l * DM * OBW, OBW, OB_O + j * 1024, 0, false, scr, r, lane); }
            else if (it < E_G) { const int q = it - E_BR, lj = q / IT_G, r = q - lj * IT_G, l = lj / 3, j = lj - 3 * l; transpose_item(tab_in(lds, I_W_GATE) + (size_t)lj * 256 * DM, 256, DM, (bf16_t*)(ws + WS_WBR) + (size_t)l * DM * OBW, OBW, j * 256, 0, false, scr, r, lane); }
            else if (it < E_OUT) { const int q = it - E_G, l = q / IT_OUT, r = q - l * IT_OUT; transpose_item(tab_in(lds, I_W_OUT) + (size_t)l * DM * DM, DM, DM, (bf16_t*)(ws + WS_WOUT) + (size_t)l * DM * DM, DM, 0, 0, false, scr, r, lane); }
            else if (it < E_F1) { const int q = it - E_OUT, l = q / IT_F1, r = q - l * IT_F1; transpose_item(tab_in(lds, I_W_FF1) + (size_t)l * DM * DFF, DM, DFF, (bf16_t*)(ws + WS_W1) + (size_t)l * DFF * DM, DM, 0, 0, false, scr, r, lane, tab_in(lds, I_NORM_FFN) + l * DM); }
            else if (it < E_F2) { const int q = it - E_F1, l = q / IT_F2, r = q - l * IT_F2; transpose_item(tab_in(lds, I_W_FF2) + (size_t)l * DFF * DM, DFF, DM, (bf16_t*)(ws + WS_W2) + (size_t)l * DM * DFF, DFF, 0, 0, false, scr, r, lane); }
            else if (it < E_MK) { const int q = it - E_F2, l = q / IT_MK, r = q - l * IT_MK; transpose_item(tab_in(lds, I_W_MEM_K) + (size_t)l * DM * 1024, DM, 1024, (bf16_t*)(ws + WS_WMK), DM, 0, l * 1024, false, scr, r, lane); }
            else { const int q = it - E_MK, l = q / IT_MK, r = q - l * IT_MK; transpose_item(tab_in(lds, I_W_MEM_V) + (size_t)l * DM * 1024, DM, 1024, (bf16_t*)(ws + WS_WMV), DM, 0, l * 1024, false, scr, r, lane); }
        }
        constexpr int PADCH = (ZW - IN_W) * DM / 8;
        for (int i = opaque_bx() * 512 + TID; i < NL * PADCH; i += opaque_g() * 512) { const int l = i / PADCH, r = i - l * PADCH; *(u32x4*)(WIN + (size_t)l * ZW * DM + (size_t)IN_W * DM + (size_t)r * 8) = (u32x4){0u, 0u, 0u, 0u}; }
        for (int m = GW; m < SEQ; m += NGW) row_bf16_ss(tab_in(lds, I_X) + (size_t)m * DM, (bf16_t*)(ws + WS_H) + (size_t)m * DM, (u64_t*)(ws + WS_SS) + m, lane);
        for (int m = GW; m < MEML; m += NGW) rmsnorm_row<false>(tab_in(lds, I_MEM) + (size_t)m * DM, tab_in(lds, I_MEM_NORM), (bf16_t*)(ws + WS_MEMN) + (size_t)m * DM, lane);
    }
    grid_bar(opaque_lds(lds0));
    {
        LAS unsigned char* lds = opaque_lds(lds0); unsigned char* ws = tab_ws(lds);
        { pg8::Gemm g{(const bf16_t*)(ws + WS_MEMN), (const bf16_t*)(ws + WS_WMK), opq(MEML), opq(DM), opq(DM), opq(DM), opq(DM)}; pg8::StaticOrder S; S.init(opq(MEML), opq(DM), opaque_g(), opaque_bx()); pg8::EpiBf16<0> E{(bf16_t*)(ws + WS_KM), DM, nullptr, nullptr, nullptr, 0, -1};
          pg8::gemm_phase<pg8::EpiBf16<0>, pg8::StaticOrder, GEMM_ALIGN, GEMM_SP2>(lds, g, S, E); }
    }
    {
        LAS unsigned char* lds = opaque_lds(lds0); unsigned char* ws = tab_ws(lds);
        { pg8::Gemm g{(const bf16_t*)(ws + WS_WMV), (const bf16_t*)(ws + WS_MEMN), opq(DM), opq(MEML), opq(DM), opq(DM), opq(DM)}; pg8::StaticOrder S; S.init(opq(DM), opq(MEML), opaque_g(), (opaque_bx() + 16) % opaque_g()); pg8::EpiBf16<0> E{(bf16_t*)(ws + WS_VMT), MEML, nullptr, nullptr, nullptr, 0, -1};
          pg8::gemm_phase<pg8::EpiBf16<0>, pg8::StaticOrder, GEMM_ALIGN, GEMM_SP2>(lds, g, S, E); }
    }
    grid_bar(opaque_lds(lds0));

    for (int l = 0; l < NL; ++l) {
        {
            LAS unsigned char* lds = opaque_lds(lds0); unsigned char* ws = tab_ws(lds);
            pg8::Gemm g{(const bf16_t*)(ws + WS_H), (const bf16_t*)(ws + WS_WIN) + (size_t)l * ZW * DM, opq(SEQ), opq(ZW), opq(DM), opq(DM), opq(DM)}; pg8::StaticOrder S; S.init(opq(SEQ), opq(ZW), opaque_g(), opaque_bx(), opq(WGM_IN)); pg8::EpiBf16<0> E{(bf16_t*)(ws + WS_Z), ZW, nullptr, (const u64_t*)(ws + WS_SS) + (size_t)(2 * l) * SEQ, (bf16_t*)(ws + WS_OB), OBW, ZC_GATE / 256};
            pg8::gemm_phase<pg8::EpiBf16<0>, pg8::StaticOrder, GEMM_ALIGN, GEMM_SP2>(lds, g, S, E);
        }
        grid_bar(opaque_lds(lds0));
        {
            LAS unsigned char* lds = opaque_lds(lds0); MixCtx C; make_ctx(C, lds, l); const int tid = TID;
            for (int rep = 0; rep < REP_MIXA; ++rep) {
            for (int r2 = 0; r2 < REP_GLAA; ++r2) for (int i = opaque_bx(); i < 4 * NCH; i += opaque_g()) gla_A_unit(C, lds, i >> 8, i & 255, tid);
            for (int i = opaque_bx(); i < 4 * NCH; i += opaque_g()) ml_A_unit(C, lds, i >> 8, i & 255, tid);
            for (int r2 = 0; r2 < REP_MEM; ++r2) for (int i = opaque_bx(); i < 4 * NCH; i += opaque_g()) mem_unit(C, lds, i >> 8, i & 255, tid);
            }
        }
        grid_bar(opaque_lds(lds0));
        { LAS unsigned char* lds = opaque_lds(lds0); MixCtx C; make_ctx(C, lds, l); for (int rep = 0; rep < REP_SCAN; ++rep) scan_phase(C, TID); }
        grid_bar(opaque_lds(lds0));
        {
            LAS unsigned char* lds = opaque_lds(lds0); MixCtx C; make_ctx(C, lds, l); const int tid = TID;
            for (int rep = 0; rep < REP_MIXB; ++rep) {
            for (int r2 = 0; r2 < REP_GLAB; ++r2) for (int i = opaque_bx(); i < 4 * NCH; i += opaque_g()) gla_B_unit(C, lds, i >> 8, i & 255, tid);
            for (int i = opaque_bx(); i < 4 * NCH; i += opaque_g()) ml_B_unit(C, lds, i >> 8, i & 255, tid);
            }
        }
        grid_bar(opaque_lds(lds0));
        for (int rep = 0; rep < REP_BR; ++rep) {
            LAS unsigned char* lds = opaque_lds(lds0); unsigned char* ws = tab_ws(lds);
            pg8::Gemm g{(const bf16_t*)(ws + WS_OB), (const bf16_t*)(ws + WS_WBR) + (size_t)l * DM * OBW, opq(SEQ), opq(DM), opq(OBW), opq(OBW), opq(OBW)}; pg8::BranchOrder S; S.init(opq(SEQ), opq(DM), opaque_g(), opaque_bx(), opq(WGM_BR)); pg8::EpiBranch E{(bf16_t*)(ws + WS_Y), DM, (bf16_t*)(ws + WS_GT), tab_in(lds, I_B_GATE) + (size_t)l * GTW};
            pg8::gemm_phase<pg8::EpiBranch, pg8::BranchOrder, GEMM_ALIGN, GEMM_SP2>(lds, g, S, E);
        }
        grid_bar(opaque_lds(lds0));
        {
            LAS unsigned char* lds = opaque_lds(lds0); unsigned char* ws = tab_ws(lds);
            const float* Xin = (l == 0) ? tab_in(lds, I_X) : (const float*)(ws + WS_X);
            pg8::Gemm g{(const bf16_t*)(ws + WS_Y), (const bf16_t*)(ws + WS_WOUT) + (size_t)l * DM * DM, opq(SEQ), opq(DM), opq(DM), opq(DM), opq(DM)}; pg8::StaticOrder S; S.init(opq(SEQ), opq(DM), opaque_g(), opaque_bx(), opq(WGM_OUT)); pg8::EpiResid E{Xin, (float*)(ws + WS_X), DM, (bf16_t*)(ws + WS_H), (u64_t*)(ws + WS_SS) + (size_t)(2 * l + 1) * SEQ};
            pg8::gemm_phase<pg8::EpiResid, pg8::StaticOrder, GEMM_ALIGN, GEMM_SP2>(lds, g, S, E);
        }
        grid_bar(opaque_lds(lds0));
        for (int rep = 0; rep < REP_FF1; ++rep) {
            LAS unsigned char* lds = opaque_lds(lds0); unsigned char* ws = tab_ws(lds);
            pg8::Gemm g{(const bf16_t*)(ws + WS_H), (const bf16_t*)(ws + WS_W1) + (size_t)l * DFF * DM, opq(SEQ), opq(DFF), opq(DM), opq(DM), opq(DM)}; pg8::StaticOrder S; S.init(opq(SEQ), opq(DFF), opaque_g(), opaque_bx(), opq(WGM_F1)); pg8::EpiBf16<1> E{(bf16_t*)(ws + WS_U), DFF, nullptr, (const u64_t*)(ws + WS_SS) + (size_t)(2 * l + 1) * SEQ, nullptr, 0, -1};
            pg8::gemm_phase<pg8::EpiBf16<1>, pg8::StaticOrder, GEMM_ALIGN, GEMM_SP2>(lds, g, S, E);
        }
        grid_bar(opaque_lds(lds0));
        {
            LAS unsigned char* lds = opaque_lds(lds0); unsigned char* ws = tab_ws(lds);
            pg8::Gemm g{(const bf16_t*)(ws + WS_U), (const bf16_t*)(ws + WS_W2) + (size_t)l * DM * DFF, opq(SEQ), opq(DM), opq(DFF), opq(DFF), opq(DFF)}; pg8::StaticOrder S; S.init(opq(SEQ), opq(DM), opaque_g(), opaque_bx(), opq(WGM_F2)); pg8::EpiResid E{(const float*)(ws + WS_X), (float*)(ws + WS_X), DM, (bf16_t*)(ws + WS_H), (u64_t*)(ws + WS_SS) + (size_t)(2 * l + 2) * SEQ};
            pg8::gemm_phase<pg8::EpiResid, pg8::StaticOrder, GEMM_ALIGN, GEMM_SP2>(lds, g, S, E);
        }
        grid_bar(opaque_lds(lds0));
    }
    {
        LAS unsigned char* lds = opaque_lds(lds0); unsigned char* ws = tab_ws(lds);
        const float* X = (const float*)(ws + WS_X); const float* gain = tab_in(lds, I_FINAL_NORM); float* out = (float*)(GAS float*)tab_ld(lds, 23); const int lane = LANE;
        const u64_t* ssf = (const u64_t*)(ws + WS_SS) + (size_t)8 * SEQ;
        for (int m = GW; m < SEQ; m += NGW) row_scale_f32(X + (size_t)m * DM, gain, ss_to_f(ssf[m]), out + (size_t)m * DM, lane);
    }
}

extern "C" void kernel_launch(void* const* d_in, const int* in_sizes, int n_in, void* d_out, int out_size, void* d_ws, size_t ws_size, hipStream_t stream) {
    static int grid = 0;
    if (grid == 0) {
        if (n_in != 23 || out_size != SEQ * DM || ws_size < WS_END) { fprintf(stderr, "kernel_launch: unexpected shapes (n_in %d out %d ws %zu, need %zu)\n", n_in, out_size, ws_size, (size_t)WS_END); grid = -1; return; }
        int dev = 0, cus = 0, per_cu = 0;
        if (hipGetDevice(&dev) != hipSuccess || hipDeviceGetAttribute(&cus, hipDeviceAttributeMultiprocessorCount, dev) != hipSuccess) { grid = -1; return; }
        if (hipFuncSetAttribute((const void*)trunk_fwd, hipFuncAttributeMaxDynamicSharedMemorySize, LDS_BYTES) != hipSuccess) { fprintf(stderr, "kernel_launch: hipFuncSetAttribute failed\n"); grid = -1; return; }
        if (hipOccupancyMaxActiveBlocksPerMultiprocessor(&per_cu, (const void*)trunk_fwd, 512, LDS_BYTES) != hipSuccess || per_cu < 1) { fprintf(stderr, "kernel_launch: occupancy query says %d\n", per_cu); (void)hipGetLastError(); }
        grid = cus;
    }
    if (grid < 0) return;
    if (hipMemsetAsync((char*)d_ws + WS_CTL, 0, CTL_ZERO_BYTES, stream) != hipSuccess) return;
    if (hipMemsetAsync((char*)d_ws + WS_SS, 0, SS_ZERO_BYTES, stream) != hipSuccess) return;
    Params p{};
    for (int i = 0; i < 23; ++i) p.in[i] = (const float*)d_in[i];
    p.out = (float*)d_out; p.ws = (unsigned char*)d_ws;
    hipLaunchKernelGGL(trunk_fwd, dim3(grid), dim3(512), LDS_BYTES, stream, p);
}
```

```cpp
#include <hip/hip_runtime.h>
#include <cstdio>
#include <cstdint>

#define DI __device__ __forceinline__
#define GAS __attribute__((address_space(1)))
#define LAS __attribute__((address_space(3)))
typedef unsigned short bf16_t;
typedef short bf16x8 __attribute__((ext_vector_type(8)));
typedef float f32x4 __attribute__((ext_vector_type(4)));
typedef float f32x2 __attribute__((ext_vector_type(2)));
typedef unsigned u32x4 __attribute__((ext_vector_type(4)));
typedef unsigned u32x2 __attribute__((ext_vector_type(2)));

constexpr int SEQ = 16384, DM = 4096, DFF = 16384, NL = 4, MEML = 256, CH = 64, NCH = SEQ / CH;
constexpr int IN_W = 7448, ZW = 7680;
constexpr int ZC_GQ = 0, ZC_GK = 512, ZC_GV = 1024, ZC_GG = 2048, ZC_MQK = 3072, ZC_MV = 4096, ZC_MO = 5120, ZC_XQ = 6144, ZC_GATE = 7168, ZC_GA = 7424, ZC_MI = 7440, ZC_MF = 7444;
constexpr int OBW = 3840, OB_O = 768;
constexpr int GTW = 12288;
constexpr float EPS = 1e-6f;
#ifndef PITCH_PAD
#define PITCH_PAD 64
#endif
constexpr int PW = DM + PITCH_PAD, PU = DFF + PITCH_PAD;

constexpr size_t MiB = 1u << 20;
constexpr size_t WS_CTL = 0, CTL_ZERO_BYTES = 1 * MiB;
constexpr size_t WS_WIN = 1 * MiB, WS_WBR = 245 * MiB, WS_WOUT = 365 * MiB, WS_W1 = 495 * MiB, WS_W2 = 1015 * MiB;
constexpr size_t WS_WMK = 1529 * MiB, WS_WMV = 1561 * MiB, WS_MEMN = 1593 * MiB, WS_KM = 1595 * MiB, WS_VMT = 1597 * MiB;
constexpr size_t WS_X = 1599 * MiB, WS_H = 1855 * MiB, WS_Z = 1985 * MiB, WS_GT = 2225 * MiB, WS_U = WS_Z  ;
constexpr size_t WS_OB = 2609 * MiB, WS_Y = 2729 * MiB, WS_DS = 2859 * MiB, WS_SP = 2987 * MiB, WS_DC = 3051 * MiB, WS_CP = 3179 * MiB;
constexpr size_t WS_SMALL = 3243 * MiB, WS_SS = 3245 * MiB, SS_ZERO_BYTES = 2 * MiB, WS_BG = 3247 * MiB, WS_END = 3279 * MiB;
static_assert(PITCH_PAD <= 64, "buffer sizes below assume at most 64 elements of row padding");
static_assert(WS_WIN + (size_t)NL * ZW * PW * 2 <= WS_WBR && WS_WBR + (size_t)NL * DM * OBW * 2 <= WS_WOUT && WS_WOUT + (size_t)NL * DM * PW * 2 <= WS_W1 && WS_W1 + (size_t)NL * DFF * PW * 2 <= WS_W2 && WS_W2 + (size_t)NL * DM * PU * 2 <= WS_WMK, "weight map");
static_assert(WS_H + (size_t)SEQ * PW * 2 <= WS_Z && WS_Y + (size_t)SEQ * PW * 2 <= WS_DS, "activation map");
static_assert(WS_OB + (size_t)SEQ * OBW * 2 <= WS_Y, "OB size");
constexpr size_t SM_DECAY = 0, SM_DN = 512 * 1024, SM_NP = 1024 * 1024, SM_GG = 1536 * 1024, SM_FL = 1536 * 1024 + 4096, SM_MP = 1536 * 1024 + 8192;
static_assert(WS_U + (size_t)SEQ * PU * 2 <= WS_OB, "U overlay");
constexpr int CW_BAR = 4096;
static_assert(9 * (size_t)SEQ * 8 <= SS_ZERO_BYTES, "SS region");
typedef unsigned long long u64_t;
DI float ss_to_f(u64_t v) { return (float)v * (1.0f / 16777216.0f); }

constexpr int LDS_BYTES = 147456;
constexpr int L_ST = 0, L_VT = 69632, L_Q = 106496, L_K = 123904, L_MISC = 141312, L_BARW = 146432;
constexpr int ROW72 = 144, ROW136 = 272, ROW264 = 528;
constexpr int NWAVES = 8;

DI float bf2f(unsigned v) { return __uint_as_float(v << 16); }
DI float bflo(unsigned w) { return __uint_as_float(w << 16); }
DI float bfhi(unsigned w) { return __uint_as_float(w & 0xffff0000u); }
typedef __bf16 bf16x2_t __attribute__((ext_vector_type(2)));
DI unsigned pk2(float lo, float hi) { const f32x2 v = {lo, hi}; const bf16x2_t b = __builtin_convertvector(v, bf16x2_t); return __builtin_bit_cast(unsigned, b); }
DI float sigmoid_f(float x) { return __builtin_amdgcn_rcpf(1.0f + __expf(-x)); }
DI float silu_f(float x) { return x * sigmoid_f(x); }
DI float log_sigmoid_f(float x) { return fminf(x, 0.f) - __logf(1.0f + __expf(-fabsf(x))); }
DI float shx(float v, int o, int lane) { return __int_as_float(__builtin_amdgcn_ds_bpermute((lane ^ o) << 2, __float_as_int(v))); }
DI float shi(float v, int src) { return __int_as_float(__builtin_amdgcn_ds_bpermute(src << 2, __float_as_int(v))); }
DI float wave_sum(float v, int lane) {
#pragma unroll
    for (int o = 1; o < 64; o <<= 1) v += shx(v, o, lane);
    return v;
}
DI float wave_max(float v, int lane) {
#pragma unroll
    for (int o = 1; o < 64; o <<= 1) v = fmaxf(v, shx(v, o, lane));
    return v;
}
DI float wave_scan_sum(float v, int lane) {
#pragma unroll
    for (int o = 1; o < 64; o <<= 1) { const float t = shi(v, lane >= o ? lane - o : lane); if (lane >= o) v += t; }
    return v;
}
DI float wave_scan_max(float v, int lane) {
#pragma unroll
    for (int o = 1; o < 64; o <<= 1) { const float t = shi(v, lane >= o ? lane - o : lane); if (lane >= o) v = fmaxf(v, t); }
    return v;
}
DI f32x4 mfma16(bf16x8 a, bf16x8 b, f32x4 c) { return __builtin_amdgcn_mfma_f32_16x16x32_bf16(a, b, c, 0, 0, 0); }
DI int opaque_tid() { int t = (int)threadIdx.x; asm volatile("" : "+v"(t)); return t; }
DI int opaque_bx() { int b = (int)blockIdx.x; asm volatile("" : "+s"(b)); return b; }
DI LAS unsigned char* opaque_lds(LAS unsigned char* p) { asm volatile("" : "+s"(p)); return p; }
DI int opq(int v) { asm volatile("" : "+s"(v)); return v; }
DI int opaque_g() { int g = (int)gridDim.x; asm volatile("" : "+s"(g)); return g; }

namespace pg8 {
#define PG8_LAS __attribute__((address_space(3)))
constexpr int BM = 256, BK = 64, HALF = 128, HTB = HALF * BK * 2  , STAGE_BYTES = 8 * HTB, NXCD = 8;
#ifndef PG8_WGM
#define PG8_WGM 4
#endif
constexpr int WGM = PG8_WGM;

__host__ __device__ __forceinline__ int lds_byte(int r, int c) { const int st = (r >> 4) * 2 + (c >> 5), rr = r & 15, cc = c & 31, ob = rr * 64 + cc * 2; return st * 1024 + (ob ^ (((ob >> 9) & 1) << 5)); }
__host__ __device__ __forceinline__ void stage_rc(int b, int& R, int& C) { const int st = b / 1024, sb = b % 1024, swz = sb ^ (((sb >> 9) & 1) << 5); R = (st >> 1) * 16 + swz / 64; C = (st & 1) * 32 + (swz % 64) / 2; }
__host__ __device__ __forceinline__ int perm32(int rho) { const int n = rho >> 4, i = rho & 15; return 8 * (i >> 2) + 4 * n + (i & 3); }

struct Unit { int pm, pn, kind; };
struct Gemm { const bf16_t* A; const bf16_t* Bt; int M, N, K, lda, ldb; };

struct StaticOrder {
    int nM, nN, nwg, G, c, wgm;
    __host__ __device__ void init(int M, int N, int G_, int c_, int wgm_ = WGM) { nM = M / BM; nN = N / BM; nwg = nM * nN; G = G_; c = c_; wgm = wgm_; }
    __host__ __device__ bool next(int i, Unit& u) const {
        const long L = (long)i * G + c; if (L >= nwg) return false;
        int wgid = (int)L; { const int q = nwg / NXCD, r = nwg % NXCD, xcd = wgid % NXCD, off = wgid / NXCD; wgid = (xcd < r ? xcd * (q + 1) : r * (q + 1) + (xcd - r) * q) + off; }
        const int nig = wgm * nN, gid = wgid / nig, fm = gid * wgm, gsz = (nM - fm) < wgm ? (nM - fm) : wgm;
        u.pm = fm + ((wgid % nig) % gsz); u.pn = (wgid % nig) / gsz; u.kind = 0; return true;
    }
    __device__ __forceinline__ void a_ready(const Unit&) const {}
    __device__ __forceinline__ void done(const Unit&) const {}
    __device__ __forceinline__ int nt(const Unit&, int nt_default) const { return nt_default; }
    __device__ __forceinline__ int koff(const Unit&) const { return 0; }
};
struct BranchOrder : StaticOrder {
    __host__ __device__ bool next(int i, Unit& u) const { if (!StaticOrder::next(i >> 2, u)) return false; u.kind = i & 3; return true; }
    __device__ __forceinline__ int nt(const Unit& u, int) const { return u.kind < 3 ? 4 : 48; }
    __device__ __forceinline__ int koff(const Unit& u) const { return u.kind < 3 ? 256 * u.kind : 768; }
};

template <int ACT  > struct EpiBf16 {
    static constexpr bool PERM = true, AFTER_DRAIN = false, HOOK = false;
    bf16_t* O; int ldc; const float* bias; const unsigned long long* ss; bf16_t* O2; int ld2, pn2;
    __device__ __forceinline__ void operator()(const f32x4 (&acc)[2][2][4][2], const Unit& u, int wr, int wc, int fr, int fq) const {
        const int row0 = u.pm * BM + wr * 64 + fr, col0 = u.pn * BM + wc * 32 + 8 * fq;
        f32x4 bv[2][2];
#pragma unroll
        for (int bj = 0; bj < 2; ++bj)
#pragma unroll
            for (int n = 0; n < 2; ++n) bv[bj][n] = (ACT == 2) ? *(const f32x4*)(bias + col0 + bj * HALF + 4 * n) : (f32x4){0.f, 0.f, 0.f, 0.f};
#pragma unroll
        for (int ai = 0; ai < 2; ++ai)
#pragma unroll
            for (int m = 0; m < 4; ++m) { bf16_t* rowp = O + (size_t)(row0 + ai * HALF + m * 16) * ldc + col0;
                const bool redir = (ACT == 0) && O2 != nullptr && u.pn == pn2;
                if (redir) rowp = O2 + (size_t)(row0 + ai * HALF + m * 16) * ld2 + (col0 - u.pn * BM);
                float rs = 1.f; if (ACT != 2) { if (ss) rs = 1.0f / sqrtf((float)ss[row0 + ai * HALF + m * 16] * (1.0f / 16777216.0f) * (1.0f / DM) + EPS); }
#pragma unroll
                for (int bj = 0; bj < 2; ++bj) { f32x4 v0 = acc[ai][bj][m][0], v1 = acc[ai][bj][m][1];
                    if (ACT != 2) { v0 = v0 * rs; v1 = v1 * rs; }
                    if (ACT == 1) {
#pragma unroll
                        for (int j = 0; j < 4; ++j) { const float a = fmaxf(v0[j], 0.f), b = fmaxf(v1[j], 0.f); v0[j] = a * a; v1[j] = b * b; } }
                    if (ACT == 2) { v0 = v0 + bv[bj][0]; v1 = v1 + bv[bj][1];
#pragma unroll
                        for (int j = 0; j < 4; ++j) { v0[j] = sigmoid_f(fminf(fmaxf(v0[j], -30.f), 30.f)); v1[j] = sigmoid_f(fminf(fmaxf(v1[j], -30.f), 30.f)); } }
                    u32x4 w; w.x = pk2(v0[0], v0[1]); w.y = pk2(v0[2], v0[3]); w.z = pk2(v1[0], v1[1]); w.w = pk2(v1[2], v1[3]);
                    *(u32x4*)(rowp + bj * HALF) = w;
                    if (redir) { *(u32x4*)(rowp + bj * HALF + 256) = w; *(u32x4*)(rowp + bj * HALF + 512) = w; } } }
    }
    __device__ __forceinline__ bool hook_at(const Unit&, int) const { return false; }
    __device__ __forceinline__ void hook(f32x4 (&)[2][2][4][2], const Unit&, int, int, int, int, int) const {}
};
struct EpiResid {
    static constexpr bool PERM = true, AFTER_DRAIN = false, HOOK = false;
    const float* in; float* out; int ldc; bf16_t* xb; unsigned long long* ss; int ldxb;
    __device__ __forceinline__ void operator()(const f32x4 (&acc)[2][2][4][2], const Unit& u, int wr, int wc, int fr, int fq) const {
        const int row0 = u.pm * BM + wr * 64 + fr, col0 = u.pn * BM + wc * 32 + 8 * fq, lane = fq * 16 + fr;
#pragma unroll
        for (int ai = 0; ai < 2; ++ai) {
            f32x4 r[4][2][2];
#pragma unroll
            for (int m = 0; m < 4; ++m) { const size_t off = (size_t)(row0 + ai * HALF + m * 16) * ldc + col0;
#pragma unroll
                for (int bj = 0; bj < 2; ++bj)
#pragma unroll
                    for (int n = 0; n < 2; ++n) r[m][bj][n] = *(const f32x4*)(in + off + bj * HALF + n * 4); }
#pragma unroll
            for (int m = 0; m < 4; ++m) { const int row = row0 + ai * HALF + m * 16; const size_t off = (size_t)row * ldc + col0;
                float sq = 0.f;
#pragma unroll
                for (int bj = 0; bj < 2; ++bj) { const f32x4 o0 = r[m][bj][0] + acc[ai][bj][m][0], o1 = r[m][bj][1] + acc[ai][bj][m][1];
                    *(f32x4*)(out + off + bj * HALF) = o0; *(f32x4*)(out + off + bj * HALF + 4) = o1;
                    sq += (o0[0] * o0[0] + o0[1] * o0[1]) + (o0[2] * o0[2] + o0[3] * o0[3]) + (o1[0] * o1[0] + o1[1] * o1[1]) + (o1[2] * o1[2] + o1[3] * o1[3]);
                    u32x4 w; w.x = pk2(o0[0], o0[1]); w.y = pk2(o0[2], o0[3]); w.z = pk2(o1[0], o1[1]); w.w = pk2(o1[2], o1[3]);
                    *(u32x4*)(xb + (size_t)row * ldxb + col0 + bj * HALF) = w; }
                sq += shx(sq, 16, lane); sq += shx(sq, 32, lane);
                if (fq == 0) (void)__hip_atomic_fetch_add(ss + row, (unsigned long long)(sq * 16777216.0f), __ATOMIC_RELAXED, __HIP_MEMORY_SCOPE_AGENT); }
            asm volatile("" ::: "memory"); }
    }
    __device__ __forceinline__ bool hook_at(const Unit&, int) const { return false; }
    __device__ __forceinline__ void hook(f32x4 (&)[2][2][4][2], const Unit&, int, int, int, int, int) const {}
};
struct EpiBranch {
    static constexpr bool PERM = true, AFTER_DRAIN = false, HOOK = true;
    bf16_t* O; int ldc; bf16_t* GT; const float* bias;
    __device__ __forceinline__ bool hook_at(const Unit& u, int t) const { return u.kind == 3 && (t == 16 || t == 32); }
    __device__ __forceinline__ void hook(f32x4 (&acc)[2][2][4][2], const Unit& u, int t, int, int, int, int) const {
        const int tid_ = opaque_tid(), wid_ = tid_ >> 6, wr = wid_ >> 2, wc = wid_ & 3, fr = tid_ & 15, fq = (tid_ >> 4) & 3;
        const int row0 = u.pm * BM + wr * 64 + fr, col0 = u.pn * BM + wc * 32 + 8 * fq;
        const bf16_t* ga = GT + (size_t)(t == 16 ? 0 : DM); const bf16_t* gb = ga + DM;
#pragma unroll
        for (int ai = 0; ai < 2; ++ai) {
            u32x4 a[4][2], b[4][2];
#pragma unroll
            for (int m = 0; m < 4; ++m) { const size_t off = (size_t)(row0 + ai * HALF + m * 16) * GTW + col0;
#pragma unroll
                for (int bj = 0; bj < 2; ++bj) { a[m][bj] = *(const u32x4*)(ga + off + bj * HALF); b[m][bj] = *(const u32x4*)(gb + off + bj * HALF); } }
#pragma unroll
            for (int m = 0; m < 4; ++m)
#pragma unroll
                for (int bj = 0; bj < 2; ++bj) { const u32x4 x = a[m][bj], y = b[m][bj];
                    f32x4 r0, r1;
                    r0[0] = bflo(y.x) * __builtin_amdgcn_rcpf(bflo(x.x)); r0[1] = bfhi(y.x) * __builtin_amdgcn_rcpf(bfhi(x.x));
                    r0[2] = bflo(y.y) * __builtin_amdgcn_rcpf(bflo(x.y)); r0[3] = bfhi(y.y) * __builtin_amdgcn_rcpf(bfhi(x.y));
                    r1[0] = bflo(y.z) * __builtin_amdgcn_rcpf(bflo(x.z)); r1[1] = bfhi(y.z) * __builtin_amdgcn_rcpf(bfhi(x.z));
                    r1[2] = bflo(y.w) * __builtin_amdgcn_rcpf(bflo(x.w)); r1[3] = bfhi(y.w) * __builtin_amdgcn_rcpf(bfhi(x.w));
                    acc[ai][bj][m][0] = acc[ai][bj][m][0] * r0; acc[ai][bj][m][1] = acc[ai][bj][m][1] * r1; }
            asm volatile("" ::: "memory"); }
    }
    __device__ __forceinline__ void operator()(const f32x4 (&acc)[2][2][4][2], const Unit& u, int wr, int wc, int fr, int fq) const {
        const int row0 = u.pm * BM + wr * 64 + fr, col0 = u.pn * BM + wc * 32 + 8 * fq;
        if (u.kind < 3) {
            bf16_t* gd = GT + (size_t)u.kind * DM; const float* bj_ = bias + (size_t)u.kind * DM + col0;
            f32x4 bv[2][2];
#pragma unroll
            for (int bj = 0; bj < 2; ++bj)
#pragma unroll
                for (int n = 0; n < 2; ++n) bv[bj][n] = *(const f32x4*)(bj_ + bj * HALF + 4 * n);
#pragma unroll
            for (int ai = 0; ai < 2; ++ai)
#pragma unroll
                for (int m = 0; m < 4; ++m) { const size_t off = (size_t)(row0 + ai * HALF + m * 16) * GTW + col0;
#pragma unroll
                    for (int bj = 0; bj < 2; ++bj) { f32x4 v0 = acc[ai][bj][m][0] + bv[bj][0], v1 = acc[ai][bj][m][1] + bv[bj][1];
#pragma unroll
                        for (int e = 0; e < 4; ++e) { v0[e] = 1.0f + __expf(-fminf(fmaxf(v0[e], -30.f), 30.f)); v1[e] = 1.0f + __expf(-fminf(fmaxf(v1[e], -30.f), 30.f)); }
                        u32x4 w; w.x = pk2(v0[0], v0[1]); w.y = pk2(v0[2], v0[3]); w.z = pk2(v1[0], v1[1]); w.w = pk2(v1[2], v1[3]);
                        *(u32x4*)(gd + off + bj * HALF) = w; } }
        } else {
            const bf16_t* gc = GT + 2 * DM;
            u32x4 g[2][4][2];
#pragma unroll
            for (int ai = 0; ai < 2; ++ai)
#pragma unroll
                for (int m = 0; m < 4; ++m)
#pragma unroll
                    for (int bj = 0; bj < 2; ++bj) g[ai][m][bj] = *(const u32x4*)(gc + (size_t)(row0 + ai * HALF + m * 16) * GTW + col0 + bj * HALF);
#pragma unroll
            for (int ai = 0; ai < 2; ++ai)
#pragma unroll
                for (int m = 0; m < 4; ++m) { const size_t r = (size_t)(row0 + ai * HALF + m * 16);
#pragma unroll
                    for (int bj = 0; bj < 2; ++bj) { const u32x4 gg = g[ai][m][bj];
                        const f32x4 v0 = acc[ai][bj][m][0], v1 = acc[ai][bj][m][1];
                        u32x4 w; w.x = pk2(v0[0] * __builtin_amdgcn_rcpf(bflo(gg.x)), v0[1] * __builtin_amdgcn_rcpf(bfhi(gg.x))); w.y = pk2(v0[2] * __builtin_amdgcn_rcpf(bflo(gg.y)), v0[3] * __builtin_amdgcn_rcpf(bfhi(gg.y)));
                        w.z = pk2(v1[0] * __builtin_amdgcn_rcpf(bflo(gg.z)), v1[1] * __builtin_amdgcn_rcpf(bfhi(gg.z))); w.w = pk2(v1[2] * __builtin_amdgcn_rcpf(bflo(gg.w)), v1[3] * __builtin_amdgcn_rcpf(bfhi(gg.w)));
                        *(u32x4*)(O + r * ldc + col0 + bj * HALF) = w; } }
        }
    }
};

template <class Epi, class Sched, bool ALIGN_EPI = false, bool SP2 = false>
__device__ __forceinline__ void gemm_phase(PG8_LAS unsigned char* lds, const Gemm g, const Sched& S, const Epi& E) {
    const int tid = opaque_tid(), wid = __builtin_amdgcn_readfirstlane(tid >> 6), lane = tid & 63, wr = wid >> 2, wc = wid & 3, fr = lane & 15, fq = lane >> 4;
    const int K = g.K, nt_default = K / BK;
    unsigned voffA[2], voffB[2];
#pragma unroll
    for (int i = 0; i < 2; ++i) { int R, C; stage_rc(tid * 16 + i * 8192, R, C); const int Rb = Epi::PERM ? ((R & ~31) + perm32(R & 31)) : R;
        voffA[i] = (unsigned)(R * g.lda + C) * 2u; voffB[i] = (unsigned)(Rb * g.ldb + C) * 2u; }
    const size_t kstep = (size_t)(BK * 2);
    const size_t hstepA = (size_t)HALF * g.lda * 2, hstepB = (size_t)HALF * g.ldb * 2;
    const size_t tstepA = 2 * hstepA, tstepB = 2 * hstepB;
    const unsigned ldsw = (unsigned)wid * 1024u;
    const int aoff = lds_byte(wr * 64 + fr, fq * 8), boff = lds_byte(wc * 32 + fr, fq * 8);
#define PG8_SA(b, h) (((b) * 2 + (h)) * HTB)
#define PG8_SB(b, h) ((4 + (b) * 2 + (h)) * HTB)
#define PG8_STAGE(bufoff, gbase, voff) do { _Pragma("unroll") for (int _i = 0; _i < 2; ++_i) \
        __builtin_amdgcn_global_load_lds((const unsigned*)((const char*)(gbase) + (voff)[_i]), (PG8_LAS unsigned*)(lds + (bufoff) + ldsw + _i * 8192), 16, 0, 0); } while (0)
#define PG8_LDA(dst, b, h) do { _Pragma("unroll") for (int m = 0; m < 4; ++m) _Pragma("unroll") for (int k = 0; k < 2; ++k) dst[m][k] = *(const PG8_LAS bf16x8*)(lds + PG8_SA(b, h) + aoff + m * 2048 + k * 1024); } while (0)
#define PG8_LDB(dst, b, h) do { _Pragma("unroll") for (int n = 0; n < 2; ++n) _Pragma("unroll") for (int k = 0; k < 2; ++k) dst[n][k] = *(const PG8_LAS bf16x8*)(lds + PG8_SB(b, h) + boff + n * 2048 + k * 1024); } while (0)
#ifndef PG8_PRIO
#define PG8_PRIO 1
#endif
#define PG8_MMA(ai, bj, At, Bt) do { if (PG8_PRIO) __builtin_amdgcn_s_setprio(PG8_PRIO); _Pragma("unroll") for (int m = 0; m < 4; ++m) _Pragma("unroll") for (int n = 0; n < 2; ++n) _Pragma("unroll") for (int k = 0; k < 2; ++k) \
        acc[ai][bj][m][n] = __builtin_amdgcn_mfma_f32_16x16x32_bf16(Bt[n][k], At[m][k], acc[ai][bj][m][n], 0, 0, 0); if (PG8_PRIO) __builtin_amdgcn_s_setprio(0); } while (0)
#define PG8_WAIT_V(n) asm volatile("s_waitcnt vmcnt(" #n ")" ::: "memory")
#define PG8_WAIT_L(n) asm volatile("s_waitcnt lgkmcnt(" #n ")" ::: "memory")
#define PG8_BAR __builtin_amdgcn_s_barrier()
#define PG8_SCHED __builtin_amdgcn_sched_barrier(0)
    Unit cur, nxt; int ui = 0;
    if (!S.next(0, cur)) return;
    f32x4 acc[2][2][4][2];
#pragma unroll
    for (int a = 0; a < 2; ++a)
#pragma unroll
        for (int b = 0; b < 2; ++b)
#pragma unroll
            for (int m = 0; m < 4; ++m)
#pragma unroll
                for (int n = 0; n < 2; ++n) acc[a][b][m][n] = (f32x4){0.f, 0.f, 0.f, 0.f};
    bf16x8 At[4][2], B0[2][2], B1[2][2];
    const char* cA = (const char*)g.A + (size_t)cur.pm * tstepA + (size_t)S.koff(cur) * 2; const char* cB = (const char*)g.Bt + (size_t)cur.pn * tstepB + (size_t)S.koff(cur) * 2;
    int nt = S.nt(cur, nt_default);
    S.a_ready(cur);
    if constexpr (SP2) {
        PG8_STAGE(PG8_SB(0, 0), cB, voffB); PG8_STAGE(PG8_SB(0, 1), cB + hstepB, voffB); PG8_STAGE(PG8_SA(0, 0), cA, voffA); PG8_STAGE(PG8_SA(0, 1), cA + hstepA, voffA);
        if (wr == 1) PG8_BAR;
        PG8_WAIT_V(2); PG8_BAR;
        PG8_STAGE(PG8_SB(1, 0), cB + kstep, voffB); PG8_STAGE(PG8_SA(1, 0), cA + kstep, voffA); PG8_STAGE(PG8_SB(1, 1), cB + hstepB + kstep, voffB);
        PG8_WAIT_V(6); PG8_BAR;
    } else {
        PG8_STAGE(PG8_SB(0, 0), cB, voffB); PG8_STAGE(PG8_SA(0, 0), cA, voffA); PG8_STAGE(PG8_SB(0, 1), cB + hstepB, voffB); PG8_STAGE(PG8_SA(0, 1), cA + hstepA, voffA);
        if (wr == 1) PG8_BAR;
        PG8_WAIT_V(4); PG8_BAR;
        PG8_STAGE(PG8_SB(1, 0), cB + kstep, voffB); PG8_STAGE(PG8_SA(1, 0), cA + kstep, voffA); PG8_STAGE(PG8_SB(1, 1), cB + hstepB + kstep, voffB);
        PG8_WAIT_V(6); PG8_BAR;
    }
    for (;;) {
        const bool has_next = S.next(ui + 1, nxt);
        const char* nA = has_next ? (const char*)g.A + (size_t)nxt.pm * tstepA + (size_t)S.koff(nxt) * 2 : cA; const char* nB = has_next ? (const char*)g.Bt + (size_t)nxt.pn * tstepB + (size_t)S.koff(nxt) * 2 : cB;
        for (int t = 0; t < nt; t += 2) {
            const bool last = (t == nt - 2);
            if constexpr (Epi::HOOK) { if (E.hook_at(cur, t)) E.hook(acc, cur, t, wr, wc, fr, fq); }
            const char* a1 = cA + (size_t)(t + 1) * kstep;
            const char* a2 = last ? nA : cA + (size_t)(t + 2) * kstep; const char* b2 = last ? nB : cB + (size_t)(t + 2) * kstep;
            const char* a3 = a2 + kstep; const char* b3 = b2 + kstep;
            if (last && has_next) S.a_ready(nxt);
            if constexpr (SP2) {
            PG8_LDB(B0, 0, 0); PG8_LDB(B1, 0, 1); PG8_SCHED; PG8_LDA(At, 0, 0); PG8_STAGE(PG8_SA(1, 1), a1 + hstepA, voffA);
            PG8_WAIT_V(8); PG8_WAIT_L(0); PG8_BAR; PG8_MMA(0, 0, At, B0); PG8_MMA(0, 1, At, B1); PG8_BAR; PG8_SCHED;
            PG8_LDA(At, 0, 1); PG8_STAGE(PG8_SB(0, 0), b2, voffB); PG8_STAGE(PG8_SB(0, 1), b2 + hstepB, voffB); PG8_STAGE(PG8_SA(0, 0), a2, voffA);
            PG8_WAIT_V(8); PG8_WAIT_L(0); PG8_BAR; PG8_MMA(1, 0, At, B0); PG8_MMA(1, 1, At, B1); PG8_BAR; PG8_SCHED;
            PG8_LDB(B0, 1, 0); PG8_LDB(B1, 1, 1); PG8_SCHED; PG8_LDA(At, 1, 0); PG8_STAGE(PG8_SA(0, 1), a2 + hstepA, voffA);
            PG8_WAIT_V(8); PG8_WAIT_L(0); PG8_BAR; PG8_MMA(0, 0, At, B0); PG8_MMA(0, 1, At, B1); PG8_BAR; PG8_SCHED;
            PG8_LDA(At, 1, 1); PG8_STAGE(PG8_SB(1, 0), b3, voffB); PG8_STAGE(PG8_SB(1, 1), b3 + hstepB, voffB); PG8_STAGE(PG8_SA(1, 0), a3, voffA);
            PG8_WAIT_V(8); PG8_WAIT_L(0); PG8_BAR; PG8_MMA(1, 0, At, B0); PG8_MMA(1, 1, At, B1); PG8_BAR; PG8_SCHED;
            } else {
            PG8_LDB(B0, 0, 0); PG8_SCHED; PG8_LDA(At, 0, 0); PG8_STAGE(PG8_SA(1, 1), a1 + hstepA, voffA);
            PG8_WAIT_L(8); PG8_BAR; PG8_WAIT_L(0); PG8_MMA(0, 0, At, B0); PG8_BAR; PG8_SCHED;
            PG8_LDB(B1, 0, 1); PG8_STAGE(PG8_SB(0, 0), b2, voffB);
            PG8_BAR; PG8_WAIT_L(0); PG8_MMA(0, 1, At, B1); PG8_BAR;
            PG8_LDA(At, 0, 1); PG8_STAGE(PG8_SA(0, 0), a2, voffA);
            PG8_BAR; PG8_WAIT_L(0); PG8_MMA(1, 0, At, B0); PG8_BAR; PG8_SCHED;
            PG8_STAGE(PG8_SB(0, 1), b2 + hstepB, voffB);
            PG8_WAIT_V(6); PG8_BAR; PG8_MMA(1, 1, At, B1); PG8_BAR;
            PG8_LDB(B0, 1, 0); PG8_SCHED; PG8_LDA(At, 1, 0); PG8_STAGE(PG8_SA(0, 1), a2 + hstepA, voffA);
            PG8_WAIT_L(8); PG8_BAR; PG8_WAIT_L(0); PG8_MMA(0, 0, At, B0); PG8_BAR; PG8_SCHED;
            PG8_LDB(B1, 1, 1); PG8_STAGE(PG8_SB(1, 0), b3, voffB);
            PG8_BAR; PG8_WAIT_L(0); PG8_MMA(0, 1, At, B1); PG8_BAR;
            PG8_LDA(At, 1, 1); PG8_STAGE(PG8_SA(1, 0), a3, voffA);
            PG8_BAR; PG8_WAIT_L(0); PG8_MMA(1, 0, At, B0); PG8_BAR; PG8_SCHED;
            PG8_STAGE(PG8_SB(1, 1), b3 + hstepB, voffB);
            PG8_WAIT_V(6); PG8_BAR; PG8_MMA(1, 1, At, B1); PG8_BAR;
            }
        }
        if constexpr (ALIGN_EPI) { if (wr == 0) PG8_BAR; }
        E(acc, cur, wr, wc, fr, fq); S.done(cur);
        if (!has_next) break;
#pragma unroll
        for (int a = 0; a < 2; ++a)
#pragma unroll
            for (int b = 0; b < 2; ++b)
#pragma unroll
                for (int m = 0; m < 4; ++m)
#pragma unroll
                    for (int n = 0; n < 2; ++n) acc[a][b][m][n] = (f32x4){0.f, 0.f, 0.f, 0.f};
        cur = nxt; cA = nA; cB = nB; ++ui; nt = S.nt(cur, nt_default);
        if constexpr (ALIGN_EPI) { if (wr == 1) PG8_BAR; }
    }
    PG8_WAIT_V(0);
    if constexpr (!ALIGN_EPI) { if (wr == 0) PG8_BAR; }
    PG8_BAR;
#undef PG8_SA
#undef PG8_SB
#undef PG8_STAGE
#undef PG8_LDA
#undef PG8_LDB
#undef PG8_MMA
#undef PG8_WAIT_V
#undef PG8_WAIT_L
#undef PG8_BAR
#undef PG8_SCHED
}
}

#define XB_TMO      128
#define XB_XCNT(j)  (256  + 64 * (j))
#define XB_XSUB(j)  (1280 + 64 * (j))
#define XB_XGEN(j)  (2304 + 64 * (j))
#define XB_TOP      3328
#define XB_TOPGEN   3392
#define XCD_BAR_WORDS 3456
#define XB_SPIN_CAP (1u << 18)

__device__ __forceinline__ unsigned xb_ld(unsigned* p)              { return __hip_atomic_load(p, __ATOMIC_RELAXED, __HIP_MEMORY_SCOPE_AGENT); }
__device__ __forceinline__ unsigned xb_add(unsigned* p, unsigned v) { return __hip_atomic_fetch_add(p, v, __ATOMIC_RELAXED, __HIP_MEMORY_SCOPE_AGENT); }
__device__ __forceinline__ unsigned xb_xcc_id() { return (unsigned)__builtin_amdgcn_s_getreg((3 << 11) | 20) & 0xFu; }
#define XB_SPIN(cond, bar) do { unsigned _sp = 0; while (cond) { __builtin_amdgcn_s_sleep(1); \
    if ((++_sp & 255u) == 0u) { if (xb_ld(&(bar)[XB_TMO])) break; if (_sp > XB_SPIN_CAP) { atomicAdd(&(bar)[XB_TMO], 1u); break; } } } } while (0)

struct XcdBarrier {
    unsigned* bar; unsigned x;
    volatile LAS unsigned* st;
};
__device__ __forceinline__ XcdBarrier xcd_barrier_post(unsigned* bar, volatile LAS unsigned* st) {
    XcdBarrier b; b.bar = bar; b.x = xb_xcc_id(); b.st = st;
    if (threadIdx.x == 0) (void)xb_add(&bar[XB_XCNT(b.x)], 1u);
    return b;
}
__device__ __forceinline__ void xcd_barrier_complete(unsigned* bar, unsigned x, unsigned& nloc, unsigned& nx) {
    const unsigned G = gridDim.x * gridDim.y * gridDim.z;
    unsigned sum, cnt, mine, sp = 0u;
    for (;;) {
        sum = 0u; cnt = 0u; mine = 0u;
#pragma unroll
        for (unsigned j = 0; j < 16; ++j) { const unsigned c = xb_ld(&bar[XB_XCNT(j)]); sum += c; cnt += (c > 0u) ? 1u : 0u; mine = (j == x) ? c : mine; }
        if (sum == G) break;
        __builtin_amdgcn_s_sleep(1);
        if ((++sp & 255u) == 0u) { if (xb_ld(&bar[XB_TMO])) break; if (sp > XB_SPIN_CAP) { atomicAdd(&bar[XB_TMO], 1u); break; } }
    }
    nloc = mine > 0u ? mine : 1u; nx = cnt > 0u ? cnt : 1u;
}
__device__ __forceinline__ void xcd_barrier(const XcdBarrier& b) {
    asm volatile("s_waitcnt vmcnt(0)" ::: "memory");
    __syncthreads();
    if (threadIdx.x == 0) {
        unsigned* bar = b.bar;
        __builtin_amdgcn_s_waitcnt(0);
        unsigned nloc = b.st[0], nx = b.st[1];
        if (nloc == 0u) { xcd_barrier_complete(bar, b.x, nloc, nx); b.st[0] = nloc; b.st[1] = nx; }
        const unsigned old = xb_add(&bar[XB_XSUB(b.x)], 1u);
        const unsigned gen = old / nloc;
        if (old + 1u == (gen + 1u) * nloc) {
            __builtin_amdgcn_fence(__ATOMIC_RELEASE, "agent");
            asm volatile("s_waitcnt vmcnt(0)" ::: "memory");
            const unsigned og = xb_add(&bar[XB_TOP], 1u);
            const unsigned tg = og / nx;
            if (og + 1u == (tg + 1u) * nx) xb_add(&bar[XB_TOPGEN], 1u);
            else XB_SPIN(xb_ld(&bar[XB_TOPGEN]) == tg, bar);
            __builtin_amdgcn_fence(__ATOMIC_ACQUIRE, "agent");
            xb_add(&bar[XB_XGEN(b.x)], 1u);
            asm volatile("s_waitcnt vmcnt(0)" ::: "memory");
        } else {
            XB_SPIN(xb_ld(&bar[XB_XGEN(b.x)]) == gen, bar);
            __builtin_amdgcn_fence(__ATOMIC_ACQUIRE, "agent");
            asm volatile("s_waitcnt vmcnt(0)" ::: "memory");
        }
    }
    __syncthreads();
}

struct Params { const float* in[23]; float* out; unsigned char* ws; };
enum { I_X = 0, I_MEM, I_NORM_MIX, I_W_IN, I_W_GLA_A, I_B_GLA_A, I_GLA_NORM, I_CONV_W, I_CONV_B, I_B_ML_I, I_B_ML_F, I_ML_NORM, I_MEM_NORM, I_W_MEM_K, I_W_MEM_V, I_W_BRANCH, I_W_GATE, I_B_GATE, I_W_OUT, I_NORM_FFN, I_W_FF1, I_W_FF2, I_FINAL_NORM };

DI int win_row(int n) {
    if (n < 3072) return n;
    if (n < 3088) return ZC_GA + (n - 3072);
    if (n < 6160) return n - 16;
    if (n < 6168) return ZC_MI + (n - 6160);
    return n - 24;
}
DI void transpose_item(const float* __restrict__ W, int K, int N, bf16_t* __restrict__ WT, int ld_dst, int col_off, int row_off, bool remap, LAS float* scr, int item, int lane, const float* __restrict__ gain = nullptr) {
    const int nblk = (N + 63) >> 6, kb = item / nblk, nb = item - kb * nblk, k0 = kb << 6, n0 = nb << 6;
    const int a = lane & 15, q = lane >> 4, n4 = 4 * a;
    const bool ok = (n0 + n4) < N;
    f32x4 v[16];
#pragma unroll
    for (int i = 0; i < 16; ++i) { const int kk = 4 * i + q; v[i] = ok ? *(const f32x4*)(W + (size_t)(k0 + kk) * N + n0 + n4) : (f32x4){0.f, 0.f, 0.f, 0.f}; }
#pragma unroll
    for (int i = 0; i < 16; ++i) { const int kk = 4 * i + q;
#pragma unroll
        for (int e = 0; e < 4; ++e) scr[(n4 + e) * 65 + kk] = v[i][e]; }
    asm volatile("s_waitcnt lgkmcnt(0)" ::: "memory");
    const int c = lane & 7;
    f32x4 g0 = (f32x4){1.f, 1.f, 1.f, 1.f}, g1 = g0;
    if (gain) { g0 = *(const f32x4*)(gain + k0 + 8 * c); g1 = *(const f32x4*)(gain + k0 + 8 * c + 4); }
#pragma unroll
    for (int jj = 0; jj < 8; ++jj) { const int n = (lane >> 3) + 8 * jj; const LAS float* s = scr + n * 65 + 8 * c;
        u32x4 o; o.x = pk2(s[0] * g0[0], s[1] * g0[1]); o.y = pk2(s[2] * g0[2], s[3] * g0[3]); o.z = pk2(s[4] * g1[0], s[5] * g1[1]); o.w = pk2(s[6] * g1[2], s[7] * g1[3]);
        const int ng = n0 + n;
        if (ng < N) { const int row = row_off + (remap ? win_row(ng) : ng); *(u32x4*)(WT + (size_t)row * ld_dst + col_off + k0 + 8 * c) = o; } }
    asm volatile("s_waitcnt lgkmcnt(0)" ::: "memory");
}

template <bool OUT_F32> DI void rmsnorm_row(const float* __restrict__ xrow, const float* __restrict__ g, void* orow, int lane) {
    const f32x4* xr = (const f32x4*)xrow + lane; const f32x4* gr = (const f32x4*)g + lane;
    f32x4 v[16]; float s = 0.f;
#pragma unroll
    for (int j = 0; j < 16; ++j) { v[j] = xr[64 * j]; s += (v[j].x * v[j].x + v[j].y * v[j].y) + (v[j].z * v[j].z + v[j].w * v[j].w); }
    const float rstd = 1.0f / sqrtf(wave_sum(s, lane) * (1.0f / DM) + EPS);
#pragma unroll
    for (int j = 0; j < 16; ++j) { const f32x4 gg = gr[64 * j]; const f32x4 o = v[j] * rstd * gg;
        if (OUT_F32) ((f32x4*)orow)[lane + 64 * j] = o;
        else { u32x2 w; w.x = pk2(o.x, o.y); w.y = pk2(o.z, o.w); ((u32x2*)orow)[lane + 64 * j] = w; } }
}

DI void row_bf16_ss(const float* __restrict__ xrow, bf16_t* orow, unsigned long long* ss, int lane) {
    const f32x4* xr = (const f32x4*)xrow + lane; float s = 0.f;
#pragma unroll
    for (int j = 0; j < 16; ++j) { const f32x4 v = xr[64 * j]; s += (v.x * v.x + v.y * v.y) + (v.z * v.z + v.w * v.w);
        u32x2 w; w.x = pk2(v.x, v.y); w.y = pk2(v.z, v.w); ((u32x2*)orow)[lane + 64 * j] = w; }
    s = wave_sum(s, lane);
    if (lane == 0) *ss = (unsigned long long)(s * 16777216.0f);
}
DI void row_scale_f32(const float* __restrict__ xrow, const float* __restrict__ g, float ssv, float* orow, int lane) {
    const f32x4* xr = (const f32x4*)xrow + lane; const f32x4* gr = (const f32x4*)g + lane;
    const float rstd = 1.0f / sqrtf(ssv * (1.0f / DM) + EPS);
#pragma unroll
    for (int j = 0; j < 16; ++j) ((f32x4*)orow)[lane + 64 * j] = xr[64 * j] * rstd * gr[64 * j];
}

DI void fill_vT(const bf16_t* __restrict__ Zv, int n, int tg, int lane, LAS unsigned char* VT) {
#pragma unroll
    for (int i = 0; i < 2; ++i) { const int cp = lane + 64 * i; unsigned w[8];
#pragma unroll
        for (int j = 0; j < 8; ++j) w[j] = *(const unsigned*)(Zv + (size_t)(n * CH + 8 * tg + j) * ZW + 2 * cp);
        u32x4 lo, hi;
        lo.x = (w[0] & 0xffffu) | (w[1] << 16); lo.y = (w[2] & 0xffffu) | (w[3] << 16); lo.z = (w[4] & 0xffffu) | (w[5] << 16); lo.w = (w[6] & 0xffffu) | (w[7] << 16);
        hi.x = (w[0] >> 16) | (w[1] & 0xffff0000u); hi.y = (w[2] >> 16) | (w[3] & 0xffff0000u); hi.z = (w[4] >> 16) | (w[5] & 0xffff0000u); hi.w = (w[6] >> 16) | (w[7] & 0xffff0000u);
        *(LAS u32x4*)(VT + (2 * cp) * ROW72 + tg * 16) = lo; *(LAS u32x4*)(VT + (2 * cp + 1) * ROW72 + tg * 16) = hi; }
}
DI void state_mfma(const LAS unsigned char* VT, const LAS unsigned char* KT, bf16_t* __restrict__ OUT, int w, int lane) {
    const int fr = lane & 15, fq = lane >> 4;
    f32x4 acc[2][8];
#pragma unroll
    for (int mi = 0; mi < 2; ++mi)
#pragma unroll
        for (int ni = 0; ni < 8; ++ni) acc[mi][ni] = (f32x4){0.f, 0.f, 0.f, 0.f};
#pragma unroll
    for (int ks = 0; ks < 2; ++ks) {
        bf16x8 a[2];
#pragma unroll
        for (int mi = 0; mi < 2; ++mi) a[mi] = *(const LAS bf16x8*)(VT + (32 * w + 16 * mi + fr) * ROW72 + (32 * ks + 8 * fq) * 2);
#pragma unroll
        for (int ni = 0; ni < 8; ++ni) { const bf16x8 b = *(const LAS bf16x8*)(KT + (16 * ni + fr) * ROW72 + (32 * ks + 8 * fq) * 2);
#pragma unroll
            for (int mi = 0; mi < 2; ++mi) acc[mi][ni] = mfma16(b, a[mi], acc[mi][ni]); }
    }
#pragma unroll
    for (int mi = 0; mi < 2; ++mi)
#pragma unroll
        for (int ni = 0; ni < 8; ++ni) *(u32x2*)(OUT + (size_t)(32 * w + 16 * mi + fr) * 128 + 16 * ni + 4 * fq) = (u32x2){pk2(acc[mi][ni][0], acc[mi][ni][1]), pk2(acc[mi][ni][2], acc[mi][ni][3])};
}
DI void copy_256x128(const bf16_t* __restrict__ src, int gp, LAS unsigned char* dst, int tid) {
#pragma unroll
    for (int i = 0; i < 8; ++i) { const int id = tid + 512 * i, row = id >> 4, cc = id & 15;
        *(LAS u32x4*)(dst + row * ROW136 + cc * 16) = *(const u32x4*)(src + (size_t)row * gp + cc * 8); }
}

DI void ld_v(const bf16_t* __restrict__ Zv, int n, int tg, int lane, unsigned (&w)[2][8]) {
#pragma unroll
    for (int i = 0; i < 2; ++i)
#pragma unroll
        for (int j = 0; j < 8; ++j) w[i][j] = *(const unsigned*)(Zv + (size_t)(n * CH + 8 * tg + j) * ZW + 2 * (lane + 64 * i));
}
DI void st_vT(const unsigned (&w)[2][8], int tg, int lane, LAS unsigned char* VT) {
#pragma unroll
    for (int i = 0; i < 2; ++i) { const int cp = lane + 64 * i; u32x4 lo, hi;
        lo.x = (w[i][0] & 0xffffu) | (w[i][1] << 16); lo.y = (w[i][2] & 0xffffu) | (w[i][3] << 16); lo.z = (w[i][4] & 0xffffu) | (w[i][5] << 16); lo.w = (w[i][6] & 0xffffu) | (w[i][7] << 16);
        hi.x = (w[i][0] >> 16) | (w[i][1] & 0xffff0000u); hi.y = (w[i][2] >> 16) | (w[i][3] & 0xffff0000u); hi.z = (w[i][4] >> 16) | (w[i][5] & 0xffff0000u); hi.w = (w[i][6] >> 16) | (w[i][7] & 0xffff0000u);
        *(LAS u32x4*)(VT + (2 * cp) * ROW72 + tg * 16) = lo; *(LAS u32x4*)(VT + (2 * cp + 1) * ROW72 + tg * 16) = hi; }
}
DI void ld_256x128(const bf16_t* __restrict__ src, int gp, int tid, u32x4 (&r)[8]) {
#pragma unroll
    for (int i = 0; i < 8; ++i) { const int id = tid + 512 * i, row = id >> 4, cc = id & 15; r[i] = *(const u32x4*)(src + (size_t)row * gp + cc * 8); }
}
DI void st_256x128(const u32x4 (&r)[8], LAS unsigned char* dst, int tid) {
#pragma unroll
    for (int i = 0; i < 8; ++i) { const int id = tid + 512 * i, row = id >> 4, cc = id & 15; *(LAS u32x4*)(dst + row * ROW136 + cc * 16) = r[i]; }
}
DI void conv_ld(const bf16_t* __restrict__ Zc, int tok0, unsigned (&x)[11]) {
#pragma unroll
    for (int i = 0; i < 11; ++i) { const int tok = tok0 - 3 + i; x[i] = 0u; if (tok >= 0) x[i] = *(const unsigned*)(Zc + (size_t)tok * ZW); }
}
DI void conv_apply(const unsigned (&x)[11], const float* __restrict__ cw, const float* __restrict__ cb, float (&o0)[8], float (&o1)[8]) {
    f32x2 wj[4];
#pragma unroll
    for (int j = 0; j < 4; ++j) wj[j] = *(const f32x2*)(cw + j * 1024);
    const f32x2 bias = *(const f32x2*)cb;
#pragma unroll
    for (int j = 0; j < 8; ++j) { float y0 = bias.x, y1 = bias.y;
#pragma unroll
        for (int jj = 0; jj < 4; ++jj) { y0 += wj[jj].x * bflo(x[j + jj]); y1 += wj[jj].y * bfhi(x[j + jj]); }
        o0[j] = silu_f(y0); o1[j] = silu_f(y1); }
}
DI void gla_b(const bf16_t* __restrict__ Z, const float* __restrict__ wa, const float* __restrict__ ba, int h, int n, int tg, int c2, LAS float* TOT, float (&b)[8][2], float (&blast)[2]) {
    const int col = h * 128 + 2 * c2;
    float w0[16], w1[16];
#pragma unroll
    for (int r = 0; r < 16; ++r) { const f32x2 w = *(const f32x2*)(wa + r * 512 + col); w0[r] = w.x; w1[r] = w.y; }
    const f32x2 bb = *(const f32x2*)(ba + col);
    float c0 = 0.f, c1 = 0.f;
#pragma unroll
    for (int j = 0; j < 8; ++j) {
        const bf16_t* gp = Z + (size_t)(n * CH + 8 * tg + j) * ZW + ZC_GA;
        const u32x4 g0 = *(const u32x4*)gp, g1 = *(const u32x4*)(gp + 8);
        const float gv[16] = {bflo(g0.x), bfhi(g0.x), bflo(g0.y), bfhi(g0.y), bflo(g0.z), bfhi(g0.z), bflo(g0.w), bfhi(g0.w),
                              bflo(g1.x), bfhi(g1.x), bflo(g1.y), bfhi(g1.y), bflo(g1.z), bfhi(g1.z), bflo(g1.w), bfhi(g1.w)};
        float p0 = bb.x, p1 = bb.y;
#pragma unroll
        for (int r = 0; r < 16; ++r) { p0 += gv[r] * w0[r]; p1 += gv[r] * w1[r]; }
        c0 += log_sigmoid_f(p0) * (1.0f / 16.0f); c1 += log_sigmoid_f(p1) * (1.0f / 16.0f);
        b[j][0] = c0; b[j][1] = c1;
    }
    *(LAS f32x2*)(TOT + tg * 128 + 2 * c2) = (f32x2){c0, c1};
    __syncthreads();
    float pre0 = 0.f, pre1 = 0.f, t0 = 0.f, t1 = 0.f;
#pragma unroll
    for (int g = 0; g < 8; ++g) { const f32x2 t = *(const LAS f32x2*)(TOT + g * 128 + 2 * c2); if (g < tg) { pre0 += t.x; pre1 += t.y; } t0 += t.x; t1 += t.y; }
#pragma unroll
    for (int j = 0; j < 8; ++j) { b[j][0] += pre0; b[j][1] += pre1; }
    blast[0] = t0; blast[1] = t1;
}
DI void conv_silu8(const bf16_t* __restrict__ Zc, const float* __restrict__ cw, const float* __restrict__ cb, int tok0, float (&o0)[8], float (&o1)[8]) {
    float x0[11], x1[11];
#pragma unroll
    for (int i = 0; i < 11; ++i) { const int tok = tok0 - 3 + i; unsigned w = 0u; if (tok >= 0) w = *(const unsigned*)(Zc + (size_t)tok * ZW); x0[i] = bflo(w); x1[i] = bfhi(w); }
    f32x2 wj[4];
#pragma unroll
    for (int j = 0; j < 4; ++j) wj[j] = *(const f32x2*)(cw + j * 1024);
    const f32x2 bias = *(const f32x2*)cb;
#pragma unroll
    for (int j = 0; j < 8; ++j) { float y0 = bias.x, y1 = bias.y;
#pragma unroll
        for (int jj = 0; jj < 4; ++jj) { y0 += wj[jj].x * x0[j + jj]; y1 += wj[jj].y * x1[j + jj]; }
        o0[j] = silu_f(y0); o1[j] = silu_f(y1); }
}
DI void score_mfma(const LAS unsigned char* QL, const LAS unsigned char* KL, int w, int lane, f32x4 (&sacc)[2]) {
    const int fr = lane & 15, fq = lane >> 4, mi = w >> 1, ni0 = 2 * (w & 1);
    sacc[0] = (f32x4){0.f, 0.f, 0.f, 0.f}; sacc[1] = sacc[0];
#pragma unroll
    for (int ks = 0; ks < 4; ++ks) { const bf16x8 a = *(const LAS bf16x8*)(QL + (16 * mi + fr) * ROW136 + (32 * ks + 8 * fq) * 2);
#pragma unroll
        for (int jn = 0; jn < 2; ++jn) { const bf16x8 b = *(const LAS bf16x8*)(KL + (16 * (ni0 + jn) + fr) * ROW136 + (32 * ks + 8 * fq) * 2); sacc[jn] = mfma16(b, a, sacc[jn]); } }
}

struct MixCtx {
    const bf16_t* Z; bf16_t* OB;
    const float *wa, *ba, *gla_norm, *conv_w, *conv_b, *b_i, *b_f, *ml_norm;
    float *DECAY, *DN, *NP, *GG, *FL, *MP, *BG; bf16_t *DS, *DC, *SP, *CP;
    const bf16_t *KM, *VMT;
};

DI void gla_A_unit(const MixCtx& C, LAS unsigned char* lds, int h, int n, int tid) {
    const int lane = tid & 63, tg = __builtin_amdgcn_readfirstlane(tid >> 6), c2 = lane;
    LAS float* TOT = (LAS float*)(lds + L_MISC);
    LAS unsigned char* KT = lds + L_ST; LAS unsigned char* VT = lds + L_VT;
    unsigned kw[8], vw[2][8];
#pragma unroll
    for (int j = 0; j < 8; ++j) kw[j] = *(const unsigned*)(C.Z + (size_t)(n * CH + 8 * tg + j) * ZW + ZC_GK + h * 128 + 2 * c2);
    ld_v(C.Z + ZC_GV + h * 256, n, tg, lane, vw);
    float b[8][2], blast[2];
    gla_b(C.Z, C.wa, C.ba, h, n, tg, c2, TOT, b, blast);
    float k0[8], k1[8];
#pragma unroll
    for (int j = 0; j < 8; ++j) { k0[j] = bflo(kw[j]) * __expf(blast[0] - b[j][0]); k1[j] = bfhi(kw[j]) * __expf(blast[1] - b[j][1]);
        *(f32x2*)(C.BG + ((size_t)(h * NCH + n) * CH + 8 * tg + j) * 128 + 2 * c2) = (f32x2){b[j][0], b[j][1]}; }
    u32x4 lo, hi;
    lo.x = pk2(k0[0], k0[1]); lo.y = pk2(k0[2], k0[3]); lo.z = pk2(k0[4], k0[5]); lo.w = pk2(k0[6], k0[7]);
    hi.x = pk2(k1[0], k1[1]); hi.y = pk2(k1[2], k1[3]); hi.z = pk2(k1[4], k1[5]); hi.w = pk2(k1[6], k1[7]);
    *(LAS u32x4*)(KT + (2 * c2) * ROW72 + tg * 16) = lo; *(LAS u32x4*)(KT + (2 * c2 + 1) * ROW72 + tg * 16) = hi;
    if (tg == 0) *(f32x2*)(C.DECAY + (size_t)(h * NCH + n) * 128 + 2 * c2) = (f32x2){__expf(blast[0]), __expf(blast[1])};
    st_vT(vw, tg, lane, VT);
    __syncthreads();
    state_mfma(VT, KT, C.DS + (size_t)(h * NCH + n) * 32768, tg, lane);
    __syncthreads();
}

DI void gla_B_unit(const MixCtx& C, LAS unsigned char* lds, int h, int n, int tid) {
    const int lane = tid & 63, w = __builtin_amdgcn_readfirstlane(tid >> 6), tg = w, c2 = lane, fr = lane & 15, fq = lane >> 4;
    LAS float* RS = (LAS float*)(lds + L_MISC + 4096);
    LAS unsigned char* ST = lds + L_ST; LAS unsigned char* VT = lds + L_VT; LAS unsigned char* QL = lds + L_Q; LAS unsigned char* KL = lds + L_K;
    const int wr = w >> 1, wc = w & 1, t = 16 * wr + fr;
    const size_t tok = (size_t)(n * CH + t);
    u32x4 st[8]; f32x2 bq[8]; unsigned wq[8], wk[8], vw[2][8]; u32x2 gg[8]; f32x4 gn[8];
    ld_256x128(C.SP + (size_t)(h * NCH + n) * 32768, 128, tid, st);
#pragma unroll
    for (int j = 0; j < 8; ++j) { const size_t zr = (size_t)(n * CH + 8 * tg + j) * ZW;
        bq[j] = *(const f32x2*)(C.BG + ((size_t)(h * NCH + n) * CH + 8 * tg + j) * 128 + 2 * c2);
        wq[j] = *(const unsigned*)(C.Z + zr + ZC_GQ + h * 128 + 2 * c2); wk[j] = *(const unsigned*)(C.Z + zr + ZC_GK + h * 128 + 2 * c2); }
    ld_v(C.Z + ZC_GV + h * 256, n, tg, lane, vw);
#pragma unroll
    for (int ni = 0; ni < 8; ++ni) { const int dv = 128 * wc + 16 * ni + 4 * fq; gg[ni] = *(const u32x2*)(C.Z + tok * ZW + ZC_GG + h * 256 + dv); gn[ni] = *(const f32x4*)(C.gla_norm + h * 256 + dv); }
    const float qs = 0.08838834764831845f;
#pragma unroll
    for (int j = 0; j < 8; ++j) { const float e0 = __expf(bq[j].x), e1 = __expf(bq[j].y);
        *(LAS unsigned*)(QL + (8 * tg + j) * ROW136 + 4 * c2) = pk2(bflo(wq[j]) * qs * e0, bfhi(wq[j]) * qs * e1);
        *(LAS unsigned*)(KL + (8 * tg + j) * ROW136 + 4 * c2) = pk2(bflo(wk[j]) * __builtin_amdgcn_rcpf(e0), bfhi(wk[j]) * __builtin_amdgcn_rcpf(e1)); }
    st_vT(vw, tg, lane, VT);
    st_256x128(st, ST, tid);
    __syncthreads();
    f32x4 sacc[2];
    score_mfma(QL, KL, w, lane, sacc);
    __syncthreads();
    { const int mi = w >> 1, ni0 = 2 * (w & 1), t2 = 16 * mi + fr;
#pragma unroll
      for (int jn = 0; jn < 2; ++jn) { const int s0 = 16 * (ni0 + jn) + 4 * fq; f32x4 v = sacc[jn];
#pragma unroll
          for (int r = 0; r < 4; ++r) if (s0 + r > t2) v[r] = 0.f;
          *(LAS u32x2*)(KL + t2 * ROW72 + s0 * 2) = (u32x2){pk2(v[0], v[1]), pk2(v[2], v[3])}; } }
    __syncthreads();
    f32x4 o[8];
#pragma unroll
    for (int ni = 0; ni < 8; ++ni) o[ni] = (f32x4){0.f, 0.f, 0.f, 0.f};
#pragma unroll
    for (int ks = 0; ks < 2; ++ks) { const bf16x8 a = *(const LAS bf16x8*)(KL + t * ROW72 + (32 * ks + 8 * fq) * 2);
#pragma unroll
        for (int ni = 0; ni < 8; ++ni) { const bf16x8 bb = *(const LAS bf16x8*)(VT + (128 * wc + 16 * ni + fr) * ROW72 + (32 * ks + 8 * fq) * 2); o[ni] = mfma16(bb, a, o[ni]); } }
#pragma unroll
    for (int ks = 0; ks < 4; ++ks) { const bf16x8 a = *(const LAS bf16x8*)(QL + t * ROW136 + (32 * ks + 8 * fq) * 2);
#pragma unroll
        for (int ni = 0; ni < 8; ++ni) { const bf16x8 bb = *(const LAS bf16x8*)(ST + (128 * wc + 16 * ni + fr) * ROW136 + (32 * ks + 8 * fq) * 2); o[ni] = mfma16(bb, a, o[ni]); } }
    float ss = 0.f;
#pragma unroll
    for (int ni = 0; ni < 8; ++ni) ss += (o[ni][0] * o[ni][0] + o[ni][1] * o[ni][1]) + (o[ni][2] * o[ni][2] + o[ni][3] * o[ni][3]);
    ss += shx(ss, 16, lane); ss += shx(ss, 32, lane);
    if (fq == 0) RS[wc * 64 + t] = ss;
    __syncthreads();
    const float rstd = 1.0f / sqrtf((RS[t] + RS[64 + t]) * (1.0f / 256.0f) + EPS);
#pragma unroll
    for (int ni = 0; ni < 8; ++ni) { const int dv = 128 * wc + 16 * ni + 4 * fq;
        const f32x4 v = o[ni] * rstd * gn[ni];
        *(u32x2*)(C.OB + tok * OBW + OB_O + h * 256 + dv) = (u32x2){pk2(v[0] * silu_f(bflo(gg[ni].x)), v[1] * silu_f(bfhi(gg[ni].x))), pk2(v[2] * silu_f(bflo(gg[ni].y)), v[3] * silu_f(bfhi(gg[ni].y)))}; }
    __syncthreads();
}

DI void ml_A_unit(const MixCtx& C, LAS unsigned char* lds, int h, int n, int tid) {
    const int lane = tid & 63, tg = __builtin_amdgcn_readfirstlane(tid >> 6), c2 = lane;
    LAS float* PART = (LAS float*)(lds + L_MISC);
    LAS unsigned char* KT = lds + L_ST; LAS unsigned char* VT = lds + L_VT;
    const size_t ztok = (size_t)(n * CH + lane) * ZW;
    const float li = bf2f(C.Z[ztok + ZC_MI + h]) + C.b_i[h];
    const float lf = log_sigmoid_f(bf2f(C.Z[ztok + ZC_MF + h]) + C.b_f[h]);
    const float F = wave_scan_sum(lf, lane);
    const float Flast = shi(F, 63);
    const float Gv = Flast - F + li;
    const float g = wave_max(Gv, lane);
    const float wG = __expf(Gv - g);
    float k0[8], k1[8];
    conv_silu8(C.Z + ZC_MQK + 512 + h * 128 + 2 * c2, C.conv_w + 512 + h * 128 + 2 * c2, C.conv_b + 512 + h * 128 + 2 * c2, n * CH + 8 * tg, k0, k1);
    const float ks = 0.08838834764831845f;
    float p0 = 0.f, p1 = 0.f;
#pragma unroll
    for (int j = 0; j < 8; ++j) { const float wj = shi(wG, 8 * tg + j) * ks; k0[j] *= wj; k1[j] *= wj; p0 += k0[j]; p1 += k1[j]; }
    u32x4 lo, hi;
    lo.x = pk2(k0[0], k0[1]); lo.y = pk2(k0[2], k0[3]); lo.z = pk2(k0[4], k0[5]); lo.w = pk2(k0[6], k0[7]);
    hi.x = pk2(k1[0], k1[1]); hi.y = pk2(k1[2], k1[3]); hi.z = pk2(k1[4], k1[5]); hi.w = pk2(k1[6], k1[7]);
    *(LAS u32x4*)(KT + (2 * c2) * ROW72 + tg * 16) = lo; *(LAS u32x4*)(KT + (2 * c2 + 1) * ROW72 + tg * 16) = hi;
    *(LAS f32x2*)(PART + tg * 128 + 2 * c2) = (f32x2){p0, p1};
    fill_vT(C.Z + ZC_MV + h * 256, n, tg, lane, VT);
    if (tid == 0) { C.GG[h * NCH + n] = g; C.FL[h * NCH + n] = Flast; }
    __syncthreads();
    if (tid < 128) { float s = 0.f;
#pragma unroll
        for (int q = 0; q < 8; ++q) s += PART[q * 128 + tid];
        C.DN[(size_t)(h * NCH + n) * 128 + tid] = s; }
    state_mfma(VT, KT, C.DC + (size_t)(h * NCH + n) * 32768, tg, lane);
    __syncthreads();
}

DI void ml_B_unit(const MixCtx& C, LAS unsigned char* lds, int h, int n, int tid) {
    const int lane = tid & 63, w = __builtin_amdgcn_readfirstlane(tid >> 6), tg = w, c2 = lane, fr = lane & 15, fq = lane >> 4;
    LAS float* MF = (LAS float*)(lds + L_MISC); LAS float* MU = MF + 64; LAS float* MM = MF + 128; LAS float* MW = MF + 192;
    LAS float* DENP = MF + 256; LAS float* DQN = MF + 512; LAS float* NPV = MF + 576; LAS float* RS = (LAS float*)(lds + L_MISC + 4096);
    LAS unsigned char* CT = lds + L_ST; LAS unsigned char* VT = lds + L_VT; LAS unsigned char* QL = lds + L_Q; LAS unsigned char* KL = lds + L_K;
    copy_256x128(C.CP + (size_t)(h * NCH + n) * 32768, 128, CT, tid);
    if (w == 0) {
        const size_t ztok = (size_t)(n * CH + lane) * ZW;
        const float li = bf2f(C.Z[ztok + ZC_MI + h]) + C.b_i[h];
        const float lf = log_sigmoid_f(bf2f(C.Z[ztok + ZC_MF + h]) + C.b_f[h]);
        const float F = wave_scan_sum(lf, lane);
        const float u = li - F;
        const float pm = wave_scan_max(u, lane);
        const float mprev = C.MP[h * NCH + n];
        const float m = F + fmaxf(pm, mprev);
        MF[lane] = F; MU[lane] = u; MM[lane] = m; MW[lane] = __expf(F + mprev - m);
    }
    if (w == 1) { NPV[lane] = C.NP[(size_t)(h * NCH + n) * 128 + lane]; NPV[64 + lane] = C.NP[(size_t)(h * NCH + n) * 128 + 64 + lane]; }
    {
        float q0[8], q1[8], k0[8], k1[8];
        conv_silu8(C.Z + ZC_MQK + h * 128 + 2 * c2, C.conv_w + h * 128 + 2 * c2, C.conv_b + h * 128 + 2 * c2, n * CH + 8 * tg, q0, q1);
        conv_silu8(C.Z + ZC_MQK + 512 + h * 128 + 2 * c2, C.conv_w + 512 + h * 128 + 2 * c2, C.conv_b + 512 + h * 128 + 2 * c2, n * CH + 8 * tg, k0, k1);
        const float ks = 0.08838834764831845f;
#pragma unroll
        for (int j = 0; j < 8; ++j) { *(LAS unsigned*)(QL + (8 * tg + j) * ROW136 + 4 * c2) = pk2(q0[j], q1[j]); *(LAS unsigned*)(KL + (8 * tg + j) * ROW136 + 4 * c2) = pk2(k0[j] * ks, k1[j] * ks); }
    }
    fill_vT(C.Z + ZC_MV + h * 256, n, tg, lane, VT);
    __syncthreads();
    f32x4 sacc[2];
    score_mfma(QL, KL, w, lane, sacc);
    {
        const int t = tid >> 3, part = tid & 7; float s = 0.f;
#pragma unroll
        for (int e = 0; e < 8; ++e) { const unsigned qq = *(const LAS unsigned*)(QL + t * ROW136 + (16 * part + 2 * e) * 2); s += bflo(qq) * NPV[16 * part + 2 * e] + bfhi(qq) * NPV[16 * part + 2 * e + 1]; }
        s += shx(s, 1, lane); s += shx(s, 2, lane); s += shx(s, 4, lane);
        if (part == 0) DQN[t] = s;
    }
    __syncthreads();
    { const int mi = w >> 1, ni0 = 2 * (w & 1), t = 16 * mi + fr; const float ft = MF[t] - MM[t];
#pragma unroll
      for (int jn = 0; jn < 2; ++jn) { const int s0 = 16 * (ni0 + jn) + 4 * fq; f32x4 v = sacc[jn]; const f32x4 us = *(const LAS f32x4*)(MU + s0);
          float ps = 0.f;
#pragma unroll
          for (int r = 0; r < 4; ++r) { v[r] = (s0 + r > t) ? 0.f : v[r] * __expf(ft + us[r]); ps += v[r]; }
          ps += shx(ps, 16, lane); ps += shx(ps, 32, lane);
          if (fq == 0) DENP[t * 4 + ni0 + jn] = ps;
          *(LAS u32x2*)(KL + t * ROW72 + s0 * 2) = (u32x2){pk2(v[0], v[1]), pk2(v[2], v[3])}; } }
    __syncthreads();
    const int wr = w >> 1, wc = w & 1, t = 16 * wr + fr;
    f32x4 o1[8], o2[8];
#pragma unroll
    for (int ni = 0; ni < 8; ++ni) { o1[ni] = (f32x4){0.f, 0.f, 0.f, 0.f}; o2[ni] = o1[ni]; }
#pragma unroll
    for (int ks = 0; ks < 2; ++ks) { const bf16x8 a = *(const LAS bf16x8*)(KL + t * ROW72 + (32 * ks + 8 * fq) * 2);
#pragma unroll
        for (int ni = 0; ni < 8; ++ni) { const bf16x8 bb = *(const LAS bf16x8*)(VT + (128 * wc + 16 * ni + fr) * ROW72 + (32 * ks + 8 * fq) * 2); o1[ni] = mfma16(bb, a, o1[ni]); } }
#pragma unroll
    for (int ks = 0; ks < 4; ++ks) { const bf16x8 a = *(const LAS bf16x8*)(QL + t * ROW136 + (32 * ks + 8 * fq) * 2);
#pragma unroll
        for (int ni = 0; ni < 8; ++ni) { const bf16x8 bb = *(const LAS bf16x8*)(CT + (128 * wc + 16 * ni + fr) * ROW136 + (32 * ks + 8 * fq) * 2); o2[ni] = mfma16(bb, a, o2[ni]); } }
    const float wi = MW[t];
    const f32x4 dp = *(const LAS f32x4*)(DENP + t * 4);
    const float den = ((dp[0] + dp[1]) + (dp[2] + dp[3])) + wi * DQN[t];
    const float inv = 1.0f / fmaxf(fabsf(den), __expf(-MM[t]));
    const size_t tok = (size_t)(n * CH + t);
    float ss = 0.f;
#pragma unroll
    for (int ni = 0; ni < 8; ++ni) { const int dv = 128 * wc + 16 * ni + 4 * fq;
        const u32x2 mo = *(const u32x2*)(C.Z + tok * ZW + ZC_MO + h * 256 + dv);
        f32x4 v = (o1[ni] + o2[ni] * wi) * inv;
        v[0] *= sigmoid_f(bflo(mo.x)); v[1] *= sigmoid_f(bfhi(mo.x)); v[2] *= sigmoid_f(bflo(mo.y)); v[3] *= sigmoid_f(bfhi(mo.y));
        o1[ni] = v; ss += (v[0] * v[0] + v[1] * v[1]) + (v[2] * v[2] + v[3] * v[3]); }
    ss += shx(ss, 16, lane); ss += shx(ss, 32, lane);
    if (fq == 0) RS[wc * 64 + t] = ss;
    __syncthreads();
    const float rstd = 1.0f / sqrtf((RS[t] + RS[64 + t]) * (1.0f / 256.0f) + EPS);
#pragma unroll
    for (int ni = 0; ni < 8; ++ni) { const int dv = 128 * wc + 16 * ni + 4 * fq; const f32x4 gn = *(const f32x4*)(C.ml_norm + h * 256 + dv);
        const f32x4 v = o1[ni] * rstd * gn;
        *(u32x2*)(C.OB + tok * OBW + OB_O + 1024 + h * 256 + dv) = (u32x2){pk2(v[0], v[1]), pk2(v[2], v[3])}; }
    __syncthreads();
}

#ifndef SCAN_U
#define SCAN_U 8
#endif
DI void scan_phase(const MixCtx& C, int tid) {
    const int NS = 2 * 65536;
    for (int slot = opaque_bx() * 512 + tid; slot < NS; slot += opaque_g() * 512) {
        const int br = slot >> 16, s = slot & 65535, h = s >> 14, dv = (s >> 6) & 255, dkp = s & 63;
        const size_t e0 = (size_t)h * NCH * 32768 + (size_t)dv * 128 + 2 * dkp;
        if (br == 0) {
            float s0 = 0.f, s1 = 0.f;
            for (int n0 = 0; n0 < NCH; n0 += SCAN_U) {
                f32x2 d[SCAN_U], dec[SCAN_U];
#pragma unroll
                for (int u = 0; u < SCAN_U; ++u) { const unsigned dw = *(const unsigned*)(C.DS + e0 + (size_t)(n0 + u) * 32768); d[u] = (f32x2){bflo(dw), bfhi(dw)}; dec[u] = *(const f32x2*)(C.DECAY + (size_t)(h * NCH + n0 + u) * 128 + 2 * dkp); }
#pragma unroll
                for (int u = 0; u < SCAN_U; ++u) { *(unsigned*)(C.SP + e0 + (size_t)(n0 + u) * 32768) = pk2(s0, s1); s0 = dec[u].x * s0 + d[u].x; s1 = dec[u].y * s1 + d[u].y; }
            }
        } else {
            float c0 = 0.f, c1 = 0.f, nn0 = 0.f, nn1 = 0.f, m = -1e30f;
            for (int n0 = 0; n0 < NCH; n0 += SCAN_U) {
                f32x2 d[SCAN_U], dn[SCAN_U]; float fl[SCAN_U], gl[SCAN_U];
#pragma unroll
                for (int u = 0; u < SCAN_U; ++u) { const unsigned dw = *(const unsigned*)(C.DC + e0 + (size_t)(n0 + u) * 32768); d[u] = (f32x2){bflo(dw), bfhi(dw)}; fl[u] = C.FL[h * NCH + n0 + u]; gl[u] = C.GG[h * NCH + n0 + u];
                    dn[u] = (dv == 0) ? *(const f32x2*)(C.DN + (size_t)(h * NCH + n0 + u) * 128 + 2 * dkp) : (f32x2){0.f, 0.f}; }
#pragma unroll
                for (int u = 0; u < SCAN_U; ++u) { *(unsigned*)(C.CP + e0 + (size_t)(n0 + u) * 32768) = pk2(c0, c1);
                    if (dv == 0) { *(f32x2*)(C.NP + (size_t)(h * NCH + n0 + u) * 128 + 2 * dkp) = (f32x2){nn0, nn1}; if (dkp == 0) C.MP[h * NCH + n0 + u] = m; }
                    const float mn = fmaxf(fl[u] + m, gl[u]); const float a = __expf(fl[u] + m - mn), bb = __expf(gl[u] - mn);
                    c0 = a * c0 + bb * d[u].x; c1 = a * c1 + bb * d[u].y; nn0 = a * nn0 + bb * dn[u].x; nn1 = a * nn1 + bb * dn[u].y; m = mn; }
            }
        }
    }
}

DI void mem_unit(const MixCtx& C, LAS unsigned char* lds, int h, int rb, int tid) {
    const int lane = tid & 63, w = __builtin_amdgcn_readfirstlane(tid >> 6), fr = lane & 15, fq = lane >> 4, wr = w >> 1, wc = w & 1, t = 16 * wr + fr;
    LAS unsigned char* QL = lds; LAS unsigned char* PL = lds + 33792; LAS unsigned char* KV = lds + 67584;
    LAS float* RMX = (LAS float*)(lds + L_MISC); LAS float* RSM = RMX + 128;
#pragma unroll
    for (int i = 0; i < 4; ++i) { const int id = tid + 512 * i, row = id >> 5, cc = id & 31;
        *(LAS u32x4*)(QL + row * ROW264 + cc * 16) = *(const u32x4*)(C.Z + (size_t)(rb * 64 + row) * ZW + ZC_XQ + h * 256 + cc * 8); }
    f32x4 s[8];
#pragma unroll
    for (int ni = 0; ni < 8; ++ni) s[ni] = (f32x4){0.f, 0.f, 0.f, 0.f};
#pragma unroll
    for (int half = 0; half < 2; ++half) {
        copy_256x128(C.KM + h * 256 + half * 128, 4096, KV, tid);
        __syncthreads();
#pragma unroll
        for (int ks = 0; ks < 4; ++ks) { const bf16x8 a = *(const LAS bf16x8*)(QL + t * ROW264 + (128 * half + 32 * ks + 8 * fq) * 2);
#pragma unroll
            for (int ni = 0; ni < 8; ++ni) { const bf16x8 bb = *(const LAS bf16x8*)(KV + (128 * wc + 16 * ni + fr) * ROW136 + (32 * ks + 8 * fq) * 2); s[ni] = mfma16(bb, a, s[ni]); } }
        __syncthreads();
    }
    float mx = -3.0e38f;
#pragma unroll
    for (int ni = 0; ni < 8; ++ni) { s[ni] = s[ni] * 0.0625f; mx = fmaxf(mx, fmaxf(fmaxf(s[ni][0], s[ni][1]), fmaxf(s[ni][2], s[ni][3]))); }
    mx = fmaxf(mx, shx(mx, 16, lane)); mx = fmaxf(mx, shx(mx, 32, lane));
    if (fq == 0) RMX[wc * 64 + t] = mx;
    copy_256x128(C.VMT + (size_t)(h * 256) * 256, 256, KV, tid);
    __syncthreads();
    mx = fmaxf(RMX[t], RMX[64 + t]);
    float sm = 0.f;
#pragma unroll
    for (int ni = 0; ni < 8; ++ni) {
#pragma unroll
        for (int r = 0; r < 4; ++r) { s[ni][r] = __expf(s[ni][r] - mx); sm += s[ni][r]; } }
    sm += shx(sm, 16, lane); sm += shx(sm, 32, lane);
    if (fq == 0) RSM[wc * 64 + t] = sm;
    __syncthreads();
    const float inv = 1.0f / (RSM[t] + RSM[64 + t]);
#pragma unroll
    for (int ni = 0; ni < 8; ++ni) { const f32x4 p = s[ni] * inv; *(LAS u32x2*)(PL + t * ROW264 + (128 * wc + 16 * ni + 4 * fq) * 2) = (u32x2){pk2(p[0], p[1]), pk2(p[2], p[3])}; }
    f32x4 o[8];
#pragma unroll
    for (int ni = 0; ni < 8; ++ni) o[ni] = (f32x4){0.f, 0.f, 0.f, 0.f};
#pragma unroll
    for (int half = 0; half < 2; ++half) {
        if (half == 1) copy_256x128(C.VMT + (size_t)(h * 256) * 256 + 128, 256, KV, tid);
        __syncthreads();
#pragma unroll
        for (int ks = 0; ks < 4; ++ks) { const bf16x8 a = *(const LAS bf16x8*)(PL + t * ROW264 + (128 * half + 32 * ks + 8 * fq) * 2);
#pragma unroll
            for (int ni = 0; ni < 8; ++ni) { const bf16x8 bb = *(const LAS bf16x8*)(KV + (128 * wc + 16 * ni + fr) * ROW136 + (32 * ks + 8 * fq) * 2); o[ni] = mfma16(bb, a, o[ni]); } }
        __syncthreads();
    }
    const size_t tok = (size_t)(rb * 64 + t);
#pragma unroll
    for (int ni = 0; ni < 8; ++ni) { const int d = 128 * wc + 16 * ni + 4 * fq; *(u32x2*)(C.OB + tok * OBW + OB_O + 2048 + h * 256 + d) = (u32x2){pk2(o[ni][0], o[ni][1]), pk2(o[ni][2], o[ni][3])}; }
}

#ifndef GEMM_ALIGN
#define GEMM_ALIGN true
#endif
#ifndef REP_PRO
#define REP_PRO 1
#endif
#ifndef REP_MIXA
#define REP_MIXA 1
#endif
#ifndef REP_SCAN
#define REP_SCAN 1
#endif
#ifndef REP_MIXB
#define REP_MIXB 1
#endif
#ifndef REP_FF1
#define REP_FF1 1
#endif
#ifndef REP_NORM
#define REP_NORM 1
#endif
#ifndef WGM_IN
#define WGM_IN PG8_WGM
#endif
#ifndef WGM_BR
#define WGM_BR PG8_WGM
#endif
#ifndef WGM_OUT
#define WGM_OUT PG8_WGM
#endif
#ifndef WGM_F1
#define WGM_F1 8
#endif
#ifndef WGM_F2
#define WGM_F2 PG8_WGM
#endif
#ifndef REP_GLAA
#define REP_GLAA 1
#endif
#ifndef REP_MEM
#define REP_MEM 1
#endif
#ifndef REP_GLAB
#define REP_GLAB 1
#endif
#ifndef REP_GATE
#define REP_GATE 1
#endif
#ifndef REP_BR
#define REP_BR 1
#endif
#ifndef GEMM_SP2
#define GEMM_SP2 true
#endif
constexpr int L_PTR = L_BARW + 256;
DI unsigned long long tab_ld(LAS unsigned char* lds, int k) {
    const unsigned long long v = *(volatile LAS unsigned long long*)(lds + L_PTR + 8 * k);
    const unsigned lo = __builtin_amdgcn_readfirstlane((unsigned)v), hi = __builtin_amdgcn_readfirstlane((unsigned)(v >> 32));
    return ((unsigned long long)hi << 32) | lo;
}
DI const float* tab_in(LAS unsigned char* lds, int k) { return (const float*)(const GAS float*)tab_ld(lds, k); }
DI unsigned char* tab_ws(LAS unsigned char* lds) { return (unsigned char*)(GAS unsigned char*)tab_ld(lds, 24); }
DI void grid_bar(LAS unsigned char* lds) {
    XcdBarrier b; b.bar = (unsigned*)(tab_ws(lds) + WS_CTL) + CW_BAR; b.x = xb_xcc_id(); b.st = (volatile LAS unsigned*)(lds + L_BARW);
    xcd_barrier(b);
}
DI void make_ctx(MixCtx& C, LAS unsigned char* lds, int l) {
    unsigned char* ws = tab_ws(lds);
    C.Z = (const bf16_t*)(ws + WS_Z); C.OB = (bf16_t*)(ws + WS_OB);
    C.wa = tab_in(lds, I_W_GLA_A) + (size_t)l * 16 * 512; C.ba = tab_in(lds, I_B_GLA_A) + l * 512; C.gla_norm = tab_in(lds, I_GLA_NORM) + l * 1024;
    C.conv_w = tab_in(lds, I_CONV_W) + (size_t)l * 4 * 1024; C.conv_b = tab_in(lds, I_CONV_B) + l * 1024; C.b_i = tab_in(lds, I_B_ML_I) + l * 4; C.b_f = tab_in(lds, I_B_ML_F) + l * 4; C.ml_norm = tab_in(lds, I_ML_NORM) + l * 1024;
    C.BG = (float*)(ws + WS_BG); C.DS = (bf16_t*)(ws + WS_DS); C.DC = (bf16_t*)(ws + WS_DC); C.SP = (bf16_t*)(ws + WS_SP); C.CP = (bf16_t*)(ws + WS_CP);
    C.DECAY = (float*)(ws + WS_SMALL + SM_DECAY); C.DN = (float*)(ws + WS_SMALL + SM_DN); C.NP = (float*)(ws + WS_SMALL + SM_NP);
    C.GG = (float*)(ws + WS_SMALL + SM_GG); C.FL = (float*)(ws + WS_SMALL + SM_FL); C.MP = (float*)(ws + WS_SMALL + SM_MP);
    C.KM = (const bf16_t*)(ws + WS_KM) + l * 1024; C.VMT = (const bf16_t*)(ws + WS_VMT) + (size_t)l * 1024 * 256;
}

__global__ void __launch_bounds__(512, 2) trunk_fwd(Params p) {
    extern __shared__ __attribute__((aligned(16))) unsigned char lds_raw[];
    LAS unsigned char* lds0 = (LAS unsigned char*)lds_raw;
    {
        LAS unsigned char* lds = lds0;
        const int tid0 = threadIdx.x;
        if (tid0 < 64) ((LAS unsigned*)(lds + L_BARW))[tid0] = 0u;
        if (tid0 < 23) *(LAS unsigned long long*)(lds + L_PTR + 8 * tid0) = (unsigned long long)p.in[tid0];
        if (tid0 == 23) *(LAS unsigned long long*)(lds + L_PTR + 8 * 23) = (unsigned long long)p.out;
        if (tid0 == 24) *(LAS unsigned long long*)(lds + L_PTR + 8 * 24) = (unsigned long long)p.ws;
        __syncthreads();
        (void)xcd_barrier_post((unsigned*)(p.ws + WS_CTL) + CW_BAR, (volatile LAS unsigned*)(lds + L_BARW));
    }
#define TID (opaque_tid())
#define LANE (opaque_tid() & 63)
#define WAVE (__builtin_amdgcn_readfirstlane(opaque_tid() >> 6))
#define GW (opaque_bx() * NWAVES + WAVE)
#define NGW (opaque_g() * NWAVES)

    for (int rep = 0; rep < REP_PRO; ++rep) {
        LAS unsigned char* lds = opaque_lds(lds0); unsigned char* ws = tab_ws(lds);
        bf16_t* WIN = (bf16_t*)(ws + WS_WIN);
        const int lane = LANE, wave = WAVE;
        LAS float* scr = (LAS float*)(lds + wave * 16640);
        constexpr int IT_IN = 64 * 117, IT_BR = 16 * 64, IT_G = 4 * 64, IT_OUT = 64 * 64, IT_F1 = 64 * 256, IT_F2 = 256 * 64, IT_MK = 64 * 16;
        constexpr int E_IN = 4 * IT_IN, E_BR = E_IN + 12 * IT_BR, E_G = E_BR + 12 * IT_G, E_OUT = E_G + 4 * IT_OUT, E_F1 = E_OUT + 4 * IT_F1, E_F2 = E_F1 + 4 * IT_F2, E_MK = E_F2 + 4 * IT_MK, E_MV = E_MK + 4 * IT_MK;
        for (int it = GW; it < E_MV; it += NGW) {
            if (it < E_IN) { const int l = it / IT_IN, r = it - l * IT_IN; transpose_item(tab_in(lds, I_W_IN) + (size_t)l * DM * IN_W, DM, IN_W, WIN + (size_t)l * ZW * PW, PW, 0, 0, true, scr, r, lane, tab_in(lds, I_NORM_MIX) + l * DM); }
            else if (it < E_BR) { const int q = it - E_IN, lj = q / IT_BR, r = q - lj * IT_BR, l = lj / 3, j = lj - 3 * l; transpose_item(tab_in(lds, I_W_BRANCH) + (size_t)lj * 1024 * DM, 1024, DM, (bf16_t*)(ws + WS_WBR) + (size_t)l * DM * OBW, OBW, OB_O + j * 1024, 0, false, scr, r, lane); }
            else if (it < E_G) { const int q = it - E_BR, lj = q / IT_G, r = q - lj * IT_G, l = lj / 3, j = lj - 3 * l; transpose_item(tab_in(lds, I_W_GATE) + (size_t)lj * 256 * DM, 256, DM, (bf16_t*)(ws + WS_WBR) + (size_t)l * DM * OBW, OBW, j * 256, 0, false, scr, r, lane); }
            else if (it < E_OUT) { const int q = it - E_G, l = q / IT_OUT, r = q - l * IT_OUT; transpose_item(tab_in(lds, I_W_OUT) + (size_t)l * DM * DM, DM, DM, (bf16_t*)(ws + WS_WOUT) + (size_t)l * DM * PW, PW, 0, 0, false, scr, r, lane); }
            else if (it < E_F1) { const int q = it - E_OUT, l = q / IT_F1, r = q - l * IT_F1; transpose_item(tab_in(lds, I_W_FF1) + (size_t)l * DM * DFF, DM, DFF, (bf16_t*)(ws + WS_W1) + (size_t)l * DFF * PW, PW, 0, 0, false, scr, r, lane, tab_in(lds, I_NORM_FFN) + l * DM); }
            else if (it < E_F2) { const int q = it - E_F1, l = q / IT_F2, r = q - l * IT_F2; transpose_item(tab_in(lds, I_W_FF2) + (size_t)l * DFF * DM, DFF, DM, (bf16_t*)(ws + WS_W2) + (size_t)l * DM * PU, PU, 0, 0, false, scr, r, lane); }
            else if (it < E_MK) { const int q = it - E_F2, l = q / IT_MK, r = q - l * IT_MK; transpose_item(tab_in(lds, I_W_MEM_K) + (size_t)l * DM * 1024, DM, 1024, (bf16_t*)(ws + WS_WMK), DM, 0, l * 1024, false, scr, r, lane); }
            else { const int q = it - E_MK, l = q / IT_MK, r = q - l * IT_MK; transpose_item(tab_in(lds, I_W_MEM_V) + (size_t)l * DM * 1024, DM, 1024, (bf16_t*)(ws + WS_WMV), DM, 0, l * 1024, false, scr, r, lane); }
        }
        constexpr int PADCH = (ZW - IN_W) * PW / 8;
        for (int i = opaque_bx() * 512 + TID; i < NL * PADCH; i += opaque_g() * 512) { const int l = i / PADCH, r = i - l * PADCH; *(u32x4*)(WIN + (size_t)l * ZW * PW + (size_t)IN_W * PW + (size_t)r * 8) = (u32x4){0u, 0u, 0u, 0u}; }
        for (int m = GW; m < SEQ; m += NGW) row_bf16_ss(tab_in(lds, I_X) + (size_t)m * DM, (bf16_t*)(ws + WS_H) + (size_t)m * PW, (u64_t*)(ws + WS_SS) + m, lane);
        for (int m = GW; m < MEML; m += NGW) rmsnorm_row<false>(tab_in(lds, I_MEM) + (size_t)m * DM, tab_in(lds, I_MEM_NORM), (bf16_t*)(ws + WS_MEMN) + (size_t)m * DM, lane);
    }
    grid_bar(opaque_lds(lds0));
    {
        LAS unsigned char* lds = opaque_lds(lds0); unsigned char* ws = tab_ws(lds);
        { pg8::Gemm g{(const bf16_t*)(ws + WS_MEMN), (const bf16_t*)(ws + WS_WMK), opq(MEML), opq(DM), opq(DM), opq(DM), opq(DM)}; pg8::StaticOrder S; S.init(opq(MEML), opq(DM), opaque_g(), opaque_bx()); pg8::EpiBf16<0> E{(bf16_t*)(ws + WS_KM), DM, nullptr, nullptr, nullptr, 0, -1};
          pg8::gemm_phase<pg8::EpiBf16<0>, pg8::StaticOrder, GEMM_ALIGN, GEMM_SP2>(lds, g, S, E); }
    }
    {
        LAS unsigned char* lds = opaque_lds(lds0); unsigned char* ws = tab_ws(lds);
        { pg8::Gemm g{(const bf16_t*)(ws + WS_WMV), (const bf16_t*)(ws + WS_MEMN), opq(DM), opq(MEML), opq(DM), opq(DM), opq(DM)}; pg8::StaticOrder S; S.init(opq(DM), opq(MEML), opaque_g(), (opaque_bx() + 16) % opaque_g()); pg8::EpiBf16<0> E{(bf16_t*)(ws + WS_VMT), MEML, nullptr, nullptr, nullptr, 0, -1};
          pg8::gemm_phase<pg8::EpiBf16<0>, pg8::StaticOrder, GEMM_ALIGN, GEMM_SP2>(lds, g, S, E); }
    }
    grid_bar(opaque_lds(lds0));

    for (int l = 0; l < NL; ++l) {
        {
            LAS unsigned char* lds = opaque_lds(lds0); unsigned char* ws = tab_ws(lds);
            pg8::Gemm g{(const bf16_t*)(ws + WS_H), (const bf16_t*)(ws + WS_WIN) + (size_t)l * ZW * PW, opq(SEQ), opq(ZW), opq(DM), opq(PW), opq(PW)}; pg8::StaticOrder S; S.init(opq(SEQ), opq(ZW), opaque_g(), opaque_bx(), opq(WGM_IN)); pg8::EpiBf16<0> E{(bf16_t*)(ws + WS_Z), ZW, nullptr, (const u64_t*)(ws + WS_SS) + (size_t)(2 * l) * SEQ, (bf16_t*)(ws + WS_OB), OBW, ZC_GATE / 256};
            pg8::gemm_phase<pg8::EpiBf16<0>, pg8::StaticOrder, GEMM_ALIGN, GEMM_SP2>(lds, g, S, E);
        }
        grid_bar(opaque_lds(lds0));
        {
            LAS unsigned char* lds = opaque_lds(lds0); MixCtx C; make_ctx(C, lds, l); const int tid = TID;
            for (int rep = 0; rep < REP_MIXA; ++rep) {
            for (int r2 = 0; r2 < REP_GLAA; ++r2) for (int i = opaque_bx(); i < 4 * NCH; i += opaque_g()) gla_A_unit(C, lds, i >> 8, i & 255, tid);
            for (int i = opaque_bx(); i < 4 * NCH; i += opaque_g()) ml_A_unit(C, lds, i >> 8, i & 255, tid);
            for (int r2 = 0; r2 < REP_MEM; ++r2) for (int i = opaque_bx(); i < 4 * NCH; i += opaque_g()) mem_unit(C, lds, i >> 8, i & 255, tid);
            }
        }
        grid_bar(opaque_lds(lds0));
        { LAS unsigned char* lds = opaque_lds(lds0); MixCtx C; make_ctx(C, lds, l); for (int rep = 0; rep < REP_SCAN; ++rep) scan_phase(C, TID); }
        grid_bar(opaque_lds(lds0));
        {
            LAS unsigned char* lds = opaque_lds(lds0); MixCtx C; make_ctx(C, lds, l); const int tid = TID;
            for (int rep = 0; rep < REP_MIXB; ++rep) {
            for (int r2 = 0; r2 < REP_GLAB; ++r2) for (int i = opaque_bx(); i < 4 * NCH; i += opaque_g()) gla_B_unit(C, lds, i >> 8, i & 255, tid);
            for (int i = opaque_bx(); i < 4 * NCH; i += opaque_g()) ml_B_unit(C, lds, i >> 8, i & 255, tid);
            }
        }
        grid_bar(opaque_lds(lds0));
        for (int rep = 0; rep < REP_BR; ++rep) {
            LAS unsigned char* lds = opaque_lds(lds0); unsigned char* ws = tab_ws(lds);
            pg8::Gemm g{(const bf16_t*)(ws + WS_OB), (const bf16_t*)(ws + WS_WBR) + (size_t)l * DM * OBW, opq(SEQ), opq(DM), opq(OBW), opq(OBW), opq(OBW)}; pg8::BranchOrder S; S.init(opq(SEQ), opq(DM), opaque_g(), opaque_bx(), opq(WGM_BR)); pg8::EpiBranch E{(bf16_t*)(ws + WS_Y), PW, (bf16_t*)(ws + WS_GT), tab_in(lds, I_B_GATE) + (size_t)l * GTW};
            pg8::gemm_phase<pg8::EpiBranch, pg8::BranchOrder, GEMM_ALIGN, GEMM_SP2>(lds, g, S, E);
        }
        grid_bar(opaque_lds(lds0));
        {
            LAS unsigned char* lds = opaque_lds(lds0); unsigned char* ws = tab_ws(lds);
            const float* Xin = (l == 0) ? tab_in(lds, I_X) : (const float*)(ws + WS_X);
            pg8::Gemm g{(const bf16_t*)(ws + WS_Y), (const bf16_t*)(ws + WS_WOUT) + (size_t)l * DM * PW, opq(SEQ), opq(DM), opq(DM), opq(PW), opq(PW)}; pg8::StaticOrder S; S.init(opq(SEQ), opq(DM), opaque_g(), opaque_bx(), opq(WGM_OUT)); pg8::EpiResid E{Xin, (float*)(ws + WS_X), DM, (bf16_t*)(ws + WS_H), (u64_t*)(ws + WS_SS) + (size_t)(2 * l + 1) * SEQ, PW};
            pg8::gemm_phase<pg8::EpiResid, pg8::StaticOrder, GEMM_ALIGN, GEMM_SP2>(lds, g, S, E);
        }
        grid_bar(opaque_lds(lds0));
        for (int rep = 0; rep < REP_FF1; ++rep) {
            LAS unsigned char* lds = opaque_lds(lds0); unsigned char* ws = tab_ws(lds);
            pg8::Gemm g{(const bf16_t*)(ws + WS_H), (const bf16_t*)(ws + WS_W1) + (size_t)l * DFF * PW, opq(SEQ), opq(DFF), opq(DM), opq(PW), opq(PW)}; pg8::StaticOrder S; S.init(opq(SEQ), opq(DFF), opaque_g(), opaque_bx(), opq(WGM_F1)); pg8::EpiBf16<1> E{(bf16_t*)(ws + WS_U), PU, nullptr, (const u64_t*)(ws + WS_SS) + (size_t)(2 * l + 1) * SEQ, nullptr, 0, -1};
            pg8::gemm_phase<pg8::EpiBf16<1>, pg8::StaticOrder, GEMM_ALIGN, GEMM_SP2>(lds, g, S, E);
        }
        grid_bar(opaque_lds(lds0));
        {
            LAS unsigned char* lds = opaque_lds(lds0); unsigned char* ws = tab_ws(lds);
            pg8::Gemm g{(const bf16_t*)(ws + WS_U), (const bf16_t*)(ws + WS_W2) + (size_t)l * DM * PU, opq(SEQ), opq(DM), opq(DFF), opq(PU), opq(PU)}; pg8::StaticOrder S; S.init(opq(SEQ), opq(DM), opaque_g(), opaque_bx(), opq(WGM_F2)); pg8::EpiResid E{(const float*)(ws + WS_X), (float*)(ws + WS_X), DM, (bf16_t*)(ws + WS_H), (u64_t*)(ws + WS_SS) + (size_t)(2 * l + 2) * SEQ, PW};
            pg8::gemm_phase<pg8::EpiResid, pg8::StaticOrder, GEMM_ALIGN, GEMM_SP2>(lds, g, S, E);
        }
        grid_bar(opaque_lds(lds0));
    }
    {
        LAS unsigned char* lds = opaque_lds(lds0); unsigned char* ws = tab_ws(lds);
        const float* X = (const float*)(ws + WS_X); const float* gain = tab_in(lds, I_FINAL_NORM); float* out = (float*)(GAS float*)tab_ld(lds, 23); const int lane = LANE;
        const u64_t* ssf = (const u64_t*)(ws + WS_SS) + (size_t)8 * SEQ;
        for (int m = GW; m < SEQ; m += NGW) row_scale_f32(X + (size_t)m * DM, gain, ss_to_f(ssf[m]), out + (size_t)m * DM, lane);
    }
}

extern "C" void kernel_launch(void* const* d_in, const int* in_sizes, int n_in, void* d_out, int out_size, void* d_ws, size_t ws_size, hipStream_t stream) {
    static int grid = 0;
    if (grid == 0) {
        if (n_in != 23 || out_size != SEQ * DM || ws_size < WS_END) { fprintf(stderr, "kernel_launch: unexpected shapes (n_in %d out %d ws %zu, need %zu)\n", n_in, out_size, ws_size, (size_t)WS_END); grid = -1; return; }
        int dev = 0, cus = 0, per_cu = 0;
        if (hipGetDevice(&dev) != hipSuccess || hipDeviceGetAttribute(&cus, hipDeviceAttributeMultiprocessorCount, dev) != hipSuccess) { grid = -1; return; }
        if (hipFuncSetAttribute((const void*)trunk_fwd, hipFuncAttributeMaxDynamicSharedMemorySize, LDS_BYTES) != hipSuccess) { fprintf(stderr, "kernel_launch: hipFuncSetAttribute failed\n"); grid = -1; return; }
        if (hipOccupancyMaxActiveBlocksPerMultiprocessor(&per_cu, (const void*)trunk_fwd, 512, LDS_BYTES) != hipSuccess || per_cu < 1) { fprintf(stderr, "kernel_launch: occupancy query says %d\n", per_cu); (void)hipGetLastError(); }
        grid = cus;
    }
    if (grid < 0) return;
    if (hipMemsetAsync((char*)d_ws + WS_CTL, 0, CTL_ZERO_BYTES, stream) != hipSuccess) return;
    if (hipMemsetAsync((char*)d_ws + WS_SS, 0, SS_ZERO_BYTES, stream) != hipSuccess) return;
    Params p{};
    for (int i = 0; i < 23; ++i) p.in[i] = (const float*)d_in[i];
    p.out = (float*)d_out; p.ws = (unsigned char*)d_ws;
    hipLaunchKernelGGL(trunk_fwd, dim3(grid), dim3(512), LDS_BYTES, stream, p);
}
```

```cpp
#include <hip/hip_runtime.h>
#include <cstdio>
#include <cstdint>

#define DI __device__ __forceinline__
#define GAS __attribute__((address_space(1)))
#define LAS __attribute__((address_space(3)))
typedef unsigned short bf16_t;
typedef short bf16x8 __attribute__((ext_vector_type(8)));
typedef float f32x4 __attribute__((ext_vector_type(4)));
typedef float f32x2 __attribute__((ext_vector_type(2)));
typedef unsigned u32x4 __attribute__((ext_vector_type(4)));
typedef unsigned u32x2 __attribute__((ext_vector_type(2)));

constexpr int SEQ = 16384, DM = 4096, DFF = 16384, NL = 4, MEML = 256, CH = 64, NCH = SEQ / CH;
constexpr int IN_W = 7448, ZW = 7680;
constexpr int ZC_GQ = 0, ZC_GK = 512, ZC_GV = 1024, ZC_GG = 2048, ZC_MQK = 3072, ZC_MV = 4096, ZC_MO = 5120, ZC_XQ = 6144, ZC_GATE = 7168, ZC_GA = 7424, ZC_MI = 7440, ZC_MF = 7444;
constexpr int OBW = 3840, OB_O = 768;
constexpr int GTW = 12288;
constexpr float EPS = 1e-6f;
#ifndef PITCH_PAD
#define PITCH_PAD 64
#endif
constexpr int PW = DM + PITCH_PAD, PU = DFF + PITCH_PAD;

constexpr size_t MiB = 1u << 20;
constexpr size_t WS_CTL = 0, CTL_ZERO_BYTES = 1 * MiB;
constexpr size_t WS_WIN = 1 * MiB, WS_WBR = 245 * MiB, WS_WOUT = 365 * MiB, WS_W1 = 495 * MiB, WS_W2 = 1015 * MiB;
constexpr size_t WS_WMK = 1529 * MiB, WS_WMV = 1561 * MiB, WS_MEMN = 1593 * MiB, WS_KM = 1595 * MiB, WS_VMT = 1597 * MiB;
constexpr size_t WS_X = 1599 * MiB, WS_H = 1855 * MiB, WS_Z = 1985 * MiB, WS_GT = 2225 * MiB, WS_U = WS_Z  ;
constexpr size_t WS_OB = 2609 * MiB, WS_Y = 2729 * MiB, WS_DS = 2859 * MiB, WS_SP = 2987 * MiB, WS_DC = 3051 * MiB, WS_CP = 3179 * MiB;
constexpr size_t WS_SMALL = 3243 * MiB, WS_SS = 3245 * MiB, SS_ZERO_BYTES = 2 * MiB, WS_BG = 3247 * MiB, WS_END = 3279 * MiB;
static_assert(PITCH_PAD <= 64, "buffer sizes below assume at most 64 elements of row padding");
static_assert(WS_WIN + (size_t)NL * ZW * PW * 2 <= WS_WBR && WS_WBR + (size_t)NL * DM * OBW * 2 <= WS_WOUT && WS_WOUT + (size_t)NL * DM * PW * 2 <= WS_W1 && WS_W1 + (size_t)NL * DFF * PW * 2 <= WS_W2 && WS_W2 + (size_t)NL * DM * PU * 2 <= WS_WMK, "weight map");
static_assert(WS_H + (size_t)SEQ * PW * 2 <= WS_Z && WS_Y + (size_t)SEQ * PW * 2 <= WS_DS, "activation map");
static_assert(WS_OB + (size_t)SEQ * OBW * 2 <= WS_Y, "OB size");
constexpr size_t SM_DECAY = 0, SM_DN = 512 * 1024, SM_NP = 1024 * 1024, SM_GG = 1536 * 1024, SM_FL = 1536 * 1024 + 4096, SM_MP = 1536 * 1024 + 8192;
static_assert(WS_U + (size_t)SEQ * PU * 2 <= WS_OB, "U overlay");
constexpr int CW_BAR = 4096;
static_assert(9 * (size_t)SEQ * 8 <= SS_ZERO_BYTES, "SS region");
typedef unsigned long long u64_t;
DI float ss_to_f(u64_t v) { return (float)v * (1.0f / 16777216.0f); }

constexpr int LDS_BYTES = 147456;
constexpr int L_ST = 0, L_VT = 69632, L_Q = 106496, L_K = 123904, L_MISC = 141312, L_BARW = 146432;
constexpr int ROW72 = 144, ROW136 = 272, ROW264 = 528;
constexpr int NWAVES = 8;

DI float bf2f(unsigned v) { return __uint_as_float(v << 16); }
DI float bflo(unsigned w) { return __uint_as_float(w << 16); }
DI float bfhi(unsigned w) { return __uint_as_float(w & 0xffff0000u); }
typedef __bf16 bf16x2_t __attribute__((ext_vector_type(2)));
DI unsigned pk2(float lo, float hi) { const f32x2 v = {lo, hi}; const bf16x2_t b = __builtin_convertvector(v, bf16x2_t); return __builtin_bit_cast(unsigned, b); }
DI float sigmoid_f(float x) { return __builtin_amdgcn_rcpf(1.0f + __expf(-x)); }
DI float silu_f(float x) { return x * sigmoid_f(x); }
DI float log_sigmoid_f(float x) { return fminf(x, 0.f) - __logf(1.0f + __expf(-fabsf(x))); }
DI float shx(float v, int o, int lane) { return __int_as_float(__builtin_amdgcn_ds_bpermute((lane ^ o) << 2, __float_as_int(v))); }
DI float shi(float v, int src) { return __int_as_float(__builtin_amdgcn_ds_bpermute(src << 2, __float_as_int(v))); }
DI float wave_sum(float v, int lane) {
#pragma unroll
    for (int o = 1; o < 64; o <<= 1) v += shx(v, o, lane);
    return v;
}
DI float wave_max(float v, int lane) {
#pragma unroll
    for (int o = 1; o < 64; o <<= 1) v = fmaxf(v, shx(v, o, lane));
    return v;
}
DI float wave_scan_sum(float v, int lane) {
#pragma unroll
    for (int o = 1; o < 64; o <<= 1) { const float t = shi(v, lane >= o ? lane - o : lane); if (lane >= o) v += t; }
    return v;
}
DI float wave_scan_max(float v, int lane) {
#pragma unroll
    for (int o = 1; o < 64; o <<= 1) { const float t = shi(v, lane >= o ? lane - o : lane); if (lane >= o) v = fmaxf(v, t); }
    return v;
}
DI f32x4 mfma16(bf16x8 a, bf16x8 b, f32x4 c) { return __builtin_amdgcn_mfma_f32_16x16x32_bf16(a, b, c, 0, 0, 0); }
DI int opaque_tid() { int t = (int)threadIdx.x; asm volatile("" : "+v"(t)); return t; }
DI int opaque_bx() { int b = (int)blockIdx.x; asm volatile("" : "+s"(b)); return b; }
DI LAS unsigned char* opaque_lds(LAS unsigned char* p) { asm volatile("" : "+s"(p)); return p; }
DI int opq(int v) { asm volatile("" : "+s"(v)); return v; }
DI int opaque_g() { int g = (int)gridDim.x; asm volatile("" : "+s"(g)); return g; }

namespace pg8 {
#define PG8_LAS __attribute__((address_space(3)))
constexpr int BM = 256, BK = 64, HALF = 128, HTB = HALF * BK * 2  , STAGE_BYTES = 8 * HTB, NXCD = 8;
#ifndef PG8_WGM
#define PG8_WGM 4
#endif
constexpr int WGM = PG8_WGM;

__host__ __device__ __forceinline__ int lds_byte(int r, int c) { const int st = (r >> 4) * 2 + (c >> 5), rr = r & 15, cc = c & 31, ob = rr * 64 + cc * 2; return st * 1024 + (ob ^ (((ob >> 9) & 1) << 5)); }
__host__ __device__ __forceinline__ void stage_rc(int b, int& R, int& C) { const int st = b / 1024, sb = b % 1024, swz = sb ^ (((sb >> 9) & 1) << 5); R = (st >> 1) * 16 + swz / 64; C = (st & 1) * 32 + (swz % 64) / 2; }
__host__ __device__ __forceinline__ int perm32(int rho) { const int n = rho >> 4, i = rho & 15; return 8 * (i >> 2) + 4 * n + (i & 3); }

struct Unit { int pm, pn, kind; };
struct Gemm { const bf16_t* A; const bf16_t* Bt; int M, N, K, lda, ldb; };

struct StaticOrder {
    int nM, nN, nwg, G, c, wgm;
    __host__ __device__ void init(int M, int N, int G_, int c_, int wgm_ = WGM) { nM = M / BM; nN = N / BM; nwg = nM * nN; G = G_; c = c_; wgm = wgm_; }
    __host__ __device__ bool next(int i, Unit& u) const {
        const long L = (long)i * G + c; if (L >= nwg) return false;
        int wgid = (int)L; { const int q = nwg / NXCD, r = nwg % NXCD, xcd = wgid % NXCD, off = wgid / NXCD; wgid = (xcd < r ? xcd * (q + 1) : r * (q + 1) + (xcd - r) * q) + off; }
        const int nig = wgm * nN, gid = wgid / nig, fm = gid * wgm, gsz = (nM - fm) < wgm ? (nM - fm) : wgm;
        u.pm = fm + ((wgid % nig) % gsz); u.pn = (wgid % nig) / gsz; u.kind = 0; return true;
    }
    __device__ __forceinline__ void a_ready(const Unit&) const {}
    __device__ __forceinline__ void done(const Unit&) const {}
    __device__ __forceinline__ int nt(const Unit&, int nt_default) const { return nt_default; }
    __device__ __forceinline__ int koff(const Unit&) const { return 0; }
};
struct BranchOrder : StaticOrder {
    __host__ __device__ bool next(int i, Unit& u) const { if (!StaticOrder::next(i >> 2, u)) return false; u.kind = i & 3; return true; }
    __device__ __forceinline__ int nt(const Unit& u, int) const { return u.kind < 3 ? 4 : 48; }
    __device__ __forceinline__ int koff(const Unit& u) const { return u.kind < 3 ? 256 * u.kind : 768; }
};

template <int ACT  > struct EpiBf16 {
    static constexpr bool PERM = true, AFTER_DRAIN = false, HOOK = false;
    bf16_t* O; int ldc; const float* bias; const unsigned long long* ss; bf16_t* O2; int ld2, pn2;
    __device__ __forceinline__ void operator()(const f32x4 (&acc)[2][2][4][2], const Unit& u, int wr, int wc, int fr, int fq) const {
        const int row0 = u.pm * BM + wr * 64 + fr, col0 = u.pn * BM + wc * 32 + 8 * fq;
        f32x4 bv[2][2];
#pragma unroll
        for (int bj = 0; bj < 2; ++bj)
#pragma unroll
            for (int n = 0; n < 2; ++n) bv[bj][n] = (ACT == 2) ? *(const f32x4*)(bias + col0 + bj * HALF + 4 * n) : (f32x4){0.f, 0.f, 0.f, 0.f};
#pragma unroll
        for (int ai = 0; ai < 2; ++ai)
#pragma unroll
            for (int m = 0; m < 4; ++m) { bf16_t* rowp = O + (size_t)(row0 + ai * HALF + m * 16) * ldc + col0;
                const bool redir = (ACT == 0) && O2 != nullptr && u.pn == pn2;
                if (redir) rowp = O2 + (size_t)(row0 + ai * HALF + m * 16) * ld2 + (col0 - u.pn * BM);
                float rs = 1.f; if (ACT != 2) { if (ss) rs = 1.0f / sqrtf((float)ss[row0 + ai * HALF + m * 16] * (1.0f / 16777216.0f) * (1.0f / DM) + EPS); }
#pragma unroll
                for (int bj = 0; bj < 2; ++bj) { f32x4 v0 = acc[ai][bj][m][0], v1 = acc[ai][bj][m][1];
                    if (ACT != 2) { v0 = v0 * rs; v1 = v1 * rs; }
                    if (ACT == 1) {
#pragma unroll
                        for (int j = 0; j < 4; ++j) { const float a = fmaxf(v0[j], 0.f), b = fmaxf(v1[j], 0.f); v0[j] = a * a; v1[j] = b * b; } }
                    if (ACT == 2) { v0 = v0 + bv[bj][0]; v1 = v1 + bv[bj][1];
#pragma unroll
                        for (int j = 0; j < 4; ++j) { v0[j] = sigmoid_f(fminf(fmaxf(v0[j], -30.f), 30.f)); v1[j] = sigmoid_f(fminf(fmaxf(v1[j], -30.f), 30.f)); } }
                    u32x4 w; w.x = pk2(v0[0], v0[1]); w.y = pk2(v0[2], v0[3]); w.z = pk2(v1[0], v1[1]); w.w = pk2(v1[2], v1[3]);
                    *(u32x4*)(rowp + bj * HALF) = w;
                    if (redir) { *(u32x4*)(rowp + bj * HALF + 256) = w; *(u32x4*)(rowp + bj * HALF + 512) = w; } } }
    }
    __device__ __forceinline__ bool hook_at(const Unit&, int) const { return false; }
    __device__ __forceinline__ void hook(f32x4 (&)[2][2][4][2], const Unit&, int, int, int, int, int) const {}
};
struct EpiResid {
    static constexpr bool PERM = true, AFTER_DRAIN = false, HOOK = false;
    const float* in; float* out; int ldc; bf16_t* xb; unsigned long long* ss; int ldxb;
    __device__ __forceinline__ void operator()(const f32x4 (&acc)[2][2][4][2], const Unit& u, int wr, int wc, int fr, int fq) const {
        const int row0 = u.pm * BM + wr * 64 + fr, col0 = u.pn * BM + wc * 32 + 8 * fq, lane = fq * 16 + fr;
#pragma unroll
        for (int ai = 0; ai < 2; ++ai) {
            f32x4 r[4][2][2];
#pragma unroll
            for (int m = 0; m < 4; ++m) { const size_t off = (size_t)(row0 + ai * HALF + m * 16) * ldc + col0;
#pragma unroll
                for (int bj = 0; bj < 2; ++bj)
#pragma unroll
                    for (int n = 0; n < 2; ++n) r[m][bj][n] = *(const f32x4*)(in + off + bj * HALF + n * 4); }
#pragma unroll
            for (int m = 0; m < 4; ++m) { const int row = row0 + ai * HALF + m * 16; const size_t off = (size_t)row * ldc + col0;
                float sq = 0.f;
#pragma unroll
                for (int bj = 0; bj < 2; ++bj) { const f32x4 o0 = r[m][bj][0] + acc[ai][bj][m][0], o1 = r[m][bj][1] + acc[ai][bj][m][1];
                    *(f32x4*)(out + off + bj * HALF) = o0; *(f32x4*)(out + off + bj * HALF + 4) = o1;
                    sq += (o0[0] * o0[0] + o0[1] * o0[1]) + (o0[2] * o0[2] + o0[3] * o0[3]) + (o1[0] * o1[0] + o1[1] * o1[1]) + (o1[2] * o1[2] + o1[3] * o1[3]);
                    u32x4 w; w.x = pk2(o0[0], o0[1]); w.y = pk2(o0[2], o0[3]); w.z = pk2(o1[0], o1[1]); w.w = pk2(o1[2], o1[3]);
                    *(u32x4*)(xb + (size_t)row * ldxb + col0 + bj * HALF) = w; }
                sq += shx(sq, 16, lane); sq += shx(sq, 32, lane);
                if (fq == 0) (void)__hip_atomic_fetch_add(ss + row, (unsigned long long)(sq * 16777216.0f), __ATOMIC_RELAXED, __HIP_MEMORY_SCOPE_AGENT); }
            asm volatile("" ::: "memory"); }
    }
    __device__ __forceinline__ bool hook_at(const Unit&, int) const { return false; }
    __device__ __forceinline__ void hook(f32x4 (&)[2][2][4][2], const Unit&, int, int, int, int, int) const {}
};
struct EpiBranch {
    static constexpr bool PERM = true, AFTER_DRAIN = false, HOOK = true;
    bf16_t* O; int ldc; bf16_t* GT; const float* bias;
    __device__ __forceinline__ bool hook_at(const Unit& u, int t) const { return u.kind == 3 && (t == 16 || t == 32); }
    __device__ __forceinline__ void hook(f32x4 (&acc)[2][2][4][2], const Unit& u, int t, int, int, int, int) const {
        const int tid_ = opaque_tid(), wid_ = tid_ >> 6, wr = wid_ >> 2, wc = wid_ & 3, fr = tid_ & 15, fq = (tid_ >> 4) & 3;
        const int row0 = u.pm * BM + wr * 64 + fr, col0 = u.pn * BM + wc * 32 + 8 * fq;
        const bf16_t* ga = GT + (size_t)(t == 16 ? 0 : DM); const bf16_t* gb = ga + DM;
#pragma unroll
        for (int ai = 0; ai < 2; ++ai) {
            u32x4 a[4][2], b[4][2];
#pragma unroll
            for (int m = 0; m < 4; ++m) { const size_t off = (size_t)(row0 + ai * HALF + m * 16) * GTW + col0;
#pragma unroll
                for (int bj = 0; bj < 2; ++bj) { a[m][bj] = *(const u32x4*)(ga + off + bj * HALF); b[m][bj] = *(const u32x4*)(gb + off + bj * HALF); } }
#pragma unroll
            for (int m = 0; m < 4; ++m)
#pragma unroll
                for (int bj = 0; bj < 2; ++bj) { const u32x4 x = a[m][bj], y = b[m][bj];
                    f32x4 r0, r1;
                    r0[0] = bflo(y.x) * __builtin_amdgcn_rcpf(bflo(x.x)); r0[1] = bfhi(y.x) * __builtin_amdgcn_rcpf(bfhi(x.x));
                    r0[2] = bflo(y.y) * __builtin_amdgcn_rcpf(bflo(x.y)); r0[3] = bfhi(y.y) * __builtin_amdgcn_rcpf(bfhi(x.y));
                    r1[0] = bflo(y.z) * __builtin_amdgcn_rcpf(bflo(x.z)); r1[1] = bfhi(y.z) * __builtin_amdgcn_rcpf(bfhi(x.z));
                    r1[2] = bflo(y.w) * __builtin_amdgcn_rcpf(bflo(x.w)); r1[3] = bfhi(y.w) * __builtin_amdgcn_rcpf(bfhi(x.w));
                    acc[ai][bj][m][0] = acc[ai][bj][m][0] * r0; acc[ai][bj][m][1] = acc[ai][bj][m][1] * r1; }
            asm volatile("" ::: "memory"); }
    }
    __device__ __forceinline__ void operator()(const f32x4 (&acc)[2][2][4][2], const Unit& u, int wr, int wc, int fr, int fq) const {
        const int row0 = u.pm * BM + wr * 64 + fr, col0 = u.pn * BM + wc * 32 + 8 * fq;
        if (u.kind < 3) {
            bf16_t* gd = GT + (size_t)u.kind * DM; const float* bj_ = bias + (size_t)u.kind * DM + col0;
            f32x4 bv[2][2];
#pragma unroll
            for (int bj = 0; bj < 2; ++bj)
#pragma unroll
                for (int n = 0; n < 2; ++n) bv[bj][n] = *(const f32x4*)(bj_ + bj * HALF + 4 * n);
#pragma unroll
            for (int ai = 0; ai < 2; ++ai)
#pragma unroll
                for (int m = 0; m < 4; ++m) { const size_t off = (size_t)(row0 + ai * HALF + m * 16) * GTW + col0;
#pragma unroll
                    for (int bj = 0; bj < 2; ++bj) { f32x4 v0 = acc[ai][bj][m][0] + bv[bj][0], v1 = acc[ai][bj][m][1] + bv[bj][1];
#pragma unroll
                        for (int e = 0; e < 4; ++e) { v0[e] = 1.0f + __expf(-fminf(fmaxf(v0[e], -30.f), 30.f)); v1[e] = 1.0f + __expf(-fminf(fmaxf(v1[e], -30.f), 30.f)); }
                        u32x4 w; w.x = pk2(v0[0], v0[1]); w.y = pk2(v0[2], v0[3]); w.z = pk2(v1[0], v1[1]); w.w = pk2(v1[2], v1[3]);
                        *(u32x4*)(gd + off + bj * HALF) = w; } }
        } else {
            const bf16_t* gc = GT + 2 * DM;
            u32x4 g[2][4][2];
#pragma unroll
            for (int ai = 0; ai < 2; ++ai)
#pragma unroll
                for (int m = 0; m < 4; ++m)
#pragma unroll
                    for (int bj = 0; bj < 2; ++bj) g[ai][m][bj] = *(const u32x4*)(gc + (size_t)(row0 + ai * HALF + m * 16) * GTW + col0 + bj * HALF);
#pragma unroll
            for (int ai = 0; ai < 2; ++ai)
#pragma unroll
                for (int m = 0; m < 4; ++m) { const size_t r = (size_t)(row0 + ai * HALF + m * 16);
#pragma unroll
                    for (int bj = 0; bj < 2; ++bj) { const u32x4 gg = g[ai][m][bj];
                        const f32x4 v0 = acc[ai][bj][m][0], v1 = acc[ai][bj][m][1];
                        u32x4 w; w.x = pk2(v0[0] * __builtin_amdgcn_rcpf(bflo(gg.x)), v0[1] * __builtin_amdgcn_rcpf(bfhi(gg.x))); w.y = pk2(v0[2] * __builtin_amdgcn_rcpf(bflo(gg.y)), v0[3] * __builtin_amdgcn_rcpf(bfhi(gg.y)));
                        w.z = pk2(v1[0] * __builtin_amdgcn_rcpf(bflo(gg.z)), v1[1] * __builtin_amdgcn_rcpf(bfhi(gg.z))); w.w = pk2(v1[2] * __builtin_amdgcn_rcpf(bflo(gg.w)), v1[3] * __builtin_amdgcn_rcpf(bfhi(gg.w)));
                        *(u32x4*)(O + r * ldc + col0 + bj * HALF) = w; } }
        }
    }
};

template <class Epi, class Sched, bool ALIGN_EPI = false, bool SP2 = false>
__device__ __forceinline__ void gemm_phase(PG8_LAS unsigned char* lds, const Gemm g, const Sched& S, const Epi& E) {
    const int tid = opaque_tid(), wid = __builtin_amdgcn_readfirstlane(tid >> 6), lane = tid & 63, wr = wid >> 2, wc = wid & 3, fr = lane & 15, fq = lane >> 4;
    const int K = g.K, nt_default = K / BK;
    unsigned voffA[2], voffB[2];
#pragma unroll
    for (int i = 0; i < 2; ++i) { int R, C; stage_rc(tid * 16 + i * 8192, R, C); const int Rb = Epi::PERM ? ((R & ~31) + perm32(R & 31)) : R;
        voffA[i] = (unsigned)(R * g.lda + C) * 2u; voffB[i] = (unsigned)(Rb * g.ldb + C) * 2u; }
    const size_t kstep = (size_t)(BK * 2);
    const size_t hstepA = (size_t)HALF * g.lda * 2, hstepB = (size_t)HALF * g.ldb * 2;
    const size_t tstepA = 2 * hstepA, tstepB = 2 * hstepB;
    const unsigned ldsw = (unsigned)wid * 1024u;
    const int aoff = lds_byte(wr * 64 + fr, fq * 8), boff = lds_byte(wc * 32 + fr, fq * 8);
#define PG8_SA(b, h) (((b) * 2 + (h)) * HTB)
#define PG8_SB(b, h) ((4 + (b) * 2 + (h)) * HTB)
#define PG8_STAGE(bufoff, gbase, voff) do { _Pragma("unroll") for (int _i = 0; _i < 2; ++_i) \
        __builtin_amdgcn_global_load_lds((const unsigned*)((const char*)(gbase) + (voff)[_i]), (PG8_LAS unsigned*)(lds + (bufoff) + ldsw + _i * 8192), 16, 0, 0); } while (0)
#define PG8_LDA(dst, b, h) do { _Pragma("unroll") for (int m = 0; m < 4; ++m) _Pragma("unroll") for (int k = 0; k < 2; ++k) dst[m][k] = *(const PG8_LAS bf16x8*)(lds + PG8_SA(b, h) + aoff + m * 2048 + k * 1024); } while (0)
#define PG8_LDB(dst, b, h) do { _Pragma("unroll") for (int n = 0; n < 2; ++n) _Pragma("unroll") for (int k = 0; k < 2; ++k) dst[n][k] = *(const PG8_LAS bf16x8*)(lds + PG8_SB(b, h) + boff + n * 2048 + k * 1024); } while (0)
#ifndef PG8_BAL
#define PG8_BAL 1
#endif
#ifndef PG8_STAGE_LATE
#define PG8_STAGE_LATE 0
#endif
#ifndef PG8_PRIO
#define PG8_PRIO 1
#endif
#define PG8_MMA(ai, bj, At, Bt) do { if (PG8_PRIO) __builtin_amdgcn_s_setprio(PG8_PRIO); _Pragma("unroll") for (int m = 0; m < 4; ++m) _Pragma("unroll") for (int n = 0; n < 2; ++n) _Pragma("unroll") for (int k = 0; k < 2; ++k) \
        acc[ai][bj][m][n] = __builtin_amdgcn_mfma_f32_16x16x32_bf16(Bt[n][k], At[m][k], acc[ai][bj][m][n], 0, 0, 0); if (PG8_PRIO) __builtin_amdgcn_s_setprio(0); } while (0)
#define PG8_WAIT_V(n) asm volatile("s_waitcnt vmcnt(" #n ")" ::: "memory")
#define PG8_WAIT_L(n) asm volatile("s_waitcnt lgkmcnt(" #n ")" ::: "memory")
#define PG8_BAR __builtin_amdgcn_s_barrier()
#define PG8_SCHED __builtin_amdgcn_sched_barrier(0)
    Unit cur, nxt; int ui = 0;
    if (!S.next(0, cur)) return;
    f32x4 acc[2][2][4][2];
#pragma unroll
    for (int a = 0; a < 2; ++a)
#pragma unroll
        for (int b = 0; b < 2; ++b)
#pragma unroll
            for (int m = 0; m < 4; ++m)
#pragma unroll
                for (int n = 0; n < 2; ++n) acc[a][b][m][n] = (f32x4){0.f, 0.f, 0.f, 0.f};
    bf16x8 At[4][2], B0[2][2], B1[2][2];
    const char* cA = (const char*)g.A + (size_t)cur.pm * tstepA + (size_t)S.koff(cur) * 2; const char* cB = (const char*)g.Bt + (size_t)cur.pn * tstepB + (size_t)S.koff(cur) * 2;
    int nt = S.nt(cur, nt_default);
    S.a_ready(cur);
    if constexpr (SP2) {
        PG8_STAGE(PG8_SB(0, 0), cB, voffB); PG8_STAGE(PG8_SB(0, 1), cB + hstepB, voffB); PG8_STAGE(PG8_SA(0, 0), cA, voffA); PG8_STAGE(PG8_SA(0, 1), cA + hstepA, voffA);
        if (wr == 1) PG8_BAR;
        PG8_WAIT_V(2); PG8_BAR;
#if PG8_BAL
        PG8_STAGE(PG8_SB(1, 0), cB + kstep, voffB); PG8_STAGE(PG8_SB(1, 1), cB + hstepB + kstep, voffB);
        PG8_WAIT_V(4); PG8_BAR;
#else
        PG8_STAGE(PG8_SB(1, 0), cB + kstep, voffB); PG8_STAGE(PG8_SA(1, 0), cA + kstep, voffA); PG8_STAGE(PG8_SB(1, 1), cB + hstepB + kstep, voffB);
        PG8_WAIT_V(6); PG8_BAR;
#endif
    } else {
        PG8_STAGE(PG8_SB(0, 0), cB, voffB); PG8_STAGE(PG8_SA(0, 0), cA, voffA); PG8_STAGE(PG8_SB(0, 1), cB + hstepB, voffB); PG8_STAGE(PG8_SA(0, 1), cA + hstepA, voffA);
        if (wr == 1) PG8_BAR;
        PG8_WAIT_V(4); PG8_BAR;
        PG8_STAGE(PG8_SB(1, 0), cB + kstep, voffB); PG8_STAGE(PG8_SA(1, 0), cA + kstep, voffA); PG8_STAGE(PG8_SB(1, 1), cB + hstepB + kstep, voffB);
        PG8_WAIT_V(6); PG8_BAR;
    }
    for (;;) {
        const bool has_next = S.next(ui + 1, nxt);
        const char* nA = has_next ? (const char*)g.A + (size_t)nxt.pm * tstepA + (size_t)S.koff(nxt) * 2 : cA; const char* nB = has_next ? (const char*)g.Bt + (size_t)nxt.pn * tstepB + (size_t)S.koff(nxt) * 2 : cB;
        for (int t = 0; t < nt; t += 2) {
            const bool last = (t == nt - 2);
            if constexpr (Epi::HOOK) { if (E.hook_at(cur, t)) E.hook(acc, cur, t, wr, wc, fr, fq); }
            const char* a1 = cA + (size_t)(t + 1) * kstep;
            const char* a2 = last ? nA : cA + (size_t)(t + 2) * kstep; const char* b2 = last ? nB : cB + (size_t)(t + 2) * kstep;
            const char* a3 = a2 + kstep; const char* b3 = b2 + kstep;
            if (last && has_next) S.a_ready(nxt);
            if constexpr (SP2) {
#if PG8_BAL
            PG8_LDB(B0, 0, 0); PG8_LDB(B1, 0, 1); PG8_SCHED; PG8_LDA(At, 0, 0); PG8_STAGE(PG8_SA(1, 0), a1, voffA); PG8_STAGE(PG8_SA(1, 1), a1 + hstepA, voffA);
            PG8_WAIT_V(8); PG8_WAIT_L(0); PG8_BAR; PG8_MMA(0, 0, At, B0); PG8_MMA(0, 1, At, B1); PG8_BAR; PG8_SCHED;
            PG8_LDA(At, 0, 1); PG8_STAGE(PG8_SB(0, 0), b2, voffB); PG8_STAGE(PG8_SB(0, 1), b2 + hstepB, voffB);
            PG8_WAIT_V(6); PG8_WAIT_L(0); PG8_BAR; PG8_MMA(1, 0, At, B0); PG8_MMA(1, 1, At, B1); PG8_BAR; PG8_SCHED;
            PG8_LDB(B0, 1, 0); PG8_LDB(B1, 1, 1); PG8_SCHED; PG8_LDA(At, 1, 0); PG8_STAGE(PG8_SA(0, 0), a2, voffA); PG8_STAGE(PG8_SA(0, 1), a2 + hstepA, voffA);
            PG8_WAIT_V(8); PG8_WAIT_L(0); PG8_BAR; PG8_MMA(0, 0, At, B0); PG8_MMA(0, 1, At, B1); PG8_BAR; PG8_SCHED;
            PG8_LDA(At, 1, 1); PG8_STAGE(PG8_SB(1, 0), b3, voffB); PG8_STAGE(PG8_SB(1, 1), b3 + hstepB, voffB);
            PG8_WAIT_V(6); PG8_WAIT_L(0); PG8_BAR; PG8_MMA(1, 0, At, B0); PG8_MMA(1, 1, At, B1); PG8_BAR; PG8_SCHED;
            (void)a3;
#else
#if PG8_STAGE_LATE
            PG8_LDB(B0, 0, 0); PG8_LDB(B1, 0, 1); PG8_SCHED; PG8_LDA(At, 0, 0); PG8_WAIT_L(0); PG8_SCHED; PG8_STAGE(PG8_SA(1, 1), a1 + hstepA, voffA);
            PG8_WAIT_V(8); PG8_BAR;
#else
            PG8_LDB(B0, 0, 0); PG8_LDB(B1, 0, 1); PG8_SCHED; PG8_LDA(At, 0, 0); PG8_STAGE(PG8_SA(1, 1), a1 + hstepA, voffA);
            PG8_WAIT_V(8); PG8_WAIT_L(0); PG8_BAR;
#endif
            PG8_MMA(0, 0, At, B0); PG8_MMA(0, 1, At, B1); PG8_BAR; PG8_SCHED;
#if PG8_STAGE_LATE
            PG8_LDA(At, 0, 1); PG8_WAIT_L(0); PG8_SCHED; PG8_STAGE(PG8_SB(0, 0), b2, voffB); PG8_STAGE(PG8_SB(0, 1), b2 + hstepB, voffB); PG8_STAGE(PG8_SA(0, 0), a2, voffA);
            PG8_WAIT_V(8); PG8_BAR;
#else
            PG8_LDA(At, 0, 1); PG8_STAGE(PG8_SB(0, 0), b2, voffB); PG8_STAGE(PG8_SB(0, 1), b2 + hstepB, voffB); PG8_STAGE(PG8_SA(0, 0), a2, voffA);
            PG8_WAIT_V(8); PG8_WAIT_L(0); PG8_BAR;
#endif
            PG8_MMA(1, 0, At, B0); PG8_MMA(1, 1, At, B1); PG8_BAR; PG8_SCHED;
#if PG8_STAGE_LATE
            PG8_LDB(B0, 1, 0); PG8_LDB(B1, 1, 1); PG8_SCHED; PG8_LDA(At, 1, 0); PG8_WAIT_L(0); PG8_SCHED; PG8_STAGE(PG8_SA(0, 1), a2 + hstepA, voffA);
            PG8_WAIT_V(8); PG8_BAR;
#else
            PG8_LDB(B0, 1, 0); PG8_LDB(B1, 1, 1); PG8_SCHED; PG8_LDA(At, 1, 0); PG8_STAGE(PG8_SA(0, 1), a2 + hstepA, voffA);
            PG8_WAIT_V(8); PG8_WAIT_L(0); PG8_BAR;
#endif
            PG8_MMA(0, 0, At, B0); PG8_MMA(0, 1, At, B1); PG8_BAR; PG8_SCHED;
#if PG8_STAGE_LATE
            PG8_LDA(At, 1, 1); PG8_WAIT_L(0); PG8_SCHED; PG8_STAGE(PG8_SB(1, 0), b3, voffB); PG8_STAGE(PG8_SB(1, 1), b3 + hstepB, voffB); PG8_STAGE(PG8_SA(1, 0), a3, voffA);
            PG8_WAIT_V(8); PG8_BAR;
#else
            PG8_LDA(At, 1, 1); PG8_STAGE(PG8_SB(1, 0), b3, voffB); PG8_STAGE(PG8_SB(1, 1), b3 + hstepB, voffB); PG8_STAGE(PG8_SA(1, 0), a3, voffA);
            PG8_WAIT_V(8); PG8_WAIT_L(0); PG8_BAR;
#endif
            PG8_MMA(1, 0, At, B0); PG8_MMA(1, 1, At, B1); PG8_BAR; PG8_SCHED;
#endif
            } else {
            PG8_LDB(B0, 0, 0); PG8_SCHED; PG8_LDA(At, 0, 0); PG8_STAGE(PG8_SA(1, 1), a1 + hstepA, voffA);
            PG8_WAIT_L(8); PG8_BAR; PG8_WAIT_L(0); PG8_MMA(0, 0, At, B0); PG8_BAR; PG8_SCHED;
            PG8_LDB(B1, 0, 1); PG8_STAGE(PG8_SB(0, 0), b2, voffB);
            PG8_BAR; PG8_WAIT_L(0); PG8_MMA(0, 1, At, B1); PG8_BAR;
            PG8_LDA(At, 0, 1); PG8_STAGE(PG8_SA(0, 0), a2, voffA);
            PG8_BAR; PG8_WAIT_L(0); PG8_MMA(1, 0, At, B0); PG8_BAR; PG8_SCHED;
            PG8_STAGE(PG8_SB(0, 1), b2 + hstepB, voffB);
            PG8_WAIT_V(6); PG8_BAR; PG8_MMA(1, 1, At, B1); PG8_BAR;
            PG8_LDB(B0, 1, 0); PG8_SCHED; PG8_LDA(At, 1, 0); PG8_STAGE(PG8_SA(0, 1), a2 + hstepA, voffA);
            PG8_WAIT_L(8); PG8_BAR; PG8_WAIT_L(0); PG8_MMA(0, 0, At, B0); PG8_BAR; PG8_SCHED;
            PG8_LDB(B1, 1, 1); PG8_STAGE(PG8_SB(1, 0), b3, voffB);
            PG8_BAR; PG8_WAIT_L(0); PG8_MMA(0, 1, At, B1); PG8_BAR;
            PG8_LDA(At, 1, 1); PG8_STAGE(PG8_SA(1, 0), a3, voffA);
            PG8_BAR; PG8_WAIT_L(0); PG8_MMA(1, 0, At, B0); PG8_BAR; PG8_SCHED;
            PG8_STAGE(PG8_SB(1, 1), b3 + hstepB, voffB);
            PG8_WAIT_V(6); PG8_BAR; PG8_MMA(1, 1, At, B1); PG8_BAR;
            }
        }
        if constexpr (ALIGN_EPI) { if (wr == 0) PG8_BAR; }
        E(acc, cur, wr, wc, fr, fq); S.done(cur);
        if (!has_next) break;
#pragma unroll
        for (int a = 0; a < 2; ++a)
#pragma unroll
            for (int b = 0; b < 2; ++b)
#pragma unroll
                for (int m = 0; m < 4; ++m)
#pragma unroll
                    for (int n = 0; n < 2; ++n) acc[a][b][m][n] = (f32x4){0.f, 0.f, 0.f, 0.f};
        cur = nxt; cA = nA; cB = nB; ++ui; nt = S.nt(cur, nt_default);
        if constexpr (ALIGN_EPI) { if (wr == 1) PG8_BAR; }
    }
    PG8_WAIT_V(0);
    if constexpr (!ALIGN_EPI) { if (wr == 0) PG8_BAR; }
    PG8_BAR;
#undef PG8_SA
#undef PG8_SB
#undef PG8_STAGE
#undef PG8_LDA
#undef PG8_LDB
#undef PG8_MMA
#undef PG8_WAIT_V
#undef PG8_WAIT_L
#undef PG8_BAR
#undef PG8_SCHED
}
}

#define XB_TMO      128
#define XB_XCNT(j)  (256  + 64 * (j))
#define XB_XSUB(j)  (1280 + 64 * (j))
#define XB_XGEN(j)  (2304 + 64 * (j))
#define XB_TOP      3328
#define XB_TOPGEN   3392
#define XCD_BAR_WORDS 3456
#define XB_SPIN_CAP (1u << 18)

__device__ __forceinline__ unsigned xb_ld(unsigned* p)              { return __hip_atomic_load(p, __ATOMIC_RELAXED, __HIP_MEMORY_SCOPE_AGENT); }
__device__ __forceinline__ unsigned xb_add(unsigned* p, unsigned v) { return __hip_atomic_fetch_add(p, v, __ATOMIC_RELAXED, __HIP_MEMORY_SCOPE_AGENT); }
__device__ __forceinline__ unsigned xb_xcc_id() { return (unsigned)__builtin_amdgcn_s_getreg((3 << 11) | 20) & 0xFu; }
#define XB_SPIN(cond, bar) do { unsigned _sp = 0; while (cond) { __builtin_amdgcn_s_sleep(1); \
    if ((++_sp & 255u) == 0u) { if (xb_ld(&(bar)[XB_TMO])) break; if (_sp > XB_SPIN_CAP) { atomicAdd(&(bar)[XB_TMO], 1u); break; } } } } while (0)

struct XcdBarrier {
    unsigned* bar; unsigned x;
    volatile LAS unsigned* st;
};
__device__ __forceinline__ XcdBarrier xcd_barrier_post(unsigned* bar, volatile LAS unsigned* st) {
    XcdBarrier b; b.bar = bar; b.x = xb_xcc_id(); b.st = st;
    if (threadIdx.x == 0) (void)xb_add(&bar[XB_XCNT(b.x)], 1u);
    return b;
}
__device__ __forceinline__ void xcd_barrier_complete(unsigned* bar, unsigned x, unsigned& nloc, unsigned& nx) {
    const unsigned G = gridDim.x * gridDim.y * gridDim.z;
    unsigned sum, cnt, mine, sp = 0u;
    for (;;) {
        sum = 0u; cnt = 0u; mine = 0u;
#pragma unroll
        for (unsigned j = 0; j < 16; ++j) { const unsigned c = xb_ld(&bar[XB_XCNT(j)]); sum += c; cnt += (c > 0u) ? 1u : 0u; mine = (j == x) ? c : mine; }
        if (sum == G) break;
        __builtin_amdgcn_s_sleep(1);
        if ((++sp & 255u) == 0u) { if (xb_ld(&bar[XB_TMO])) break; if (sp > XB_SPIN_CAP) { atomicAdd(&bar[XB_TMO], 1u); break; } }
    }
    nloc = mine > 0u ? mine : 1u; nx = cnt > 0u ? cnt : 1u;
}
__device__ __forceinline__ void xcd_barrier(const XcdBarrier& b) {
    asm volatile("s_waitcnt vmcnt(0)" ::: "memory");
    __syncthreads();
    if (threadIdx.x == 0) {
        unsigned* bar = b.bar;
        __builtin_amdgcn_s_waitcnt(0);
        unsigned nloc = b.st[0], nx = b.st[1];
        if (nloc == 0u) { xcd_barrier_complete(bar, b.x, nloc, nx); b.st[0] = nloc; b.st[1] = nx; }
        const unsigned old = xb_add(&bar[XB_XSUB(b.x)], 1u);
        const unsigned gen = old / nloc;
        if (old + 1u == (gen + 1u) * nloc) {
            __builtin_amdgcn_fence(__ATOMIC_RELEASE, "agent");
            asm volatile("s_waitcnt vmcnt(0)" ::: "memory");
            const unsigned og = xb_add(&bar[XB_TOP], 1u);
            const unsigned tg = og / nx;
            if (og + 1u == (tg + 1u) * nx) xb_add(&bar[XB_TOPGEN], 1u);
            else XB_SPIN(xb_ld(&bar[XB_TOPGEN]) == tg, bar);
            __builtin_amdgcn_fence(__ATOMIC_ACQUIRE, "agent");
            xb_add(&bar[XB_XGEN(b.x)], 1u);
            asm volatile("s_waitcnt vmcnt(0)" ::: "memory");
        } else {
            XB_SPIN(xb_ld(&bar[XB_XGEN(b.x)]) == gen, bar);
            __builtin_amdgcn_fence(__ATOMIC_ACQUIRE, "agent");
            asm volatile("s_waitcnt vmcnt(0)" ::: "memory");
        }
    }
    __syncthreads();
}

struct Params { const float* in[23]; float* out; unsigned char* ws; };
enum { I_X = 0, I_MEM, I_NORM_MIX, I_W_IN, I_W_GLA_A, I_B_GLA_A, I_GLA_NORM, I_CONV_W, I_CONV_B, I_B_ML_I, I_B_ML_F, I_ML_NORM, I_MEM_NORM, I_W_MEM_K, I_W_MEM_V, I_W_BRANCH, I_W_GATE, I_B_GATE, I_W_OUT, I_NORM_FFN, I_W_FF1, I_W_FF2, I_FINAL_NORM };

DI int win_row(int n) {
    if (n < 3072) return n;
    if (n < 3088) return ZC_GA + (n - 3072);
    if (n < 6160) return n - 16;
    if (n < 6168) return ZC_MI + (n - 6160);
    return n - 24;
}
DI void transpose_item(const float* __restrict__ W, int K, int N, bf16_t* __restrict__ WT, int ld_dst, int col_off, int row_off, bool remap, LAS float* scr, int item, int lane, const float* __restrict__ gain = nullptr) {
    const int nblk = (N + 63) >> 6, kb = item / nblk, nb = item - kb * nblk, k0 = kb << 6, n0 = nb << 6;
    const int a = lane & 15, q = lane >> 4, n4 = 4 * a;
    const bool ok = (n0 + n4) < N;
    f32x4 v[16];
#pragma unroll
    for (int i = 0; i < 16; ++i) { const int kk = 4 * i + q; v[i] = ok ? *(const f32x4*)(W + (size_t)(k0 + kk) * N + n0 + n4) : (f32x4){0.f, 0.f, 0.f, 0.f}; }
#pragma unroll
    for (int i = 0; i < 16; ++i) { const int kk = 4 * i + q;
#pragma unroll
        for (int e = 0; e < 4; ++e) scr[(n4 + e) * 65 + kk] = v[i][e]; }
    asm volatile("s_waitcnt lgkmcnt(0)" ::: "memory");
    const int c = lane & 7;
    f32x4 g0 = (f32x4){1.f, 1.f, 1.f, 1.f}, g1 = g0;
    if (gain) { g0 = *(const f32x4*)(gain + k0 + 8 * c); g1 = *(const f32x4*)(gain + k0 + 8 * c + 4); }
#pragma unroll
    for (int jj = 0; jj < 8; ++jj) { const int n = (lane >> 3) + 8 * jj; const LAS float* s = scr + n * 65 + 8 * c;
        u32x4 o; o.x = pk2(s[0] * g0[0], s[1] * g0[1]); o.y = pk2(s[2] * g0[2], s[3] * g0[3]); o.z = pk2(s[4] * g1[0], s[5] * g1[1]); o.w = pk2(s[6] * g1[2], s[7] * g1[3]);
        const int ng = n0 + n;
        if (ng < N) { const int row = row_off + (remap ? win_row(ng) : ng); *(u32x4*)(WT + (size_t)row * ld_dst + col_off + k0 + 8 * c) = o; } }
    asm volatile("s_waitcnt lgkmcnt(0)" ::: "memory");
}

template <bool OUT_F32> DI void rmsnorm_row(const float* __restrict__ xrow, const float* __restrict__ g, void* orow, int lane) {
    const f32x4* xr = (const f32x4*)xrow + lane; const f32x4* gr = (const f32x4*)g + lane;
    f32x4 v[16]; float s = 0.f;
#pragma unroll
    for (int j = 0; j < 16; ++j) { v[j] = xr[64 * j]; s += (v[j].x * v[j].x + v[j].y * v[j].y) + (v[j].z * v[j].z + v[j].w * v[j].w); }
    const float rstd = 1.0f / sqrtf(wave_sum(s, lane) * (1.0f / DM) + EPS);
#pragma unroll
    for (int j = 0; j < 16; ++j) { const f32x4 gg = gr[64 * j]; const f32x4 o = v[j] * rstd * gg;
        if (OUT_F32) ((f32x4*)orow)[lane + 64 * j] = o;
        else { u32x2 w; w.x = pk2(o.x, o.y); w.y = pk2(o.z, o.w); ((u32x2*)orow)[lane + 64 * j] = w; } }
}

DI void row_bf16_ss(const float* __restrict__ xrow, bf16_t* orow, unsigned long long* ss, int lane) {
    const f32x4* xr = (const f32x4*)xrow + lane; float s = 0.f;
#pragma unroll
    for (int j = 0; j < 16; ++j) { const f32x4 v = xr[64 * j]; s += (v.x * v.x + v.y * v.y) + (v.z * v.z + v.w * v.w);
        u32x2 w; w.x = pk2(v.x, v.y); w.y = pk2(v.z, v.w); ((u32x2*)orow)[lane + 64 * j] = w; }
    s = wave_sum(s, lane);
    if (lane == 0) *ss = (unsigned long long)(s * 16777216.0f);
}
DI void row_scale_f32(const float* __restrict__ xrow, const float* __restrict__ g, float ssv, float* orow, int lane) {
    const f32x4* xr = (const f32x4*)xrow + lane; const f32x4* gr = (const f32x4*)g + lane;
    const float rstd = 1.0f / sqrtf(ssv * (1.0f / DM) + EPS);
#pragma unroll
    for (int j = 0; j < 16; ++j) ((f32x4*)orow)[lane + 64 * j] = xr[64 * j] * rstd * gr[64 * j];
}

DI void fill_vT(const bf16_t* __restrict__ Zv, int n, int tg, int lane, LAS unsigned char* VT) {
#pragma unroll
    for (int i = 0; i < 2; ++i) { const int cp = lane + 64 * i; unsigned w[8];
#pragma unroll
        for (int j = 0; j < 8; ++j) w[j] = *(const unsigned*)(Zv + (size_t)(n * CH + 8 * tg + j) * ZW + 2 * cp);
        u32x4 lo, hi;
        lo.x = (w[0] & 0xffffu) | (w[1] << 16); lo.y = (w[2] & 0xffffu) | (w[3] << 16); lo.z = (w[4] & 0xffffu) | (w[5] << 16); lo.w = (w[6] & 0xffffu) | (w[7] << 16);
        hi.x = (w[0] >> 16) | (w[1] & 0xffff0000u); hi.y = (w[2] >> 16) | (w[3] & 0xffff0000u); hi.z = (w[4] >> 16) | (w[5] & 0xffff0000u); hi.w = (w[6] >> 16) | (w[7] & 0xffff0000u);
        *(LAS u32x4*)(VT + (2 * cp) * ROW72 + tg * 16) = lo; *(LAS u32x4*)(VT + (2 * cp + 1) * ROW72 + tg * 16) = hi; }
}
DI void state_mfma(const LAS unsigned char* VT, const LAS unsigned char* KT, bf16_t* __restrict__ OUT, int w, int lane) {
    const int fr = lane & 15, fq = lane >> 4;
    f32x4 acc[2][8];
#pragma unroll
    for (int mi = 0; mi < 2; ++mi)
#pragma unroll
        for (int ni = 0; ni < 8; ++ni) acc[mi][ni] = (f32x4){0.f, 0.f, 0.f, 0.f};
#pragma unroll
    for (int ks = 0; ks < 2; ++ks) {
        bf16x8 a[2];
#pragma unroll
        for (int mi = 0; mi < 2; ++mi) a[mi] = *(const LAS bf16x8*)(VT + (32 * w + 16 * mi + fr) * ROW72 + (32 * ks + 8 * fq) * 2);
#pragma unroll
        for (int ni = 0; ni < 8; ++ni) { const bf16x8 b = *(const LAS bf16x8*)(KT + (16 * ni + fr) * ROW72 + (32 * ks + 8 * fq) * 2);
#pragma unroll
            for (int mi = 0; mi < 2; ++mi) acc[mi][ni] = mfma16(b, a[mi], acc[mi][ni]); }
    }
#pragma unroll
    for (int mi = 0; mi < 2; ++mi)
#pragma unroll
        for (int ni = 0; ni < 8; ++ni) *(u32x2*)(OUT + (size_t)(32 * w + 16 * mi + fr) * 128 + 16 * ni + 4 * fq) = (u32x2){pk2(acc[mi][ni][0], acc[mi][ni][1]), pk2(acc[mi][ni][2], acc[mi][ni][3])};
}
DI void copy_256x128(const bf16_t* __restrict__ src, int gp, LAS unsigned char* dst, int tid) {
#pragma unroll
    for (int i = 0; i < 8; ++i) { const int id = tid + 512 * i, row = id >> 4, cc = id & 15;
        *(LAS u32x4*)(dst + row * ROW136 + cc * 16) = *(const u32x4*)(src + (size_t)row * gp + cc * 8); }
}

DI void ld_v(const bf16_t* __restrict__ Zv, int n, int tg, int lane, unsigned (&w)[2][8]) {
#pragma unroll
    for (int i = 0; i < 2; ++i)
#pragma unroll
        for (int j = 0; j < 8; ++j) w[i][j] = *(const unsigned*)(Zv + (size_t)(n * CH + 8 * tg + j) * ZW + 2 * (lane + 64 * i));
}
DI void st_vT(const unsigned (&w)[2][8], int tg, int lane, LAS unsigned char* VT) {
#pragma unroll
    for (int i = 0; i < 2; ++i) { const int cp = lane + 64 * i; u32x4 lo, hi;
        lo.x = (w[i][0] & 0xffffu) | (w[i][1] << 16); lo.y = (w[i][2] & 0xffffu) | (w[i][3] << 16); lo.z = (w[i][4] & 0xffffu) | (w[i][5] << 16); lo.w = (w[i][6] & 0xffffu) | (w[i][7] << 16);
        hi.x = (w[i][0] >> 16) | (w[i][1] & 0xffff0000u); hi.y = (w[i][2] >> 16) | (w[i][3] & 0xffff0000u); hi.z = (w[i][4] >> 16) | (w[i][5] & 0xffff0000u); hi.w = (w[i][6] >> 16) | (w[i][7] & 0xffff0000u);
        *(LAS u32x4*)(VT + (2 * cp) * ROW72 + tg * 16) = lo; *(LAS u32x4*)(VT + (2 * cp + 1) * ROW72 + tg * 16) = hi; }
}
DI void ld_256x128(const bf16_t* __restrict__ src, int gp, int tid, u32x4 (&r)[8]) {
#pragma unroll
    for (int i = 0; i < 8; ++i) { const int id = tid + 512 * i, row = id >> 4, cc = id & 15; r[i] = *(const u32x4*)(src + (size_t)row * gp + cc * 8); }
}
DI void st_256x128(const u32x4 (&r)[8], LAS unsigned char* dst, int tid) {
#pragma unroll
    for (int i = 0; i < 8; ++i) { const int id = tid + 512 * i, row = id >> 4, cc = id & 15; *(LAS u32x4*)(dst + row * ROW136 + cc * 16) = r[i]; }
}
DI void conv_ld(const bf16_t* __restrict__ Zc, int tok0, unsigned (&x)[11]) {
#pragma unroll
    for (int i = 0; i < 11; ++i) { const int tok = tok0 - 3 + i; x[i] = 0u; if (tok >= 0) x[i] = *(const unsigned*)(Zc + (size_t)tok * ZW); }
}
DI void conv_apply(const unsigned (&x)[11], const float* __restrict__ cw, const float* __restrict__ cb, float (&o0)[8], float (&o1)[8]) {
    f32x2 wj[4];
#pragma unroll
    for (int j = 0; j < 4; ++j) wj[j] = *(const f32x2*)(cw + j * 1024);
    const f32x2 bias = *(const f32x2*)cb;
#pragma unroll
    for (int j = 0; j < 8; ++j) { float y0 = bias.x, y1 = bias.y;
#pragma unroll
        for (int jj = 0; jj < 4; ++jj) { y0 += wj[jj].x * bflo(x[j + jj]); y1 += wj[jj].y * bfhi(x[j + jj]); }
        o0[j] = silu_f(y0); o1[j] = silu_f(y1); }
}
DI void gla_b(const bf16_t* __restrict__ Z, const float* __restrict__ wa, const float* __restrict__ ba, int h, int n, int tg, int c2, LAS float* TOT, float (&b)[8][2], float (&blast)[2]) {
    const int col = h * 128 + 2 * c2;
    float w0[16], w1[16];
#pragma unroll
    for (int r = 0; r < 16; ++r) { const f32x2 w = *(const f32x2*)(wa + r * 512 + col); w0[r] = w.x; w1[r] = w.y; }
    const f32x2 bb = *(const f32x2*)(ba + col);
    float c0 = 0.f, c1 = 0.f;
#pragma unroll
    for (int j = 0; j < 8; ++j) {
        const bf16_t* gp = Z + (size_t)(n * CH + 8 * tg + j) * ZW + ZC_GA;
        const u32x4 g0 = *(const u32x4*)gp, g1 = *(const u32x4*)(gp + 8);
        const float gv[16] = {bflo(g0.x), bfhi(g0.x), bflo(g0.y), bfhi(g0.y), bflo(g0.z), bfhi(g0.z), bflo(g0.w), bfhi(g0.w),
                              bflo(g1.x), bfhi(g1.x), bflo(g1.y), bfhi(g1.y), bflo(g1.z), bfhi(g1.z), bflo(g1.w), bfhi(g1.w)};
        float p0 = bb.x, p1 = bb.y;
#pragma unroll
        for (int r = 0; r < 16; ++r) { p0 += gv[r] * w0[r]; p1 += gv[r] * w1[r]; }
        c0 += log_sigmoid_f(p0) * (1.0f / 16.0f); c1 += log_sigmoid_f(p1) * (1.0f / 16.0f);
        b[j][0] = c0; b[j][1] = c1;
    }
    *(LAS f32x2*)(TOT + tg * 128 + 2 * c2) = (f32x2){c0, c1};
    __syncthreads();
    float pre0 = 0.f, pre1 = 0.f, t0 = 0.f, t1 = 0.f;
#pragma unroll
    for (int g = 0; g < 8; ++g) { const f32x2 t = *(const LAS f32x2*)(TOT + g * 128 + 2 * c2); if (g < tg) { pre0 += t.x; pre1 += t.y; } t0 += t.x; t1 += t.y; }
#pragma unroll
    for (int j = 0; j < 8; ++j) { b[j][0] += pre0; b[j][1] += pre1; }
    blast[0] = t0; blast[1] = t1;
}
DI void conv_silu8(const bf16_t* __restrict__ Zc, const float* __restrict__ cw, const float* __restrict__ cb, int tok0, float (&o0)[8], float (&o1)[8]) {
    float x0[11], x1[11];
#pragma unroll
    for (int i = 0; i < 11; ++i) { const int tok = tok0 - 3 + i; unsigned w = 0u; if (tok >= 0) w = *(const unsigned*)(Zc + (size_t)tok * ZW); x0[i] = bflo(w); x1[i] = bfhi(w); }
    f32x2 wj[4];
#pragma unroll
    for (int j = 0; j < 4; ++j) wj[j] = *(const f32x2*)(cw + j * 1024);
    const f32x2 bias = *(const f32x2*)cb;
#pragma unroll
    for (int j = 0; j < 8; ++j) { float y0 = bias.x, y1 = bias.y;
#pragma unroll
        for (int jj = 0; jj < 4; ++jj) { y0 += wj[jj].x * x0[j + jj]; y1 += wj[jj].y * x1[j + jj]; }
        o0[j] = silu_f(y0); o1[j] = silu_f(y1); }
}
DI void score_mfma(const LAS unsigned char* QL, const LAS unsigned char* KL, int w, int lane, f32x4 (&sacc)[2]) {
    const int fr = lane & 15, fq = lane >> 4, mi = w >> 1, ni0 = 2 * (w & 1);
    sacc[0] = (f32x4){0.f, 0.f, 0.f, 0.f}; sacc[1] = sacc[0];
#pragma unroll
    for (int ks = 0; ks < 4; ++ks) { const bf16x8 a = *(const LAS bf16x8*)(QL + (16 * mi + fr) * ROW136 + (32 * ks + 8 * fq) * 2);
#pragma unroll
        for (int jn = 0; jn < 2; ++jn) { const bf16x8 b = *(const LAS bf16x8*)(KL + (16 * (ni0 + jn) + fr) * ROW136 + (32 * ks + 8 * fq) * 2); sacc[jn] = mfma16(b, a, sacc[jn]); } }
}

struct MixCtx {
    const bf16_t* Z; bf16_t* OB;
    const float *wa, *ba, *gla_norm, *conv_w, *conv_b, *b_i, *b_f, *ml_norm;
    float *DECAY, *DN, *NP, *GG, *FL, *MP, *BG; bf16_t *DS, *DC, *SP, *CP;
    const bf16_t *KM, *VMT;
};

DI void gla_A_unit(const MixCtx& C, LAS unsigned char* lds, int h, int n, int tid) {
    const int lane = tid & 63, tg = __builtin_amdgcn_readfirstlane(tid >> 6), c2 = lane;
    LAS float* TOT = (LAS float*)(lds + L_MISC);
    LAS unsigned char* KT = lds + L_ST; LAS unsigned char* VT = lds + L_VT;
    unsigned kw[8], vw[2][8];
#pragma unroll
    for (int j = 0; j < 8; ++j) kw[j] = *(const unsigned*)(C.Z + (size_t)(n * CH + 8 * tg + j) * ZW + ZC_GK + h * 128 + 2 * c2);
    ld_v(C.Z + ZC_GV + h * 256, n, tg, lane, vw);
    float b[8][2], blast[2];
    gla_b(C.Z, C.wa, C.ba, h, n, tg, c2, TOT, b, blast);
    float k0[8], k1[8];
#pragma unroll
    for (int j = 0; j < 8; ++j) { k0[j] = bflo(kw[j]) * __expf(blast[0] - b[j][0]); k1[j] = bfhi(kw[j]) * __expf(blast[1] - b[j][1]);
        *(f32x2*)(C.BG + ((size_t)(h * NCH + n) * CH + 8 * tg + j) * 128 + 2 * c2) = (f32x2){b[j][0], b[j][1]}; }
    u32x4 lo, hi;
    lo.x = pk2(k0[0], k0[1]); lo.y = pk2(k0[2], k0[3]); lo.z = pk2(k0[4], k0[5]); lo.w = pk2(k0[6], k0[7]);
    hi.x = pk2(k1[0], k1[1]); hi.y = pk2(k1[2], k1[3]); hi.z = pk2(k1[4], k1[5]); hi.w = pk2(k1[6], k1[7]);
    *(LAS u32x4*)(KT + (2 * c2) * ROW72 + tg * 16) = lo; *(LAS u32x4*)(KT + (2 * c2 + 1) * ROW72 + tg * 16) = hi;
    if (tg == 0) *(f32x2*)(C.DECAY + (size_t)(h * NCH + n) * 128 + 2 * c2) = (f32x2){__expf(blast[0]), __expf(blast[1])};
    st_vT(vw, tg, lane, VT);
    __syncthreads();
    state_mfma(VT, KT, C.DS + (size_t)(h * NCH + n) * 32768, tg, lane);
    __syncthreads();
}

DI void gla_B_unit(const MixCtx& C, LAS unsigned char* lds, int h, int n, int tid) {
    const int lane = tid & 63, w = __builtin_amdgcn_readfirstlane(tid >> 6), tg = w, c2 = lane, fr = lane & 15, fq = lane >> 4;
    LAS float* RS = (LAS float*)(lds + L_MISC + 4096);
    LAS unsigned char* ST = lds + L_ST; LAS unsigned char* VT = lds + L_VT; LAS unsigned char* QL = lds + L_Q; LAS unsigned char* KL = lds + L_K;
    const int wr = w >> 1, wc = w & 1, t = 16 * wr + fr;
    const size_t tok = (size_t)(n * CH + t);
    u32x4 st[8]; f32x2 bq[8]; unsigned wq[8], wk[8], vw[2][8]; u32x2 gg[8]; f32x4 gn[8];
    ld_256x128(C.SP + (size_t)(h * NCH + n) * 32768, 128, tid, st);
#pragma unroll
    for (int j = 0; j < 8; ++j) { const size_t zr = (size_t)(n * CH + 8 * tg + j) * ZW;
        bq[j] = *(const f32x2*)(C.BG + ((size_t)(h * NCH + n) * CH + 8 * tg + j) * 128 + 2 * c2);
        wq[j] = *(const unsigned*)(C.Z + zr + ZC_GQ + h * 128 + 2 * c2); wk[j] = *(const unsigned*)(C.Z + zr + ZC_GK + h * 128 + 2 * c2); }
    ld_v(C.Z + ZC_GV + h * 256, n, tg, lane, vw);
#pragma unroll
    for (int ni = 0; ni < 8; ++ni) { const int dv = 128 * wc + 16 * ni + 4 * fq; gg[ni] = *(const u32x2*)(C.Z + tok * ZW + ZC_GG + h * 256 + dv); gn[ni] = *(const f32x4*)(C.gla_norm + h * 256 + dv); }
    const float qs = 0.08838834764831845f;
#pragma unroll
    for (int j = 0; j < 8; ++j) { const float e0 = __expf(bq[j].x), e1 = __expf(bq[j].y);
        *(LAS unsigned*)(QL + (8 * tg + j) * ROW136 + 4 * c2) = pk2(bflo(wq[j]) * qs * e0, bfhi(wq[j]) * qs * e1);
        *(LAS unsigned*)(KL + (8 * tg + j) * ROW136 + 4 * c2) = pk2(bflo(wk[j]) * __builtin_amdgcn_rcpf(e0), bfhi(wk[j]) * __builtin_amdgcn_rcpf(e1)); }
    st_vT(vw, tg, lane, VT);
    st_256x128(st, ST, tid);
    __syncthreads();
    f32x4 sacc[2];
    score_mfma(QL, KL, w, lane, sacc);
    __syncthreads();
    { const int mi = w >> 1, ni0 = 2 * (w & 1), t2 = 16 * mi + fr;
#pragma unroll
      for (int jn = 0; jn < 2; ++jn) { const int s0 = 16 * (ni0 + jn) + 4 * fq; f32x4 v = sacc[jn];
#pragma unroll
          for (int r = 0; r < 4; ++r) if (s0 + r > t2) v[r] = 0.f;
          *(LAS u32x2*)(KL + t2 * ROW72 + s0 * 2) = (u32x2){pk2(v[0], v[1]), pk2(v[2], v[3])}; } }
    __syncthreads();
    f32x4 o[8];
#pragma unroll
    for (int ni = 0; ni < 8; ++ni) o[ni] = (f32x4){0.f, 0.f, 0.f, 0.f};
#pragma unroll
    for (int ks = 0; ks < 2; ++ks) { const bf16x8 a = *(const LAS bf16x8*)(KL + t * ROW72 + (32 * ks + 8 * fq) * 2);
#pragma unroll
        for (int ni = 0; ni < 8; ++ni) { const bf16x8 bb = *(const LAS bf16x8*)(VT + (128 * wc + 16 * ni + fr) * ROW72 + (32 * ks + 8 * fq) * 2); o[ni] = mfma16(bb, a, o[ni]); } }
#pragma unroll
    for (int ks = 0; ks < 4; ++ks) { const bf16x8 a = *(const LAS bf16x8*)(QL + t * ROW136 + (32 * ks + 8 * fq) * 2);
#pragma unroll
        for (int ni = 0; ni < 8; ++ni) { const bf16x8 bb = *(const LAS bf16x8*)(ST + (128 * wc + 16 * ni + fr) * ROW136 + (32 * ks + 8 * fq) * 2); o[ni] = mfma16(bb, a, o[ni]); } }
    float ss = 0.f;
#pragma unroll
    for (int ni = 0; ni < 8; ++ni) ss += (o[ni][0] * o[ni][0] + o[ni][1] * o[ni][1]) + (o[ni][2] * o[ni][2] + o[ni][3] * o[ni][3]);
    ss += shx(ss, 16, lane); ss += shx(ss, 32, lane);
    if (fq == 0) RS[wc * 64 + t] = ss;
    __syncthreads();
    const float rstd = 1.0f / sqrtf((RS[t] + RS[64 + t]) * (1.0f / 256.0f) + EPS);
#pragma unroll
    for (int ni = 0; ni < 8; ++ni) { const int dv = 128 * wc + 16 * ni + 4 * fq;
        const f32x4 v = o[ni] * rstd * gn[ni];
        *(u32x2*)(C.OB + tok * OBW + OB_O + h * 256 + dv) = (u32x2){pk2(v[0] * silu_f(bflo(gg[ni].x)), v[1] * silu_f(bfhi(gg[ni].x))), pk2(v[2] * silu_f(bflo(gg[ni].y)), v[3] * silu_f(bfhi(gg[ni].y)))}; }
    __syncthreads();
}

DI void ml_A_unit(const MixCtx& C, LAS unsigned char* lds, int h, int n, int tid) {
    const int lane = tid & 63, tg = __builtin_amdgcn_readfirstlane(tid >> 6), c2 = lane;
    LAS float* PART = (LAS float*)(lds + L_MISC);
    LAS unsigned char* KT = lds + L_ST; LAS unsigned char* VT = lds + L_VT;
    const size_t ztok = (size_t)(n * CH + lane) * ZW;
    const float li = bf2f(C.Z[ztok + ZC_MI + h]) + C.b_i[h];
    const float lf = log_sigmoid_f(bf2f(C.Z[ztok + ZC_MF + h]) + C.b_f[h]);
    const float F = wave_scan_sum(lf, lane);
    const float Flast = shi(F, 63);
    const float Gv = Flast - F + li;
    const float g = wave_max(Gv, lane);
    const float wG = __expf(Gv - g);
    float k0[8], k1[8];
    conv_silu8(C.Z + ZC_MQK + 512 + h * 128 + 2 * c2, C.conv_w + 512 + h * 128 + 2 * c2, C.conv_b + 512 + h * 128 + 2 * c2, n * CH + 8 * tg, k0, k1);
    const float ks = 0.08838834764831845f;
    float p0 = 0.f, p1 = 0.f;
#pragma unroll
    for (int j = 0; j < 8; ++j) { const float wj = shi(wG, 8 * tg + j) * ks; k0[j] *= wj; k1[j] *= wj; p0 += k0[j]; p1 += k1[j]; }
    u32x4 lo, hi;
    lo.x = pk2(k0[0], k0[1]); lo.y = pk2(k0[2], k0[3]); lo.z = pk2(k0[4], k0[5]); lo.w = pk2(k0[6], k0[7]);
    hi.x = pk2(k1[0], k1[1]); hi.y = pk2(k1[2], k1[3]); hi.z = pk2(k1[4], k1[5]); hi.w = pk2(k1[6], k1[7]);
    *(LAS u32x4*)(KT + (2 * c2) * ROW72 + tg * 16) = lo; *(LAS u32x4*)(KT + (2 * c2 + 1) * ROW72 + tg * 16) = hi;
    *(LAS f32x2*)(PART + tg * 128 + 2 * c2) = (f32x2){p0, p1};
    fill_vT(C.Z + ZC_MV + h * 256, n, tg, lane, VT);
    if (tid == 0) { C.GG[h * NCH + n] = g; C.FL[h * NCH + n] = Flast; }
    __syncthreads();
    if (tid < 128) { float s = 0.f;
#pragma unroll
        for (int q = 0; q < 8; ++q) s += PART[q * 128 + tid];
        C.DN[(size_t)(h * NCH + n) * 128 + tid] = s; }
    state_mfma(VT, KT, C.DC + (size_t)(h * NCH + n) * 32768, tg, lane);
    __syncthreads();
}

DI void ml_B_unit(const MixCtx& C, LAS unsigned char* lds, int h, int n, int tid) {
    const int lane = tid & 63, w = __builtin_amdgcn_readfirstlane(tid >> 6), tg = w, c2 = lane, fr = lane & 15, fq = lane >> 4;
    LAS float* MF = (LAS float*)(lds + L_MISC); LAS float* MU = MF + 64; LAS float* MM = MF + 128; LAS float* MW = MF + 192;
    LAS float* DENP = MF + 256; LAS float* DQN = MF + 512; LAS float* NPV = MF + 576; LAS float* RS = (LAS float*)(lds + L_MISC + 4096);
    LAS unsigned char* CT = lds + L_ST; LAS unsigned char* VT = lds + L_VT; LAS unsigned char* QL = lds + L_Q; LAS unsigned char* KL = lds + L_K;
    copy_256x128(C.CP + (size_t)(h * NCH + n) * 32768, 128, CT, tid);
    if (w == 0) {
        const size_t ztok = (size_t)(n * CH + lane) * ZW;
        const float li = bf2f(C.Z[ztok + ZC_MI + h]) + C.b_i[h];
        const float lf = log_sigmoid_f(bf2f(C.Z[ztok + ZC_MF + h]) + C.b_f[h]);
        const float F = wave_scan_sum(lf, lane);
        const float u = li - F;
        const float pm = wave_scan_max(u, lane);
        const float mprev = C.MP[h * NCH + n];
        const float m = F + fmaxf(pm, mprev);
        MF[lane] = F; MU[lane] = u; MM[lane] = m; MW[lane] = __expf(F + mprev - m);
    }
    if (w == 1) { NPV[lane] = C.NP[(size_t)(h * NCH + n) * 128 + lane]; NPV[64 + lane] = C.NP[(size_t)(h * NCH + n) * 128 + 64 + lane]; }
    {
        float q0[8], q1[8], k0[8], k1[8];
        conv_silu8(C.Z + ZC_MQK + h * 128 + 2 * c2, C.conv_w + h * 128 + 2 * c2, C.conv_b + h * 128 + 2 * c2, n * CH + 8 * tg, q0, q1);
        conv_silu8(C.Z + ZC_MQK + 512 + h * 128 + 2 * c2, C.conv_w + 512 + h * 128 + 2 * c2, C.conv_b + 512 + h * 128 + 2 * c2, n * CH + 8 * tg, k0, k1);
        const float ks = 0.08838834764831845f;
#pragma unroll
        for (int j = 0; j < 8; ++j) { *(LAS unsigned*)(QL + (8 * tg + j) * ROW136 + 4 * c2) = pk2(q0[j], q1[j]); *(LAS unsigned*)(KL + (8 * tg + j) * ROW136 + 4 * c2) = pk2(k0[j] * ks, k1[j] * ks); }
    }
    fill_vT(C.Z + ZC_MV + h * 256, n, tg, lane, VT);
    __syncthreads();
    f32x4 sacc[2];
    score_mfma(QL, KL, w, lane, sacc);
    {
        const int t = tid >> 3, part = tid & 7; float s = 0.f;
#pragma unroll
        for (int e = 0; e < 8; ++e) { const unsigned qq = *(const LAS unsigned*)(QL + t * ROW136 + (16 * part + 2 * e) * 2); s += bflo(qq) * NPV[16 * part + 2 * e] + bfhi(qq) * NPV[16 * part + 2 * e + 1]; }
        s += shx(s, 1, lane); s += shx(s, 2, lane); s += shx(s, 4, lane);
        if (part == 0) DQN[t] = s;
    }
    __syncthreads();
    { const int mi = w >> 1, ni0 = 2 * (w & 1), t = 16 * mi + fr; const float ft = MF[t] - MM[t];
#pragma unroll
      for (int jn = 0; jn < 2; ++jn) { const int s0 = 16 * (ni0 + jn) + 4 * fq; f32x4 v = sacc[jn]; const f32x4 us = *(const LAS f32x4*)(MU + s0);
          float ps = 0.f;
#pragma unroll
          for (int r = 0; r < 4; ++r) { v[r] = (s0 + r > t) ? 0.f : v[r] * __expf(ft + us[r]); ps += v[r]; }
          ps += shx(ps, 16, lane); ps += shx(ps, 32, lane);
          if (fq == 0) DENP[t * 4 + ni0 + jn] = ps;
          *(LAS u32x2*)(KL + t * ROW72 + s0 * 2) = (u32x2){pk2(v[0], v[1]), pk2(v[2], v[3])}; } }
    __syncthreads();
    const int wr = w >> 1, wc = w & 1, t = 16 * wr + fr;
    f32x4 o1[8], o2[8];
#pragma unroll
    for (int ni = 0; ni < 8; ++ni) { o1[ni] = (f32x4){0.f, 0.f, 0.f, 0.f}; o2[ni] = o1[ni]; }
#pragma unroll
    for (int ks = 0; ks < 2; ++ks) { const bf16x8 a = *(const LAS bf16x8*)(KL + t * ROW72 + (32 * ks + 8 * fq) * 2);
#pragma unroll
        for (int ni = 0; ni < 8; ++ni) { const bf16x8 bb = *(const LAS bf16x8*)(VT + (128 * wc + 16 * ni + fr) * ROW72 + (32 * ks + 8 * fq) * 2); o1[ni] = mfma16(bb, a, o1[ni]); } }
#pragma unroll
    for (int ks = 0; ks < 4; ++ks) { const bf16x8 a = *(const LAS bf16x8*)(QL + t * ROW136 + (32 * ks + 8 * fq) * 2);
#pragma unroll
        for (int ni = 0; ni < 8; ++ni) { const bf16x8 bb = *(const LAS bf16x8*)(CT + (128 * wc + 16 * ni + fr) * ROW136 + (32 * ks + 8 * fq) * 2); o2[ni] = mfma16(bb, a, o2[ni]); } }
    const float wi = MW[t];
    const f32x4 dp = *(const LAS f32x4*)(DENP + t * 4);
    const float den = ((dp[0] + dp[1]) + (dp[2] + dp[3])) + wi * DQN[t];
    const float inv = 1.0f / fmaxf(fabsf(den), __expf(-MM[t]));
    const size_t tok = (size_t)(n * CH + t);
    float ss = 0.f;
#pragma unroll
    for (int ni = 0; ni < 8; ++ni) { const int dv = 128 * wc + 16 * ni + 4 * fq;
        const u32x2 mo = *(const u32x2*)(C.Z + tok * ZW + ZC_MO + h * 256 + dv);
        f32x4 v = (o1[ni] + o2[ni] * wi) * inv;
        v[0] *= sigmoid_f(bflo(mo.x)); v[1] *= sigmoid_f(bfhi(mo.x)); v[2] *= sigmoid_f(bflo(mo.y)); v[3] *= sigmoid_f(bfhi(mo.y));
        o1[ni] = v; ss += (v[0] * v[0] + v[1] * v[1]) + (v[2] * v[2] + v[3] * v[3]); }
    ss += shx(ss, 16, lane); ss += shx(ss, 32, lane);
    if (fq == 0) RS[wc * 64 + t] = ss;
    __syncthreads();
    const float rstd = 1.0f / sqrtf((RS[t] + RS[64 + t]) * (1.0f / 256.0f) + EPS);
#pragma unroll
    for (int ni = 0; ni < 8; ++ni) { const int dv = 128 * wc + 16 * ni + 4 * fq; const f32x4 gn = *(const f32x4*)(C.ml_norm + h * 256 + dv);
        const f32x4 v = o1[ni] * rstd * gn;
        *(u32x2*)(C.OB + tok * OBW + OB_O + 1024 + h * 256 + dv) = (u32x2){pk2(v[0], v[1]), pk2(v[2], v[3])}; }
    __syncthreads();
}

#ifndef SCAN_U
#define SCAN_U 8
#endif
DI void scan_phase(const MixCtx& C, int tid) {
    const int NS = 2 * 65536;
    for (int slot = opaque_bx() * 512 + tid; slot < NS; slot += opaque_g() * 512) {
        const int br = slot >> 16, s = slot & 65535, h = s >> 14, dv = (s >> 6) & 255, dkp = s & 63;
        const size_t e0 = (size_t)h * NCH * 32768 + (size_t)dv * 128 + 2 * dkp;
        if (br == 0) {
            float s0 = 0.f, s1 = 0.f;
            for (int n0 = 0; n0 < NCH; n0 += SCAN_U) {
                f32x2 d[SCAN_U], dec[SCAN_U];
#pragma unroll
                for (int u = 0; u < SCAN_U; ++u) { const unsigned dw = *(const unsigned*)(C.DS + e0 + (size_t)(n0 + u) * 32768); d[u] = (f32x2){bflo(dw), bfhi(dw)}; dec[u] = *(const f32x2*)(C.DECAY + (size_t)(h * NCH + n0 + u) * 128 + 2 * dkp); }
#pragma unroll
                for (int u = 0; u < SCAN_U; ++u) { *(unsigned*)(C.SP + e0 + (size_t)(n0 + u) * 32768) = pk2(s0, s1); s0 = dec[u].x * s0 + d[u].x; s1 = dec[u].y * s1 + d[u].y; }
            }
        } else {
            float c0 = 0.f, c1 = 0.f, nn0 = 0.f, nn1 = 0.f, m = -1e30f;
            for (int n0 = 0; n0 < NCH; n0 += SCAN_U) {
                f32x2 d[SCAN_U], dn[SCAN_U]; float fl[SCAN_U], gl[SCAN_U];
#pragma unroll
                for (int u = 0; u < SCAN_U; ++u) { const unsigned dw = *(const unsigned*)(C.DC + e0 + (size_t)(n0 + u) * 32768); d[u] = (f32x2){bflo(dw), bfhi(dw)}; fl[u] = C.FL[h * NCH + n0 + u]; gl[u] = C.GG[h * NCH + n0 + u];
                    dn[u] = (dv == 0) ? *(const f32x2*)(C.DN + (size_t)(h * NCH + n0 + u) * 128 + 2 * dkp) : (f32x2){0.f, 0.f}; }
#pragma unroll
                for (int u = 0; u < SCAN_U; ++u) { *(unsigned*)(C.CP + e0 + (size_t)(n0 + u) * 32768) = pk2(c0, c1);
                    if (dv == 0) { *(f32x2*)(C.NP + (size_t)(h * NCH + n0 + u) * 128 + 2 * dkp) = (f32x2){nn0, nn1}; if (dkp == 0) C.MP[h * NCH + n0 + u] = m; }
                    const float mn = fmaxf(fl[u] + m, gl[u]); const float a = __expf(fl[u] + m - mn), bb = __expf(gl[u] - mn);
                    c0 = a * c0 + bb * d[u].x; c1 = a * c1 + bb * d[u].y; nn0 = a * nn0 + bb * dn[u].x; nn1 = a * nn1 + bb * dn[u].y; m = mn; }
            }
        }
    }
}

DI void mem_unit(const MixCtx& C, LAS unsigned char* lds, int h, int rb, int tid) {
    const int lane = tid & 63, w = __builtin_amdgcn_readfirstlane(tid >> 6), fr = lane & 15, fq = lane >> 4, wr = w >> 1, wc = w & 1, t = 16 * wr + fr;
    LAS unsigned char* QL = lds; LAS unsigned char* PL = lds + 33792; LAS unsigned char* KV = lds + 67584;
    LAS float* RMX = (LAS float*)(lds + L_MISC); LAS float* RSM = RMX + 128;
#pragma unroll
    for (int i = 0; i < 4; ++i) { const int id = tid + 512 * i, row = id >> 5, cc = id & 31;
        *(LAS u32x4*)(QL + row * ROW264 + cc * 16) = *(const u32x4*)(C.Z + (size_t)(rb * 64 + row) * ZW + ZC_XQ + h * 256 + cc * 8); }
    f32x4 s[8];
#pragma unroll
    for (int ni = 0; ni < 8; ++ni) s[ni] = (f32x4){0.f, 0.f, 0.f, 0.f};
#pragma unroll
    for (int half = 0; half < 2; ++half) {
        copy_256x128(C.KM + h * 256 + half * 128, 4096, KV, tid);
        __syncthreads();
#pragma unroll
        for (int ks = 0; ks < 4; ++ks) { const bf16x8 a = *(const LAS bf16x8*)(QL + t * ROW264 + (128 * half + 32 * ks + 8 * fq) * 2);
#pragma unroll
            for (int ni = 0; ni < 8; ++ni) { const bf16x8 bb = *(const LAS bf16x8*)(KV + (128 * wc + 16 * ni + fr) * ROW136 + (32 * ks + 8 * fq) * 2); s[ni] = mfma16(bb, a, s[ni]); } }
        __syncthreads();
    }
    float mx = -3.0e38f;
#pragma unroll
    for (int ni = 0; ni < 8; ++ni) { s[ni] = s[ni] * 0.0625f; mx = fmaxf(mx, fmaxf(fmaxf(s[ni][0], s[ni][1]), fmaxf(s[ni][2], s[ni][3]))); }
    mx = fmaxf(mx, shx(mx, 16, lane)); mx = fmaxf(mx, shx(mx, 32, lane));
    if (fq == 0) RMX[wc * 64 + t] = mx;
    copy_256x128(C.VMT + (size_t)(h * 256) * 256, 256, KV, tid);
    __syncthreads();
    mx = fmaxf(RMX[t], RMX[64 + t]);
    float sm = 0.f;
#pragma unroll
    for (int ni = 0; ni < 8; ++ni) {
#pragma unroll
        for (int r = 0; r < 4; ++r) { s[ni][r] = __expf(s[ni][r] - mx); sm += s[ni][r]; } }
    sm += shx(sm, 16, lane); sm += shx(sm, 32, lane);
    if (fq == 0) RSM[wc * 64 + t] = sm;
    __syncthreads();
    const float inv = 1.0f / (RSM[t] + RSM[64 + t]);
#pragma unroll
    for (int ni = 0; ni < 8; ++ni) { const f32x4 p = s[ni] * inv; *(LAS u32x2*)(PL + t * ROW264 + (128 * wc + 16 * ni + 4 * fq) * 2) = (u32x2){pk2(p[0], p[1]), pk2(p[2], p[3])}; }
    f32x4 o[8];
#pragma unroll
    for (int ni = 0; ni < 8; ++ni) o[ni] = (f32x4){0.f, 0.f, 0.f, 0.f};
#pragma unroll
    for (int half = 0; half < 2; ++half) {
        if (half == 1) copy_256x128(C.VMT + (size_t)(h * 256) * 256 + 128, 256, KV, tid);
        __syncthreads();
#pragma unroll
        for (int ks = 0; ks < 4; ++ks) { const bf16x8 a = *(const LAS bf16x8*)(PL + t * ROW264 + (128 * half + 32 * ks + 8 * fq) * 2);
#pragma unroll
            for (int ni = 0; ni < 8; ++ni) { const bf16x8 bb = *(const LAS bf16x8*)(KV + (128 * wc + 16 * ni + fr) * ROW136 + (32 * ks + 8 * fq) * 2); o[ni] = mfma16(bb, a, o[ni]); } }
        __syncthreads();
    }
    const size_t tok = (size_t)(rb * 64 + t);
#pragma unroll
    for (int ni = 0; ni < 8; ++ni) { const int d = 128 * wc + 16 * ni + 4 * fq; *(u32x2*)(C.OB + tok * OBW + OB_O + 2048 + h * 256 + d) = (u32x2){pk2(o[ni][0], o[ni][1]), pk2(o[ni][2], o[ni][3])}; }
}

#ifndef GEMM_ALIGN
#define GEMM_ALIGN true
#endif
#ifndef REP_PRO
#define REP_PRO 1
#endif
#ifndef REP_MIXA
#define REP_MIXA 1
#endif
#ifndef REP_SCAN
#define REP_SCAN 1
#endif
#ifndef REP_MIXB
#define REP_MIXB 1
#endif
#ifndef REP_FF1
#define REP_FF1 1
#endif
#ifndef REP_NORM
#define REP_NORM 1
#endif
#ifndef WGM_IN
#define WGM_IN PG8_WGM
#endif
#ifndef WGM_BR
#define WGM_BR PG8_WGM
#endif
#ifndef WGM_OUT
#define WGM_OUT PG8_WGM
#endif
#ifndef WGM_F1
#define WGM_F1 8
#endif
#ifndef WGM_F2
#define WGM_F2 PG8_WGM
#endif
#ifndef REP_GLAA
#define REP_GLAA 1
#endif
#ifndef REP_MEM
#define REP_MEM 1
#endif
#ifndef REP_GLAB
#define REP_GLAB 1
#endif
#ifndef REP_GATE
#define REP_GATE 1
#endif
#ifndef REP_BR
#define REP_BR 1
#endif
#ifndef GEMM_SP2
#define GEMM_SP2 true
#endif
constexpr int L_PTR = L_BARW + 256;
DI unsigned long long tab_ld(LAS unsigned char* lds, int k) {
    const unsigned long long v = *(volatile LAS unsigned long long*)(lds + L_PTR + 8 * k);
    const unsigned lo = __builtin_amdgcn_readfirstlane((unsigned)v), hi = __builtin_amdgcn_readfirstlane((unsigned)(v >> 32));
    return ((unsigned long long)hi << 32) | lo;
}
DI const float* tab_in(LAS unsigned char* lds, int k) { return (const float*)(const GAS float*)tab_ld(lds, k); }
DI unsigned char* tab_ws(LAS unsigned char* lds) { return (unsigned char*)(GAS unsigned char*)tab_ld(lds, 24); }
DI void grid_bar(LAS unsigned char* lds) {
    XcdBarrier b; b.bar = (unsigned*)(tab_ws(lds) + WS_CTL) + CW_BAR; b.x = xb_xcc_id(); b.st = (volatile LAS unsigned*)(lds + L_BARW);
    xcd_barrier(b);
}
DI void make_ctx(MixCtx& C, LAS unsigned char* lds, int l) {
    unsigned char* ws = tab_ws(lds);
    C.Z = (const bf16_t*)(ws + WS_Z); C.OB = (bf16_t*)(ws + WS_OB);
    C.wa = tab_in(lds, I_W_GLA_A) + (size_t)l * 16 * 512; C.ba = tab_in(lds, I_B_GLA_A) + l * 512; C.gla_norm = tab_in(lds, I_GLA_NORM) + l * 1024;
    C.conv_w = tab_in(lds, I_CONV_W) + (size_t)l * 4 * 1024; C.conv_b = tab_in(lds, I_CONV_B) + l * 1024; C.b_i = tab_in(lds, I_B_ML_I) + l * 4; C.b_f = tab_in(lds, I_B_ML_F) + l * 4; C.ml_norm = tab_in(lds, I_ML_NORM) + l * 1024;
    C.BG = (float*)(ws + WS_BG); C.DS = (bf16_t*)(ws + WS_DS); C.DC = (bf16_t*)(ws + WS_DC); C.SP = (bf16_t*)(ws + WS_SP); C.CP = (bf16_t*)(ws + WS_CP);
    C.DECAY = (float*)(ws + WS_SMALL + SM_DECAY); C.DN = (float*)(ws + WS_SMALL + SM_DN); C.NP = (float*)(ws + WS_SMALL + SM_NP);
    C.GG = (float*)(ws + WS_SMALL + SM_GG); C.FL = (float*)(ws + WS_SMALL + SM_FL); C.MP = (float*)(ws + WS_SMALL + SM_MP);
    C.KM = (const bf16_t*)(ws + WS_KM) + l * 1024; C.VMT = (const bf16_t*)(ws + WS_VMT) + (size_t)l * 1024 * 256;
}

__global__ void __launch_bounds__(512, 2) trunk_fwd(Params p) {
    extern __shared__ __attribute__((aligned(16))) unsigned char lds_raw[];
    LAS unsigned char* lds0 = (LAS unsigned char*)lds_raw;
    {
        LAS unsigned char* lds = lds0;
        const int tid0 = threadIdx.x;
        if (tid0 < 64) ((LAS unsigned*)(lds + L_BARW))[tid0] = 0u;
        if (tid0 < 23) *(LAS unsigned long long*)(lds + L_PTR + 8 * tid0) = (unsigned long long)p.in[tid0];
        if (tid0 == 23) *(LAS unsigned long long*)(lds + L_PTR + 8 * 23) = (unsigned long long)p.out;
        if (tid0 == 24) *(LAS unsigned long long*)(lds + L_PTR + 8 * 24) = (unsigned long long)p.ws;
        __syncthreads();
        (void)xcd_barrier_post((unsigned*)(p.ws + WS_CTL) + CW_BAR, (volatile LAS unsigned*)(lds + L_BARW));
    }
#define TID (opaque_tid())
#define LANE (opaque_tid() & 63)
#define WAVE (__builtin_amdgcn_readfirstlane(opaque_tid() >> 6))
#define GW (opaque_bx() * NWAVES + WAVE)
#define NGW (opaque_g() * NWAVES)

    for (int rep = 0; rep < REP_PRO; ++rep) {
        LAS unsigned char* lds = opaque_lds(lds0); unsigned char* ws = tab_ws(lds);
        bf16_t* WIN = (bf16_t*)(ws + WS_WIN);
        const int lane = LANE, wave = WAVE;
        LAS float* scr = (LAS float*)(lds + wave * 16640);
        constexpr int IT_IN = 64 * 117, IT_BR = 16 * 64, IT_G = 4 * 64, IT_OUT = 64 * 64, IT_F1 = 64 * 256, IT_F2 = 256 * 64, IT_MK = 64 * 16;
        constexpr int E_IN = 4 * IT_IN, E_BR = E_IN + 12 * IT_BR, E_G = E_BR + 12 * IT_G, E_OUT = E_G + 4 * IT_OUT, E_F1 = E_OUT + 4 * IT_F1, E_F2 = E_F1 + 4 * IT_F2, E_MK = E_F2 + 4 * IT_MK, E_MV = E_MK + 4 * IT_MK;
        for (int it = GW; it < E_MV; it += NGW) {
            if (it < E_IN) { const int l = it / IT_IN, r = it - l * IT_IN; transpose_item(tab_in(lds, I_W_IN) + (size_t)l * DM * IN_W, DM, IN_W, WIN + (size_t)l * ZW * PW, PW, 0, 0, true, scr, r, lane, tab_in(lds, I_NORM_MIX) + l * DM); }
            else if (it < E_BR) { const int q = it - E_IN, lj = q / IT_BR, r = q - lj * IT_BR, l = lj / 3, j = lj - 3 * l; transpose_item(tab_in(lds, I_W_BRANCH) + (size_t)lj * 1024 * DM, 1024, DM, (bf16_t*)(ws + WS_WBR) + (size_t)l * DM * OBW, OBW, OB_O + j * 1024, 0, false, scr, r, lane); }
            else if (it < E_G) { const int q = it - E_BR, lj = q / IT_G, r = q - lj * IT_G, l = lj / 3, j = lj - 3 * l; transpose_item(tab_in(lds, I_W_GATE) + (size_t)lj * 256 * DM, 256, DM, (bf16_t*)(ws + WS_WBR) + (size_t)l * DM * OBW, OBW, j * 256, 0, false, scr, r, lane); }
            else if (it < E_OUT) { const int q = it - E_G, l = q / IT_OUT, r = q - l * IT_OUT; transpose_item(tab_in(lds, I_W_OUT) + (size_t)l * DM * DM, DM, DM, (bf16_t*)(ws + WS_WOUT) + (size_t)l * DM * PW, PW, 0, 0, false, scr, r, lane); }
            else if (it < E_F1) { const int q = it - E_OUT, l = q / IT_F1, r = q - l * IT_F1; transpose_item(tab_in(lds, I_W_FF1) + (size_t)l * DM * DFF, DM, DFF, (bf16_t*)(ws + WS_W1) + (size_t)l * DFF * PW, PW, 0, 0, false, scr, r, lane, tab_in(lds, I_NORM_FFN) + l * DM); }
            else if (it < E_F2) { const int q = it - E_F1, l = q / IT_F2, r = q - l * IT_F2; transpose_item(tab_in(lds, I_W_FF2) + (size_t)l * DFF * DM, DFF, DM, (bf16_t*)(ws + WS_W2) + (size_t)l * DM * PU, PU, 0, 0, false, scr, r, lane); }
            else if (it < E_MK) { const int q = it - E_F2, l = q / IT_MK, r = q - l * IT_MK; transpose_item(tab_in(lds, I_W_MEM_K) + (size_t)l * DM * 1024, DM, 1024, (bf16_t*)(ws + WS_WMK), DM, 0, l * 1024, false, scr, r, lane); }
            else { const int q = it - E_MK, l = q / IT_MK, r = q - l * IT_MK; transpose_item(tab_in(lds, I_W_MEM_V) + (size_t)l * DM * 1024, DM, 1024, (bf16_t*)(ws + WS_WMV), DM, 0, l * 1024, false, scr, r, lane); }
        }
        constexpr int PADCH = (ZW - IN_W) * PW / 8;
        for (int i = opaque_bx() * 512 + TID; i < NL * PADCH; i += opaque_g() * 512) { const int l = i / PADCH, r = i - l * PADCH; *(u32x4*)(WIN + (size_t)l * ZW * PW + (size_t)IN_W * PW + (size_t)r * 8) = (u32x4){0u, 0u, 0u, 0u}; }
        for (int m = GW; m < SEQ; m += NGW) row_bf16_ss(tab_in(lds, I_X) + (size_t)m * DM, (bf16_t*)(ws + WS_H) + (size_t)m * PW, (u64_t*)(ws + WS_SS) + m, lane);
        for (int m = GW; m < MEML; m += NGW) rmsnorm_row<false>(tab_in(lds, I_MEM) + (size_t)m * DM, tab_in(lds, I_MEM_NORM), (bf16_t*)(ws + WS_MEMN) + (size_t)m * DM, lane);
    }
    grid_bar(opaque_lds(lds0));
    {
        LAS unsigned char* lds = opaque_lds(lds0); unsigned char* ws = tab_ws(lds);
        { pg8::Gemm g{(const bf16_t*)(ws + WS_MEMN), (const bf16_t*)(ws + WS_WMK), opq(MEML), opq(DM), opq(DM), opq(DM), opq(DM)}; pg8::StaticOrder S; S.init(opq(MEML), opq(DM), opaque_g(), opaque_bx()); pg8::EpiBf16<0> E{(bf16_t*)(ws + WS_KM), DM, nullptr, nullptr, nullptr, 0, -1};
          pg8::gemm_phase<pg8::EpiBf16<0>, pg8::StaticOrder, GEMM_ALIGN, GEMM_SP2>(lds, g, S, E); }
    }
    {
        LAS unsigned char* lds = opaque_lds(lds0); unsigned char* ws = tab_ws(lds);
        { pg8::Gemm g{(const bf16_t*)(ws + WS_WMV), (const bf16_t*)(ws + WS_MEMN), opq(DM), opq(MEML), opq(DM), opq(DM), opq(DM)}; pg8::StaticOrder S; S.init(opq(DM), opq(MEML), opaque_g(), (opaque_bx() + 16) % opaque_g()); pg8::EpiBf16<0> E{(bf16_t*)(ws + WS_VMT), MEML, nullptr, nullptr, nullptr, 0, -1};
          pg8::gemm_phase<pg8::EpiBf16<0>, pg8::StaticOrder, GEMM_ALIGN, GEMM_SP2>(lds, g, S, E); }
    }
    grid_bar(opaque_lds(lds0));

    for (int l = 0; l < NL; ++l) {
        {
            LAS unsigned char* lds = opaque_lds(lds0); unsigned char* ws = tab_ws(lds);
            pg8::Gemm g{(const bf16_t*)(ws + WS_H), (const bf16_t*)(ws + WS_WIN) + (size_t)l * ZW * PW, opq(SEQ), opq(ZW), opq(DM), opq(PW), opq(PW)}; pg8::StaticOrder S; S.init(opq(SEQ), opq(ZW), opaque_g(), opaque_bx(), opq(WGM_IN)); pg8::EpiBf16<0> E{(bf16_t*)(ws + WS_Z), ZW, nullptr, (const u64_t*)(ws + WS_SS) + (size_t)(2 * l) * SEQ, (bf16_t*)(ws + WS_OB), OBW, ZC_GATE / 256};
            pg8::gemm_phase<pg8::EpiBf16<0>, pg8::StaticOrder, GEMM_ALIGN, GEMM_SP2>(lds, g, S, E);
        }
        grid_bar(opaque_lds(lds0));
        {
            LAS unsigned char* lds = opaque_lds(lds0); MixCtx C; make_ctx(C, lds, l); const int tid = TID;
            for (int rep = 0; rep < REP_MIXA; ++rep) {
            for (int r2 = 0; r2 < REP_GLAA; ++r2) for (int i = opaque_bx(); i < 4 * NCH; i += opaque_g()) gla_A_unit(C, lds, i >> 8, i & 255, tid);
            for (int i = opaque_bx(); i < 4 * NCH; i += opaque_g()) ml_A_unit(C, lds, i >> 8, i & 255, tid);
            for (int r2 = 0; r2 < REP_MEM; ++r2) for (int i = opaque_bx(); i < 4 * NCH; i += opaque_g()) mem_unit(C, lds, i >> 8, i & 255, tid);
            }
        }
        grid_bar(opaque_lds(lds0));
        { LAS unsigned char* lds = opaque_lds(lds0); MixCtx C; make_ctx(C, lds, l); for (int rep = 0; rep < REP_SCAN; ++rep) scan_phase(C, TID); }
        grid_bar(opaque_lds(lds0));
        {
            LAS unsigned char* lds = opaque_lds(lds0); MixCtx C; make_ctx(C, lds, l); const int tid = TID;
            for (int rep = 0; rep < REP_MIXB; ++rep) {
            for (int r2 = 0; r2 < REP_GLAB; ++r2) for (int i = opaque_bx(); i < 4 * NCH; i += opaque_g()) gla_B_unit(C, lds, i >> 8, i & 255, tid);
            for (int i = opaque_bx(); i < 4 * NCH; i += opaque_g()) ml_B_unit(C, lds, i >> 8, i & 255, tid);
            }
        }
        grid_bar(opaque_lds(lds0));
        for (int rep = 0; rep < REP_BR; ++rep) {
            LAS unsigned char* lds = opaque_lds(lds0); unsigned char* ws = tab_ws(lds);
            pg8::Gemm g{(const bf16_t*)(ws + WS_OB), (const bf16_t*)(ws + WS_WBR) + (size_t)l * DM * OBW, opq(SEQ), opq(DM), opq(OBW), opq(OBW), opq(OBW)}; pg8::BranchOrder S; S.init(opq(SEQ), opq(DM), opaque_g(), opaque_bx(), opq(WGM_BR)); pg8::EpiBranch E{(bf16_t*)(ws + WS_Y), PW, (bf16_t*)(ws + WS_GT), tab_in(lds, I_B_GATE) + (size_t)l * GTW};
            pg8::gemm_phase<pg8::EpiBranch, pg8::BranchOrder, GEMM_ALIGN, GEMM_SP2>(lds, g, S, E);
        }
        grid_bar(opaque_lds(lds0));
        {
            LAS unsigned char* lds = opaque_lds(lds0); unsigned char* ws = tab_ws(lds);
            const float* Xin = (l == 0) ? tab_in(lds, I_X) : (const float*)(ws + WS_X);
            pg8::Gemm g{(const bf16_t*)(ws + WS_Y), (const bf16_t*)(ws + WS_WOUT) + (size_t)l * DM * PW, opq(SEQ), opq(DM), opq(DM), opq(PW), opq(PW)}; pg8::StaticOrder S; S.init(opq(SEQ), opq(DM), opaque_g(), opaque_bx(), opq(WGM_OUT)); pg8::EpiResid E{Xin, (float*)(ws + WS_X), DM, (bf16_t*)(ws + WS_H), (u64_t*)(ws + WS_SS) + (size_t)(2 * l + 1) * SEQ, PW};
            pg8::gemm_phase<pg8::EpiResid, pg8::StaticOrder, GEMM_ALIGN, GEMM_SP2>(lds, g, S, E);
        }
        grid_bar(opaque_lds(lds0));
        for (int rep = 0; rep < REP_FF1; ++rep) {
            LAS unsigned char* lds = opaque_lds(lds0); unsigned char* ws = tab_ws(lds);
            pg8::Gemm g{(const bf16_t*)(ws + WS_H), (const bf16_t*)(ws + WS_W1) + (size_t)l * DFF * PW, opq(SEQ), opq(DFF), opq(DM), opq(PW), opq(PW)}; pg8::StaticOrder S; S.init(opq(SEQ), opq(DFF), opaque_g(), opaque_bx(), opq(WGM_F1)); pg8::EpiBf16<1> E{(bf16_t*)(ws + WS_U), PU, nullptr, (const u64_t*)(ws + WS_SS) + (size_t)(2 * l + 1) * SEQ, nullptr, 0, -1};
            pg8::gemm_phase<pg8::EpiBf16<1>, pg8::StaticOrder, GEMM_ALIGN, GEMM_SP2>(lds, g, S, E);
        }
        grid_bar(opaque_lds(lds0));
        {
            LAS unsigned char* lds = opaque_lds(lds0); unsigned char* ws = tab_ws(lds);
            pg8::Gemm g{(const bf16_t*)(ws + WS_U), (const bf16_t*)(ws + WS_W2) + (size_t)l * DM * PU, opq(SEQ), opq(DM), opq(DFF), opq(PU), opq(PU)}; pg8::StaticOrder S; S.init(opq(SEQ), opq(DM), opaque_g(), opaque_bx(), opq(WGM_F2)); pg8::EpiResid E{(const float*)(ws + WS_X), (float*)(ws + WS_X), DM, (bf16_t*)(ws + WS_H), (u64_t*)(ws + WS_SS) + (size_t)(2 * l + 2) * SEQ, PW};
            pg8::gemm_phase<pg8::EpiResid, pg8::StaticOrder, GEMM_ALIGN, GEMM_SP2>(lds, g, S, E);
        }
        grid_bar(opaque_lds(lds0));
    }
    {
        LAS unsigned char* lds = opaque_lds(lds0); unsigned char* ws = tab_ws(lds);
        const float* X = (const float*)(ws + WS_X); const float* gain = tab_in(lds, I_FINAL_NORM); float* out = (float*)(GAS float*)tab_ld(lds, 23); const int lane = LANE;
        const u64_t* ssf = (const u64_t*)(ws + WS_SS) + (size_t)8 * SEQ;
        for (int m = GW; m < SEQ; m += NGW) row_scale_f32(X + (size_t)m * DM, gain, ss_to_f(ssf[m]), out + (size_t)m * DM, lane);
    }
}

extern "C" void kernel_launch(void* const* d_in, const int* in_sizes, int n_in, void* d_out, int out_size, void* d_ws, size_t ws_size, hipStream_t stream) {
    static int grid = 0;
    if (grid == 0) {
        if (n_in != 23 || out_size != SEQ * DM || ws_size < WS_END) { fprintf(stderr, "kernel_launch: unexpected shapes (n_in %d out %d ws %zu, need %zu)\n", n_in, out_size, ws_size, (size_t)WS_END); grid = -1; return; }
        int dev = 0, cus = 0, per_cu = 0;
        if (hipGetDevice(&dev) != hipSuccess || hipDeviceGetAttribute(&cus, hipDeviceAttributeMultiprocessorCount, dev) != hipSuccess) { grid = -1; return; }
        if (hipFuncSetAttribute((const void*)trunk_fwd, hipFuncAttributeMaxDynamicSharedMemorySize, LDS_BYTES) != hipSuccess) { fprintf(stderr, "kernel_launch: hipFuncSetAttribute failed\n"); grid = -1; return; }
        if (hipOccupancyMaxActiveBlocksPerMultiprocessor(&per_cu, (const void*)trunk_fwd, 512, LDS_BYTES) != hipSuccess || per_cu < 1) { fprintf(stderr, "kernel_launch: occupancy query says %d\n", per_cu); (void)hipGetLastError(); }
        grid = cus;
    }
    if (grid < 0) return;
    if (hipMemsetAsync((char*)d_ws + WS_CTL, 0, CTL_ZERO_BYTES, stream) != hipSuccess) return;
    if (hipMemsetAsync((char*)d_ws + WS_SS, 0, SS_ZERO_BYTES, stream) != hipSuccess) return;
    Params p{};
    for (int i = 0; i < 23; ++i) p.in[i] = (const float*)d_in[i];
    p.out = (float*)d_out; p.ws = (unsigned char*)d_ws;
    hipLaunchKernelGGL(trunk_fwd, dim3(grid), dim3(512), LDS_BYTES, stream, p);
}
```

```cpp
#include <hip/hip_runtime.h>
#include <cstdio>
#include <cstdint>

#define DI __device__ __forceinline__
#define GAS __attribute__((address_space(1)))
#define LAS __attribute__((address_space(3)))
typedef unsigned short bf16_t;
typedef short bf16x8 __attribute__((ext_vector_type(8)));
typedef float f32x4 __attribute__((ext_vector_type(4)));
typedef float f32x2 __attribute__((ext_vector_type(2)));
typedef unsigned u32x4 __attribute__((ext_vector_type(4)));
typedef unsigned u32x2 __attribute__((ext_vector_type(2)));

constexpr int SEQ = 16384, DM = 4096, DFF = 16384, NL = 4, MEML = 256, CH = 64, NCH = SEQ / CH;
constexpr int IN_W = 7448, ZW = 7680;
constexpr int ZC_GQ = 0, ZC_GK = 512, ZC_GV = 1024, ZC_GG = 2048, ZC_MQK = 3072, ZC_MV = 4096, ZC_MO = 5120, ZC_XQ = 6144, ZC_GATE = 7168, ZC_GA = 7424, ZC_MI = 7440, ZC_MF = 7444;
constexpr int OBW = 3840, OB_O = 768;
constexpr int GTW = 12288;
constexpr float EPS = 1e-6f;
#ifndef PITCH_PAD
#define PITCH_PAD 64
#endif
constexpr int PW = DM + PITCH_PAD, PU = DFF + PITCH_PAD;

constexpr size_t MiB = 1u << 20;
constexpr size_t WS_CTL = 0, CTL_ZERO_BYTES = 1 * MiB;
constexpr size_t WS_WIN = 1 * MiB, WS_WBR = 245 * MiB, WS_WOUT = 365 * MiB, WS_W1 = 495 * MiB, WS_W2 = 1015 * MiB;
constexpr size_t WS_WMK = 1529 * MiB, WS_WMV = 1561 * MiB, WS_MEMN = 1593 * MiB, WS_KM = 1595 * MiB, WS_VMT = 1597 * MiB;
constexpr size_t WS_X = 1599 * MiB, WS_H = 1855 * MiB, WS_Z = 1985 * MiB, WS_GT = 2225 * MiB, WS_U = WS_Z  ;
constexpr size_t WS_OB = 2609 * MiB, WS_Y = 2729 * MiB, WS_DS = 2859 * MiB, WS_SP = 2987 * MiB, WS_DC = 3051 * MiB, WS_CP = 3179 * MiB;
constexpr size_t WS_SMALL = 3243 * MiB, WS_SS = 3245 * MiB, SS_ZERO_BYTES = 2 * MiB, WS_BG = 3247 * MiB, WS_END = 3279 * MiB;
static_assert(PITCH_PAD <= 64, "buffer sizes below assume at most 64 elements of row padding");
static_assert(WS_WIN + (size_t)NL * ZW * PW * 2 <= WS_WBR && WS_WBR + (size_t)NL * DM * OBW * 2 <= WS_WOUT && WS_WOUT + (size_t)NL * DM * PW * 2 <= WS_W1 && WS_W1 + (size_t)NL * DFF * PW * 2 <= WS_W2 && WS_W2 + (size_t)NL * DM * PU * 2 <= WS_WMK, "weight map");
static_assert(WS_H + (size_t)SEQ * PW * 2 <= WS_Z && WS_Y + (size_t)SEQ * PW * 2 <= WS_DS, "activation map");
static_assert(WS_OB + (size_t)SEQ * OBW * 2 <= WS_Y, "OB size");
constexpr size_t SM_DECAY = 0, SM_DN = 512 * 1024, SM_NP = 1024 * 1024, SM_GG = 1536 * 1024, SM_FL = 1536 * 1024 + 4096, SM_MP = 1536 * 1024 + 8192;
static_assert(WS_U + (size_t)SEQ * PU * 2 <= WS_OB, "U overlay");
constexpr int CW_BAR = 4096;
static_assert(9 * (size_t)SEQ * 8 <= SS_ZERO_BYTES, "SS region");
typedef unsigned long long u64_t;
DI float ss_to_f(u64_t v) { return (float)v * (1.0f / 16777216.0f); }

constexpr int LDS_BYTES = 147456;
constexpr int L_ST = 0, L_VT = 69632, L_Q = 106496, L_K = 123904, L_MISC = 141312, L_BARW = 146432;
constexpr int ROW72 = 144, ROW136 = 272, ROW264 = 528;
constexpr int NWAVES = 8;

DI float bf2f(unsigned v) { return __uint_as_float(v << 16); }
DI float bflo(unsigned w) { return __uint_as_float(w << 16); }
DI float bfhi(unsigned w) { return __uint_as_float(w & 0xffff0000u); }
typedef __bf16 bf16x2_t __attribute__((ext_vector_type(2)));
DI unsigned pk2(float lo, float hi) { const f32x2 v = {lo, hi}; const bf16x2_t b = __builtin_convertvector(v, bf16x2_t); return __builtin_bit_cast(unsigned, b); }
DI float sigmoid_f(float x) { return __builtin_amdgcn_rcpf(1.0f + __expf(-x)); }
DI float silu_f(float x) { return x * sigmoid_f(x); }
DI float log_sigmoid_f(float x) { return fminf(x, 0.f) - __logf(1.0f + __expf(-fabsf(x))); }
DI float shx(float v, int o, int lane) { return __int_as_float(__builtin_amdgcn_ds_bpermute((lane ^ o) << 2, __float_as_int(v))); }
DI float shi(float v, int src) { return __int_as_float(__builtin_amdgcn_ds_bpermute(src << 2, __float_as_int(v))); }
DI float wave_sum(float v, int lane) {
#pragma unroll
    for (int o = 1; o < 64; o <<= 1) v += shx(v, o, lane);
    return v;
}
DI float wave_max(float v, int lane) {
#pragma unroll
    for (int o = 1; o < 64; o <<= 1) v = fmaxf(v, shx(v, o, lane));
    return v;
}
DI float wave_scan_sum(float v, int lane) {
#pragma unroll
    for (int o = 1; o < 64; o <<= 1) { const float t = shi(v, lane >= o ? lane - o : lane); if (lane >= o) v += t; }
    return v;
}
DI float wave_scan_max(float v, int lane) {
#pragma unroll
    for (int o = 1; o < 64; o <<= 1) { const float t = shi(v, lane >= o ? lane - o : lane); if (lane >= o) v = fmaxf(v, t); }
    return v;
}
DI f32x4 mfma16(bf16x8 a, bf16x8 b, f32x4 c) { return __builtin_amdgcn_mfma_f32_16x16x32_bf16(a, b, c, 0, 0, 0); }
DI int opaque_tid() { int t = (int)threadIdx.x; asm volatile("" : "+v"(t)); return t; }
DI int opaque_bx() { int b = (int)blockIdx.x; asm volatile("" : "+s"(b)); return b; }
DI LAS unsigned char* opaque_lds(LAS unsigned char* p) { asm volatile("" : "+s"(p)); return p; }
DI int opq(int v) { asm volatile("" : "+s"(v)); return v; }
DI int opaque_g() { int g = (int)gridDim.x; asm volatile("" : "+s"(g)); return g; }

namespace pg8 {
#define PG8_LAS __attribute__((address_space(3)))
constexpr int BM = 256, BK = 64, HALF = 128, HTB = HALF * BK * 2  , STAGE_BYTES = 8 * HTB, NXCD = 8;
#ifndef PG8_WGM
#define PG8_WGM 4
#endif
constexpr int WGM = PG8_WGM;

__host__ __device__ __forceinline__ int lds_byte(int r, int c) { const int st = (r >> 4) * 2 + (c >> 5), rr = r & 15, cc = c & 31, ob = rr * 64 + cc * 2; return st * 1024 + (ob ^ (((ob >> 9) & 1) << 5)); }
__host__ __device__ __forceinline__ void stage_rc(int b, int& R, int& C) { const int st = b / 1024, sb = b % 1024, swz = sb ^ (((sb >> 9) & 1) << 5); R = (st >> 1) * 16 + swz / 64; C = (st & 1) * 32 + (swz % 64) / 2; }
__host__ __device__ __forceinline__ int perm32(int rho) { const int n = rho >> 4, i = rho & 15; return 8 * (i >> 2) + 4 * n + (i & 3); }

struct Unit { int pm, pn, kind; };
struct Gemm { const bf16_t* A; const bf16_t* Bt; int M, N, K, lda, ldb; };

struct StaticOrder {
    int nM, nN, nwg, G, c, wgm;
    __host__ __device__ void init(int M, int N, int G_, int c_, int wgm_ = WGM) { nM = M / BM; nN = N / BM; nwg = nM * nN; G = G_; c = c_; wgm = wgm_; }
    __host__ __device__ bool next(int i, Unit& u) const {
        const long L = (long)i * G + c; if (c < 0 || L >= nwg) return false;
        int wgid = (int)L; { const int q = nwg / NXCD, r = nwg % NXCD, xcd = wgid % NXCD, off = wgid / NXCD; wgid = (xcd < r ? xcd * (q + 1) : r * (q + 1) + (xcd - r) * q) + off; }
        const int nig = wgm * nN, gid = wgid / nig, fm = gid * wgm, gsz = (nM - fm) < wgm ? (nM - fm) : wgm;
        u.pm = fm + ((wgid % nig) % gsz); u.pn = (wgid % nig) / gsz; u.kind = 0; return true;
    }
    __device__ __forceinline__ void a_ready(const Unit&) const {}
    __device__ __forceinline__ void done(const Unit&) const {}
    __device__ __forceinline__ int nt(const Unit&, int nt_default) const { return nt_default; }
    __device__ __forceinline__ int koff(const Unit&) const { return 0; }
};
struct BranchOrder : StaticOrder {
    __host__ __device__ bool next(int i, Unit& u) const { if (!StaticOrder::next(i >> 2, u)) return false; u.kind = i & 3; return true; }
    __device__ __forceinline__ int nt(const Unit& u, int) const { return u.kind < 3 ? 4 : 48; }
    __device__ __forceinline__ int koff(const Unit& u) const { return u.kind < 3 ? 256 * u.kind : 768; }
};

template <int ACT  > struct EpiBf16 {
    static constexpr bool PERM = true, AFTER_DRAIN = false, HOOK = false;
    bf16_t* O; int ldc; const float* bias; const unsigned long long* ss; bf16_t* O2; int ld2, pn2;
    __device__ __forceinline__ void operator()(const f32x4 (&acc)[2][2][4][2], const Unit& u, int wr, int wc, int fr, int fq) const {
        const int row0 = u.pm * BM + wr * 64 + fr, col0 = u.pn * BM + wc * 32 + 8 * fq;
        f32x4 bv[2][2];
#pragma unroll
        for (int bj = 0; bj < 2; ++bj)
#pragma unroll
            for (int n = 0; n < 2; ++n) bv[bj][n] = (ACT == 2) ? *(const f32x4*)(bias + col0 + bj * HALF + 4 * n) : (f32x4){0.f, 0.f, 0.f, 0.f};
#pragma unroll
        for (int ai = 0; ai < 2; ++ai)
#pragma unroll
            for (int m = 0; m < 4; ++m) { bf16_t* rowp = O + (size_t)(row0 + ai * HALF + m * 16) * ldc + col0;
                const bool redir = (ACT == 0) && O2 != nullptr && u.pn == pn2;
                if (redir) rowp = O2 + (size_t)(row0 + ai * HALF + m * 16) * ld2 + (col0 - u.pn * BM);
                float rs = 1.f; if (ACT != 2) { if (ss) rs = 1.0f / sqrtf((float)ss[row0 + ai * HALF + m * 16] * (1.0f / 16777216.0f) * (1.0f / DM) + EPS); }
#pragma unroll
                for (int bj = 0; bj < 2; ++bj) { f32x4 v0 = acc[ai][bj][m][0], v1 = acc[ai][bj][m][1];
                    if (ACT != 2) { v0 = v0 * rs; v1 = v1 * rs; }
                    if (ACT == 1) {
#pragma unroll
                        for (int j = 0; j < 4; ++j) { const float a = fmaxf(v0[j], 0.f), b = fmaxf(v1[j], 0.f); v0[j] = a * a; v1[j] = b * b; } }
                    if (ACT == 2) { v0 = v0 + bv[bj][0]; v1 = v1 + bv[bj][1];
#pragma unroll
                        for (int j = 0; j < 4; ++j) { v0[j] = sigmoid_f(fminf(fmaxf(v0[j], -30.f), 30.f)); v1[j] = sigmoid_f(fminf(fmaxf(v1[j], -30.f), 30.f)); } }
                    u32x4 w; w.x = pk2(v0[0], v0[1]); w.y = pk2(v0[2], v0[3]); w.z = pk2(v1[0], v1[1]); w.w = pk2(v1[2], v1[3]);
                    *(u32x4*)(rowp + bj * HALF) = w;
                    if (redir) { *(u32x4*)(rowp + bj * HALF + 256) = w; *(u32x4*)(rowp + bj * HALF + 512) = w; } } }
    }
    __device__ __forceinline__ bool hook_at(const Unit&, int) const { return false; }
    __device__ __forceinline__ void hook(f32x4 (&)[2][2][4][2], const Unit&, int, int, int, int, int) const {}
};
struct EpiResid {
    static constexpr bool PERM = true, AFTER_DRAIN = false, HOOK = false;
    const float* in; float* out; int ldc; bf16_t* xb; unsigned long long* ss; int ldxb;
    __device__ __forceinline__ void operator()(const f32x4 (&acc)[2][2][4][2], const Unit& u, int wr, int wc, int fr, int fq) const {
        const int row0 = u.pm * BM + wr * 64 + fr, col0 = u.pn * BM + wc * 32 + 8 * fq, lane = fq * 16 + fr;
#pragma unroll
        for (int ai = 0; ai < 2; ++ai) {
            f32x4 r[4][2][2];
#pragma unroll
            for (int m = 0; m < 4; ++m) { const size_t off = (size_t)(row0 + ai * HALF + m * 16) * ldc + col0;
#pragma unroll
                for (int bj = 0; bj < 2; ++bj)
#pragma unroll
                    for (int n = 0; n < 2; ++n) r[m][bj][n] = *(const f32x4*)(in + off + bj * HALF + n * 4); }
#pragma unroll
            for (int m = 0; m < 4; ++m) { const int row = row0 + ai * HALF + m * 16; const size_t off = (size_t)row * ldc + col0;
                float sq = 0.f;
#pragma unroll
                for (int bj = 0; bj < 2; ++bj) { const f32x4 o0 = r[m][bj][0] + acc[ai][bj][m][0], o1 = r[m][bj][1] + acc[ai][bj][m][1];
                    *(f32x4*)(out + off + bj * HALF) = o0; *(f32x4*)(out + off + bj * HALF + 4) = o1;
                    sq += (o0[0] * o0[0] + o0[1] * o0[1]) + (o0[2] * o0[2] + o0[3] * o0[3]) + (o1[0] * o1[0] + o1[1] * o1[1]) + (o1[2] * o1[2] + o1[3] * o1[3]);
                    u32x4 w; w.x = pk2(o0[0], o0[1]); w.y = pk2(o0[2], o0[3]); w.z = pk2(o1[0], o1[1]); w.w = pk2(o1[2], o1[3]);
                    *(u32x4*)(xb + (size_t)row * ldxb + col0 + bj * HALF) = w; }
                sq += shx(sq, 16, lane); sq += shx(sq, 32, lane);
                if (fq == 0) (void)__hip_atomic_fetch_add(ss + row, (unsigned long long)(sq * 16777216.0f), __ATOMIC_RELAXED, __HIP_MEMORY_SCOPE_AGENT); }
            asm volatile("" ::: "memory"); }
    }
    __device__ __forceinline__ bool hook_at(const Unit&, int) const { return false; }
    __device__ __forceinline__ void hook(f32x4 (&)[2][2][4][2], const Unit&, int, int, int, int, int) const {}
};
struct EpiBranch {
    static constexpr bool PERM = true, AFTER_DRAIN = false, HOOK = true;
    bf16_t* O; int ldc; bf16_t* GT; const float* bias;
    __device__ __forceinline__ bool hook_at(const Unit& u, int t) const { return u.kind == 3 && (t == 16 || t == 32); }
    __device__ __forceinline__ void hook(f32x4 (&acc)[2][2][4][2], const Unit& u, int t, int, int, int, int) const {
        const int tid_ = opaque_tid(), wid_ = tid_ >> 6, wr = wid_ >> 2, wc = wid_ & 3, fr = tid_ & 15, fq = (tid_ >> 4) & 3;
        const int row0 = u.pm * BM + wr * 64 + fr, col0 = u.pn * BM + wc * 32 + 8 * fq;
        const bf16_t* ga = GT + (size_t)(t == 16 ? 0 : DM); const bf16_t* gb = ga + DM;
#pragma unroll
        for (int ai = 0; ai < 2; ++ai) {
            u32x4 a[4][2], b[4][2];
#pragma unroll
            for (int m = 0; m < 4; ++m) { const size_t off = (size_t)(row0 + ai * HALF + m * 16) * GTW + col0;
#pragma unroll
                for (int bj = 0; bj < 2; ++bj) { a[m][bj] = *(const u32x4*)(ga + off + bj * HALF); b[m][bj] = *(const u32x4*)(gb + off + bj * HALF); } }
#pragma unroll
            for (int m = 0; m < 4; ++m)
#pragma unroll
                for (int bj = 0; bj < 2; ++bj) { const u32x4 x = a[m][bj], y = b[m][bj];
                    f32x4 r0, r1;
                    r0[0] = bflo(y.x) * __builtin_amdgcn_rcpf(bflo(x.x)); r0[1] = bfhi(y.x) * __builtin_amdgcn_rcpf(bfhi(x.x));
                    r0[2] = bflo(y.y) * __builtin_amdgcn_rcpf(bflo(x.y)); r0[3] = bfhi(y.y) * __builtin_amdgcn_rcpf(bfhi(x.y));
                    r1[0] = bflo(y.z) * __builtin_amdgcn_rcpf(bflo(x.z)); r1[1] = bfhi(y.z) * __builtin_amdgcn_rcpf(bfhi(x.z));
                    r1[2] = bflo(y.w) * __builtin_amdgcn_rcpf(bflo(x.w)); r1[3] = bfhi(y.w) * __builtin_amdgcn_rcpf(bfhi(x.w));
                    acc[ai][bj][m][0] = acc[ai][bj][m][0] * r0; acc[ai][bj][m][1] = acc[ai][bj][m][1] * r1; }
            asm volatile("" ::: "memory"); }
    }
    __device__ __forceinline__ void operator()(const f32x4 (&acc)[2][2][4][2], const Unit& u, int wr, int wc, int fr, int fq) const {
        const int row0 = u.pm * BM + wr * 64 + fr, col0 = u.pn * BM + wc * 32 + 8 * fq;
        if (u.kind < 3) {
            bf16_t* gd = GT + (size_t)u.kind * DM; const float* bj_ = bias + (size_t)u.kind * DM + col0;
            f32x4 bv[2][2];
#pragma unroll
            for (int bj = 0; bj < 2; ++bj)
#pragma unroll
                for (int n = 0; n < 2; ++n) bv[bj][n] = *(const f32x4*)(bj_ + bj * HALF + 4 * n);
#pragma unroll
            for (int ai = 0; ai < 2; ++ai)
#pragma unroll
                for (int m = 0; m < 4; ++m) { const size_t off = (size_t)(row0 + ai * HALF + m * 16) * GTW + col0;
#pragma unroll
                    for (int bj = 0; bj < 2; ++bj) { f32x4 v0 = acc[ai][bj][m][0] + bv[bj][0], v1 = acc[ai][bj][m][1] + bv[bj][1];
#pragma unroll
                        for (int e = 0; e < 4; ++e) { v0[e] = 1.0f + __expf(-fminf(fmaxf(v0[e], -30.f), 30.f)); v1[e] = 1.0f + __expf(-fminf(fmaxf(v1[e], -30.f), 30.f)); }
                        u32x4 w; w.x = pk2(v0[0], v0[1]); w.y = pk2(v0[2], v0[3]); w.z = pk2(v1[0], v1[1]); w.w = pk2(v1[2], v1[3]);
                        *(u32x4*)(gd + off + bj * HALF) = w; } }
        } else {
            const bf16_t* gc = GT + 2 * DM;
            u32x4 g[2][4][2];
#pragma unroll
            for (int ai = 0; ai < 2; ++ai)
#pragma unroll
                for (int m = 0; m < 4; ++m)
#pragma unroll
                    for (int bj = 0; bj < 2; ++bj) g[ai][m][bj] = *(const u32x4*)(gc + (size_t)(row0 + ai * HALF + m * 16) * GTW + col0 + bj * HALF);
#pragma unroll
            for (int ai = 0; ai < 2; ++ai)
#pragma unroll
                for (int m = 0; m < 4; ++m) { const size_t r = (size_t)(row0 + ai * HALF + m * 16);
#pragma unroll
                    for (int bj = 0; bj < 2; ++bj) { const u32x4 gg = g[ai][m][bj];
                        const f32x4 v0 = acc[ai][bj][m][0], v1 = acc[ai][bj][m][1];
                        u32x4 w; w.x = pk2(v0[0] * __builtin_amdgcn_rcpf(bflo(gg.x)), v0[1] * __builtin_amdgcn_rcpf(bfhi(gg.x))); w.y = pk2(v0[2] * __builtin_amdgcn_rcpf(bflo(gg.y)), v0[3] * __builtin_amdgcn_rcpf(bfhi(gg.y)));
                        w.z = pk2(v1[0] * __builtin_amdgcn_rcpf(bflo(gg.z)), v1[1] * __builtin_amdgcn_rcpf(bfhi(gg.z))); w.w = pk2(v1[2] * __builtin_amdgcn_rcpf(bflo(gg.w)), v1[3] * __builtin_amdgcn_rcpf(bfhi(gg.w)));
                        *(u32x4*)(O + r * ldc + col0 + bj * HALF) = w; } }
        }
    }
};

template <class Epi, class Sched, bool ALIGN_EPI = false, bool SP2 = false>
__device__ __forceinline__ void gemm_phase(PG8_LAS unsigned char* lds, const Gemm g, const Sched& S, const Epi& E) {
    const int tid = opaque_tid(), wid = __builtin_amdgcn_readfirstlane(tid >> 6), lane = tid & 63, wr = wid >> 2, wc = wid & 3, fr = lane & 15, fq = lane >> 4;
    const int K = g.K, nt_default = K / BK;
    unsigned voffA[2], voffB[2];
#pragma unroll
    for (int i = 0; i < 2; ++i) { int R, C; stage_rc(tid * 16 + i * 8192, R, C); const int Rb = Epi::PERM ? ((R & ~31) + perm32(R & 31)) : R;
        voffA[i] = (unsigned)(R * g.lda + C) * 2u; voffB[i] = (unsigned)(Rb * g.ldb + C) * 2u; }
    const size_t kstep = (size_t)(BK * 2);
    const size_t hstepA = (size_t)HALF * g.lda * 2, hstepB = (size_t)HALF * g.ldb * 2;
    const size_t tstepA = 2 * hstepA, tstepB = 2 * hstepB;
    const unsigned ldsw = (unsigned)wid * 1024u;
    const int aoff = lds_byte(wr * 64 + fr, fq * 8), boff = lds_byte(wc * 32 + fr, fq * 8);
#define PG8_SA(b, h) (((b) * 2 + (h)) * HTB)
#define PG8_SB(b, h) ((4 + (b) * 2 + (h)) * HTB)
#define PG8_STAGE(bufoff, gbase, voff) do { _Pragma("unroll") for (int _i = 0; _i < 2; ++_i) \
        __builtin_amdgcn_global_load_lds((const unsigned*)((const char*)(gbase) + (voff)[_i]), (PG8_LAS unsigned*)(lds + (bufoff) + ldsw + _i * 8192), 16, 0, 0); } while (0)
#define PG8_LDA(dst, b, h) do { _Pragma("unroll") for (int m = 0; m < 4; ++m) _Pragma("unroll") for (int k = 0; k < 2; ++k) dst[m][k] = *(const PG8_LAS bf16x8*)(lds + PG8_SA(b, h) + aoff + m * 2048 + k * 1024); } while (0)
#define PG8_LDB(dst, b, h) do { _Pragma("unroll") for (int n = 0; n < 2; ++n) _Pragma("unroll") for (int k = 0; k < 2; ++k) dst[n][k] = *(const PG8_LAS bf16x8*)(lds + PG8_SB(b, h) + boff + n * 2048 + k * 1024); } while (0)
#ifndef PG8_BAL
#define PG8_BAL 1
#endif
#ifndef PG8_STAGE_LATE
#define PG8_STAGE_LATE 0
#endif
#ifndef PG8_PRIO
#define PG8_PRIO 1
#endif
#define PG8_MMA(ai, bj, At, Bt) do { if (PG8_PRIO) __builtin_amdgcn_s_setprio(PG8_PRIO); _Pragma("unroll") for (int m = 0; m < 4; ++m) _Pragma("unroll") for (int n = 0; n < 2; ++n) _Pragma("unroll") for (int k = 0; k < 2; ++k) \
        acc[ai][bj][m][n] = __builtin_amdgcn_mfma_f32_16x16x32_bf16(Bt[n][k], At[m][k], acc[ai][bj][m][n], 0, 0, 0); if (PG8_PRIO) __builtin_amdgcn_s_setprio(0); } while (0)
#define PG8_WAIT_V(n) asm volatile("s_waitcnt vmcnt(" #n ")" ::: "memory")
#define PG8_WAIT_L(n) asm volatile("s_waitcnt lgkmcnt(" #n ")" ::: "memory")
#define PG8_BAR __builtin_amdgcn_s_barrier()
#define PG8_SCHED __builtin_amdgcn_sched_barrier(0)
    Unit cur, nxt; int ui = 0;
    if (!S.next(0, cur)) return;
    f32x4 acc[2][2][4][2];
#pragma unroll
    for (int a = 0; a < 2; ++a)
#pragma unroll
        for (int b = 0; b < 2; ++b)
#pragma unroll
            for (int m = 0; m < 4; ++m)
#pragma unroll
                for (int n = 0; n < 2; ++n) acc[a][b][m][n] = (f32x4){0.f, 0.f, 0.f, 0.f};
    bf16x8 At[4][2], B0[2][2], B1[2][2];
    const char* cA = (const char*)g.A + (size_t)cur.pm * tstepA + (size_t)S.koff(cur) * 2; const char* cB = (const char*)g.Bt + (size_t)cur.pn * tstepB + (size_t)S.koff(cur) * 2;
    int nt = S.nt(cur, nt_default);
    S.a_ready(cur);
    if constexpr (SP2) {
        PG8_STAGE(PG8_SB(0, 0), cB, voffB); PG8_STAGE(PG8_SB(0, 1), cB + hstepB, voffB); PG8_STAGE(PG8_SA(0, 0), cA, voffA); PG8_STAGE(PG8_SA(0, 1), cA + hstepA, voffA);
        if (wr == 1) PG8_BAR;
        PG8_WAIT_V(2); PG8_BAR;
#if PG8_BAL == 2
        PG8_STAGE(PG8_SA(1, 0), cA + kstep, voffA); PG8_STAGE(PG8_SB(1, 0), cB + kstep, voffB);
        PG8_WAIT_V(6); PG8_BAR;
#elif PG8_BAL
        PG8_STAGE(PG8_SB(1, 0), cB + kstep, voffB); PG8_STAGE(PG8_SB(1, 1), cB + hstepB + kstep, voffB);
        PG8_WAIT_V(4); PG8_BAR;
#else
        PG8_STAGE(PG8_SB(1, 0), cB + kstep, voffB); PG8_STAGE(PG8_SA(1, 0), cA + kstep, voffA); PG8_STAGE(PG8_SB(1, 1), cB + hstepB + kstep, voffB);
        PG8_WAIT_V(6); PG8_BAR;
#endif
    } else {
        PG8_STAGE(PG8_SB(0, 0), cB, voffB); PG8_STAGE(PG8_SA(0, 0), cA, voffA); PG8_STAGE(PG8_SB(0, 1), cB + hstepB, voffB); PG8_STAGE(PG8_SA(0, 1), cA + hstepA, voffA);
        if (wr == 1) PG8_BAR;
        PG8_WAIT_V(4); PG8_BAR;
        PG8_STAGE(PG8_SB(1, 0), cB + kstep, voffB); PG8_STAGE(PG8_SA(1, 0), cA + kstep, voffA); PG8_STAGE(PG8_SB(1, 1), cB + hstepB + kstep, voffB);
        PG8_WAIT_V(6); PG8_BAR;
    }
    for (;;) {
        const bool has_next = S.next(ui + 1, nxt);
        const char* nA = has_next ? (const char*)g.A + (size_t)nxt.pm * tstepA + (size_t)S.koff(nxt) * 2 : cA; const char* nB = has_next ? (const char*)g.Bt + (size_t)nxt.pn * tstepB + (size_t)S.koff(nxt) * 2 : cB;
        for (int t = 0; t < nt; t += 2) {
            const bool last = (t == nt - 2);
            if constexpr (Epi::HOOK) { if (E.hook_at(cur, t)) E.hook(acc, cur, t, wr, wc, fr, fq); }
            const char* a1 = cA + (size_t)(t + 1) * kstep;
            const char* a2 = last ? nA : cA + (size_t)(t + 2) * kstep; const char* b2 = last ? nB : cB + (size_t)(t + 2) * kstep;
            const char* a3 = a2 + kstep; const char* b3 = b2 + kstep;
            if (last && has_next) S.a_ready(nxt);
            if constexpr (SP2) {
#if PG8_BAL == 2
            { const char* b1 = cB + (size_t)(t + 1) * kstep;
            PG8_LDB(B0, 0, 0); PG8_LDB(B1, 0, 1); PG8_SCHED; PG8_LDA(At, 0, 0); PG8_STAGE(PG8_SB(1, 1), b1 + hstepB, voffB); PG8_STAGE(PG8_SA(1, 1), a1 + hstepA, voffA);
            PG8_WAIT_V(8); PG8_WAIT_L(0); PG8_BAR; PG8_MMA(0, 0, At, B0); PG8_MMA(0, 1, At, B1); PG8_BAR; PG8_SCHED;
            PG8_LDA(At, 0, 1); PG8_STAGE(PG8_SA(0, 0), a2, voffA); PG8_STAGE(PG8_SB(0, 0), b2, voffB);
            PG8_WAIT_V(6); PG8_WAIT_L(0); PG8_BAR; PG8_MMA(1, 0, At, B0); PG8_MMA(1, 1, At, B1); PG8_BAR; PG8_SCHED;
            PG8_LDB(B0, 1, 0); PG8_LDB(B1, 1, 1); PG8_SCHED; PG8_LDA(At, 1, 0); PG8_STAGE(PG8_SB(0, 1), b2 + hstepB, voffB); PG8_STAGE(PG8_SA(0, 1), a2 + hstepA, voffA);
            PG8_WAIT_V(8); PG8_WAIT_L(0); PG8_BAR; PG8_MMA(0, 0, At, B0); PG8_MMA(0, 1, At, B1); PG8_BAR; PG8_SCHED;
            PG8_LDA(At, 1, 1); PG8_STAGE(PG8_SA(1, 0), a3, voffA); PG8_STAGE(PG8_SB(1, 0), b3, voffB);
            PG8_WAIT_V(6); PG8_WAIT_L(0); PG8_BAR; PG8_MMA(1, 0, At, B0); PG8_MMA(1, 1, At, B1); PG8_BAR; PG8_SCHED; }
#elif PG8_BAL
            PG8_LDB(B0, 0, 0); PG8_LDB(B1, 0, 1); PG8_SCHED; PG8_LDA(At, 0, 0); PG8_STAGE(PG8_SA(1, 0), a1, voffA); PG8_STAGE(PG8_SA(1, 1), a1 + hstepA, voffA);
            PG8_WAIT_V(8); PG8_WAIT_L(0); PG8_BAR; PG8_MMA(0, 0, At, B0); PG8_MMA(0, 1, At, B1); PG8_BAR; PG8_SCHED;
            PG8_LDA(At, 0, 1); PG8_STAGE(PG8_SB(0, 0), b2, voffB); PG8_STAGE(PG8_SB(0, 1), b2 + hstepB, voffB);
            PG8_WAIT_V(6); PG8_WAIT_L(0); PG8_BAR; PG8_MMA(1, 0, At, B0); PG8_MMA(1, 1, At, B1); PG8_BAR; PG8_SCHED;
            PG8_LDB(B0, 1, 0); PG8_LDB(B1, 1, 1); PG8_SCHED; PG8_LDA(At, 1, 0); PG8_STAGE(PG8_SA(0, 0), a2, voffA); PG8_STAGE(PG8_SA(0, 1), a2 + hstepA, voffA);
            PG8_WAIT_V(8); PG8_WAIT_L(0); PG8_BAR; PG8_MMA(0, 0, At, B0); PG8_MMA(0, 1, At, B1); PG8_BAR; PG8_SCHED;
            PG8_LDA(At, 1, 1); PG8_STAGE(PG8_SB(1, 0), b3, voffB); PG8_STAGE(PG8_SB(1, 1), b3 + hstepB, voffB);
            PG8_WAIT_V(6); PG8_WAIT_L(0); PG8_BAR; PG8_MMA(1, 0, At, B0); PG8_MMA(1, 1, At, B1); PG8_BAR; PG8_SCHED;
            (void)a3;
#else
#if PG8_STAGE_LATE
            PG8_LDB(B0, 0, 0); PG8_LDB(B1, 0, 1); PG8_SCHED; PG8_LDA(At, 0, 0); PG8_WAIT_L(0); PG8_SCHED; PG8_STAGE(PG8_SA(1, 1), a1 + hstepA, voffA);
            PG8_WAIT_V(8); PG8_BAR;
#else
            PG8_LDB(B0, 0, 0); PG8_LDB(B1, 0, 1); PG8_SCHED; PG8_LDA(At, 0, 0); PG8_STAGE(PG8_SA(1, 1), a1 + hstepA, voffA);
            PG8_WAIT_V(8); PG8_WAIT_L(0); PG8_BAR;
#endif
            PG8_MMA(0, 0, At, B0); PG8_MMA(0, 1, At, B1); PG8_BAR; PG8_SCHED;
#if PG8_STAGE_LATE
            PG8_LDA(At, 0, 1); PG8_WAIT_L(0); PG8_SCHED; PG8_STAGE(PG8_SB(0, 0), b2, voffB); PG8_STAGE(PG8_SB(0, 1), b2 + hstepB, voffB); PG8_STAGE(PG8_SA(0, 0), a2, voffA);
            PG8_WAIT_V(8); PG8_BAR;
#else
            PG8_LDA(At, 0, 1); PG8_STAGE(PG8_SB(0, 0), b2, voffB); PG8_STAGE(PG8_SB(0, 1), b2 + hstepB, voffB); PG8_STAGE(PG8_SA(0, 0), a2, voffA);
            PG8_WAIT_V(8); PG8_WAIT_L(0); PG8_BAR;
#endif
            PG8_MMA(1, 0, At, B0); PG8_MMA(1, 1, At, B1); PG8_BAR; PG8_SCHED;
#if PG8_STAGE_LATE
            PG8_LDB(B0, 1, 0); PG8_LDB(B1, 1, 1); PG8_SCHED; PG8_LDA(At, 1, 0); PG8_WAIT_L(0); PG8_SCHED; PG8_STAGE(PG8_SA(0, 1), a2 + hstepA, voffA);
            PG8_WAIT_V(8); PG8_BAR;
#else
            PG8_LDB(B0, 1, 0); PG8_LDB(B1, 1, 1); PG8_SCHED; PG8_LDA(At, 1, 0); PG8_STAGE(PG8_SA(0, 1), a2 + hstepA, voffA);
            PG8_WAIT_V(8); PG8_WAIT_L(0); PG8_BAR;
#endif
            PG8_MMA(0, 0, At, B0); PG8_MMA(0, 1, At, B1); PG8_BAR; PG8_SCHED;
#if PG8_STAGE_LATE
            PG8_LDA(At, 1, 1); PG8_WAIT_L(0); PG8_SCHED; PG8_STAGE(PG8_SB(1, 0), b3, voffB); PG8_STAGE(PG8_SB(1, 1), b3 + hstepB, voffB); PG8_STAGE(PG8_SA(1, 0), a3, voffA);
            PG8_WAIT_V(8); PG8_BAR;
#else
            PG8_LDA(At, 1, 1); PG8_STAGE(PG8_SB(1, 0), b3, voffB); PG8_STAGE(PG8_SB(1, 1), b3 + hstepB, voffB); PG8_STAGE(PG8_SA(1, 0), a3, voffA);
            PG8_WAIT_V(8); PG8_WAIT_L(0); PG8_BAR;
#endif
            PG8_MMA(1, 0, At, B0); PG8_MMA(1, 1, At, B1); PG8_BAR; PG8_SCHED;
#endif
            } else {
            PG8_LDB(B0, 0, 0); PG8_SCHED; PG8_LDA(At, 0, 0); PG8_STAGE(PG8_SA(1, 1), a1 + hstepA, voffA);
            PG8_WAIT_L(8); PG8_BAR; PG8_WAIT_L(0); PG8_MMA(0, 0, At, B0); PG8_BAR; PG8_SCHED;
            PG8_LDB(B1, 0, 1); PG8_STAGE(PG8_SB(0, 0), b2, voffB);
            PG8_BAR; PG8_WAIT_L(0); PG8_MMA(0, 1, At, B1); PG8_BAR;
            PG8_LDA(At, 0, 1); PG8_STAGE(PG8_SA(0, 0), a2, voffA);
            PG8_BAR; PG8_WAIT_L(0); PG8_MMA(1, 0, At, B0); PG8_BAR; PG8_SCHED;
            PG8_STAGE(PG8_SB(0, 1), b2 + hstepB, voffB);
            PG8_WAIT_V(6); PG8_BAR; PG8_MMA(1, 1, At, B1); PG8_BAR;
            PG8_LDB(B0, 1, 0); PG8_SCHED; PG8_LDA(At, 1, 0); PG8_STAGE(PG8_SA(0, 1), a2 + hstepA, voffA);
            PG8_WAIT_L(8); PG8_BAR; PG8_WAIT_L(0); PG8_MMA(0, 0, At, B0); PG8_BAR; PG8_SCHED;
            PG8_LDB(B1, 1, 1); PG8_STAGE(PG8_SB(1, 0), b3, voffB);
            PG8_BAR; PG8_WAIT_L(0); PG8_MMA(0, 1, At, B1); PG8_BAR;
            PG8_LDA(At, 1, 1); PG8_STAGE(PG8_SA(1, 0), a3, voffA);
            PG8_BAR; PG8_WAIT_L(0); PG8_MMA(1, 0, At, B0); PG8_BAR; PG8_SCHED;
            PG8_STAGE(PG8_SB(1, 1), b3 + hstepB, voffB);
            PG8_WAIT_V(6); PG8_BAR; PG8_MMA(1, 1, At, B1); PG8_BAR;
            }
        }
        if constexpr (ALIGN_EPI) { if (wr == 0) PG8_BAR; }
        E(acc, cur, wr, wc, fr, fq); S.done(cur);
        if (!has_next) break;
#pragma unroll
        for (int a = 0; a < 2; ++a)
#pragma unroll
            for (int b = 0; b < 2; ++b)
#pragma unroll
                for (int m = 0; m < 4; ++m)
#pragma unroll
                    for (int n = 0; n < 2; ++n) acc[a][b][m][n] = (f32x4){0.f, 0.f, 0.f, 0.f};
        cur = nxt; cA = nA; cB = nB; ++ui; nt = S.nt(cur, nt_default);
        if constexpr (ALIGN_EPI) { if (wr == 1) PG8_BAR; }
    }
    PG8_WAIT_V(0);
    if constexpr (!ALIGN_EPI) { if (wr == 0) PG8_BAR; }
    PG8_BAR;
#undef PG8_SA
#undef PG8_SB
#undef PG8_STAGE
#undef PG8_LDA
#undef PG8_LDB
#undef PG8_MMA
#undef PG8_WAIT_V
#undef PG8_WAIT_L
#undef PG8_BAR
#undef PG8_SCHED
}
}

#define XB_TMO      128
#define XB_XCNT(j)  (256  + 64 * (j))
#define XB_XSUB(j)  (1280 + 64 * (j))
#define XB_XGEN(j)  (2304 + 64 * (j))
#define XB_TOP      3328
#define XB_TOPGEN   3392
#define XCD_BAR_WORDS 3456
#define XB_SPIN_CAP (1u << 18)

__device__ __forceinline__ unsigned xb_ld(unsigned* p)              { return __hip_atomic_load(p, __ATOMIC_RELAXED, __HIP_MEMORY_SCOPE_AGENT); }
__device__ __forceinline__ unsigned xb_add(unsigned* p, unsigned v) { return __hip_atomic_fetch_add(p, v, __ATOMIC_RELAXED, __HIP_MEMORY_SCOPE_AGENT); }
__device__ __forceinline__ unsigned xb_xcc_id() { return (unsigned)__builtin_amdgcn_s_getreg((3 << 11) | 20) & 0xFu; }
#define XB_SPIN(cond, bar) do { unsigned _sp = 0; while (cond) { __builtin_amdgcn_s_sleep(1); \
    if ((++_sp & 255u) == 0u) { if (xb_ld(&(bar)[XB_TMO])) break; if (_sp > XB_SPIN_CAP) { atomicAdd(&(bar)[XB_TMO], 1u); break; } } } } while (0)

struct XcdBarrier {
    unsigned* bar; unsigned x;
    volatile LAS unsigned* st;
};
__device__ __forceinline__ XcdBarrier xcd_barrier_post(unsigned* bar, volatile LAS unsigned* st) {
    XcdBarrier b; b.bar = bar; b.x = xb_xcc_id(); b.st = st;
    if (threadIdx.x == 0) (void)xb_add(&bar[XB_XCNT(b.x)], 1u);
    return b;
}
__device__ __forceinline__ void xcd_barrier_complete(unsigned* bar, unsigned x, unsigned& nloc, unsigned& nx) {
    const unsigned G = gridDim.x * gridDim.y * gridDim.z;
    unsigned sum, cnt, mine, sp = 0u;
    for (;;) {
        sum = 0u; cnt = 0u; mine = 0u;
#pragma unroll
        for (unsigned j = 0; j < 16; ++j) { const unsigned c = xb_ld(&bar[XB_XCNT(j)]); sum += c; cnt += (c > 0u) ? 1u : 0u; mine = (j == x) ? c : mine; }
        if (sum == G) break;
        __builtin_amdgcn_s_sleep(1);
        if ((++sp & 255u) == 0u) { if (xb_ld(&bar[XB_TMO])) break; if (sp > XB_SPIN_CAP) { atomicAdd(&bar[XB_TMO], 1u); break; } }
    }
    nloc = mine > 0u ? mine : 1u; nx = cnt > 0u ? cnt : 1u;
}
__device__ __forceinline__ void xcd_barrier(const XcdBarrier& b) {
    asm volatile("s_waitcnt vmcnt(0)" ::: "memory");
    __syncthreads();
    if (threadIdx.x == 0) {
        unsigned* bar = b.bar;
        __builtin_amdgcn_s_waitcnt(0);
        unsigned nloc = b.st[0], nx = b.st[1];
        if (nloc == 0u) { xcd_barrier_complete(bar, b.x, nloc, nx); b.st[0] = nloc; b.st[1] = nx; }
        const unsigned old = xb_add(&bar[XB_XSUB(b.x)], 1u);
        const unsigned gen = old / nloc;
        if (old + 1u == (gen + 1u) * nloc) {
            __builtin_amdgcn_fence(__ATOMIC_RELEASE, "agent");
            asm volatile("s_waitcnt vmcnt(0)" ::: "memory");
            const unsigned og = xb_add(&bar[XB_TOP], 1u);
            const unsigned tg = og / nx;
            if (og + 1u == (tg + 1u) * nx) xb_add(&bar[XB_TOPGEN], 1u);
            else XB_SPIN(xb_ld(&bar[XB_TOPGEN]) == tg, bar);
            __builtin_amdgcn_fence(__ATOMIC_ACQUIRE, "agent");
            xb_add(&bar[XB_XGEN(b.x)], 1u);
            asm volatile("s_waitcnt vmcnt(0)" ::: "memory");
        } else {
            XB_SPIN(xb_ld(&bar[XB_XGEN(b.x)]) == gen, bar);
            __builtin_amdgcn_fence(__ATOMIC_ACQUIRE, "agent");
            asm volatile("s_waitcnt vmcnt(0)" ::: "memory");
        }
    }
    __syncthreads();
}

struct Params { const float* in[23]; float* out; unsigned char* ws; };
enum { I_X = 0, I_MEM, I_NORM_MIX, I_W_IN, I_W_GLA_A, I_B_GLA_A, I_GLA_NORM, I_CONV_W, I_CONV_B, I_B_ML_I, I_B_ML_F, I_ML_NORM, I_MEM_NORM, I_W_MEM_K, I_W_MEM_V, I_W_BRANCH, I_W_GATE, I_B_GATE, I_W_OUT, I_NORM_FFN, I_W_FF1, I_W_FF2, I_FINAL_NORM };

DI int win_row(int n) {
    if (n < 3072) return n;
    if (n < 3088) return ZC_GA + (n - 3072);
    if (n < 6160) return n - 16;
    if (n < 6168) return ZC_MI + (n - 6160);
    return n - 24;
}
DI void transpose_item(const float* __restrict__ W, int K, int N, bf16_t* __restrict__ WT, int ld_dst, int col_off, int row_off, bool remap, LAS float* scr, int item, int lane, const float* __restrict__ gain = nullptr) {
    const int nblk = (N + 63) >> 6, kb = item / nblk, nb = item - kb * nblk, k0 = kb << 6, n0 = nb << 6;
    const int a = lane & 15, q = lane >> 4, n4 = 4 * a;
    const bool ok = (n0 + n4) < N;
    f32x4 v[16];
#pragma unroll
    for (int i = 0; i < 16; ++i) { const int kk = 4 * i + q; v[i] = ok ? *(const f32x4*)(W + (size_t)(k0 + kk) * N + n0 + n4) : (f32x4){0.f, 0.f, 0.f, 0.f}; }
#pragma unroll
    for (int i = 0; i < 16; ++i) { const int kk = 4 * i + q;
#pragma unroll
        for (int e = 0; e < 4; ++e) scr[(n4 + e) * 65 + kk] = v[i][e]; }
    asm volatile("s_waitcnt lgkmcnt(0)" ::: "memory");
    const int c = lane & 7;
    f32x4 g0 = (f32x4){1.f, 1.f, 1.f, 1.f}, g1 = g0;
    if (gain) { g0 = *(const f32x4*)(gain + k0 + 8 * c); g1 = *(const f32x4*)(gain + k0 + 8 * c + 4); }
#pragma unroll
    for (int jj = 0; jj < 8; ++jj) { const int n = (lane >> 3) + 8 * jj; const LAS float* s = scr + n * 65 + 8 * c;
        u32x4 o; o.x = pk2(s[0] * g0[0], s[1] * g0[1]); o.y = pk2(s[2] * g0[2], s[3] * g0[3]); o.z = pk2(s[4] * g1[0], s[5] * g1[1]); o.w = pk2(s[6] * g1[2], s[7] * g1[3]);
        const int ng = n0 + n;
        if (ng < N) { const int row = row_off + (remap ? win_row(ng) : ng); *(u32x4*)(WT + (size_t)row * ld_dst + col_off + k0 + 8 * c) = o; } }
    asm volatile("s_waitcnt lgkmcnt(0)" ::: "memory");
}

template <bool OUT_F32> DI void rmsnorm_row(const float* __restrict__ xrow, const float* __restrict__ g, void* orow, int lane) {
    const f32x4* xr = (const f32x4*)xrow + lane; const f32x4* gr = (const f32x4*)g + lane;
    f32x4 v[16]; float s = 0.f;
#pragma unroll
    for (int j = 0; j < 16; ++j) { v[j] = xr[64 * j]; s += (v[j].x * v[j].x + v[j].y * v[j].y) + (v[j].z * v[j].z + v[j].w * v[j].w); }
    const float rstd = 1.0f / sqrtf(wave_sum(s, lane) * (1.0f / DM) + EPS);
#pragma unroll
    for (int j = 0; j < 16; ++j) { const f32x4 gg = gr[64 * j]; const f32x4 o = v[j] * rstd * gg;
        if (OUT_F32) ((f32x4*)orow)[lane + 64 * j] = o;
        else { u32x2 w; w.x = pk2(o.x, o.y); w.y = pk2(o.z, o.w); ((u32x2*)orow)[lane + 64 * j] = w; } }
}

DI void row_bf16_ss(const float* __restrict__ xrow, bf16_t* orow, unsigned long long* ss, int lane) {
    const f32x4* xr = (const f32x4*)xrow + lane; float s = 0.f;
#pragma unroll
    for (int j = 0; j < 16; ++j) { const f32x4 v = xr[64 * j]; s += (v.x * v.x + v.y * v.y) + (v.z * v.z + v.w * v.w);
        u32x2 w; w.x = pk2(v.x, v.y); w.y = pk2(v.z, v.w); ((u32x2*)orow)[lane + 64 * j] = w; }
    s = wave_sum(s, lane);
    if (lane == 0) *ss = (unsigned long long)(s * 16777216.0f);
}
DI void row_scale_f32(const float* __restrict__ xrow, const float* __restrict__ g, float ssv, float* orow, int lane) {
    const f32x4* xr = (const f32x4*)xrow + lane; const f32x4* gr = (const f32x4*)g + lane;
    const float rstd = 1.0f / sqrtf(ssv * (1.0f / DM) + EPS);
#pragma unroll
    for (int j = 0; j < 16; ++j) ((f32x4*)orow)[lane + 64 * j] = xr[64 * j] * rstd * gr[64 * j];
}

DI void fill_vT(const bf16_t* __restrict__ Zv, int n, int tg, int lane, LAS unsigned char* VT) {
#pragma unroll
    for (int i = 0; i < 2; ++i) { const int cp = lane + 64 * i; unsigned w[8];
#pragma unroll
        for (int j = 0; j < 8; ++j) w[j] = *(const unsigned*)(Zv + (size_t)(n * CH + 8 * tg + j) * ZW + 2 * cp);
        u32x4 lo, hi;
        lo.x = (w[0] & 0xffffu) | (w[1] << 16); lo.y = (w[2] & 0xffffu) | (w[3] << 16); lo.z = (w[4] & 0xffffu) | (w[5] << 16); lo.w = (w[6] & 0xffffu) | (w[7] << 16);
        hi.x = (w[0] >> 16) | (w[1] & 0xffff0000u); hi.y = (w[2] >> 16) | (w[3] & 0xffff0000u); hi.z = (w[4] >> 16) | (w[5] & 0xffff0000u); hi.w = (w[6] >> 16) | (w[7] & 0xffff0000u);
        *(LAS u32x4*)(VT + (2 * cp) * ROW72 + tg * 16) = lo; *(LAS u32x4*)(VT + (2 * cp + 1) * ROW72 + tg * 16) = hi; }
}
DI void state_mfma(const LAS unsigned char* VT, const LAS unsigned char* KT, bf16_t* __restrict__ OUT, int w, int lane) {
    const int fr = lane & 15, fq = lane >> 4;
    f32x4 acc[2][8];
#pragma unroll
    for (int mi = 0; mi < 2; ++mi)
#pragma unroll
        for (int ni = 0; ni < 8; ++ni) acc[mi][ni] = (f32x4){0.f, 0.f, 0.f, 0.f};
#pragma unroll
    for (int ks = 0; ks < 2; ++ks) {
        bf16x8 a[2];
#pragma unroll
        for (int mi = 0; mi < 2; ++mi) a[mi] = *(const LAS bf16x8*)(VT + (32 * w + 16 * mi + fr) * ROW72 + (32 * ks + 8 * fq) * 2);
#pragma unroll
        for (int ni = 0; ni < 8; ++ni) { const bf16x8 b = *(const LAS bf16x8*)(KT + (16 * ni + fr) * ROW72 + (32 * ks + 8 * fq) * 2);
#pragma unroll
            for (int mi = 0; mi < 2; ++mi) acc[mi][ni] = mfma16(b, a[mi], acc[mi][ni]); }
    }
#pragma unroll
    for (int mi = 0; mi < 2; ++mi)
#pragma unroll
        for (int ni = 0; ni < 8; ++ni) *(u32x2*)(OUT + (size_t)(32 * w + 16 * mi + fr) * 128 + 16 * ni + 4 * fq) = (u32x2){pk2(acc[mi][ni][0], acc[mi][ni][1]), pk2(acc[mi][ni][2], acc[mi][ni][3])};
}
DI void copy_256x128(const bf16_t* __restrict__ src, int gp, LAS unsigned char* dst, int tid) {
#pragma unroll
    for (int i = 0; i < 8; ++i) { const int id = tid + 512 * i, row = id >> 4, cc = id & 15;
        *(LAS u32x4*)(dst + row * ROW136 + cc * 16) = *(const u32x4*)(src + (size_t)row * gp + cc * 8); }
}

DI void ld_v(const bf16_t* __restrict__ Zv, int n, int tg, int lane, unsigned (&w)[2][8]) {
#pragma unroll
    for (int i = 0; i < 2; ++i)
#pragma unroll
        for (int j = 0; j < 8; ++j) w[i][j] = *(const unsigned*)(Zv + (size_t)(n * CH + 8 * tg + j) * ZW + 2 * (lane + 64 * i));
}
DI void st_vT(const unsigned (&w)[2][8], int tg, int lane, LAS unsigned char* VT) {
#pragma unroll
    for (int i = 0; i < 2; ++i) { const int cp = lane + 64 * i; u32x4 lo, hi;
        lo.x = (w[i][0] & 0xffffu) | (w[i][1] << 16); lo.y = (w[i][2] & 0xffffu) | (w[i][3] << 16); lo.z = (w[i][4] & 0xffffu) | (w[i][5] << 16); lo.w = (w[i][6] & 0xffffu) | (w[i][7] << 16);
        hi.x = (w[i][0] >> 16) | (w[i][1] & 0xffff0000u); hi.y = (w[i][2] >> 16) | (w[i][3] & 0xffff0000u); hi.z = (w[i][4] >> 16) | (w[i][5] & 0xffff0000u); hi.w = (w[i][6] >> 16) | (w[i][7] & 0xffff0000u);
        *(LAS u32x4*)(VT + (2 * cp) * ROW72 + tg * 16) = lo; *(LAS u32x4*)(VT + (2 * cp + 1) * ROW72 + tg * 16) = hi; }
}
DI void ld_256x128(const bf16_t* __restrict__ src, int gp, int tid, u32x4 (&r)[8]) {
#pragma unroll
    for (int i = 0; i < 8; ++i) { const int id = tid + 512 * i, row = id >> 4, cc = id & 15; r[i] = *(const u32x4*)(src + (size_t)row * gp + cc * 8); }
}
DI void st_256x128(const u32x4 (&r)[8], LAS unsigned char* dst, int tid) {
#pragma unroll
    for (int i = 0; i < 8; ++i) { const int id = tid + 512 * i, row = id >> 4, cc = id & 15; *(LAS u32x4*)(dst + row * ROW136 + cc * 16) = r[i]; }
}
DI void conv_ld(const bf16_t* __restrict__ Zc, int tok0, unsigned (&x)[11]) {
#pragma unroll
    for (int i = 0; i < 11; ++i) { const int tok = tok0 - 3 + i; x[i] = 0u; if (tok >= 0) x[i] = *(const unsigned*)(Zc + (size_t)tok * ZW); }
}
DI void conv_apply(const unsigned (&x)[11], const float* __restrict__ cw, const float* __restrict__ cb, float (&o0)[8], float (&o1)[8]) {
    f32x2 wj[4];
#pragma unroll
    for (int j = 0; j < 4; ++j) wj[j] = *(const f32x2*)(cw + j * 1024);
    const f32x2 bias = *(const f32x2*)cb;
#pragma unroll
    for (int j = 0; j < 8; ++j) { float y0 = bias.x, y1 = bias.y;
#pragma unroll
        for (int jj = 0; jj < 4; ++jj) { y0 += wj[jj].x * bflo(x[j + jj]); y1 += wj[jj].y * bfhi(x[j + jj]); }
        o0[j] = silu_f(y0); o1[j] = silu_f(y1); }
}
DI void gla_b(const bf16_t* __restrict__ Z, const float* __restrict__ wa, const float* __restrict__ ba, int h, int n, int tg, int c2, LAS float* TOT, float (&b)[8][2], float (&blast)[2]) {
    const int col = h * 128 + 2 * c2;
    float w0[16], w1[16];
#pragma unroll
    for (int r = 0; r < 16; ++r) { const f32x2 w = *(const f32x2*)(wa + r * 512 + col); w0[r] = w.x; w1[r] = w.y; }
    const f32x2 bb = *(const f32x2*)(ba + col);
    float c0 = 0.f, c1 = 0.f;
#pragma unroll
    for (int j = 0; j < 8; ++j) {
        const bf16_t* gp = Z + (size_t)(n * CH + 8 * tg + j) * ZW + ZC_GA;
        const u32x4 g0 = *(const u32x4*)gp, g1 = *(const u32x4*)(gp + 8);
        const float gv[16] = {bflo(g0.x), bfhi(g0.x), bflo(g0.y), bfhi(g0.y), bflo(g0.z), bfhi(g0.z), bflo(g0.w), bfhi(g0.w),
                              bflo(g1.x), bfhi(g1.x), bflo(g1.y), bfhi(g1.y), bflo(g1.z), bfhi(g1.z), bflo(g1.w), bfhi(g1.w)};
        float p0 = bb.x, p1 = bb.y;
#pragma unroll
        for (int r = 0; r < 16; ++r) { p0 += gv[r] * w0[r]; p1 += gv[r] * w1[r]; }
        c0 += log_sigmoid_f(p0) * (1.0f / 16.0f); c1 += log_sigmoid_f(p1) * (1.0f / 16.0f);
        b[j][0] = c0; b[j][1] = c1;
    }
    *(LAS f32x2*)(TOT + tg * 128 + 2 * c2) = (f32x2){c0, c1};
    __syncthreads();
    float pre0 = 0.f, pre1 = 0.f, t0 = 0.f, t1 = 0.f;
#pragma unroll
    for (int g = 0; g < 8; ++g) { const f32x2 t = *(const LAS f32x2*)(TOT + g * 128 + 2 * c2); if (g < tg) { pre0 += t.x; pre1 += t.y; } t0 += t.x; t1 += t.y; }
#pragma unroll
    for (int j = 0; j < 8; ++j) { b[j][0] += pre0; b[j][1] += pre1; }
    blast[0] = t0; blast[1] = t1;
}
DI void conv_silu8(const bf16_t* __restrict__ Zc, const float* __restrict__ cw, const float* __restrict__ cb, int tok0, float (&o0)[8], float (&o1)[8]) {
    float x0[11], x1[11];
#pragma unroll
    for (int i = 0; i < 11; ++i) { const int tok = tok0 - 3 + i; unsigned w = 0u; if (tok >= 0) w = *(const unsigned*)(Zc + (size_t)tok * ZW); x0[i] = bflo(w); x1[i] = bfhi(w); }
    f32x2 wj[4];
#pragma unroll
    for (int j = 0; j < 4; ++j) wj[j] = *(const f32x2*)(cw + j * 1024);
    const f32x2 bias = *(const f32x2*)cb;
#pragma unroll
    for (int j = 0; j < 8; ++j) { float y0 = bias.x, y1 = bias.y;
#pragma unroll
        for (int jj = 0; jj < 4; ++jj) { y0 += wj[jj].x * x0[j + jj]; y1 += wj[jj].y * x1[j + jj]; }
        o0[j] = silu_f(y0); o1[j] = silu_f(y1); }
}
DI void score_mfma(const LAS unsigned char* QL, const LAS unsigned char* KL, int w, int lane, f32x4 (&sacc)[2]) {
    const int fr = lane & 15, fq = lane >> 4, mi = w >> 1, ni0 = 2 * (w & 1);
    sacc[0] = (f32x4){0.f, 0.f, 0.f, 0.f}; sacc[1] = sacc[0];
#pragma unroll
    for (int ks = 0; ks < 4; ++ks) { const bf16x8 a = *(const LAS bf16x8*)(QL + (16 * mi + fr) * ROW136 + (32 * ks + 8 * fq) * 2);
#pragma unroll
        for (int jn = 0; jn < 2; ++jn) { const bf16x8 b = *(const LAS bf16x8*)(KL + (16 * (ni0 + jn) + fr) * ROW136 + (32 * ks + 8 * fq) * 2); sacc[jn] = mfma16(b, a, sacc[jn]); } }
}

struct MixCtx {
    const bf16_t* Z; bf16_t* OB;
    const float *wa, *ba, *gla_norm, *conv_w, *conv_b, *b_i, *b_f, *ml_norm;
    float *DECAY, *DN, *NP, *GG, *FL, *MP, *BG; bf16_t *DS, *DC, *SP, *CP;
    const bf16_t *KM, *VMT;
};

DI void gla_A_unit(const MixCtx& C, LAS unsigned char* lds, int h, int n, int tid) {
    const int lane = tid & 63, tg = __builtin_amdgcn_readfirstlane(tid >> 6), c2 = lane;
    LAS float* TOT = (LAS float*)(lds + L_MISC);
    LAS unsigned char* KT = lds + L_ST; LAS unsigned char* VT = lds + L_VT;
    unsigned kw[8], vw[2][8];
#pragma unroll
    for (int j = 0; j < 8; ++j) kw[j] = *(const unsigned*)(C.Z + (size_t)(n * CH + 8 * tg + j) * ZW + ZC_GK + h * 128 + 2 * c2);
    ld_v(C.Z + ZC_GV + h * 256, n, tg, lane, vw);
    float b[8][2], blast[2];
    gla_b(C.Z, C.wa, C.ba, h, n, tg, c2, TOT, b, blast);
    float k0[8], k1[8];
#pragma unroll
    for (int j = 0; j < 8; ++j) { k0[j] = bflo(kw[j]) * __expf(blast[0] - b[j][0]); k1[j] = bfhi(kw[j]) * __expf(blast[1] - b[j][1]);
        *(f32x2*)(C.BG + ((size_t)(h * NCH + n) * CH + 8 * tg + j) * 128 + 2 * c2) = (f32x2){b[j][0], b[j][1]}; }
    u32x4 lo, hi;
    lo.x = pk2(k0[0], k0[1]); lo.y = pk2(k0[2], k0[3]); lo.z = pk2(k0[4], k0[5]); lo.w = pk2(k0[6], k0[7]);
    hi.x = pk2(k1[0], k1[1]); hi.y = pk2(k1[2], k1[3]); hi.z = pk2(k1[4], k1[5]); hi.w = pk2(k1[6], k1[7]);
    *(LAS u32x4*)(KT + (2 * c2) * ROW72 + tg * 16) = lo; *(LAS u32x4*)(KT + (2 * c2 + 1) * ROW72 + tg * 16) = hi;
    if (tg == 0) *(f32x2*)(C.DECAY + (size_t)(h * NCH + n) * 128 + 2 * c2) = (f32x2){__expf(blast[0]), __expf(blast[1])};
    st_vT(vw, tg, lane, VT);
    __syncthreads();
    state_mfma(VT, KT, C.DS + (size_t)(h * NCH + n) * 32768, tg, lane);
    __syncthreads();
}

DI void gla_B_unit(const MixCtx& C, LAS unsigned char* lds, int h, int n, int tid) {
    const int lane = tid & 63, w = __builtin_amdgcn_readfirstlane(tid >> 6), tg = w, c2 = lane, fr = lane & 15, fq = lane >> 4;
    LAS float* RS = (LAS float*)(lds + L_MISC + 4096);
    LAS unsigned char* ST = lds + L_ST; LAS unsigned char* VT = lds + L_VT; LAS unsigned char* QL = lds + L_Q; LAS unsigned char* KL = lds + L_K;
    const int wr = w >> 1, wc = w & 1, t = 16 * wr + fr;
    const size_t tok = (size_t)(n * CH + t);
    u32x4 st[8]; f32x2 bq[8]; unsigned wq[8], wk[8], vw[2][8]; u32x2 gg[8]; f32x4 gn[8];
    ld_256x128(C.SP + (size_t)(h * NCH + n) * 32768, 128, tid, st);
#pragma unroll
    for (int j = 0; j < 8; ++j) { const size_t zr = (size_t)(n * CH + 8 * tg + j) * ZW;
        bq[j] = *(const f32x2*)(C.BG + ((size_t)(h * NCH + n) * CH + 8 * tg + j) * 128 + 2 * c2);
        wq[j] = *(const unsigned*)(C.Z + zr + ZC_GQ + h * 128 + 2 * c2); wk[j] = *(const unsigned*)(C.Z + zr + ZC_GK + h * 128 + 2 * c2); }
    ld_v(C.Z + ZC_GV + h * 256, n, tg, lane, vw);
#pragma unroll
    for (int ni = 0; ni < 8; ++ni) { const int dv = 128 * wc + 16 * ni + 4 * fq; gg[ni] = *(const u32x2*)(C.Z + tok * ZW + ZC_GG + h * 256 + dv); gn[ni] = *(const f32x4*)(C.gla_norm + h * 256 + dv); }
    const float qs = 0.08838834764831845f;
#pragma unroll
    for (int j = 0; j < 8; ++j) { const float e0 = __expf(bq[j].x), e1 = __expf(bq[j].y);
        *(LAS unsigned*)(QL + (8 * tg + j) * ROW136 + 4 * c2) = pk2(bflo(wq[j]) * qs * e0, bfhi(wq[j]) * qs * e1);
        *(LAS unsigned*)(KL + (8 * tg + j) * ROW136 + 4 * c2) = pk2(bflo(wk[j]) * __builtin_amdgcn_rcpf(e0), bfhi(wk[j]) * __builtin_amdgcn_rcpf(e1)); }
    st_vT(vw, tg, lane, VT);
    st_256x128(st, ST, tid);
    __syncthreads();
    f32x4 sacc[2];
    score_mfma(QL, KL, w, lane, sacc);
    __syncthreads();
    { const int mi = w >> 1, ni0 = 2 * (w & 1), t2 = 16 * mi + fr;
#pragma unroll
      for (int jn = 0; jn < 2; ++jn) { const int s0 = 16 * (ni0 + jn) + 4 * fq; f32x4 v = sacc[jn];
#pragma unroll
          for (int r = 0; r < 4; ++r) if (s0 + r > t2) v[r] = 0.f;
          *(LAS u32x2*)(KL + t2 * ROW72 + s0 * 2) = (u32x2){pk2(v[0], v[1]), pk2(v[2], v[3])}; } }
    __syncthreads();
    f32x4 o[8];
#pragma unroll
    for (int ni = 0; ni < 8; ++ni) o[ni] = (f32x4){0.f, 0.f, 0.f, 0.f};
#pragma unroll
    for (int ks = 0; ks < 2; ++ks) { const bf16x8 a = *(const LAS bf16x8*)(KL + t * ROW72 + (32 * ks + 8 * fq) * 2);
#pragma unroll
        for (int ni = 0; ni < 8; ++ni) { const bf16x8 bb = *(const LAS bf16x8*)(VT + (128 * wc + 16 * ni + fr) * ROW72 + (32 * ks + 8 * fq) * 2); o[ni] = mfma16(bb, a, o[ni]); } }
#pragma unroll
    for (int ks = 0; ks < 4; ++ks) { const bf16x8 a = *(const LAS bf16x8*)(QL + t * ROW136 + (32 * ks + 8 * fq) * 2);
#pragma unroll
        for (int ni = 0; ni < 8; ++ni) { const bf16x8 bb = *(const LAS bf16x8*)(ST + (128 * wc + 16 * ni + fr) * ROW136 + (32 * ks + 8 * fq) * 2); o[ni] = mfma16(bb, a, o[ni]); } }
    float ss = 0.f;
#pragma unroll
    for (int ni = 0; ni < 8; ++ni) ss += (o[ni][0] * o[ni][0] + o[ni][1] * o[ni][1]) + (o[ni][2] * o[ni][2] + o[ni][3] * o[ni][3]);
    ss += shx(ss, 16, lane); ss += shx(ss, 32, lane);
    if (fq == 0) RS[wc * 64 + t] = ss;
    __syncthreads();
    const float rstd = 1.0f / sqrtf((RS[t] + RS[64 + t]) * (1.0f / 256.0f) + EPS);
#pragma unroll
    for (int ni = 0; ni < 8; ++ni) { const int dv = 128 * wc + 16 * ni + 4 * fq;
        const f32x4 v = o[ni] * rstd * gn[ni];
        *(u32x2*)(C.OB + tok * OBW + OB_O + h * 256 + dv) = (u32x2){pk2(v[0] * silu_f(bflo(gg[ni].x)), v[1] * silu_f(bfhi(gg[ni].x))), pk2(v[2] * silu_f(bflo(gg[ni].y)), v[3] * silu_f(bfhi(gg[ni].y)))}; }
    __syncthreads();
}

DI void ml_A_unit(const MixCtx& C, LAS unsigned char* lds, int h, int n, int tid) {
    const int lane = tid & 63, tg = __builtin_amdgcn_readfirstlane(tid >> 6), c2 = lane;
    LAS float* PART = (LAS float*)(lds + L_MISC);
    LAS unsigned char* KT = lds + L_ST; LAS unsigned char* VT = lds + L_VT;
    const size_t ztok = (size_t)(n * CH + lane) * ZW;
    const float li = bf2f(C.Z[ztok + ZC_MI + h]) + C.b_i[h];
    const float lf = log_sigmoid_f(bf2f(C.Z[ztok + ZC_MF + h]) + C.b_f[h]);
    const float F = wave_scan_sum(lf, lane);
    const float Flast = shi(F, 63);
    const float Gv = Flast - F + li;
    const float g = wave_max(Gv, lane);
    const float wG = __expf(Gv - g);
    float k0[8], k1[8];
    conv_silu8(C.Z + ZC_MQK + 512 + h * 128 + 2 * c2, C.conv_w + 512 + h * 128 + 2 * c2, C.conv_b + 512 + h * 128 + 2 * c2, n * CH + 8 * tg, k0, k1);
    const float ks = 0.08838834764831845f;
    float p0 = 0.f, p1 = 0.f;
#pragma unroll
    for (int j = 0; j < 8; ++j) { const float wj = shi(wG, 8 * tg + j) * ks; k0[j] *= wj; k1[j] *= wj; p0 += k0[j]; p1 += k1[j]; }
    u32x4 lo, hi;
    lo.x = pk2(k0[0], k0[1]); lo.y = pk2(k0[2], k0[3]); lo.z = pk2(k0[4], k0[5]); lo.w = pk2(k0[6], k0[7]);
    hi.x = pk2(k1[0], k1[1]); hi.y = pk2(k1[2], k1[3]); hi.z = pk2(k1[4], k1[5]); hi.w = pk2(k1[6], k1[7]);
    *(LAS u32x4*)(KT + (2 * c2) * ROW72 + tg * 16) = lo; *(LAS u32x4*)(KT + (2 * c2 + 1) * ROW72 + tg * 16) = hi;
    *(LAS f32x2*)(PART + tg * 128 + 2 * c2) = (f32x2){p0, p1};
    fill_vT(C.Z + ZC_MV + h * 256, n, tg, lane, VT);
    if (tid == 0) { C.GG[h * NCH + n] = g; C.FL[h * NCH + n] = Flast; }
    __syncthreads();
    if (tid < 128) { float s = 0.f;
#pragma unroll
        for (int q = 0; q < 8; ++q) s += PART[q * 128 + tid];
        C.DN[(size_t)(h * NCH + n) * 128 + tid] = s; }
    state_mfma(VT, KT, C.DC + (size_t)(h * NCH + n) * 32768, tg, lane);
    __syncthreads();
}

DI void ml_B_unit(const MixCtx& C, LAS unsigned char* lds, int h, int n, int tid) {
    const int lane = tid & 63, w = __builtin_amdgcn_readfirstlane(tid >> 6), tg = w, c2 = lane, fr = lane & 15, fq = lane >> 4;
    LAS float* MF = (LAS float*)(lds + L_MISC); LAS float* MU = MF + 64; LAS float* MM = MF + 128; LAS float* MW = MF + 192;
    LAS float* DENP = MF + 256; LAS float* DQN = MF + 512; LAS float* NPV = MF + 576; LAS float* RS = (LAS float*)(lds + L_MISC + 4096);
    LAS unsigned char* CT = lds + L_ST; LAS unsigned char* VT = lds + L_VT; LAS unsigned char* QL = lds + L_Q; LAS unsigned char* KL = lds + L_K;
    copy_256x128(C.CP + (size_t)(h * NCH + n) * 32768, 128, CT, tid);
    if (w == 0) {
        const size_t ztok = (size_t)(n * CH + lane) * ZW;
        const float li = bf2f(C.Z[ztok + ZC_MI + h]) + C.b_i[h];
        const float lf = log_sigmoid_f(bf2f(C.Z[ztok + ZC_MF + h]) + C.b_f[h]);
        const float F = wave_scan_sum(lf, lane);
        const float u = li - F;
        const float pm = wave_scan_max(u, lane);
        const float mprev = C.MP[h * NCH + n];
        const float m = F + fmaxf(pm, mprev);
        MF[lane] = F; MU[lane] = u; MM[lane] = m; MW[lane] = __expf(F + mprev - m);
    }
    if (w == 1) { NPV[lane] = C.NP[(size_t)(h * NCH + n) * 128 + lane]; NPV[64 + lane] = C.NP[(size_t)(h * NCH + n) * 128 + 64 + lane]; }
    {
        float q0[8], q1[8], k0[8], k1[8];
        conv_silu8(C.Z + ZC_MQK + h * 128 + 2 * c2, C.conv_w + h * 128 + 2 * c2, C.conv_b + h * 128 + 2 * c2, n * CH + 8 * tg, q0, q1);
        conv_silu8(C.Z + ZC_MQK + 512 + h * 128 + 2 * c2, C.conv_w + 512 + h * 128 + 2 * c2, C.conv_b + 512 + h * 128 + 2 * c2, n * CH + 8 * tg, k0, k1);
        const float ks = 0.08838834764831845f;
#pragma unroll
        for (int j = 0; j < 8; ++j) { *(LAS unsigned*)(QL + (8 * tg + j) * ROW136 + 4 * c2) = pk2(q0[j], q1[j]); *(LAS unsigned*)(KL + (8 * tg + j) * ROW136 + 4 * c2) = pk2(k0[j] * ks, k1[j] * ks); }
    }
    fill_vT(C.Z + ZC_MV + h * 256, n, tg, lane, VT);
    __syncthreads();
    f32x4 sacc[2];
    score_mfma(QL, KL, w, lane, sacc);
    {
        const int t = tid >> 3, part = tid & 7; float s = 0.f;
#pragma unroll
        for (int e = 0; e < 8; ++e) { const unsigned qq = *(const LAS unsigned*)(QL + t * ROW136 + (16 * part + 2 * e) * 2); s += bflo(qq) * NPV[16 * part + 2 * e] + bfhi(qq) * NPV[16 * part + 2 * e + 1]; }
        s += shx(s, 1, lane); s += shx(s, 2, lane); s += shx(s, 4, lane);
        if (part == 0) DQN[t] = s;
    }
    __syncthreads();
    { const int mi = w >> 1, ni0 = 2 * (w & 1), t = 16 * mi + fr; const float ft = MF[t] - MM[t];
#pragma unroll
      for (int jn = 0; jn < 2; ++jn) { const int s0 = 16 * (ni0 + jn) + 4 * fq; f32x4 v = sacc[jn]; const f32x4 us = *(const LAS f32x4*)(MU + s0);
          float ps = 0.f;
#pragma unroll
          for (int r = 0; r < 4; ++r) { v[r] = (s0 + r > t) ? 0.f : v[r] * __expf(ft + us[r]); ps += v[r]; }
          ps += shx(ps, 16, lane); ps += shx(ps, 32, lane);
          if (fq == 0) DENP[t * 4 + ni0 + jn] = ps;
          *(LAS u32x2*)(KL + t * ROW72 + s0 * 2) = (u32x2){pk2(v[0], v[1]), pk2(v[2], v[3])}; } }
    __syncthreads();
    const int wr = w >> 1, wc = w & 1, t = 16 * wr + fr;
    f32x4 o1[8], o2[8];
#pragma unroll
    for (int ni = 0; ni < 8; ++ni) { o1[ni] = (f32x4){0.f, 0.f, 0.f, 0.f}; o2[ni] = o1[ni]; }
#pragma unroll
    for (int ks = 0; ks < 2; ++ks) { const bf16x8 a = *(const LAS bf16x8*)(KL + t * ROW72 + (32 * ks + 8 * fq) * 2);
#pragma unroll
        for (int ni = 0; ni < 8; ++ni) { const bf16x8 bb = *(const LAS bf16x8*)(VT + (128 * wc + 16 * ni + fr) * ROW72 + (32 * ks + 8 * fq) * 2); o1[ni] = mfma16(bb, a, o1[ni]); } }
#pragma unroll
    for (int ks = 0; ks < 4; ++ks) { const bf16x8 a = *(const LAS bf16x8*)(QL + t * ROW136 + (32 * ks + 8 * fq) * 2);
#pragma unroll
        for (int ni = 0; ni < 8; ++ni) { const bf16x8 bb = *(const LAS bf16x8*)(CT + (128 * wc + 16 * ni + fr) * ROW136 + (32 * ks + 8 * fq) * 2); o2[ni] = mfma16(bb, a, o2[ni]); } }
    const float wi = MW[t];
    const f32x4 dp = *(const LAS f32x4*)(DENP + t * 4);
    const float den = ((dp[0] + dp[1]) + (dp[2] + dp[3])) + wi * DQN[t];
    const float inv = 1.0f / fmaxf(fabsf(den), __expf(-MM[t]));
    const size_t tok = (size_t)(n * CH + t);
    float ss = 0.f;
#pragma unroll
    for (int ni = 0; ni < 8; ++ni) { const int dv = 128 * wc + 16 * ni + 4 * fq;
        const u32x2 mo = *(const u32x2*)(C.Z + tok * ZW + ZC_MO + h * 256 + dv);
        f32x4 v = (o1[ni] + o2[ni] * wi) * inv;
        v[0] *= sigmoid_f(bflo(mo.x)); v[1] *= sigmoid_f(bfhi(mo.x)); v[2] *= sigmoid_f(bflo(mo.y)); v[3] *= sigmoid_f(bfhi(mo.y));
        o1[ni] = v; ss += (v[0] * v[0] + v[1] * v[1]) + (v[2] * v[2] + v[3] * v[3]); }
    ss += shx(ss, 16, lane); ss += shx(ss, 32, lane);
    if (fq == 0) RS[wc * 64 + t] = ss;
    __syncthreads();
    const float rstd = 1.0f / sqrtf((RS[t] + RS[64 + t]) * (1.0f / 256.0f) + EPS);
#pragma unroll
    for (int ni = 0; ni < 8; ++ni) { const int dv = 128 * wc + 16 * ni + 4 * fq; const f32x4 gn = *(const f32x4*)(C.ml_norm + h * 256 + dv);
        const f32x4 v = o1[ni] * rstd * gn;
        *(u32x2*)(C.OB + tok * OBW + OB_O + 1024 + h * 256 + dv) = (u32x2){pk2(v[0], v[1]), pk2(v[2], v[3])}; }
    __syncthreads();
}

#ifndef SCAN_U
#define SCAN_U 8
#endif
DI void scan_phase(const MixCtx& C, int tid) {
    const int NS = 2 * 65536;
    for (int slot = opaque_bx() * 512 + tid; slot < NS; slot += opaque_g() * 512) {
        const int br = slot >> 16, s = slot & 65535, h = s >> 14, dv = (s >> 6) & 255, dkp = s & 63;
        const size_t e0 = (size_t)h * NCH * 32768 + (size_t)dv * 128 + 2 * dkp;
        if (br == 0) {
            float s0 = 0.f, s1 = 0.f;
            for (int n0 = 0; n0 < NCH; n0 += SCAN_U) {
                f32x2 d[SCAN_U], dec[SCAN_U];
#pragma unroll
                for (int u = 0; u < SCAN_U; ++u) { const unsigned dw = *(const unsigned*)(C.DS + e0 + (size_t)(n0 + u) * 32768); d[u] = (f32x2){bflo(dw), bfhi(dw)}; dec[u] = *(const f32x2*)(C.DECAY + (size_t)(h * NCH + n0 + u) * 128 + 2 * dkp); }
#pragma unroll
                for (int u = 0; u < SCAN_U; ++u) { *(unsigned*)(C.SP + e0 + (size_t)(n0 + u) * 32768) = pk2(s0, s1); s0 = dec[u].x * s0 + d[u].x; s1 = dec[u].y * s1 + d[u].y; }
            }
        } else {
            float c0 = 0.f, c1 = 0.f, nn0 = 0.f, nn1 = 0.f, m = -1e30f;
            for (int n0 = 0; n0 < NCH; n0 += SCAN_U) {
                f32x2 d[SCAN_U], dn[SCAN_U]; float fl[SCAN_U], gl[SCAN_U];
#pragma unroll
                for (int u = 0; u < SCAN_U; ++u) { const unsigned dw = *(const unsigned*)(C.DC + e0 + (size_t)(n0 + u) * 32768); d[u] = (f32x2){bflo(dw), bfhi(dw)}; fl[u] = C.FL[h * NCH + n0 + u]; gl[u] = C.GG[h * NCH + n0 + u];
                    dn[u] = (dv == 0) ? *(const f32x2*)(C.DN + (size_t)(h * NCH + n0 + u) * 128 + 2 * dkp) : (f32x2){0.f, 0.f}; }
#pragma unroll
                for (int u = 0; u < SCAN_U; ++u) { *(unsigned*)(C.CP + e0 + (size_t)(n0 + u) * 32768) = pk2(c0, c1);
                    if (dv == 0) { *(f32x2*)(C.NP + (size_t)(h * NCH + n0 + u) * 128 + 2 * dkp) = (f32x2){nn0, nn1}; if (dkp == 0) C.MP[h * NCH + n0 + u] = m; }
                    const float mn = fmaxf(fl[u] + m, gl[u]); const float a = __expf(fl[u] + m - mn), bb = __expf(gl[u] - mn);
                    c0 = a * c0 + bb * d[u].x; c1 = a * c1 + bb * d[u].y; nn0 = a * nn0 + bb * dn[u].x; nn1 = a * nn1 + bb * dn[u].y; m = mn; }
            }
        }
    }
}

DI void mem_unit(const MixCtx& C, LAS unsigned char* lds, int h, int rb, int tid) {
    const int lane = tid & 63, w = __builtin_amdgcn_readfirstlane(tid >> 6), fr = lane & 15, fq = lane >> 4, wr = w >> 1, wc = w & 1, t = 16 * wr + fr;
    LAS unsigned char* QL = lds; LAS unsigned char* PL = lds + 33792; LAS unsigned char* KV = lds + 67584;
    LAS float* RMX = (LAS float*)(lds + L_MISC); LAS float* RSM = RMX + 128;
#pragma unroll
    for (int i = 0; i < 4; ++i) { const int id = tid + 512 * i, row = id >> 5, cc = id & 31;
        *(LAS u32x4*)(QL + row * ROW264 + cc * 16) = *(const u32x4*)(C.Z + (size_t)(rb * 64 + row) * ZW + ZC_XQ + h * 256 + cc * 8); }
    f32x4 s[8];
#pragma unroll
    for (int ni = 0; ni < 8; ++ni) s[ni] = (f32x4){0.f, 0.f, 0.f, 0.f};
#pragma unroll
    for (int half = 0; half < 2; ++half) {
        copy_256x128(C.KM + h * 256 + half * 128, 4096, KV, tid);
        __syncthreads();
#pragma unroll
        for (int ks = 0; ks < 4; ++ks) { const bf16x8 a = *(const LAS bf16x8*)(QL + t * ROW264 + (128 * half + 32 * ks + 8 * fq) * 2);
#pragma unroll
            for (int ni = 0; ni < 8; ++ni) { const bf16x8 bb = *(const LAS bf16x8*)(KV + (128 * wc + 16 * ni + fr) * ROW136 + (32 * ks + 8 * fq) * 2); s[ni] = mfma16(bb, a, s[ni]); } }
        __syncthreads();
    }
    float mx = -3.0e38f;
#pragma unroll
    for (int ni = 0; ni < 8; ++ni) { s[ni] = s[ni] * 0.0625f; mx = fmaxf(mx, fmaxf(fmaxf(s[ni][0], s[ni][1]), fmaxf(s[ni][2], s[ni][3]))); }
    mx = fmaxf(mx, shx(mx, 16, lane)); mx = fmaxf(mx, shx(mx, 32, lane));
    if (fq == 0) RMX[wc * 64 + t] = mx;
    copy_256x128(C.VMT + (size_t)(h * 256) * 256, 256, KV, tid);
    __syncthreads();
    mx = fmaxf(RMX[t], RMX[64 + t]);
    float sm = 0.f;
#pragma unroll
    for (int ni = 0; ni < 8; ++ni) {
#pragma unroll
        for (int r = 0; r < 4; ++r) { s[ni][r] = __expf(s[ni][r] - mx); sm += s[ni][r]; } }
    sm += shx(sm, 16, lane); sm += shx(sm, 32, lane);
    if (fq == 0) RSM[wc * 64 + t] = sm;
    __syncthreads();
    const float inv = 1.0f / (RSM[t] + RSM[64 + t]);
#pragma unroll
    for (int ni = 0; ni < 8; ++ni) { const f32x4 p = s[ni] * inv; *(LAS u32x2*)(PL + t * ROW264 + (128 * wc + 16 * ni + 4 * fq) * 2) = (u32x2){pk2(p[0], p[1]), pk2(p[2], p[3])}; }
    f32x4 o[8];
#pragma unroll
    for (int ni = 0; ni < 8; ++ni) o[ni] = (f32x4){0.f, 0.f, 0.f, 0.f};
#pragma unroll
    for (int half = 0; half < 2; ++half) {
        if (half == 1) copy_256x128(C.VMT + (size_t)(h * 256) * 256 + 128, 256, KV, tid);
        __syncthreads();
#pragma unroll
        for (int ks = 0; ks < 4; ++ks) { const bf16x8 a = *(const LAS bf16x8*)(PL + t * ROW264 + (128 * half + 32 * ks + 8 * fq) * 2);
#pragma unroll
            for (int ni = 0; ni < 8; ++ni) { const bf16x8 bb = *(const LAS bf16x8*)(KV + (128 * wc + 16 * ni + fr) * ROW136 + (32 * ks + 8 * fq) * 2); o[ni] = mfma16(bb, a, o[ni]); } }
        __syncthreads();
    }
    const size_t tok = (size_t)(rb * 64 + t);
#pragma unroll
    for (int ni = 0; ni < 8; ++ni) { const int d = 128 * wc + 16 * ni + 4 * fq; *(u32x2*)(C.OB + tok * OBW + OB_O + 2048 + h * 256 + d) = (u32x2){pk2(o[ni][0], o[ni][1]), pk2(o[ni][2], o[ni][3])}; }
}

#ifndef GEMM_ALIGN
#define GEMM_ALIGN true
#endif
#ifndef REP_PRO
#define REP_PRO 1
#endif
#ifndef REP_MIXA
#define REP_MIXA 1
#endif
#ifndef REP_SCAN
#define REP_SCAN 1
#endif
#ifndef REP_MIXB
#define REP_MIXB 1
#endif
#ifndef REP_FF1
#define REP_FF1 1
#endif
#ifndef REP_NORM
#define REP_NORM 1
#endif
#ifndef WGM_IN
#define WGM_IN PG8_WGM
#endif
#ifndef WGM_BR
#define WGM_BR PG8_WGM
#endif
#ifndef WGM_OUT
#define WGM_OUT PG8_WGM
#endif
#ifndef WGM_F1
#define WGM_F1 8
#endif
#ifndef WGM_F2
#define WGM_F2 PG8_WGM
#endif
#ifndef REP_GLAA
#define REP_GLAA 1
#endif
#ifndef REP_MEM
#define REP_MEM 1
#endif
#ifndef REP_GLAB
#define REP_GLAB 1
#endif
#ifndef REP_GATE
#define REP_GATE 1
#endif
#ifndef REP_BR
#define REP_BR 1
#endif
#ifndef GEMM_SP2
#define GEMM_SP2 true
#endif
constexpr int L_PTR = L_BARW + 256;
DI unsigned long long tab_ld(LAS unsigned char* lds, int k) {
    const unsigned long long v = *(volatile LAS unsigned long long*)(lds + L_PTR + 8 * k);
    const unsigned lo = __builtin_amdgcn_readfirstlane((unsigned)v), hi = __builtin_amdgcn_readfirstlane((unsigned)(v >> 32));
    return ((unsigned long long)hi << 32) | lo;
}
DI const float* tab_in(LAS unsigned char* lds, int k) { return (const float*)(const GAS float*)tab_ld(lds, k); }
DI unsigned char* tab_ws(LAS unsigned char* lds) { return (unsigned char*)(GAS unsigned char*)tab_ld(lds, 24); }
DI void grid_bar(LAS unsigned char* lds) {
    XcdBarrier b; b.bar = (unsigned*)(tab_ws(lds) + WS_CTL) + CW_BAR; b.x = xb_xcc_id(); b.st = (volatile LAS unsigned*)(lds + L_BARW);
    xcd_barrier(b);
}
DI void make_ctx(MixCtx& C, LAS unsigned char* lds, int l) {
    unsigned char* ws = tab_ws(lds);
    C.Z = (const bf16_t*)(ws + WS_Z); C.OB = (bf16_t*)(ws + WS_OB);
    C.wa = tab_in(lds, I_W_GLA_A) + (size_t)l * 16 * 512; C.ba = tab_in(lds, I_B_GLA_A) + l * 512; C.gla_norm = tab_in(lds, I_GLA_NORM) + l * 1024;
    C.conv_w = tab_in(lds, I_CONV_W) + (size_t)l * 4 * 1024; C.conv_b = tab_in(lds, I_CONV_B) + l * 1024; C.b_i = tab_in(lds, I_B_ML_I) + l * 4; C.b_f = tab_in(lds, I_B_ML_F) + l * 4; C.ml_norm = tab_in(lds, I_ML_NORM) + l * 1024;
    C.BG = (float*)(ws + WS_BG); C.DS = (bf16_t*)(ws + WS_DS); C.DC = (bf16_t*)(ws + WS_DC); C.SP = (bf16_t*)(ws + WS_SP); C.CP = (bf16_t*)(ws + WS_CP);
    C.DECAY = (float*)(ws + WS_SMALL + SM_DECAY); C.DN = (float*)(ws + WS_SMALL + SM_DN); C.NP = (float*)(ws + WS_SMALL + SM_NP);
    C.GG = (float*)(ws + WS_SMALL + SM_GG); C.FL = (float*)(ws + WS_SMALL + SM_FL); C.MP = (float*)(ws + WS_SMALL + SM_MP);
    C.KM = (const bf16_t*)(ws + WS_KM) + l * 1024; C.VMT = (const bf16_t*)(ws + WS_VMT) + (size_t)l * 1024 * 256;
}

__global__ void __launch_bounds__(512, 2) trunk_fwd(Params p) {
    extern __shared__ __attribute__((aligned(16))) unsigned char lds_raw[];
    LAS unsigned char* lds0 = (LAS unsigned char*)lds_raw;
    {
        LAS unsigned char* lds = lds0;
        const int tid0 = threadIdx.x;
        if (tid0 < 64) ((LAS unsigned*)(lds + L_BARW))[tid0] = 0u;
        if (tid0 < 23) *(LAS unsigned long long*)(lds + L_PTR + 8 * tid0) = (unsigned long long)p.in[tid0];
        if (tid0 == 23) *(LAS unsigned long long*)(lds + L_PTR + 8 * 23) = (unsigned long long)p.out;
        if (tid0 == 24) *(LAS unsigned long long*)(lds + L_PTR + 8 * 24) = (unsigned long long)p.ws;
        __syncthreads();
        (void)xcd_barrier_post((unsigned*)(p.ws + WS_CTL) + CW_BAR, (volatile LAS unsigned*)(lds + L_BARW));
    }
#define TID (opaque_tid())
#define LANE (opaque_tid() & 63)
#define WAVE (__builtin_amdgcn_readfirstlane(opaque_tid() >> 6))
#define GW (opaque_bx() * NWAVES + WAVE)
#define NGW (opaque_g() * NWAVES)

    for (int rep = 0; rep < REP_PRO; ++rep) {
        LAS unsigned char* lds = opaque_lds(lds0); unsigned char* ws = tab_ws(lds);
        bf16_t* WIN = (bf16_t*)(ws + WS_WIN);
        const int lane = LANE, wave = WAVE;
        LAS float* scr = (LAS float*)(lds + wave * 16640);
        constexpr int IT_IN = 64 * 117, IT_BR = 16 * 64, IT_G = 4 * 64, IT_OUT = 64 * 64, IT_F1 = 64 * 256, IT_F2 = 256 * 64, IT_MK = 64 * 16;
        constexpr int E_IN = 4 * IT_IN, E_BR = E_IN + 12 * IT_BR, E_G = E_BR + 12 * IT_G, E_OUT = E_G + 4 * IT_OUT, E_F1 = E_OUT + 4 * IT_F1, E_F2 = E_F1 + 4 * IT_F2, E_MK = E_F2 + 4 * IT_MK, E_MV = E_MK + 4 * IT_MK;
        for (int it = GW; it < E_MV; it += NGW) {
            if (it < E_IN) { const int l = it / IT_IN, r = it - l * IT_IN; transpose_item(tab_in(lds, I_W_IN) + (size_t)l * DM * IN_W, DM, IN_W, WIN + (size_t)l * ZW * PW, PW, 0, 0, true, scr, r, lane, tab_in(lds, I_NORM_MIX) + l * DM); }
            else if (it < E_BR) { const int q = it - E_IN, lj = q / IT_BR, r = q - lj * IT_BR, l = lj / 3, j = lj - 3 * l; transpose_item(tab_in(lds, I_W_BRANCH) + (size_t)lj * 1024 * DM, 1024, DM, (bf16_t*)(ws + WS_WBR) + (size_t)l * DM * OBW, OBW, OB_O + j * 1024, 0, false, scr, r, lane); }
            else if (it < E_G) { const int q = it - E_BR, lj = q / IT_G, r = q - lj * IT_G, l = lj / 3, j = lj - 3 * l; transpose_item(tab_in(lds, I_W_GATE) + (size_t)lj * 256 * DM, 256, DM, (bf16_t*)(ws + WS_WBR) + (size_t)l * DM * OBW, OBW, j * 256, 0, false, scr, r, lane); }
            else if (it < E_OUT) { const int q = it - E_G, l = q / IT_OUT, r = q - l * IT_OUT; transpose_item(tab_in(lds, I_W_OUT) + (size_t)l * DM * DM, DM, DM, (bf16_t*)(ws + WS_WOUT) + (size_t)l * DM * PW, PW, 0, 0, false, scr, r, lane); }
            else if (it < E_F1) { const int q = it - E_OUT, l = q / IT_F1, r = q - l * IT_F1; transpose_item(tab_in(lds, I_W_FF1) + (size_t)l * DM * DFF, DM, DFF, (bf16_t*)(ws + WS_W1) + (size_t)l * DFF * PW, PW, 0, 0, false, scr, r, lane, tab_in(lds, I_NORM_FFN) + l * DM); }
            else if (it < E_F2) { const int q = it - E_F1, l = q / IT_F2, r = q - l * IT_F2; transpose_item(tab_in(lds, I_W_FF2) + (size_t)l * DFF * DM, DFF, DM, (bf16_t*)(ws + WS_W2) + (size_t)l * DM * PU, PU, 0, 0, false, scr, r, lane); }
            else if (it < E_MK) { const int q = it - E_F2, l = q / IT_MK, r = q - l * IT_MK; transpose_item(tab_in(lds, I_W_MEM_K) + (size_t)l * DM * 1024, DM, 1024, (bf16_t*)(ws + WS_WMK), DM, 0, l * 1024, false, scr, r, lane); }
            else { const int q = it - E_MK, l = q / IT_MK, r = q - l * IT_MK; transpose_item(tab_in(lds, I_W_MEM_V) + (size_t)l * DM * 1024, DM, 1024, (bf16_t*)(ws + WS_WMV), DM, 0, l * 1024, false, scr, r, lane); }
        }
        constexpr int PADCH = (ZW - IN_W) * PW / 8;
        for (int i = opaque_bx() * 512 + TID; i < NL * PADCH; i += opaque_g() * 512) { const int l = i / PADCH, r = i - l * PADCH; *(u32x4*)(WIN + (size_t)l * ZW * PW + (size_t)IN_W * PW + (size_t)r * 8) = (u32x4){0u, 0u, 0u, 0u}; }
        for (int m = GW; m < SEQ; m += NGW) row_bf16_ss(tab_in(lds, I_X) + (size_t)m * DM, (bf16_t*)(ws + WS_H) + (size_t)m * PW, (u64_t*)(ws + WS_SS) + m, lane);
        for (int m = GW; m < MEML; m += NGW) rmsnorm_row<false>(tab_in(lds, I_MEM) + (size_t)m * DM, tab_in(lds, I_MEM_NORM), (bf16_t*)(ws + WS_MEMN) + (size_t)m * DM, lane);
    }
    grid_bar(opaque_lds(lds0));
    for (int l = 0; l < NL; ++l) {
        {
            LAS unsigned char* lds = opaque_lds(lds0); unsigned char* ws = tab_ws(lds);
            pg8::Gemm g{(const bf16_t*)(ws + WS_H), (const bf16_t*)(ws + WS_WIN) + (size_t)l * ZW * PW, opq(SEQ), opq(ZW), opq(DM), opq(PW), opq(PW)}; pg8::StaticOrder S; S.init(opq(SEQ), opq(ZW), opaque_g(), opaque_bx(), opq(WGM_IN)); pg8::EpiBf16<0> E{(bf16_t*)(ws + WS_Z), ZW, nullptr, (const u64_t*)(ws + WS_SS) + (size_t)(2 * l) * SEQ, (bf16_t*)(ws + WS_OB), OBW, ZC_GATE / 256};
            pg8::gemm_phase<pg8::EpiBf16<0>, pg8::StaticOrder, GEMM_ALIGN, GEMM_SP2>(lds, g, S, E);
        }
        if (l == 0) {
            const int kvc = (opaque_g() >= 256 && opaque_bx() >= 128) ? opaque_bx() - 128 : opaque_bx() + (1 << 20) * (opaque_g() >= 256 ? 1 : 0);
        {
            LAS unsigned char* lds = opaque_lds(lds0); unsigned char* ws = tab_ws(lds);
        { pg8::Gemm g{(const bf16_t*)(ws + WS_MEMN), (const bf16_t*)(ws + WS_WMK), opq(MEML), opq(DM), opq(DM), opq(DM), opq(DM)}; pg8::StaticOrder S; S.init(opq(MEML), opq(DM), opaque_g(), kvc); pg8::EpiBf16<0> E{(bf16_t*)(ws + WS_KM), DM, nullptr, nullptr, nullptr, 0, -1};
          pg8::gemm_phase<pg8::EpiBf16<0>, pg8::StaticOrder, GEMM_ALIGN, GEMM_SP2>(lds, g, S, E); }
    }
        {
            LAS unsigned char* lds = opaque_lds(lds0); unsigned char* ws = tab_ws(lds);
        { pg8::Gemm g{(const bf16_t*)(ws + WS_WMV), (const bf16_t*)(ws + WS_MEMN), opq(DM), opq(MEML), opq(DM), opq(DM), opq(DM)}; pg8::StaticOrder S; S.init(opq(DM), opq(MEML), opaque_g(), kvc - 16); pg8::EpiBf16<0> E{(bf16_t*)(ws + WS_VMT), MEML, nullptr, nullptr, nullptr, 0, -1};
          pg8::gemm_phase<pg8::EpiBf16<0>, pg8::StaticOrder, GEMM_ALIGN, GEMM_SP2>(lds, g, S, E); }
    }
        }
        grid_bar(opaque_lds(lds0));
        {
            LAS unsigned char* lds = opaque_lds(lds0); MixCtx C; make_ctx(C, lds, l); const int tid = TID;
            for (int rep = 0; rep < REP_MIXA; ++rep) {
            for (int r2 = 0; r2 < REP_GLAA; ++r2) for (int i = opaque_bx(); i < 4 * NCH; i += opaque_g()) gla_A_unit(C, lds, i >> 8, i & 255, tid);
            for (int i = opaque_bx(); i < 4 * NCH; i += opaque_g()) ml_A_unit(C, lds, i >> 8, i & 255, tid);
            for (int r2 = 0; r2 < REP_MEM; ++r2) for (int i = opaque_bx(); i < 4 * NCH; i += opaque_g()) mem_unit(C, lds, i >> 8, i & 255, tid);
            }
        }
        grid_bar(opaque_lds(lds0));
        { LAS unsigned char* lds = opaque_lds(lds0); MixCtx C; make_ctx(C, lds, l); for (int rep = 0; rep < REP_SCAN; ++rep) scan_phase(C, TID); }
        grid_bar(opaque_lds(lds0));
        {
            LAS unsigned char* lds = opaque_lds(lds0); MixCtx C; make_ctx(C, lds, l); const int tid = TID;
            for (int rep = 0; rep < REP_MIXB; ++rep) {
            for (int r2 = 0; r2 < REP_GLAB; ++r2) for (int i = opaque_bx(); i < 4 * NCH; i += opaque_g()) gla_B_unit(C, lds, i >> 8, i & 255, tid);
            for (int i = opaque_bx(); i < 4 * NCH; i += opaque_g()) ml_B_unit(C, lds, i >> 8, i & 255, tid);
            }
        }
        grid_bar(opaque_lds(lds0));
        for (int rep = 0; rep < REP_BR; ++rep) {
            LAS unsigned char* lds = opaque_lds(lds0); unsigned char* ws = tab_ws(lds);
            pg8::Gemm g{(const bf16_t*)(ws + WS_OB), (const bf16_t*)(ws + WS_WBR) + (size_t)l * DM * OBW, opq(SEQ), opq(DM), opq(OBW), opq(OBW), opq(OBW)}; pg8::BranchOrder S; S.init(opq(SEQ), opq(DM), opaque_g(), opaque_bx(), opq(WGM_BR)); pg8::EpiBranch E{(bf16_t*)(ws + WS_Y), PW, (bf16_t*)(ws + WS_GT), tab_in(lds, I_B_GATE) + (size_t)l * GTW};
            pg8::gemm_phase<pg8::EpiBranch, pg8::BranchOrder, GEMM_ALIGN, GEMM_SP2>(lds, g, S, E);
        }
        grid_bar(opaque_lds(lds0));
        {
            LAS unsigned char* lds = opaque_lds(lds0); unsigned char* ws = tab_ws(lds);
            const float* Xin = (l == 0) ? tab_in(lds, I_X) : (const float*)(ws + WS_X);
            pg8::Gemm g{(const bf16_t*)(ws + WS_Y), (const bf16_t*)(ws + WS_WOUT) + (size_t)l * DM * PW, opq(SEQ), opq(DM), opq(DM), opq(PW), opq(PW)}; pg8::StaticOrder S; S.init(opq(SEQ), opq(DM), opaque_g(), opaque_bx(), opq(WGM_OUT)); pg8::EpiResid E{Xin, (float*)(ws + WS_X), DM, (bf16_t*)(ws + WS_H), (u64_t*)(ws + WS_SS) + (size_t)(2 * l + 1) * SEQ, PW};
            pg8::gemm_phase<pg8::EpiResid, pg8::StaticOrder, GEMM_ALIGN, GEMM_SP2>(lds, g, S, E);
        }
        grid_bar(opaque_lds(lds0));
        for (int rep = 0; rep < REP_FF1; ++rep) {
            LAS unsigned char* lds = opaque_lds(lds0); unsigned char* ws = tab_ws(lds);
            pg8::Gemm g{(const bf16_t*)(ws + WS_H), (const bf16_t*)(ws + WS_W1) + (size_t)l * DFF * PW, opq(SEQ), opq(DFF), opq(DM), opq(PW), opq(PW)}; pg8::StaticOrder S; S.init(opq(SEQ), opq(DFF), opaque_g(), opaque_bx(), opq(WGM_F1)); pg8::EpiBf16<1> E{(bf16_t*)(ws + WS_U), PU, nullptr, (const u64_t*)(ws + WS_SS) + (size_t)(2 * l + 1) * SEQ, nullptr, 0, -1};
            pg8::gemm_phase<pg8::EpiBf16<1>, pg8::StaticOrder, GEMM_ALIGN, GEMM_SP2>(lds, g, S, E);
        }
        grid_bar(opaque_lds(lds0));
        {
            LAS unsigned char* lds = opaque_lds(lds0); unsigned char* ws = tab_ws(lds);
            pg8::Gemm g{(const bf16_t*)(ws + WS_U), (const bf16_t*)(ws + WS_W2) + (size_t)l * DM * PU, opq(SEQ), opq(DM), opq(DFF), opq(PU), opq(PU)}; pg8::StaticOrder S; S.init(opq(SEQ), opq(DM), opaque_g(), opaque_bx(), opq(WGM_F2)); pg8::EpiResid E{(const float*)(ws + WS_X), (float*)(ws + WS_X), DM, (bf16_t*)(ws + WS_H), (u64_t*)(ws + WS_SS) + (size_t)(2 * l + 2) * SEQ, PW};
            pg8::gemm_phase<pg8::EpiResid, pg8::StaticOrder, GEMM_ALIGN, GEMM_SP2>(lds, g, S, E);
        }
        grid_bar(opaque_lds(lds0));
    }
    {
        LAS unsigned char* lds = opaque_lds(lds0); unsigned char* ws = tab_ws(lds);
        const float* X = (const float*)(ws + WS_X); const float* gain = tab_in(lds, I_FINAL_NORM); float* out = (float*)(GAS float*)tab_ld(lds, 23); const int lane = LANE;
        const u64_t* ssf = (const u64_t*)(ws + WS_SS) + (size_t)8 * SEQ;
        for (int m = GW; m < SEQ; m += NGW) row_scale_f32(X + (size_t)m * DM, gain, ss_to_f(ssf[m]), out + (size_t)m * DM, lane);
    }
}

extern "C" void kernel_launch(void* const* d_in, const int* in_sizes, int n_in, void* d_out, int out_size, void* d_ws, size_t ws_size, hipStream_t stream) {
    static int grid = 0;
    if (grid == 0) {
        if (n_in != 23 || out_size != SEQ * DM || ws_size < WS_END) { fprintf(stderr, "kernel_launch: unexpected shapes (n_in %d out %d ws %zu, need %zu)\n", n_in, out_size, ws_size, (size_t)WS_END); grid = -1; return; }
        int dev = 0, cus = 0, per_cu = 0;
        if (hipGetDevice(&dev) != hipSuccess || hipDeviceGetAttribute(&cus, hipDeviceAttributeMultiprocessorCount, dev) != hipSuccess) { grid = -1; return; }
        if (hipFuncSetAttribute((const void*)trunk_fwd, hipFuncAttributeMaxDynamicSharedMemorySize, LDS_BYTES) != hipSuccess) { fprintf(stderr, "kernel_launch: hipFuncSetAttribute failed\n"); grid = -1; return; }
        if (hipOccupancyMaxActiveBlocksPerMultiprocessor(&per_cu, (const void*)trunk_fwd, 512, LDS_BYTES) != hipSuccess || per_cu < 1) { fprintf(stderr, "kernel_launch: occupancy query says %d\n", per_cu); (void)hipGetLastError(); }
        grid = cus;
    }
    if (grid < 0) return;
    if (hipMemsetAsync((char*)d_ws + WS_CTL, 0, CTL_ZERO_BYTES, stream) != hipSuccess) return;
    if (hipMemsetAsync((char*)d_ws + WS_SS, 0, SS_ZERO_BYTES, stream) != hipSuccess) return;
    Params p{};
    for (int i = 0; i < 23; ++i) p.in[i] = (const float*)d_in[i];
    p.out = (float*)d_out; p.ws = (unsigned char*)d_ws;
    hipLaunchKernelGGL(trunk_fwd, dim3(grid), dim3(512), LDS_BYTES, stream, p);
}
```

```cpp
#include <hip/hip_runtime.h>
#include <cstdio>
#include <cstdint>

#define DI __device__ __forceinline__
#define GAS __attribute__((address_space(1)))
#define LAS __attribute__((address_space(3)))
typedef unsigned short bf16_t;
typedef short bf16x8 __attribute__((ext_vector_type(8)));
typedef float f32x4 __attribute__((ext_vector_type(4)));
typedef float f32x2 __attribute__((ext_vector_type(2)));
typedef unsigned u32x4 __attribute__((ext_vector_type(4)));
typedef unsigned u32x2 __attribute__((ext_vector_type(2)));

constexpr int SEQ = 16384, DM = 4096, DFF = 16384, NL = 4, MEML = 256, CH = 64, NCH = SEQ / CH;
constexpr int IN_W = 7448, ZW = 7680;
constexpr int ZC_GQ = 0, ZC_GK = 512, ZC_GV = 1024, ZC_GG = 2048, ZC_MQK = 3072, ZC_MV = 4096, ZC_MO = 5120, ZC_XQ = 6144, ZC_GATE = 7168, ZC_GA = 7424, ZC_MI = 7440, ZC_MF = 7444;
constexpr int OBW = 3840, OB_O = 768;
constexpr int GTW = 12288;
constexpr float EPS = 1e-6f;
#ifndef PITCH_PAD
#define PITCH_PAD 64
#endif
constexpr int PW = DM + PITCH_PAD, PU = DFF + PITCH_PAD;

constexpr size_t MiB = 1u << 20;
constexpr size_t WS_CTL = 0, CTL_ZERO_BYTES = 1 * MiB;
constexpr size_t WS_WIN = 1 * MiB, WS_WBR = 245 * MiB, WS_WOUT = 365 * MiB, WS_W1 = 495 * MiB, WS_W2 = 1015 * MiB;
constexpr size_t WS_WMK = 1529 * MiB, WS_WMV = 1561 * MiB, WS_MEMN = 1593 * MiB, WS_KM = 1595 * MiB, WS_VMT = 1597 * MiB;
constexpr size_t WS_X = 1599 * MiB, WS_H = 1855 * MiB, WS_Z = 1985 * MiB, WS_GT = 2225 * MiB, WS_U = WS_Z  ;
constexpr size_t WS_OB = 2609 * MiB, WS_Y = 2729 * MiB, WS_DS = 2859 * MiB, WS_SP = 2987 * MiB, WS_DC = 3051 * MiB, WS_CP = 3179 * MiB;
constexpr size_t WS_SMALL = 3243 * MiB, WS_SS = 3245 * MiB, SS_ZERO_BYTES = 2 * MiB, WS_BG = 3247 * MiB, WS_END = 3279 * MiB;
static_assert(PITCH_PAD <= 64, "buffer sizes below assume at most 64 elements of row padding");
static_assert(WS_WIN + (size_t)NL * ZW * PW * 2 <= WS_WBR && WS_WBR + (size_t)NL * DM * OBW * 2 <= WS_WOUT && WS_WOUT + (size_t)NL * DM * PW * 2 <= WS_W1 && WS_W1 + (size_t)NL * DFF * PW * 2 <= WS_W2 && WS_W2 + (size_t)NL * DM * PU * 2 <= WS_WMK, "weight map");
static_assert(WS_H + (size_t)SEQ * PW * 2 <= WS_Z && WS_Y + (size_t)SEQ * PW * 2 <= WS_DS, "activation map");
static_assert(WS_OB + (size_t)SEQ * OBW * 2 <= WS_Y, "OB size");
constexpr size_t SM_DECAY = 0, SM_DN = 512 * 1024, SM_NP = 1024 * 1024, SM_GG = 1536 * 1024, SM_FL = 1536 * 1024 + 4096, SM_MP = 1536 * 1024 + 8192;
static_assert(WS_U + (size_t)SEQ * PU * 2 <= WS_OB, "U overlay");
constexpr int CW_BAR = 4096;
static_assert(9 * (size_t)SEQ * 8 <= SS_ZERO_BYTES, "SS region");
typedef unsigned long long u64_t;
DI float ss_to_f(u64_t v) { return (float)v * (1.0f / 16777216.0f); }

constexpr int LDS_BYTES = 147456;
constexpr int L_ST = 0, L_VT = 69632, L_Q = 106496, L_K = 123904, L_MISC = 141312, L_BARW = 146432;
constexpr int ROW72 = 144, ROW136 = 272, ROW264 = 528;
constexpr int NWAVES = 8;

DI float bf2f(unsigned v) { return __uint_as_float(v << 16); }
DI float bflo(unsigned w) { return __uint_as_float(w << 16); }
DI float bfhi(unsigned w) { return __uint_as_float(w & 0xffff0000u); }
typedef __bf16 bf16x2_t __attribute__((ext_vector_type(2)));
DI unsigned pk2(float lo, float hi) { const f32x2 v = {lo, hi}; const bf16x2_t b = __builtin_convertvector(v, bf16x2_t); return __builtin_bit_cast(unsigned, b); }
DI float sigmoid_f(float x) { return __builtin_amdgcn_rcpf(1.0f + __expf(-x)); }
DI float silu_f(float x) { return x * sigmoid_f(x); }
DI float log_sigmoid_f(float x) { return fminf(x, 0.f) - __logf(1.0f + __expf(-fabsf(x))); }
DI float shx(float v, int o, int lane) { return __int_as_float(__builtin_amdgcn_ds_bpermute((lane ^ o) << 2, __float_as_int(v))); }
DI float shi(float v, int src) { return __int_as_float(__builtin_amdgcn_ds_bpermute(src << 2, __float_as_int(v))); }
DI float wave_sum(float v, int lane) {
#pragma unroll
    for (int o = 1; o < 64; o <<= 1) v += shx(v, o, lane);
    return v;
}
DI float wave_max(float v, int lane) {
#pragma unroll
    for (int o = 1; o < 64; o <<= 1) v = fmaxf(v, shx(v, o, lane));
    return v;
}
DI float wave_scan_sum(float v, int lane) {
#pragma unroll
    for (int o = 1; o < 64; o <<= 1) { const float t = shi(v, lane >= o ? lane - o : lane); if (lane >= o) v += t; }
    return v;
}
DI float wave_scan_max(float v, int lane) {
#pragma unroll
    for (int o = 1; o < 64; o <<= 1) { const float t = shi(v, lane >= o ? lane - o : lane); if (lane >= o) v = fmaxf(v, t); }
    return v;
}
DI f32x4 mfma16(bf16x8 a, bf16x8 b, f32x4 c) { return __builtin_amdgcn_mfma_f32_16x16x32_bf16(a, b, c, 0, 0, 0); }
DI int opaque_tid() { int t = (int)threadIdx.x; asm volatile("" : "+v"(t)); return t; }
DI int opaque_bx() { int b = (int)blockIdx.x; asm volatile("" : "+s"(b)); return b; }
DI LAS unsigned char* opaque_lds(LAS unsigned char* p) { asm volatile("" : "+s"(p)); return p; }
DI int opq(int v) { asm volatile("" : "+s"(v)); return v; }
DI int opaque_g() { int g = (int)gridDim.x; asm volatile("" : "+s"(g)); return g; }

namespace pg8 {
#define PG8_LAS __attribute__((address_space(3)))
constexpr int BM = 256, BK = 64, HALF = 128, HTB = HALF * BK * 2  , STAGE_BYTES = 8 * HTB, NXCD = 8;
#ifndef PG8_WGM
#define PG8_WGM 4
#endif
constexpr int WGM = PG8_WGM;

__host__ __device__ __forceinline__ int lds_byte(int r, int c) { const int st = (r >> 4) * 2 + (c >> 5), rr = r & 15, cc = c & 31, ob = rr * 64 + cc * 2; return st * 1024 + (ob ^ (((ob >> 9) & 1) << 5)); }
__host__ __device__ __forceinline__ void stage_rc(int b, int& R, int& C) { const int st = b / 1024, sb = b % 1024, swz = sb ^ (((sb >> 9) & 1) << 5); R = (st >> 1) * 16 + swz / 64; C = (st & 1) * 32 + (swz % 64) / 2; }
__host__ __device__ __forceinline__ int perm32(int rho) { const int n = rho >> 4, i = rho & 15; return 8 * (i >> 2) + 4 * n + (i & 3); }

struct Unit { int pm, pn, kind; };
struct Gemm { const bf16_t* A; const bf16_t* Bt; int M, N, K, lda, ldb; };

struct StaticOrder {
    int nM, nN, nwg, G, c, wgm;
    __host__ __device__ void init(int M, int N, int G_, int c_, int wgm_ = WGM) { nM = M / BM; nN = N / BM; nwg = nM * nN; G = G_; c = c_; wgm = wgm_; }
    __host__ __device__ bool next(int i, Unit& u) const {
        const long L = (long)i * G + c; if (c < 0 || L >= nwg) return false;
        int wgid = (int)L; { const int q = nwg / NXCD, r = nwg % NXCD, xcd = wgid % NXCD, off = wgid / NXCD; wgid = (xcd < r ? xcd * (q + 1) : r * (q + 1) + (xcd - r) * q) + off; }
        const int nig = wgm * nN, gid = wgid / nig, fm = gid * wgm, gsz = (nM - fm) < wgm ? (nM - fm) : wgm;
        u.pm = fm + ((wgid % nig) % gsz); u.pn = (wgid % nig) / gsz; u.kind = 0; return true;
    }
    __device__ __forceinline__ void a_ready(const Unit&) const {}
    __device__ __forceinline__ void done(const Unit&) const {}
    __device__ __forceinline__ int nt(const Unit&, int nt_default) const { return nt_default; }
    __device__ __forceinline__ int koff(const Unit&) const { return 0; }
};
struct BranchOrder : StaticOrder {
    __host__ __device__ bool next(int i, Unit& u) const { if (!StaticOrder::next(i >> 2, u)) return false; u.kind = i & 3; return true; }
    __device__ __forceinline__ int nt(const Unit& u, int) const { return u.kind < 3 ? 4 : 48; }
    __device__ __forceinline__ int koff(const Unit& u) const { return u.kind < 3 ? 256 * u.kind : 768; }
};

template <int ACT  > struct EpiBf16 {
    static constexpr bool PERM = true, AFTER_DRAIN = false, HOOK = false;
    bf16_t* O; int ldc; const float* bias; const unsigned long long* ss; bf16_t* O2; int ld2, pn2;
    __device__ __forceinline__ void operator()(const f32x4 (&acc)[2][2][4][2], const Unit& u, int wr, int wc, int fr, int fq) const {
        const int row0 = u.pm * BM + wr * 64 + fr, col0 = u.pn * BM + wc * 32 + 8 * fq;
        f32x4 bv[2][2];
#pragma unroll
        for (int bj = 0; bj < 2; ++bj)
#pragma unroll
            for (int n = 0; n < 2; ++n) bv[bj][n] = (ACT == 2) ? *(const f32x4*)(bias + col0 + bj * HALF + 4 * n) : (f32x4){0.f, 0.f, 0.f, 0.f};
#pragma unroll
        for (int ai = 0; ai < 2; ++ai)
#pragma unroll
            for (int m = 0; m < 4; ++m) { bf16_t* rowp = O + (size_t)(row0 + ai * HALF + m * 16) * ldc + col0;
                const bool redir = (ACT == 0) && O2 != nullptr && u.pn == pn2;
                if (redir) rowp = O2 + (size_t)(row0 + ai * HALF + m * 16) * ld2 + (col0 - u.pn * BM);
                float rs = 1.f; if (ACT != 2) { if (ss) rs = 1.0f / sqrtf((float)ss[row0 + ai * HALF + m * 16] * (1.0f / 16777216.0f) * (1.0f / DM) + EPS); }
#pragma unroll
                for (int bj = 0; bj < 2; ++bj) { f32x4 v0 = acc[ai][bj][m][0], v1 = acc[ai][bj][m][1];
                    if (ACT != 2) { v0 = v0 * rs; v1 = v1 * rs; }
                    if (ACT == 1) {
#pragma unroll
                        for (int j = 0; j < 4; ++j) { const float a = fmaxf(v0[j], 0.f), b = fmaxf(v1[j], 0.f); v0[j] = a * a; v1[j] = b * b; } }
                    if (ACT == 2) { v0 = v0 + bv[bj][0]; v1 = v1 + bv[bj][1];
#pragma unroll
                        for (int j = 0; j < 4; ++j) { v0[j] = sigmoid_f(fminf(fmaxf(v0[j], -30.f), 30.f)); v1[j] = sigmoid_f(fminf(fmaxf(v1[j], -30.f), 30.f)); } }
                    u32x4 w; w.x = pk2(v0[0], v0[1]); w.y = pk2(v0[2], v0[3]); w.z = pk2(v1[0], v1[1]); w.w = pk2(v1[2], v1[3]);
                    *(u32x4*)(rowp + bj * HALF) = w;
                    if (redir) { *(u32x4*)(rowp + bj * HALF + 256) = w; *(u32x4*)(rowp + bj * HALF + 512) = w; } } }
    }
    __device__ __forceinline__ bool hook_at(const Unit&, int) const { return false; }
    __device__ __forceinline__ void hook(f32x4 (&)[2][2][4][2], const Unit&, int, int, int, int, int) const {}
};
struct EpiResid {
    static constexpr bool PERM = true, AFTER_DRAIN = false, HOOK = false;
    const float* in; float* out; int ldc; bf16_t* xb; unsigned long long* ss; int ldxb;
    __device__ __forceinline__ void operator()(const f32x4 (&acc)[2][2][4][2], const Unit& u, int wr, int wc, int fr, int fq) const {
        const int row0 = u.pm * BM + wr * 64 + fr, col0 = u.pn * BM + wc * 32 + 8 * fq, lane = fq * 16 + fr;
#pragma unroll
        for (int ai = 0; ai < 2; ++ai) {
            f32x4 r[4][2][2];
#pragma unroll
            for (int m = 0; m < 4; ++m) { const size_t off = (size_t)(row0 + ai * HALF + m * 16) * ldc + col0;
#pragma unroll
                for (int bj = 0; bj < 2; ++bj)
#pragma unroll
                    for (int n = 0; n < 2; ++n) r[m][bj][n] = *(const f32x4*)(in + off + bj * HALF + n * 4); }
#pragma unroll
            for (int m = 0; m < 4; ++m) { const int row = row0 + ai * HALF + m * 16; const size_t off = (size_t)row * ldc + col0;
                float sq = 0.f;
#pragma unroll
                for (int bj = 0; bj < 2; ++bj) { const f32x4 o0 = r[m][bj][0] + acc[ai][bj][m][0], o1 = r[m][bj][1] + acc[ai][bj][m][1];
                    *(f32x4*)(out + off + bj * HALF) = o0; *(f32x4*)(out + off + bj * HALF + 4) = o1;
                    sq += (o0[0] * o0[0] + o0[1] * o0[1]) + (o0[2] * o0[2] + o0[3] * o0[3]) + (o1[0] * o1[0] + o1[1] * o1[1]) + (o1[2] * o1[2] + o1[3] * o1[3]);
                    u32x4 w; w.x = pk2(o0[0], o0[1]); w.y = pk2(o0[2], o0[3]); w.z = pk2(o1[0], o1[1]); w.w = pk2(o1[2], o1[3]);
                    *(u32x4*)(xb + (size_t)row * ldxb + col0 + bj * HALF) = w; }
                sq += shx(sq, 16, lane); sq += shx(sq, 32, lane);
                if (fq == 0) (void)__hip_atomic_fetch_add(ss + row, (unsigned long long)(sq * 16777216.0f), __ATOMIC_RELAXED, __HIP_MEMORY_SCOPE_AGENT); }
            asm volatile("" ::: "memory"); }
    }
    __device__ __forceinline__ bool hook_at(const Unit&, int) const { return false; }
    __device__ __forceinline__ void hook(f32x4 (&)[2][2][4][2], const Unit&, int, int, int, int, int) const {}
};
struct EpiBranch {
    static constexpr bool PERM = true, AFTER_DRAIN = false, HOOK = true;
    bf16_t* O; int ldc; bf16_t* GT; const float* bias;
    __device__ __forceinline__ bool hook_at(const Unit& u, int t) const { return u.kind == 3 && (t == 16 || t == 32); }
    __device__ __forceinline__ void hook(f32x4 (&acc)[2][2][4][2], const Unit& u, int t, int, int, int, int) const {
        const int tid_ = opaque_tid(), wid_ = tid_ >> 6, wr = wid_ >> 2, wc = wid_ & 3, fr = tid_ & 15, fq = (tid_ >> 4) & 3;
        const int row0 = u.pm * BM + wr * 64 + fr, col0 = u.pn * BM + wc * 32 + 8 * fq;
        const bf16_t* ga = GT + (size_t)(t == 16 ? 0 : DM); const bf16_t* gb = ga + DM;
#pragma unroll
        for (int ai = 0; ai < 2; ++ai) {
            u32x4 a[4][2], b[4][2];
#pragma unroll
            for (int m = 0; m < 4; ++m) { const size_t off = (size_t)(row0 + ai * HALF + m * 16) * GTW + col0;
#pragma unroll
                for (int bj = 0; bj < 2; ++bj) { a[m][bj] = *(const u32x4*)(ga + off + bj * HALF); b[m][bj] = *(const u32x4*)(gb + off + bj * HALF); } }
#pragma unroll
            for (int m = 0; m < 4; ++m)
#pragma unroll
                for (int bj = 0; bj < 2; ++bj) { const u32x4 x = a[m][bj], y = b[m][bj];
                    f32x4 r0, r1;
                    r0[0] = bflo(y.x) * __builtin_amdgcn_rcpf(bflo(x.x)); r0[1] = bfhi(y.x) * __builtin_amdgcn_rcpf(bfhi(x.x));
                    r0[2] = bflo(y.y) * __builtin_amdgcn_rcpf(bflo(x.y)); r0[3] = bfhi(y.y) * __builtin_amdgcn_rcpf(bfhi(x.y));
                    r1[0] = bflo(y.z) * __builtin_amdgcn_rcpf(bflo(x.z)); r1[1] = bfhi(y.z) * __builtin_amdgcn_rcpf(bfhi(x.z));
                    r1[2] = bflo(y.w) * __builtin_amdgcn_rcpf(bflo(x.w)); r1[3] = bfhi(y.w) * __builtin_amdgcn_rcpf(bfhi(x.w));
                    acc[ai][bj][m][0] = acc[ai][bj][m][0] * r0; acc[ai][bj][m][1] = acc[ai][bj][m][1] * r1; }
            asm volatile("" ::: "memory"); }
    }
    __device__ __forceinline__ void operator()(const f32x4 (&acc)[2][2][4][2], const Unit& u, int wr, int wc, int fr, int fq) const {
        const int row0 = u.pm * BM + wr * 64 + fr, col0 = u.pn * BM + wc * 32 + 8 * fq;
        if (u.kind < 3) {
            bf16_t* gd = GT + (size_t)u.kind * DM; const float* bj_ = bias + (size_t)u.kind * DM + col0;
            f32x4 bv[2][2];
#pragma unroll
            for (int bj = 0; bj < 2; ++bj)
#pragma unroll
                for (int n = 0; n < 2; ++n) bv[bj][n] = *(const f32x4*)(bj_ + bj * HALF + 4 * n);
#pragma unroll
            for (int ai = 0; ai < 2; ++ai)
#pragma unroll
                for (int m = 0; m < 4; ++m) { const size_t off = (size_t)(row0 + ai * HALF + m * 16) * GTW + col0;
#pragma unroll
                    for (int bj = 0; bj < 2; ++bj) { f32x4 v0 = acc[ai][bj][m][0] + bv[bj][0], v1 = acc[ai][bj][m][1] + bv[bj][1];
#pragma unroll
                        for (int e = 0; e < 4; ++e) { v0[e] = 1.0f + __expf(-fminf(fmaxf(v0[e], -30.f), 30.f)); v1[e] = 1.0f + __expf(-fminf(fmaxf(v1[e], -30.f), 30.f)); }
                        u32x4 w; w.x = pk2(v0[0], v0[1]); w.y = pk2(v0[2], v0[3]); w.z = pk2(v1[0], v1[1]); w.w = pk2(v1[2], v1[3]);
                        *(u32x4*)(gd + off + bj * HALF) = w; } }
        } else {
            const bf16_t* gc = GT + 2 * DM;
            u32x4 g[2][4][2];
#pragma unroll
            for (int ai = 0; ai < 2; ++ai)
#pragma unroll
                for (int m = 0; m < 4; ++m)
#pragma unroll
                    for (int bj = 0; bj < 2; ++bj) g[ai][m][bj] = *(const u32x4*)(gc + (size_t)(row0 + ai * HALF + m * 16) * GTW + col0 + bj * HALF);
#pragma unroll
            for (int ai = 0; ai < 2; ++ai)
#pragma unroll
                for (int m = 0; m < 4; ++m) { const size_t r = (size_t)(row0 + ai * HALF + m * 16);
#pragma unroll
                    for (int bj = 0; bj < 2; ++bj) { const u32x4 gg = g[ai][m][bj];
                        const f32x4 v0 = acc[ai][bj][m][0], v1 = acc[ai][bj][m][1];
                        u32x4 w; w.x = pk2(v0[0] * __builtin_amdgcn_rcpf(bflo(gg.x)), v0[1] * __builtin_amdgcn_rcpf(bfhi(gg.x))); w.y = pk2(v0[2] * __builtin_amdgcn_rcpf(bflo(gg.y)), v0[3] * __builtin_amdgcn_rcpf(bfhi(gg.y)));
                        w.z = pk2(v1[0] * __builtin_amdgcn_rcpf(bflo(gg.z)), v1[1] * __builtin_amdgcn_rcpf(bfhi(gg.z))); w.w = pk2(v1[2] * __builtin_amdgcn_rcpf(bflo(gg.w)), v1[3] * __builtin_amdgcn_rcpf(bfhi(gg.w)));
                        *(u32x4*)(O + r * ldc + col0 + bj * HALF) = w; } }
        }
    }
};

template <class Epi, class Sched, bool ALIGN_EPI = false, bool SP2 = false>
__device__ __forceinline__ void gemm_phase(PG8_LAS unsigned char* lds, const Gemm g, const Sched& S, const Epi& E) {
    const int tid = opaque_tid(), wid = __builtin_amdgcn_readfirstlane(tid >> 6), lane = tid & 63, wr = wid >> 2, wc = wid & 3, fr = lane & 15, fq = lane >> 4;
    const int K = g.K, nt_default = K / BK;
    unsigned voffA[2], voffB[2];
#pragma unroll
    for (int i = 0; i < 2; ++i) { int R, C; stage_rc(tid * 16 + i * 8192, R, C); const int Rb = Epi::PERM ? ((R & ~31) + perm32(R & 31)) : R;
        voffA[i] = (unsigned)(R * g.lda + C) * 2u; voffB[i] = (unsigned)(Rb * g.ldb + C) * 2u; }
    const unsigned kstep = (unsigned)(BK * 2);
    const unsigned hstepA = (unsigned)HALF * g.lda * 2, hstepB = (unsigned)HALF * g.ldb * 2;
    const unsigned tstepA = 2 * hstepA, tstepB = 2 * hstepB;
    const __amdgpu_buffer_rsrc_t rA = __builtin_amdgcn_make_buffer_rsrc((void*)g.A, 0, (int)0xffffffffu, 0x00020000), rB = __builtin_amdgcn_make_buffer_rsrc((void*)g.Bt, 0, (int)0xffffffffu, 0x00020000);
    const unsigned ldsw = (unsigned)wid * 1024u;
    const int aoff = lds_byte(wr * 64 + fr, fq * 8), boff = lds_byte(wc * 32 + fr, fq * 8);
#define PG8_SA(b, h) (((b) * 2 + (h)) * HTB)
#define PG8_SB(b, h) ((4 + (b) * 2 + (h)) * HTB)
#define PG8_STAGE(bufoff, gbase, voff) do { _Pragma("unroll") for (int _i = 0; _i < 2; ++_i) \
        __builtin_amdgcn_raw_ptr_buffer_load_lds(PG8_RSRC_##voff, (PG8_LAS void*)(lds + (bufoff) + ldsw + _i * 8192), 16, (int)(voff)[_i], (int)(gbase), 0, 0); } while (0)
#define PG8_RSRC_voffA rA
#define PG8_RSRC_voffB rB
#define PG8_LDA(dst, b, h) do { _Pragma("unroll") for (int m = 0; m < 4; ++m) _Pragma("unroll") for (int k = 0; k < 2; ++k) dst[m][k] = *(const PG8_LAS bf16x8*)(lds + PG8_SA(b, h) + aoff + m * 2048 + k * 1024); } while (0)
#define PG8_LDB(dst, b, h) do { _Pragma("unroll") for (int n = 0; n < 2; ++n) _Pragma("unroll") for (int k = 0; k < 2; ++k) dst[n][k] = *(const PG8_LAS bf16x8*)(lds + PG8_SB(b, h) + boff + n * 2048 + k * 1024); } while (0)
#ifndef PG8_BAL
#define PG8_BAL 1
#endif
#ifndef PG8_STAGE_LATE
#define PG8_STAGE_LATE 0
#endif
#ifndef PG8_PRIO
#define PG8_PRIO 1
#endif
#define PG8_MMA(ai, bj, At, Bt) do { if (PG8_PRIO) __builtin_amdgcn_s_setprio(PG8_PRIO); _Pragma("unroll") for (int m = 0; m < 4; ++m) _Pragma("unroll") for (int n = 0; n < 2; ++n) _Pragma("unroll") for (int k = 0; k < 2; ++k) \
        acc[ai][bj][m][n] = __builtin_amdgcn_mfma_f32_16x16x32_bf16(Bt[n][k], At[m][k], acc[ai][bj][m][n], 0, 0, 0); if (PG8_PRIO) __builtin_amdgcn_s_setprio(0); } while (0)
#define PG8_WAIT_V(n) asm volatile("s_waitcnt vmcnt(" #n ")" ::: "memory")
#define PG8_WAIT_L(n) asm volatile("s_waitcnt lgkmcnt(" #n ")" ::: "memory")
#define PG8_BAR __builtin_amdgcn_s_barrier()
#define PG8_SCHED __builtin_amdgcn_sched_barrier(0)
    Unit cur, nxt; int ui = 0;
    if (!S.next(0, cur)) return;
    f32x4 acc[2][2][4][2];
#pragma unroll
    for (int a = 0; a < 2; ++a)
#pragma unroll
        for (int b = 0; b < 2; ++b)
#pragma unroll
            for (int m = 0; m < 4; ++m)
#pragma unroll
                for (int n = 0; n < 2; ++n) acc[a][b][m][n] = (f32x4){0.f, 0.f, 0.f, 0.f};
    bf16x8 At[4][2], B0[2][2], B1[2][2];
    unsigned cA = (unsigned)cur.pm * tstepA + (unsigned)S.koff(cur) * 2u, cB = (unsigned)cur.pn * tstepB + (unsigned)S.koff(cur) * 2u;
    int nt = S.nt(cur, nt_default);
    S.a_ready(cur);
    if constexpr (SP2) {
        PG8_STAGE(PG8_SB(0, 0), cB, voffB); PG8_STAGE(PG8_SB(0, 1), cB + hstepB, voffB); PG8_STAGE(PG8_SA(0, 0), cA, voffA); PG8_STAGE(PG8_SA(0, 1), cA + hstepA, voffA);
        if (wr == 1) PG8_BAR;
        PG8_WAIT_V(2); PG8_BAR;
#if PG8_BAL == 2
        PG8_STAGE(PG8_SA(1, 0), cA + kstep, voffA); PG8_STAGE(PG8_SB(1, 0), cB + kstep, voffB);
        PG8_WAIT_V(6); PG8_BAR;
#elif PG8_BAL
        PG8_STAGE(PG8_SB(1, 0), cB + kstep, voffB); PG8_STAGE(PG8_SB(1, 1), cB + hstepB + kstep, voffB);
        PG8_WAIT_V(4); PG8_BAR;
#else
        PG8_STAGE(PG8_SB(1, 0), cB + kstep, voffB); PG8_STAGE(PG8_SA(1, 0), cA + kstep, voffA); PG8_STAGE(PG8_SB(1, 1), cB + hstepB + kstep, voffB);
        PG8_WAIT_V(6); PG8_BAR;
#endif
    } else {
        PG8_STAGE(PG8_SB(0, 0), cB, voffB); PG8_STAGE(PG8_SA(0, 0), cA, voffA); PG8_STAGE(PG8_SB(0, 1), cB + hstepB, voffB); PG8_STAGE(PG8_SA(0, 1), cA + hstepA, voffA);
        if (wr == 1) PG8_BAR;
        PG8_WAIT_V(4); PG8_BAR;
        PG8_STAGE(PG8_SB(1, 0), cB + kstep, voffB); PG8_STAGE(PG8_SA(1, 0), cA + kstep, voffA); PG8_STAGE(PG8_SB(1, 1), cB + hstepB + kstep, voffB);
        PG8_WAIT_V(6); PG8_BAR;
    }
    for (;;) {
        const bool has_next = S.next(ui + 1, nxt);
        const unsigned nA = has_next ? (unsigned)nxt.pm * tstepA + (unsigned)S.koff(nxt) * 2u : cA, nB = has_next ? (unsigned)nxt.pn * tstepB + (unsigned)S.koff(nxt) * 2u : cB;
        for (int t = 0; t < nt; t += 2) {
            const bool last = (t == nt - 2);
            if constexpr (Epi::HOOK) { if (E.hook_at(cur, t)) E.hook(acc, cur, t, wr, wc, fr, fq); }
            const unsigned a1 = cA + (unsigned)(t + 1) * kstep;
            const unsigned a2 = last ? nA : cA + (unsigned)(t + 2) * kstep, b2 = last ? nB : cB + (unsigned)(t + 2) * kstep;
            const unsigned a3 = a2 + kstep, b3 = b2 + kstep;
            if (last && has_next) S.a_ready(nxt);
            if constexpr (SP2) {
#if PG8_BAL == 2
            { const unsigned b1 = cB + (unsigned)(t + 1) * kstep;
            PG8_LDB(B0, 0, 0); PG8_LDB(B1, 0, 1); PG8_SCHED; PG8_LDA(At, 0, 0); PG8_STAGE(PG8_SB(1, 1), b1 + hstepB, voffB); PG8_STAGE(PG8_SA(1, 1), a1 + hstepA, voffA);
            PG8_WAIT_V(8); PG8_WAIT_L(0); PG8_BAR; PG8_MMA(0, 0, At, B0); PG8_MMA(0, 1, At, B1); PG8_BAR; PG8_SCHED;
            PG8_LDA(At, 0, 1); PG8_STAGE(PG8_SA(0, 0), a2, voffA); PG8_STAGE(PG8_SB(0, 0), b2, voffB);
            PG8_WAIT_V(6); PG8_WAIT_L(0); PG8_BAR; PG8_MMA(1, 0, At, B0); PG8_MMA(1, 1, At, B1); PG8_BAR; PG8_SCHED;
            PG8_LDB(B0, 1, 0); PG8_LDB(B1, 1, 1); PG8_SCHED; PG8_LDA(At, 1, 0); PG8_STAGE(PG8_SB(0, 1), b2 + hstepB, voffB); PG8_STAGE(PG8_SA(0, 1), a2 + hstepA, voffA);
            PG8_WAIT_V(8); PG8_WAIT_L(0); PG8_BAR; PG8_MMA(0, 0, At, B0); PG8_MMA(0, 1, At, B1); PG8_BAR; PG8_SCHED;
            PG8_LDA(At, 1, 1); PG8_STAGE(PG8_SA(1, 0), a3, voffA); PG8_STAGE(PG8_SB(1, 0), b3, voffB);
            PG8_WAIT_V(6); PG8_WAIT_L(0); PG8_BAR; PG8_MMA(1, 0, At, B0); PG8_MMA(1, 1, At, B1); PG8_BAR; PG8_SCHED; }
#elif PG8_BAL
            PG8_LDB(B0, 0, 0); PG8_LDB(B1, 0, 1); PG8_SCHED; PG8_LDA(At, 0, 0); PG8_STAGE(PG8_SA(1, 0), a1, voffA); PG8_STAGE(PG8_SA(1, 1), a1 + hstepA, voffA);
            PG8_WAIT_V(8); PG8_WAIT_L(0); PG8_BAR; PG8_MMA(0, 0, At, B0); PG8_MMA(0, 1, At, B1); PG8_BAR; PG8_SCHED;
            PG8_LDA(At, 0, 1); PG8_STAGE(PG8_SB(0, 0), b2, voffB); PG8_STAGE(PG8_SB(0, 1), b2 + hstepB, voffB);
            PG8_WAIT_V(6); PG8_WAIT_L(0); PG8_BAR; PG8_MMA(1, 0, At, B0); PG8_MMA(1, 1, At, B1); PG8_BAR; PG8_SCHED;
            PG8_LDB(B0, 1, 0); PG8_LDB(B1, 1, 1); PG8_SCHED; PG8_LDA(At, 1, 0); PG8_STAGE(PG8_SA(0, 0), a2, voffA); PG8_STAGE(PG8_SA(0, 1), a2 + hstepA, voffA);
            PG8_WAIT_V(8); PG8_WAIT_L(0); PG8_BAR; PG8_MMA(0, 0, At, B0); PG8_MMA(0, 1, At, B1); PG8_BAR; PG8_SCHED;
            PG8_LDA(At, 1, 1); PG8_STAGE(PG8_SB(1, 0), b3, voffB); PG8_STAGE(PG8_SB(1, 1), b3 + hstepB, voffB);
            PG8_WAIT_V(6); PG8_WAIT_L(0); PG8_BAR; PG8_MMA(1, 0, At, B0); PG8_MMA(1, 1, At, B1); PG8_BAR; PG8_SCHED;
            (void)a3;
#else
#if PG8_STAGE_LATE
            PG8_LDB(B0, 0, 0); PG8_LDB(B1, 0, 1); PG8_SCHED; PG8_LDA(At, 0, 0); PG8_WAIT_L(0); PG8_SCHED; PG8_STAGE(PG8_SA(1, 1), a1 + hstepA, voffA);
            PG8_WAIT_V(8); PG8_BAR;
#else
            PG8_LDB(B0, 0, 0); PG8_LDB(B1, 0, 1); PG8_SCHED; PG8_LDA(At, 0, 0); PG8_STAGE(PG8_SA(1, 1), a1 + hstepA, voffA);
            PG8_WAIT_V(8); PG8_WAIT_L(0); PG8_BAR;
#endif
            PG8_MMA(0, 0, At, B0); PG8_MMA(0, 1, At, B1); PG8_BAR; PG8_SCHED;
#if PG8_STAGE_LATE
            PG8_LDA(At, 0, 1); PG8_WAIT_L(0); PG8_SCHED; PG8_STAGE(PG8_SB(0, 0), b2, voffB); PG8_STAGE(PG8_SB(0, 1), b2 + hstepB, voffB); PG8_STAGE(PG8_SA(0, 0), a2, voffA);
            PG8_WAIT_V(8); PG8_BAR;
#else
            PG8_LDA(At, 0, 1); PG8_STAGE(PG8_SB(0, 0), b2, voffB); PG8_STAGE(PG8_SB(0, 1), b2 + hstepB, voffB); PG8_STAGE(PG8_SA(0, 0), a2, voffA);
            PG8_WAIT_V(8); PG8_WAIT_L(0); PG8_BAR;
#endif
            PG8_MMA(1, 0, At, B0); PG8_MMA(1, 1, At, B1); PG8_BAR; PG8_SCHED;
#if PG8_STAGE_LATE
            PG8_LDB(B0, 1, 0); PG8_LDB(B1, 1, 1); PG8_SCHED; PG8_LDA(At, 1, 0); PG8_WAIT_L(0); PG8_SCHED; PG8_STAGE(PG8_SA(0, 1), a2 + hstepA, voffA);
            PG8_WAIT_V(8); PG8_BAR;
#else
            PG8_LDB(B0, 1, 0); PG8_LDB(B1, 1, 1); PG8_SCHED; PG8_LDA(At, 1, 0); PG8_STAGE(PG8_SA(0, 1), a2 + hstepA, voffA);
            PG8_WAIT_V(8); PG8_WAIT_L(0); PG8_BAR;
#endif
            PG8_MMA(0, 0, At, B0); PG8_MMA(0, 1, At, B1); PG8_BAR; PG8_SCHED;
#if PG8_STAGE_LATE
            PG8_LDA(At, 1, 1); PG8_WAIT_L(0); PG8_SCHED; PG8_STAGE(PG8_SB(1, 0), b3, voffB); PG8_STAGE(PG8_SB(1, 1), b3 + hstepB, voffB); PG8_STAGE(PG8_SA(1, 0), a3, voffA);
            PG8_WAIT_V(8); PG8_BAR;
#else
            PG8_LDA(At, 1, 1); PG8_STAGE(PG8_SB(1, 0), b3, voffB); PG8_STAGE(PG8_SB(1, 1), b3 + hstepB, voffB); PG8_STAGE(PG8_SA(1, 0), a3, voffA);
            PG8_WAIT_V(8); PG8_WAIT_L(0); PG8_BAR;
#endif
            PG8_MMA(1, 0, At, B0); PG8_MMA(1, 1, At, B1); PG8_BAR; PG8_SCHED;
#endif
            } else {
            PG8_LDB(B0, 0, 0); PG8_SCHED; PG8_LDA(At, 0, 0); PG8_STAGE(PG8_SA(1, 1), a1 + hstepA, voffA);
            PG8_WAIT_L(8); PG8_BAR; PG8_WAIT_L(0); PG8_MMA(0, 0, At, B0); PG8_BAR; PG8_SCHED;
            PG8_LDB(B1, 0, 1); PG8_STAGE(PG8_SB(0, 0), b2, voffB);
            PG8_BAR; PG8_WAIT_L(0); PG8_MMA(0, 1, At, B1); PG8_BAR;
            PG8_LDA(At, 0, 1); PG8_STAGE(PG8_SA(0, 0), a2, voffA);
            PG8_BAR; PG8_WAIT_L(0); PG8_MMA(1, 0, At, B0); PG8_BAR; PG8_SCHED;
            PG8_STAGE(PG8_SB(0, 1), b2 + hstepB, voffB);
            PG8_WAIT_V(6); PG8_BAR; PG8_MMA(1, 1, At, B1); PG8_BAR;
            PG8_LDB(B0, 1, 0); PG8_SCHED; PG8_LDA(At, 1, 0); PG8_STAGE(PG8_SA(0, 1), a2 + hstepA, voffA);
            PG8_WAIT_L(8); PG8_BAR; PG8_WAIT_L(0); PG8_MMA(0, 0, At, B0); PG8_BAR; PG8_SCHED;
            PG8_LDB(B1, 1, 1); PG8_STAGE(PG8_SB(1, 0), b3, voffB);
            PG8_BAR; PG8_WAIT_L(0); PG8_MMA(0, 1, At, B1); PG8_BAR;
            PG8_LDA(At, 1, 1); PG8_STAGE(PG8_SA(1, 0), a3, voffA);
            PG8_BAR; PG8_WAIT_L(0); PG8_MMA(1, 0, At, B0); PG8_BAR; PG8_SCHED;
            PG8_STAGE(PG8_SB(1, 1), b3 + hstepB, voffB);
            PG8_WAIT_V(6); PG8_BAR; PG8_MMA(1, 1, At, B1); PG8_BAR;
            }
        }
        if constexpr (ALIGN_EPI) { if (wr == 0) PG8_BAR; }
        E(acc, cur, wr, wc, fr, fq); S.done(cur);
        if (!has_next) break;
#pragma unroll
        for (int a = 0; a < 2; ++a)
#pragma unroll
            for (int b = 0; b < 2; ++b)
#pragma unroll
                for (int m = 0; m < 4; ++m)
#pragma unroll
                    for (int n = 0; n < 2; ++n) acc[a][b][m][n] = (f32x4){0.f, 0.f, 0.f, 0.f};
        cur = nxt; cA = nA; cB = nB; ++ui; nt = S.nt(cur, nt_default);
        if constexpr (ALIGN_EPI) { if (wr == 1) PG8_BAR; }
    }
    PG8_WAIT_V(0);
    if constexpr (!ALIGN_EPI) { if (wr == 0) PG8_BAR; }
    PG8_BAR;
#undef PG8_SA
#undef PG8_SB
#undef PG8_STAGE
#undef PG8_RSRC_voffA
#undef PG8_RSRC_voffB
#undef PG8_LDA
#undef PG8_LDB
#undef PG8_MMA
#undef PG8_WAIT_V
#undef PG8_WAIT_L
#undef PG8_BAR
#undef PG8_SCHED
}
}

#define XB_TMO      128
#define XB_XCNT(j)  (256  + 64 * (j))
#define XB_XSUB(j)  (1280 + 64 * (j))
#define XB_XGEN(j)  (2304 + 64 * (j))
#define XB_TOP      3328
#define XB_TOPGEN   3392
#define XCD_BAR_WORDS 3456
#define XB_SPIN_CAP (1u << 18)

__device__ __forceinline__ unsigned xb_ld(unsigned* p)              { return __hip_atomic_load(p, __ATOMIC_RELAXED, __HIP_MEMORY_SCOPE_AGENT); }
__device__ __forceinline__ unsigned xb_add(unsigned* p, unsigned v) { return __hip_atomic_fetch_add(p, v, __ATOMIC_RELAXED, __HIP_MEMORY_SCOPE_AGENT); }
__device__ __forceinline__ unsigned xb_xcc_id() { return (unsigned)__builtin_amdgcn_s_getreg((3 << 11) | 20) & 0xFu; }
#define XB_SPIN(cond, bar) do { unsigned _sp = 0; while (cond) { __builtin_amdgcn_s_sleep(1); \
    if ((++_sp & 255u) == 0u) { if (xb_ld(&(bar)[XB_TMO])) break; if (_sp > XB_SPIN_CAP) { atomicAdd(&(bar)[XB_TMO], 1u); break; } } } } while (0)

struct XcdBarrier {
    unsigned* bar; unsigned x;
    volatile LAS unsigned* st;
};
__device__ __forceinline__ XcdBarrier xcd_barrier_post(unsigned* bar, volatile LAS unsigned* st) {
    XcdBarrier b; b.bar = bar; b.x = xb_xcc_id(); b.st = st;
    if (threadIdx.x == 0) (void)xb_add(&bar[XB_XCNT(b.x)], 1u);
    return b;
}
__device__ __forceinline__ void xcd_barrier_complete(unsigned* bar, unsigned x, unsigned& nloc, unsigned& nx) {
    const unsigned G = gridDim.x * gridDim.y * gridDim.z;
    unsigned sum, cnt, mine, sp = 0u;
    for (;;) {
        sum = 0u; cnt = 0u; mine = 0u;
#pragma unroll
        for (unsigned j = 0; j < 16; ++j) { const unsigned c = xb_ld(&bar[XB_XCNT(j)]); sum += c; cnt += (c > 0u) ? 1u : 0u; mine = (j == x) ? c : mine; }
        if (sum == G) break;
        __builtin_amdgcn_s_sleep(1);
        if ((++sp & 255u) == 0u) { if (xb_ld(&bar[XB_TMO])) break; if (sp > XB_SPIN_CAP) { atomicAdd(&bar[XB_TMO], 1u); break; } }
    }
    nloc = mine > 0u ? mine : 1u; nx = cnt > 0u ? cnt : 1u;
}
__device__ __forceinline__ void xcd_barrier(const XcdBarrier& b) {
    asm volatile("s_waitcnt vmcnt(0)" ::: "memory");
    __syncthreads();
    if (threadIdx.x == 0) {
        unsigned* bar = b.bar;
        __builtin_amdgcn_s_waitcnt(0);
        unsigned nloc = b.st[0], nx = b.st[1];
        if (nloc == 0u) { xcd_barrier_complete(bar, b.x, nloc, nx); b.st[0] = nloc; b.st[1] = nx; }
        const unsigned old = xb_add(&bar[XB_XSUB(b.x)], 1u);
        const unsigned gen = old / nloc;
        if (old + 1u == (gen + 1u) * nloc) {
            __builtin_amdgcn_fence(__ATOMIC_RELEASE, "agent");
            asm volatile("s_waitcnt vmcnt(0)" ::: "memory");
            const unsigned og = xb_add(&bar[XB_TOP], 1u);
            const unsigned tg = og / nx;
            if (og + 1u == (tg + 1u) * nx) xb_add(&bar[XB_TOPGEN], 1u);
            else XB_SPIN(xb_ld(&bar[XB_TOPGEN]) == tg, bar);
            __builtin_amdgcn_fence(__ATOMIC_ACQUIRE, "agent");
            xb_add(&bar[XB_XGEN(b.x)], 1u);
            asm volatile("s_waitcnt vmcnt(0)" ::: "memory");
        } else {
            XB_SPIN(xb_ld(&bar[XB_XGEN(b.x)]) == gen, bar);
            __builtin_amdgcn_fence(__ATOMIC_ACQUIRE, "agent");
            asm volatile("s_waitcnt vmcnt(0)" ::: "memory");
        }
    }
    __syncthreads();
}

struct Params { const float* in[23]; float* out; unsigned char* ws; };
enum { I_X = 0, I_MEM, I_NORM_MIX, I_W_IN, I_W_GLA_A, I_B_GLA_A, I_GLA_NORM, I_CONV_W, I_CONV_B, I_B_ML_I, I_B_ML_F, I_ML_NORM, I_MEM_NORM, I_W_MEM_K, I_W_MEM_V, I_W_BRANCH, I_W_GATE, I_B_GATE, I_W_OUT, I_NORM_FFN, I_W_FF1, I_W_FF2, I_FINAL_NORM };

DI int win_row(int n) {
    if (n < 3072) return n;
    if (n < 3088) return ZC_GA + (n - 3072);
    if (n < 6160) return n - 16;
    if (n < 6168) return ZC_MI + (n - 6160);
    return n - 24;
}
DI void transpose_item(const float* __restrict__ W, int K, int N, bf16_t* __restrict__ WT, int ld_dst, int col_off, int row_off, bool remap, LAS float* scr, int item, int lane, const float* __restrict__ gain = nullptr) {
    const int nblk = (N + 63) >> 6, kb = item / nblk, nb = item - kb * nblk, k0 = kb << 6, n0 = nb << 6;
    const int a = lane & 15, q = lane >> 4, n4 = 4 * a;
    const bool ok = (n0 + n4) < N;
    f32x4 v[16];
#pragma unroll
    for (int i = 0; i < 16; ++i) { const int kk = 4 * i + q; v[i] = ok ? *(const f32x4*)(W + (size_t)(k0 + kk) * N + n0 + n4) : (f32x4){0.f, 0.f, 0.f, 0.f}; }
#pragma unroll
    for (int i = 0; i < 16; ++i) { const int kk = 4 * i + q;
#pragma unroll
        for (int e = 0; e < 4; ++e) scr[(n4 + e) * 65 + kk] = v[i][e]; }
    asm volatile("s_waitcnt lgkmcnt(0)" ::: "memory");
    const int c = lane & 7;
    f32x4 g0 = (f32x4){1.f, 1.f, 1.f, 1.f}, g1 = g0;
    if (gain) { g0 = *(const f32x4*)(gain + k0 + 8 * c); g1 = *(const f32x4*)(gain + k0 + 8 * c + 4); }
#pragma unroll
    for (int jj = 0; jj < 8; ++jj) { const int n = (lane >> 3) + 8 * jj; const LAS float* s = scr + n * 65 + 8 * c;
        u32x4 o; o.x = pk2(s[0] * g0[0], s[1] * g0[1]); o.y = pk2(s[2] * g0[2], s[3] * g0[3]); o.z = pk2(s[4] * g1[0], s[5] * g1[1]); o.w = pk2(s[6] * g1[2], s[7] * g1[3]);
        const int ng = n0 + n;
        if (ng < N) { const int row = row_off + (remap ? win_row(ng) : ng); *(u32x4*)(WT + (size_t)row * ld_dst + col_off + k0 + 8 * c) = o; } }
    asm volatile("s_waitcnt lgkmcnt(0)" ::: "memory");
}

template <bool OUT_F32> DI void rmsnorm_row(const float* __restrict__ xrow, const float* __restrict__ g, void* orow, int lane) {
    const f32x4* xr = (const f32x4*)xrow + lane; const f32x4* gr = (const f32x4*)g + lane;
    f32x4 v[16]; float s = 0.f;
#pragma unroll
    for (int j = 0; j < 16; ++j) { v[j] = xr[64 * j]; s += (v[j].x * v[j].x + v[j].y * v[j].y) + (v[j].z * v[j].z + v[j].w * v[j].w); }
    const float rstd = 1.0f / sqrtf(wave_sum(s, lane) * (1.0f / DM) + EPS);
#pragma unroll
    for (int j = 0; j < 16; ++j) { const f32x4 gg = gr[64 * j]; const f32x4 o = v[j] * rstd * gg;
        if (OUT_F32) ((f32x4*)orow)[lane + 64 * j] = o;
        else { u32x2 w; w.x = pk2(o.x, o.y); w.y = pk2(o.z, o.w); ((u32x2*)orow)[lane + 64 * j] = w; } }
}

DI void row_bf16_ss(const float* __restrict__ xrow, bf16_t* orow, unsigned long long* ss, int lane) {
    const f32x4* xr = (const f32x4*)xrow + lane; float s = 0.f;
#pragma unroll
    for (int j = 0; j < 16; ++j) { const f32x4 v = xr[64 * j]; s += (v.x * v.x + v.y * v.y) + (v.z * v.z + v.w * v.w);
        u32x2 w; w.x = pk2(v.x, v.y); w.y = pk2(v.z, v.w); ((u32x2*)orow)[lane + 64 * j] = w; }
    s = wave_sum(s, lane);
    if (lane == 0) *ss = (unsigned long long)(s * 16777216.0f);
}
DI void row_scale_f32(const float* __restrict__ xrow, const float* __restrict__ g, float ssv, float* orow, int lane) {
    const f32x4* xr = (const f32x4*)xrow + lane; const f32x4* gr = (const f32x4*)g + lane;
    const float rstd = 1.0f / sqrtf(ssv * (1.0f / DM) + EPS);
#pragma unroll
    for (int j = 0; j < 16; ++j) ((f32x4*)orow)[lane + 64 * j] = xr[64 * j] * rstd * gr[64 * j];
}

DI void fill_vT(const bf16_t* __restrict__ Zv, int n, int tg, int lane, LAS unsigned char* VT) {
#pragma unroll
    for (int i = 0; i < 2; ++i) { const int cp = lane + 64 * i; unsigned w[8];
#pragma unroll
        for (int j = 0; j < 8; ++j) w[j] = *(const unsigned*)(Zv + (size_t)(n * CH + 8 * tg + j) * ZW + 2 * cp);
        u32x4 lo, hi;
        lo.x = (w[0] & 0xffffu) | (w[1] << 16); lo.y = (w[2] & 0xffffu) | (w[3] << 16); lo.z = (w[4] & 0xffffu) | (w[5] << 16); lo.w = (w[6] & 0xffffu) | (w[7] << 16);
        hi.x = (w[0] >> 16) | (w[1] & 0xffff0000u); hi.y = (w[2] >> 16) | (w[3] & 0xffff0000u); hi.z = (w[4] >> 16) | (w[5] & 0xffff0000u); hi.w = (w[6] >> 16) | (w[7] & 0xffff0000u);
        *(LAS u32x4*)(VT + (2 * cp) * ROW72 + tg * 16) = lo; *(LAS u32x4*)(VT + (2 * cp + 1) * ROW72 + tg * 16) = hi; }
}
DI void state_mfma(const LAS unsigned char* VT, const LAS unsigned char* KT, bf16_t* __restrict__ OUT, int w, int lane) {
    const int fr = lane & 15, fq = lane >> 4;
    f32x4 acc[2][8];
#pragma unroll
    for (int mi = 0; mi < 2; ++mi)
#pragma unroll
        for (int ni = 0; ni < 8; ++ni) acc[mi][ni] = (f32x4){0.f, 0.f, 0.f, 0.f};
#pragma unroll
    for (int ks = 0; ks < 2; ++ks) {
        bf16x8 a[2];
#pragma unroll
        for (int mi = 0; mi < 2; ++mi) a[mi] = *(const LAS bf16x8*)(VT + (32 * w + 16 * mi + fr) * ROW72 + (32 * ks + 8 * fq) * 2);
#pragma unroll
        for (int ni = 0; ni < 8; ++ni) { const bf16x8 b = *(const LAS bf16x8*)(KT + (16 * ni + fr) * ROW72 + (32 * ks + 8 * fq) * 2);
#pragma unroll
            for (int mi = 0; mi < 2; ++mi) acc[mi][ni] = mfma16(b, a[mi], acc[mi][ni]); }
    }
#pragma unroll
    for (int mi = 0; mi < 2; ++mi)
#pragma unroll
        for (int ni = 0; ni < 8; ++ni) *(u32x2*)(OUT + (size_t)(32 * w + 16 * mi + fr) * 128 + 16 * ni + 4 * fq) = (u32x2){pk2(acc[mi][ni][0], acc[mi][ni][1]), pk2(acc[mi][ni][2], acc[mi][ni][3])};
}
DI void copy_256x128(const bf16_t* __restrict__ src, int gp, LAS unsigned char* dst, int tid) {
#pragma unroll
    for (int i = 0; i < 8; ++i) { const int id = tid + 512 * i, row = id >> 4, cc = id & 15;
        *(LAS u32x4*)(dst + row * ROW136 + cc * 16) = *(const u32x4*)(src + (size_t)row * gp + cc * 8); }
}

DI void ld_v(const bf16_t* __restrict__ Zv, int n, int tg, int lane, unsigned (&w)[2][8]) {
#pragma unroll
    for (int i = 0; i < 2; ++i)
#pragma unroll
        for (int j = 0; j < 8; ++j) w[i][j] = *(const unsigned*)(Zv + (size_t)(n * CH + 8 * tg + j) * ZW + 2 * (lane + 64 * i));
}
DI void st_vT(const unsigned (&w)[2][8], int tg, int lane, LAS unsigned char* VT) {
#pragma unroll
    for (int i = 0; i < 2; ++i) { const int cp = lane + 64 * i; u32x4 lo, hi;
        lo.x = (w[i][0] & 0xffffu) | (w[i][1] << 16); lo.y = (w[i][2] & 0xffffu) | (w[i][3] << 16); lo.z = (w[i][4] & 0xffffu) | (w[i][5] << 16); lo.w = (w[i][6] & 0xffffu) | (w[i][7] << 16);
        hi.x = (w[i][0] >> 16) | (w[i][1] & 0xffff0000u); hi.y = (w[i][2] >> 16) | (w[i][3] & 0xffff0000u); hi.z = (w[i][4] >> 16) | (w[i][5] & 0xffff0000u); hi.w = (w[i][6] >> 16) | (w[i][7] & 0xffff0000u);
        *(LAS u32x4*)(VT + (2 * cp) * ROW72 + tg * 16) = lo; *(LAS u32x4*)(VT + (2 * cp + 1) * ROW72 + tg * 16) = hi; }
}
DI void ld_256x128(const bf16_t* __restrict__ src, int gp, int tid, u32x4 (&r)[8]) {
#pragma unroll
    for (int i = 0; i < 8; ++i) { const int id = tid + 512 * i, row = id >> 4, cc = id & 15; r[i] = *(const u32x4*)(src + (size_t)row * gp + cc * 8); }
}
DI void st_256x128(const u32x4 (&r)[8], LAS unsigned char* dst, int tid) {
#pragma unroll
    for (int i = 0; i < 8; ++i) { const int id = tid + 512 * i, row = id >> 4, cc = id & 15; *(LAS u32x4*)(dst + row * ROW136 + cc * 16) = r[i]; }
}
DI void conv_ld(const bf16_t* __restrict__ Zc, int tok0, unsigned (&x)[11]) {
#pragma unroll
    for (int i = 0; i < 11; ++i) { const int tok = tok0 - 3 + i; x[i] = 0u; if (tok >= 0) x[i] = *(const unsigned*)(Zc + (size_t)tok * ZW); }
}
DI void conv_apply(const unsigned (&x)[11], const float* __restrict__ cw, const float* __restrict__ cb, float (&o0)[8], float (&o1)[8]) {
    f32x2 wj[4];
#pragma unroll
    for (int j = 0; j < 4; ++j) wj[j] = *(const f32x2*)(cw + j * 1024);
    const f32x2 bias = *(const f32x2*)cb;
#pragma unroll
    for (int j = 0; j < 8; ++j) { float y0 = bias.x, y1 = bias.y;
#pragma unroll
        for (int jj = 0; jj < 4; ++jj) { y0 += wj[jj].x * bflo(x[j + jj]); y1 += wj[jj].y * bfhi(x[j + jj]); }
        o0[j] = silu_f(y0); o1[j] = silu_f(y1); }
}
DI void gla_b(const bf16_t* __restrict__ Z, const float* __restrict__ wa, const float* __restrict__ ba, int h, int n, int tg, int c2, LAS float* TOT, float (&b)[8][2], float (&blast)[2]) {
    const int col = h * 128 + 2 * c2;
    float w0[16], w1[16];
#pragma unroll
    for (int r = 0; r < 16; ++r) { const f32x2 w = *(const f32x2*)(wa + r * 512 + col); w0[r] = w.x; w1[r] = w.y; }
    const f32x2 bb = *(const f32x2*)(ba + col);
    float c0 = 0.f, c1 = 0.f;
#pragma unroll
    for (int j = 0; j < 8; ++j) {
        const bf16_t* gp = Z + (size_t)(n * CH + 8 * tg + j) * ZW + ZC_GA;
        const u32x4 g0 = *(const u32x4*)gp, g1 = *(const u32x4*)(gp + 8);
        const float gv[16] = {bflo(g0.x), bfhi(g0.x), bflo(g0.y), bfhi(g0.y), bflo(g0.z), bfhi(g0.z), bflo(g0.w), bfhi(g0.w),
                              bflo(g1.x), bfhi(g1.x), bflo(g1.y), bfhi(g1.y), bflo(g1.z), bfhi(g1.z), bflo(g1.w), bfhi(g1.w)};
        float p0 = bb.x, p1 = bb.y;
#pragma unroll
        for (int r = 0; r < 16; ++r) { p0 += gv[r] * w0[r]; p1 += gv[r] * w1[r]; }
        c0 += log_sigmoid_f(p0) * (1.0f / 16.0f); c1 += log_sigmoid_f(p1) * (1.0f / 16.0f);
        b[j][0] = c0; b[j][1] = c1;
    }
    *(LAS f32x2*)(TOT + tg * 128 + 2 * c2) = (f32x2){c0, c1};
    __syncthreads();
    float pre0 = 0.f, pre1 = 0.f, t0 = 0.f, t1 = 0.f;
#pragma unroll
    for (int g = 0; g < 8; ++g) { const f32x2 t = *(const LAS f32x2*)(TOT + g * 128 + 2 * c2); if (g < tg) { pre0 += t.x; pre1 += t.y; } t0 += t.x; t1 += t.y; }
#pragma unroll
    for (int j = 0; j < 8; ++j) { b[j][0] += pre0; b[j][1] += pre1; }
    blast[0] = t0; blast[1] = t1;
}
DI void conv_silu8(const bf16_t* __restrict__ Zc, const float* __restrict__ cw, const float* __restrict__ cb, int tok0, float (&o0)[8], float (&o1)[8]) {
    float x0[11], x1[11];
#pragma unroll
    for (int i = 0; i < 11; ++i) { const int tok = tok0 - 3 + i; unsigned w = 0u; if (tok >= 0) w = *(const unsigned*)(Zc + (size_t)tok * ZW); x0[i] = bflo(w); x1[i] = bfhi(w); }
    f32x2 wj[4];
#pragma unroll
    for (int j = 0; j < 4; ++j) wj[j] = *(const f32x2*)(cw + j * 1024);
    const f32x2 bias = *(const f32x2*)cb;
#pragma unroll
    for (int j = 0; j < 8; ++j) { float y0 = bias.x, y1 = bias.y;
#pragma unroll
        for (int jj = 0; jj < 4; ++jj) { y0 += wj[jj].x * x0[j + jj]; y1 += wj[jj].y * x1[j + jj]; }
        o0[j] = silu_f(y0); o1[j] = silu_f(y1); }
}
DI void score_mfma(const LAS unsigned char* QL, const LAS unsigned char* KL, int w, int lane, f32x4 (&sacc)[2]) {
    const int fr = lane & 15, fq = lane >> 4, mi = w >> 1, ni0 = 2 * (w & 1);
    sacc[0] = (f32x4){0.f, 0.f, 0.f, 0.f}; sacc[1] = sacc[0];
#pragma unroll
    for (int ks = 0; ks < 4; ++ks) { const bf16x8 a = *(const LAS bf16x8*)(QL + (16 * mi + fr) * ROW136 + (32 * ks + 8 * fq) * 2);
#pragma unroll
        for (int jn = 0; jn < 2; ++jn) { const bf16x8 b = *(const LAS bf16x8*)(KL + (16 * (ni0 + jn) + fr) * ROW136 + (32 * ks + 8 * fq) * 2); sacc[jn] = mfma16(b, a, sacc[jn]); } }
}

struct MixCtx {
    const bf16_t* Z; bf16_t* OB;
    const float *wa, *ba, *gla_norm, *conv_w, *conv_b, *b_i, *b_f, *ml_norm;
    float *DECAY, *DN, *NP, *GG, *FL, *MP, *BG; bf16_t *DS, *DC, *SP, *CP;
    const bf16_t *KM, *VMT;
};

DI void gla_A_unit(const MixCtx& C, LAS unsigned char* lds, int h, int n, int tid) {
    const int lane = tid & 63, tg = __builtin_amdgcn_readfirstlane(tid >> 6), c2 = lane;
    LAS float* TOT = (LAS float*)(lds + L_MISC);
    LAS unsigned char* KT = lds + L_ST; LAS unsigned char* VT = lds + L_VT;
    unsigned kw[8], vw[2][8];
#pragma unroll
    for (int j = 0; j < 8; ++j) kw[j] = *(const unsigned*)(C.Z + (size_t)(n * CH + 8 * tg + j) * ZW + ZC_GK + h * 128 + 2 * c2);
    ld_v(C.Z + ZC_GV + h * 256, n, tg, lane, vw);
    float b[8][2], blast[2];
    gla_b(C.Z, C.wa, C.ba, h, n, tg, c2, TOT, b, blast);
    float k0[8], k1[8];
#pragma unroll
    for (int j = 0; j < 8; ++j) { k0[j] = bflo(kw[j]) * __expf(blast[0] - b[j][0]); k1[j] = bfhi(kw[j]) * __expf(blast[1] - b[j][1]);
        *(f32x2*)(C.BG + ((size_t)(h * NCH + n) * CH + 8 * tg + j) * 128 + 2 * c2) = (f32x2){b[j][0], b[j][1]}; }
    u32x4 lo, hi;
    lo.x = pk2(k0[0], k0[1]); lo.y = pk2(k0[2], k0[3]); lo.z = pk2(k0[4], k0[5]); lo.w = pk2(k0[6], k0[7]);
    hi.x = pk2(k1[0], k1[1]); hi.y = pk2(k1[2], k1[3]); hi.z = pk2(k1[4], k1[5]); hi.w = pk2(k1[6], k1[7]);
    *(LAS u32x4*)(KT + (2 * c2) * ROW72 + tg * 16) = lo; *(LAS u32x4*)(KT + (2 * c2 + 1) * ROW72 + tg * 16) = hi;
    if (tg == 0) *(f32x2*)(C.DECAY + (size_t)(h * NCH + n) * 128 + 2 * c2) = (f32x2){__expf(blast[0]), __expf(blast[1])};
    st_vT(vw, tg, lane, VT);
    __syncthreads();
    state_mfma(VT, KT, C.DS + (size_t)(h * NCH + n) * 32768, tg, lane);
    __syncthreads();
}

DI void gla_B_unit(const MixCtx& C, LAS unsigned char* lds, int h, int n, int tid) {
    const int lane = tid & 63, w = __builtin_amdgcn_readfirstlane(tid >> 6), tg = w, c2 = lane, fr = lane & 15, fq = lane >> 4;
    LAS float* RS = (LAS float*)(lds + L_MISC + 4096);
    LAS unsigned char* ST = lds + L_ST; LAS unsigned char* VT = lds + L_VT; LAS unsigned char* QL = lds + L_Q; LAS unsigned char* KL = lds + L_K;
    const int wr = w >> 1, wc = w & 1, t = 16 * wr + fr;
    const size_t tok = (size_t)(n * CH + t);
    u32x4 st[8]; f32x2 bq[8]; unsigned wq[8], wk[8], vw[2][8]; u32x2 gg[8]; f32x4 gn[8];
    ld_256x128(C.SP + (size_t)(h * NCH + n) * 32768, 128, tid, st);
#pragma unroll
    for (int j = 0; j < 8; ++j) { const size_t zr = (size_t)(n * CH + 8 * tg + j) * ZW;
        bq[j] = *(const f32x2*)(C.BG + ((size_t)(h * NCH + n) * CH + 8 * tg + j) * 128 + 2 * c2);
        wq[j] = *(const unsigned*)(C.Z + zr + ZC_GQ + h * 128 + 2 * c2); wk[j] = *(const unsigned*)(C.Z + zr + ZC_GK + h * 128 + 2 * c2); }
    ld_v(C.Z + ZC_GV + h * 256, n, tg, lane, vw);
#pragma unroll
    for (int ni = 0; ni < 8; ++ni) { const int dv = 128 * wc + 16 * ni + 4 * fq; gg[ni] = *(const u32x2*)(C.Z + tok * ZW + ZC_GG + h * 256 + dv); gn[ni] = *(const f32x4*)(C.gla_norm + h * 256 + dv); }
    const float qs = 0.08838834764831845f;
#pragma unroll
    for (int j = 0; j < 8; ++j) { const float e0 = __expf(bq[j].x), e1 = __expf(bq[j].y);
        *(LAS unsigned*)(QL + (8 * tg + j) * ROW136 + 4 * c2) = pk2(bflo(wq[j]) * qs * e0, bfhi(wq[j]) * qs * e1);
        *(LAS unsigned*)(KL + (8 * tg + j) * ROW136 + 4 * c2) = pk2(bflo(wk[j]) * __builtin_amdgcn_rcpf(e0), bfhi(wk[j]) * __builtin_amdgcn_rcpf(e1)); }
    st_vT(vw, tg, lane, VT);
    st_256x128(st, ST, tid);
    __syncthreads();
    f32x4 sacc[2];
    score_mfma(QL, KL, w, lane, sacc);
    __syncthreads();
    { const int mi = w >> 1, ni0 = 2 * (w & 1), t2 = 16 * mi + fr;
#pragma unroll
      for (int jn = 0; jn < 2; ++jn) { const int s0 = 16 * (ni0 + jn) + 4 * fq; f32x4 v = sacc[jn];
#pragma unroll
          for (int r = 0; r < 4; ++r) if (s0 + r > t2) v[r] = 0.f;
          *(LAS u32x2*)(KL + t2 * ROW72 + s0 * 2) = (u32x2){pk2(v[0], v[1]), pk2(v[2], v[3])}; } }
    __syncthreads();
    f32x4 o[8];
#pragma unroll
    for (int ni = 0; ni < 8; ++ni) o[ni] = (f32x4){0.f, 0.f, 0.f, 0.f};
#pragma unroll
    for (int ks = 0; ks < 2; ++ks) { const bf16x8 a = *(const LAS bf16x8*)(KL + t * ROW72 + (32 * ks + 8 * fq) * 2);
#pragma unroll
        for (int ni = 0; ni < 8; ++ni) { const bf16x8 bb = *(const LAS bf16x8*)(VT + (128 * wc + 16 * ni + fr) * ROW72 + (32 * ks + 8 * fq) * 2); o[ni] = mfma16(bb, a, o[ni]); } }
#pragma unroll
    for (int ks = 0; ks < 4; ++ks) { const bf16x8 a = *(const LAS bf16x8*)(QL + t * ROW136 + (32 * ks + 8 * fq) * 2);
#pragma unroll
        for (int ni = 0; ni < 8; ++ni) { const bf16x8 bb = *(const LAS bf16x8*)(ST + (128 * wc + 16 * ni + fr) * ROW136 + (32 * ks + 8 * fq) * 2); o[ni] = mfma16(bb, a, o[ni]); } }
    float ss = 0.f;
#pragma unroll
    for (int ni = 0; ni < 8; ++ni) ss += (o[ni][0] * o[ni][0] + o[ni][1] * o[ni][1]) + (o[ni][2] * o[ni][2] + o[ni][3] * o[ni][3]);
    ss += shx(ss, 16, lane); ss += shx(ss, 32, lane);
    if (fq == 0) RS[wc * 64 + t] = ss;
    __syncthreads();
    const float rstd = 1.0f / sqrtf((RS[t] + RS[64 + t]) * (1.0f / 256.0f) + EPS);
#pragma unroll
    for (int ni = 0; ni < 8; ++ni) { const int dv = 128 * wc + 16 * ni + 4 * fq;
        const f32x4 v = o[ni] * rstd * gn[ni];
        *(u32x2*)(C.OB + tok * OBW + OB_O + h * 256 + dv) = (u32x2){pk2(v[0] * silu_f(bflo(gg[ni].x)), v[1] * silu_f(bfhi(gg[ni].x))), pk2(v[2] * silu_f(bflo(gg[ni].y)), v[3] * silu_f(bfhi(gg[ni].y)))}; }
    __syncthreads();
}

DI void ml_A_unit(const MixCtx& C, LAS unsigned char* lds, int h, int n, int tid) {
    const int lane = tid & 63, tg = __builtin_amdgcn_readfirstlane(tid >> 6), c2 = lane;
    LAS float* PART = (LAS float*)(lds + L_MISC);
    LAS unsigned char* KT = lds + L_ST; LAS unsigned char* VT = lds + L_VT;
    const size_t ztok = (size_t)(n * CH + lane) * ZW;
    const float li = bf2f(C.Z[ztok + ZC_MI + h]) + C.b_i[h];
    const float lf = log_sigmoid_f(bf2f(C.Z[ztok + ZC_MF + h]) + C.b_f[h]);
    const float F = wave_scan_sum(lf, lane);
    const float Flast = shi(F, 63);
    const float Gv = Flast - F + li;
    const float g = wave_max(Gv, lane);
    const float wG = __expf(Gv - g);
    float k0[8], k1[8];
    conv_silu8(C.Z + ZC_MQK + 512 + h * 128 + 2 * c2, C.conv_w + 512 + h * 128 + 2 * c2, C.conv_b + 512 + h * 128 + 2 * c2, n * CH + 8 * tg, k0, k1);
    const float ks = 0.08838834764831845f;
    float p0 = 0.f, p1 = 0.f;
#pragma unroll
    for (int j = 0; j < 8; ++j) { const float wj = shi(wG, 8 * tg + j) * ks; k0[j] *= wj; k1[j] *= wj; p0 += k0[j]; p1 += k1[j]; }
    u32x4 lo, hi;
    lo.x = pk2(k0[0], k0[1]); lo.y = pk2(k0[2], k0[3]); lo.z = pk2(k0[4], k0[5]); lo.w = pk2(k0[6], k0[7]);
    hi.x = pk2(k1[0], k1[1]); hi.y = pk2(k1[2], k1[3]); hi.z = pk2(k1[4], k1[5]); hi.w = pk2(k1[6], k1[7]);
    *(LAS u32x4*)(KT + (2 * c2) * ROW72 + tg * 16) = lo; *(LAS u32x4*)(KT + (2 * c2 + 1) * ROW72 + tg * 16) = hi;
    *(LAS f32x2*)(PART + tg * 128 + 2 * c2) = (f32x2){p0, p1};
    fill_vT(C.Z + ZC_MV + h * 256, n, tg, lane, VT);
    if (tid == 0) { C.GG[h * NCH + n] = g; C.FL[h * NCH + n] = Flast; }
    __syncthreads();
    if (tid < 128) { float s = 0.f;
#pragma unroll
        for (int q = 0; q < 8; ++q) s += PART[q * 128 + tid];
        C.DN[(size_t)(h * NCH + n) * 128 + tid] = s; }
    state_mfma(VT, KT, C.DC + (size_t)(h * NCH + n) * 32768, tg, lane);
    __syncthreads();
}

DI void ml_B_unit(const MixCtx& C, LAS unsigned char* lds, int h, int n, int tid) {
    const int lane = tid & 63, w = __builtin_amdgcn_readfirstlane(tid >> 6), tg = w, c2 = lane, fr = lane & 15, fq = lane >> 4;
    LAS float* MF = (LAS float*)(lds + L_MISC); LAS float* MU = MF + 64; LAS float* MM = MF + 128; LAS float* MW = MF + 192;
    LAS float* DENP = MF + 256; LAS float* DQN = MF + 512; LAS float* NPV = MF + 576; LAS float* RS = (LAS float*)(lds + L_MISC + 4096);
    LAS unsigned char* CT = lds + L_ST; LAS unsigned char* VT = lds + L_VT; LAS unsigned char* QL = lds + L_Q; LAS unsigned char* KL = lds + L_K;
    copy_256x128(C.CP + (size_t)(h * NCH + n) * 32768, 128, CT, tid);
    if (w == 0) {
        const size_t ztok = (size_t)(n * CH + lane) * ZW;
        const float li = bf2f(C.Z[ztok + ZC_MI + h]) + C.b_i[h];
        const float lf = log_sigmoid_f(bf2f(C.Z[ztok + ZC_MF + h]) + C.b_f[h]);
        const float F = wave_scan_sum(lf, lane);
        const float u = li - F;
        const float pm = wave_scan_max(u, lane);
        const float mprev = C.MP[h * NCH + n];
        const float m = F + fmaxf(pm, mprev);
        MF[lane] = F; MU[lane] = u; MM[lane] = m; MW[lane] = __expf(F + mprev - m);
    }
    if (w == 1) { NPV[lane] = C.NP[(size_t)(h * NCH + n) * 128 + lane]; NPV[64 + lane] = C.NP[(size_t)(h * NCH + n) * 128 + 64 + lane]; }
    {
        float q0[8], q1[8], k0[8], k1[8];
        conv_silu8(C.Z + ZC_MQK + h * 128 + 2 * c2, C.conv_w + h * 128 + 2 * c2, C.conv_b + h * 128 + 2 * c2, n * CH + 8 * tg, q0, q1);
        conv_silu8(C.Z + ZC_MQK + 512 + h * 128 + 2 * c2, C.conv_w + 512 + h * 128 + 2 * c2, C.conv_b + 512 + h * 128 + 2 * c2, n * CH + 8 * tg, k0, k1);
        const float ks = 0.08838834764831845f;
#pragma unroll
        for (int j = 0; j < 8; ++j) { *(LAS unsigned*)(QL + (8 * tg + j) * ROW136 + 4 * c2) = pk2(q0[j], q1[j]); *(LAS unsigned*)(KL + (8 * tg + j) * ROW136 + 4 * c2) = pk2(k0[j] * ks, k1[j] * ks); }
    }
    fill_vT(C.Z + ZC_MV + h * 256, n, tg, lane, VT);
    __syncthreads();
    f32x4 sacc[2];
    score_mfma(QL, KL, w, lane, sacc);
    {
        const int t = tid >> 3, part = tid & 7; float s = 0.f;
#pragma unroll
        for (int e = 0; e < 8; ++e) { const unsigned qq = *(const LAS unsigned*)(QL + t * ROW136 + (16 * part + 2 * e) * 2); s += bflo(qq) * NPV[16 * part + 2 * e] + bfhi(qq) * NPV[16 * part + 2 * e + 1]; }
        s += shx(s, 1, lane); s += shx(s, 2, lane); s += shx(s, 4, lane);
        if (part == 0) DQN[t] = s;
    }
    __syncthreads();
    { const int mi = w >> 1, ni0 = 2 * (w & 1), t = 16 * mi + fr; const float ft = MF[t] - MM[t];
#pragma unroll
      for (int jn = 0; jn < 2; ++jn) { const int s0 = 16 * (ni0 + jn) + 4 * fq; f32x4 v = sacc[jn]; const f32x4 us = *(const LAS f32x4*)(MU + s0);
          float ps = 0.f;
#pragma unroll
          for (int r = 0; r < 4; ++r) { v[r] = (s0 + r > t) ? 0.f : v[r] * __expf(ft + us[r]); ps += v[r]; }
          ps += shx(ps, 16, lane); ps += shx(ps, 32, lane);
          if (fq == 0) DENP[t * 4 + ni0 + jn] = ps;
          *(LAS u32x2*)(KL + t * ROW72 + s0 * 2) = (u32x2){pk2(v[0], v[1]), pk2(v[2], v[3])}; } }
    __syncthreads();
    const int wr = w >> 1, wc = w & 1, t = 16 * wr + fr;
    f32x4 o1[8], o2[8];
#pragma unroll
    for (int ni = 0; ni < 8; ++ni) { o1[ni] = (f32x4){0.f, 0.f, 0.f, 0.f}; o2[ni] = o1[ni]; }
#pragma unroll
    for (int ks = 0; ks < 2; ++ks) { const bf16x8 a = *(const LAS bf16x8*)(KL + t * ROW72 + (32 * ks + 8 * fq) * 2);
#pragma unroll
        for (int ni = 0; ni < 8; ++ni) { const bf16x8 bb = *(const LAS bf16x8*)(VT + (128 * wc + 16 * ni + fr) * ROW72 + (32 * ks + 8 * fq) * 2); o1[ni] = mfma16(bb, a, o1[ni]); } }
#pragma unroll
    for (int ks = 0; ks < 4; ++ks) { const bf16x8 a = *(const LAS bf16x8*)(QL + t * ROW136 + (32 * ks + 8 * fq) * 2);
#pragma unroll
        for (int ni = 0; ni < 8; ++ni) { const bf16x8 bb = *(const LAS bf16x8*)(CT + (128 * wc + 16 * ni + fr) * ROW136 + (32 * ks + 8 * fq) * 2); o2[ni] = mfma16(bb, a, o2[ni]); } }
    const float wi = MW[t];
    const f32x4 dp = *(const LAS f32x4*)(DENP + t * 4);
    const float den = ((dp[0] + dp[1]) + (dp[2] + dp[3])) + wi * DQN[t];
    const float inv = 1.0f / fmaxf(fabsf(den), __expf(-MM[t]));
    const size_t tok = (size_t)(n * CH + t);
    float ss = 0.f;
#pragma unroll
    for (int ni = 0; ni < 8; ++ni) { const int dv = 128 * wc + 16 * ni + 4 * fq;
        const u32x2 mo = *(const u32x2*)(C.Z + tok * ZW + ZC_MO + h * 256 + dv);
        f32x4 v = (o1[ni] + o2[ni] * wi) * inv;
        v[0] *= sigmoid_f(bflo(mo.x)); v[1] *= sigmoid_f(bfhi(mo.x)); v[2] *= sigmoid_f(bflo(mo.y)); v[3] *= sigmoid_f(bfhi(mo.y));
        o1[ni] = v; ss += (v[0] * v[0] + v[1] * v[1]) + (v[2] * v[2] + v[3] * v[3]); }
    ss += shx(ss, 16, lane); ss += shx(ss, 32, lane);
    if (fq == 0) RS[wc * 64 + t] = ss;
    __syncthreads();
    const float rstd = 1.0f / sqrtf((RS[t] + RS[64 + t]) * (1.0f / 256.0f) + EPS);
#pragma unroll
    for (int ni = 0; ni < 8; ++ni) { const int dv = 128 * wc + 16 * ni + 4 * fq; const f32x4 gn = *(const f32x4*)(C.ml_norm + h * 256 + dv);
        const f32x4 v = o1[ni] * rstd * gn;
        *(u32x2*)(C.OB + tok * OBW + OB_O + 1024 + h * 256 + dv) = (u32x2){pk2(v[0], v[1]), pk2(v[2], v[3])}; }
    __syncthreads();
}

#ifndef SCAN_U
#define SCAN_U 8
#endif
DI void scan_phase(const MixCtx& C, int tid) {
    const int NS = 2 * 65536;
    for (int slot = opaque_bx() * 512 + tid; slot < NS; slot += opaque_g() * 512) {
        const int br = slot >> 16, s = slot & 65535, h = s >> 14, dv = (s >> 6) & 255, dkp = s & 63;
        const size_t e0 = (size_t)h * NCH * 32768 + (size_t)dv * 128 + 2 * dkp;
        if (br == 0) {
            float s0 = 0.f, s1 = 0.f;
            for (int n0 = 0; n0 < NCH; n0 += SCAN_U) {
                f32x2 d[SCAN_U], dec[SCAN_U];
#pragma unroll
                for (int u = 0; u < SCAN_U; ++u) { const unsigned dw = *(const unsigned*)(C.DS + e0 + (size_t)(n0 + u) * 32768); d[u] = (f32x2){bflo(dw), bfhi(dw)}; dec[u] = *(const f32x2*)(C.DECAY + (size_t)(h * NCH + n0 + u) * 128 + 2 * dkp); }
#pragma unroll
                for (int u = 0; u < SCAN_U; ++u) { *(unsigned*)(C.SP + e0 + (size_t)(n0 + u) * 32768) = pk2(s0, s1); s0 = dec[u].x * s0 + d[u].x; s1 = dec[u].y * s1 + d[u].y; }
            }
        } else {
            float c0 = 0.f, c1 = 0.f, nn0 = 0.f, nn1 = 0.f, m = -1e30f;
            for (int n0 = 0; n0 < NCH; n0 += SCAN_U) {
                f32x2 d[SCAN_U], dn[SCAN_U]; float fl[SCAN_U], gl[SCAN_U];
#pragma unroll
                for (int u = 0; u < SCAN_U; ++u) { const unsigned dw = *(const unsigned*)(C.DC + e0 + (size_t)(n0 + u) * 32768); d[u] = (f32x2){bflo(dw), bfhi(dw)}; fl[u] = C.FL[h * NCH + n0 + u]; gl[u] = C.GG[h * NCH + n0 + u];
                    dn[u] = (dv == 0) ? *(const f32x2*)(C.DN + (size_t)(h * NCH + n0 + u) * 128 + 2 * dkp) : (f32x2){0.f, 0.f}; }
#pragma unroll
                for (int u = 0; u < SCAN_U; ++u) { *(unsigned*)(C.CP + e0 + (size_t)(n0 + u) * 32768) = pk2(c0, c1);
                    if (dv == 0) { *(f32x2*)(C.NP + (size_t)(h * NCH + n0 + u) * 128 + 2 * dkp) = (f32x2){nn0, nn1}; if (dkp == 0) C.MP[h * NCH + n0 + u] = m; }
                    const float mn = fmaxf(fl[u] + m, gl[u]); const float a = __expf(fl[u] + m - mn), bb = __expf(gl[u] - mn);
                    c0 = a * c0 + bb * d[u].x; c1 = a * c1 + bb * d[u].y; nn0 = a * nn0 + bb * dn[u].x; nn1 = a * nn1 + bb * dn[u].y; m = mn; }
            }
        }
    }
}

DI void mem_unit(const MixCtx& C, LAS unsigned char* lds, int h, int rb, int tid) {
    const int lane = tid & 63, w = __builtin_amdgcn_readfirstlane(tid >> 6), fr = lane & 15, fq = lane >> 4, wr = w >> 1, wc = w & 1, t = 16 * wr + fr;
    LAS unsigned char* QL = lds; LAS unsigned char* PL = lds + 33792; LAS unsigned char* KV = lds + 67584;
    LAS float* RMX = (LAS float*)(lds + L_MISC); LAS float* RSM = RMX + 128;
#pragma unroll
    for (int i = 0; i < 4; ++i) { const int id = tid + 512 * i, row = id >> 5, cc = id & 31;
        *(LAS u32x4*)(QL + row * ROW264 + cc * 16) = *(const u32x4*)(C.Z + (size_t)(rb * 64 + row) * ZW + ZC_XQ + h * 256 + cc * 8); }
    f32x4 s[8];
#pragma unroll
    for (int ni = 0; ni < 8; ++ni) s[ni] = (f32x4){0.f, 0.f, 0.f, 0.f};
#pragma unroll
    for (int half = 0; half < 2; ++half) {
        copy_256x128(C.KM + h * 256 + half * 128, 4096, KV, tid);
        __syncthreads();
#pragma unroll
        for (int ks = 0; ks < 4; ++ks) { const bf16x8 a = *(const LAS bf16x8*)(QL + t * ROW264 + (128 * half + 32 * ks + 8 * fq) * 2);
#pragma unroll
            for (int ni = 0; ni < 8; ++ni) { const bf16x8 bb = *(const LAS bf16x8*)(KV + (128 * wc + 16 * ni + fr) * ROW136 + (32 * ks + 8 * fq) * 2); s[ni] = mfma16(bb, a, s[ni]); } }
        __syncthreads();
    }
    float mx = -3.0e38f;
#pragma unroll
    for (int ni = 0; ni < 8; ++ni) { s[ni] = s[ni] * 0.0625f; mx = fmaxf(mx, fmaxf(fmaxf(s[ni][0], s[ni][1]), fmaxf(s[ni][2], s[ni][3]))); }
    mx = fmaxf(mx, shx(mx, 16, lane)); mx = fmaxf(mx, shx(mx, 32, lane));
    if (fq == 0) RMX[wc * 64 + t] = mx;
    copy_256x128(C.VMT + (size_t)(h * 256) * 256, 256, KV, tid);
    __syncthreads();
    mx = fmaxf(RMX[t], RMX[64 + t]);
    float sm = 0.f;
#pragma unroll
    for (int ni = 0; ni < 8; ++ni) {
#pragma unroll
        for (int r = 0; r < 4; ++r) { s[ni][r] = __expf(s[ni][r] - mx); sm += s[ni][r]; } }
    sm += shx(sm, 16, lane); sm += shx(sm, 32, lane);
    if (fq == 0) RSM[wc * 64 + t] = sm;
    __syncthreads();
    const float inv = 1.0f / (RSM[t] + RSM[64 + t]);
#pragma unroll
    for (int ni = 0; ni < 8; ++ni) { const f32x4 p = s[ni] * inv; *(LAS u32x2*)(PL + t * ROW264 + (128 * wc + 16 * ni + 4 * fq) * 2) = (u32x2){pk2(p[0], p[1]), pk2(p[2], p[3])}; }
    f32x4 o[8];
#pragma unroll
    for (int ni = 0; ni < 8; ++ni) o[ni] = (f32x4){0.f, 0.f, 0.f, 0.f};
#pragma unroll
    for (int half = 0; half < 2; ++half) {
        if (half == 1) copy_256x128(C.VMT + (size_t)(h * 256) * 256 + 128, 256, KV, tid);
        __syncthreads();
#pragma unroll
        for (int ks = 0; ks < 4; ++ks) { const bf16x8 a = *(const LAS bf16x8*)(PL + t * ROW264 + (128 * half + 32 * ks + 8 * fq) * 2);
#pragma unroll
            for (int ni = 0; ni < 8; ++ni) { const bf16x8 bb = *(const LAS bf16x8*)(KV + (128 * wc + 16 * ni + fr) * ROW136 + (32 * ks + 8 * fq) * 2); o[ni] = mfma16(bb, a, o[ni]); } }
        __syncthreads();
    }
    const size_t tok = (size_t)(rb * 64 + t);
#pragma unroll
    for (int ni = 0; ni < 8; ++ni) { const int d = 128 * wc + 16 * ni + 4 * fq; *(u32x2*)(C.OB + tok * OBW + OB_O + 2048 + h * 256 + d) = (u32x2){pk2(o[ni][0], o[ni][1]), pk2(o[ni][2], o[ni][3])}; }
}

#ifndef GEMM_ALIGN
#define GEMM_ALIGN true
#endif
#ifndef REP_PRO
#define REP_PRO 1
#endif
#ifndef REP_MIXA
#define REP_MIXA 1
#endif
#ifndef REP_SCAN
#define REP_SCAN 1
#endif
#ifndef REP_MIXB
#define REP_MIXB 1
#endif
#ifndef REP_FF1
#define REP_FF1 1
#endif
#ifndef REP_NORM
#define REP_NORM 1
#endif
#ifndef WGM_IN
#define WGM_IN PG8_WGM
#endif
#ifndef WGM_BR
#define WGM_BR PG8_WGM
#endif
#ifndef WGM_OUT
#define WGM_OUT PG8_WGM
#endif
#ifndef WGM_F1
#define WGM_F1 8
#endif
#ifndef WGM_F2
#define WGM_F2 PG8_WGM
#endif
#ifndef REP_GLAA
#define REP_GLAA 1
#endif
#ifndef REP_MEM
#define REP_MEM 1
#endif
#ifndef REP_GLAB
#define REP_GLAB 1
#endif
#ifndef REP_GATE
#define REP_GATE 1
#endif
#ifndef REP_BR
#define REP_BR 1
#endif
#ifndef GEMM_SP2
#define GEMM_SP2 true
#endif
constexpr int L_PTR = L_BARW + 256;
DI unsigned long long tab_ld(LAS unsigned char* lds, int k) {
    const unsigned long long v = *(volatile LAS unsigned long long*)(lds + L_PTR + 8 * k);
    const unsigned lo = __builtin_amdgcn_readfirstlane((unsigned)v), hi = __builtin_amdgcn_readfirstlane((unsigned)(v >> 32));
    return ((unsigned long long)hi << 32) | lo;
}
DI const float* tab_in(LAS unsigned char* lds, int k) { return (const float*)(const GAS float*)tab_ld(lds, k); }
DI unsigned char* tab_ws(LAS unsigned char* lds) { return (unsigned char*)(GAS unsigned char*)tab_ld(lds, 24); }
DI void grid_bar(LAS unsigned char* lds) {
    XcdBarrier b; b.bar = (unsigned*)(tab_ws(lds) + WS_CTL) + CW_BAR; b.x = xb_xcc_id(); b.st = (volatile LAS unsigned*)(lds + L_BARW);
    xcd_barrier(b);
}
DI void make_ctx(MixCtx& C, LAS unsigned char* lds, int l) {
    unsigned char* ws = tab_ws(lds);
    C.Z = (const bf16_t*)(ws + WS_Z); C.OB = (bf16_t*)(ws + WS_OB);
    C.wa = tab_in(lds, I_W_GLA_A) + (size_t)l * 16 * 512; C.ba = tab_in(lds, I_B_GLA_A) + l * 512; C.gla_norm = tab_in(lds, I_GLA_NORM) + l * 1024;
    C.conv_w = tab_in(lds, I_CONV_W) + (size_t)l * 4 * 1024; C.conv_b = tab_in(lds, I_CONV_B) + l * 1024; C.b_i = tab_in(lds, I_B_ML_I) + l * 4; C.b_f = tab_in(lds, I_B_ML_F) + l * 4; C.ml_norm = tab_in(lds, I_ML_NORM) + l * 1024;
    C.BG = (float*)(ws + WS_BG); C.DS = (bf16_t*)(ws + WS_DS); C.DC = (bf16_t*)(ws + WS_DC); C.SP = (bf16_t*)(ws + WS_SP); C.CP = (bf16_t*)(ws + WS_CP);
    C.DECAY = (float*)(ws + WS_SMALL + SM_DECAY); C.DN = (float*)(ws + WS_SMALL + SM_DN); C.NP = (float*)(ws + WS_SMALL + SM_NP);
    C.GG = (float*)(ws + WS_SMALL + SM_GG); C.FL = (float*)(ws + WS_SMALL + SM_FL); C.MP = (float*)(ws + WS_SMALL + SM_MP);
    C.KM = (const bf16_t*)(ws + WS_KM) + l * 1024; C.VMT = (const bf16_t*)(ws + WS_VMT) + (size_t)l * 1024 * 256;
}

__global__ void __launch_bounds__(512, 2) trunk_fwd(Params p) {
    extern __shared__ __attribute__((aligned(16))) unsigned char lds_raw[];
    LAS unsigned char* lds0 = (LAS unsigned char*)lds_raw;
    {
        LAS unsigned char* lds = lds0;
        const int tid0 = threadIdx.x;
        if (tid0 < 64) ((LAS unsigned*)(lds + L_BARW))[tid0] = 0u;
        if (tid0 < 23) *(LAS unsigned long long*)(lds + L_PTR + 8 * tid0) = (unsigned long long)p.in[tid0];
        if (tid0 == 23) *(LAS unsigned long long*)(lds + L_PTR + 8 * 23) = (unsigned long long)p.out;
        if (tid0 == 24) *(LAS unsigned long long*)(lds + L_PTR + 8 * 24) = (unsigned long long)p.ws;
        __syncthreads();
        (void)xcd_barrier_post((unsigned*)(p.ws + WS_CTL) + CW_BAR, (volatile LAS unsigned*)(lds + L_BARW));
    }
#define TID (opaque_tid())
#define LANE (opaque_tid() & 63)
#define WAVE (__builtin_amdgcn_readfirstlane(opaque_tid() >> 6))
#define GW (opaque_bx() * NWAVES + WAVE)
#define NGW (opaque_g() * NWAVES)

    for (int rep = 0; rep < REP_PRO; ++rep) {
        LAS unsigned char* lds = opaque_lds(lds0); unsigned char* ws = tab_ws(lds);
        bf16_t* WIN = (bf16_t*)(ws + WS_WIN);
        const int lane = LANE, wave = WAVE;
        LAS float* scr = (LAS float*)(lds + wave * 16640);
        constexpr int IT_IN = 64 * 117, IT_BR = 16 * 64, IT_G = 4 * 64, IT_OUT = 64 * 64, IT_F1 = 64 * 256, IT_F2 = 256 * 64, IT_MK = 64 * 16;
        constexpr int E_IN = 4 * IT_IN, E_BR = E_IN + 12 * IT_BR, E_G = E_BR + 12 * IT_G, E_OUT = E_G + 4 * IT_OUT, E_F1 = E_OUT + 4 * IT_F1, E_F2 = E_F1 + 4 * IT_F2, E_MK = E_F2 + 4 * IT_MK, E_MV = E_MK + 4 * IT_MK;
        for (int it = GW; it < E_MV; it += NGW) {
            if (it < E_IN) { const int l = it / IT_IN, r = it - l * IT_IN; transpose_item(tab_in(lds, I_W_IN) + (size_t)l * DM * IN_W, DM, IN_W, WIN + (size_t)l * ZW * PW, PW, 0, 0, true, scr, r, lane, tab_in(lds, I_NORM_MIX) + l * DM); }
            else if (it < E_BR) { const int q = it - E_IN, lj = q / IT_BR, r = q - lj * IT_BR, l = lj / 3, j = lj - 3 * l; transpose_item(tab_in(lds, I_W_BRANCH) + (size_t)lj * 1024 * DM, 1024, DM, (bf16_t*)(ws + WS_WBR) + (size_t)l * DM * OBW, OBW, OB_O + j * 1024, 0, false, scr, r, lane); }
            else if (it < E_G) { const int q = it - E_BR, lj = q / IT_G, r = q - lj * IT_G, l = lj / 3, j = lj - 3 * l; transpose_item(tab_in(lds, I_W_GATE) + (size_t)lj * 256 * DM, 256, DM, (bf16_t*)(ws + WS_WBR) + (size_t)l * DM * OBW, OBW, j * 256, 0, false, scr, r, lane); }
            else if (it < E_OUT) { const int q = it - E_G, l = q / IT_OUT, r = q - l * IT_OUT; transpose_item(tab_in(lds, I_W_OUT) + (size_t)l * DM * DM, DM, DM, (bf16_t*)(ws + WS_WOUT) + (size_t)l * DM * PW, PW, 0, 0, false, scr, r, lane); }
            else if (it < E_F1) { const int q = it - E_OUT, l = q / IT_F1, r = q - l * IT_F1; transpose_item(tab_in(lds, I_W_FF1) + (size_t)l * DM * DFF, DM, DFF, (bf16_t*)(ws + WS_W1) + (size_t)l * DFF * PW, PW, 0, 0, false, scr, r, lane, tab_in(lds, I_NORM_FFN) + l * DM); }
            else if (it < E_F2) { const int q = it - E_F1, l = q / IT_F2, r = q - l * IT_F2; transpose_item(tab_in(lds, I_W_FF2) + (size_t)l * DFF * DM, DFF, DM, (bf16_t*)(ws + WS_W2) + (size_t)l * DM * PU, PU, 0, 0, false, scr, r, lane); }
            else if (it < E_MK) { const int q = it - E_F2, l = q / IT_MK, r = q - l * IT_MK; transpose_item(tab_in(lds, I_W_MEM_K) + (size_t)l * DM * 1024, DM, 1024, (bf16_t*)(ws + WS_WMK), DM, 0, l * 1024, false, scr, r, lane); }
            else { const int q = it - E_MK, l = q / IT_MK, r = q - l * IT_MK; transpose_item(tab_in(lds, I_W_MEM_V) + (size_t)l * DM * 1024, DM, 1024, (bf16_t*)(ws + WS_WMV), DM, 0, l * 1024, false, scr, r, lane); }
        }
        constexpr int PADCH = (ZW - IN_W) * PW / 8;
        for (int i = opaque_bx() * 512 + TID; i < NL * PADCH; i += opaque_g() * 512) { const int l = i / PADCH, r = i - l * PADCH; *(u32x4*)(WIN + (size_t)l * ZW * PW + (size_t)IN_W * PW + (size_t)r * 8) = (u32x4){0u, 0u, 0u, 0u}; }
        for (int m = GW; m < SEQ; m += NGW) row_bf16_ss(tab_in(lds, I_X) + (size_t)m * DM, (bf16_t*)(ws + WS_H) + (size_t)m * PW, (u64_t*)(ws + WS_SS) + m, lane);
        for (int m = GW; m < MEML; m += NGW) rmsnorm_row<false>(tab_in(lds, I_MEM) + (size_t)m * DM, tab_in(lds, I_MEM_NORM), (bf16_t*)(ws + WS_MEMN) + (size_t)m * DM, lane);
    }
    grid_bar(opaque_lds(lds0));
    for (int l = 0; l < NL; ++l) {
        {
            LAS unsigned char* lds = opaque_lds(lds0); unsigned char* ws = tab_ws(lds);
            pg8::Gemm g{(const bf16_t*)(ws + WS_H), (const bf16_t*)(ws + WS_WIN) + (size_t)l * ZW * PW, opq(SEQ), opq(ZW), opq(DM), opq(PW), opq(PW)}; pg8::StaticOrder S; S.init(opq(SEQ), opq(ZW), opaque_g(), opaque_bx(), opq(WGM_IN)); pg8::EpiBf16<0> E{(bf16_t*)(ws + WS_Z), ZW, nullptr, (const u64_t*)(ws + WS_SS) + (size_t)(2 * l) * SEQ, (bf16_t*)(ws + WS_OB), OBW, ZC_GATE / 256};
            pg8::gemm_phase<pg8::EpiBf16<0>, pg8::StaticOrder, GEMM_ALIGN, GEMM_SP2>(lds, g, S, E);
        }
        if (l == 0) {
            const int kvc = (opaque_g() >= 256 && opaque_bx() >= 128) ? opaque_bx() - 128 : opaque_bx() + (1 << 20) * (opaque_g() >= 256 ? 1 : 0);
        {
            LAS unsigned char* lds = opaque_lds(lds0); unsigned char* ws = tab_ws(lds);
        { pg8::Gemm g{(const bf16_t*)(ws + WS_MEMN), (const bf16_t*)(ws + WS_WMK), opq(MEML), opq(DM), opq(DM), opq(DM), opq(DM)}; pg8::StaticOrder S; S.init(opq(MEML), opq(DM), opaque_g(), kvc); pg8::EpiBf16<0> E{(bf16_t*)(ws + WS_KM), DM, nullptr, nullptr, nullptr, 0, -1};
          pg8::gemm_phase<pg8::EpiBf16<0>, pg8::StaticOrder, GEMM_ALIGN, GEMM_SP2>(lds, g, S, E); }
    }
        {
            LAS unsigned char* lds = opaque_lds(lds0); unsigned char* ws = tab_ws(lds);
        { pg8::Gemm g{(const bf16_t*)(ws + WS_WMV), (const bf16_t*)(ws + WS_MEMN), opq(DM), opq(MEML), opq(DM), opq(DM), opq(DM)}; pg8::StaticOrder S; S.init(opq(DM), opq(MEML), opaque_g(), kvc - 16); pg8::EpiBf16<0> E{(bf16_t*)(ws + WS_VMT), MEML, nullptr, nullptr, nullptr, 0, -1};
          pg8::gemm_phase<pg8::EpiBf16<0>, pg8::StaticOrder, GEMM_ALIGN, GEMM_SP2>(lds, g, S, E); }
    }
        }
        grid_bar(opaque_lds(lds0));
        {
            LAS unsigned char* lds = opaque_lds(lds0); MixCtx C; make_ctx(C, lds, l); const int tid = TID;
            for (int rep = 0; rep < REP_MIXA; ++rep) {
            for (int r2 = 0; r2 < REP_GLAA; ++r2) for (int i = opaque_bx(); i < 4 * NCH; i += opaque_g()) gla_A_unit(C, lds, i >> 8, i & 255, tid);
            for (int i = opaque_bx(); i < 4 * NCH; i += opaque_g()) ml_A_unit(C, lds, i >> 8, i & 255, tid);
            for (int r2 = 0; r2 < REP_MEM; ++r2) for (int i = opaque_bx(); i < 4 * NCH; i += opaque_g()) mem_unit(C, lds, i >> 8, i & 255, tid);
            }
        }
        grid_bar(opaque_lds(lds0));
        { LAS unsigned char* lds = opaque_lds(lds0); MixCtx C; make_ctx(C, lds, l); for (int rep = 0; rep < REP_SCAN; ++rep) scan_phase(C, TID); }
        grid_bar(opaque_lds(lds0));
        {
            LAS unsigned char* lds = opaque_lds(lds0); MixCtx C; make_ctx(C, lds, l); const int tid = TID;
            for (int rep = 0; rep < REP_MIXB; ++rep) {
            for (int r2 = 0; r2 < REP_GLAB; ++r2) for (int i = opaque_bx(); i < 4 * NCH; i += opaque_g()) gla_B_unit(C, lds, i >> 8, i & 255, tid);
            for (int i = opaque_bx(); i < 4 * NCH; i += opaque_g()) ml_B_unit(C, lds, i >> 8, i & 255, tid);
            }
        }
        grid_bar(opaque_lds(lds0));
        for (int rep = 0; rep < REP_BR; ++rep) {
            LAS unsigned char* lds = opaque_lds(lds0); unsigned char* ws = tab_ws(lds);
            pg8::Gemm g{(const bf16_t*)(ws + WS_OB), (const bf16_t*)(ws + WS_WBR) + (size_t)l * DM * OBW, opq(SEQ), opq(DM), opq(OBW), opq(OBW), opq(OBW)}; pg8::BranchOrder S; S.init(opq(SEQ), opq(DM), opaque_g(), opaque_bx(), opq(WGM_BR)); pg8::EpiBranch E{(bf16_t*)(ws + WS_Y), PW, (bf16_t*)(ws + WS_GT), tab_in(lds, I_B_GATE) + (size_t)l * GTW};
            pg8::gemm_phase<pg8::EpiBranch, pg8::BranchOrder, GEMM_ALIGN, GEMM_SP2>(lds, g, S, E);
        }
        grid_bar(opaque_lds(lds0));
        {
            LAS unsigned char* lds = opaque_lds(lds0); unsigned char* ws = tab_ws(lds);
            const float* Xin = (l == 0) ? tab_in(lds, I_X) : (const float*)(ws + WS_X);
            pg8::Gemm g{(const bf16_t*)(ws + WS_Y), (const bf16_t*)(ws + WS_WOUT) + (size_t)l * DM * PW, opq(SEQ), opq(DM), opq(DM), opq(PW), opq(PW)}; pg8::StaticOrder S; S.init(opq(SEQ), opq(DM), opaque_g(), opaque_bx(), opq(WGM_OUT)); pg8::EpiResid E{Xin, (float*)(ws + WS_X), DM, (bf16_t*)(ws + WS_H), (u64_t*)(ws + WS_SS) + (size_t)(2 * l + 1) * SEQ, PW};
            pg8::gemm_phase<pg8::EpiResid, pg8::StaticOrder, GEMM_ALIGN, GEMM_SP2>(lds, g, S, E);
        }
        grid_bar(opaque_lds(lds0));
        for (int rep = 0; rep < REP_FF1; ++rep) {
            LAS unsigned char* lds = opaque_lds(lds0); unsigned char* ws = tab_ws(lds);
            pg8::Gemm g{(const bf16_t*)(ws + WS_H), (const bf16_t*)(ws + WS_W1) + (size_t)l * DFF * PW, opq(SEQ), opq(DFF), opq(DM), opq(PW), opq(PW)}; pg8::StaticOrder S; S.init(opq(SEQ), opq(DFF), opaque_g(), opaque_bx(), opq(WGM_F1)); pg8::EpiBf16<1> E{(bf16_t*)(ws + WS_U), PU, nullptr, (const u64_t*)(ws + WS_SS) + (size_t)(2 * l + 1) * SEQ, nullptr, 0, -1};
            pg8::gemm_phase<pg8::EpiBf16<1>, pg8::StaticOrder, GEMM_ALIGN, GEMM_SP2>(lds, g, S, E);
        }
        grid_bar(opaque_lds(lds0));
        {
            LAS unsigned char* lds = opaque_lds(lds0); unsigned char* ws = tab_ws(lds);
            pg8::Gemm g{(const bf16_t*)(ws + WS_U), (const bf16_t*)(ws + WS_W2) + (size_t)l * DM * PU, opq(SEQ), opq(DM), opq(DFF), opq(PU), opq(PU)}; pg8::StaticOrder S; S.init(opq(SEQ), opq(DM), opaque_g(), opaque_bx(), opq(WGM_F2)); pg8::EpiResid E{(const float*)(ws + WS_X), (float*)(ws + WS_X), DM, (bf16_t*)(ws + WS_H), (u64_t*)(ws + WS_SS) + (size_t)(2 * l + 2) * SEQ, PW};
            pg8::gemm_phase<pg8::EpiResid, pg8::StaticOrder, GEMM_ALIGN, GEMM_SP2>(lds, g, S, E);
        }
        grid_bar(opaque_lds(lds0));
    }
    {
        LAS unsigned char* lds = opaque_lds(lds0); unsigned char* ws = tab_ws(lds);
        const float* X = (const float*)(ws + WS_X); const float* gain = tab_in(lds, I_FINAL_NORM); float* out = (float*)(GAS float*)tab_ld(lds, 23); const int lane = LANE;
        const u64_t* ssf = (const u64_t*)(ws + WS_SS) + (size_t)8 * SEQ;
        for (int m = GW; m < SEQ; m += NGW) row_scale_f32(X + (size_t)m * DM, gain, ss_to_f(ssf[m]), out + (size_t)m * DM, lane);
    }
}

extern "C" void kernel_launch(void* const* d_in, const int* in_sizes, int n_in, void* d_out, int out_size, void* d_ws, size_t ws_size, hipStream_t stream) {
    static int grid = 0;
    if (grid == 0) {
        if (n_in != 23 || out_size != SEQ * DM || ws_size < WS_END) { fprintf(stderr, "kernel_launch: unexpected shapes (n_in %d out %d ws %zu, need %zu)\n", n_in, out_size, ws_size, (size_t)WS_END); grid = -1; return; }
        int dev = 0, cus = 0, per_cu = 0;
        if (hipGetDevice(&dev) != hipSuccess || hipDeviceGetAttribute(&cus, hipDeviceAttributeMultiprocessorCount, dev) != hipSuccess) { grid = -1; return; }
        if (hipFuncSetAttribute((const void*)trunk_fwd, hipFuncAttributeMaxDynamicSharedMemorySize, LDS_BYTES) != hipSuccess) { fprintf(stderr, "kernel_launch: hipFuncSetAttribute failed\n"); grid = -1; return; }
        if (hipOccupancyMaxActiveBlocksPerMultiprocessor(&per_cu, (const void*)trunk_fwd, 512, LDS_BYTES) != hipSuccess || per_cu < 1) { fprintf(stderr, "kernel_launch: occupancy query says %d\n", per_cu); (void)hipGetLastError(); }
        grid = cus;
    }
    if (grid < 0) return;
    if (hipMemsetAsync((char*)d_ws + WS_CTL, 0, CTL_ZERO_BYTES, stream) != hipSuccess) return;
    if (hipMemsetAsync((char*)d_ws + WS_SS, 0, SS_ZERO_BYTES, stream) != hipSuccess) return;
    Params p{};
    for (int i = 0; i < 23; ++i) p.in[i] = (const float*)d_in[i];
    p.out = (float*)d_out; p.ws = (unsigned char*)d_ws;
    hipLaunchKernelGGL(trunk_fwd, dim3(grid), dim3(512), LDS_BYTES, stream, p);
}
```

```cpp
#include <hip/hip_runtime.h>
#include <cstdio>
#include <cstdint>

#define DI __device__ __forceinline__
#define GAS __attribute__((address_space(1)))
#define LAS __attribute__((address_space(3)))
typedef unsigned short bf16_t;
typedef short bf16x8 __attribute__((ext_vector_type(8)));
typedef float f32x4 __attribute__((ext_vector_type(4)));
typedef float f32x2 __attribute__((ext_vector_type(2)));
typedef unsigned u32x4 __attribute__((ext_vector_type(4)));
typedef unsigned u32x2 __attribute__((ext_vector_type(2)));

constexpr int SEQ = 16384, DM = 4096, DFF = 16384, NL = 4, MEML = 256, CH = 64, NCH = SEQ / CH;
constexpr int IN_W = 7448, ZW = 7680;
constexpr int ZC_GQ = 0, ZC_GK = 512, ZC_GV = 1024, ZC_GG = 2048, ZC_MQK = 3072, ZC_MV = 4096, ZC_MO = 5120, ZC_XQ = 6144, ZC_GATE = 7168, ZC_GA = 7424, ZC_MI = 7440, ZC_MF = 7444;
constexpr int OBW = 3840, OB_O = 768;
constexpr int GTW = 12288;
constexpr float EPS = 1e-6f;
#ifndef PITCH_PAD
#define PITCH_PAD 64
#endif
constexpr int PW = DM + PITCH_PAD, PU = DFF + PITCH_PAD;

constexpr size_t MiB = 1u << 20;
constexpr size_t WS_CTL = 0, CTL_ZERO_BYTES = 1 * MiB;
constexpr size_t WS_WIN = 1 * MiB, WS_WBR = 245 * MiB, WS_WOUT = 365 * MiB, WS_W1 = 495 * MiB, WS_W2 = 1015 * MiB;
constexpr size_t WS_WMK = 1529 * MiB, WS_WMV = 1561 * MiB, WS_MEMN = 1593 * MiB, WS_KM = 1595 * MiB, WS_VMT = 1597 * MiB;
constexpr size_t WS_X = 1599 * MiB, WS_H = 1855 * MiB, WS_Z = 1985 * MiB, WS_GT = 2225 * MiB, WS_U = WS_Z  ;
constexpr size_t WS_OB = 2609 * MiB, WS_Y = 2729 * MiB, WS_DS = 2859 * MiB, WS_SP = 2987 * MiB, WS_DC = 3051 * MiB, WS_CP = 3179 * MiB;
constexpr size_t WS_SMALL = 3243 * MiB, WS_SS = 3245 * MiB, SS_ZERO_BYTES = 2 * MiB, WS_BG = 3247 * MiB, WS_END = 3279 * MiB;
static_assert(PITCH_PAD <= 64, "buffer sizes below assume at most 64 elements of row padding");
static_assert(WS_WIN + (size_t)NL * ZW * PW * 2 <= WS_WBR && WS_WBR + (size_t)NL * DM * OBW * 2 <= WS_WOUT && WS_WOUT + (size_t)NL * DM * PW * 2 <= WS_W1 && WS_W1 + (size_t)NL * DFF * PW * 2 <= WS_W2 && WS_W2 + (size_t)NL * DM * PU * 2 <= WS_WMK, "weight map");
static_assert(WS_H + (size_t)SEQ * PW * 2 <= WS_Z && WS_Y + (size_t)SEQ * PW * 2 <= WS_DS, "activation map");
static_assert(WS_OB + (size_t)SEQ * OBW * 2 <= WS_Y, "OB size");
constexpr size_t SM_DECAY = 0, SM_DN = 512 * 1024, SM_NP = 1024 * 1024, SM_GG = 1536 * 1024, SM_FL = 1536 * 1024 + 4096, SM_MP = 1536 * 1024 + 8192;
static_assert(WS_U + (size_t)SEQ * PU * 2 <= WS_OB, "U overlay");
constexpr int CW_BAR = 4096;
static_assert(9 * (size_t)SEQ * 8 <= SS_ZERO_BYTES, "SS region");
typedef unsigned long long u64_t;
DI float ss_to_f(u64_t v) { return (float)v * (1.0f / 16777216.0f); }

constexpr int LDS_BYTES = 147456;
constexpr int L_ST = 0, L_VT = 69632, L_Q = 106496, L_K = 123904, L_MISC = 141312, L_BARW = 146432;
constexpr int ROW72 = 144, ROW136 = 272, ROW264 = 528;
constexpr int NWAVES = 8;

DI float bf2f(unsigned v) { return __uint_as_float(v << 16); }
DI float bflo(unsigned w) { return __uint_as_float(w << 16); }
DI float bfhi(unsigned w) { return __uint_as_float(w & 0xffff0000u); }
typedef __bf16 bf16x2_t __attribute__((ext_vector_type(2)));
DI unsigned pk2(float lo, float hi) { const f32x2 v = {lo, hi}; const bf16x2_t b = __builtin_convertvector(v, bf16x2_t); return __builtin_bit_cast(unsigned, b); }
DI float sigmoid_f(float x) { return __builtin_amdgcn_rcpf(1.0f + __expf(-x)); }
DI float silu_f(float x) { return x * sigmoid_f(x); }
DI float log_sigmoid_f(float x) { return fminf(x, 0.f) - __logf(1.0f + __expf(-fabsf(x))); }
DI float shx(float v, int o, int lane) { return __int_as_float(__builtin_amdgcn_ds_bpermute((lane ^ o) << 2, __float_as_int(v))); }
DI float shi(float v, int src) { return __int_as_float(__builtin_amdgcn_ds_bpermute(src << 2, __float_as_int(v))); }
DI float wave_sum(float v, int lane) {
#pragma unroll
    for (int o = 1; o < 64; o <<= 1) v += shx(v, o, lane);
    return v;
}
DI float wave_max(float v, int lane) {
#pragma unroll
    for (int o = 1; o < 64; o <<= 1) v = fmaxf(v, shx(v, o, lane));
    return v;
}
DI float wave_scan_sum(float v, int lane) {
#pragma unroll
    for (int o = 1; o < 64; o <<= 1) { const float t = shi(v, lane >= o ? lane - o : lane); if (lane >= o) v += t; }
    return v;
}
DI float wave_scan_max(float v, int lane) {
#pragma unroll
    for (int o = 1; o < 64; o <<= 1) { const float t = shi(v, lane >= o ? lane - o : lane); if (lane >= o) v = fmaxf(v, t); }
    return v;
}
DI f32x4 mfma16(bf16x8 a, bf16x8 b, f32x4 c) { return __builtin_amdgcn_mfma_f32_16x16x32_bf16(a, b, c, 0, 0, 0); }
DI int opaque_tid() { int t = (int)threadIdx.x; asm volatile("" : "+v"(t)); return t; }
DI int opaque_bx() { int b = (int)blockIdx.x; asm volatile("" : "+s"(b)); return b; }
DI LAS unsigned char* opaque_lds(LAS unsigned char* p) { asm volatile("" : "+s"(p)); return p; }
DI int opq(int v) { asm volatile("" : "+s"(v)); return v; }
DI int opaque_g() { int g = (int)gridDim.x; asm volatile("" : "+s"(g)); return g; }

namespace pg8 {
#define PG8_LAS __attribute__((address_space(3)))
constexpr int BM = 256, BK = 64, HALF = 128, HTB = HALF * BK * 2  , STAGE_BYTES = 8 * HTB, NXCD = 8;
#ifndef PG8_WGM
#define PG8_WGM 4
#endif
constexpr int WGM = PG8_WGM;

__host__ __device__ __forceinline__ int lds_byte(int r, int c) { const int st = (r >> 4) * 2 + (c >> 5), rr = r & 15, cc = c & 31, ob = rr * 64 + cc * 2; return st * 1024 + (ob ^ (((ob >> 9) & 1) << 5)); }
__host__ __device__ __forceinline__ void stage_rc(int b, int& R, int& C) { const int st = b / 1024, sb = b % 1024, swz = sb ^ (((sb >> 9) & 1) << 5); R = (st >> 1) * 16 + swz / 64; C = (st & 1) * 32 + (swz % 64) / 2; }
__host__ __device__ __forceinline__ int perm32(int rho) { const int n = rho >> 4, i = rho & 15; return 8 * (i >> 2) + 4 * n + (i & 3); }

struct Unit { int pm, pn, kind; };
struct Gemm { const bf16_t* A; const bf16_t* Bt; int M, N, K, lda, ldb; };

struct StaticOrder {
    int nM, nN, nwg, G, c, wgm;
    __host__ __device__ void init(int M, int N, int G_, int c_, int wgm_ = WGM) { nM = M / BM; nN = N / BM; nwg = nM * nN; G = G_; c = c_; wgm = wgm_; }
    __host__ __device__ bool next(int i, Unit& u) const {
        const long L = (long)i * G + c; if (c < 0 || L >= nwg) return false;
        int wgid = (int)L; { const int q = nwg / NXCD, r = nwg % NXCD, xcd = wgid % NXCD, off = wgid / NXCD; wgid = (xcd < r ? xcd * (q + 1) : r * (q + 1) + (xcd - r) * q) + off; }
        const int nig = wgm * nN, gid = wgid / nig, fm = gid * wgm, gsz = (nM - fm) < wgm ? (nM - fm) : wgm;
        u.pm = fm + ((wgid % nig) % gsz); u.pn = (wgid % nig) / gsz; u.kind = 0; return true;
    }
    __device__ __forceinline__ void a_ready(const Unit&) const {}
    __device__ __forceinline__ void done(const Unit&) const {}
    __device__ __forceinline__ int nt(const Unit&, int nt_default) const { return nt_default; }
    __device__ __forceinline__ int koff(const Unit&) const { return 0; }
};
struct BranchOrder : StaticOrder {
    __host__ __device__ bool next(int i, Unit& u) const { if (!StaticOrder::next(i >> 2, u)) return false; u.kind = i & 3; return true; }
    __device__ __forceinline__ int nt(const Unit& u, int) const { return u.kind < 3 ? 4 : 48; }
    __device__ __forceinline__ int koff(const Unit& u) const { return u.kind < 3 ? 256 * u.kind : 768; }
};

template <int ACT  > struct EpiBf16 {
    static constexpr bool PERM = true, AFTER_DRAIN = false, HOOK = false;
    bf16_t* O; int ldc; const float* bias; const unsigned long long* ss; bf16_t* O2; int ld2, pn2;
    __device__ __forceinline__ void operator()(const f32x4 (&acc)[2][2][4][2], const Unit& u, int wr, int wc, int fr, int fq) const {
        const int row0 = u.pm * BM + wr * 64 + fr, col0 = u.pn * BM + wc * 32 + 8 * fq;
        f32x4 bv[2][2];
#pragma unroll
        for (int bj = 0; bj < 2; ++bj)
#pragma unroll
            for (int n = 0; n < 2; ++n) bv[bj][n] = (ACT == 2) ? *(const f32x4*)(bias + col0 + bj * HALF + 4 * n) : (f32x4){0.f, 0.f, 0.f, 0.f};
#pragma unroll
        for (int ai = 0; ai < 2; ++ai)
#pragma unroll
            for (int m = 0; m < 4; ++m) { bf16_t* rowp = O + (size_t)(row0 + ai * HALF + m * 16) * ldc + col0;
                const bool redir = (ACT == 0) && O2 != nullptr && u.pn == pn2;
                if (redir) rowp = O2 + (size_t)(row0 + ai * HALF + m * 16) * ld2 + (col0 - u.pn * BM);
                float rs = 1.f; if (ACT != 2) { if (ss) rs = 1.0f / sqrtf((float)ss[row0 + ai * HALF + m * 16] * (1.0f / 16777216.0f) * (1.0f / DM) + EPS); }
#pragma unroll
                for (int bj = 0; bj < 2; ++bj) { f32x4 v0 = acc[ai][bj][m][0], v1 = acc[ai][bj][m][1];
                    if (ACT != 2) { v0 = v0 * rs; v1 = v1 * rs; }
                    if (ACT == 1) {
#pragma unroll
                        for (int j = 0; j < 4; ++j) { const float a = fmaxf(v0[j], 0.f), b = fmaxf(v1[j], 0.f); v0[j] = a * a; v1[j] = b * b; } }
                    if (ACT == 2) { v0 = v0 + bv[bj][0]; v1 = v1 + bv[bj][1];
#pragma unroll
                        for (int j = 0; j < 4; ++j) { v0[j] = sigmoid_f(fminf(fmaxf(v0[j], -30.f), 30.f)); v1[j] = sigmoid_f(fminf(fmaxf(v1[j], -30.f), 30.f)); } }
                    u32x4 w; w.x = pk2(v0[0], v0[1]); w.y = pk2(v0[2], v0[3]); w.z = pk2(v1[0], v1[1]); w.w = pk2(v1[2], v1[3]);
                    *(u32x4*)(rowp + bj * HALF) = w;
                    if (redir) { *(u32x4*)(rowp + bj * HALF + 256) = w; *(u32x4*)(rowp + bj * HALF + 512) = w; } } }
    }
    __device__ __forceinline__ bool hook_at(const Unit&, int) const { return false; }
    __device__ __forceinline__ void hook(f32x4 (&)[2][2][4][2], const Unit&, int, int, int, int, int) const {}
};
struct EpiResid {
    static constexpr bool PERM = true, AFTER_DRAIN = false, HOOK = false;
    const float* in; float* out; int ldc; bf16_t* xb; unsigned long long* ss; int ldxb;
    __device__ __forceinline__ void operator()(const f32x4 (&acc)[2][2][4][2], const Unit& u, int wr, int wc, int fr, int fq) const {
        const int row0 = u.pm * BM + wr * 64 + fr, col0 = u.pn * BM + wc * 32 + 8 * fq, lane = fq * 16 + fr;
#pragma unroll
        for (int ai = 0; ai < 2; ++ai) {
            f32x4 r[4][2][2];
#pragma unroll
            for (int m = 0; m < 4; ++m) { const size_t off = (size_t)(row0 + ai * HALF + m * 16) * ldc + col0;
#pragma unroll
                for (int bj = 0; bj < 2; ++bj)
#pragma unroll
                    for (int n = 0; n < 2; ++n) r[m][bj][n] = *(const f32x4*)(in + off + bj * HALF + n * 4); }
#pragma unroll
            for (int m = 0; m < 4; ++m) { const int row = row0 + ai * HALF + m * 16; const size_t off = (size_t)row * ldc + col0;
                float sq = 0.f;
#pragma unroll
                for (int bj = 0; bj < 2; ++bj) { const f32x4 o0 = r[m][bj][0] + acc[ai][bj][m][0], o1 = r[m][bj][1] + acc[ai][bj][m][1];
                    *(f32x4*)(out + off + bj * HALF) = o0; *(f32x4*)(out + off + bj * HALF + 4) = o1;
                    sq += (o0[0] * o0[0] + o0[1] * o0[1]) + (o0[2] * o0[2] + o0[3] * o0[3]) + (o1[0] * o1[0] + o1[1] * o1[1]) + (o1[2] * o1[2] + o1[3] * o1[3]);
                    u32x4 w; w.x = pk2(o0[0], o0[1]); w.y = pk2(o0[2], o0[3]); w.z = pk2(o1[0], o1[1]); w.w = pk2(o1[2], o1[3]);
                    *(u32x4*)(xb + (size_t)row * ldxb + col0 + bj * HALF) = w; }
                sq += shx(sq, 16, lane); sq += shx(sq, 32, lane);
                if (fq == 0) (void)__hip_atomic_fetch_add(ss + row, (unsigned long long)(sq * 16777216.0f), __ATOMIC_RELAXED, __HIP_MEMORY_SCOPE_AGENT); }
            asm volatile("" ::: "memory"); }
    }
    __device__ __forceinline__ bool hook_at(const Unit&, int) const { return false; }
    __device__ __forceinline__ void hook(f32x4 (&)[2][2][4][2], const Unit&, int, int, int, int, int) const {}
};
struct EpiBranch {
    static constexpr bool PERM = true, AFTER_DRAIN = false, HOOK = true;
    bf16_t* O; int ldc; bf16_t* GT; const float* bias;
    __device__ __forceinline__ bool hook_at(const Unit& u, int t) const { return u.kind == 3 && (t == 16 || t == 32); }
    __device__ __forceinline__ void hook(f32x4 (&acc)[2][2][4][2], const Unit& u, int t, int, int, int, int) const {
        const int tid_ = opaque_tid(), wid_ = tid_ >> 6, wr = wid_ >> 2, wc = wid_ & 3, fr = tid_ & 15, fq = (tid_ >> 4) & 3;
        const int row0 = u.pm * BM + wr * 64 + fr, col0 = u.pn * BM + wc * 32 + 8 * fq;
        const bf16_t* ga = GT + (size_t)(t == 16 ? 0 : DM); const bf16_t* gb = ga + DM;
#pragma unroll
        for (int ai = 0; ai < 2; ++ai) {
            u32x4 a[4][2], b[4][2];
#pragma unroll
            for (int m = 0; m < 4; ++m) { const size_t off = (size_t)(row0 + ai * HALF + m * 16) * GTW + col0;
#pragma unroll
                for (int bj = 0; bj < 2; ++bj) { a[m][bj] = *(const u32x4*)(ga + off + bj * HALF); b[m][bj] = *(const u32x4*)(gb + off + bj * HALF); } }
#pragma unroll
            for (int m = 0; m < 4; ++m)
#pragma unroll
                for (int bj = 0; bj < 2; ++bj) { const u32x4 x = a[m][bj], y = b[m][bj];
                    f32x4 r0, r1;
                    r0[0] = bflo(y.x) * __builtin_amdgcn_rcpf(bflo(x.x)); r0[1] = bfhi(y.x) * __builtin_amdgcn_rcpf(bfhi(x.x));
                    r0[2] = bflo(y.y) * __builtin_amdgcn_rcpf(bflo(x.y)); r0[3] = bfhi(y.y) * __builtin_amdgcn_rcpf(bfhi(x.y));
                    r1[0] = bflo(y.z) * __builtin_amdgcn_rcpf(bflo(x.z)); r1[1] = bfhi(y.z) * __builtin_amdgcn_rcpf(bfhi(x.z));
                    r1[2] = bflo(y.w) * __builtin_amdgcn_rcpf(bflo(x.w)); r1[3] = bfhi(y.w) * __builtin_amdgcn_rcpf(bfhi(x.w));
                    acc[ai][bj][m][0] = acc[ai][bj][m][0] * r0; acc[ai][bj][m][1] = acc[ai][bj][m][1] * r1; }
            asm volatile("" ::: "memory"); }
    }
    __device__ __forceinline__ void operator()(const f32x4 (&acc)[2][2][4][2], const Unit& u, int wr, int wc, int fr, int fq) const {
        const int row0 = u.pm * BM + wr * 64 + fr, col0 = u.pn * BM + wc * 32 + 8 * fq;
        if (u.kind < 3) {
            bf16_t* gd = GT + (size_t)u.kind * DM; const float* bj_ = bias + (size_t)u.kind * DM + col0;
            f32x4 bv[2][2];
#pragma unroll
            for (int bj = 0; bj < 2; ++bj)
#pragma unroll
                for (int n = 0; n < 2; ++n) bv[bj][n] = *(const f32x4*)(bj_ + bj * HALF + 4 * n);
#pragma unroll
            for (int ai = 0; ai < 2; ++ai)
#pragma unroll
                for (int m = 0; m < 4; ++m) { const size_t off = (size_t)(row0 + ai * HALF + m * 16) * GTW + col0;
#pragma unroll
                    for (int bj = 0; bj < 2; ++bj) { f32x4 v0 = acc[ai][bj][m][0] + bv[bj][0], v1 = acc[ai][bj][m][1] + bv[bj][1];
#pragma unroll
                        for (int e = 0; e < 4; ++e) { v0[e] = 1.0f + __expf(-fminf(fmaxf(v0[e], -30.f), 30.f)); v1[e] = 1.0f + __expf(-fminf(fmaxf(v1[e], -30.f), 30.f)); }
                        u32x4 w; w.x = pk2(v0[0], v0[1]); w.y = pk2(v0[2], v0[3]); w.z = pk2(v1[0], v1[1]); w.w = pk2(v1[2], v1[3]);
                        *(u32x4*)(gd + off + bj * HALF) = w; } }
        } else {
            const bf16_t* gc = GT + 2 * DM;
            u32x4 g[2][4][2];
#pragma unroll
            for (int ai = 0; ai < 2; ++ai)
#pragma unroll
                for (int m = 0; m < 4; ++m)
#pragma unroll
                    for (int bj = 0; bj < 2; ++bj) g[ai][m][bj] = *(const u32x4*)(gc + (size_t)(row0 + ai * HALF + m * 16) * GTW + col0 + bj * HALF);
#pragma unroll
            for (int ai = 0; ai < 2; ++ai)
#pragma unroll
                for (int m = 0; m < 4; ++m) { const size_t r = (size_t)(row0 + ai * HALF + m * 16);
#pragma unroll
                    for (int bj = 0; bj < 2; ++bj) { const u32x4 gg = g[ai][m][bj];
                        const f32x4 v0 = acc[ai][bj][m][0], v1 = acc[ai][bj][m][1];
                        u32x4 w; w.x = pk2(v0[0] * __builtin_amdgcn_rcpf(bflo(gg.x)), v0[1] * __builtin_amdgcn_rcpf(bfhi(gg.x))); w.y = pk2(v0[2] * __builtin_amdgcn_rcpf(bflo(gg.y)), v0[3] * __builtin_amdgcn_rcpf(bfhi(gg.y)));
                        w.z = pk2(v1[0] * __builtin_amdgcn_rcpf(bflo(gg.z)), v1[1] * __builtin_amdgcn_rcpf(bfhi(gg.z))); w.w = pk2(v1[2] * __builtin_amdgcn_rcpf(bflo(gg.w)), v1[3] * __builtin_amdgcn_rcpf(bfhi(gg.w)));
                        *(u32x4*)(O + r * ldc + col0 + bj * HALF) = w; } }
        }
    }
};

template <class Epi, class Sched, bool ALIGN_EPI = false, bool SP2 = false>
__device__ __forceinline__ void gemm_phase(PG8_LAS unsigned char* lds, const Gemm g, const Sched& S, const Epi& E) {
    const int tid = opaque_tid(), wid = __builtin_amdgcn_readfirstlane(tid >> 6), lane = tid & 63, wr = wid >> 2, wc = wid & 3, fr = lane & 15, fq = lane >> 4;
    const int K = g.K, nt_default = K / BK;
    unsigned voffA[2], voffB[2];
#pragma unroll
    for (int i = 0; i < 2; ++i) { int R, C; stage_rc(tid * 16 + i * 8192, R, C); const int Rb = Epi::PERM ? ((R & ~31) + perm32(R & 31)) : R;
        voffA[i] = (unsigned)(R * g.lda + C) * 2u; voffB[i] = (unsigned)(Rb * g.ldb + C) * 2u; }
    const unsigned kstep = (unsigned)(BK * 2);
    const unsigned hstepA = (unsigned)HALF * g.lda * 2, hstepB = (unsigned)HALF * g.ldb * 2;
    const unsigned tstepA = 2 * hstepA, tstepB = 2 * hstepB;
    const __amdgpu_buffer_rsrc_t rA = __builtin_amdgcn_make_buffer_rsrc((void*)g.A, 0, (int)0xffffffffu, 0x00020000), rB = __builtin_amdgcn_make_buffer_rsrc((void*)g.Bt, 0, (int)0xffffffffu, 0x00020000);
    const unsigned ldsw = (unsigned)wid * 1024u;
    const int aoff = lds_byte(wr * 64 + fr, fq * 8), boff = lds_byte(wc * 32 + fr, fq * 8);
#define PG8_SA(b, h) (((b) * 2 + (h)) * HTB)
#define PG8_SB(b, h) ((4 + (b) * 2 + (h)) * HTB)
#define PG8_STAGE(bufoff, gbase, voff) do { _Pragma("unroll") for (int _i = 0; _i < 2; ++_i) \
        __builtin_amdgcn_raw_ptr_buffer_load_lds(PG8_RSRC_##voff, (PG8_LAS void*)(lds + (bufoff) + ldsw + _i * 8192), 16, (int)(voff)[_i], (int)(gbase), 0, 0); } while (0)
#define PG8_RSRC_voffA rA
#define PG8_RSRC_voffB rB
#define PG8_LDA(dst, b, h) do { _Pragma("unroll") for (int m = 0; m < 4; ++m) _Pragma("unroll") for (int k = 0; k < 2; ++k) dst[m][k] = *(const PG8_LAS bf16x8*)(lds + PG8_SA(b, h) + aoff + m * 2048 + k * 1024); } while (0)
#define PG8_LDB(dst, b, h) do { _Pragma("unroll") for (int n = 0; n < 2; ++n) _Pragma("unroll") for (int k = 0; k < 2; ++k) dst[n][k] = *(const PG8_LAS bf16x8*)(lds + PG8_SB(b, h) + boff + n * 2048 + k * 1024); } while (0)
#ifndef PG8_BAL
#define PG8_BAL 3
#endif
#ifndef PG8_STAGE_LATE
#define PG8_STAGE_LATE 0
#endif
#ifndef PG8_PRIO
#define PG8_PRIO 1
#endif
#define PG8_MMA(ai, bj, At, Bt) do { if (PG8_PRIO) __builtin_amdgcn_s_setprio(PG8_PRIO); _Pragma("unroll") for (int m = 0; m < 4; ++m) _Pragma("unroll") for (int n = 0; n < 2; ++n) _Pragma("unroll") for (int k = 0; k < 2; ++k) \
        acc[ai][bj][m][n] = __builtin_amdgcn_mfma_f32_16x16x32_bf16(Bt[n][k], At[m][k], acc[ai][bj][m][n], 0, 0, 0); if (PG8_PRIO) __builtin_amdgcn_s_setprio(0); } while (0)
#define PG8_WAIT_V(n) asm volatile("s_waitcnt vmcnt(" #n ")" ::: "memory")
#define PG8_WAIT_L(n) asm volatile("s_waitcnt lgkmcnt(" #n ")" ::: "memory")
#define PG8_BAR __builtin_amdgcn_s_barrier()
#define PG8_SCHED __builtin_amdgcn_sched_barrier(0)
    Unit cur, nxt; int ui = 0;
    if (!S.next(0, cur)) return;
    f32x4 acc[2][2][4][2];
#pragma unroll
    for (int a = 0; a < 2; ++a)
#pragma unroll
        for (int b = 0; b < 2; ++b)
#pragma unroll
            for (int m = 0; m < 4; ++m)
#pragma unroll
                for (int n = 0; n < 2; ++n) acc[a][b][m][n] = (f32x4){0.f, 0.f, 0.f, 0.f};
    bf16x8 At[4][2], B0[2][2], B1[2][2];
#if PG8_BAL == 3
    bf16x8 B0n[2][2];
#endif
    unsigned cA = (unsigned)cur.pm * tstepA + (unsigned)S.koff(cur) * 2u, cB = (unsigned)cur.pn * tstepB + (unsigned)S.koff(cur) * 2u;
    int nt = S.nt(cur, nt_default);
    S.a_ready(cur);
    if constexpr (SP2) {
        PG8_STAGE(PG8_SB(0, 0), cB, voffB); PG8_STAGE(PG8_SB(0, 1), cB + hstepB, voffB); PG8_STAGE(PG8_SA(0, 0), cA, voffA); PG8_STAGE(PG8_SA(0, 1), cA + hstepA, voffA);
        if (wr == 1) PG8_BAR;
        PG8_WAIT_V(2); PG8_BAR;
#if PG8_BAL == 2
        PG8_STAGE(PG8_SA(1, 0), cA + kstep, voffA); PG8_STAGE(PG8_SB(1, 0), cB + kstep, voffB);
        PG8_WAIT_V(6); PG8_BAR;
#elif PG8_BAL
        PG8_STAGE(PG8_SB(1, 0), cB + kstep, voffB); PG8_STAGE(PG8_SB(1, 1), cB + hstepB + kstep, voffB);
        PG8_WAIT_V(4); PG8_BAR;
#if PG8_BAL == 3
        PG8_LDB(B0, 0, 0);
#endif
#else
        PG8_STAGE(PG8_SB(1, 0), cB + kstep, voffB); PG8_STAGE(PG8_SA(1, 0), cA + kstep, voffA); PG8_STAGE(PG8_SB(1, 1), cB + hstepB + kstep, voffB);
        PG8_WAIT_V(6); PG8_BAR;
#endif
    } else {
        PG8_STAGE(PG8_SB(0, 0), cB, voffB); PG8_STAGE(PG8_SA(0, 0), cA, voffA); PG8_STAGE(PG8_SB(0, 1), cB + hstepB, voffB); PG8_STAGE(PG8_SA(0, 1), cA + hstepA, voffA);
        if (wr == 1) PG8_BAR;
        PG8_WAIT_V(4); PG8_BAR;
        PG8_STAGE(PG8_SB(1, 0), cB + kstep, voffB); PG8_STAGE(PG8_SA(1, 0), cA + kstep, voffA); PG8_STAGE(PG8_SB(1, 1), cB + hstepB + kstep, voffB);
        PG8_WAIT_V(6); PG8_BAR;
    }
    for (;;) {
        const bool has_next = S.next(ui + 1, nxt);
        const unsigned nA = has_next ? (unsigned)nxt.pm * tstepA + (unsigned)S.koff(nxt) * 2u : cA, nB = has_next ? (unsigned)nxt.pn * tstepB + (unsigned)S.koff(nxt) * 2u : cB;
        for (int t = 0; t < nt; t += 2) {
            const bool last = (t == nt - 2);
            if constexpr (Epi::HOOK) { if (E.hook_at(cur, t)) E.hook(acc, cur, t, wr, wc, fr, fq); }
            const unsigned a1 = cA + (unsigned)(t + 1) * kstep;
            const unsigned a2 = last ? nA : cA + (unsigned)(t + 2) * kstep, b2 = last ? nB : cB + (unsigned)(t + 2) * kstep;
            const unsigned a3 = a2 + kstep, b3 = b2 + kstep;
            if (last && has_next) S.a_ready(nxt);
            if constexpr (SP2) {
#if PG8_BAL == 2
            { const unsigned b1 = cB + (unsigned)(t + 1) * kstep;
            PG8_LDB(B0, 0, 0); PG8_LDB(B1, 0, 1); PG8_SCHED; PG8_LDA(At, 0, 0); PG8_STAGE(PG8_SB(1, 1), b1 + hstepB, voffB); PG8_STAGE(PG8_SA(1, 1), a1 + hstepA, voffA);
            PG8_WAIT_V(8); PG8_WAIT_L(0); PG8_BAR; PG8_MMA(0, 0, At, B0); PG8_MMA(0, 1, At, B1); PG8_BAR; PG8_SCHED;
            PG8_LDA(At, 0, 1); PG8_STAGE(PG8_SA(0, 0), a2, voffA); PG8_STAGE(PG8_SB(0, 0), b2, voffB);
            PG8_WAIT_V(6); PG8_WAIT_L(0); PG8_BAR; PG8_MMA(1, 0, At, B0); PG8_MMA(1, 1, At, B1); PG8_BAR; PG8_SCHED;
            PG8_LDB(B0, 1, 0); PG8_LDB(B1, 1, 1); PG8_SCHED; PG8_LDA(At, 1, 0); PG8_STAGE(PG8_SB(0, 1), b2 + hstepB, voffB); PG8_STAGE(PG8_SA(0, 1), a2 + hstepA, voffA);
            PG8_WAIT_V(8); PG8_WAIT_L(0); PG8_BAR; PG8_MMA(0, 0, At, B0); PG8_MMA(0, 1, At, B1); PG8_BAR; PG8_SCHED;
            PG8_LDA(At, 1, 1); PG8_STAGE(PG8_SA(1, 0), a3, voffA); PG8_STAGE(PG8_SB(1, 0), b3, voffB);
            PG8_WAIT_V(6); PG8_WAIT_L(0); PG8_BAR; PG8_MMA(1, 0, At, B0); PG8_MMA(1, 1, At, B1); PG8_BAR; PG8_SCHED; }
#elif PG8_BAL == 3
            PG8_LDB(B1, 0, 1); PG8_SCHED; PG8_LDA(At, 0, 0); PG8_STAGE(PG8_SA(1, 0), a1, voffA); PG8_STAGE(PG8_SA(1, 1), a1 + hstepA, voffA);
            PG8_WAIT_V(6); PG8_WAIT_L(0); PG8_BAR; PG8_MMA(0, 0, At, B0); PG8_MMA(0, 1, At, B1); PG8_BAR; PG8_SCHED;
            PG8_LDA(At, 0, 1); PG8_LDB(B0n, 1, 0); PG8_STAGE(PG8_SB(0, 0), b2, voffB); PG8_STAGE(PG8_SB(0, 1), b2 + hstepB, voffB);
            PG8_WAIT_V(6); PG8_WAIT_L(0); PG8_BAR; PG8_MMA(1, 0, At, B0); PG8_MMA(1, 1, At, B1); PG8_BAR; PG8_SCHED;
            PG8_LDB(B1, 1, 1); PG8_SCHED; PG8_LDA(At, 1, 0); PG8_STAGE(PG8_SA(0, 0), a2, voffA); PG8_STAGE(PG8_SA(0, 1), a2 + hstepA, voffA);
            PG8_WAIT_V(6); PG8_WAIT_L(0); PG8_BAR; PG8_MMA(0, 0, At, B0n); PG8_MMA(0, 1, At, B1); PG8_BAR; PG8_SCHED;
            PG8_LDA(At, 1, 1); PG8_LDB(B0, 0, 0); PG8_STAGE(PG8_SB(1, 0), b3, voffB); PG8_STAGE(PG8_SB(1, 1), b3 + hstepB, voffB);
            PG8_WAIT_V(6); PG8_WAIT_L(0); PG8_BAR; PG8_MMA(1, 0, At, B0n); PG8_MMA(1, 1, At, B1); PG8_BAR; PG8_SCHED;
            (void)a3;
#elif PG8_BAL
            PG8_LDB(B0, 0, 0); PG8_LDB(B1, 0, 1); PG8_SCHED; PG8_LDA(At, 0, 0); PG8_STAGE(PG8_SA(1, 0), a1, voffA); PG8_STAGE(PG8_SA(1, 1), a1 + hstepA, voffA);
            PG8_WAIT_V(8); PG8_WAIT_L(0); PG8_BAR; PG8_MMA(0, 0, At, B0); PG8_MMA(0, 1, At, B1); PG8_BAR; PG8_SCHED;
            PG8_LDA(At, 0, 1); PG8_STAGE(PG8_SB(0, 0), b2, voffB); PG8_STAGE(PG8_SB(0, 1), b2 + hstepB, voffB);
            PG8_WAIT_V(6); PG8_WAIT_L(0); PG8_BAR; PG8_MMA(1, 0, At, B0); PG8_MMA(1, 1, At, B1); PG8_BAR; PG8_SCHED;
            PG8_LDB(B0, 1, 0); PG8_LDB(B1, 1, 1); PG8_SCHED; PG8_LDA(At, 1, 0); PG8_STAGE(PG8_SA(0, 0), a2, voffA); PG8_STAGE(PG8_SA(0, 1), a2 + hstepA, voffA);
            PG8_WAIT_V(8); PG8_WAIT_L(0); PG8_BAR; PG8_MMA(0, 0, At, B0); PG8_MMA(0, 1, At, B1); PG8_BAR; PG8_SCHED;
            PG8_LDA(At, 1, 1); PG8_STAGE(PG8_SB(1, 0), b3, voffB); PG8_STAGE(PG8_SB(1, 1), b3 + hstepB, voffB);
            PG8_WAIT_V(6); PG8_WAIT_L(0); PG8_BAR; PG8_MMA(1, 0, At, B0); PG8_MMA(1, 1, At, B1); PG8_BAR; PG8_SCHED;
            (void)a3;
#else
#if PG8_STAGE_LATE
            PG8_LDB(B0, 0, 0); PG8_LDB(B1, 0, 1); PG8_SCHED; PG8_LDA(At, 0, 0); PG8_WAIT_L(0); PG8_SCHED; PG8_STAGE(PG8_SA(1, 1), a1 + hstepA, voffA);
            PG8_WAIT_V(8); PG8_BAR;
#else
            PG8_LDB(B0, 0, 0); PG8_LDB(B1, 0, 1); PG8_SCHED; PG8_LDA(At, 0, 0); PG8_STAGE(PG8_SA(1, 1), a1 + hstepA, voffA);
            PG8_WAIT_V(8); PG8_WAIT_L(0); PG8_BAR;
#endif
            PG8_MMA(0, 0, At, B0); PG8_MMA(0, 1, At, B1); PG8_BAR; PG8_SCHED;
#if PG8_STAGE_LATE
            PG8_LDA(At, 0, 1); PG8_WAIT_L(0); PG8_SCHED; PG8_STAGE(PG8_SB(0, 0), b2, voffB); PG8_STAGE(PG8_SB(0, 1), b2 + hstepB, voffB); PG8_STAGE(PG8_SA(0, 0), a2, voffA);
            PG8_WAIT_V(8); PG8_BAR;
#else
            PG8_LDA(At, 0, 1); PG8_STAGE(PG8_SB(0, 0), b2, voffB); PG8_STAGE(PG8_SB(0, 1), b2 + hstepB, voffB); PG8_STAGE(PG8_SA(0, 0), a2, voffA);
            PG8_WAIT_V(8); PG8_WAIT_L(0); PG8_BAR;
#endif
            PG8_MMA(1, 0, At, B0); PG8_MMA(1, 1, At, B1); PG8_BAR; PG8_SCHED;
#if PG8_STAGE_LATE
            PG8_LDB(B0, 1, 0); PG8_LDB(B1, 1, 1); PG8_SCHED; PG8_LDA(At, 1, 0); PG8_WAIT_L(0); PG8_SCHED; PG8_STAGE(PG8_SA(0, 1), a2 + hstepA, voffA);
            PG8_WAIT_V(8); PG8_BAR;
#else
            PG8_LDB(B0, 1, 0); PG8_LDB(B1, 1, 1); PG8_SCHED; PG8_LDA(At, 1, 0); PG8_STAGE(PG8_SA(0, 1), a2 + hstepA, voffA);
            PG8_WAIT_V(8); PG8_WAIT_L(0); PG8_BAR;
#endif
            PG8_MMA(0, 0, At, B0); PG8_MMA(0, 1, At, B1); PG8_BAR; PG8_SCHED;
#if PG8_STAGE_LATE
            PG8_LDA(At, 1, 1); PG8_WAIT_L(0); PG8_SCHED; PG8_STAGE(PG8_SB(1, 0), b3, voffB); PG8_STAGE(PG8_SB(1, 1), b3 + hstepB, voffB); PG8_STAGE(PG8_SA(1, 0), a3, voffA);
            PG8_WAIT_V(8); PG8_BAR;
#else
            PG8_LDA(At, 1, 1); PG8_STAGE(PG8_SB(1, 0), b3, voffB); PG8_STAGE(PG8_SB(1, 1), b3 + hstepB, voffB); PG8_STAGE(PG8_SA(1, 0), a3, voffA);
            PG8_WAIT_V(8); PG8_WAIT_L(0); PG8_BAR;
#endif
            PG8_MMA(1, 0, At, B0); PG8_MMA(1, 1, At, B1); PG8_BAR; PG8_SCHED;
#endif
            } else {
            PG8_LDB(B0, 0, 0); PG8_SCHED; PG8_LDA(At, 0, 0); PG8_STAGE(PG8_SA(1, 1), a1 + hstepA, voffA);
            PG8_WAIT_L(8); PG8_BAR; PG8_WAIT_L(0); PG8_MMA(0, 0, At, B0); PG8_BAR; PG8_SCHED;
            PG8_LDB(B1, 0, 1); PG8_STAGE(PG8_SB(0, 0), b2, voffB);
            PG8_BAR; PG8_WAIT_L(0); PG8_MMA(0, 1, At, B1); PG8_BAR;
            PG8_LDA(At, 0, 1); PG8_STAGE(PG8_SA(0, 0), a2, voffA);
            PG8_BAR; PG8_WAIT_L(0); PG8_MMA(1, 0, At, B0); PG8_BAR; PG8_SCHED;
            PG8_STAGE(PG8_SB(0, 1), b2 + hstepB, voffB);
            PG8_WAIT_V(6); PG8_BAR; PG8_MMA(1, 1, At, B1); PG8_BAR;
            PG8_LDB(B0, 1, 0); PG8_SCHED; PG8_LDA(At, 1, 0); PG8_STAGE(PG8_SA(0, 1), a2 + hstepA, voffA);
            PG8_WAIT_L(8); PG8_BAR; PG8_WAIT_L(0); PG8_MMA(0, 0, At, B0); PG8_BAR; PG8_SCHED;
            PG8_LDB(B1, 1, 1); PG8_STAGE(PG8_SB(1, 0), b3, voffB);
            PG8_BAR; PG8_WAIT_L(0); PG8_MMA(0, 1, At, B1); PG8_BAR;
            PG8_LDA(At, 1, 1); PG8_STAGE(PG8_SA(1, 0), a3, voffA);
            PG8_BAR; PG8_WAIT_L(0); PG8_MMA(1, 0, At, B0); PG8_BAR; PG8_SCHED;
            PG8_STAGE(PG8_SB(1, 1), b3 + hstepB, voffB);
            PG8_WAIT_V(6); PG8_BAR; PG8_MMA(1, 1, At, B1); PG8_BAR;
            }
        }
        if constexpr (ALIGN_EPI) { if (wr == 0) PG8_BAR; }
        E(acc, cur, wr, wc, fr, fq); S.done(cur);
        if (!has_next) break;
#pragma unroll
        for (int a = 0; a < 2; ++a)
#pragma unroll
            for (int b = 0; b < 2; ++b)
#pragma unroll
                for (int m = 0; m < 4; ++m)
#pragma unroll
                    for (int n = 0; n < 2; ++n) acc[a][b][m][n] = (f32x4){0.f, 0.f, 0.f, 0.f};
        cur = nxt; cA = nA; cB = nB; ++ui; nt = S.nt(cur, nt_default);
        if constexpr (ALIGN_EPI) { if (wr == 1) PG8_BAR; }
    }
    PG8_WAIT_V(0);
    if constexpr (!ALIGN_EPI) { if (wr == 0) PG8_BAR; }
    PG8_BAR;
#undef PG8_SA
#undef PG8_SB
#undef PG8_STAGE
#undef PG8_RSRC_voffA
#undef PG8_RSRC_voffB
#undef PG8_LDA
#undef PG8_LDB
#undef PG8_MMA
#undef PG8_WAIT_V
#undef PG8_WAIT_L
#undef PG8_BAR
#undef PG8_SCHED
}
}

#define XB_TMO      128
#define XB_XCNT(j)  (256  + 64 * (j))
#define XB_XSUB(j)  (1280 + 64 * (j))
#define XB_XGEN(j)  (2304 + 64 * (j))
#define XB_TOP      3328
#define XB_TOPGEN   3392
#define XCD_BAR_WORDS 3456
#define XB_SPIN_CAP (1u << 18)

__device__ __forceinline__ unsigned xb_ld(unsigned* p)              { return __hip_atomic_load(p, __ATOMIC_RELAXED, __HIP_MEMORY_SCOPE_AGENT); }
__device__ __forceinline__ unsigned xb_add(unsigned* p, unsigned v) { return __hip_atomic_fetch_add(p, v, __ATOMIC_RELAXED, __HIP_MEMORY_SCOPE_AGENT); }
__device__ __forceinline__ unsigned xb_xcc_id() { return (unsigned)__builtin_amdgcn_s_getreg((3 << 11) | 20) & 0xFu; }
#define XB_SPIN(cond, bar) do { unsigned _sp = 0; while (cond) { __builtin_amdgcn_s_sleep(1); \
    if ((++_sp & 255u) == 0u) { if (xb_ld(&(bar)[XB_TMO])) break; if (_sp > XB_SPIN_CAP) { atomicAdd(&(bar)[XB_TMO], 1u); break; } } } } while (0)

struct XcdBarrier {
    unsigned* bar; unsigned x;
    volatile LAS unsigned* st;
};
__device__ __forceinline__ XcdBarrier xcd_barrier_post(unsigned* bar, volatile LAS unsigned* st) {
    XcdBarrier b; b.bar = bar; b.x = xb_xcc_id(); b.st = st;
    if (threadIdx.x == 0) (void)xb_add(&bar[XB_XCNT(b.x)], 1u);
    return b;
}
__device__ __forceinline__ void xcd_barrier_complete(unsigned* bar, unsigned x, unsigned& nloc, unsigned& nx) {
    const unsigned G = gridDim.x * gridDim.y * gridDim.z;
    unsigned sum, cnt, mine, sp = 0u;
    for (;;) {
        sum = 0u; cnt = 0u; mine = 0u;
#pragma unroll
        for (unsigned j = 0; j < 16; ++j) { const unsigned c = xb_ld(&bar[XB_XCNT(j)]); sum += c; cnt += (c > 0u) ? 1u : 0u; mine = (j == x) ? c : mine; }
        if (sum == G) break;
        __builtin_amdgcn_s_sleep(1);
        if ((++sp & 255u) == 0u) { if (xb_ld(&bar[XB_TMO])) break; if (sp > XB_SPIN_CAP) { atomicAdd(&bar[XB_TMO], 1u); break; } }
    }
    nloc = mine > 0u ? mine : 1u; nx = cnt > 0u ? cnt : 1u;
}
__device__ __forceinline__ void xcd_barrier(const XcdBarrier& b) {
    asm volatile("s_waitcnt vmcnt(0)" ::: "memory");
    __syncthreads();
    if (threadIdx.x == 0) {
        unsigned* bar = b.bar;
        __builtin_amdgcn_s_waitcnt(0);
        unsigned nloc = b.st[0], nx = b.st[1];
        if (nloc == 0u) { xcd_barrier_complete(bar, b.x, nloc, nx); b.st[0] = nloc; b.st[1] = nx; }
        const unsigned old = xb_add(&bar[XB_XSUB(b.x)], 1u);
        const unsigned gen = old / nloc;
        if (old + 1u == (gen + 1u) * nloc) {
            __builtin_amdgcn_fence(__ATOMIC_RELEASE, "agent");
            asm volatile("s_waitcnt vmcnt(0)" ::: "memory");
            const unsigned og = xb_add(&bar[XB_TOP], 1u);
            const unsigned tg = og / nx;
            if (og + 1u == (tg + 1u) * nx) xb_add(&bar[XB_TOPGEN], 1u);
            else XB_SPIN(xb_ld(&bar[XB_TOPGEN]) == tg, bar);
            __builtin_amdgcn_fence(__ATOMIC_ACQUIRE, "agent");
            xb_add(&bar[XB_XGEN(b.x)], 1u);
            asm volatile("s_waitcnt vmcnt(0)" ::: "memory");
        } else {
            XB_SPIN(xb_ld(&bar[XB_XGEN(b.x)]) == gen, bar);
            __builtin_amdgcn_fence(__ATOMIC_ACQUIRE, "agent");
            asm volatile("s_waitcnt vmcnt(0)" ::: "memory");
        }
    }
    __syncthreads();
}

struct Params { const float* in[23]; float* out; unsigned char* ws; };
enum { I_X = 0, I_MEM, I_NORM_MIX, I_W_IN, I_W_GLA_A, I_B_GLA_A, I_GLA_NORM, I_CONV_W, I_CONV_B, I_B_ML_I, I_B_ML_F, I_ML_NORM, I_MEM_NORM, I_W_MEM_K, I_W_MEM_V, I_W_BRANCH, I_W_GATE, I_B_GATE, I_W_OUT, I_NORM_FFN, I_W_FF1, I_W_FF2, I_FINAL_NORM };

DI int win_row(int n) {
    if (n < 3072) return n;
    if (n < 3088) return ZC_GA + (n - 3072);
    if (n < 6160) return n - 16;
    if (n < 6168) return ZC_MI + (n - 6160);
    return n - 24;
}
DI void transpose_item(const float* __restrict__ W, int K, int N, bf16_t* __restrict__ WT, int ld_dst, int col_off, int row_off, bool remap, LAS float* scr, int item, int lane, const float* __restrict__ gain = nullptr) {
    const int nblk = (N + 63) >> 6, kb = item / nblk, nb = item - kb * nblk, k0 = kb << 6, n0 = nb << 6;
    const int a = lane & 15, q = lane >> 4, n4 = 4 * a;
    const bool ok = (n0 + n4) < N;
    f32x4 v[16];
#pragma unroll
    for (int i = 0; i < 16; ++i) { const int kk = 4 * i + q; v[i] = ok ? *(const f32x4*)(W + (size_t)(k0 + kk) * N + n0 + n4) : (f32x4){0.f, 0.f, 0.f, 0.f}; }
#pragma unroll
    for (int i = 0; i < 16; ++i) { const int kk = 4 * i + q;
#pragma unroll
        for (int e = 0; e < 4; ++e) scr[(n4 + e) * 65 + kk] = v[i][e]; }
    asm volatile("s_waitcnt lgkmcnt(0)" ::: "memory");
    const int c = lane & 7;
    f32x4 g0 = (f32x4){1.f, 1.f, 1.f, 1.f}, g1 = g0;
    if (gain) { g0 = *(const f32x4*)(gain + k0 + 8 * c); g1 = *(const f32x4*)(gain + k0 + 8 * c + 4); }
#pragma unroll
    for (int jj = 0; jj < 8; ++jj) { const int n = (lane >> 3) + 8 * jj; const LAS float* s = scr + n * 65 + 8 * c;
        u32x4 o; o.x = pk2(s[0] * g0[0], s[1] * g0[1]); o.y = pk2(s[2] * g0[2], s[3] * g0[3]); o.z = pk2(s[4] * g1[0], s[5] * g1[1]); o.w = pk2(s[6] * g1[2], s[7] * g1[3]);
        const int ng = n0 + n;
        if (ng < N) { const int row = row_off + (remap ? win_row(ng) : ng); *(u32x4*)(WT + (size_t)row * ld_dst + col_off + k0 + 8 * c) = o; } }
    asm volatile("s_waitcnt lgkmcnt(0)" ::: "memory");
}

template <bool OUT_F32> DI void rmsnorm_row(const float* __restrict__ xrow, const float* __restrict__ g, void* orow, int lane) {
    const f32x4* xr = (const f32x4*)xrow + lane; const f32x4* gr = (const f32x4*)g + lane;
    f32x4 v[16]; float s = 0.f;
#pragma unroll
    for (int j = 0; j < 16; ++j) { v[j] = xr[64 * j]; s += (v[j].x * v[j].x + v[j].y * v[j].y) + (v[j].z * v[j].z + v[j].w * v[j].w); }
    const float rstd = 1.0f / sqrtf(wave_sum(s, lane) * (1.0f / DM) + EPS);
#pragma unroll
    for (int j = 0; j < 16; ++j) { const f32x4 gg = gr[64 * j]; const f32x4 o = v[j] * rstd * gg;
        if (OUT_F32) ((f32x4*)orow)[lane + 64 * j] = o;
        else { u32x2 w; w.x = pk2(o.x, o.y); w.y = pk2(o.z, o.w); ((u32x2*)orow)[lane + 64 * j] = w; } }
}

DI void row_bf16_ss(const float* __restrict__ xrow, bf16_t* orow, unsigned long long* ss, int lane) {
    const f32x4* xr = (const f32x4*)xrow + lane; float s = 0.f;
#pragma unroll
    for (int j = 0; j < 16; ++j) { const f32x4 v = xr[64 * j]; s += (v.x * v.x + v.y * v.y) + (v.z * v.z + v.w * v.w);
        u32x2 w; w.x = pk2(v.x, v.y); w.y = pk2(v.z, v.w); ((u32x2*)orow)[lane + 64 * j] = w; }
    s = wave_sum(s, lane);
    if (lane == 0) *ss = (unsigned long long)(s * 16777216.0f);
}
DI void row_scale_f32(const float* __restrict__ xrow, const float* __restrict__ g, float ssv, float* orow, int lane) {
    const f32x4* xr = (const f32x4*)xrow + lane; const f32x4* gr = (const f32x4*)g + lane;
    const float rstd = 1.0f / sqrtf(ssv * (1.0f / DM) + EPS);
#pragma unroll
    for (int j = 0; j < 16; ++j) ((f32x4*)orow)[lane + 64 * j] = xr[64 * j] * rstd * gr[64 * j];
}

DI void fill_vT(const bf16_t* __restrict__ Zv, int n, int tg, int lane, LAS unsigned char* VT) {
#pragma unroll
    for (int i = 0; i < 2; ++i) { const int cp = lane + 64 * i; unsigned w[8];
#pragma unroll
        for (int j = 0; j < 8; ++j) w[j] = *(const unsigned*)(Zv + (size_t)(n * CH + 8 * tg + j) * ZW + 2 * cp);
        u32x4 lo, hi;
        lo.x = (w[0] & 0xffffu) | (w[1] << 16); lo.y = (w[2] & 0xffffu) | (w[3] << 16); lo.z = (w[4] & 0xffffu) | (w[5] << 16); lo.w = (w[6] & 0xffffu) | (w[7] << 16);
        hi.x = (w[0] >> 16) | (w[1] & 0xffff0000u); hi.y = (w[2] >> 16) | (w[3] & 0xffff0000u); hi.z = (w[4] >> 16) | (w[5] & 0xffff0000u); hi.w = (w[6] >> 16) | (w[7] & 0xffff0000u);
        *(LAS u32x4*)(VT + (2 * cp) * ROW72 + tg * 16) = lo; *(LAS u32x4*)(VT + (2 * cp + 1) * ROW72 + tg * 16) = hi; }
}
DI void state_mfma(const LAS unsigned char* VT, const LAS unsigned char* KT, bf16_t* __restrict__ OUT, int w, int lane) {
    const int fr = lane & 15, fq = lane >> 4;
    f32x4 acc[2][8];
#pragma unroll
    for (int mi = 0; mi < 2; ++mi)
#pragma unroll
        for (int ni = 0; ni < 8; ++ni) acc[mi][ni] = (f32x4){0.f, 0.f, 0.f, 0.f};
#pragma unroll
    for (int ks = 0; ks < 2; ++ks) {
        bf16x8 a[2];
#pragma unroll
        for (int mi = 0; mi < 2; ++mi) a[mi] = *(const LAS bf16x8*)(VT + (32 * w + 16 * mi + fr) * ROW72 + (32 * ks + 8 * fq) * 2);
#pragma unroll
        for (int ni = 0; ni < 8; ++ni) { const bf16x8 b = *(const LAS bf16x8*)(KT + (16 * ni + fr) * ROW72 + (32 * ks + 8 * fq) * 2);
#pragma unroll
            for (int mi = 0; mi < 2; ++mi) acc[mi][ni] = mfma16(b, a[mi], acc[mi][ni]); }
    }
#pragma unroll
    for (int mi = 0; mi < 2; ++mi)
#pragma unroll
        for (int ni = 0; ni < 8; ++ni) *(u32x2*)(OUT + (size_t)(32 * w + 16 * mi + fr) * 128 + 16 * ni + 4 * fq) = (u32x2){pk2(acc[mi][ni][0], acc[mi][ni][1]), pk2(acc[mi][ni][2], acc[mi][ni][3])};
}
DI void copy_256x128(const bf16_t* __restrict__ src, int gp, LAS unsigned char* dst, int tid) {
#pragma unroll
    for (int i = 0; i < 8; ++i) { const int id = tid + 512 * i, row = id >> 4, cc = id & 15;
        *(LAS u32x4*)(dst + row * ROW136 + cc * 16) = *(const u32x4*)(src + (size_t)row * gp + cc * 8); }
}

DI void ld_v(const bf16_t* __restrict__ Zv, int n, int tg, int lane, unsigned (&w)[2][8]) {
#pragma unroll
    for (int i = 0; i < 2; ++i)
#pragma unroll
        for (int j = 0; j < 8; ++j) w[i][j] = *(const unsigned*)(Zv + (size_t)(n * CH + 8 * tg + j) * ZW + 2 * (lane + 64 * i));
}
DI void st_vT(const unsigned (&w)[2][8], int tg, int lane, LAS unsigned char* VT) {
#pragma unroll
    for (int i = 0; i < 2; ++i) { const int cp = lane + 64 * i; u32x4 lo, hi;
        lo.x = (w[i][0] & 0xffffu) | (w[i][1] << 16); lo.y = (w[i][2] & 0xffffu) | (w[i][3] << 16); lo.z = (w[i][4] & 0xffffu) | (w[i][5] << 16); lo.w = (w[i][6] & 0xffffu) | (w[i][7] << 16);
        hi.x = (w[i][0] >> 16) | (w[i][1] & 0xffff0000u); hi.y = (w[i][2] >> 16) | (w[i][3] & 0xffff0000u); hi.z = (w[i][4] >> 16) | (w[i][5] & 0xffff0000u); hi.w = (w[i][6] >> 16) | (w[i][7] & 0xffff0000u);
        *(LAS u32x4*)(VT + (2 * cp) * ROW72 + tg * 16) = lo; *(LAS u32x4*)(VT + (2 * cp + 1) * ROW72 + tg * 16) = hi; }
}
DI void ld_256x128(const bf16_t* __restrict__ src, int gp, int tid, u32x4 (&r)[8]) {
#pragma unroll
    for (int i = 0; i < 8; ++i) { const int id = tid + 512 * i, row = id >> 4, cc = id & 15; r[i] = *(const u32x4*)(src + (size_t)row * gp + cc * 8); }
}
DI void st_256x128(const u32x4 (&r)[8], LAS unsigned char* dst, int tid) {
#pragma unroll
    for (int i = 0; i < 8; ++i) { const int id = tid + 512 * i, row = id >> 4, cc = id & 15; *(LAS u32x4*)(dst + row * ROW136 + cc * 16) = r[i]; }
}
DI void conv_ld(const bf16_t* __restrict__ Zc, int tok0, unsigned (&x)[11]) {
#pragma unroll
    for (int i = 0; i < 11; ++i) { const int tok = tok0 - 3 + i; x[i] = 0u; if (tok >= 0) x[i] = *(const unsigned*)(Zc + (size_t)tok * ZW); }
}
DI void conv_apply(const unsigned (&x)[11], const float* __restrict__ cw, const float* __restrict__ cb, float (&o0)[8], float (&o1)[8]) {
    f32x2 wj[4];
#pragma unroll
    for (int j = 0; j < 4; ++j) wj[j] = *(const f32x2*)(cw + j * 1024);
    const f32x2 bias = *(const f32x2*)cb;
#pragma unroll
    for (int j = 0; j < 8; ++j) { float y0 = bias.x, y1 = bias.y;
#pragma unroll
        for (int jj = 0; jj < 4; ++jj) { y0 += wj[jj].x * bflo(x[j + jj]); y1 += wj[jj].y * bfhi(x[j + jj]); }
        o0[j] = silu_f(y0); o1[j] = silu_f(y1); }
}
DI void gla_b(const bf16_t* __restrict__ Z, const float* __restrict__ wa, const float* __restrict__ ba, int h, int n, int tg, int c2, LAS float* TOT, float (&b)[8][2], float (&blast)[2]) {
    const int col = h * 128 + 2 * c2;
    float w0[16], w1[16];
#pragma unroll
    for (int r = 0; r < 16; ++r) { const f32x2 w = *(const f32x2*)(wa + r * 512 + col); w0[r] = w.x; w1[r] = w.y; }
    const f32x2 bb = *(const f32x2*)(ba + col);
    float c0 = 0.f, c1 = 0.f;
#pragma unroll
    for (int j = 0; j < 8; ++j) {
        const bf16_t* gp = Z + (size_t)(n * CH + 8 * tg + j) * ZW + ZC_GA;
        const u32x4 g0 = *(const u32x4*)gp, g1 = *(const u32x4*)(gp + 8);
        const float gv[16] = {bflo(g0.x), bfhi(g0.x), bflo(g0.y), bfhi(g0.y), bflo(g0.z), bfhi(g0.z), bflo(g0.w), bfhi(g0.w),
                              bflo(g1.x), bfhi(g1.x), bflo(g1.y), bfhi(g1.y), bflo(g1.z), bfhi(g1.z), bflo(g1.w), bfhi(g1.w)};
        float p0 = bb.x, p1 = bb.y;
#pragma unroll
        for (int r = 0; r < 16; ++r) { p0 += gv[r] * w0[r]; p1 += gv[r] * w1[r]; }
        c0 += log_sigmoid_f(p0) * (1.0f / 16.0f); c1 += log_sigmoid_f(p1) * (1.0f / 16.0f);
        b[j][0] = c0; b[j][1] = c1;
    }
    *(LAS f32x2*)(TOT + tg * 128 + 2 * c2) = (f32x2){c0, c1};
    __syncthreads();
    float pre0 = 0.f, pre1 = 0.f, t0 = 0.f, t1 = 0.f;
#pragma unroll
    for (int g = 0; g < 8; ++g) { const f32x2 t = *(const LAS f32x2*)(TOT + g * 128 + 2 * c2); if (g < tg) { pre0 += t.x; pre1 += t.y; } t0 += t.x; t1 += t.y; }
#pragma unroll
    for (int j = 0; j < 8; ++j) { b[j][0] += pre0; b[j][1] += pre1; }
    blast[0] = t0; blast[1] = t1;
}
DI void conv_silu8(const bf16_t* __restrict__ Zc, const float* __restrict__ cw, const float* __restrict__ cb, int tok0, float (&o0)[8], float (&o1)[8]) {
    float x0[11], x1[11];
#pragma unroll
    for (int i = 0; i < 11; ++i) { const int tok = tok0 - 3 + i; unsigned w = 0u; if (tok >= 0) w = *(const unsigned*)(Zc + (size_t)tok * ZW); x0[i] = bflo(w); x1[i] = bfhi(w); }
    f32x2 wj[4];
#pragma unroll
    for (int j = 0; j < 4; ++j) wj[j] = *(const f32x2*)(cw + j * 1024);
    const f32x2 bias = *(const f32x2*)cb;
#pragma unroll
    for (int j = 0; j < 8; ++j) { float y0 = bias.x, y1 = bias.y;
#pragma unroll
        for (int jj = 0; jj < 4; ++jj) { y0 += wj[jj].x * x0[j + jj]; y1 += wj[jj].y * x1[j + jj]; }
        o0[j] = silu_f(y0); o1[j] = silu_f(y1); }
}
DI void score_mfma(const LAS unsigned char* QL, const LAS unsigned char* KL, int w, int lane, f32x4 (&sacc)[2]) {
    const int fr = lane & 15, fq = lane >> 4, mi = w >> 1, ni0 = 2 * (w & 1);
    sacc[0] = (f32x4){0.f, 0.f, 0.f, 0.f}; sacc[1] = sacc[0];
#pragma unroll
    for (int ks = 0; ks < 4; ++ks) { const bf16x8 a = *(const LAS bf16x8*)(QL + (16 * mi + fr) * ROW136 + (32 * ks + 8 * fq) * 2);
#pragma unroll
        for (int jn = 0; jn < 2; ++jn) { const bf16x8 b = *(const LAS bf16x8*)(KL + (16 * (ni0 + jn) + fr) * ROW136 + (32 * ks + 8 * fq) * 2); sacc[jn] = mfma16(b, a, sacc[jn]); } }
}

struct MixCtx {
    const bf16_t* Z; bf16_t* OB;
    const float *wa, *ba, *gla_norm, *conv_w, *conv_b, *b_i, *b_f, *ml_norm;
    float *DECAY, *DN, *NP, *GG, *FL, *MP, *BG; bf16_t *DS, *DC, *SP, *CP;
    const bf16_t *KM, *VMT;
};

DI void gla_A_unit(const MixCtx& C, LAS unsigned char* lds, int h, int n, int tid) {
    const int lane = tid & 63, tg = __builtin_amdgcn_readfirstlane(tid >> 6), c2 = lane;
    LAS float* TOT = (LAS float*)(lds + L_MISC);
    LAS unsigned char* KT = lds + L_ST; LAS unsigned char* VT = lds + L_VT;
    unsigned kw[8], vw[2][8];
#pragma unroll
    for (int j = 0; j < 8; ++j) kw[j] = *(const unsigned*)(C.Z + (size_t)(n * CH + 8 * tg + j) * ZW + ZC_GK + h * 128 + 2 * c2);
    ld_v(C.Z + ZC_GV + h * 256, n, tg, lane, vw);
    float b[8][2], blast[2];
    gla_b(C.Z, C.wa, C.ba, h, n, tg, c2, TOT, b, blast);
    float k0[8], k1[8];
#pragma unroll
    for (int j = 0; j < 8; ++j) { k0[j] = bflo(kw[j]) * __expf(blast[0] - b[j][0]); k1[j] = bfhi(kw[j]) * __expf(blast[1] - b[j][1]);
        *(f32x2*)(C.BG + ((size_t)(h * NCH + n) * CH + 8 * tg + j) * 128 + 2 * c2) = (f32x2){b[j][0], b[j][1]}; }
    u32x4 lo, hi;
    lo.x = pk2(k0[0], k0[1]); lo.y = pk2(k0[2], k0[3]); lo.z = pk2(k0[4], k0[5]); lo.w = pk2(k0[6], k0[7]);
    hi.x = pk2(k1[0], k1[1]); hi.y = pk2(k1[2], k1[3]); hi.z = pk2(k1[4], k1[5]); hi.w = pk2(k1[6], k1[7]);
    *(LAS u32x4*)(KT + (2 * c2) * ROW72 + tg * 16) = lo; *(LAS u32x4*)(KT + (2 * c2 + 1) * ROW72 + tg * 16) = hi;
    if (tg == 0) *(f32x2*)(C.DECAY + (size_t)(h * NCH + n) * 128 + 2 * c2) = (f32x2){__expf(blast[0]), __expf(blast[1])};
    st_vT(vw, tg, lane, VT);
    __syncthreads();
    state_mfma(VT, KT, C.DS + (size_t)(h * NCH + n) * 32768, tg, lane);
    __syncthreads();
}

DI void gla_B_unit(const MixCtx& C, LAS unsigned char* lds, int h, int n, int tid) {
    const int lane = tid & 63, w = __builtin_amdgcn_readfirstlane(tid >> 6), tg = w, c2 = lane, fr = lane & 15, fq = lane >> 4;
    LAS float* RS = (LAS float*)(lds + L_MISC + 4096);
    LAS unsigned char* ST = lds + L_ST; LAS unsigned char* VT = lds + L_VT; LAS unsigned char* QL = lds + L_Q; LAS unsigned char* KL = lds + L_K;
    const int wr = w >> 1, wc = w & 1, t = 16 * wr + fr;
    const size_t tok = (size_t)(n * CH + t);
    u32x4 st[8]; f32x2 bq[8]; unsigned wq[8], wk[8], vw[2][8]; u32x2 gg[8]; f32x4 gn[8];
    ld_256x128(C.SP + (size_t)(h * NCH + n) * 32768, 128, tid, st);
#pragma unroll
    for (int j = 0; j < 8; ++j) { const size_t zr = (size_t)(n * CH + 8 * tg + j) * ZW;
        bq[j] = *(const f32x2*)(C.BG + ((size_t)(h * NCH + n) * CH + 8 * tg + j) * 128 + 2 * c2);
        wq[j] = *(const unsigned*)(C.Z + zr + ZC_GQ + h * 128 + 2 * c2); wk[j] = *(const unsigned*)(C.Z + zr + ZC_GK + h * 128 + 2 * c2); }
    ld_v(C.Z + ZC_GV + h * 256, n, tg, lane, vw);
#pragma unroll
    for (int ni = 0; ni < 8; ++ni) { const int dv = 128 * wc + 16 * ni + 4 * fq; gg[ni] = *(const u32x2*)(C.Z + tok * ZW + ZC_GG + h * 256 + dv); gn[ni] = *(const f32x4*)(C.gla_norm + h * 256 + dv); }
    const float qs = 0.08838834764831845f;
#pragma unroll
    for (int j = 0; j < 8; ++j) { const float e0 = __expf(bq[j].x), e1 = __expf(bq[j].y);
        *(LAS unsigned*)(QL + (8 * tg + j) * ROW136 + 4 * c2) = pk2(bflo(wq[j]) * qs * e0, bfhi(wq[j]) * qs * e1);
        *(LAS unsigned*)(KL + (8 * tg + j) * ROW136 + 4 * c2) = pk2(bflo(wk[j]) * __builtin_amdgcn_rcpf(e0), bfhi(wk[j]) * __builtin_amdgcn_rcpf(e1)); }
    st_vT(vw, tg, lane, VT);
    st_256x128(st, ST, tid);
    __syncthreads();
    f32x4 sacc[2];
    score_mfma(QL, KL, w, lane, sacc);
    __syncthreads();
    { const int mi = w >> 1, ni0 = 2 * (w & 1), t2 = 16 * mi + fr;
#pragma unroll
      for (int jn = 0; jn < 2; ++jn) { const int s0 = 16 * (ni0 + jn) + 4 * fq; f32x4 v = sacc[jn];
#pragma unroll
          for (int r = 0; r < 4; ++r) if (s0 + r > t2) v[r] = 0.f;
          *(LAS u32x2*)(KL + t2 * ROW72 + s0 * 2) = (u32x2){pk2(v[0], v[1]), pk2(v[2], v[3])}; } }
    __syncthreads();
    f32x4 o[8];
#pragma unroll
    for (int ni = 0; ni < 8; ++ni) o[ni] = (f32x4){0.f, 0.f, 0.f, 0.f};
#pragma unroll
    for (int ks = 0; ks < 2; ++ks) { const bf16x8 a = *(const LAS bf16x8*)(KL + t * ROW72 + (32 * ks + 8 * fq) * 2);
#pragma unroll
        for (int ni = 0; ni < 8; ++ni) { const bf16x8 bb = *(const LAS bf16x8*)(VT + (128 * wc + 16 * ni + fr) * ROW72 + (32 * ks + 8 * fq) * 2); o[ni] = mfma16(bb, a, o[ni]); } }
#pragma unroll
    for (int ks = 0; ks < 4; ++ks) { const bf16x8 a = *(const LAS bf16x8*)(QL + t * ROW136 + (32 * ks + 8 * fq) * 2);
#pragma unroll
        for (int ni = 0; ni < 8; ++ni) { const bf16x8 bb = *(const LAS bf16x8*)(ST + (128 * wc + 16 * ni + fr) * ROW136 + (32 * ks + 8 * fq) * 2); o[ni] = mfma16(bb, a, o[ni]); } }
    float ss = 0.f;
#pragma unroll
    for (int ni = 0; ni < 8; ++ni) ss += (o[ni][0] * o[ni][0] + o[ni][1] * o[ni][1]) + (o[ni][2] * o[ni][2] + o[ni][3] * o[ni][3]);
    ss += shx(ss, 16, lane); ss += shx(ss, 32, lane);
    if (fq == 0) RS[wc * 64 + t] = ss;
    __syncthreads();
    const float rstd = 1.0f / sqrtf((RS[t] + RS[64 + t]) * (1.0f / 256.0f) + EPS);
#pragma unroll
    for (int ni = 0; ni < 8; ++ni) { const int dv = 128 * wc + 16 * ni + 4 * fq;
        const f32x4 v = o[ni] * rstd * gn[ni];
        *(u32x2*)(C.OB + tok * OBW + OB_O + h * 256 + dv) = (u32x2){pk2(v[0] * silu_f(bflo(gg[ni].x)), v[1] * silu_f(bfhi(gg[ni].x))), pk2(v[2] * silu_f(bflo(gg[ni].y)), v[3] * silu_f(bfhi(gg[ni].y)))}; }
    __syncthreads();
}

DI void ml_A_unit(const MixCtx& C, LAS unsigned char* lds, int h, int n, int tid) {
    const int lane = tid & 63, tg = __builtin_amdgcn_readfirstlane(tid >> 6), c2 = lane;
    LAS float* PART = (LAS float*)(lds + L_MISC);
    LAS unsigned char* KT = lds + L_ST; LAS unsigned char* VT = lds + L_VT;
    const size_t ztok = (size_t)(n * CH + lane) * ZW;
    const float li = bf2f(C.Z[ztok + ZC_MI + h]) + C.b_i[h];
    const float lf = log_sigmoid_f(bf2f(C.Z[ztok + ZC_MF + h]) + C.b_f[h]);
    const float F = wave_scan_sum(lf, lane);
    const float Flast = shi(F, 63);
    const float Gv = Flast - F + li;
    const float g = wave_max(Gv, lane);
    const float wG = __expf(Gv - g);
    float k0[8], k1[8];
    conv_silu8(C.Z + ZC_MQK + 512 + h * 128 + 2 * c2, C.conv_w + 512 + h * 128 + 2 * c2, C.conv_b + 512 + h * 128 + 2 * c2, n * CH + 8 * tg, k0, k1);
    const float ks = 0.08838834764831845f;
    float p0 = 0.f, p1 = 0.f;
#pragma unroll
    for (int j = 0; j < 8; ++j) { const float wj = shi(wG, 8 * tg + j) * ks; k0[j] *= wj; k1[j] *= wj; p0 += k0[j]; p1 += k1[j]; }
    u32x4 lo, hi;
    lo.x = pk2(k0[0], k0[1]); lo.y = pk2(k0[2], k0[3]); lo.z = pk2(k0[4], k0[5]); lo.w = pk2(k0[6], k0[7]);
    hi.x = pk2(k1[0], k1[1]); hi.y = pk2(k1[2], k1[3]); hi.z = pk2(k1[4], k1[5]); hi.w = pk2(k1[6], k1[7]);
    *(LAS u32x4*)(KT + (2 * c2) * ROW72 + tg * 16) = lo; *(LAS u32x4*)(KT + (2 * c2 + 1) * ROW72 + tg * 16) = hi;
    *(LAS f32x2*)(PART + tg * 128 + 2 * c2) = (f32x2){p0, p1};
    fill_vT(C.Z + ZC_MV + h * 256, n, tg, lane, VT);
    if (tid == 0) { C.GG[h * NCH + n] = g; C.FL[h * NCH + n] = Flast; }
    __syncthreads();
    if (tid < 128) { float s = 0.f;
#pragma unroll
        for (int q = 0; q < 8; ++q) s += PART[q * 128 + tid];
        C.DN[(size_t)(h * NCH + n) * 128 + tid] = s; }
    state_mfma(VT, KT, C.DC + (size_t)(h * NCH + n) * 32768, tg, lane);
    __syncthreads();
}

DI void ml_B_unit(const MixCtx& C, LAS unsigned char* lds, int h, int n, int tid) {
    const int lane = tid & 63, w = __builtin_amdgcn_readfirstlane(tid >> 6), tg = w, c2 = lane, fr = lane & 15, fq = lane >> 4;
    LAS float* MF = (LAS float*)(lds + L_MISC); LAS float* MU = MF + 64; LAS float* MM = MF + 128; LAS float* MW = MF + 192;
    LAS float* DENP = MF + 256; LAS float* DQN = MF + 512; LAS float* NPV = MF + 576; LAS float* RS = (LAS float*)(lds + L_MISC + 4096);
    LAS unsigned char* CT = lds + L_ST; LAS unsigned char* VT = lds + L_VT; LAS unsigned char* QL = lds + L_Q; LAS unsigned char* KL = lds + L_K;
    copy_256x128(C.CP + (size_t)(h * NCH + n) * 32768, 128, CT, tid);
    if (w == 0) {
        const size_t ztok = (size_t)(n * CH + lane) * ZW;
        const float li = bf2f(C.Z[ztok + ZC_MI + h]) + C.b_i[h];
        const float lf = log_sigmoid_f(bf2f(C.Z[ztok + ZC_MF + h]) + C.b_f[h]);
        const float F = wave_scan_sum(lf, lane);
        const float u = li - F;
        const float pm = wave_scan_max(u, lane);
        const float mprev = C.MP[h * NCH + n];
        const float m = F + fmaxf(pm, mprev);
        MF[lane] = F; MU[lane] = u; MM[lane] = m; MW[lane] = __expf(F + mprev - m);
    }
    if (w == 1) { NPV[lane] = C.NP[(size_t)(h * NCH + n) * 128 + lane]; NPV[64 + lane] = C.NP[(size_t)(h * NCH + n) * 128 + 64 + lane]; }
    {
        float q0[8], q1[8], k0[8], k1[8];
        conv_silu8(C.Z + ZC_MQK + h * 128 + 2 * c2, C.conv_w + h * 128 + 2 * c2, C.conv_b + h * 128 + 2 * c2, n * CH + 8 * tg, q0, q1);
        conv_silu8(C.Z + ZC_MQK + 512 + h * 128 + 2 * c2, C.conv_w + 512 + h * 128 + 2 * c2, C.conv_b + 512 + h * 128 + 2 * c2, n * CH + 8 * tg, k0, k1);
        const float ks = 0.08838834764831845f;
#pragma unroll
        for (int j = 0; j < 8; ++j) { *(LAS unsigned*)(QL + (8 * tg + j) * ROW136 + 4 * c2) = pk2(q0[j], q1[j]); *(LAS unsigned*)(KL + (8 * tg + j) * ROW136 + 4 * c2) = pk2(k0[j] * ks, k1[j] * ks); }
    }
    fill_vT(C.Z + ZC_MV + h * 256, n, tg, lane, VT);
    __syncthreads();
    f32x4 sacc[2];
    score_mfma(QL, KL, w, lane, sacc);
    {
        const int t = tid >> 3, part = tid & 7; float s = 0.f;
#pragma unroll
        for (int e = 0; e < 8; ++e) { const unsigned qq = *(const LAS unsigned*)(QL + t * ROW136 + (16 * part + 2 * e) * 2); s += bflo(qq) * NPV[16 * part + 2 * e] + bfhi(qq) * NPV[16 * part + 2 * e + 1]; }
        s += shx(s, 1, lane); s += shx(s, 2, lane); s += shx(s, 4, lane);
        if (part == 0) DQN[t] = s;
    }
    __syncthreads();
    { const int mi = w >> 1, ni0 = 2 * (w & 1), t = 16 * mi + fr; const float ft = MF[t] - MM[t];
#pragma unroll
      for (int jn = 0; jn < 2; ++jn) { const int s0 = 16 * (ni0 + jn) + 4 * fq; f32x4 v = sacc[jn]; const f32x4 us = *(const LAS f32x4*)(MU + s0);
          float ps = 0.f;
#pragma unroll
          for (int r = 0; r < 4; ++r) { v[r] = (s0 + r > t) ? 0.f : v[r] * __expf(ft + us[r]); ps += v[r]; }
          ps += shx(ps, 16, lane); ps += shx(ps, 32, lane);
          if (fq == 0) DENP[t * 4 + ni0 + jn] = ps;
          *(LAS u32x2*)(KL + t * ROW72 + s0 * 2) = (u32x2){pk2(v[0], v[1]), pk2(v[2], v[3])}; } }
    __syncthreads();
    const int wr = w >> 1, wc = w & 1, t = 16 * wr + fr;
    f32x4 o1[8], o2[8];
#pragma unroll
    for (int ni = 0; ni < 8; ++ni) { o1[ni] = (f32x4){0.f, 0.f, 0.f, 0.f}; o2[ni] = o1[ni]; }
#pragma unroll
    for (int ks = 0; ks < 2; ++ks) { const bf16x8 a = *(const LAS bf16x8*)(KL + t * ROW72 + (32 * ks + 8 * fq) * 2);
#pragma unroll
        for (int ni = 0; ni < 8; ++ni) { const bf16x8 bb = *(const LAS bf16x8*)(VT + (128 * wc + 16 * ni + fr) * ROW72 + (32 * ks + 8 * fq) * 2); o1[ni] = mfma16(bb, a, o1[ni]); } }
#pragma unroll
    for (int ks = 0; ks < 4; ++ks) { const bf16x8 a = *(const LAS bf16x8*)(QL + t * ROW136 + (32 * ks + 8 * fq) * 2);
#pragma unroll
        for (int ni = 0; ni < 8; ++ni) { const bf16x8 bb = *(const LAS bf16x8*)(CT + (128 * wc + 16 * ni + fr) * ROW136 + (32 * ks + 8 * fq) * 2); o2[ni] = mfma16(bb, a, o2[ni]); } }
    const float wi = MW[t];
    const f32x4 dp = *(const LAS f32x4*)(DENP + t * 4);
    const float den = ((dp[0] + dp[1]) + (dp[2] + dp[3])) + wi * DQN[t];
    const float inv = 1.0f / fmaxf(fabsf(den), __expf(-MM[t]));
    const size_t tok = (size_t)(n * CH + t);
    float ss = 0.f;
#pragma unroll
    for (int ni = 0; ni < 8; ++ni) { const int dv = 128 * wc + 16 * ni + 4 * fq;
        const u32x2 mo = *(const u32x2*)(C.Z + tok * ZW + ZC_MO + h * 256 + dv);
        f32x4 v = (o1[ni] + o2[ni] * wi) * inv;
        v[0] *= sigmoid_f(bflo(mo.x)); v[1] *= sigmoid_f(bfhi(mo.x)); v[2] *= sigmoid_f(bflo(mo.y)); v[3] *= sigmoid_f(bfhi(mo.y));
        o1[ni] = v; ss += (v[0] * v[0] + v[1] * v[1]) + (v[2] * v[2] + v[3] * v[3]); }
    ss += shx(ss, 16, lane); ss += shx(ss, 32, lane);
    if (fq == 0) RS[wc * 64 + t] = ss;
    __syncthreads();
    const float rstd = 1.0f / sqrtf((RS[t] + RS[64 + t]) * (1.0f / 256.0f) + EPS);
#pragma unroll
    for (int ni = 0; ni < 8; ++ni) { const int dv = 128 * wc + 16 * ni + 4 * fq; const f32x4 gn = *(const f32x4*)(C.ml_norm + h * 256 + dv);
        const f32x4 v = o1[ni] * rstd * gn;
        *(u32x2*)(C.OB + tok * OBW + OB_O + 1024 + h * 256 + dv) = (u32x2){pk2(v[0], v[1]), pk2(v[2], v[3])}; }
    __syncthreads();
}

#ifndef SCAN_U
#define SCAN_U 8
#endif
DI void scan_phase(const MixCtx& C, int tid) {
    const int NS = 2 * 65536;
    for (int slot = opaque_bx() * 512 + tid; slot < NS; slot += opaque_g() * 512) {
        const int br = slot >> 16, s = slot & 65535, h = s >> 14, dv = (s >> 6) & 255, dkp = s & 63;
        const size_t e0 = (size_t)h * NCH * 32768 + (size_t)dv * 128 + 2 * dkp;
        if (br == 0) {
            float s0 = 0.f, s1 = 0.f;
            for (int n0 = 0; n0 < NCH; n0 += SCAN_U) {
                f32x2 d[SCAN_U], dec[SCAN_U];
#pragma unroll
                for (int u = 0; u < SCAN_U; ++u) { const unsigned dw = *(const unsigned*)(C.DS + e0 + (size_t)(n0 + u) * 32768); d[u] = (f32x2){bflo(dw), bfhi(dw)}; dec[u] = *(const f32x2*)(C.DECAY + (size_t)(h * NCH + n0 + u) * 128 + 2 * dkp); }
#pragma unroll
                for (int u = 0; u < SCAN_U; ++u) { *(unsigned*)(C.SP + e0 + (size_t)(n0 + u) * 32768) = pk2(s0, s1); s0 = dec[u].x * s0 + d[u].x; s1 = dec[u].y * s1 + d[u].y; }
            }
        } else {
            float c0 = 0.f, c1 = 0.f, nn0 = 0.f, nn1 = 0.f, m = -1e30f;
            for (int n0 = 0; n0 < NCH; n0 += SCAN_U) {
                f32x2 d[SCAN_U], dn[SCAN_U]; float fl[SCAN_U], gl[SCAN_U];
#pragma unroll
                for (int u = 0; u < SCAN_U; ++u) { const unsigned dw = *(const unsigned*)(C.DC + e0 + (size_t)(n0 + u) * 32768); d[u] = (f32x2){bflo(dw), bfhi(dw)}; fl[u] = C.FL[h * NCH + n0 + u]; gl[u] = C.GG[h * NCH + n0 + u];
                    dn[u] = (dv == 0) ? *(const f32x2*)(C.DN + (size_t)(h * NCH + n0 + u) * 128 + 2 * dkp) : (f32x2){0.f, 0.f}; }
#pragma unroll
                for (int u = 0; u < SCAN_U; ++u) { *(unsigned*)(C.CP + e0 + (size_t)(n0 + u) * 32768) = pk2(c0, c1);
                    if (dv == 0) { *(f32x2*)(C.NP + (size_t)(h * NCH + n0 + u) * 128 + 2 * dkp) = (f32x2){nn0, nn1}; if (dkp == 0) C.MP[h * NCH + n0 + u] = m; }
                    const float mn = fmaxf(fl[u] + m, gl[u]); const float a = __expf(fl[u] + m - mn), bb = __expf(gl[u] - mn);
                    c0 = a * c0 + bb * d[u].x; c1 = a * c1 + bb * d[u].y; nn0 = a * nn0 + bb * dn[u].x; nn1 = a * nn1 + bb * dn[u].y; m = mn; }
            }
        }
    }
}

DI void mem_unit(const MixCtx& C, LAS unsigned char* lds, int h, int rb, int tid) {
    const int lane = tid & 63, w = __builtin_amdgcn_readfirstlane(tid >> 6), fr = lane & 15, fq = lane >> 4, wr = w >> 1, wc = w & 1, t = 16 * wr + fr;
    LAS unsigned char* QL = lds; LAS unsigned char* PL = lds + 33792; LAS unsigned char* KV = lds + 67584;
    LAS float* RMX = (LAS float*)(lds + L_MISC); LAS float* RSM = RMX + 128;
#pragma unroll
    for (int i = 0; i < 4; ++i) { const int id = tid + 512 * i, row = id >> 5, cc = id & 31;
        *(LAS u32x4*)(QL + row * ROW264 + cc * 16) = *(const u32x4*)(C.Z + (size_t)(rb * 64 + row) * ZW + ZC_XQ + h * 256 + cc * 8); }
    f32x4 s[8];
#pragma unroll
    for (int ni = 0; ni < 8; ++ni) s[ni] = (f32x4){0.f, 0.f, 0.f, 0.f};
#pragma unroll
    for (int half = 0; half < 2; ++half) {
        copy_256x128(C.KM + h * 256 + half * 128, 4096, KV, tid);
        __syncthreads();
#pragma unroll
        for (int ks = 0; ks < 4; ++ks) { const bf16x8 a = *(const LAS bf16x8*)(QL + t * ROW264 + (128 * half + 32 * ks + 8 * fq) * 2);
#pragma unroll
            for (int ni = 0; ni < 8; ++ni) { const bf16x8 bb = *(const LAS bf16x8*)(KV + (128 * wc + 16 * ni + fr) * ROW136 + (32 * ks + 8 * fq) * 2); s[ni] = mfma16(bb, a, s[ni]); } }
        __syncthreads();
    }
    float mx = -3.0e38f;
#pragma unroll
    for (int ni = 0; ni < 8; ++ni) { s[ni] = s[ni] * 0.0625f; mx = fmaxf(mx, fmaxf(fmaxf(s[ni][0], s[ni][1]), fmaxf(s[ni][2], s[ni][3]))); }
    mx = fmaxf(mx, shx(mx, 16, lane)); mx = fmaxf(mx, shx(mx, 32, lane));
    if (fq == 0) RMX[wc * 64 + t] = mx;
    copy_256x128(C.VMT + (size_t)(h * 256) * 256, 256, KV, tid);
    __syncthreads();
    mx = fmaxf(RMX[t], RMX[64 + t]);
    float sm = 0.f;
#pragma unroll
    for (int ni = 0; ni < 8; ++ni) {
#pragma unroll
        for (int r = 0; r < 4; ++r) { s[ni][r] = __expf(s[ni][r] - mx); sm += s[ni][r]; } }
    sm += shx(sm, 16, lane); sm += shx(sm, 32, lane);
    if (fq == 0) RSM[wc * 64 + t] = sm;
    __syncthreads();
    const float inv = 1.0f / (RSM[t] + RSM[64 + t]);
#pragma unroll
    for (int ni = 0; ni < 8; ++ni) { const f32x4 p = s[ni] * inv; *(LAS u32x2*)(PL + t * ROW264 + (128 * wc + 16 * ni + 4 * fq) * 2) = (u32x2){pk2(p[0], p[1]), pk2(p[2], p[3])}; }
    f32x4 o[8];
#pragma unroll
    for (int ni = 0; ni < 8; ++ni) o[ni] = (f32x4){0.f, 0.f, 0.f, 0.f};
#pragma unroll
    for (int half = 0; half < 2; ++half) {
        if (half == 1) copy_256x128(C.VMT + (size_t)(h * 256) * 256 + 128, 256, KV, tid);
        __syncthreads();
#pragma unroll
        for (int ks = 0; ks < 4; ++ks) { const bf16x8 a = *(const LAS bf16x8*)(PL + t * ROW264 + (128 * half + 32 * ks + 8 * fq) * 2);
#pragma unroll
            for (int ni = 0; ni < 8; ++ni) { const bf16x8 bb = *(const LAS bf16x8*)(KV + (128 * wc + 16 * ni + fr) * ROW136 + (32 * ks + 8 * fq) * 2); o[ni] = mfma16(bb, a, o[ni]); } }
        __syncthreads();
    }
    const size_t tok = (size_t)(rb * 64 + t);
#pragma unroll
    for (int ni = 0; ni < 8; ++ni) { const int d = 128 * wc + 16 * ni + 4 * fq; *(u32x2*)(C.OB + tok * OBW + OB_O + 2048 + h * 256 + d) = (u32x2){pk2(o[ni][0], o[ni][1]), pk2(o[ni][2], o[ni][3])}; }
}

#ifndef GEMM_ALIGN
#define GEMM_ALIGN true
#endif
#ifndef REP_PRO
#define REP_PRO 1
#endif
#ifndef REP_MIXA
#define REP_MIXA 1
#endif
#ifndef REP_SCAN
#define REP_SCAN 1
#endif
#ifndef REP_MIXB
#define REP_MIXB 1
#endif
#ifndef REP_FF1
#define REP_FF1 1
#endif
#ifndef REP_NORM
#define REP_NORM 1
#endif
#ifndef WGM_IN
#define WGM_IN PG8_WGM
#endif
#ifndef WGM_BR
#define WGM_BR PG8_WGM
#endif
#ifndef WGM_OUT
#define WGM_OUT PG8_WGM
#endif
#ifndef WGM_F1
#define WGM_F1 8
#endif
#ifndef WGM_F2
#define WGM_F2 PG8_WGM
#endif
#ifndef REP_GLAA
#define REP_GLAA 1
#endif
#ifndef REP_MEM
#define REP_MEM 1
#endif
#ifndef REP_GLAB
#define REP_GLAB 1
#endif
#ifndef REP_GATE
#define REP_GATE 1
#endif
#ifndef REP_BR
#define REP_BR 1
#endif
#ifndef GEMM_SP2
#define GEMM_SP2 true
#endif
constexpr int L_PTR = L_BARW + 256;
DI unsigned long long tab_ld(LAS unsigned char* lds, int k) {
    const unsigned long long v = *(volatile LAS unsigned long long*)(lds + L_PTR + 8 * k);
    const unsigned lo = __builtin_amdgcn_readfirstlane((unsigned)v), hi = __builtin_amdgcn_readfirstlane((unsigned)(v >> 32));
    return ((unsigned long long)hi << 32) | lo;
}
DI const float* tab_in(LAS unsigned char* lds, int k) { return (const float*)(const GAS float*)tab_ld(lds, k); }
DI unsigned char* tab_ws(LAS unsigned char* lds) { return (unsigned char*)(GAS unsigned char*)tab_ld(lds, 24); }
DI void grid_bar(LAS unsigned char* lds) {
    XcdBarrier b; b.bar = (unsigned*)(tab_ws(lds) + WS_CTL) + CW_BAR; b.x = xb_xcc_id(); b.st = (volatile LAS unsigned*)(lds + L_BARW);
    xcd_barrier(b);
}
DI void make_ctx(MixCtx& C, LAS unsigned char* lds, int l) {
    unsigned char* ws = tab_ws(lds);
    C.Z = (const bf16_t*)(ws + WS_Z); C.OB = (bf16_t*)(ws + WS_OB);
    C.wa = tab_in(lds, I_W_GLA_A) + (size_t)l * 16 * 512; C.ba = tab_in(lds, I_B_GLA_A) + l * 512; C.gla_norm = tab_in(lds, I_GLA_NORM) + l * 1024;
    C.conv_w = tab_in(lds, I_CONV_W) + (size_t)l * 4 * 1024; C.conv_b = tab_in(lds, I_CONV_B) + l * 1024; C.b_i = tab_in(lds, I_B_ML_I) + l * 4; C.b_f = tab_in(lds, I_B_ML_F) + l * 4; C.ml_norm = tab_in(lds, I_ML_NORM) + l * 1024;
    C.BG = (float*)(ws + WS_BG); C.DS = (bf16_t*)(ws + WS_DS); C.DC = (bf16_t*)(ws + WS_DC); C.SP = (bf16_t*)(ws + WS_SP); C.CP = (bf16_t*)(ws + WS_CP);
    C.DECAY = (float*)(ws + WS_SMALL + SM_DECAY); C.DN = (float*)(ws + WS_SMALL + SM_DN); C.NP = (float*)(ws + WS_SMALL + SM_NP);
    C.GG = (float*)(ws + WS_SMALL + SM_GG); C.FL = (float*)(ws + WS_SMALL + SM_FL); C.MP = (float*)(ws + WS_SMALL + SM_MP);
    C.KM = (const bf16_t*)(ws + WS_KM) + l * 1024; C.VMT = (const bf16_t*)(ws + WS_VMT) + (size_t)l * 1024 * 256;
}

__global__ void __launch_bounds__(512, 2) trunk_fwd(Params p) {
    extern __shared__ __attribute__((aligned(16))) unsigned char lds_raw[];
    LAS unsigned char* lds0 = (LAS unsigned char*)lds_raw;
    {
        LAS unsigned char* lds = lds0;
        const int tid0 = threadIdx.x;
        if (tid0 < 64) ((LAS unsigned*)(lds + L_BARW))[tid0] = 0u;
        if (tid0 < 23) *(LAS unsigned long long*)(lds + L_PTR + 8 * tid0) = (unsigned long long)p.in[tid0];
        if (tid0 == 23) *(LAS unsigned long long*)(lds + L_PTR + 8 * 23) = (unsigned long long)p.out;
        if (tid0 == 24) *(LAS unsigned long long*)(lds + L_PTR + 8 * 24) = (unsigned long long)p.ws;
        __syncthreads();
        (void)xcd_barrier_post((unsigned*)(p.ws + WS_CTL) + CW_BAR, (volatile LAS unsigned*)(lds + L_BARW));
    }
#define TID (opaque_tid())
#define LANE (opaque_tid() & 63)
#define WAVE (__builtin_amdgcn_readfirstlane(opaque_tid() >> 6))
#define GW (opaque_bx() * NWAVES + WAVE)
#define NGW (opaque_g() * NWAVES)

    for (int rep = 0; rep < REP_PRO; ++rep) {
        LAS unsigned char* lds = opaque_lds(lds0); unsigned char* ws = tab_ws(lds);
        bf16_t* WIN = (bf16_t*)(ws + WS_WIN);
        const int lane = LANE, wave = WAVE;
        LAS float* scr = (LAS float*)(lds + wave * 16640);
        constexpr int IT_IN = 64 * 117, IT_BR = 16 * 64, IT_G = 4 * 64, IT_OUT = 64 * 64, IT_F1 = 64 * 256, IT_F2 = 256 * 64, IT_MK = 64 * 16;
        constexpr int E_IN = 4 * IT_IN, E_BR = E_IN + 12 * IT_BR, E_G = E_BR + 12 * IT_G, E_OUT = E_G + 4 * IT_OUT, E_F1 = E_OUT + 4 * IT_F1, E_F2 = E_F1 + 4 * IT_F2, E_MK = E_F2 + 4 * IT_MK, E_MV = E_MK + 4 * IT_MK;
        for (int it = GW; it < E_MV; it += NGW) {
            if (it < E_IN) { const int l = it / IT_IN, r = it - l * IT_IN; transpose_item(tab_in(lds, I_W_IN) + (size_t)l * DM * IN_W, DM, IN_W, WIN + (size_t)l * ZW * PW, PW, 0, 0, true, scr, r, lane, tab_in(lds, I_NORM_MIX) + l * DM); }
            else if (it < E_BR) { const int q = it - E_IN, lj = q / IT_BR, r = q - lj * IT_BR, l = lj / 3, j = lj - 3 * l; transpose_item(tab_in(lds, I_W_BRANCH) + (size_t)lj * 1024 * DM, 1024, DM, (bf16_t*)(ws + WS_WBR) + (size_t)l * DM * OBW, OBW, OB_O + j * 1024, 0, false, scr, r, lane); }
            else if (it < E_G) { const int q = it - E_BR, lj = q / IT_G, r = q - lj * IT_G, l = lj / 3, j = lj - 3 * l; transpose_item(tab_in(lds, I_W_GATE) + (size_t)lj * 256 * DM, 256, DM, (bf16_t*)(ws + WS_WBR) + (size_t)l * DM * OBW, OBW, j * 256, 0, false, scr, r, lane); }
            else if (it < E_OUT) { const int q = it - E_G, l = q / IT_OUT, r = q - l * IT_OUT; transpose_item(tab_in(lds, I_W_OUT) + (size_t)l * DM * DM, DM, DM, (bf16_t*)(ws + WS_WOUT) + (size_t)l * DM * PW, PW, 0, 0, false, scr, r, lane); }
            else if (it < E_F1) { const int q = it - E_OUT, l = q / IT_F1, r = q - l * IT_F1; transpose_item(tab_in(lds, I_W_FF1) + (size_t)l * DM * DFF, DM, DFF, (bf16_t*)(ws + WS_W1) + (size_t)l * DFF * PW, PW, 0, 0, false, scr, r, lane, tab_in(lds, I_NORM_FFN) + l * DM); }
            else if (it < E_F2) { const int q = it - E_F1, l = q / IT_F2, r = q - l * IT_F2; transpose_item(tab_in(lds, I_W_FF2) + (size_t)l * DFF * DM, DFF, DM, (bf16_t*)(ws + WS_W2) + (size_t)l * DM * PU, PU, 0, 0, false, scr, r, lane); }
            else if (it < E_MK) { const int q = it - E_F2, l = q / IT_MK, r = q - l * IT_MK; transpose_item(tab_in(lds, I_W_MEM_K) + (size_t)l * DM * 1024, DM, 1024, (bf16_t*)(ws + WS_WMK), DM, 0, l * 1024, false, scr, r, lane); }
            else { const int q = it - E_MK, l = q / IT_MK, r = q - l * IT_MK; transpose_item(tab_in(lds, I_W_MEM_V) + (size_t)l * DM * 1024, DM, 1024, (bf16_t*)(ws + WS_WMV), DM, 0, l * 1024, false, scr, r, lane); }
        }
        constexpr int PADCH = (ZW - IN_W) * PW / 8;
        for (int i = opaque_bx() * 512 + TID; i < NL * PADCH; i += opaque_g() * 512) { const int l = i / PADCH, r = i - l * PADCH; *(u32x4*)(WIN + (size_t)l * ZW * PW + (size_t)IN_W * PW + (size_t)r * 8) = (u32x4){0u, 0u, 0u, 0u}; }
        for (int m = GW; m < SEQ; m += NGW) row_bf16_ss(tab_in(lds, I_X) + (size_t)m * DM, (bf16_t*)(ws + WS_H) + (size_t)m * PW, (u64_t*)(ws + WS_SS) + m, lane);
        for (int m = GW; m < MEML; m += NGW) rmsnorm_row<false>(tab_in(lds, I_MEM) + (size_t)m * DM, tab_in(lds, I_MEM_NORM), (bf16_t*)(ws + WS_MEMN) + (size_t)m * DM, lane);
    }
    grid_bar(opaque_lds(lds0));
    for (int l = 0; l < NL; ++l) {
        {
            LAS unsigned char* lds = opaque_lds(lds0); unsigned char* ws = tab_ws(lds);
            pg8::Gemm g{(const bf16_t*)(ws + WS_H), (const bf16_t*)(ws + WS_WIN) + (size_t)l * ZW * PW, opq(SEQ), opq(ZW), opq(DM), opq(PW), opq(PW)}; pg8::StaticOrder S; S.init(opq(SEQ), opq(ZW), opaque_g(), opaque_bx(), opq(WGM_IN)); pg8::EpiBf16<0> E{(bf16_t*)(ws + WS_Z), ZW, nullptr, (const u64_t*)(ws + WS_SS) + (size_t)(2 * l) * SEQ, (bf16_t*)(ws + WS_OB), OBW, ZC_GATE / 256};
            pg8::gemm_phase<pg8::EpiBf16<0>, pg8::StaticOrder, GEMM_ALIGN, GEMM_SP2>(lds, g, S, E);
        }
        if (l == 0) {
            const int kvc = (opaque_g() >= 256 && opaque_bx() >= 128) ? opaque_bx() - 128 : opaque_bx() + (1 << 20) * (opaque_g() >= 256 ? 1 : 0);
        {
            LAS unsigned char* lds = opaque_lds(lds0); unsigned char* ws = tab_ws(lds);
        { pg8::Gemm g{(const bf16_t*)(ws + WS_MEMN), (const bf16_t*)(ws + WS_WMK), opq(MEML), opq(DM), opq(DM), opq(DM), opq(DM)}; pg8::StaticOrder S; S.init(opq(MEML), opq(DM), opaque_g(), kvc); pg8::EpiBf16<0> E{(bf16_t*)(ws + WS_KM), DM, nullptr, nullptr, nullptr, 0, -1};
          pg8::gemm_phase<pg8::EpiBf16<0>, pg8::StaticOrder, GEMM_ALIGN, GEMM_SP2>(lds, g, S, E); }
    }
        {
            LAS unsigned char* lds = opaque_lds(lds0); unsigned char* ws = tab_ws(lds);
        { pg8::Gemm g{(const bf16_t*)(ws + WS_WMV), (const bf16_t*)(ws + WS_MEMN), opq(DM), opq(MEML), opq(DM), opq(DM), opq(DM)}; pg8::StaticOrder S; S.init(opq(DM), opq(MEML), opaque_g(), kvc - 16); pg8::EpiBf16<0> E{(bf16_t*)(ws + WS_VMT), MEML, nullptr, nullptr, nullptr, 0, -1};
          pg8::gemm_phase<pg8::EpiBf16<0>, pg8::StaticOrder, GEMM_ALIGN, GEMM_SP2>(lds, g, S, E); }
    }
        }
        grid_bar(opaque_lds(lds0));
        {
            LAS unsigned char* lds = opaque_lds(lds0); MixCtx C; make_ctx(C, lds, l); const int tid = TID;
            for (int rep = 0; rep < REP_MIXA; ++rep) {
            for (int r2 = 0; r2 < REP_GLAA; ++r2) for (int i = opaque_bx(); i < 4 * NCH; i += opaque_g()) gla_A_unit(C, lds, i >> 8, i & 255, tid);
            for (int i = opaque_bx(); i < 4 * NCH; i += opaque_g()) ml_A_unit(C, lds, i >> 8, i & 255, tid);
            for (int r2 = 0; r2 < REP_MEM; ++r2) for (int i = opaque_bx(); i < 4 * NCH; i += opaque_g()) mem_unit(C, lds, i >> 8, i & 255, tid);
            }
        }
        grid_bar(opaque_lds(lds0));
        { LAS unsigned char* lds = opaque_lds(lds0); MixCtx C; make_ctx(C, lds, l); for (int rep = 0; rep < REP_SCAN; ++rep) scan_phase(C, TID); }
        grid_bar(opaque_lds(lds0));
        {
            LAS unsigned char* lds = opaque_lds(lds0); MixCtx C; make_ctx(C, lds, l); const int tid = TID;
            for (int rep = 0; rep < REP_MIXB; ++rep) {
            for (int r2 = 0; r2 < REP_GLAB; ++r2) for (int i = opaque_bx(); i < 4 * NCH; i += opaque_g()) gla_B_unit(C, lds, i >> 8, i & 255, tid);
            for (int i = opaque_bx(); i < 4 * NCH; i += opaque_g()) ml_B_unit(C, lds, i >> 8, i & 255, tid);
            }
        }
        grid_bar(opaque_lds(lds0));
        for (int rep = 0; rep < REP_BR; ++rep) {
            LAS unsigned char* lds = opaque_lds(lds0); unsigned char* ws = tab_ws(lds);
            pg8::Gemm g{(const bf16_t*)(ws + WS_OB), (const bf16_t*)(ws + WS_WBR) + (size_t)l * DM * OBW, opq(SEQ), opq(DM), opq(OBW), opq(OBW), opq(OBW)}; pg8::BranchOrder S; S.init(opq(SEQ), opq(DM), opaque_g(), opaque_bx(), opq(WGM_BR)); pg8::EpiBranch E{(bf16_t*)(ws + WS_Y), PW, (bf16_t*)(ws + WS_GT), tab_in(lds, I_B_GATE) + (size_t)l * GTW};
            pg8::gemm_phase<pg8::EpiBranch, pg8::BranchOrder, GEMM_ALIGN, GEMM_SP2>(lds, g, S, E);
        }
        grid_bar(opaque_lds(lds0));
        {
            LAS unsigned char* lds = opaque_lds(lds0); unsigned char* ws = tab_ws(lds);
            const float* Xin = (l == 0) ? tab_in(lds, I_X) : (const float*)(ws + WS_X);
            pg8::Gemm g{(const bf16_t*)(ws + WS_Y), (const bf16_t*)(ws + WS_WOUT) + (size_t)l * DM * PW, opq(SEQ), opq(DM), opq(DM), opq(PW), opq(PW)}; pg8::StaticOrder S; S.init(opq(SEQ), opq(DM), opaque_g(), opaque_bx(), opq(WGM_OUT)); pg8::EpiResid E{Xin, (float*)(ws + WS_X), DM, (bf16_t*)(ws + WS_H), (u64_t*)(ws + WS_SS) + (size_t)(2 * l + 1) * SEQ, PW};
            pg8::gemm_phase<pg8::EpiResid, pg8::StaticOrder, GEMM_ALIGN, GEMM_SP2>(lds, g, S, E);
        }
        grid_bar(opaque_lds(lds0));
        for (int rep = 0; rep < REP_FF1; ++rep) {
            LAS unsigned char* lds = opaque_lds(lds0); unsigned char* ws = tab_ws(lds);
            pg8::Gemm g{(const bf16_t*)(ws + WS_H), (const bf16_t*)(ws + WS_W1) + (size_t)l * DFF * PW, opq(SEQ), opq(DFF), opq(DM), opq(PW), opq(PW)}; pg8::StaticOrder S; S.init(opq(SEQ), opq(DFF), opaque_g(), opaque_bx(), opq(WGM_F1)); pg8::EpiBf16<1> E{(bf16_t*)(ws + WS_U), PU, nullptr, (const u64_t*)(ws + WS_SS) + (size_t)(2 * l + 1) * SEQ, nullptr, 0, -1};
            pg8::gemm_phase<pg8::EpiBf16<1>, pg8::StaticOrder, GEMM_ALIGN, GEMM_SP2>(lds, g, S, E);
        }
        grid_bar(opaque_lds(lds0));
        {
            LAS unsigned char* lds = opaque_lds(lds0); unsigned char* ws = tab_ws(lds);
            pg8::Gemm g{(const bf16_t*)(ws + WS_U), (const bf16_t*)(ws + WS_W2) + (size_t)l * DM * PU, opq(SEQ), opq(DM), opq(DFF), opq(PU), opq(PU)}; pg8::StaticOrder S; S.init(opq(SEQ), opq(DM), opaque_g(), opaque_bx(), opq(WGM_F2)); pg8::EpiResid E{(const float*)(ws + WS_X), (float*)(ws + WS_X), DM, (bf16_t*)(ws + WS_H), (u64_t*)(ws + WS_SS) + (size_t)(2 * l + 2) * SEQ, PW};
            pg8::gemm_phase<pg8::EpiResid, pg8::StaticOrder, GEMM_ALIGN, GEMM_SP2>(lds, g, S, E);
        }
        grid_bar(opaque_lds(lds0));
    }
    {
        LAS unsigned char* lds = opaque_lds(lds0); unsigned char* ws = tab_ws(lds);
        const float* X = (const float*)(ws + WS_X); const float* gain = tab_in(lds, I_FINAL_NORM); float* out = (float*)(GAS float*)tab_ld(lds, 23); const int lane = LANE;
        const u64_t* ssf = (const u64_t*)(ws + WS_SS) + (size_t)8 * SEQ;
        for (int m = GW; m < SEQ; m += NGW) row_scale_f32(X + (size_t)m * DM, gain, ss_to_f(ssf[m]), out + (size_t)m * DM, lane);
    }
}

extern "C" void kernel_launch(void* const* d_in, const int* in_sizes, int n_in, void* d_out, int out_size, void* d_ws, size_t ws_size, hipStream_t stream) {
    static int grid = 0;
    if (grid == 0) {
        if (n_in != 23 || out_size != SEQ * DM || ws_size < WS_END) { fprintf(stderr, "kernel_launch: unexpected shapes (n_in %d out %d ws %zu, need %zu)\n", n_in, out_size, ws_size, (size_t)WS_END); grid = -1; return; }
        int dev = 0, cus = 0, per_cu = 0;
        if (hipGetDevice(&dev) != hipSuccess || hipDeviceGetAttribute(&cus, hipDeviceAttributeMultiprocessorCount, dev) != hipSuccess) { grid = -1; return; }
        if (hipFuncSetAttribute((const void*)trunk_fwd, hipFuncAttributeMaxDynamicSharedMemorySize, LDS_BYTES) != hipSuccess) { fprintf(stderr, "kernel_launch: hipFuncSetAttribute failed\n"); grid = -1; return; }
        if (hipOccupancyMaxActiveBlocksPerMultiprocessor(&per_cu, (const void*)trunk_fwd, 512, LDS_BYTES) != hipSuccess || per_cu < 1) { fprintf(stderr, "kernel_launch: occupancy query says %d\n", per_cu); (void)hipGetLastError(); }
        grid = cus;
    }
    if (grid < 0) return;
    if (hipMemsetAsync((char*)d_ws + WS_CTL, 0, CTL_ZERO_BYTES, stream) != hipSuccess) return;
    if (hipMemsetAsync((char*)d_ws + WS_SS, 0, SS_ZERO_BYTES, stream) != hipSuccess) return;
    Params p{};
    for (int i = 0; i < 23; ++i) p.in[i] = (const float*)d_in[i];
    p.out = (float*)d_out; p.ws = (unsigned char*)d_ws;
    hipLaunchKernelGGL(trunk_fwd, dim3(grid), dim3(512), LDS_BYTES, stream, p);
}
```

```cpp
#include <hip/hip_runtime.h>
#include <cstdio>
#include <cstdint>

#define DI __device__ __forceinline__
#define GAS __attribute__((address_space(1)))
#define LAS __attribute__((address_space(3)))
typedef unsigned short bf16_t;
typedef short bf16x8 __attribute__((ext_vector_type(8)));
typedef float f32x4 __attribute__((ext_vector_type(4)));
typedef float f32x2 __attribute__((ext_vector_type(2)));
typedef unsigned u32x4 __attribute__((ext_vector_type(4)));
typedef unsigned u32x2 __attribute__((ext_vector_type(2)));

constexpr int SEQ = 16384, DM = 4096, DFF = 16384, NL = 4, MEML = 256, CH = 64, NCH = SEQ / CH;
constexpr int IN_W = 7448, ZW = 7680;
constexpr int ZC_GQ = 0, ZC_GK = 512, ZC_GV = 1024, ZC_GG = 2048, ZC_MQK = 3072, ZC_MV = 4096, ZC_MO = 5120, ZC_XQ = 6144, ZC_GATE = 7168, ZC_GA = 7424, ZC_MI = 7440, ZC_MF = 7444;
constexpr int OBW = 3840, OB_O = 768;
constexpr int GTW = 12288;
constexpr float EPS = 1e-6f;
#ifndef PITCH_PAD
#define PITCH_PAD 64
#endif
constexpr int PW = DM + PITCH_PAD, PU = DFF + PITCH_PAD;

constexpr size_t MiB = 1u << 20;
constexpr size_t WS_CTL = 0, CTL_ZERO_BYTES = 1 * MiB;
constexpr size_t WS_WIN = 1 * MiB, WS_WBR = 245 * MiB, WS_WOUT = 365 * MiB, WS_W1 = 495 * MiB, WS_W2 = 1015 * MiB;
constexpr size_t WS_WMK = 1529 * MiB, WS_WMV = 1561 * MiB, WS_MEMN = 1593 * MiB, WS_KM = 1595 * MiB, WS_VMT = 1597 * MiB;
constexpr size_t WS_X = 1599 * MiB, WS_H = 1855 * MiB, WS_Z = 1985 * MiB, WS_GT = 2225 * MiB, WS_U = WS_Z  ;
constexpr size_t WS_OB = 2609 * MiB, WS_Y = 2729 * MiB, WS_DS = 2859 * MiB, WS_SP = 2987 * MiB, WS_DC = 3051 * MiB, WS_CP = 3179 * MiB;
constexpr size_t WS_SMALL = 3243 * MiB, WS_SS = 3245 * MiB, SS_ZERO_BYTES = 2 * MiB, WS_BG = 3247 * MiB, WS_END = 3279 * MiB;
static_assert(PITCH_PAD <= 64, "buffer sizes below assume at most 64 elements of row padding");
static_assert(WS_WIN + (size_t)NL * ZW * PW * 2 <= WS_WBR && WS_WBR + (size_t)NL * DM * OBW * 2 <= WS_WOUT && WS_WOUT + (size_t)NL * DM * PW * 2 <= WS_W1 && WS_W1 + (size_t)NL * DFF * PW * 2 <= WS_W2 && WS_W2 + (size_t)NL * DM * PU * 2 <= WS_WMK, "weight map");
static_assert(WS_H + (size_t)SEQ * PW * 2 <= WS_Z && WS_Y + (size_t)SEQ * PW * 2 <= WS_DS, "activation map");
static_assert(WS_OB + (size_t)SEQ * OBW * 2 <= WS_Y, "OB size");
constexpr size_t SM_DECAY = 0, SM_DN = 512 * 1024, SM_NP = 1024 * 1024, SM_GG = 1536 * 1024, SM_FL = 1536 * 1024 + 4096, SM_MP = 1536 * 1024 + 8192;
static_assert(WS_U + (size_t)SEQ * PU * 2 <= WS_OB, "U overlay");
constexpr int CW_BAR = 4096;
static_assert(9 * (size_t)SEQ * 8 <= SS_ZERO_BYTES, "SS region");
typedef unsigned long long u64_t;
DI float ss_to_f(u64_t v) { return (float)v * (1.0f / 16777216.0f); }

constexpr int LDS_BYTES = 147456;
constexpr int L_ST = 0, L_VT = 69632, L_Q = 106496, L_K = 123904, L_MISC = 141312, L_BARW = 146432;
constexpr int ROW72 = 144, ROW136 = 272, ROW264 = 528;
constexpr int NWAVES = 8;

DI float bf2f(unsigned v) { return __uint_as_float(v << 16); }
DI float bflo(unsigned w) { return __uint_as_float(w << 16); }
DI float bfhi(unsigned w) { return __uint_as_float(w & 0xffff0000u); }
typedef __bf16 bf16x2_t __attribute__((ext_vector_type(2)));
DI unsigned pk2(float lo, float hi) { const f32x2 v = {lo, hi}; const bf16x2_t b = __builtin_convertvector(v, bf16x2_t); return __builtin_bit_cast(unsigned, b); }
DI float sigmoid_f(float x) { return __builtin_amdgcn_rcpf(1.0f + __expf(-x)); }
DI float silu_f(float x) { return x * sigmoid_f(x); }
DI float log_sigmoid_f(float x) { return fminf(x, 0.f) - __logf(1.0f + __expf(-fabsf(x))); }
DI float shx(float v, int o, int lane) { return __int_as_float(__builtin_amdgcn_ds_bpermute((lane ^ o) << 2, __float_as_int(v))); }
DI float shi(float v, int src) { return __int_as_float(__builtin_amdgcn_ds_bpermute(src << 2, __float_as_int(v))); }
DI float wave_sum(float v, int lane) {
#pragma unroll
    for (int o = 1; o < 64; o <<= 1) v += shx(v, o, lane);
    return v;
}
DI float wave_max(float v, int lane) {
#pragma unroll
    for (int o = 1; o < 64; o <<= 1) v = fmaxf(v, shx(v, o, lane));
    return v;
}
DI float wave_scan_sum(float v, int lane) {
#pragma unroll
    for (int o = 1; o < 64; o <<= 1) { const float t = shi(v, lane >= o ? lane - o : lane); if (lane >= o) v += t; }
    return v;
}
DI float wave_scan_max(float v, int lane) {
#pragma unroll
    for (int o = 1; o < 64; o <<= 1) { const float t = shi(v, lane >= o ? lane - o : lane); if (lane >= o) v = fmaxf(v, t); }
    return v;
}
DI f32x4 mfma16(bf16x8 a, bf16x8 b, f32x4 c) { return __builtin_amdgcn_mfma_f32_16x16x32_bf16(a, b, c, 0, 0, 0); }
DI int opaque_tid() { int t = (int)threadIdx.x; asm volatile("" : "+v"(t)); return t; }
DI int opaque_bx() { int b = (int)blockIdx.x; asm volatile("" : "+s"(b)); return b; }
DI LAS unsigned char* opaque_lds(LAS unsigned char* p) { asm volatile("" : "+s"(p)); return p; }
DI int opq(int v) { asm volatile("" : "+s"(v)); return v; }
DI int opaque_g() { int g = (int)gridDim.x; asm volatile("" : "+s"(g)); return g; }

namespace pg8 {
#define PG8_LAS __attribute__((address_space(3)))
constexpr int BM = 256, BK = 64, HALF = 128, HTB = HALF * BK * 2  , STAGE_BYTES = 8 * HTB, NXCD = 8;
#ifndef PG8_WGM
#define PG8_WGM 4
#endif
constexpr int WGM = PG8_WGM;

__host__ __device__ __forceinline__ int lds_byte(int r, int c) { const int st = (r >> 4) * 2 + (c >> 5), rr = r & 15, cc = c & 31, ob = rr * 64 + cc * 2; return st * 1024 + (ob ^ (((ob >> 9) & 1) << 5)); }
__host__ __device__ __forceinline__ void stage_rc(int b, int& R, int& C) { const int st = b / 1024, sb = b % 1024, swz = sb ^ (((sb >> 9) & 1) << 5); R = (st >> 1) * 16 + swz / 64; C = (st & 1) * 32 + (swz % 64) / 2; }
__host__ __device__ __forceinline__ int perm32(int rho) { const int n = rho >> 4, i = rho & 15; return 8 * (i >> 2) + 4 * n + (i & 3); }

struct Unit { int pm, pn, kind; };
struct Gemm { const bf16_t* A; const bf16_t* Bt; int M, N, K, lda, ldb; };

struct StaticOrder {
    int nM, nN, nwg, G, c, wgm;
    __host__ __device__ void init(int M, int N, int G_, int c_, int wgm_ = WGM) { nM = M / BM; nN = N / BM; nwg = nM * nN; G = G_; c = c_; wgm = wgm_; }
    __host__ __device__ bool next(int i, Unit& u) const {
        const long L = (long)i * G + c; if (c < 0 || L >= nwg) return false;
        int wgid = (int)L; { const int q = nwg / NXCD, r = nwg % NXCD, xcd = wgid % NXCD, off = wgid / NXCD; wgid = (xcd < r ? xcd * (q + 1) : r * (q + 1) + (xcd - r) * q) + off; }
        const int nig = wgm * nN, gid = wgid / nig, fm = gid * wgm, gsz = (nM - fm) < wgm ? (nM - fm) : wgm;
        u.pm = fm + ((wgid % nig) % gsz); u.pn = (wgid % nig) / gsz; u.kind = 0; return true;
    }
    __device__ __forceinline__ void a_ready(const Unit&) const {}
    __device__ __forceinline__ void done(const Unit&) const {}
    __device__ __forceinline__ int nt(const Unit&, int nt_default) const { return nt_default; }
    __device__ __forceinline__ int koff(const Unit&) const { return 0; }
};
struct BranchOrder : StaticOrder {
    __host__ __device__ bool next(int i, Unit& u) const { if (!StaticOrder::next(i >> 2, u)) return false; u.kind = i & 3; return true; }
    __device__ __forceinline__ int nt(const Unit& u, int) const { return u.kind < 3 ? 4 : 48; }
    __device__ __forceinline__ int koff(const Unit& u) const { return u.kind < 3 ? 256 * u.kind : 768; }
};

template <int ACT  > struct EpiBf16 {
    static constexpr bool PERM = true, AFTER_DRAIN = false, HOOK = false;
    bf16_t* O; int ldc; const float* bias; const unsigned long long* ss; bf16_t* O2; int ld2, pn2;
    __device__ __forceinline__ void operator()(const f32x4 (&acc)[2][2][4][2], const Unit& u, int wr, int wc, int fr, int fq) const {
        const int row0 = u.pm * BM + wr * 64 + fr, col0 = u.pn * BM + wc * 32 + 8 * fq;
        f32x4 bv[2][2];
#pragma unroll
        for (int bj = 0; bj < 2; ++bj)
#pragma unroll
            for (int n = 0; n < 2; ++n) bv[bj][n] = (ACT == 2) ? *(const f32x4*)(bias + col0 + bj * HALF + 4 * n) : (f32x4){0.f, 0.f, 0.f, 0.f};
#pragma unroll
        for (int ai = 0; ai < 2; ++ai)
#pragma unroll
            for (int m = 0; m < 4; ++m) { bf16_t* rowp = O + (size_t)(row0 + ai * HALF + m * 16) * ldc + col0;
                const bool redir = (ACT == 0) && O2 != nullptr && u.pn == pn2;
                if (redir) rowp = O2 + (size_t)(row0 + ai * HALF + m * 16) * ld2 + (col0 - u.pn * BM);
                float rs = 1.f; if (ACT != 2) { if (ss) rs = 1.0f / sqrtf((float)ss[row0 + ai * HALF + m * 16] * (1.0f / 16777216.0f) * (1.0f / DM) + EPS); }
#pragma unroll
                for (int bj = 0; bj < 2; ++bj) { f32x4 v0 = acc[ai][bj][m][0], v1 = acc[ai][bj][m][1];
                    if (ACT != 2) { v0 = v0 * rs; v1 = v1 * rs; }
                    if (ACT == 1) {
#pragma unroll
                        for (int j = 0; j < 4; ++j) { const float a = fmaxf(v0[j], 0.f), b = fmaxf(v1[j], 0.f); v0[j] = a * a; v1[j] = b * b; } }
                    if (ACT == 2) { v0 = v0 + bv[bj][0]; v1 = v1 + bv[bj][1];
#pragma unroll
                        for (int j = 0; j < 4; ++j) { v0[j] = sigmoid_f(fminf(fmaxf(v0[j], -30.f), 30.f)); v1[j] = sigmoid_f(fminf(fmaxf(v1[j], -30.f), 30.f)); } }
                    u32x4 w; w.x = pk2(v0[0], v0[1]); w.y = pk2(v0[2], v0[3]); w.z = pk2(v1[0], v1[1]); w.w = pk2(v1[2], v1[3]);
                    *(u32x4*)(rowp + bj * HALF) = w;
                    if (redir) { *(u32x4*)(rowp + bj * HALF + 256) = w; *(u32x4*)(rowp + bj * HALF + 512) = w; } } }
    }
    __device__ __forceinline__ bool hook_at(const Unit&, int) const { return false; }
    __device__ __forceinline__ void hook(f32x4 (&)[2][2][4][2], const Unit&, int, int, int, int, int) const {}
};
struct EpiResid {
    static constexpr bool PERM = true, AFTER_DRAIN = false, HOOK = false;
    const float* in; float* out; int ldc; bf16_t* xb; unsigned long long* ss; int ldxb;
    __device__ __forceinline__ void operator()(const f32x4 (&acc)[2][2][4][2], const Unit& u, int wr, int wc, int fr, int fq) const {
        const int row0 = u.pm * BM + wr * 64 + fr, col0 = u.pn * BM + wc * 32 + 8 * fq, lane = fq * 16 + fr;
#pragma unroll
        for (int ai = 0; ai < 2; ++ai) {
            f32x4 r[4][2][2];
#pragma unroll
            for (int m = 0; m < 4; ++m) { const size_t off = (size_t)(row0 + ai * HALF + m * 16) * ldc + col0;
#pragma unroll
                for (int bj = 0; bj < 2; ++bj)
#pragma unroll
                    for (int n = 0; n < 2; ++n) r[m][bj][n] = *(const f32x4*)(in + off + bj * HALF + n * 4); }
#pragma unroll
            for (int m = 0; m < 4; ++m) { const int row = row0 + ai * HALF + m * 16; const size_t off = (size_t)row * ldc + col0;
                float sq = 0.f;
#pragma unroll
                for (int bj = 0; bj < 2; ++bj) { const f32x4 o0 = r[m][bj][0] + acc[ai][bj][m][0], o1 = r[m][bj][1] + acc[ai][bj][m][1];
                    *(f32x4*)(out + off + bj * HALF) = o0; *(f32x4*)(out + off + bj * HALF + 4) = o1;
                    sq += (o0[0] * o0[0] + o0[1] * o0[1]) + (o0[2] * o0[2] + o0[3] * o0[3]) + (o1[0] * o1[0] + o1[1] * o1[1]) + (o1[2] * o1[2] + o1[3] * o1[3]);
                    u32x4 w; w.x = pk2(o0[0], o0[1]); w.y = pk2(o0[2], o0[3]); w.z = pk2(o1[0], o1[1]); w.w = pk2(o1[2], o1[3]);
                    *(u32x4*)(xb + (size_t)row * ldxb + col0 + bj * HALF) = w; }
                sq += shx(sq, 16, lane); sq += shx(sq, 32, lane);
                if (fq == 0) (void)__hip_atomic_fetch_add(ss + row, (unsigned long long)(sq * 16777216.0f), __ATOMIC_RELAXED, __HIP_MEMORY_SCOPE_AGENT); }
            asm volatile("" ::: "memory"); }
    }
    __device__ __forceinline__ bool hook_at(const Unit&, int) const { return false; }
    __device__ __forceinline__ void hook(f32x4 (&)[2][2][4][2], const Unit&, int, int, int, int, int) const {}
};
struct EpiBranch {
    static constexpr bool PERM = true, AFTER_DRAIN = false, HOOK = true;
    bf16_t* O; int ldc; bf16_t* GT; const float* bias;
    __device__ __forceinline__ bool hook_at(const Unit& u, int t) const { return u.kind == 3 && (t == 16 || t == 32); }
    __device__ __forceinline__ void hook(f32x4 (&acc)[2][2][4][2], const Unit& u, int t, int, int, int, int) const {
        const int tid_ = opaque_tid(), wid_ = tid_ >> 6, wr = wid_ >> 2, wc = wid_ & 3, fr = tid_ & 15, fq = (tid_ >> 4) & 3;
        const int row0 = u.pm * BM + wr * 64 + fr, col0 = u.pn * BM + wc * 32 + 8 * fq;
        const bf16_t* ga = GT + (size_t)(t == 16 ? 0 : DM); const bf16_t* gb = ga + DM;
#pragma unroll
        for (int ai = 0; ai < 2; ++ai) {
            u32x4 a[4][2], b[4][2];
#pragma unroll
            for (int m = 0; m < 4; ++m) { const size_t off = (size_t)(row0 + ai * HALF + m * 16) * GTW + col0;
#pragma unroll
                for (int bj = 0; bj < 2; ++bj) { a[m][bj] = *(const u32x4*)(ga + off + bj * HALF); b[m][bj] = *(const u32x4*)(gb + off + bj * HALF); } }
#pragma unroll
            for (int m = 0; m < 4; ++m)
#pragma unroll
                for (int bj = 0; bj < 2; ++bj) { const u32x4 x = a[m][bj], y = b[m][bj];
                    f32x4 r0, r1;
                    r0[0] = bflo(y.x) * __builtin_amdgcn_rcpf(bflo(x.x)); r0[1] = bfhi(y.x) * __builtin_amdgcn_rcpf(bfhi(x.x));
                    r0[2] = bflo(y.y) * __builtin_amdgcn_rcpf(bflo(x.y)); r0[3] = bfhi(y.y) * __builtin_amdgcn_rcpf(bfhi(x.y));
                    r1[0] = bflo(y.z) * __builtin_amdgcn_rcpf(bflo(x.z)); r1[1] = bfhi(y.z) * __builtin_amdgcn_rcpf(bfhi(x.z));
                    r1[2] = bflo(y.w) * __builtin_amdgcn_rcpf(bflo(x.w)); r1[3] = bfhi(y.w) * __builtin_amdgcn_rcpf(bfhi(x.w));
                    acc[ai][bj][m][0] = acc[ai][bj][m][0] * r0; acc[ai][bj][m][1] = acc[ai][bj][m][1] * r1; }
            asm volatile("" ::: "memory"); }
    }
    __device__ __forceinline__ void operator()(const f32x4 (&acc)[2][2][4][2], const Unit& u, int wr, int wc, int fr, int fq) const {
        const int row0 = u.pm * BM + wr * 64 + fr, col0 = u.pn * BM + wc * 32 + 8 * fq;
        if (u.kind < 3) {
            bf16_t* gd = GT + (size_t)u.kind * DM; const float* bj_ = bias + (size_t)u.kind * DM + col0;
            f32x4 bv[2][2];
#pragma unroll
            for (int bj = 0; bj < 2; ++bj)
#pragma unroll
                for (int n = 0; n < 2; ++n) bv[bj][n] = *(const f32x4*)(bj_ + bj * HALF + 4 * n);
#pragma unroll
            for (int ai = 0; ai < 2; ++ai)
#pragma unroll
                for (int m = 0; m < 4; ++m) { const size_t off = (size_t)(row0 + ai * HALF + m * 16) * GTW + col0;
#pragma unroll
                    for (int bj = 0; bj < 2; ++bj) { f32x4 v0 = acc[ai][bj][m][0] + bv[bj][0], v1 = acc[ai][bj][m][1] + bv[bj][1];
#pragma unroll
                        for (int e = 0; e < 4; ++e) { v0[e] = 1.0f + __expf(-fminf(fmaxf(v0[e], -30.f), 30.f)); v1[e] = 1.0f + __expf(-fminf(fmaxf(v1[e], -30.f), 30.f)); }
                        u32x4 w; w.x = pk2(v0[0], v0[1]); w.y = pk2(v0[2], v0[3]); w.z = pk2(v1[0], v1[1]); w.w = pk2(v1[2], v1[3]);
                        *(u32x4*)(gd + off + bj * HALF) = w; } }
        } else {
            const bf16_t* gc = GT + 2 * DM;
            u32x4 g[2][4][2];
#pragma unroll
            for (int ai = 0; ai < 2; ++ai)
#pragma unroll
                for (int m = 0; m < 4; ++m)
#pragma unroll
                    for (int bj = 0; bj < 2; ++bj) g[ai][m][bj] = *(const u32x4*)(gc + (size_t)(row0 + ai * HALF + m * 16) * GTW + col0 + bj * HALF);
#pragma unroll
            for (int ai = 0; ai < 2; ++ai)
#pragma unroll
                for (int m = 0; m < 4; ++m) { const size_t r = (size_t)(row0 + ai * HALF + m * 16);
#pragma unroll
                    for (int bj = 0; bj < 2; ++bj) { const u32x4 gg = g[ai][m][bj];
                        const f32x4 v0 = acc[ai][bj][m][0], v1 = acc[ai][bj][m][1];
                        u32x4 w; w.x = pk2(v0[0] * __builtin_amdgcn_rcpf(bflo(gg.x)), v0[1] * __builtin_amdgcn_rcpf(bfhi(gg.x))); w.y = pk2(v0[2] * __builtin_amdgcn_rcpf(bflo(gg.y)), v0[3] * __builtin_amdgcn_rcpf(bfhi(gg.y)));
                        w.z = pk2(v1[0] * __builtin_amdgcn_rcpf(bflo(gg.z)), v1[1] * __builtin_amdgcn_rcpf(bfhi(gg.z))); w.w = pk2(v1[2] * __builtin_amdgcn_rcpf(bflo(gg.w)), v1[3] * __builtin_amdgcn_rcpf(bfhi(gg.w)));
                        *(u32x4*)(O + r * ldc + col0 + bj * HALF) = w; } }
        }
    }
};

template <class Epi, class Sched, bool ALIGN_EPI = false, bool SP2 = false>
__device__ __forceinline__ void gemm_phase(PG8_LAS unsigned char* lds, const Gemm g, const Sched& S, const Epi& E) {
    const int tid = opaque_tid(), wid = __builtin_amdgcn_readfirstlane(tid >> 6), lane = tid & 63, wr = wid >> 2, wc = wid & 3, fr = lane & 15, fq = lane >> 4;
    const int K = g.K, nt_default = K / BK;
    unsigned voffA[2], voffB[2];
#pragma unroll
    for (int i = 0; i < 2; ++i) { int R, C; stage_rc(tid * 16 + i * 8192, R, C); const int Rb = Epi::PERM ? ((R & ~31) + perm32(R & 31)) : R;
        voffA[i] = (unsigned)(R * g.lda + C) * 2u; voffB[i] = (unsigned)(Rb * g.ldb + C) * 2u; }
    const unsigned kstep = (unsigned)(BK * 2);
    const unsigned hstepA = (unsigned)HALF * g.lda * 2, hstepB = (unsigned)HALF * g.ldb * 2;
    const unsigned tstepA = 2 * hstepA, tstepB = 2 * hstepB;
    const __amdgpu_buffer_rsrc_t rA = __builtin_amdgcn_make_buffer_rsrc((void*)g.A, 0, (int)0xffffffffu, 0x00020000), rB = __builtin_amdgcn_make_buffer_rsrc((void*)g.Bt, 0, (int)0xffffffffu, 0x00020000);
    const unsigned ldsw = (unsigned)wid * 1024u;
    const int aoff = lds_byte(wr * 64 + fr, fq * 8), boff = lds_byte(wc * 32 + fr, fq * 8);
#define PG8_SA(b, h) (((b) * 2 + (h)) * HTB)
#define PG8_SB(b, h) ((4 + (b) * 2 + (h)) * HTB)
#define PG8_STAGE(bufoff, gbase, voff) do { _Pragma("unroll") for (int _i = 0; _i < 2; ++_i) \
        __builtin_amdgcn_raw_ptr_buffer_load_lds(PG8_RSRC_##voff, (PG8_LAS void*)(lds + (bufoff) + ldsw + _i * 8192), 16, (int)(voff)[_i], (int)(gbase), 0, 0); } while (0)
#define PG8_STAGE1(bufoff, gbase, voff, _i) __builtin_amdgcn_raw_ptr_buffer_load_lds(PG8_RSRC_##voff, (PG8_LAS void*)(lds + (bufoff) + ldsw + (_i) * 8192), 16, (int)(voff)[_i], (int)(gbase), 0, 0)
#define PG8_LDA2(dst, b, h, m0) do { _Pragma("unroll") for (int m = (m0); m < (m0) + 2; ++m) _Pragma("unroll") for (int k = 0; k < 2; ++k) dst[m][k] = *(const PG8_LAS bf16x8*)(lds + PG8_SA(b, h) + aoff + m * 2048 + k * 1024); } while (0)
#define PG8_RSRC_voffA rA
#define PG8_RSRC_voffB rB
#define PG8_LDA(dst, b, h) do { _Pragma("unroll") for (int m = 0; m < 4; ++m) _Pragma("unroll") for (int k = 0; k < 2; ++k) dst[m][k] = *(const PG8_LAS bf16x8*)(lds + PG8_SA(b, h) + aoff + m * 2048 + k * 1024); } while (0)
#define PG8_LDB(dst, b, h) do { _Pragma("unroll") for (int n = 0; n < 2; ++n) _Pragma("unroll") for (int k = 0; k < 2; ++k) dst[n][k] = *(const PG8_LAS bf16x8*)(lds + PG8_SB(b, h) + boff + n * 2048 + k * 1024); } while (0)
#ifndef PG8_BAL
#define PG8_BAL 7
#endif
#ifndef PG8_STAGE_LATE
#define PG8_STAGE_LATE 0
#endif
#ifndef PG8_PRIO
#define PG8_PRIO 1
#endif
#define PG8_MMA(ai, bj, At, Bt) do { if (PG8_PRIO) __builtin_amdgcn_s_setprio(PG8_PRIO); _Pragma("unroll") for (int m = 0; m < 4; ++m) _Pragma("unroll") for (int n = 0; n < 2; ++n) _Pragma("unroll") for (int k = 0; k < 2; ++k) \
        acc[ai][bj][m][n] = __builtin_amdgcn_mfma_f32_16x16x32_bf16(Bt[n][k], At[m][k], acc[ai][bj][m][n], 0, 0, 0); if (PG8_PRIO) __builtin_amdgcn_s_setprio(0); } while (0)
#define PG8_WAIT_V(n) asm volatile("s_waitcnt vmcnt(" #n ")" ::: "memory")
#define PG8_WAIT_L(n) asm volatile("s_waitcnt lgkmcnt(" #n ")" ::: "memory")
#define PG8_BAR __builtin_amdgcn_s_barrier()
#define PG8_SCHED __builtin_amdgcn_sched_barrier(0)
    Unit cur, nxt; int ui = 0;
    if (!S.next(0, cur)) return;
    f32x4 acc[2][2][4][2];
#pragma unroll
    for (int a = 0; a < 2; ++a)
#pragma unroll
        for (int b = 0; b < 2; ++b)
#pragma unroll
            for (int m = 0; m < 4; ++m)
#pragma unroll
                for (int n = 0; n < 2; ++n) acc[a][b][m][n] = (f32x4){0.f, 0.f, 0.f, 0.f};
    bf16x8 At[4][2], B0[2][2], B1[2][2];
#if PG8_BAL >= 3
    bf16x8 B0n[2][2];
#endif
    unsigned cA = (unsigned)cur.pm * tstepA + (unsigned)S.koff(cur) * 2u, cB = (unsigned)cur.pn * tstepB + (unsigned)S.koff(cur) * 2u;
    int nt = S.nt(cur, nt_default);
    S.a_ready(cur);
    if constexpr (SP2) {
        PG8_STAGE(PG8_SB(0, 0), cB, voffB); PG8_STAGE(PG8_SB(0, 1), cB + hstepB, voffB); PG8_STAGE(PG8_SA(0, 0), cA, voffA); PG8_STAGE(PG8_SA(0, 1), cA + hstepA, voffA);
        if (wr == 1) PG8_BAR;
        PG8_WAIT_V(2); PG8_BAR;
#if PG8_BAL == 4
        PG8_STAGE(PG8_SB(1, 0), cB + kstep, voffB); PG8_STAGE(PG8_SB(1, 1), cB + hstepB + kstep, voffB); PG8_STAGE(PG8_SA(1, 0), cA + kstep, voffA);
        PG8_WAIT_V(6); PG8_BAR;
        PG8_LDB(B0, 0, 0);
#elif PG8_BAL == 2
        PG8_STAGE(PG8_SA(1, 0), cA + kstep, voffA); PG8_STAGE(PG8_SB(1, 0), cB + kstep, voffB);
        PG8_WAIT_V(6); PG8_BAR;
#elif PG8_BAL
        PG8_STAGE(PG8_SB(1, 0), cB + kstep, voffB); PG8_STAGE(PG8_SB(1, 1), cB + hstepB + kstep, voffB);
        PG8_WAIT_V(4); PG8_BAR;
#if PG8_BAL == 3 || PG8_BAL == 5 || PG8_BAL == 7 || PG8_BAL == 8
        PG8_LDB(B0, 0, 0);
#endif
#else
        PG8_STAGE(PG8_SB(1, 0), cB + kstep, voffB); PG8_STAGE(PG8_SA(1, 0), cA + kstep, voffA); PG8_STAGE(PG8_SB(1, 1), cB + hstepB + kstep, voffB);
        PG8_WAIT_V(6); PG8_BAR;
#endif
    } else {
        PG8_STAGE(PG8_SB(0, 0), cB, voffB); PG8_STAGE(PG8_SA(0, 0), cA, voffA); PG8_STAGE(PG8_SB(0, 1), cB + hstepB, voffB); PG8_STAGE(PG8_SA(0, 1), cA + hstepA, voffA);
        if (wr == 1) PG8_BAR;
        PG8_WAIT_V(4); PG8_BAR;
        PG8_STAGE(PG8_SB(1, 0), cB + kstep, voffB); PG8_STAGE(PG8_SA(1, 0), cA + kstep, voffA); PG8_STAGE(PG8_SB(1, 1), cB + hstepB + kstep, voffB);
        PG8_WAIT_V(6); PG8_BAR;
    }
    for (;;) {
        const bool has_next = S.next(ui + 1, nxt);
        const unsigned nA = has_next ? (unsigned)nxt.pm * tstepA + (unsigned)S.koff(nxt) * 2u : cA, nB = has_next ? (unsigned)nxt.pn * tstepB + (unsigned)S.koff(nxt) * 2u : cB;
        for (int t = 0; t < nt; t += 2) {
            const bool last = (t == nt - 2);
            if constexpr (Epi::HOOK) { if (E.hook_at(cur, t)) E.hook(acc, cur, t, wr, wc, fr, fq); }
            const unsigned a1 = cA + (unsigned)(t + 1) * kstep;
            const unsigned a2 = last ? nA : cA + (unsigned)(t + 2) * kstep, b2 = last ? nB : cB + (unsigned)(t + 2) * kstep;
            const unsigned a3 = a2 + kstep, b3 = b2 + kstep;
            if (last && has_next) S.a_ready(nxt);
            if constexpr (SP2) {
#if PG8_BAL == 2
            { const unsigned b1 = cB + (unsigned)(t + 1) * kstep;
            PG8_LDB(B0, 0, 0); PG8_LDB(B1, 0, 1); PG8_SCHED; PG8_LDA(At, 0, 0); PG8_STAGE(PG8_SB(1, 1), b1 + hstepB, voffB); PG8_STAGE(PG8_SA(1, 1), a1 + hstepA, voffA);
            PG8_WAIT_V(8); PG8_WAIT_L(0); PG8_BAR; PG8_MMA(0, 0, At, B0); PG8_MMA(0, 1, At, B1); PG8_BAR; PG8_SCHED;
            PG8_LDA(At, 0, 1); PG8_STAGE(PG8_SA(0, 0), a2, voffA); PG8_STAGE(PG8_SB(0, 0), b2, voffB);
            PG8_WAIT_V(6); PG8_WAIT_L(0); PG8_BAR; PG8_MMA(1, 0, At, B0); PG8_MMA(1, 1, At, B1); PG8_BAR; PG8_SCHED;
            PG8_LDB(B0, 1, 0); PG8_LDB(B1, 1, 1); PG8_SCHED; PG8_LDA(At, 1, 0); PG8_STAGE(PG8_SB(0, 1), b2 + hstepB, voffB); PG8_STAGE(PG8_SA(0, 1), a2 + hstepA, voffA);
            PG8_WAIT_V(8); PG8_WAIT_L(0); PG8_BAR; PG8_MMA(0, 0, At, B0); PG8_MMA(0, 1, At, B1); PG8_BAR; PG8_SCHED;
            PG8_LDA(At, 1, 1); PG8_STAGE(PG8_SA(1, 0), a3, voffA); PG8_STAGE(PG8_SB(1, 0), b3, voffB);
            PG8_WAIT_V(6); PG8_WAIT_L(0); PG8_BAR; PG8_MMA(1, 0, At, B0); PG8_MMA(1, 1, At, B1); PG8_BAR; PG8_SCHED; }
#elif PG8_BAL == 4
            PG8_LDB(B1, 0, 1); PG8_SCHED; PG8_LDA(At, 0, 0); PG8_STAGE(PG8_SA(1, 1), a1 + hstepA, voffA);
            PG8_WAIT_V(6); PG8_WAIT_L(0); PG8_BAR; PG8_MMA(0, 0, At, B0); PG8_MMA(0, 1, At, B1); PG8_BAR; PG8_SCHED;
            PG8_LDA(At, 0, 1); PG8_LDB(B0n, 1, 0); PG8_STAGE(PG8_SB(0, 0), b2, voffB); PG8_STAGE(PG8_SB(0, 1), b2 + hstepB, voffB); PG8_STAGE(PG8_SA(0, 0), a2, voffA);
            PG8_WAIT_V(8); PG8_WAIT_L(0); PG8_BAR; PG8_MMA(1, 0, At, B0); PG8_MMA(1, 1, At, B1); PG8_BAR; PG8_SCHED;
            PG8_LDB(B1, 1, 1); PG8_SCHED; PG8_LDA(At, 1, 0); PG8_STAGE(PG8_SA(0, 1), a2 + hstepA, voffA);
            PG8_WAIT_V(6); PG8_WAIT_L(0); PG8_BAR; PG8_MMA(0, 0, At, B0n); PG8_MMA(0, 1, At, B1); PG8_BAR; PG8_SCHED;
            PG8_LDA(At, 1, 1); PG8_LDB(B0, 0, 0); PG8_STAGE(PG8_SB(1, 0), b3, voffB); PG8_STAGE(PG8_SB(1, 1), b3 + hstepB, voffB); PG8_STAGE(PG8_SA(1, 0), a3, voffA);
            PG8_WAIT_V(8); PG8_WAIT_L(0); PG8_BAR; PG8_MMA(1, 0, At, B0n); PG8_MMA(1, 1, At, B1); PG8_BAR; PG8_SCHED;
#elif PG8_BAL == 8
            PG8_STAGE1(PG8_SA(1, 0), a1, voffA, 0); PG8_SCHED; PG8_LDB(B1, 0, 1); PG8_SCHED; PG8_STAGE1(PG8_SA(1, 0), a1, voffA, 1); PG8_SCHED; PG8_LDA2(At, 0, 0, 0); PG8_SCHED; PG8_STAGE1(PG8_SA(1, 1), a1 + hstepA, voffA, 0); PG8_SCHED; PG8_LDA2(At, 0, 0, 2); PG8_SCHED; PG8_STAGE1(PG8_SA(1, 1), a1 + hstepA, voffA, 1);
            PG8_WAIT_V(6); PG8_WAIT_L(0); PG8_BAR; PG8_MMA(0, 0, At, B0); PG8_MMA(0, 1, At, B1); PG8_BAR; PG8_SCHED;
            PG8_STAGE1(PG8_SB(0, 0), b2, voffB, 0); PG8_SCHED; PG8_LDB(B0n, 1, 0); PG8_SCHED; PG8_STAGE1(PG8_SB(0, 0), b2, voffB, 1); PG8_SCHED; PG8_LDA2(At, 0, 1, 0); PG8_SCHED; PG8_STAGE1(PG8_SB(0, 1), b2 + hstepB, voffB, 0); PG8_SCHED; PG8_LDA2(At, 0, 1, 2); PG8_SCHED; PG8_STAGE1(PG8_SB(0, 1), b2 + hstepB, voffB, 1);
            PG8_WAIT_V(6); PG8_WAIT_L(0); PG8_BAR; PG8_MMA(1, 0, At, B0); PG8_MMA(1, 1, At, B1); PG8_BAR; PG8_SCHED;
            PG8_STAGE1(PG8_SA(0, 0), a2, voffA, 0); PG8_SCHED; PG8_LDB(B1, 1, 1); PG8_SCHED; PG8_STAGE1(PG8_SA(0, 0), a2, voffA, 1); PG8_SCHED; PG8_LDA2(At, 1, 0, 0); PG8_SCHED; PG8_STAGE1(PG8_SA(0, 1), a2 + hstepA, voffA, 0); PG8_SCHED; PG8_LDA2(At, 1, 0, 2); PG8_SCHED; PG8_STAGE1(PG8_SA(0, 1), a2 + hstepA, voffA, 1);
            PG8_WAIT_V(6); PG8_WAIT_L(0); PG8_BAR; PG8_MMA(0, 0, At, B0n); PG8_MMA(0, 1, At, B1); PG8_BAR; PG8_SCHED;
            PG8_STAGE1(PG8_SB(1, 0), b3, voffB, 0); PG8_SCHED; PG8_LDB(B0, 0, 0); PG8_SCHED; PG8_STAGE1(PG8_SB(1, 0), b3, voffB, 1); PG8_SCHED; PG8_LDA2(At, 1, 1, 0); PG8_SCHED; PG8_STAGE1(PG8_SB(1, 1), b3 + hstepB, voffB, 0); PG8_SCHED; PG8_LDA2(At, 1, 1, 2); PG8_SCHED; PG8_STAGE1(PG8_SB(1, 1), b3 + hstepB, voffB, 1);
            PG8_WAIT_V(6); PG8_WAIT_L(0); PG8_BAR; PG8_MMA(1, 0, At, B0n); PG8_MMA(1, 1, At, B1); PG8_BAR; PG8_SCHED;
            (void)a3;
#elif PG8_BAL == 7
            PG8_LDB(B1, 0, 1); PG8_SCHED; PG8_STAGE1(PG8_SA(1, 0), a1, voffA, 0); PG8_SCHED; PG8_LDA2(At, 0, 0, 0); PG8_SCHED; PG8_STAGE1(PG8_SA(1, 0), a1, voffA, 1); PG8_SCHED; PG8_LDA2(At, 0, 0, 2); PG8_SCHED; PG8_STAGE(PG8_SA(1, 1), a1 + hstepA, voffA);
            PG8_WAIT_V(6); PG8_WAIT_L(0); PG8_BAR; PG8_MMA(0, 0, At, B0); PG8_MMA(0, 1, At, B1); PG8_BAR; PG8_SCHED;
            PG8_LDB(B0n, 1, 0); PG8_SCHED; PG8_STAGE1(PG8_SB(0, 0), b2, voffB, 0); PG8_SCHED; PG8_LDA2(At, 0, 1, 0); PG8_SCHED; PG8_STAGE1(PG8_SB(0, 0), b2, voffB, 1); PG8_SCHED; PG8_LDA2(At, 0, 1, 2); PG8_SCHED; PG8_STAGE(PG8_SB(0, 1), b2 + hstepB, voffB);
            PG8_WAIT_V(6); PG8_WAIT_L(0); PG8_BAR; PG8_MMA(1, 0, At, B0); PG8_MMA(1, 1, At, B1); PG8_BAR; PG8_SCHED;
            PG8_LDB(B1, 1, 1); PG8_SCHED; PG8_STAGE1(PG8_SA(0, 0), a2, voffA, 0); PG8_SCHED; PG8_LDA2(At, 1, 0, 0); PG8_SCHED; PG8_STAGE1(PG8_SA(0, 0), a2, voffA, 1); PG8_SCHED; PG8_LDA2(At, 1, 0, 2); PG8_SCHED; PG8_STAGE(PG8_SA(0, 1), a2 + hstepA, voffA);
            PG8_WAIT_V(6); PG8_WAIT_L(0); PG8_BAR; PG8_MMA(0, 0, At, B0n); PG8_MMA(0, 1, At, B1); PG8_BAR; PG8_SCHED;
            PG8_LDB(B0, 0, 0); PG8_SCHED; PG8_STAGE1(PG8_SB(1, 0), b3, voffB, 0); PG8_SCHED; PG8_LDA2(At, 1, 1, 0); PG8_SCHED; PG8_STAGE1(PG8_SB(1, 0), b3, voffB, 1); PG8_SCHED; PG8_LDA2(At, 1, 1, 2); PG8_SCHED; PG8_STAGE(PG8_SB(1, 1), b3 + hstepB, voffB);
            PG8_WAIT_V(6); PG8_WAIT_L(0); PG8_BAR; PG8_MMA(1, 0, At, B0n); PG8_MMA(1, 1, At, B1); PG8_BAR; PG8_SCHED;
            (void)a3;
#elif PG8_BAL == 5
            PG8_LDB(B1, 0, 1); PG8_SCHED; PG8_STAGE(PG8_SA(1, 0), a1, voffA); PG8_SCHED; PG8_LDA(At, 0, 0); PG8_SCHED; PG8_STAGE(PG8_SA(1, 1), a1 + hstepA, voffA);
            PG8_WAIT_V(6); PG8_WAIT_L(0); PG8_BAR; PG8_MMA(0, 0, At, B0); PG8_MMA(0, 1, At, B1); PG8_BAR; PG8_SCHED;
            PG8_LDB(B0n, 1, 0); PG8_SCHED; PG8_STAGE(PG8_SB(0, 0), b2, voffB); PG8_SCHED; PG8_LDA(At, 0, 1); PG8_SCHED; PG8_STAGE(PG8_SB(0, 1), b2 + hstepB, voffB);
            PG8_WAIT_V(6); PG8_WAIT_L(0); PG8_BAR; PG8_MMA(1, 0, At, B0); PG8_MMA(1, 1, At, B1); PG8_BAR; PG8_SCHED;
            PG8_LDB(B1, 1, 1); PG8_SCHED; PG8_STAGE(PG8_SA(0, 0), a2, voffA); PG8_SCHED; PG8_LDA(At, 1, 0); PG8_SCHED; PG8_STAGE(PG8_SA(0, 1), a2 + hstepA, voffA);
            PG8_WAIT_V(6); PG8_WAIT_L(0); PG8_BAR; PG8_MMA(0, 0, At, B0n); PG8_MMA(0, 1, At, B1); PG8_BAR; PG8_SCHED;
            PG8_LDB(B0, 0, 0); PG8_SCHED; PG8_STAGE(PG8_SB(1, 0), b3, voffB); PG8_SCHED; PG8_LDA(At, 1, 1); PG8_SCHED; PG8_STAGE(PG8_SB(1, 1), b3 + hstepB, voffB);
            PG8_WAIT_V(6); PG8_WAIT_L(0); PG8_BAR; PG8_MMA(1, 0, At, B0n); PG8_MMA(1, 1, At, B1); PG8_BAR; PG8_SCHED;
            (void)a3;
#elif PG8_BAL == 3
            PG8_LDB(B1, 0, 1); PG8_SCHED; PG8_LDA(At, 0, 0); PG8_STAGE(PG8_SA(1, 0), a1, voffA); PG8_STAGE(PG8_SA(1, 1), a1 + hstepA, voffA);
            PG8_WAIT_V(6); PG8_WAIT_L(0); PG8_BAR; PG8_MMA(0, 0, At, B0); PG8_MMA(0, 1, At, B1); PG8_BAR; PG8_SCHED;
            PG8_LDA(At, 0, 1); PG8_LDB(B0n, 1, 0); PG8_STAGE(PG8_SB(0, 0), b2, voffB); PG8_STAGE(PG8_SB(0, 1), b2 + hstepB, voffB);
            PG8_WAIT_V(6); PG8_WAIT_L(0); PG8_BAR; PG8_MMA(1, 0, At, B0); PG8_MMA(1, 1, At, B1); PG8_BAR; PG8_SCHED;
            PG8_LDB(B1, 1, 1); PG8_SCHED; PG8_LDA(At, 1, 0); PG8_STAGE(PG8_SA(0, 0), a2, voffA); PG8_STAGE(PG8_SA(0, 1), a2 + hstepA, voffA);
            PG8_WAIT_V(6); PG8_WAIT_L(0); PG8_BAR; PG8_MMA(0, 0, At, B0n); PG8_MMA(0, 1, At, B1); PG8_BAR; PG8_SCHED;
            PG8_LDA(At, 1, 1); PG8_LDB(B0, 0, 0); PG8_STAGE(PG8_SB(1, 0), b3, voffB); PG8_STAGE(PG8_SB(1, 1), b3 + hstepB, voffB);
            PG8_WAIT_V(6); PG8_WAIT_L(0); PG8_BAR; PG8_MMA(1, 0, At, B0n); PG8_MMA(1, 1, At, B1); PG8_BAR; PG8_SCHED;
            (void)a3;
#elif PG8_BAL
            PG8_LDB(B0, 0, 0); PG8_LDB(B1, 0, 1); PG8_SCHED; PG8_LDA(At, 0, 0); PG8_STAGE(PG8_SA(1, 0), a1, voffA); PG8_STAGE(PG8_SA(1, 1), a1 + hstepA, voffA);
            PG8_WAIT_V(8); PG8_WAIT_L(0); PG8_BAR; PG8_MMA(0, 0, At, B0); PG8_MMA(0, 1, At, B1); PG8_BAR; PG8_SCHED;
            PG8_LDA(At, 0, 1); PG8_STAGE(PG8_SB(0, 0), b2, voffB); PG8_STAGE(PG8_SB(0, 1), b2 + hstepB, voffB);
            PG8_WAIT_V(6); PG8_WAIT_L(0); PG8_BAR; PG8_MMA(1, 0, At, B0); PG8_MMA(1, 1, At, B1); PG8_BAR; PG8_SCHED;
            PG8_LDB(B0, 1, 0); PG8_LDB(B1, 1, 1); PG8_SCHED; PG8_LDA(At, 1, 0); PG8_STAGE(PG8_SA(0, 0), a2, voffA); PG8_STAGE(PG8_SA(0, 1), a2 + hstepA, voffA);
            PG8_WAIT_V(8); PG8_WAIT_L(0); PG8_BAR; PG8_MMA(0, 0, At, B0); PG8_MMA(0, 1, At, B1); PG8_BAR; PG8_SCHED;
            PG8_LDA(At, 1, 1); PG8_STAGE(PG8_SB(1, 0), b3, voffB); PG8_STAGE(PG8_SB(1, 1), b3 + hstepB, voffB);
            PG8_WAIT_V(6); PG8_WAIT_L(0); PG8_BAR; PG8_MMA(1, 0, At, B0); PG8_MMA(1, 1, At, B1); PG8_BAR; PG8_SCHED;
            (void)a3;
#else
#if PG8_STAGE_LATE
            PG8_LDB(B0, 0, 0); PG8_LDB(B1, 0, 1); PG8_SCHED; PG8_LDA(At, 0, 0); PG8_WAIT_L(0); PG8_SCHED; PG8_STAGE(PG8_SA(1, 1), a1 + hstepA, voffA);
            PG8_WAIT_V(8); PG8_BAR;
#else
            PG8_LDB(B0, 0, 0); PG8_LDB(B1, 0, 1); PG8_SCHED; PG8_LDA(At, 0, 0); PG8_STAGE(PG8_SA(1, 1), a1 + hstepA, voffA);
            PG8_WAIT_V(8); PG8_WAIT_L(0); PG8_BAR;
#endif
            PG8_MMA(0, 0, At, B0); PG8_MMA(0, 1, At, B1); PG8_BAR; PG8_SCHED;
#if PG8_STAGE_LATE
            PG8_LDA(At, 0, 1); PG8_WAIT_L(0); PG8_SCHED; PG8_STAGE(PG8_SB(0, 0), b2, voffB); PG8_STAGE(PG8_SB(0, 1), b2 + hstepB, voffB); PG8_STAGE(PG8_SA(0, 0), a2, voffA);
            PG8_WAIT_V(8); PG8_BAR;
#else
            PG8_LDA(At, 0, 1); PG8_STAGE(PG8_SB(0, 0), b2, voffB); PG8_STAGE(PG8_SB(0, 1), b2 + hstepB, voffB); PG8_STAGE(PG8_SA(0, 0), a2, voffA);
            PG8_WAIT_V(8); PG8_WAIT_L(0); PG8_BAR;
#endif
            PG8_MMA(1, 0, At, B0); PG8_MMA(1, 1, At, B1); PG8_BAR; PG8_SCHED;
#if PG8_STAGE_LATE
            PG8_LDB(B0, 1, 0); PG8_LDB(B1, 1, 1); PG8_SCHED; PG8_LDA(At, 1, 0); PG8_WAIT_L(0); PG8_SCHED; PG8_STAGE(PG8_SA(0, 1), a2 + hstepA, voffA);
            PG8_WAIT_V(8); PG8_BAR;
#else
            PG8_LDB(B0, 1, 0); PG8_LDB(B1, 1, 1); PG8_SCHED; PG8_LDA(At, 1, 0); PG8_STAGE(PG8_SA(0, 1), a2 + hstepA, voffA);
            PG8_WAIT_V(8); PG8_WAIT_L(0); PG8_BAR;
#endif
            PG8_MMA(0, 0, At, B0); PG8_MMA(0, 1, At, B1); PG8_BAR; PG8_SCHED;
#if PG8_STAGE_LATE
            PG8_LDA(At, 1, 1); PG8_WAIT_L(0); PG8_SCHED; PG8_STAGE(PG8_SB(1, 0), b3, voffB); PG8_STAGE(PG8_SB(1, 1), b3 + hstepB, voffB); PG8_STAGE(PG8_SA(1, 0), a3, voffA);
            PG8_WAIT_V(8); PG8_BAR;
#else
            PG8_LDA(At, 1, 1); PG8_STAGE(PG8_SB(1, 0), b3, voffB); PG8_STAGE(PG8_SB(1, 1), b3 + hstepB, voffB); PG8_STAGE(PG8_SA(1, 0), a3, voffA);
            PG8_WAIT_V(8); PG8_WAIT_L(0); PG8_BAR;
#endif
            PG8_MMA(1, 0, At, B0); PG8_MMA(1, 1, At, B1); PG8_BAR; PG8_SCHED;
#endif
            } else {
            PG8_LDB(B0, 0, 0); PG8_SCHED; PG8_LDA(At, 0, 0); PG8_STAGE(PG8_SA(1, 1), a1 + hstepA, voffA);
            PG8_WAIT_L(8); PG8_BAR; PG8_WAIT_L(0); PG8_MMA(0, 0, At, B0); PG8_BAR; PG8_SCHED;
            PG8_LDB(B1, 0, 1); PG8_STAGE(PG8_SB(0, 0), b2, voffB);
            PG8_BAR; PG8_WAIT_L(0); PG8_MMA(0, 1, At, B1); PG8_BAR;
            PG8_LDA(At, 0, 1); PG8_STAGE(PG8_SA(0, 0), a2, voffA);
            PG8_BAR; PG8_WAIT_L(0); PG8_MMA(1, 0, At, B0); PG8_BAR; PG8_SCHED;
            PG8_STAGE(PG8_SB(0, 1), b2 + hstepB, voffB);
            PG8_WAIT_V(6); PG8_BAR; PG8_MMA(1, 1, At, B1); PG8_BAR;
            PG8_LDB(B0, 1, 0); PG8_SCHED; PG8_LDA(At, 1, 0); PG8_STAGE(PG8_SA(0, 1), a2 + hstepA, voffA);
            PG8_WAIT_L(8); PG8_BAR; PG8_WAIT_L(0); PG8_MMA(0, 0, At, B0); PG8_BAR; PG8_SCHED;
            PG8_LDB(B1, 1, 1); PG8_STAGE(PG8_SB(1, 0), b3, voffB);
            PG8_BAR; PG8_WAIT_L(0); PG8_MMA(0, 1, At, B1); PG8_BAR;
            PG8_LDA(At, 1, 1); PG8_STAGE(PG8_SA(1, 0), a3, voffA);
            PG8_BAR; PG8_WAIT_L(0); PG8_MMA(1, 0, At, B0); PG8_BAR; PG8_SCHED;
            PG8_STAGE(PG8_SB(1, 1), b3 + hstepB, voffB);
            PG8_WAIT_V(6); PG8_BAR; PG8_MMA(1, 1, At, B1); PG8_BAR;
            }
        }
        if constexpr (ALIGN_EPI) { if (wr == 0) PG8_BAR; }
        E(acc, cur, wr, wc, fr, fq); S.done(cur);
        if (!has_next) break;
#pragma unroll
        for (int a = 0; a < 2; ++a)
#pragma unroll
            for (int b = 0; b < 2; ++b)
#pragma unroll
                for (int m = 0; m < 4; ++m)
#pragma unroll
                    for (int n = 0; n < 2; ++n) acc[a][b][m][n] = (f32x4){0.f, 0.f, 0.f, 0.f};
        cur = nxt; cA = nA; cB = nB; ++ui; nt = S.nt(cur, nt_default);
        if constexpr (ALIGN_EPI) { if (wr == 1) PG8_BAR; }
    }
    PG8_WAIT_V(0);
    if constexpr (!ALIGN_EPI) { if (wr == 0) PG8_BAR; }
    PG8_BAR;
#undef PG8_SA
#undef PG8_SB
#undef PG8_STAGE
#undef PG8_RSRC_voffA
#undef PG8_STAGE1
#undef PG8_LDA2
#undef PG8_RSRC_voffB
#undef PG8_LDA
#undef PG8_LDB
#undef PG8_MMA
#undef PG8_WAIT_V
#undef PG8_WAIT_L
#undef PG8_BAR
#undef PG8_SCHED
}
}

#define XB_TMO      128
#define XB_XCNT(j)  (256  + 64 * (j))
#define XB_XSUB(j)  (1280 + 64 * (j))
#define XB_XGEN(j)  (2304 + 64 * (j))
#define XB_TOP      3328
#define XB_TOPGEN   3392
#define XCD_BAR_WORDS 3456
#define XB_SPIN_CAP (1u << 18)

__device__ __forceinline__ unsigned xb_ld(unsigned* p)              { return __hip_atomic_load(p, __ATOMIC_RELAXED, __HIP_MEMORY_SCOPE_AGENT); }
__device__ __forceinline__ unsigned xb_add(unsigned* p, unsigned v) { return __hip_atomic_fetch_add(p, v, __ATOMIC_RELAXED, __HIP_MEMORY_SCOPE_AGENT); }
__device__ __forceinline__ unsigned xb_xcc_id() { return (unsigned)__builtin_amdgcn_s_getreg((3 << 11) | 20) & 0xFu; }
#define XB_SPIN(cond, bar) do { unsigned _sp = 0; while (cond) { __builtin_amdgcn_s_sleep(1); \
    if ((++_sp & 255u) == 0u) { if (xb_ld(&(bar)[XB_TMO])) break; if (_sp > XB_SPIN_CAP) { atomicAdd(&(bar)[XB_TMO], 1u); break; } } } } while (0)

struct XcdBarrier {
    unsigned* bar; unsigned x;
    volatile LAS unsigned* st;
};
__device__ __forceinline__ XcdBarrier xcd_barrier_post(unsigned* bar, volatile LAS unsigned* st) {
    XcdBarrier b; b.bar = bar; b.x = xb_xcc_id(); b.st = st;
    if (threadIdx.x == 0) (void)xb_add(&bar[XB_XCNT(b.x)], 1u);
    return b;
}
__device__ __forceinline__ void xcd_barrier_complete(unsigned* bar, unsigned x, unsigned& nloc, unsigned& nx) {
    const unsigned G = gridDim.x * gridDim.y * gridDim.z;
    unsigned sum, cnt, mine, sp = 0u;
    for (;;) {
        sum = 0u; cnt = 0u; mine = 0u;
#pragma unroll
        for (unsigned j = 0; j < 16; ++j) { const unsigned c = xb_ld(&bar[XB_XCNT(j)]); sum += c; cnt += (c > 0u) ? 1u : 0u; mine = (j == x) ? c : mine; }
        if (sum == G) break;
        __builtin_amdgcn_s_sleep(1);
        if ((++sp & 255u) == 0u) { if (xb_ld(&bar[XB_TMO])) break; if (sp > XB_SPIN_CAP) { atomicAdd(&bar[XB_TMO], 1u); break; } }
    }
    nloc = mine > 0u ? mine : 1u; nx = cnt > 0u ? cnt : 1u;
}
__device__ __forceinline__ void xcd_barrier(const XcdBarrier& b) {
    asm volatile("s_waitcnt vmcnt(0)" ::: "memory");
    __syncthreads();
    if (threadIdx.x == 0) {
        unsigned* bar = b.bar;
        __builtin_amdgcn_s_waitcnt(0);
        unsigned nloc = b.st[0], nx = b.st[1];
        if (nloc == 0u) { xcd_barrier_complete(bar, b.x, nloc, nx); b.st[0] = nloc; b.st[1] = nx; }
        const unsigned old = xb_add(&bar[XB_XSUB(b.x)], 1u);
        const unsigned gen = old / nloc;
        if (old + 1u == (gen + 1u) * nloc) {
            __builtin_amdgcn_fence(__ATOMIC_RELEASE, "agent");
            asm volatile("s_waitcnt vmcnt(0)" ::: "memory");
            const unsigned og = xb_add(&bar[XB_TOP], 1u);
            const unsigned tg = og / nx;
            if (og + 1u == (tg + 1u) * nx) xb_add(&bar[XB_TOPGEN], 1u);
            else XB_SPIN(xb_ld(&bar[XB_TOPGEN]) == tg, bar);
            __builtin_amdgcn_fence(__ATOMIC_ACQUIRE, "agent");
            xb_add(&bar[XB_XGEN(b.x)], 1u);
            asm volatile("s_waitcnt vmcnt(0)" ::: "memory");
        } else {
            XB_SPIN(xb_ld(&bar[XB_XGEN(b.x)]) == gen, bar);
            __builtin_amdgcn_fence(__ATOMIC_ACQUIRE, "agent");
            asm volatile("s_waitcnt vmcnt(0)" ::: "memory");
        }
    }
    __syncthreads();
}

struct Params { const float* in[23]; float* out; unsigned char* ws; };
enum { I_X = 0, I_MEM, I_NORM_MIX, I_W_IN, I_W_GLA_A, I_B_GLA_A, I_GLA_NORM, I_CONV_W, I_CONV_B, I_B_ML_I, I_B_ML_F, I_ML_NORM, I_MEM_NORM, I_W_MEM_K, I_W_MEM_V, I_W_BRANCH, I_W_GATE, I_B_GATE, I_W_OUT, I_NORM_FFN, I_W_FF1, I_W_FF2, I_FINAL_NORM };

DI int win_row(int n) {
    if (n < 3072) return n;
    if (n < 3088) return ZC_GA + (n - 3072);
    if (n < 6160) return n - 16;
    if (n < 6168) return ZC_MI + (n - 6160);
    return n - 24;
}
DI void transpose_item(const float* __restrict__ W, int K, int N, bf16_t* __restrict__ WT, int ld_dst, int col_off, int row_off, bool remap, LAS float* scr, int item, int lane, const float* __restrict__ gain = nullptr) {
    const int nblk = (N + 63) >> 6, kb = item / nblk, nb = item - kb * nblk, k0 = kb << 6, n0 = nb << 6;
    const int a = lane & 15, q = lane >> 4, n4 = 4 * a;
    const bool ok = (n0 + n4) < N;
    f32x4 v[16];
#pragma unroll
    for (int i = 0; i < 16; ++i) { const int kk = 4 * i + q; v[i] = ok ? *(const f32x4*)(W + (size_t)(k0 + kk) * N + n0 + n4) : (f32x4){0.f, 0.f, 0.f, 0.f}; }
#pragma unroll
    for (int i = 0; i < 16; ++i) { const int kk = 4 * i + q;
#pragma unroll
        for (int e = 0; e < 4; ++e) scr[(n4 + e) * 65 + kk] = v[i][e]; }
    asm volatile("s_waitcnt lgkmcnt(0)" ::: "memory");
    const int c = lane & 7;
    f32x4 g0 = (f32x4){1.f, 1.f, 1.f, 1.f}, g1 = g0;
    if (gain) { g0 = *(const f32x4*)(gain + k0 + 8 * c); g1 = *(const f32x4*)(gain + k0 + 8 * c + 4); }
#pragma unroll
    for (int jj = 0; jj < 8; ++jj) { const int n = (lane >> 3) + 8 * jj; const LAS float* s = scr + n * 65 + 8 * c;
        u32x4 o; o.x = pk2(s[0] * g0[0], s[1] * g0[1]); o.y = pk2(s[2] * g0[2], s[3] * g0[3]); o.z = pk2(s[4] * g1[0], s[5] * g1[1]); o.w = pk2(s[6] * g1[2], s[7] * g1[3]);
        const int ng = n0 + n;
        if (ng < N) { const int row = row_off + (remap ? win_row(ng) : ng); *(u32x4*)(WT + (size_t)row * ld_dst + col_off + k0 + 8 * c) = o; } }
    asm volatile("s_waitcnt lgkmcnt(0)" ::: "memory");
}

template <bool OUT_F32> DI void rmsnorm_row(const float* __restrict__ xrow, const float* __restrict__ g, void* orow, int lane) {
    const f32x4* xr = (const f32x4*)xrow + lane; const f32x4* gr = (const f32x4*)g + lane;
    f32x4 v[16]; float s = 0.f;
#pragma unroll
    for (int j = 0; j < 16; ++j) { v[j] = xr[64 * j]; s += (v[j].x * v[j].x + v[j].y * v[j].y) + (v[j].z * v[j].z + v[j].w * v[j].w); }
    const float rstd = 1.0f / sqrtf(wave_sum(s, lane) * (1.0f / DM) + EPS);
#pragma unroll
    for (int j = 0; j < 16; ++j) { const f32x4 gg = gr[64 * j]; const f32x4 o = v[j] * rstd * gg;
        if (OUT_F32) ((f32x4*)orow)[lane + 64 * j] = o;
        else { u32x2 w; w.x = pk2(o.x, o.y); w.y = pk2(o.z, o.w); ((u32x2*)orow)[lane + 64 * j] = w; } }
}

DI void row_bf16_ss(const float* __restrict__ xrow, bf16_t* orow, unsigned long long* ss, int lane) {
    const f32x4* xr = (const f32x4*)xrow + lane; float s = 0.f;
#pragma unroll
    for (int j = 0; j < 16; ++j) { const f32x4 v = xr[64 * j]; s += (v.x * v.x + v.y * v.y) + (v.z * v.z + v.w * v.w);
        u32x2 w; w.x = pk2(v.x, v.y); w.y = pk2(v.z, v.w); ((u32x2*)orow)[lane + 64 * j] = w; }
    s = wave_sum(s, lane);
    if (lane == 0) *ss = (unsigned long long)(s * 16777216.0f);
}
DI void row_scale_f32(const float* __restrict__ xrow, const float* __restrict__ g, float ssv, float* orow, int lane) {
    const f32x4* xr = (const f32x4*)xrow + lane; const f32x4* gr = (const f32x4*)g + lane;
    const float rstd = 1.0f / sqrtf(ssv * (1.0f / DM) + EPS);
#pragma unroll
    for (int j = 0; j < 16; ++j) ((f32x4*)orow)[lane + 64 * j] = xr[64 * j] * rstd * gr[64 * j];
}

DI void fill_vT(const bf16_t* __restrict__ Zv, int n, int tg, int lane, LAS unsigned char* VT) {
#pragma unroll
    for (int i = 0; i < 2; ++i) { const int cp = lane + 64 * i; unsigned w[8];
#pragma unroll
        for (int j = 0; j < 8; ++j) w[j] = *(const unsigned*)(Zv + (size_t)(n * CH + 8 * tg + j) * ZW + 2 * cp);
        u32x4 lo, hi;
        lo.x = (w[0] & 0xffffu) | (w[1] << 16); lo.y = (w[2] & 0xffffu) | (w[3] << 16); lo.z = (w[4] & 0xffffu) | (w[5] << 16); lo.w = (w[6] & 0xffffu) | (w[7] << 16);
        hi.x = (w[0] >> 16) | (w[1] & 0xffff0000u); hi.y = (w[2] >> 16) | (w[3] & 0xffff0000u); hi.z = (w[4] >> 16) | (w[5] & 0xffff0000u); hi.w = (w[6] >> 16) | (w[7] & 0xffff0000u);
        *(LAS u32x4*)(VT + (2 * cp) * ROW72 + tg * 16) = lo; *(LAS u32x4*)(VT + (2 * cp + 1) * ROW72 + tg * 16) = hi; }
}
DI void state_mfma(const LAS unsigned char* VT, const LAS unsigned char* KT, bf16_t* __restrict__ OUT, int w, int lane) {
    const int fr = lane & 15, fq = lane >> 4;
    f32x4 acc[2][8];
#pragma unroll
    for (int mi = 0; mi < 2; ++mi)
#pragma unroll
        for (int ni = 0; ni < 8; ++ni) acc[mi][ni] = (f32x4){0.f, 0.f, 0.f, 0.f};
#pragma unroll
    for (int ks = 0; ks < 2; ++ks) {
        bf16x8 a[2];
#pragma unroll
        for (int mi = 0; mi < 2; ++mi) a[mi] = *(const LAS bf16x8*)(VT + (32 * w + 16 * mi + fr) * ROW72 + (32 * ks + 8 * fq) * 2);
#pragma unroll
        for (int ni = 0; ni < 8; ++ni) { const bf16x8 b = *(const LAS bf16x8*)(KT + (16 * ni + fr) * ROW72 + (32 * ks + 8 * fq) * 2);
#pragma unroll
            for (int mi = 0; mi < 2; ++mi) acc[mi][ni] = mfma16(b, a[mi], acc[mi][ni]); }
    }
#pragma unroll
    for (int mi = 0; mi < 2; ++mi)
#pragma unroll
        for (int ni = 0; ni < 8; ++ni) *(u32x2*)(OUT + (size_t)(32 * w + 16 * mi + fr) * 128 + 16 * ni + 4 * fq) = (u32x2){pk2(acc[mi][ni][0], acc[mi][ni][1]), pk2(acc[mi][ni][2], acc[mi][ni][3])};
}
DI void copy_256x128(const bf16_t* __restrict__ src, int gp, LAS unsigned char* dst, int tid) {
#pragma unroll
    for (int i = 0; i < 8; ++i) { const int id = tid + 512 * i, row = id >> 4, cc = id & 15;
        *(LAS u32x4*)(dst + row * ROW136 + cc * 16) = *(const u32x4*)(src + (size_t)row * gp + cc * 8); }
}

DI void ld_v(const bf16_t* __restrict__ Zv, int n, int tg, int lane, unsigned (&w)[2][8]) {
#pragma unroll
    for (int i = 0; i < 2; ++i)
#pragma unroll
        for (int j = 0; j < 8; ++j) w[i][j] = *(const unsigned*)(Zv + (size_t)(n * CH + 8 * tg + j) * ZW + 2 * (lane + 64 * i));
}
DI void st_vT(const unsigned (&w)[2][8], int tg, int lane, LAS unsigned char* VT) {
#pragma unroll
    for (int i = 0; i < 2; ++i) { const int cp = lane + 64 * i; u32x4 lo, hi;
        lo.x = (w[i][0] & 0xffffu) | (w[i][1] << 16); lo.y = (w[i][2] & 0xffffu) | (w[i][3] << 16); lo.z = (w[i][4] & 0xffffu) | (w[i][5] << 16); lo.w = (w[i][6] & 0xffffu) | (w[i][7] << 16);
        hi.x = (w[i][0] >> 16) | (w[i][1] & 0xffff0000u); hi.y = (w[i][2] >> 16) | (w[i][3] & 0xffff0000u); hi.z = (w[i][4] >> 16) | (w[i][5] & 0xffff0000u); hi.w = (w[i][6] >> 16) | (w[i][7] & 0xffff0000u);
        *(LAS u32x4*)(VT + (2 * cp) * ROW72 + tg * 16) = lo; *(LAS u32x4*)(VT + (2 * cp + 1) * ROW72 + tg * 16) = hi; }
}
DI void ld_256x128(const bf16_t* __restrict__ src, int gp, int tid, u32x4 (&r)[8]) {
#pragma unroll
    for (int i = 0; i < 8; ++i) { const int id = tid + 512 * i, row = id >> 4, cc = id & 15; r[i] = *(const u32x4*)(src + (size_t)row * gp + cc * 8); }
}
DI void st_256x128(const u32x4 (&r)[8], LAS unsigned char* dst, int tid) {
#pragma unroll
    for (int i = 0; i < 8; ++i) { const int id = tid + 512 * i, row = id >> 4, cc = id & 15; *(LAS u32x4*)(dst + row * ROW136 + cc * 16) = r[i]; }
}
DI void conv_ld(const bf16_t* __restrict__ Zc, int tok0, unsigned (&x)[11]) {
#pragma unroll
    for (int i = 0; i < 11; ++i) { const int tok = tok0 - 3 + i; x[i] = 0u; if (tok >= 0) x[i] = *(const unsigned*)(Zc + (size_t)tok * ZW); }
}
DI void conv_apply(const unsigned (&x)[11], const float* __restrict__ cw, const float* __restrict__ cb, float (&o0)[8], float (&o1)[8]) {
    f32x2 wj[4];
#pragma unroll
    for (int j = 0; j < 4; ++j) wj[j] = *(const f32x2*)(cw + j * 1024);
    const f32x2 bias = *(const f32x2*)cb;
#pragma unroll
    for (int j = 0; j < 8; ++j) { float y0 = bias.x, y1 = bias.y;
#pragma unroll
        for (int jj = 0; jj < 4; ++jj) { y0 += wj[jj].x * bflo(x[j + jj]); y1 += wj[jj].y * bfhi(x[j + jj]); }
        o0[j] = silu_f(y0); o1[j] = silu_f(y1); }
}
DI void gla_b(const bf16_t* __restrict__ Z, const float* __restrict__ wa, const float* __restrict__ ba, int h, int n, int tg, int c2, LAS float* TOT, float (&b)[8][2], float (&blast)[2]) {
    const int col = h * 128 + 2 * c2;
    float w0[16], w1[16];
#pragma unroll
    for (int r = 0; r < 16; ++r) { const f32x2 w = *(const f32x2*)(wa + r * 512 + col); w0[r] = w.x; w1[r] = w.y; }
    const f32x2 bb = *(const f32x2*)(ba + col);
    float c0 = 0.f, c1 = 0.f;
#pragma unroll
    for (int j = 0; j < 8; ++j) {
        const bf16_t* gp = Z + (size_t)(n * CH + 8 * tg + j) * ZW + ZC_GA;
        const u32x4 g0 = *(const u32x4*)gp, g1 = *(const u32x4*)(gp + 8);
        const float gv[16] = {bflo(g0.x), bfhi(g0.x), bflo(g0.y), bfhi(g0.y), bflo(g0.z), bfhi(g0.z), bflo(g0.w), bfhi(g0.w),
                              bflo(g1.x), bfhi(g1.x), bflo(g1.y), bfhi(g1.y), bflo(g1.z), bfhi(g1.z), bflo(g1.w), bfhi(g1.w)};
        float p0 = bb.x, p1 = bb.y;
#pragma unroll
        for (int r = 0; r < 16; ++r) { p0 += gv[r] * w0[r]; p1 += gv[r] * w1[r]; }
        c0 += log_sigmoid_f(p0) * (1.0f / 16.0f); c1 += log_sigmoid_f(p1) * (1.0f / 16.0f);
        b[j][0] = c0; b[j][1] = c1;
    }
    *(LAS f32x2*)(TOT + tg * 128 + 2 * c2) = (f32x2){c0, c1};
    __syncthreads();
    float pre0 = 0.f, pre1 = 0.f, t0 = 0.f, t1 = 0.f;
#pragma unroll
    for (int g = 0; g < 8; ++g) { const f32x2 t = *(const LAS f32x2*)(TOT + g * 128 + 2 * c2); if (g < tg) { pre0 += t.x; pre1 += t.y; } t0 += t.x; t1 += t.y; }
#pragma unroll
    for (int j = 0; j < 8; ++j) { b[j][0] += pre0; b[j][1] += pre1; }
    blast[0] = t0; blast[1] = t1;
}
DI void conv_silu8(const bf16_t* __restrict__ Zc, const float* __restrict__ cw, const float* __restrict__ cb, int tok0, float (&o0)[8], float (&o1)[8]) {
    float x0[11], x1[11];
#pragma unroll
    for (int i = 0; i < 11; ++i) { const int tok = tok0 - 3 + i; unsigned w = 0u; if (tok >= 0) w = *(const unsigned*)(Zc + (size_t)tok * ZW); x0[i] = bflo(w); x1[i] = bfhi(w); }
    f32x2 wj[4];
#pragma unroll
    for (int j = 0; j < 4; ++j) wj[j] = *(const f32x2*)(cw + j * 1024);
    const f32x2 bias = *(const f32x2*)cb;
#pragma unroll
    for (int j = 0; j < 8; ++j) { float y0 = bias.x, y1 = bias.y;
#pragma unroll
        for (int jj = 0; jj < 4; ++jj) { y0 += wj[jj].x * x0[j + jj]; y1 += wj[jj].y * x1[j + jj]; }
        o0[j] = silu_f(y0); o1[j] = silu_f(y1); }
}
DI void score_mfma(const LAS unsigned char* QL, const LAS unsigned char* KL, int w, int lane, f32x4 (&sacc)[2]) {
    const int fr = lane & 15, fq = lane >> 4, mi = w >> 1, ni0 = 2 * (w & 1);
    sacc[0] = (f32x4){0.f, 0.f, 0.f, 0.f}; sacc[1] = sacc[0];
#pragma unroll
    for (int ks = 0; ks < 4; ++ks) { const bf16x8 a = *(const LAS bf16x8*)(QL + (16 * mi + fr) * ROW136 + (32 * ks + 8 * fq) * 2);
#pragma unroll
        for (int jn = 0; jn < 2; ++jn) { const bf16x8 b = *(const LAS bf16x8*)(KL + (16 * (ni0 + jn) + fr) * ROW136 + (32 * ks + 8 * fq) * 2); sacc[jn] = mfma16(b, a, sacc[jn]); } }
}

struct MixCtx {
    const bf16_t* Z; bf16_t* OB;
    const float *wa, *ba, *gla_norm, *conv_w, *conv_b, *b_i, *b_f, *ml_norm;
    float *DECAY, *DN, *NP, *GG, *FL, *MP, *BG; bf16_t *DS, *DC, *SP, *CP;
    const bf16_t *KM, *VMT;
};

DI void gla_A_unit(const MixCtx& C, LAS unsigned char* lds, int h, int n, int tid) {
    const int lane = tid & 63, tg = __builtin_amdgcn_readfirstlane(tid >> 6), c2 = lane;
    LAS float* TOT = (LAS float*)(lds + L_MISC);
    LAS unsigned char* KT = lds + L_ST; LAS unsigned char* VT = lds + L_VT;
    unsigned kw[8], vw[2][8];
#pragma unroll
    for (int j = 0; j < 8; ++j) kw[j] = *(const unsigned*)(C.Z + (size_t)(n * CH + 8 * tg + j) * ZW + ZC_GK + h * 128 + 2 * c2);
    ld_v(C.Z + ZC_GV + h * 256, n, tg, lane, vw);
    float b[8][2], blast[2];
    gla_b(C.Z, C.wa, C.ba, h, n, tg, c2, TOT, b, blast);
    float k0[8], k1[8];
#pragma unroll
    for (int j = 0; j < 8; ++j) { k0[j] = bflo(kw[j]) * __expf(blast[0] - b[j][0]); k1[j] = bfhi(kw[j]) * __expf(blast[1] - b[j][1]);
        *(f32x2*)(C.BG + ((size_t)(h * NCH + n) * CH + 8 * tg + j) * 128 + 2 * c2) = (f32x2){b[j][0], b[j][1]}; }
    u32x4 lo, hi;
    lo.x = pk2(k0[0], k0[1]); lo.y = pk2(k0[2], k0[3]); lo.z = pk2(k0[4], k0[5]); lo.w = pk2(k0[6], k0[7]);
    hi.x = pk2(k1[0], k1[1]); hi.y = pk2(k1[2], k1[3]); hi.z = pk2(k1[4], k1[5]); hi.w = pk2(k1[6], k1[7]);
    *(LAS u32x4*)(KT + (2 * c2) * ROW72 + tg * 16) = lo; *(LAS u32x4*)(KT + (2 * c2 + 1) * ROW72 + tg * 16) = hi;
    if (tg == 0) *(f32x2*)(C.DECAY + (size_t)(h * NCH + n) * 128 + 2 * c2) = (f32x2){__expf(blast[0]), __expf(blast[1])};
    st_vT(vw, tg, lane, VT);
    __syncthreads();
    state_mfma(VT, KT, C.DS + (size_t)(h * NCH + n) * 32768, tg, lane);
    __syncthreads();
}

DI void gla_B_unit(const MixCtx& C, LAS unsigned char* lds, int h, int n, int tid) {
    const int lane = tid & 63, w = __builtin_amdgcn_readfirstlane(tid >> 6), tg = w, c2 = lane, fr = lane & 15, fq = lane >> 4;
    LAS float* RS = (LAS float*)(lds + L_MISC + 4096);
    LAS unsigned char* ST = lds + L_ST; LAS unsigned char* VT = lds + L_VT; LAS unsigned char* QL = lds + L_Q; LAS unsigned char* KL = lds + L_K;
    const int wr = w >> 1, wc = w & 1, t = 16 * wr + fr;
    const size_t tok = (size_t)(n * CH + t);
    u32x4 st[8]; f32x2 bq[8]; unsigned wq[8], wk[8], vw[2][8]; u32x2 gg[8]; f32x4 gn[8];
    ld_256x128(C.SP + (size_t)(h * NCH + n) * 32768, 128, tid, st);
#pragma unroll
    for (int j = 0; j < 8; ++j) { const size_t zr = (size_t)(n * CH + 8 * tg + j) * ZW;
        bq[j] = *(const f32x2*)(C.BG + ((size_t)(h * NCH + n) * CH + 8 * tg + j) * 128 + 2 * c2);
        wq[j] = *(const unsigned*)(C.Z + zr + ZC_GQ + h * 128 + 2 * c2); wk[j] = *(const unsigned*)(C.Z + zr + ZC_GK + h * 128 + 2 * c2); }
    ld_v(C.Z + ZC_GV + h * 256, n, tg, lane, vw);
#pragma unroll
    for (int ni = 0; ni < 8; ++ni) { const int dv = 128 * wc + 16 * ni + 4 * fq; gg[ni] = *(const u32x2*)(C.Z + tok * ZW + ZC_GG + h * 256 + dv); gn[ni] = *(const f32x4*)(C.gla_norm + h * 256 + dv); }
    const float qs = 0.08838834764831845f;
#pragma unroll
    for (int j = 0; j < 8; ++j) { const float e0 = __expf(bq[j].x), e1 = __expf(bq[j].y);
        *(LAS unsigned*)(QL + (8 * tg + j) * ROW136 + 4 * c2) = pk2(bflo(wq[j]) * qs * e0, bfhi(wq[j]) * qs * e1);
        *(LAS unsigned*)(KL + (8 * tg + j) * ROW136 + 4 * c2) = pk2(bflo(wk[j]) * __builtin_amdgcn_rcpf(e0), bfhi(wk[j]) * __builtin_amdgcn_rcpf(e1)); }
    st_vT(vw, tg, lane, VT);
    st_256x128(st, ST, tid);
    __syncthreads();
    f32x4 sacc[2];
    score_mfma(QL, KL, w, lane, sacc);
    __syncthreads();
    { const int mi = w >> 1, ni0 = 2 * (w & 1), t2 = 16 * mi + fr;
#pragma unroll
      for (int jn = 0; jn < 2; ++jn) { const int s0 = 16 * (ni0 + jn) + 4 * fq; f32x4 v = sacc[jn];
#pragma unroll
          for (int r = 0; r < 4; ++r) if (s0 + r > t2) v[r] = 0.f;
          *(LAS u32x2*)(KL + t2 * ROW72 + s0 * 2) = (u32x2){pk2(v[0], v[1]), pk2(v[2], v[3])}; } }
    __syncthreads();
    f32x4 o[8];
#pragma unroll
    for (int ni = 0; ni < 8; ++ni) o[ni] = (f32x4){0.f, 0.f, 0.f, 0.f};
#pragma unroll
    for (int ks = 0; ks < 2; ++ks) { const bf16x8 a = *(const LAS bf16x8*)(KL + t * ROW72 + (32 * ks + 8 * fq) * 2);
#pragma unroll
        for (int ni = 0; ni < 8; ++ni) { const bf16x8 bb = *(const LAS bf16x8*)(VT + (128 * wc + 16 * ni + fr) * ROW72 + (32 * ks + 8 * fq) * 2); o[ni] = mfma16(bb, a, o[ni]); } }
#pragma unroll
    for (int ks = 0; ks < 4; ++ks) { const bf16x8 a = *(const LAS bf16x8*)(QL + t * ROW136 + (32 * ks + 8 * fq) * 2);
#pragma unroll
        for (int ni = 0; ni < 8; ++ni) { const bf16x8 bb = *(const LAS bf16x8*)(ST + (128 * wc + 16 * ni + fr) * ROW136 + (32 * ks + 8 * fq) * 2); o[ni] = mfma16(bb, a, o[ni]); } }
    float ss = 0.f;
#pragma unroll
    for (int ni = 0; ni < 8; ++ni) ss += (o[ni][0] * o[ni][0] + o[ni][1] * o[ni][1]) + (o[ni][2] * o[ni][2] + o[ni][3] * o[ni][3]);
    ss += shx(ss, 16, lane); ss += shx(ss, 32, lane);
    if (fq == 0) RS[wc * 64 + t] = ss;
    __syncthreads();
    const float rstd = 1.0f / sqrtf((RS[t] + RS[64 + t]) * (1.0f / 256.0f) + EPS);
#pragma unroll
    for (int ni = 0; ni < 8; ++ni) { const int dv = 128 * wc + 16 * ni + 4 * fq;
        const f32x4 v = o[ni] * rstd * gn[ni];
        *(u32x2*)(C.OB + tok * OBW + OB_O + h * 256 + dv) = (u32x2){pk2(v[0] * silu_f(bflo(gg[ni].x)), v[1] * silu_f(bfhi(gg[ni].x))), pk2(v[2] * silu_f(bflo(gg[ni].y)), v[3] * silu_f(bfhi(gg[ni].y)))}; }
    __syncthreads();
}

DI void ml_A_unit(const MixCtx& C, LAS unsigned char* lds, int h, int n, int tid) {
    const int lane = tid & 63, tg = __builtin_amdgcn_readfirstlane(tid >> 6), c2 = lane;
    LAS float* PART = (LAS float*)(lds + L_MISC);
    LAS unsigned char* KT = lds + L_ST; LAS unsigned char* VT = lds + L_VT;
    const size_t ztok = (size_t)(n * CH + lane) * ZW;
    const float li = bf2f(C.Z[ztok + ZC_MI + h]) + C.b_i[h];
    const float lf = log_sigmoid_f(bf2f(C.Z[ztok + ZC_MF + h]) + C.b_f[h]);
    const float F = wave_scan_sum(lf, lane);
    const float Flast = shi(F, 63);
    const float Gv = Flast - F + li;
    const float g = wave_max(Gv, lane);
    const float wG = __expf(Gv - g);
    float k0[8], k1[8];
    conv_silu8(C.Z + ZC_MQK + 512 + h * 128 + 2 * c2, C.conv_w + 512 + h * 128 + 2 * c2, C.conv_b + 512 + h * 128 + 2 * c2, n * CH + 8 * tg, k0, k1);
    const float ks = 0.08838834764831845f;
    float p0 = 0.f, p1 = 0.f;
#pragma unroll
    for (int j = 0; j < 8; ++j) { const float wj = shi(wG, 8 * tg + j) * ks; k0[j] *= wj; k1[j] *= wj; p0 += k0[j]; p1 += k1[j]; }
    u32x4 lo, hi;
    lo.x = pk2(k0[0], k0[1]); lo.y = pk2(k0[2], k0[3]); lo.z = pk2(k0[4], k0[5]); lo.w = pk2(k0[6], k0[7]);
    hi.x = pk2(k1[0], k1[1]); hi.y = pk2(k1[2], k1[3]); hi.z = pk2(k1[4], k1[5]); hi.w = pk2(k1[6], k1[7]);
    *(LAS u32x4*)(KT + (2 * c2) * ROW72 + tg * 16) = lo; *(LAS u32x4*)(KT + (2 * c2 + 1) * ROW72 + tg * 16) = hi;
    *(LAS f32x2*)(PART + tg * 128 + 2 * c2) = (f32x2){p0, p1};
    fill_vT(C.Z + ZC_MV + h * 256, n, tg, lane, VT);
    if (tid == 0) { C.GG[h * NCH + n] = g; C.FL[h * NCH + n] = Flast; }
    __syncthreads();
    if (tid < 128) { float s = 0.f;
#pragma unroll
        for (int q = 0; q < 8; ++q) s += PART[q * 128 + tid];
        C.DN[(size_t)(h * NCH + n) * 128 + tid] = s; }
    state_mfma(VT, KT, C.DC + (size_t)(h * NCH + n) * 32768, tg, lane);
    __syncthreads();
}

DI void ml_B_unit(const MixCtx& C, LAS unsigned char* lds, int h, int n, int tid) {
    const int lane = tid & 63, w = __builtin_amdgcn_readfirstlane(tid >> 6), tg = w, c2 = lane, fr = lane & 15, fq = lane >> 4;
    LAS float* MF = (LAS float*)(lds + L_MISC); LAS float* MU = MF + 64; LAS float* MM = MF + 128; LAS float* MW = MF + 192;
    LAS float* DENP = MF + 256; LAS float* DQN = MF + 512; LAS float* NPV = MF + 576; LAS float* RS = (LAS float*)(lds + L_MISC + 4096);
    LAS unsigned char* CT = lds + L_ST; LAS unsigned char* VT = lds + L_VT; LAS unsigned char* QL = lds + L_Q; LAS unsigned char* KL = lds + L_K;
    copy_256x128(C.CP + (size_t)(h * NCH + n) * 32768, 128, CT, tid);
    if (w == 0) {
        const size_t ztok = (size_t)(n * CH + lane) * ZW;
        const float li = bf2f(C.Z[ztok + ZC_MI + h]) + C.b_i[h];
        const float lf = log_sigmoid_f(bf2f(C.Z[ztok + ZC_MF + h]) + C.b_f[h]);
        const float F = wave_scan_sum(lf, lane);
        const float u = li - F;
        const float pm = wave_scan_max(u, lane);
        const float mprev = C.MP[h * NCH + n];
        const float m = F + fmaxf(pm, mprev);
        MF[lane] = F; MU[lane] = u; MM[lane] = m; MW[lane] = __expf(F + mprev - m);
    }
    if (w == 1) { NPV[lane] = C.NP[(size_t)(h * NCH + n) * 128 + lane]; NPV[64 + lane] = C.NP[(size_t)(h * NCH + n) * 128 + 64 + lane]; }
    {
        float q0[8], q1[8], k0[8], k1[8];
        conv_silu8(C.Z + ZC_MQK + h * 128 + 2 * c2, C.conv_w + h * 128 + 2 * c2, C.conv_b + h * 128 + 2 * c2, n * CH + 8 * tg, q0, q1);
        conv_silu8(C.Z + ZC_MQK + 512 + h * 128 + 2 * c2, C.conv_w + 512 + h * 128 + 2 * c2, C.conv_b + 512 + h * 128 + 2 * c2, n * CH + 8 * tg, k0, k1);
        const float ks = 0.08838834764831845f;
#pragma unroll
        for (int j = 0; j < 8; ++j) { *(LAS unsigned*)(QL + (8 * tg + j) * ROW136 + 4 * c2) = pk2(q0[j], q1[j]); *(LAS unsigned*)(KL + (8 * tg + j) * ROW136 + 4 * c2) = pk2(k0[j] * ks, k1[j] * ks); }
    }
    fill_vT(C.Z + ZC_MV + h * 256, n, tg, lane, VT);
    __syncthreads();
    f32x4 sacc[2];
    score_mfma(QL, KL, w, lane, sacc);
    {
        const int t = tid >> 3, part = tid & 7; float s = 0.f;
#pragma unroll
        for (int e = 0; e < 8; ++e) { const unsigned qq = *(const LAS unsigned*)(QL + t * ROW136 + (16 * part + 2 * e) * 2); s += bflo(qq) * NPV[16 * part + 2 * e] + bfhi(qq) * NPV[16 * part + 2 * e + 1]; }
        s += shx(s, 1, lane); s += shx(s, 2, lane); s += shx(s, 4, lane);
        if (part == 0) DQN[t] = s;
    }
    __syncthreads();
    { const int mi = w >> 1, ni0 = 2 * (w & 1), t = 16 * mi + fr; const float ft = MF[t] - MM[t];
#pragma unroll
      for (int jn = 0; jn < 2; ++jn) { const int s0 = 16 * (ni0 + jn) + 4 * fq; f32x4 v = sacc[jn]; const f32x4 us = *(const LAS f32x4*)(MU + s0);
          float ps = 0.f;
#pragma unroll
          for (int r = 0; r < 4; ++r) { v[r] = (s0 + r > t) ? 0.f : v[r] * __expf(ft + us[r]); ps += v[r]; }
          ps += shx(ps, 16, lane); ps += shx(ps, 32, lane);
          if (fq == 0) DENP[t * 4 + ni0 + jn] = ps;
          *(LAS u32x2*)(KL + t * ROW72 + s0 * 2) = (u32x2){pk2(v[0], v[1]), pk2(v[2], v[3])}; } }
    __syncthreads();
    const int wr = w >> 1, wc = w & 1, t = 16 * wr + fr;
    f32x4 o1[8], o2[8];
#pragma unroll
    for (int ni = 0; ni < 8; ++ni) { o1[ni] = (f32x4){0.f, 0.f, 0.f, 0.f}; o2[ni] = o1[ni]; }
#pragma unroll
    for (int ks = 0; ks < 2; ++ks) { const bf16x8 a = *(const LAS bf16x8*)(KL + t * ROW72 + (32 * ks + 8 * fq) * 2);
#pragma unroll
        for (int ni = 0; ni < 8; ++ni) { const bf16x8 bb = *(const LAS bf16x8*)(VT + (128 * wc + 16 * ni + fr) * ROW72 + (32 * ks + 8 * fq) * 2); o1[ni] = mfma16(bb, a, o1[ni]); } }
#pragma unroll
    for (int ks = 0; ks < 4; ++ks) { const bf16x8 a = *(const LAS bf16x8*)(QL + t * ROW136 + (32 * ks + 8 * fq) * 2);
#pragma unroll
        for (int ni = 0; ni < 8; ++ni) { const bf16x8 bb = *(const LAS bf16x8*)(CT + (128 * wc + 16 * ni + fr) * ROW136 + (32 * ks + 8 * fq) * 2); o2[ni] = mfma16(bb, a, o2[ni]); } }
    const float wi = MW[t];
    const f32x4 dp = *(const LAS f32x4*)(DENP + t * 4);
    const float den = ((dp[0] + dp[1]) + (dp[2] + dp[3])) + wi * DQN[t];
    const float inv = 1.0f / fmaxf(fabsf(den), __expf(-MM[t]));
    const size_t tok = (size_t)(n * CH + t);
    float ss = 0.f;
#pragma unroll
    for (int ni = 0; ni < 8; ++ni) { const int dv = 128 * wc + 16 * ni + 4 * fq;
        const u32x2 mo = *(const u32x2*)(C.Z + tok * ZW + ZC_MO + h * 256 + dv);
        f32x4 v = (o1[ni] + o2[ni] * wi) * inv;
        v[0] *= sigmoid_f(bflo(mo.x)); v[1] *= sigmoid_f(bfhi(mo.x)); v[2] *= sigmoid_f(bflo(mo.y)); v[3] *= sigmoid_f(bfhi(mo.y));
        o1[ni] = v; ss += (v[0] * v[0] + v[1] * v[1]) + (v[2] * v[2] + v[3] * v[3]); }
    ss += shx(ss, 16, lane); ss += shx(ss, 32, lane);
    if (fq == 0) RS[wc * 64 + t] = ss;
    __syncthreads();
    const float rstd = 1.0f / sqrtf((RS[t] + RS[64 + t]) * (1.0f / 256.0f) + EPS);
#pragma unroll
    for (int ni = 0; ni < 8; ++ni) { const int dv = 128 * wc + 16 * ni + 4 * fq; const f32x4 gn = *(const f32x4*)(C.ml_norm + h * 256 + dv);
        const f32x4 v = o1[ni] * rstd * gn;
        *(u32x2*)(C.OB + tok * OBW + OB_O + 1024 + h * 256 + dv) = (u32x2){pk2(v[0], v[1]), pk2(v[2], v[3])}; }
    __syncthreads();
}

#ifndef SCAN_U
#define SCAN_U 8
#endif
DI void scan_phase(const MixCtx& C, int tid) {
    const int NS = 2 * 65536;
    for (int slot = opaque_bx() * 512 + tid; slot < NS; slot += opaque_g() * 512) {
        const int br = slot >> 16, s = slot & 65535, h = s >> 14, dv = (s >> 6) & 255, dkp = s & 63;
        const size_t e0 = (size_t)h * NCH * 32768 + (size_t)dv * 128 + 2 * dkp;
        if (br == 0) {
            float s0 = 0.f, s1 = 0.f;
            for (int n0 = 0; n0 < NCH; n0 += SCAN_U) {
                f32x2 d[SCAN_U], dec[SCAN_U];
#pragma unroll
                for (int u = 0; u < SCAN_U; ++u) { const unsigned dw = *(const unsigned*)(C.DS + e0 + (size_t)(n0 + u) * 32768); d[u] = (f32x2){bflo(dw), bfhi(dw)}; dec[u] = *(const f32x2*)(C.DECAY + (size_t)(h * NCH + n0 + u) * 128 + 2 * dkp); }
#pragma unroll
                for (int u = 0; u < SCAN_U; ++u) { *(unsigned*)(C.SP + e0 + (size_t)(n0 + u) * 32768) = pk2(s0, s1); s0 = dec[u].x * s0 + d[u].x; s1 = dec[u].y * s1 + d[u].y; }
            }
        } else {
            float c0 = 0.f, c1 = 0.f, nn0 = 0.f, nn1 = 0.f, m = -1e30f;
            for (int n0 = 0; n0 < NCH; n0 += SCAN_U) {
                f32x2 d[SCAN_U], dn[SCAN_U]; float fl[SCAN_U], gl[SCAN_U];
#pragma unroll
                for (int u = 0; u < SCAN_U; ++u) { const unsigned dw = *(const unsigned*)(C.DC + e0 + (size_t)(n0 + u) * 32768); d[u] = (f32x2){bflo(dw), bfhi(dw)}; fl[u] = C.FL[h * NCH + n0 + u]; gl[u] = C.GG[h * NCH + n0 + u];
                    dn[u] = (dv == 0) ? *(const f32x2*)(C.DN + (size_t)(h * NCH + n0 + u) * 128 + 2 * dkp) : (f32x2){0.f, 0.f}; }
#pragma unroll
                for (int u = 0; u < SCAN_U; ++u) { *(unsigned*)(C.CP + e0 + (size_t)(n0 + u) * 32768) = pk2(c0, c1);
                    if (dv == 0) { *(f32x2*)(C.NP + (size_t)(h * NCH + n0 + u) * 128 + 2 * dkp) = (f32x2){nn0, nn1}; if (dkp == 0) C.MP[h * NCH + n0 + u] = m; }
                    const float mn = fmaxf(fl[u] + m, gl[u]); const float a = __expf(fl[u] + m - mn), bb = __expf(gl[u] - mn);
                    c0 = a * c0 + bb * d[u].x; c1 = a * c1 + bb * d[u].y; nn0 = a * nn0 + bb * dn[u].x; nn1 = a * nn1 + bb * dn[u].y; m = mn; }
            }
        }
    }
}

DI void mem_unit(const MixCtx& C, LAS unsigned char* lds, int h, int rb, int tid) {
    const int lane = tid & 63, w = __builtin_amdgcn_readfirstlane(tid >> 6), fr = lane & 15, fq = lane >> 4, wr = w >> 1, wc = w & 1, t = 16 * wr + fr;
    LAS unsigned char* QL = lds; LAS unsigned char* PL = lds + 33792; LAS unsigned char* KV = lds + 67584;
    LAS float* RMX = (LAS float*)(lds + L_MISC); LAS float* RSM = RMX + 128;
#pragma unroll
    for (int i = 0; i < 4; ++i) { const int id = tid + 512 * i, row = id >> 5, cc = id & 31;
        *(LAS u32x4*)(QL + row * ROW264 + cc * 16) = *(const u32x4*)(C.Z + (size_t)(rb * 64 + row) * ZW + ZC_XQ + h * 256 + cc * 8); }
    f32x4 s[8];
#pragma unroll
    for (int ni = 0; ni < 8; ++ni) s[ni] = (f32x4){0.f, 0.f, 0.f, 0.f};
#pragma unroll
    for (int half = 0; half < 2; ++half) {
        copy_256x128(C.KM + h * 256 + half * 128, 4096, KV, tid);
        __syncthreads();
#pragma unroll
        for (int ks = 0; ks < 4; ++ks) { const bf16x8 a = *(const LAS bf16x8*)(QL + t * ROW264 + (128 * half + 32 * ks + 8 * fq) * 2);
#pragma unroll
            for (int ni = 0; ni < 8; ++ni) { const bf16x8 bb = *(const LAS bf16x8*)(KV + (128 * wc + 16 * ni + fr) * ROW136 + (32 * ks + 8 * fq) * 2); s[ni] = mfma16(bb, a, s[ni]); } }
        __syncthreads();
    }
    float mx = -3.0e38f;
#pragma unroll
    for (int ni = 0; ni < 8; ++ni) { s[ni] = s[ni] * 0.0625f; mx = fmaxf(mx, fmaxf(fmaxf(s[ni][0], s[ni][1]), fmaxf(s[ni][2], s[ni][3]))); }
    mx = fmaxf(mx, shx(mx, 16, lane)); mx = fmaxf(mx, shx(mx, 32, lane));
    if (fq == 0) RMX[wc * 64 + t] = mx;
    copy_256x128(C.VMT + (size_t)(h * 256) * 256, 256, KV, tid);
    __syncthreads();
    mx = fmaxf(RMX[t], RMX[64 + t]);
    float sm = 0.f;
#pragma unroll
    for (int ni = 0; ni < 8; ++ni) {
#pragma unroll
        for (int r = 0; r < 4; ++r) { s[ni][r] = __expf(s[ni][r] - mx); sm += s[ni][r]; } }
    sm += shx(sm, 16, lane); sm += shx(sm, 32, lane);
    if (fq == 0) RSM[wc * 64 + t] = sm;
    __syncthreads();
    const float inv = 1.0f / (RSM[t] + RSM[64 + t]);
#pragma unroll
    for (int ni = 0; ni < 8; ++ni) { const f32x4 p = s[ni] * inv; *(LAS u32x2*)(PL + t * ROW264 + (128 * wc + 16 * ni + 4 * fq) * 2) = (u32x2){pk2(p[0], p[1]), pk2(p[2], p[3])}; }
    f32x4 o[8];
#pragma unroll
    for (int ni = 0; ni < 8; ++ni) o[ni] = (f32x4){0.f, 0.f, 0.f, 0.f};
#pragma unroll
    for (int half = 0; half < 2; ++half) {
        if (half == 1) copy_256x128(C.VMT + (size_t)(h * 256) * 256 + 128, 256, KV, tid);
        __syncthreads();
#pragma unroll
        for (int ks = 0; ks < 4; ++ks) { const bf16x8 a = *(const LAS bf16x8*)(PL + t * ROW264 + (128 * half + 32 * ks + 8 * fq) * 2);
#pragma unroll
            for (int ni = 0; ni < 8; ++ni) { const bf16x8 bb = *(const LAS bf16x8*)(KV + (128 * wc + 16 * ni + fr) * ROW136 + (32 * ks + 8 * fq) * 2); o[ni] = mfma16(bb, a, o[ni]); } }
        __syncthreads();
    }
    const size_t tok = (size_t)(rb * 64 + t);
#pragma unroll
    for (int ni = 0; ni < 8; ++ni) { const int d = 128 * wc + 16 * ni + 4 * fq; *(u32x2*)(C.OB + tok * OBW + OB_O + 2048 + h * 256 + d) = (u32x2){pk2(o[ni][0], o[ni][1]), pk2(o[ni][2], o[ni][3])}; }
}

#ifndef GEMM_ALIGN
#define GEMM_ALIGN true
#endif
#ifndef REP_PRO
#define REP_PRO 1
#endif
#ifndef REP_MIXA
#define REP_MIXA 1
#endif
#ifndef REP_SCAN
#define REP_SCAN 1
#endif
#ifndef REP_MIXB
#define REP_MIXB 1
#endif
#ifndef REP_FF1
#define REP_FF1 1
#endif
#ifndef REP_NORM
#define REP_NORM 1
#endif
#ifndef WGM_IN
#define WGM_IN PG8_WGM
#endif
#ifndef WGM_BR
#define WGM_BR PG8_WGM
#endif
#ifndef WGM_OUT
#define WGM_OUT PG8_WGM
#endif
#ifndef WGM_F1
#define WGM_F1 8
#endif
#ifndef WGM_F2
#define WGM_F2 PG8_WGM
#endif
#ifndef REP_GLAA
#define REP_GLAA 1
#endif
#ifndef REP_MEM
#define REP_MEM 1
#endif
#ifndef REP_GLAB
#define REP_GLAB 1
#endif
#ifndef REP_GATE
#define REP_GATE 1
#endif
#ifndef REP_BR
#define REP_BR 1
#endif
#ifndef GEMM_SP2
#define GEMM_SP2 true
#endif
constexpr int L_PTR = L_BARW + 256;
DI unsigned long long tab_ld(LAS unsigned char* lds, int k) {
    const unsigned long long v = *(volatile LAS unsigned long long*)(lds + L_PTR + 8 * k);
    const unsigned lo = __builtin_amdgcn_readfirstlane((unsigned)v), hi = __builtin_amdgcn_readfirstlane((unsigned)(v >> 32));
    return ((unsigned long long)hi << 32) | lo;
}
DI const float* tab_in(LAS unsigned char* lds, int k) { return (const float*)(const GAS float*)tab_ld(lds, k); }
DI unsigned char* tab_ws(LAS unsigned char* lds) { return (unsigned char*)(GAS unsigned char*)tab_ld(lds, 24); }
DI void grid_bar(LAS unsigned char* lds) {
    XcdBarrier b; b.bar = (unsigned*)(tab_ws(lds) + WS_CTL) + CW_BAR; b.x = xb_xcc_id(); b.st = (volatile LAS unsigned*)(lds + L_BARW);
    xcd_barrier(b);
}
DI void make_ctx(MixCtx& C, LAS unsigned char* lds, int l) {
    unsigned char* ws = tab_ws(lds);
    C.Z = (const bf16_t*)(ws + WS_Z); C.OB = (bf16_t*)(ws + WS_OB);
    C.wa = tab_in(lds, I_W_GLA_A) + (size_t)l * 16 * 512; C.ba = tab_in(lds, I_B_GLA_A) + l * 512; C.gla_norm = tab_in(lds, I_GLA_NORM) + l * 1024;
    C.conv_w = tab_in(lds, I_CONV_W) + (size_t)l * 4 * 1024; C.conv_b = tab_in(lds, I_CONV_B) + l * 1024; C.b_i = tab_in(lds, I_B_ML_I) + l * 4; C.b_f = tab_in(lds, I_B_ML_F) + l * 4; C.ml_norm = tab_in(lds, I_ML_NORM) + l * 1024;
    C.BG = (float*)(ws + WS_BG); C.DS = (bf16_t*)(ws + WS_DS); C.DC = (bf16_t*)(ws + WS_DC); C.SP = (bf16_t*)(ws + WS_SP); C.CP = (bf16_t*)(ws + WS_CP);
    C.DECAY = (float*)(ws + WS_SMALL + SM_DECAY); C.DN = (float*)(ws + WS_SMALL + SM_DN); C.NP = (float*)(ws + WS_SMALL + SM_NP);
    C.GG = (float*)(ws + WS_SMALL + SM_GG); C.FL = (float*)(ws + WS_SMALL + SM_FL); C.MP = (float*)(ws + WS_SMALL + SM_MP);
    C.KM = (const bf16_t*)(ws + WS_KM) + l * 1024; C.VMT = (const bf16_t*)(ws + WS_VMT) + (size_t)l * 1024 * 256;
}

__global__ void __launch_bounds__(512, 2) trunk_fwd(Params p) {
    extern __shared__ __attribute__((aligned(16))) unsigned char lds_raw[];
    LAS unsigned char* lds0 = (LAS unsigned char*)lds_raw;
    {
        LAS unsigned char* lds = lds0;
        const int tid0 = threadIdx.x;
        if (tid0 < 64) ((LAS unsigned*)(lds + L_BARW))[tid0] = 0u;
        if (tid0 < 23) *(LAS unsigned long long*)(lds + L_PTR + 8 * tid0) = (unsigned long long)p.in[tid0];
        if (tid0 == 23) *(LAS unsigned long long*)(lds + L_PTR + 8 * 23) = (unsigned long long)p.out;
        if (tid0 == 24) *(LAS unsigned long long*)(lds + L_PTR + 8 * 24) = (unsigned long long)p.ws;
        __syncthreads();
        (void)xcd_barrier_post((unsigned*)(p.ws + WS_CTL) + CW_BAR, (volatile LAS unsigned*)(lds + L_BARW));
    }
#define TID (opaque_tid())
#define LANE (opaque_tid() & 63)
#define WAVE (__builtin_amdgcn_readfirstlane(opaque_tid() >> 6))
#define GW (opaque_bx() * NWAVES + WAVE)
#define NGW (opaque_g() * NWAVES)

    for (int rep = 0; rep < REP_PRO; ++rep) {
        LAS unsigned char* lds = opaque_lds(lds0); unsigned char* ws = tab_ws(lds);
        bf16_t* WIN = (bf16_t*)(ws + WS_WIN);
        const int lane = LANE, wave = WAVE;
        LAS float* scr = (LAS float*)(lds + wave * 16640);
        constexpr int IT_IN = 64 * 117, IT_BR = 16 * 64, IT_G = 4 * 64, IT_OUT = 64 * 64, IT_F1 = 64 * 256, IT_F2 = 256 * 64, IT_MK = 64 * 16;
        constexpr int E_IN = 4 * IT_IN, E_BR = E_IN + 12 * IT_BR, E_G = E_BR + 12 * IT_G, E_OUT = E_G + 4 * IT_OUT, E_F1 = E_OUT + 4 * IT_F1, E_F2 = E_F1 + 4 * IT_F2, E_MK = E_F2 + 4 * IT_MK, E_MV = E_MK + 4 * IT_MK;
        for (int it = GW; it < E_MV; it += NGW) {
            if (it < E_IN) { const int l = it / IT_IN, r = it - l * IT_IN; transpose_item(tab_in(lds, I_W_IN) + (size_t)l * DM * IN_W, DM, IN_W, WIN + (size_t)l * ZW * PW, PW, 0, 0, true, scr, r, lane, tab_in(lds, I_NORM_MIX) + l * DM); }
            else if (it < E_BR) { const int q = it - E_IN, lj = q / IT_BR, r = q - lj * IT_BR, l = lj / 3, j = lj - 3 * l; transpose_item(tab_in(lds, I_W_BRANCH) + (size_t)lj * 1024 * DM, 1024, DM, (bf16_t*)(ws + WS_WBR) + (size_t)l * DM * OBW, OBW, OB_O + j * 1024, 0, false, scr, r, lane); }
            else if (it < E_G) { const int q = it - E_BR, lj = q / IT_G, r = q - lj * IT_G, l = lj / 3, j = lj - 3 * l; transpose_item(tab_in(lds, I_W_GATE) + (size_t)lj * 256 * DM, 256, DM, (bf16_t*)(ws + WS_WBR) + (size_t)l * DM * OBW, OBW, j * 256, 0, false, scr, r, lane); }
            else if (it < E_OUT) { const int q = it - E_G, l = q / IT_OUT, r = q - l * IT_OUT; transpose_item(tab_in(lds, I_W_OUT) + (size_t)l * DM * DM, DM, DM, (bf16_t*)(ws + WS_WOUT) + (size_t)l * DM * PW, PW, 0, 0, false, scr, r, lane); }
            else if (it < E_F1) { const int q = it - E_OUT, l = q / IT_F1, r = q - l * IT_F1; transpose_item(tab_in(lds, I_W_FF1) + (size_t)l * DM * DFF, DM, DFF, (bf16_t*)(ws + WS_W1) + (size_t)l * DFF * PW, PW, 0, 0, false, scr, r, lane, tab_in(lds, I_NORM_FFN) + l * DM); }
            else if (it < E_F2) { const int q = it - E_F1, l = q / IT_F2, r = q - l * IT_F2; transpose_item(tab_in(lds, I_W_FF2) + (size_t)l * DFF * DM, DFF, DM, (bf16_t*)(ws + WS_W2) + (size_t)l * DM * PU, PU, 0, 0, false, scr, r, lane); }
            else if (it < E_MK) { const int q = it - E_F2, l = q / IT_MK, r = q - l * IT_MK; transpose_item(tab_in(lds, I_W_MEM_K) + (size_t)l * DM * 1024, DM, 1024, (bf16_t*)(ws + WS_WMK), DM, 0, l * 1024, false, scr, r, lane); }
            else { const int q = it - E_MK, l = q / IT_MK, r = q - l * IT_MK; transpose_item(tab_in(lds, I_W_MEM_V) + (size_t)l * DM * 1024, DM, 1024, (bf16_t*)(ws + WS_WMV), DM, 0, l * 1024, false, scr, r, lane); }
        }
        constexpr int PADCH = (ZW - IN_W) * PW / 8;
        for (int i = opaque_bx() * 512 + TID; i < NL * PADCH; i += opaque_g() * 512) { const int l = i / PADCH, r = i - l * PADCH; *(u32x4*)(WIN + (size_t)l * ZW * PW + (size_t)IN_W * PW + (size_t)r * 8) = (u32x4){0u, 0u, 0u, 0u}; }
        for (int m = GW; m < SEQ; m += NGW) row_bf16_ss(tab_in(lds, I_X) + (size_t)m * DM, (bf16_t*)(ws + WS_H) + (size_t)m * PW, (u64_t*)(ws + WS_SS) + m, lane);
        for (int m = GW; m < MEML; m += NGW) rmsnorm_row<false>(tab_in(lds, I_MEM) + (size_t)m * DM, tab_in(lds, I_MEM_NORM), (bf16_t*)(ws + WS_MEMN) + (size_t)m * DM, lane);
    }
    grid_bar(opaque_lds(lds0));
    for (int l = 0; l < NL; ++l) {
        {
            LAS unsigned char* lds = opaque_lds(lds0); unsigned char* ws = tab_ws(lds);
            pg8::Gemm g{(const bf16_t*)(ws + WS_H), (const bf16_t*)(ws + WS_WIN) + (size_t)l * ZW * PW, opq(SEQ), opq(ZW), opq(DM), opq(PW), opq(PW)}; pg8::StaticOrder S; S.init(opq(SEQ), opq(ZW), opaque_g(), opaque_bx(), opq(WGM_IN)); pg8::EpiBf16<0> E{(bf16_t*)(ws + WS_Z), ZW, nullptr, (const u64_t*)(ws + WS_SS) + (size_t)(2 * l) * SEQ, (bf16_t*)(ws + WS_OB), OBW, ZC_GATE / 256};
            pg8::gemm_phase<pg8::EpiBf16<0>, pg8::StaticOrder, GEMM_ALIGN, GEMM_SP2>(lds, g, S, E);
        }
        if (l == 0) {
            const int kvc = (opaque_g() >= 256 && opaque_bx() >= 128) ? opaque_bx() - 128 : opaque_bx() + (1 << 20) * (opaque_g() >= 256 ? 1 : 0);
        {
            LAS unsigned char* lds = opaque_lds(lds0); unsigned char* ws = tab_ws(lds);
        { pg8::Gemm g{(const bf16_t*)(ws + WS_MEMN), (const bf16_t*)(ws + WS_WMK), opq(MEML), opq(DM), opq(DM), opq(DM), opq(DM)}; pg8::StaticOrder S; S.init(opq(MEML), opq(DM), opaque_g(), kvc); pg8::EpiBf16<0> E{(bf16_t*)(ws + WS_KM), DM, nullptr, nullptr, nullptr, 0, -1};
          pg8::gemm_phase<pg8::EpiBf16<0>, pg8::StaticOrder, GEMM_ALIGN, GEMM_SP2>(lds, g, S, E); }
    }
        {
            LAS unsigned char* lds = opaque_lds(lds0); unsigned char* ws = tab_ws(lds);
        { pg8::Gemm g{(const bf16_t*)(ws + WS_WMV), (const bf16_t*)(ws + WS_MEMN), opq(DM), opq(MEML), opq(DM), opq(DM), opq(DM)}; pg8::StaticOrder S; S.init(opq(DM), opq(MEML), opaque_g(), kvc - 16); pg8::EpiBf16<0> E{(bf16_t*)(ws + WS_VMT), MEML, nullptr, nullptr, nullptr, 0, -1};
          pg8::gemm_phase<pg8::EpiBf16<0>, pg8::StaticOrder, GEMM_ALIGN, GEMM_SP2>(lds, g, S, E); }
    }
        }
        grid_bar(opaque_lds(lds0));
        {
            LAS unsigned char* lds = opaque_lds(lds0); MixCtx C; make_ctx(C, lds, l); const int tid = TID;
            for (int rep = 0; rep < REP_MIXA; ++rep) {
            for (int r2 = 0; r2 < REP_GLAA; ++r2) for (int i = opaque_bx(); i < 4 * NCH; i += opaque_g()) gla_A_unit(C, lds, i >> 8, i & 255, tid);
            for (int i = opaque_bx(); i < 4 * NCH; i += opaque_g()) ml_A_unit(C, lds, i >> 8, i & 255, tid);
            for (int r2 = 0; r2 < REP_MEM; ++r2) for (int i = opaque_bx(); i < 4 * NCH; i += opaque_g()) mem_unit(C, lds, i >> 8, i & 255, tid);
            }
        }
        grid_bar(opaque_lds(lds0));
        { LAS unsigned char* lds = opaque_lds(lds0); MixCtx C; make_ctx(C, lds, l); for (int rep = 0; rep < REP_SCAN; ++rep) scan_phase(C, TID); }
        grid_bar(opaque_lds(lds0));
        {
            LAS unsigned char* lds = opaque_lds(lds0); MixCtx C; make_ctx(C, lds, l); const int tid = TID;
            for (int rep = 0; rep < REP_MIXB; ++rep) {
            for (int r2 = 0; r2 < REP_GLAB; ++r2) for (int i = opaque_bx(); i < 4 * NCH; i += opaque_g()) gla_B_unit(C, lds, i >> 8, i & 255, tid);
            for (int i = opaque_bx(); i < 4 * NCH; i += opaque_g()) ml_B_unit(C, lds, i >> 8, i & 255, tid);
            }
        }
        grid_bar(opaque_lds(lds0));
        for (int rep = 0; rep < REP_BR; ++rep) {
            LAS unsigned char* lds = opaque_lds(lds0); unsigned char* ws = tab_ws(lds);
            pg8::Gemm g{(const bf16_t*)(ws + WS_OB), (const bf16_t*)(ws + WS_WBR) + (size_t)l * DM * OBW, opq(SEQ), opq(DM), opq(OBW), opq(OBW), opq(OBW)}; pg8::BranchOrder S; S.init(opq(SEQ), opq(DM), opaque_g(), opaque_bx(), opq(WGM_BR)); pg8::EpiBranch E{(bf16_t*)(ws + WS_Y), PW, (bf16_t*)(ws + WS_GT), tab_in(lds, I_B_GATE) + (size_t)l * GTW};
            pg8::gemm_phase<pg8::EpiBranch, pg8::BranchOrder, GEMM_ALIGN, GEMM_SP2>(lds, g, S, E);
        }
        grid_bar(opaque_lds(lds0));
        {
            LAS unsigned char* lds = opaque_lds(lds0); unsigned char* ws = tab_ws(lds);
            const float* Xin = (l == 0) ? tab_in(lds, I_X) : (const float*)(ws + WS_X);
            pg8::Gemm g{(const bf16_t*)(ws + WS_Y), (const bf16_t*)(ws + WS_WOUT) + (size_t)l * DM * PW, opq(SEQ), opq(DM), opq(DM), opq(PW), opq(PW)}; pg8::StaticOrder S; S.init(opq(SEQ), opq(DM), opaque_g(), opaque_bx(), opq(WGM_OUT)); pg8::EpiResid E{Xin, (float*)(ws + WS_X), DM, (bf16_t*)(ws + WS_H), (u64_t*)(ws + WS_SS) + (size_t)(2 * l + 1) * SEQ, PW};
            pg8::gemm_phase<pg8::EpiResid, pg8::StaticOrder, GEMM_ALIGN, GEMM_SP2>(lds, g, S, E);
        }
        grid_bar(opaque_lds(lds0));
        for (int rep = 0; rep < REP_FF1; ++rep) {
            LAS unsigned char* lds = opaque_lds(lds0); unsigned char* ws = tab_ws(lds);
            pg8::Gemm g{(const bf16_t*)(ws + WS_H), (const bf16_t*)(ws + WS_W1) + (size_t)l * DFF * PW, opq(SEQ), opq(DFF), opq(DM), opq(PW), opq(PW)}; pg8::StaticOrder S; S.init(opq(SEQ), opq(DFF), opaque_g(), opaque_bx(), opq(WGM_F1)); pg8::EpiBf16<1> E{(bf16_t*)(ws + WS_U), PU, nullptr, (const u64_t*)(ws + WS_SS) + (size_t)(2 * l + 1) * SEQ, nullptr, 0, -1};
            pg8::gemm_phase<pg8::EpiBf16<1>, pg8::StaticOrder, GEMM_ALIGN, GEMM_SP2>(lds, g, S, E);
        }
        grid_bar(opaque_lds(lds0));
        {
            LAS unsigned char* lds = opaque_lds(lds0); unsigned char* ws = tab_ws(lds);
            pg8::Gemm g{(const bf16_t*)(ws + WS_U), (const bf16_t*)(ws + WS_W2) + (size_t)l * DM * PU, opq(SEQ), opq(DM), opq(DFF), opq(PU), opq(PU)}; pg8::StaticOrder S; S.init(opq(SEQ), opq(DM), opaque_g(), opaque_bx(), opq(WGM_F2)); pg8::EpiResid E{(const float*)(ws + WS_X), (float*)(ws + WS_X), DM, (bf16_t*)(ws + WS_H), (u64_t*)(ws + WS_SS) + (size_t)(2 * l + 2) * SEQ, PW};
            pg8::gemm_phase<pg8::EpiResid, pg8::StaticOrder, GEMM_ALIGN, GEMM_SP2>(lds, g, S, E);
        }
        grid_bar(opaque_lds(lds0));
    }
    {
        LAS unsigned char* lds = opaque_lds(lds0); unsigned char* ws = tab_ws(lds);
        const float* X = (const float*)(ws + WS_X); const float* gain = tab_in(lds, I_FINAL_NORM); float* out = (float*)(GAS float*)tab_ld(lds, 23); const int lane = LANE;
        const u64_t* ssf = (const u64_t*)(ws + WS_SS) + (size_t)8 * SEQ;
        for (int m = GW; m < SEQ; m += NGW) row_scale_f32(X + (size_t)m * DM, gain, ss_to_f(ssf[m]), out + (size_t)m * DM, lane);
    }
}

extern "C" void kernel_launch(void* const* d_in, const int* in_sizes, int n_in, void* d_out, int out_size, void* d_ws, size_t ws_size, hipStream_t stream) {
    static int grid = 0;
    if (grid == 0) {
        if (n_in != 23 || out_size != SEQ * DM || ws_size < WS_END) { fprintf(stderr, "kernel_launch: unexpected shapes (n_in %d out %d ws %zu, need %zu)\n", n_in, out_size, ws_size, (size_t)WS_END); grid = -1; return; }
        int dev = 0, cus = 0, per_cu = 0;
        if (hipGetDevice(&dev) != hipSuccess || hipDeviceGetAttribute(&cus, hipDeviceAttributeMultiprocessorCount, dev) != hipSuccess) { grid = -1; return; }
        if (hipFuncSetAttribute((const void*)trunk_fwd, hipFuncAttributeMaxDynamicSharedMemorySize, LDS_BYTES) != hipSuccess) { fprintf(stderr, "kernel_launch: hipFuncSetAttribute failed\n"); grid = -1; return; }
        if (hipOccupancyMaxActiveBlocksPerMultiprocessor(&per_cu, (const void*)trunk_fwd, 512, LDS_BYTES) != hipSuccess || per_cu < 1) { fprintf(stderr, "kernel_launch: occupancy query says %d\n", per_cu); (void)hipGetLastError(); }
        grid = cus;
    }
    if (grid < 0) return;
    if (hipMemsetAsync((char*)d_ws + WS_CTL, 0, CTL_ZERO_BYTES, stream) != hipSuccess) return;
    if (hipMemsetAsync((char*)d_ws + WS_SS, 0, SS_ZERO_BYTES, stream) != hipSuccess) return;
    Params p{};
    for (int i = 0; i < 23; ++i) p.in[i] = (const float*)d_in[i];
    p.out = (float*)d_out; p.ws = (unsigned char*)d_ws;
    hipLaunchKernelGGL(trunk_fwd, dim3(grid), dim3(512), LDS_BYTES, stream, p);
}
```

```cpp
#include <hip/hip_runtime.h>
#include <cstdio>
#include <cstdint>

#define DI __device__ __forceinline__
#define GAS __attribute__((address_space(1)))
#define LAS __attribute__((address_space(3)))
typedef unsigned short bf16_t;
typedef short bf16x8 __attribute__((ext_vector_type(8)));
typedef float f32x4 __attribute__((ext_vector_type(4)));
typedef float f32x2 __attribute__((ext_vector_type(2)));
typedef unsigned u32x4 __attribute__((ext_vector_type(4)));
typedef unsigned u32x2 __attribute__((ext_vector_type(2)));

constexpr int SEQ = 16384, DM = 4096, DFF = 16384, NL = 4, MEML = 256, CH = 64, NCH = SEQ / CH;
constexpr int IN_W = 7448, ZW = 7680;
constexpr int ZC_GQ = 0, ZC_GK = 512, ZC_GV = 1024, ZC_GG = 2048, ZC_MQK = 3072, ZC_MV = 4096, ZC_MO = 5120, ZC_XQ = 6144, ZC_GATE = 7168, ZC_GA = 7424, ZC_MI = 7440, ZC_MF = 7444;
constexpr int OBW = 3840, OB_O = 768;
constexpr int GTW = 12288;
constexpr float EPS = 1e-6f;
#ifndef PITCH_PAD
#define PITCH_PAD 64
#endif
constexpr int PW = DM + PITCH_PAD, PU = DFF + PITCH_PAD;

constexpr size_t MiB = 1u << 20;
constexpr size_t WS_CTL = 0, CTL_ZERO_BYTES = 1 * MiB;
constexpr size_t WS_WIN = 1 * MiB, WS_WBR = 245 * MiB, WS_WOUT = 365 * MiB, WS_W1 = 495 * MiB, WS_W2 = 1015 * MiB;
constexpr size_t WS_WMK = 1529 * MiB, WS_WMV = 1561 * MiB, WS_MEMN = 1593 * MiB, WS_KM = 1595 * MiB, WS_VMT = 1597 * MiB;
constexpr size_t WS_X = 1599 * MiB, WS_H = 1855 * MiB, WS_Z = 1985 * MiB, WS_GT = 2225 * MiB, WS_U = WS_Z  ;
constexpr size_t WS_OB = 2609 * MiB, WS_Y = 2729 * MiB, WS_DS = 2859 * MiB, WS_SP = 2987 * MiB, WS_DC = 3051 * MiB, WS_CP = 3179 * MiB;
constexpr size_t WS_SMALL = 3243 * MiB, WS_SS = 3245 * MiB, SS_ZERO_BYTES = 2 * MiB, WS_BG = 3247 * MiB, WS_END = 3279 * MiB;
static_assert(PITCH_PAD <= 64, "buffer sizes below assume at most 64 elements of row padding");
static_assert(WS_WIN + (size_t)NL * ZW * PW * 2 <= WS_WBR && WS_WBR + (size_t)NL * DM * OBW * 2 <= WS_WOUT && WS_WOUT + (size_t)NL * DM * PW * 2 <= WS_W1 && WS_W1 + (size_t)NL * DFF * PW * 2 <= WS_W2 && WS_W2 + (size_t)NL * DM * PU * 2 <= WS_WMK, "weight map");
static_assert(WS_H + (size_t)SEQ * PW * 2 <= WS_Z && WS_Y + (size_t)SEQ * PW * 2 <= WS_DS, "activation map");
static_assert(WS_OB + (size_t)SEQ * OBW * 2 <= WS_Y, "OB size");
constexpr size_t SM_DECAY = 0, SM_DN = 512 * 1024, SM_NP = 1024 * 1024, SM_GG = 1536 * 1024, SM_FL = 1536 * 1024 + 4096, SM_MP = 1536 * 1024 + 8192;
static_assert(WS_U + (size_t)SEQ * PU * 2 <= WS_OB, "U overlay");
constexpr int CW_BAR = 4096;
static_assert(9 * (size_t)SEQ * 8 <= SS_ZERO_BYTES, "SS region");
typedef unsigned long long u64_t;
DI float ss_to_f(u64_t v) { return (float)v * (1.0f / 16777216.0f); }

constexpr int LDS_BYTES = 147456;
constexpr int L_ST = 0, L_VT = 69632, L_Q = 106496, L_K = 123904, L_MISC = 141312, L_BARW = 146432;
constexpr int ROW72 = 144, ROW136 = 272, ROW264 = 528;
constexpr int NWAVES = 8;

DI float bf2f(unsigned v) { return __uint_as_float(v << 16); }
DI float bflo(unsigned w) { return __uint_as_float(w << 16); }
DI float bfhi(unsigned w) { return __uint_as_float(w & 0xffff0000u); }
typedef __bf16 bf16x2_t __attribute__((ext_vector_type(2)));
DI unsigned pk2(float lo, float hi) { const f32x2 v = {lo, hi}; const bf16x2_t b = __builtin_convertvector(v, bf16x2_t); return __builtin_bit_cast(unsigned, b); }
DI float sigmoid_f(float x) { return __builtin_amdgcn_rcpf(1.0f + __expf(-x)); }
DI float silu_f(float x) { return x * sigmoid_f(x); }
DI float log_sigmoid_f(float x) { return fminf(x, 0.f) - __logf(1.0f + __expf(-fabsf(x))); }
DI float shx(float v, int o, int lane) { return __int_as_float(__builtin_amdgcn_ds_bpermute((lane ^ o) << 2, __float_as_int(v))); }
DI float shi(float v, int src) { return __int_as_float(__builtin_amdgcn_ds_bpermute(src << 2, __float_as_int(v))); }
DI float wave_sum(float v, int lane) {
#pragma unroll
    for (int o = 1; o < 64; o <<= 1) v += shx(v, o, lane);
    return v;
}
DI float wave_max(float v, int lane) {
#pragma unroll
    for (int o = 1; o < 64; o <<= 1) v = fmaxf(v, shx(v, o, lane));
    return v;
}
DI float wave_scan_sum(float v, int lane) {
#pragma unroll
    for (int o = 1; o < 64; o <<= 1) { const float t = shi(v, lane >= o ? lane - o : lane); if (lane >= o) v += t; }
    return v;
}
DI float wave_scan_max(float v, int lane) {
#pragma unroll
    for (int o = 1; o < 64; o <<= 1) { const float t = shi(v, lane >= o ? lane - o : lane); if (lane >= o) v = fmaxf(v, t); }
    return v;
}
DI f32x4 mfma16(bf16x8 a, bf16x8 b, f32x4 c) { return __builtin_amdgcn_mfma_f32_16x16x32_bf16(a, b, c, 0, 0, 0); }
DI int opaque_tid() { int t = (int)threadIdx.x; asm volatile("" : "+v"(t)); return t; }
DI int opaque_bx() { int b = (int)blockIdx.x; asm volatile("" : "+s"(b)); return b; }
DI LAS unsigned char* opaque_lds(LAS unsigned char* p) { asm volatile("" : "+s"(p)); return p; }
DI int opq(int v) { asm volatile("" : "+s"(v)); return v; }
DI int opaque_g() { int g = (int)gridDim.x; asm volatile("" : "+s"(g)); return g; }

namespace pg8 {
#define PG8_LAS __attribute__((address_space(3)))
constexpr int BM = 256, BK = 64, HALF = 128, HTB = HALF * BK * 2  , STAGE_BYTES = 8 * HTB, NXCD = 8;
#ifndef PG8_WGM
#define PG8_WGM 4
#endif
constexpr int WGM = PG8_WGM;

__host__ __device__ __forceinline__ int lds_byte(int r, int c) { const int st = (r >> 4) * 2 + (c >> 5), rr = r & 15, cc = c & 31, ob = rr * 64 + cc * 2; return st * 1024 + (ob ^ (((ob >> 9) & 1) << 5)); }
__host__ __device__ __forceinline__ void stage_rc(int b, int& R, int& C) { const int st = b / 1024, sb = b % 1024, swz = sb ^ (((sb >> 9) & 1) << 5); R = (st >> 1) * 16 + swz / 64; C = (st & 1) * 32 + (swz % 64) / 2; }
__host__ __device__ __forceinline__ int perm32(int rho) { const int n = rho >> 4, i = rho & 15; return 8 * (i >> 2) + 4 * n + (i & 3); }

struct Unit { int pm, pn, kind; };
struct Gemm { const bf16_t* A; const bf16_t* Bt; int M, N, K, lda, ldb; };

struct StaticOrder {
    int nM, nN, nwg, G, c, wgm;
    __host__ __device__ void init(int M, int N, int G_, int c_, int wgm_ = WGM) { nM = M / BM; nN = N / BM; nwg = nM * nN; G = G_; c = c_; wgm = wgm_; }
    __host__ __device__ bool next(int i, Unit& u) const {
        const long L = (long)i * G + c; if (c < 0 || L >= nwg) return false;
        int wgid = (int)L; { const int q = nwg / NXCD, r = nwg % NXCD, xcd = wgid % NXCD, off = wgid / NXCD; wgid = (xcd < r ? xcd * (q + 1) : r * (q + 1) + (xcd - r) * q) + off; }
        const int nig = wgm * nN, gid = wgid / nig, fm = gid * wgm, gsz = (nM - fm) < wgm ? (nM - fm) : wgm;
        u.pm = fm + ((wgid % nig) % gsz); u.pn = (wgid % nig) / gsz; u.kind = 0; return true;
    }
    __device__ __forceinline__ void a_ready(const Unit&) const {}
    __device__ __forceinline__ void done(const Unit&) const {}
    __device__ __forceinline__ int nt(const Unit&, int nt_default) const { return nt_default; }
    __device__ __forceinline__ int koff(const Unit&) const { return 0; }
};
struct BranchOrder : StaticOrder {
    __host__ __device__ bool next(int i, Unit& u) const { if (!StaticOrder::next(i >> 2, u)) return false; u.kind = i & 3; return true; }
    __device__ __forceinline__ int nt(const Unit& u, int) const { return u.kind < 3 ? 4 : 48; }
    __device__ __forceinline__ int koff(const Unit& u) const { return u.kind < 3 ? 256 * u.kind : 768; }
};

template <int ACT  > struct EpiBf16 {
    static constexpr bool PERM = true, AFTER_DRAIN = false, HOOK = false;
    bf16_t* O; int ldc; const float* bias; const unsigned long long* ss; bf16_t* O2; int ld2, pn2;
    __device__ __forceinline__ void operator()(const f32x4 (&acc)[2][2][4][2], const Unit& u, int wr, int wc, int fr, int fq) const {
        const int row0 = u.pm * BM + wr * 64 + fr, col0 = u.pn * BM + wc * 32 + 8 * fq;
        f32x4 bv[2][2];
#pragma unroll
        for (int bj = 0; bj < 2; ++bj)
#pragma unroll
            for (int n = 0; n < 2; ++n) bv[bj][n] = (ACT == 2) ? *(const f32x4*)(bias + col0 + bj * HALF + 4 * n) : (f32x4){0.f, 0.f, 0.f, 0.f};
#pragma unroll
        for (int ai = 0; ai < 2; ++ai)
#pragma unroll
            for (int m = 0; m < 4; ++m) { bf16_t* rowp = O + (size_t)(row0 + ai * HALF + m * 16) * ldc + col0;
                const bool redir = (ACT == 0) && O2 != nullptr && u.pn == pn2;
                if (redir) rowp = O2 + (size_t)(row0 + ai * HALF + m * 16) * ld2 + (col0 - u.pn * BM);
                float rs = 1.f; if (ACT != 2) { if (ss) rs = 1.0f / sqrtf((float)ss[row0 + ai * HALF + m * 16] * (1.0f / 16777216.0f) * (1.0f / DM) + EPS); }
#pragma unroll
                for (int bj = 0; bj < 2; ++bj) { f32x4 v0 = acc[ai][bj][m][0], v1 = acc[ai][bj][m][1];
                    if (ACT != 2) { v0 = v0 * rs; v1 = v1 * rs; }
                    if (ACT == 1) {
#pragma unroll
                        for (int j = 0; j < 4; ++j) { const float a = fmaxf(v0[j], 0.f), b = fmaxf(v1[j], 0.f); v0[j] = a * a; v1[j] = b * b; } }
                    if (ACT == 2) { v0 = v0 + bv[bj][0]; v1 = v1 + bv[bj][1];
#pragma unroll
                        for (int j = 0; j < 4; ++j) { v0[j] = sigmoid_f(fminf(fmaxf(v0[j], -30.f), 30.f)); v1[j] = sigmoid_f(fminf(fmaxf(v1[j], -30.f), 30.f)); } }
                    u32x4 w; w.x = pk2(v0[0], v0[1]); w.y = pk2(v0[2], v0[3]); w.z = pk2(v1[0], v1[1]); w.w = pk2(v1[2], v1[3]);
                    *(u32x4*)(rowp + bj * HALF) = w;
                    if (redir) { *(u32x4*)(rowp + bj * HALF + 256) = w; *(u32x4*)(rowp + bj * HALF + 512) = w; } } }
    }
    __device__ __forceinline__ bool hook_at(const Unit&, int) const { return false; }
    __device__ __forceinline__ void hook(f32x4 (&)[2][2][4][2], const Unit&, int, int, int, int, int) const {}
};
struct EpiResid {
    static constexpr bool PERM = true, AFTER_DRAIN = false, HOOK = false;
    const float* in; float* out; int ldc; bf16_t* xb; unsigned long long* ss; int ldxb;
    __device__ __forceinline__ void operator()(const f32x4 (&acc)[2][2][4][2], const Unit& u, int wr, int wc, int fr, int fq) const {
        const int row0 = u.pm * BM + wr * 64 + fr, col0 = u.pn * BM + wc * 32 + 8 * fq, lane = fq * 16 + fr;
#pragma unroll
        for (int ai = 0; ai < 2; ++ai) {
            f32x4 r[4][2][2];
#pragma unroll
            for (int m = 0; m < 4; ++m) { const size_t off = (size_t)(row0 + ai * HALF + m * 16) * ldc + col0;
#pragma unroll
                for (int bj = 0; bj < 2; ++bj)
#pragma unroll
                    for (int n = 0; n < 2; ++n) r[m][bj][n] = *(const f32x4*)(in + off + bj * HALF + n * 4); }
#pragma unroll
            for (int m = 0; m < 4; ++m) { const int row = row0 + ai * HALF + m * 16; const size_t off = (size_t)row * ldc + col0;
                float sq = 0.f;
#pragma unroll
                for (int bj = 0; bj < 2; ++bj) { const f32x4 o0 = r[m][bj][0] + acc[ai][bj][m][0], o1 = r[m][bj][1] + acc[ai][bj][m][1];
                    *(f32x4*)(out + off + bj * HALF) = o0; *(f32x4*)(out + off + bj * HALF + 4) = o1;
                    sq += (o0[0] * o0[0] + o0[1] * o0[1]) + (o0[2] * o0[2] + o0[3] * o0[3]) + (o1[0] * o1[0] + o1[1] * o1[1]) + (o1[2] * o1[2] + o1[3] * o1[3]);
                    u32x4 w; w.x = pk2(o0[0], o0[1]); w.y = pk2(o0[2], o0[3]); w.z = pk2(o1[0], o1[1]); w.w = pk2(o1[2], o1[3]);
                    *(u32x4*)(xb + (size_t)row * ldxb + col0 + bj * HALF) = w; }
                sq += shx(sq, 16, lane); sq += shx(sq, 32, lane);
                if (fq == 0) (void)__hip_atomic_fetch_add(ss + row, (unsigned long long)(sq * 16777216.0f), __ATOMIC_RELAXED, __HIP_MEMORY_SCOPE_AGENT); }
            asm volatile("" ::: "memory"); }
    }
    __device__ __forceinline__ bool hook_at(const Unit&, int) const { return false; }
    __device__ __forceinline__ void hook(f32x4 (&)[2][2][4][2], const Unit&, int, int, int, int, int) const {}
};
struct EpiBranch {
    static constexpr bool PERM = true, AFTER_DRAIN = false, HOOK = true;
    bf16_t* O; int ldc; bf16_t* GT; const float* bias;
    __device__ __forceinline__ bool hook_at(const Unit& u, int t) const { return u.kind == 3 && (t == 16 || t == 32); }
    __device__ __forceinline__ void hook(f32x4 (&acc)[2][2][4][2], const Unit& u, int t, int, int, int, int) const {
        const int tid_ = opaque_tid(), wid_ = tid_ >> 6, wr = wid_ >> 2, wc = wid_ & 3, fr = tid_ & 15, fq = (tid_ >> 4) & 3;
        const int row0 = u.pm * BM + wr * 64 + fr, col0 = u.pn * BM + wc * 32 + 8 * fq;
        const bf16_t* ga = GT + (size_t)(t == 16 ? 0 : DM); const bf16_t* gb = ga + DM;
#pragma unroll
        for (int ai = 0; ai < 2; ++ai) {
            u32x4 a[4][2], b[4][2];
#pragma unroll
            for (int m = 0; m < 4; ++m) { const size_t off = (size_t)(row0 + ai * HALF + m * 16) * GTW + col0;
#pragma unroll
                for (int bj = 0; bj < 2; ++bj) { a[m][bj] = *(const u32x4*)(ga + off + bj * HALF); b[m][bj] = *(const u32x4*)(gb + off + bj * HALF); } }
#pragma unroll
            for (int m = 0; m < 4; ++m)
#pragma unroll
                for (int bj = 0; bj < 2; ++bj) { const u32x4 x = a[m][bj], y = b[m][bj];
                    f32x4 r0, r1;
                    r0[0] = bflo(y.x) * __builtin_amdgcn_rcpf(bflo(x.x)); r0[1] = bfhi(y.x) * __builtin_amdgcn_rcpf(bfhi(x.x));
                    r0[2] = bflo(y.y) * __builtin_amdgcn_rcpf(bflo(x.y)); r0[3] = bfhi(y.y) * __builtin_amdgcn_rcpf(bfhi(x.y));
                    r1[0] = bflo(y.z) * __builtin_amdgcn_rcpf(bflo(x.z)); r1[1] = bfhi(y.z) * __builtin_amdgcn_rcpf(bfhi(x.z));
                    r1[2] = bflo(y.w) * __builtin_amdgcn_rcpf(bflo(x.w)); r1[3] = bfhi(y.w) * __builtin_amdgcn_rcpf(bfhi(x.w));
                    acc[ai][bj][m][0] = acc[ai][bj][m][0] * r0; acc[ai][bj][m][1] = acc[ai][bj][m][1] * r1; }
            asm volatile("" ::: "memory"); }
    }
    __device__ __forceinline__ void operator()(const f32x4 (&acc)[2][2][4][2], const Unit& u, int wr, int wc, int fr, int fq) const {
        const int row0 = u.pm * BM + wr * 64 + fr, col0 = u.pn * BM + wc * 32 + 8 * fq;
        if (u.kind < 3) {
            bf16_t* gd = GT + (size_t)u.kind * DM; const float* bj_ = bias + (size_t)u.kind * DM + col0;
            f32x4 bv[2][2];
#pragma unroll
            for (int bj = 0; bj < 2; ++bj)
#pragma unroll
                for (int n = 0; n < 2; ++n) bv[bj][n] = *(const f32x4*)(bj_ + bj * HALF + 4 * n);
#pragma unroll
            for (int ai = 0; ai < 2; ++ai)
#pragma unroll
                for (int m = 0; m < 4; ++m) { const size_t off = (size_t)(row0 + ai * HALF + m * 16) * GTW + col0;
#pragma unroll
                    for (int bj = 0; bj < 2; ++bj) { f32x4 v0 = acc[ai][bj][m][0] + bv[bj][0], v1 = acc[ai][bj][m][1] + bv[bj][1];
#pragma unroll
                        for (int e = 0; e < 4; ++e) { v0[e] = 1.0f + __expf(-fminf(fmaxf(v0[e], -30.f), 30.f)); v1[e] = 1.0f + __expf(-fminf(fmaxf(v1[e], -30.f), 30.f)); }
                        u32x4 w; w.x = pk2(v0[0], v0[1]); w.y = pk2(v0[2], v0[3]); w.z = pk2(v1[0], v1[1]); w.w = pk2(v1[2], v1[3]);
                        *(u32x4*)(gd + off + bj * HALF) = w; } }
        } else {
            const bf16_t* gc = GT + 2 * DM;
            u32x4 g[2][4][2];
#pragma unroll
            for (int ai = 0; ai < 2; ++ai)
#pragma unroll
                for (int m = 0; m < 4; ++m)
#pragma unroll
                    for (int bj = 0; bj < 2; ++bj) g[ai][m][bj] = *(const u32x4*)(gc + (size_t)(row0 + ai * HALF + m * 16) * GTW + col0 + bj * HALF);
#pragma unroll
            for (int ai = 0; ai < 2; ++ai)
#pragma unroll
                for (int m = 0; m < 4; ++m) { const size_t r = (size_t)(row0 + ai * HALF + m * 16);
#pragma unroll
                    for (int bj = 0; bj < 2; ++bj) { const u32x4 gg = g[ai][m][bj];
                        const f32x4 v0 = acc[ai][bj][m][0], v1 = acc[ai][bj][m][1];
                        u32x4 w; w.x = pk2(v0[0] * __builtin_amdgcn_rcpf(bflo(gg.x)), v0[1] * __builtin_amdgcn_rcpf(bfhi(gg.x))); w.y = pk2(v0[2] * __builtin_amdgcn_rcpf(bflo(gg.y)), v0[3] * __builtin_amdgcn_rcpf(bfhi(gg.y)));
                        w.z = pk2(v1[0] * __builtin_amdgcn_rcpf(bflo(gg.z)), v1[1] * __builtin_amdgcn_rcpf(bfhi(gg.z))); w.w = pk2(v1[2] * __builtin_amdgcn_rcpf(bflo(gg.w)), v1[3] * __builtin_amdgcn_rcpf(bfhi(gg.w)));
                        *(u32x4*)(O + r * ldc + col0 + bj * HALF) = w; } }
        }
    }
};

template <class Epi, class Sched, bool ALIGN_EPI = false, bool SP2 = false>
__device__ __forceinline__ void gemm_phase(PG8_LAS unsigned char* lds, const Gemm g, const Sched& S, const Epi& E) {
    const int tid = opaque_tid(), wid = __builtin_amdgcn_readfirstlane(tid >> 6), lane = tid & 63, wr = wid >> 2, wc = wid & 3, fr = lane & 15, fq = lane >> 4;
    const int K = g.K, nt_default = K / BK;
    unsigned voffA[2], voffB[2];
#pragma unroll
    for (int i = 0; i < 2; ++i) { int R, C; stage_rc(tid * 16 + i * 8192, R, C); const int Rb = Epi::PERM ? ((R & ~31) + perm32(R & 31)) : R;
        voffA[i] = (unsigned)(R * g.lda + C) * 2u; voffB[i] = (unsigned)(Rb * g.ldb + C) * 2u; }
    const unsigned kstep = (unsigned)(BK * 2);
    const unsigned hstepA = (unsigned)HALF * g.lda * 2, hstepB = (unsigned)HALF * g.ldb * 2;
    const unsigned tstepA = 2 * hstepA, tstepB = 2 * hstepB;
    const __amdgpu_buffer_rsrc_t rA = __builtin_amdgcn_make_buffer_rsrc((void*)g.A, 0, (int)0xffffffffu, 0x00020000), rB = __builtin_amdgcn_make_buffer_rsrc((void*)g.Bt, 0, (int)0xffffffffu, 0x00020000);
    const unsigned ldsw = (unsigned)wid * 1024u;
    const int aoff = lds_byte(wr * 64 + fr, fq * 8), boff = lds_byte(wc * 32 + fr, fq * 8);
#define PG8_SA(b, h) (((b) * 2 + (h)) * HTB)
#define PG8_SB(b, h) ((4 + (b) * 2 + (h)) * HTB)
#define PG8_STAGE(bufoff, gbase, voff) do { _Pragma("unroll") for (int _i = 0; _i < 2; ++_i) \
        __builtin_amdgcn_raw_ptr_buffer_load_lds(PG8_RSRC_##voff, (PG8_LAS void*)(lds + (bufoff) + ldsw + _i * 8192), 16, (int)(voff)[_i], (int)(gbase), 0, 0); } while (0)
#define PG8_STAGE1(bufoff, gbase, voff, _i) __builtin_amdgcn_raw_ptr_buffer_load_lds(PG8_RSRC_##voff, (PG8_LAS void*)(lds + (bufoff) + ldsw + (_i) * 8192), 16, (int)(voff)[_i], (int)(gbase), 0, 0)
#define PG8_LDA2(dst, b, h, m0) do { _Pragma("unroll") for (int m = (m0); m < (m0) + 2; ++m) _Pragma("unroll") for (int k = 0; k < 2; ++k) dst[m][k] = *(const PG8_LAS bf16x8*)(lds + PG8_SA(b, h) + aoff + m * 2048 + k * 1024); } while (0)
#define PG8_RSRC_voffA rA
#define PG8_RSRC_voffB rB
#define PG8_LDA(dst, b, h) do { _Pragma("unroll") for (int m = 0; m < 4; ++m) _Pragma("unroll") for (int k = 0; k < 2; ++k) dst[m][k] = *(const PG8_LAS bf16x8*)(lds + PG8_SA(b, h) + aoff + m * 2048 + k * 1024); } while (0)
#define PG8_LDB(dst, b, h) do { _Pragma("unroll") for (int n = 0; n < 2; ++n) _Pragma("unroll") for (int k = 0; k < 2; ++k) dst[n][k] = *(const PG8_LAS bf16x8*)(lds + PG8_SB(b, h) + boff + n * 2048 + k * 1024); } while (0)
#ifndef PG8_PRIO
#define PG8_PRIO 1
#endif
#define PG8_MMA(ai, bj, At, Bt) do { if (PG8_PRIO) __builtin_amdgcn_s_setprio(PG8_PRIO); _Pragma("unroll") for (int m = 0; m < 4; ++m) _Pragma("unroll") for (int n = 0; n < 2; ++n) _Pragma("unroll") for (int k = 0; k < 2; ++k) \
        acc[ai][bj][m][n] = __builtin_amdgcn_mfma_f32_16x16x32_bf16(Bt[n][k], At[m][k], acc[ai][bj][m][n], 0, 0, 0); if (PG8_PRIO) __builtin_amdgcn_s_setprio(0); } while (0)
#define PG8_WAIT_V(n) asm volatile("s_waitcnt vmcnt(" #n ")" ::: "memory")
#define PG8_WAIT_L(n) asm volatile("s_waitcnt lgkmcnt(" #n ")" ::: "memory")
#define PG8_BAR __builtin_amdgcn_s_barrier()
#define PG8_SCHED __builtin_amdgcn_sched_barrier(0)
    Unit cur, nxt; int ui = 0;
    if (!S.next(0, cur)) return;
    f32x4 acc[2][2][4][2];
#pragma unroll
    for (int a = 0; a < 2; ++a)
#pragma unroll
        for (int b = 0; b < 2; ++b)
#pragma unroll
            for (int m = 0; m < 4; ++m)
#pragma unroll
                for (int n = 0; n < 2; ++n) acc[a][b][m][n] = (f32x4){0.f, 0.f, 0.f, 0.f};
    bf16x8 At[4][2], B0[2][2], B1[2][2];
    bf16x8 B0n[2][2];
    unsigned cA = (unsigned)cur.pm * tstepA + (unsigned)S.koff(cur) * 2u, cB = (unsigned)cur.pn * tstepB + (unsigned)S.koff(cur) * 2u;
    int nt = S.nt(cur, nt_default);
    S.a_ready(cur);
    if constexpr (SP2) {
        PG8_STAGE(PG8_SB(0, 0), cB, voffB); PG8_STAGE(PG8_SB(0, 1), cB + hstepB, voffB); PG8_STAGE(PG8_SA(0, 0), cA, voffA); PG8_STAGE(PG8_SA(0, 1), cA + hstepA, voffA);
        if (wr == 1) PG8_BAR;
        PG8_WAIT_V(2); PG8_BAR;
        PG8_STAGE(PG8_SB(1, 0), cB + kstep, voffB); PG8_STAGE(PG8_SB(1, 1), cB + hstepB + kstep, voffB);
        PG8_WAIT_V(4); PG8_BAR;
        PG8_LDB(B0, 0, 0);
    } else {
        PG8_STAGE(PG8_SB(0, 0), cB, voffB); PG8_STAGE(PG8_SA(0, 0), cA, voffA); PG8_STAGE(PG8_SB(0, 1), cB + hstepB, voffB); PG8_STAGE(PG8_SA(0, 1), cA + hstepA, voffA);
        if (wr == 1) PG8_BAR;
        PG8_WAIT_V(4); PG8_BAR;
        PG8_STAGE(PG8_SB(1, 0), cB + kstep, voffB); PG8_STAGE(PG8_SA(1, 0), cA + kstep, voffA); PG8_STAGE(PG8_SB(1, 1), cB + hstepB + kstep, voffB);
        PG8_WAIT_V(6); PG8_BAR;
    }
    for (;;) {
        const bool has_next = S.next(ui + 1, nxt);
        const unsigned nA = has_next ? (unsigned)nxt.pm * tstepA + (unsigned)S.koff(nxt) * 2u : cA, nB = has_next ? (unsigned)nxt.pn * tstepB + (unsigned)S.koff(nxt) * 2u : cB;
        for (int t = 0; t < nt; t += 2) {
            const bool last = (t == nt - 2);
            if constexpr (Epi::HOOK) { if (E.hook_at(cur, t)) E.hook(acc, cur, t, wr, wc, fr, fq); }
            const unsigned a1 = cA + (unsigned)(t + 1) * kstep;
            const unsigned a2 = last ? nA : cA + (unsigned)(t + 2) * kstep, b2 = last ? nB : cB + (unsigned)(t + 2) * kstep;
            const unsigned a3 = a2 + kstep, b3 = b2 + kstep;
            if (last && has_next) S.a_ready(nxt);
            if constexpr (SP2) {
            PG8_LDB(B1, 0, 1); PG8_SCHED; PG8_STAGE1(PG8_SA(1, 0), a1, voffA, 0); PG8_SCHED; PG8_LDA2(At, 0, 0, 0); PG8_SCHED; PG8_STAGE1(PG8_SA(1, 0), a1, voffA, 1); PG8_SCHED; PG8_LDA2(At, 0, 0, 2); PG8_SCHED; PG8_STAGE(PG8_SA(1, 1), a1 + hstepA, voffA);
            PG8_WAIT_V(6); PG8_WAIT_L(0); PG8_BAR; PG8_MMA(0, 0, At, B0); PG8_MMA(0, 1, At, B1); PG8_BAR; PG8_SCHED;
            PG8_LDB(B0n, 1, 0); PG8_SCHED; PG8_STAGE1(PG8_SB(0, 0), b2, voffB, 0); PG8_SCHED; PG8_LDA2(At, 0, 1, 0); PG8_SCHED; PG8_STAGE1(PG8_SB(0, 0), b2, voffB, 1); PG8_SCHED; PG8_LDA2(At, 0, 1, 2); PG8_SCHED; PG8_STAGE(PG8_SB(0, 1), b2 + hstepB, voffB);
            PG8_WAIT_V(6); PG8_WAIT_L(0); PG8_BAR; PG8_MMA(1, 0, At, B0); PG8_MMA(1, 1, At, B1); PG8_BAR; PG8_SCHED;
            PG8_LDB(B1, 1, 1); PG8_SCHED; PG8_STAGE1(PG8_SA(0, 0), a2, voffA, 0); PG8_SCHED; PG8_LDA2(At, 1, 0, 0); PG8_SCHED; PG8_STAGE1(PG8_SA(0, 0), a2, voffA, 1); PG8_SCHED; PG8_LDA2(At, 1, 0, 2); PG8_SCHED; PG8_STAGE(PG8_SA(0, 1), a2 + hstepA, voffA);
            PG8_WAIT_V(6); PG8_WAIT_L(0); PG8_BAR; PG8_MMA(0, 0, At, B0n); PG8_MMA(0, 1, At, B1); PG8_BAR; PG8_SCHED;
            PG8_LDB(B0, 0, 0); PG8_SCHED; PG8_STAGE1(PG8_SB(1, 0), b3, voffB, 0); PG8_SCHED; PG8_LDA2(At, 1, 1, 0); PG8_SCHED; PG8_STAGE1(PG8_SB(1, 0), b3, voffB, 1); PG8_SCHED; PG8_LDA2(At, 1, 1, 2); PG8_SCHED; PG8_STAGE(PG8_SB(1, 1), b3 + hstepB, voffB);
            PG8_WAIT_V(6); PG8_WAIT_L(0); PG8_BAR; PG8_MMA(1, 0, At, B0n); PG8_MMA(1, 1, At, B1); PG8_BAR; PG8_SCHED;
            (void)a3;
            } else {
            PG8_LDB(B0, 0, 0); PG8_SCHED; PG8_LDA(At, 0, 0); PG8_STAGE(PG8_SA(1, 1), a1 + hstepA, voffA);
            PG8_WAIT_L(8); PG8_BAR; PG8_WAIT_L(0); PG8_MMA(0, 0, At, B0); PG8_BAR; PG8_SCHED;
            PG8_LDB(B1, 0, 1); PG8_STAGE(PG8_SB(0, 0), b2, voffB);
            PG8_BAR; PG8_WAIT_L(0); PG8_MMA(0, 1, At, B1); PG8_BAR;
            PG8_LDA(At, 0, 1); PG8_STAGE(PG8_SA(0, 0), a2, voffA);
            PG8_BAR; PG8_WAIT_L(0); PG8_MMA(1, 0, At, B0); PG8_BAR; PG8_SCHED;
            PG8_STAGE(PG8_SB(0, 1), b2 + hstepB, voffB);
            PG8_WAIT_V(6); PG8_BAR; PG8_MMA(1, 1, At, B1); PG8_BAR;
            PG8_LDB(B0, 1, 0); PG8_SCHED; PG8_LDA(At, 1, 0); PG8_STAGE(PG8_SA(0, 1), a2 + hstepA, voffA);
            PG8_WAIT_L(8); PG8_BAR; PG8_WAIT_L(0); PG8_MMA(0, 0, At, B0); PG8_BAR; PG8_SCHED;
            PG8_LDB(B1, 1, 1); PG8_STAGE(PG8_SB(1, 0), b3, voffB);
            PG8_BAR; PG8_WAIT_L(0); PG8_MMA(0, 1, At, B1); PG8_BAR;
            PG8_LDA(At, 1, 1); PG8_STAGE(PG8_SA(1, 0), a3, voffA);
            PG8_BAR; PG8_WAIT_L(0); PG8_MMA(1, 0, At, B0); PG8_BAR; PG8_SCHED;
            PG8_STAGE(PG8_SB(1, 1), b3 + hstepB, voffB);
            PG8_WAIT_V(6); PG8_BAR; PG8_MMA(1, 1, At, B1); PG8_BAR;
            }
        }
        if constexpr (ALIGN_EPI) { if (wr == 0) PG8_BAR; }
        E(acc, cur, wr, wc, fr, fq); S.done(cur);
        if (!has_next) break;
#pragma unroll
        for (int a = 0; a < 2; ++a)
#pragma unroll
            for (int b = 0; b < 2; ++b)
#pragma unroll
                for (int m = 0; m < 4; ++m)
#pragma unroll
                    for (int n = 0; n < 2; ++n) acc[a][b][m][n] = (f32x4){0.f, 0.f, 0.f, 0.f};
        cur = nxt; cA = nA; cB = nB; ++ui; nt = S.nt(cur, nt_default);
        if constexpr (ALIGN_EPI) { if (wr == 1) PG8_BAR; }
    }
    PG8_WAIT_V(0);
    if constexpr (!ALIGN_EPI) { if (wr == 0) PG8_BAR; }
    PG8_BAR;
#undef PG8_SA
#undef PG8_SB
#undef PG8_STAGE
#undef PG8_RSRC_voffA
#undef PG8_STAGE1
#undef PG8_LDA2
#undef PG8_RSRC_voffB
#undef PG8_LDA
#undef PG8_LDB
#undef PG8_MMA
#undef PG8_WAIT_V
#undef PG8_WAIT_L
#undef PG8_BAR
#undef PG8_SCHED
}
}

#define XB_TMO      128
#define XB_XCNT(j)  (256  + 64 * (j))
#define XB_XSUB(j)  (1280 + 64 * (j))
#define XB_XGEN(j)  (2304 + 64 * (j))
#define XB_TOP      3328
#define XB_TOPGEN   3392
#define XCD_BAR_WORDS 3456
#define XB_SPIN_CAP (1u << 18)

__device__ __forceinline__ unsigned xb_ld(unsigned* p)              { return __hip_atomic_load(p, __ATOMIC_RELAXED, __HIP_MEMORY_SCOPE_AGENT); }
__device__ __forceinline__ unsigned xb_add(unsigned* p, unsigned v) { return __hip_atomic_fetch_add(p, v, __ATOMIC_RELAXED, __HIP_MEMORY_SCOPE_AGENT); }
__device__ __forceinline__ unsigned xb_xcc_id() { return (unsigned)__builtin_amdgcn_s_getreg((3 << 11) | 20) & 0xFu; }
#define XB_SPIN(cond, bar) do { unsigned _sp = 0; while (cond) { __builtin_amdgcn_s_sleep(1); \
    if ((++_sp & 255u) == 0u) { if (xb_ld(&(bar)[XB_TMO])) break; if (_sp > XB_SPIN_CAP) { atomicAdd(&(bar)[XB_TMO], 1u); break; } } } } while (0)

struct XcdBarrier {
    unsigned* bar; unsigned x;
    volatile LAS unsigned* st;
};
__device__ __forceinline__ XcdBarrier xcd_barrier_post(unsigned* bar, volatile LAS unsigned* st) {
    XcdBarrier b; b.bar = bar; b.x = xb_xcc_id(); b.st = st;
    if (threadIdx.x == 0) (void)xb_add(&bar[XB_XCNT(b.x)], 1u);
    return b;
}
__device__ __forceinline__ void xcd_barrier_complete(unsigned* bar, unsigned x, unsigned& nloc, unsigned& nx) {
    const unsigned G = gridDim.x * gridDim.y * gridDim.z;
    unsigned sum, cnt, mine, sp = 0u;
    for (;;) {
        sum = 0u; cnt = 0u; mine = 0u;
#pragma unroll
        for (unsigned j = 0; j < 16; ++j) { const unsigned c = xb_ld(&bar[XB_XCNT(j)]); sum += c; cnt += (c > 0u) ? 1u : 0u; mine = (j == x) ? c : mine; }
        if (sum == G) break;
        __builtin_amdgcn_s_sleep(1);
        if ((++sp & 255u) == 0u) { if (xb_ld(&bar[XB_TMO])) break; if (sp > XB_SPIN_CAP) { atomicAdd(&bar[XB_TMO], 1u); break; } }
    }
    nloc = mine > 0u ? mine : 1u; nx = cnt > 0u ? cnt : 1u;
}
__device__ __forceinline__ void xcd_barrier(const XcdBarrier& b) {
    asm volatile("s_waitcnt vmcnt(0)" ::: "memory");
    __syncthreads();
    if (threadIdx.x == 0) {
        unsigned* bar = b.bar;
        __builtin_amdgcn_s_waitcnt(0);
        unsigned nloc = b.st[0], nx = b.st[1];
        if (nloc == 0u) { xcd_barrier_complete(bar, b.x, nloc, nx); b.st[0] = nloc; b.st[1] = nx; }
        const unsigned old = xb_add(&bar[XB_XSUB(b.x)], 1u);
        const unsigned gen = old / nloc;
        if (old + 1u == (gen + 1u) * nloc) {
            __builtin_amdgcn_fence(__ATOMIC_RELEASE, "agent");
            asm volatile("s_waitcnt vmcnt(0)" ::: "memory");
            const unsigned og = xb_add(&bar[XB_TOP], 1u);
            const unsigned tg = og / nx;
            if (og + 1u == (tg + 1u) * nx) xb_add(&bar[XB_TOPGEN], 1u);
            else XB_SPIN(xb_ld(&bar[XB_TOPGEN]) == tg, bar);
            __builtin_amdgcn_fence(__ATOMIC_ACQUIRE, "agent");
            xb_add(&bar[XB_XGEN(b.x)], 1u);
            asm volatile("s_waitcnt vmcnt(0)" ::: "memory");
        } else {
            XB_SPIN(xb_ld(&bar[XB_XGEN(b.x)]) == gen, bar);
            __builtin_amdgcn_fence(__ATOMIC_ACQUIRE, "agent");
            asm volatile("s_waitcnt vmcnt(0)" ::: "memory");
        }
    }
    __syncthreads();
}

struct Params { const float* in[23]; float* out; unsigned char* ws; };
enum { I_X = 0, I_MEM, I_NORM_MIX, I_W_IN, I_W_GLA_A, I_B_GLA_A, I_GLA_NORM, I_CONV_W, I_CONV_B, I_B_ML_I, I_B_ML_F, I_ML_NORM, I_MEM_NORM, I_W_MEM_K, I_W_MEM_V, I_W_BRANCH, I_W_GATE, I_B_GATE, I_W_OUT, I_NORM_FFN, I_W_FF1, I_W_FF2, I_FINAL_NORM };

DI int win_row(int n) {
    if (n < 3072) return n;
    if (n < 3088) return ZC_GA + (n - 3072);
    if (n < 6160) return n - 16;
    if (n < 6168) return ZC_MI + (n - 6160);
    return n - 24;
}
DI void transpose_item(const float* __restrict__ W, int K, int N, bf16_t* __restrict__ WT, int ld_dst, int col_off, int row_off, bool remap, LAS float* scr, int item, int lane, const float* __restrict__ gain = nullptr) {
    const int nblk = (N + 63) >> 6, kb = item / nblk, nb = item - kb * nblk, k0 = kb << 6, n0 = nb << 6;
    const int a = lane & 15, q = lane >> 4, n4 = 4 * a;
    const bool ok = (n0 + n4) < N;
    f32x4 v[16];
#pragma unroll
    for (int i = 0; i < 16; ++i) { const int kk = 4 * i + q; v[i] = ok ? *(const f32x4*)(W + (size_t)(k0 + kk) * N + n0 + n4) : (f32x4){0.f, 0.f, 0.f, 0.f}; }
#pragma unroll
    for (int i = 0; i < 16; ++i) { const int kk = 4 * i + q;
#pragma unroll
        for (int e = 0; e < 4; ++e) scr[(n4 + e) * 65 + kk] = v[i][e]; }
    asm volatile("s_waitcnt lgkmcnt(0)" ::: "memory");
    const int c = lane & 7;
    f32x4 g0 = (f32x4){1.f, 1.f, 1.f, 1.f}, g1 = g0;
    if (gain) { g0 = *(const f32x4*)(gain + k0 + 8 * c); g1 = *(const f32x4*)(gain + k0 + 8 * c + 4); }
#pragma unroll
    for (int jj = 0; jj < 8; ++jj) { const int n = (lane >> 3) + 8 * jj; const LAS float* s = scr + n * 65 + 8 * c;
        u32x4 o; o.x = pk2(s[0] * g0[0], s[1] * g0[1]); o.y = pk2(s[2] * g0[2], s[3] * g0[3]); o.z = pk2(s[4] * g1[0], s[5] * g1[1]); o.w = pk2(s[6] * g1[2], s[7] * g1[3]);
        const int ng = n0 + n;
        if (ng < N) { const int row = row_off + (remap ? win_row(ng) : ng); *(u32x4*)(WT + (size_t)row * ld_dst + col_off + k0 + 8 * c) = o; } }
    asm volatile("s_waitcnt lgkmcnt(0)" ::: "memory");
}

template <bool OUT_F32> DI void rmsnorm_row(const float* __restrict__ xrow, const float* __restrict__ g, void* orow, int lane) {
    const f32x4* xr = (const f32x4*)xrow + lane; const f32x4* gr = (const f32x4*)g + lane;
    f32x4 v[16]; float s = 0.f;
#pragma unroll
    for (int j = 0; j < 16; ++j) { v[j] = xr[64 * j]; s += (v[j].x * v[j].x + v[j].y * v[j].y) + (v[j].z * v[j].z + v[j].w * v[j].w); }
    const float rstd = 1.0f / sqrtf(wave_sum(s, lane) * (1.0f / DM) + EPS);
#pragma unroll
    for (int j = 0; j < 16; ++j) { const f32x4 gg = gr[64 * j]; const f32x4 o = v[j] * rstd * gg;
        if (OUT_F32) ((f32x4*)orow)[lane + 64 * j] = o;
        else { u32x2 w; w.x = pk2(o.x, o.y); w.y = pk2(o.z, o.w); ((u32x2*)orow)[lane + 64 * j] = w; } }
}

DI void row_bf16_ss(const float* __restrict__ xrow, bf16_t* orow, unsigned long long* ss, int lane) {
    const f32x4* xr = (const f32x4*)xrow + lane; float s = 0.f;
#pragma unroll
    for (int j = 0; j < 16; ++j) { const f32x4 v = xr[64 * j]; s += (v.x * v.x + v.y * v.y) + (v.z * v.z + v.w * v.w);
        u32x2 w; w.x = pk2(v.x, v.y); w.y = pk2(v.z, v.w); ((u32x2*)orow)[lane + 64 * j] = w; }
    s = wave_sum(s, lane);
    if (lane == 0) *ss = (unsigned long long)(s * 16777216.0f);
}
DI void row_scale_f32(const float* __restrict__ xrow, const float* __restrict__ g, float ssv, float* orow, int lane) {
    const f32x4* xr = (const f32x4*)xrow + lane; const f32x4* gr = (const f32x4*)g + lane;
    const float rstd = 1.0f / sqrtf(ssv * (1.0f / DM) + EPS);
#pragma unroll
    for (int j = 0; j < 16; ++j) ((f32x4*)orow)[lane + 64 * j] = xr[64 * j] * rstd * gr[64 * j];
}

DI void fill_vT(const bf16_t* __restrict__ Zv, int n, int tg, int lane, LAS unsigned char* VT) {
#pragma unroll
    for (int i = 0; i < 2; ++i) { const int cp = lane + 64 * i; unsigned w[8];
#pragma unroll
        for (int j = 0; j < 8; ++j) w[j] = *(const unsigned*)(Zv + (size_t)(n * CH + 8 * tg + j) * ZW + 2 * cp);
        u32x4 lo, hi;
        lo.x = (w[0] & 0xffffu) | (w[1] << 16); lo.y = (w[2] & 0xffffu) | (w[3] << 16); lo.z = (w[4] & 0xffffu) | (w[5] << 16); lo.w = (w[6] & 0xffffu) | (w[7] << 16);
        hi.x = (w[0] >> 16) | (w[1] & 0xffff0000u); hi.y = (w[2] >> 16) | (w[3] & 0xffff0000u); hi.z = (w[4] >> 16) | (w[5] & 0xffff0000u); hi.w = (w[6] >> 16) | (w[7] & 0xffff0000u);
        *(LAS u32x4*)(VT + (2 * cp) * ROW72 + tg * 16) = lo; *(LAS u32x4*)(VT + (2 * cp + 1) * ROW72 + tg * 16) = hi; }
}
DI void state_mfma(const LAS unsigned char* VT, const LAS unsigned char* KT, bf16_t* __restrict__ OUT, int w, int lane) {
    const int fr = lane & 15, fq = lane >> 4;
    f32x4 acc[2][8];
#pragma unroll
    for (int mi = 0; mi < 2; ++mi)
#pragma unroll
        for (int ni = 0; ni < 8; ++ni) acc[mi][ni] = (f32x4){0.f, 0.f, 0.f, 0.f};
#pragma unroll
    for (int ks = 0; ks < 2; ++ks) {
        bf16x8 a[2];
#pragma unroll
        for (int mi = 0; mi < 2; ++mi) a[mi] = *(const LAS bf16x8*)(VT + (32 * w + 16 * mi + fr) * ROW72 + (32 * ks + 8 * fq) * 2);
#pragma unroll
        for (int ni = 0; ni < 8; ++ni) { const bf16x8 b = *(const LAS bf16x8*)(KT + (16 * ni + fr) * ROW72 + (32 * ks + 8 * fq) * 2);
#pragma unroll
            for (int mi = 0; mi < 2; ++mi) acc[mi][ni] = mfma16(b, a[mi], acc[mi][ni]); }
    }
#pragma unroll
    for (int mi = 0; mi < 2; ++mi)
#pragma unroll
        for (int ni = 0; ni < 8; ++ni) *(u32x2*)(OUT + (size_t)(32 * w + 16 * mi + fr) * 128 + 16 * ni + 4 * fq) = (u32x2){pk2(acc[mi][ni][0], acc[mi][ni][1]), pk2(acc[mi][ni][2], acc[mi][ni][3])};
}
DI void copy_256x128(const bf16_t* __restrict__ src, int gp, LAS unsigned char* dst, int tid) {
#pragma unroll
    for (int i = 0; i < 8; ++i) { const int id = tid + 512 * i, row = id >> 4, cc = id & 15;
        *(LAS u32x4*)(dst + row * ROW136 + cc * 16) = *(const u32x4*)(src + (size_t)row * gp + cc * 8); }
}

DI void ld_v(const bf16_t* __restrict__ Zv, int n, int tg, int lane, unsigned (&w)[2][8]) {
#pragma unroll
    for (int i = 0; i < 2; ++i)
#pragma unroll
        for (int j = 0; j < 8; ++j) w[i][j] = *(const unsigned*)(Zv + (size_t)(n * CH + 8 * tg + j) * ZW + 2 * (lane + 64 * i));
}
DI void st_vT(const unsigned (&w)[2][8], int tg, int lane, LAS unsigned char* VT) {
#pragma unroll
    for (int i = 0; i < 2; ++i) { const int cp = lane + 64 * i; u32x4 lo, hi;
        lo.x = (w[i][0] & 0xffffu) | (w[i][1] << 16); lo.y = (w[i][2] & 0xffffu) | (w[i][3] << 16); lo.z = (w[i][4] & 0xffffu) | (w[i][5] << 16); lo.w = (w[i][6] & 0xffffu) | (w[i][7] << 16);
        hi.x = (w[i][0] >> 16) | (w[i][1] & 0xffff0000u); hi.y = (w[i][2] >> 16) | (w[i][3] & 0xffff0000u); hi.z = (w[i][4] >> 16) | (w[i][5] & 0xffff0000u); hi.w = (w[i][6] >> 16) | (w[i][7] & 0xffff0000u);
        *(LAS u32x4*)(VT + (2 * cp) * ROW72 + tg * 16) = lo; *(LAS u32x4*)(VT + (2 * cp + 1) * ROW72 + tg * 16) = hi; }
}
DI void ld_256x128(const bf16_t* __restrict__ src, int gp, int tid, u32x4 (&r)[8]) {
#pragma unroll
    for (int i = 0; i < 8; ++i) { const int id = tid + 512 * i, row = id >> 4, cc = id & 15; r[i] = *(const u32x4*)(src + (size_t)row * gp + cc * 8); }
}
DI void st_256x128(const u32x4 (&r)[8], LAS unsigned char* dst, int tid) {
#pragma unroll
    for (int i = 0; i < 8; ++i) { const int id = tid + 512 * i, row = id >> 4, cc = id & 15; *(LAS u32x4*)(dst + row * ROW136 + cc * 16) = r[i]; }
}
DI void conv_ld(const bf16_t* __restrict__ Zc, int tok0, unsigned (&x)[11]) {
#pragma unroll
    for (int i = 0; i < 11; ++i) { const int tok = tok0 - 3 + i; x[i] = 0u; if (tok >= 0) x[i] = *(const unsigned*)(Zc + (size_t)tok * ZW); }
}
DI void conv_apply(const unsigned (&x)[11], const float* __restrict__ cw, const float* __restrict__ cb, float (&o0)[8], float (&o1)[8]) {
    f32x2 wj[4];
#pragma unroll
    for (int j = 0; j < 4; ++j) wj[j] = *(const f32x2*)(cw + j * 1024);
    const f32x2 bias = *(const f32x2*)cb;
#pragma unroll
    for (int j = 0; j < 8; ++j) { float y0 = bias.x, y1 = bias.y;
#pragma unroll
        for (int jj = 0; jj < 4; ++jj) { y0 += wj[jj].x * bflo(x[j + jj]); y1 += wj[jj].y * bfhi(x[j + jj]); }
        o0[j] = silu_f(y0); o1[j] = silu_f(y1); }
}
DI void gla_b(const bf16_t* __restrict__ Z, const float* __restrict__ wa, const float* __restrict__ ba, int h, int n, int tg, int c2, LAS float* TOT, float (&b)[8][2], float (&blast)[2]) {
    const int col = h * 128 + 2 * c2;
    float w0[16], w1[16];
#pragma unroll
    for (int r = 0; r < 16; ++r) { const f32x2 w = *(const f32x2*)(wa + r * 512 + col); w0[r] = w.x; w1[r] = w.y; }
    const f32x2 bb = *(const f32x2*)(ba + col);
    float c0 = 0.f, c1 = 0.f;
#pragma unroll
    for (int j = 0; j < 8; ++j) {
        const bf16_t* gp = Z + (size_t)(n * CH + 8 * tg + j) * ZW + ZC_GA;
        const u32x4 g0 = *(const u32x4*)gp, g1 = *(const u32x4*)(gp + 8);
        const float gv[16] = {bflo(g0.x), bfhi(g0.x), bflo(g0.y), bfhi(g0.y), bflo(g0.z), bfhi(g0.z), bflo(g0.w), bfhi(g0.w),
                              bflo(g1.x), bfhi(g1.x), bflo(g1.y), bfhi(g1.y), bflo(g1.z), bfhi(g1.z), bflo(g1.w), bfhi(g1.w)};
        float p0 = bb.x, p1 = bb.y;
#pragma unroll
        for (int r = 0; r < 16; ++r) { p0 += gv[r] * w0[r]; p1 += gv[r] * w1[r]; }
        c0 += log_sigmoid_f(p0) * (1.0f / 16.0f); c1 += log_sigmoid_f(p1) * (1.0f / 16.0f);
        b[j][0] = c0; b[j][1] = c1;
    }
    *(LAS f32x2*)(TOT + tg * 128 + 2 * c2) = (f32x2){c0, c1};
    __syncthreads();
    float pre0 = 0.f, pre1 = 0.f, t0 = 0.f, t1 = 0.f;
#pragma unroll
    for (int g = 0; g < 8; ++g) { const f32x2 t = *(const LAS f32x2*)(TOT + g * 128 + 2 * c2); if (g < tg) { pre0 += t.x; pre1 += t.y; } t0 += t.x; t1 += t.y; }
#pragma unroll
    for (int j = 0; j < 8; ++j) { b[j][0] += pre0; b[j][1] += pre1; }
    blast[0] = t0; blast[1] = t1;
}
DI void conv_silu8(const bf16_t* __restrict__ Zc, const float* __restrict__ cw, const float* __restrict__ cb, int tok0, float (&o0)[8], float (&o1)[8]) {
    float x0[11], x1[11];
#pragma unroll
    for (int i = 0; i < 11; ++i) { const int tok = tok0 - 3 + i; unsigned w = 0u; if (tok >= 0) w = *(const unsigned*)(Zc + (size_t)tok * ZW); x0[i] = bflo(w); x1[i] = bfhi(w); }
    f32x2 wj[4];
#pragma unroll
    for (int j = 0; j < 4; ++j) wj[j] = *(const f32x2*)(cw + j * 1024);
    const f32x2 bias = *(const f32x2*)cb;
#pragma unroll
    for (int j = 0; j < 8; ++j) { float y0 = bias.x, y1 = bias.y;
#pragma unroll
        for (int jj = 0; jj < 4; ++jj) { y0 += wj[jj].x * x0[j + jj]; y1 += wj[jj].y * x1[j + jj]; }
        o0[j] = silu_f(y0); o1[j] = silu_f(y1); }
}
DI void score_mfma(const LAS unsigned char* QL, const LAS unsigned char* KL, int w, int lane, f32x4 (&sacc)[2]) {
    const int fr = lane & 15, fq = lane >> 4, mi = w >> 1, ni0 = 2 * (w & 1);
    sacc[0] = (f32x4){0.f, 0.f, 0.f, 0.f}; sacc[1] = sacc[0];
#pragma unroll
    for (int ks = 0; ks < 4; ++ks) { const bf16x8 a = *(const LAS bf16x8*)(QL + (16 * mi + fr) * ROW136 + (32 * ks + 8 * fq) * 2);
#pragma unroll
        for (int jn = 0; jn < 2; ++jn) { const bf16x8 b = *(const LAS bf16x8*)(KL + (16 * (ni0 + jn) + fr) * ROW136 + (32 * ks + 8 * fq) * 2); sacc[jn] = mfma16(b, a, sacc[jn]); } }
}

struct MixCtx {
    const bf16_t* Z; bf16_t* OB;
    const float *wa, *ba, *gla_norm, *conv_w, *conv_b, *b_i, *b_f, *ml_norm;
    float *DECAY, *DN, *NP, *GG, *FL, *MP, *BG; bf16_t *DS, *DC, *SP, *CP;
    const bf16_t *KM, *VMT;
};

DI void gla_A_unit(const MixCtx& C, LAS unsigned char* lds, int h, int n, int tid) {
    const int lane = tid & 63, tg = __builtin_amdgcn_readfirstlane(tid >> 6), c2 = lane;
    LAS float* TOT = (LAS float*)(lds + L_MISC);
    LAS unsigned char* KT = lds + L_ST; LAS unsigned char* VT = lds + L_VT;
    unsigned kw[8], vw[2][8];
#pragma unroll
    for (int j = 0; j < 8; ++j) kw[j] = *(const unsigned*)(C.Z + (size_t)(n * CH + 8 * tg + j) * ZW + ZC_GK + h * 128 + 2 * c2);
    ld_v(C.Z + ZC_GV + h * 256, n, tg, lane, vw);
    float b[8][2], blast[2];
    gla_b(C.Z, C.wa, C.ba, h, n, tg, c2, TOT, b, blast);
    float k0[8], k1[8];
#pragma unroll
    for (int j = 0; j < 8; ++j) { k0[j] = bflo(kw[j]) * __expf(blast[0] - b[j][0]); k1[j] = bfhi(kw[j]) * __expf(blast[1] - b[j][1]);
        *(f32x2*)(C.BG + ((size_t)(h * NCH + n) * CH + 8 * tg + j) * 128 + 2 * c2) = (f32x2){b[j][0], b[j][1]}; }
    u32x4 lo, hi;
    lo.x = pk2(k0[0], k0[1]); lo.y = pk2(k0[2], k0[3]); lo.z = pk2(k0[4], k0[5]); lo.w = pk2(k0[6], k0[7]);
    hi.x = pk2(k1[0], k1[1]); hi.y = pk2(k1[2], k1[3]); hi.z = pk2(k1[4], k1[5]); hi.w = pk2(k1[6], k1[7]);
    *(LAS u32x4*)(KT + (2 * c2) * ROW72 + tg * 16) = lo; *(LAS u32x4*)(KT + (2 * c2 + 1) * ROW72 + tg * 16) = hi;
    if (tg == 0) *(f32x2*)(C.DECAY + (size_t)(h * NCH + n) * 128 + 2 * c2) = (f32x2){__expf(blast[0]), __expf(blast[1])};
    st_vT(vw, tg, lane, VT);
    __syncthreads();
    state_mfma(VT, KT, C.DS + (size_t)(h * NCH + n) * 32768, tg, lane);
    __syncthreads();
}

DI void gla_B_unit(const MixCtx& C, LAS unsigned char* lds, int h, int n, int tid) {
    const int lane = tid & 63, w = __builtin_amdgcn_readfirstlane(tid >> 6), tg = w, c2 = lane, fr = lane & 15, fq = lane >> 4;
    LAS float* RS = (LAS float*)(lds + L_MISC + 4096);
    LAS unsigned char* ST = lds + L_ST; LAS unsigned char* VT = lds + L_VT; LAS unsigned char* QL = lds + L_Q; LAS unsigned char* KL = lds + L_K;
    const int wr = w >> 1, wc = w & 1, t = 16 * wr + fr;
    const size_t tok = (size_t)(n * CH + t);
    u32x4 st[8]; f32x2 bq[8]; unsigned wq[8], wk[8], vw[2][8]; u32x2 gg[8]; f32x4 gn[8];
    ld_256x128(C.SP + (size_t)(h * NCH + n) * 32768, 128, tid, st);
#pragma unroll
    for (int j = 0; j < 8; ++j) { const size_t zr = (size_t)(n * CH + 8 * tg + j) * ZW;
        bq[j] = *(const f32x2*)(C.BG + ((size_t)(h * NCH + n) * CH + 8 * tg + j) * 128 + 2 * c2);
        wq[j] = *(const unsigned*)(C.Z + zr + ZC_GQ + h * 128 + 2 * c2); wk[j] = *(const unsigned*)(C.Z + zr + ZC_GK + h * 128 + 2 * c2); }
    ld_v(C.Z + ZC_GV + h * 256, n, tg, lane, vw);
#pragma unroll
    for (int ni = 0; ni < 8; ++ni) { const int dv = 128 * wc + 16 * ni + 4 * fq; gg[ni] = *(const u32x2*)(C.Z + tok * ZW + ZC_GG + h * 256 + dv); gn[ni] = *(const f32x4*)(C.gla_norm + h * 256 + dv); }
    const float qs = 0.08838834764831845f;
#pragma unroll
    for (int j = 0; j < 8; ++j) { const float e0 = __expf(bq[j].x), e1 = __expf(bq[j].y);
        *(LAS unsigned*)(QL + (8 * tg + j) * ROW136 + 4 * c2) = pk2(bflo(wq[j]) * qs * e0, bfhi(wq[j]) * qs * e1);
        *(LAS unsigned*)(KL + (8 * tg + j) * ROW136 + 4 * c2) = pk2(bflo(wk[j]) * __builtin_amdgcn_rcpf(e0), bfhi(wk[j]) * __builtin_amdgcn_rcpf(e1)); }
    st_vT(vw, tg, lane, VT);
    st_256x128(st, ST, tid);
    __syncthreads();
    f32x4 sacc[2];
    score_mfma(QL, KL, w, lane, sacc);
    __syncthreads();
    { const int mi = w >> 1, ni0 = 2 * (w & 1), t2 = 16 * mi + fr;
#pragma unroll
      for (int jn = 0; jn < 2; ++jn) { const int s0 = 16 * (ni0 + jn) + 4 * fq; f32x4 v = sacc[jn];
#pragma unroll
          for (int r = 0; r < 4; ++r) if (s0 + r > t2) v[r] = 0.f;
          *(LAS u32x2*)(KL + t2 * ROW72 + s0 * 2) = (u32x2){pk2(v[0], v[1]), pk2(v[2], v[3])}; } }
    __syncthreads();
    f32x4 o[8];
#pragma unroll
    for (int ni = 0; ni < 8; ++ni) o[ni] = (f32x4){0.f, 0.f, 0.f, 0.f};
#pragma unroll
    for (int ks = 0; ks < 2; ++ks) { const bf16x8 a = *(const LAS bf16x8*)(KL + t * ROW72 + (32 * ks + 8 * fq) * 2);
#pragma unroll
        for (int ni = 0; ni < 8; ++ni) { const bf16x8 bb = *(const LAS bf16x8*)(VT + (128 * wc + 16 * ni + fr) * ROW72 + (32 * ks + 8 * fq) * 2); o[ni] = mfma16(bb, a, o[ni]); } }
#pragma unroll
    for (int ks = 0; ks < 4; ++ks) { const bf16x8 a = *(const LAS bf16x8*)(QL + t * ROW136 + (32 * ks + 8 * fq) * 2);
#pragma unroll
        for (int ni = 0; ni < 8; ++ni) { const bf16x8 bb = *(const LAS bf16x8*)(ST + (128 * wc + 16 * ni + fr) * ROW136 + (32 * ks + 8 * fq) * 2); o[ni] = mfma16(bb, a, o[ni]); } }
    float ss = 0.f;
#pragma unroll
    for (int ni = 0; ni < 8; ++ni) ss += (o[ni][0] * o[ni][0] + o[ni][1] * o[ni][1]) + (o[ni][2] * o[ni][2] + o[ni][3] * o[ni][3]);
    ss += shx(ss, 16, lane); ss += shx(ss, 32, lane);
    if (fq == 0) RS[wc * 64 + t] = ss;
    __syncthreads();
    const float rstd = 1.0f / sqrtf((RS[t] + RS[64 + t]) * (1.0f / 256.0f) + EPS);
#pragma unroll
    for (int ni = 0; ni < 8; ++ni) { const int dv = 128 * wc + 16 * ni + 4 * fq;
        const f32x4 v = o[ni] * rstd * gn[ni];
        *(u32x2*)(C.OB + tok * OBW + OB_O + h * 256 + dv) = (u32x2){pk2(v[0] * silu_f(bflo(gg[ni].x)), v[1] * silu_f(bfhi(gg[ni].x))), pk2(v[2] * silu_f(bflo(gg[ni].y)), v[3] * silu_f(bfhi(gg[ni].y)))}; }
    __syncthreads();
}

DI void ml_A_unit(const MixCtx& C, LAS unsigned char* lds, int h, int n, int tid) {
    const int lane = tid & 63, tg = __builtin_amdgcn_readfirstlane(tid >> 6), c2 = lane;
    LAS float* PART = (LAS float*)(lds + L_MISC);
    LAS unsigned char* KT = lds + L_ST; LAS unsigned char* VT = lds + L_VT;
    const size_t ztok = (size_t)(n * CH + lane) * ZW;
    const float li = bf2f(C.Z[ztok + ZC_MI + h]) + C.b_i[h];
    const float lf = log_sigmoid_f(bf2f(C.Z[ztok + ZC_MF + h]) + C.b_f[h]);
    const float F = wave_scan_sum(lf, lane);
    const float Flast = shi(F, 63);
    const float Gv = Flast - F + li;
    const float g = wave_max(Gv, lane);
    const float wG = __expf(Gv - g);
    float k0[8], k1[8];
    conv_silu8(C.Z + ZC_MQK + 512 + h * 128 + 2 * c2, C.conv_w + 512 + h * 128 + 2 * c2, C.conv_b + 512 + h * 128 + 2 * c2, n * CH + 8 * tg, k0, k1);
    const float ks = 0.08838834764831845f;
    float p0 = 0.f, p1 = 0.f;
#pragma unroll
    for (int j = 0; j < 8; ++j) { const float wj = shi(wG, 8 * tg + j) * ks; k0[j] *= wj; k1[j] *= wj; p0 += k0[j]; p1 += k1[j]; }
    u32x4 lo, hi;
    lo.x = pk2(k0[0], k0[1]); lo.y = pk2(k0[2], k0[3]); lo.z = pk2(k0[4], k0[5]); lo.w = pk2(k0[6], k0[7]);
    hi.x = pk2(k1[0], k1[1]); hi.y = pk2(k1[2], k1[3]); hi.z = pk2(k1[4], k1[5]); hi.w = pk2(k1[6], k1[7]);
    *(LAS u32x4*)(KT + (2 * c2) * ROW72 + tg * 16) = lo; *(LAS u32x4*)(KT + (2 * c2 + 1) * ROW72 + tg * 16) = hi;
    *(LAS f32x2*)(PART + tg * 128 + 2 * c2) = (f32x2){p0, p1};
    fill_vT(C.Z + ZC_MV + h * 256, n, tg, lane, VT);
    if (tid == 0) { C.GG[h * NCH + n] = g; C.FL[h * NCH + n] = Flast; }
    __syncthreads();
    if (tid < 128) { float s = 0.f;
#pragma unroll
        for (int q = 0; q < 8; ++q) s += PART[q * 128 + tid];
        C.DN[(size_t)(h * NCH + n) * 128 + tid] = s; }
    state_mfma(VT, KT, C.DC + (size_t)(h * NCH + n) * 32768, tg, lane);
    __syncthreads();
}

DI void ml_B_unit(const MixCtx& C, LAS unsigned char* lds, int h, int n, int tid) {
    const int lane = tid & 63, w = __builtin_amdgcn_readfirstlane(tid >> 6), tg = w, c2 = lane, fr = lane & 15, fq = lane >> 4;
    LAS float* MF = (LAS float*)(lds + L_MISC); LAS float* MU = MF + 64; LAS float* MM = MF + 128; LAS float* MW = MF + 192;
    LAS float* DENP = MF + 256; LAS float* DQN = MF + 512; LAS float* NPV = MF + 576; LAS float* RS = (LAS float*)(lds + L_MISC + 4096);
    LAS unsigned char* CT = lds + L_ST; LAS unsigned char* VT = lds + L_VT; LAS unsigned char* QL = lds + L_Q; LAS unsigned char* KL = lds + L_K;
    copy_256x128(C.CP + (size_t)(h * NCH + n) * 32768, 128, CT, tid);
    if (w == 0) {
        const size_t ztok = (size_t)(n * CH + lane) * ZW;
        const float li = bf2f(C.Z[ztok + ZC_MI + h]) + C.b_i[h];
        const float lf = log_sigmoid_f(bf2f(C.Z[ztok + ZC_MF + h]) + C.b_f[h]);
        const float F = wave_scan_sum(lf, lane);
        const float u = li - F;
        const float pm = wave_scan_max(u, lane);
        const float mprev = C.MP[h * NCH + n];
        const float m = F + fmaxf(pm, mprev);
        MF[lane] = F; MU[lane] = u; MM[lane] = m; MW[lane] = __expf(F + mprev - m);
    }
    if (w == 1) { NPV[lane] = C.NP[(size_t)(h * NCH + n) * 128 + lane]; NPV[64 + lane] = C.NP[(size_t)(h * NCH + n) * 128 + 64 + lane]; }
    {
        float q0[8], q1[8], k0[8], k1[8];
        conv_silu8(C.Z + ZC_MQK + h * 128 + 2 * c2, C.conv_w + h * 128 + 2 * c2, C.conv_b + h * 128 + 2 * c2, n * CH + 8 * tg, q0, q1);
        conv_silu8(C.Z + ZC_MQK + 512 + h * 128 + 2 * c2, C.conv_w + 512 + h * 128 + 2 * c2, C.conv_b + 512 + h * 128 + 2 * c2, n * CH + 8 * tg, k0, k1);
        const float ks = 0.08838834764831845f;
#pragma unroll
        for (int j = 0; j < 8; ++j) { *(LAS unsigned*)(QL + (8 * tg + j) * ROW136 + 4 * c2) = pk2(q0[j], q1[j]); *(LAS unsigned*)(KL + (8 * tg + j) * ROW136 + 4 * c2) = pk2(k0[j] * ks, k1[j] * ks); }
    }
    fill_vT(C.Z + ZC_MV + h * 256, n, tg, lane, VT);
    __syncthreads();
    f32x4 sacc[2];
    score_mfma(QL, KL, w, lane, sacc);
    {
        const int t = tid >> 3, part = tid & 7; float s = 0.f;
#pragma unroll
        for (int e = 0; e < 8; ++e) { const unsigned qq = *(const LAS unsigned*)(QL + t * ROW136 + (16 * part + 2 * e) * 2); s += bflo(qq) * NPV[16 * part + 2 * e] + bfhi(qq) * NPV[16 * part + 2 * e + 1]; }
        s += shx(s, 1, lane); s += shx(s, 2, lane); s += shx(s, 4, lane);
        if (part == 0) DQN[t] = s;
    }
    __syncthreads();
    { const int mi = w >> 1, ni0 = 2 * (w & 1), t = 16 * mi + fr; const float ft = MF[t] - MM[t];
#pragma unroll
      for (int jn = 0; jn < 2; ++jn) { const int s0 = 16 * (ni0 + jn) + 4 * fq; f32x4 v = sacc[jn]; const f32x4 us = *(const LAS f32x4*)(MU + s0);
          float ps = 0.f;
#pragma unroll
          for (int r = 0; r < 4; ++r) { v[r] = (s0 + r > t) ? 0.f : v[r] * __expf(ft + us[r]); ps += v[r]; }
          ps += shx(ps, 16, lane); ps += shx(ps, 32, lane);
          if (fq == 0) DENP[t * 4 + ni0 + jn] = ps;
          *(LAS u32x2*)(KL + t * ROW72 + s0 * 2) = (u32x2){pk2(v[0], v[1]), pk2(v[2], v[3])}; } }
    __syncthreads();
    const int wr = w >> 1, wc = w & 1, t = 16 * wr + fr;
    f32x4 o1[8], o2[8];
#pragma unroll
    for (int ni = 0; ni < 8; ++ni) { o1[ni] = (f32x4){0.f, 0.f, 0.f, 0.f}; o2[ni] = o1[ni]; }
#pragma unroll
    for (int ks = 0; ks < 2; ++ks) { const bf16x8 a = *(const LAS bf16x8*)(KL + t * ROW72 + (32 * ks + 8 * fq) * 2);
#pragma unroll
        for (int ni = 0; ni < 8; ++ni) { const bf16x8 bb = *(const LAS bf16x8*)(VT + (128 * wc + 16 * ni + fr) * ROW72 + (32 * ks + 8 * fq) * 2); o1[ni] = mfma16(bb, a, o1[ni]); } }
#pragma unroll
    for (int ks = 0; ks < 4; ++ks) { const bf16x8 a = *(const LAS bf16x8*)(QL + t * ROW136 + (32 * ks + 8 * fq) * 2);
#pragma unroll
        for (int ni = 0; ni < 8; ++ni) { const bf16x8 bb = *(const LAS bf16x8*)(CT + (128 * wc + 16 * ni + fr) * ROW136 + (32 * ks + 8 * fq) * 2); o2[ni] = mfma16(bb, a, o2[ni]); } }
    const float wi = MW[t];
    const f32x4 dp = *(const LAS f32x4*)(DENP + t * 4);
    const float den = ((dp[0] + dp[1]) + (dp[2] + dp[3])) + wi * DQN[t];
    const float inv = 1.0f / fmaxf(fabsf(den), __expf(-MM[t]));
    const size_t tok = (size_t)(n * CH + t);
    float ss = 0.f;
#pragma unroll
    for (int ni = 0; ni < 8; ++ni) { const int dv = 128 * wc + 16 * ni + 4 * fq;
        const u32x2 mo = *(const u32x2*)(C.Z + tok * ZW + ZC_MO + h * 256 + dv);
        f32x4 v = (o1[ni] + o2[ni] * wi) * inv;
        v[0] *= sigmoid_f(bflo(mo.x)); v[1] *= sigmoid_f(bfhi(mo.x)); v[2] *= sigmoid_f(bflo(mo.y)); v[3] *= sigmoid_f(bfhi(mo.y));
        o1[ni] = v; ss += (v[0] * v[0] + v[1] * v[1]) + (v[2] * v[2] + v[3] * v[3]); }
    ss += shx(ss, 16, lane); ss += shx(ss, 32, lane);
    if (fq == 0) RS[wc * 64 + t] = ss;
    __syncthreads();
    const float rstd = 1.0f / sqrtf((RS[t] + RS[64 + t]) * (1.0f / 256.0f) + EPS);
#pragma unroll
    for (int ni = 0; ni < 8; ++ni) { const int dv = 128 * wc + 16 * ni + 4 * fq; const f32x4 gn = *(const f32x4*)(C.ml_norm + h * 256 + dv);
        const f32x4 v = o1[ni] * rstd * gn;
        *(u32x2*)(C.OB + tok * OBW + OB_O + 1024 + h * 256 + dv) = (u32x2){pk2(v[0], v[1]), pk2(v[2], v[3])}; }
    __syncthreads();
}

#ifndef SCAN_U
#define SCAN_U 8
#endif
DI void scan_phase(const MixCtx& C, int tid) {
    const int NS = 2 * 65536;
    for (int slot = opaque_bx() * 512 + tid; slot < NS; slot += opaque_g() * 512) {
        const int br = slot >> 16, s = slot & 65535, h = s >> 14, dv = (s >> 6) & 255, dkp = s & 63;
        const size_t e0 = (size_t)h * NCH * 32768 + (size_t)dv * 128 + 2 * dkp;
        if (br == 0) {
            float s0 = 0.f, s1 = 0.f;
            for (int n0 = 0; n0 < NCH; n0 += SCAN_U) {
                f32x2 d[SCAN_U], dec[SCAN_U];
#pragma unroll
                for (int u = 0; u < SCAN_U; ++u) { const unsigned dw = *(const unsigned*)(C.DS + e0 + (size_t)(n0 + u) * 32768); d[u] = (f32x2){bflo(dw), bfhi(dw)}; dec[u] = *(const f32x2*)(C.DECAY + (size_t)(h * NCH + n0 + u) * 128 + 2 * dkp); }
#pragma unroll
                for (int u = 0; u < SCAN_U; ++u) { *(unsigned*)(C.SP + e0 + (size_t)(n0 + u) * 32768) = pk2(s0, s1); s0 = dec[u].x * s0 + d[u].x; s1 = dec[u].y * s1 + d[u].y; }
            }
        } else {
            float c0 = 0.f, c1 = 0.f, nn0 = 0.f, nn1 = 0.f, m = -1e30f;
            for (int n0 = 0; n0 < NCH; n0 += SCAN_U) {
                f32x2 d[SCAN_U], dn[SCAN_U]; float fl[SCAN_U], gl[SCAN_U];
#pragma unroll
                for (int u = 0; u < SCAN_U; ++u) { const unsigned dw = *(const unsigned*)(C.DC + e0 + (size_t)(n0 + u) * 32768); d[u] = (f32x2){bflo(dw), bfhi(dw)}; fl[u] = C.FL[h * NCH + n0 + u]; gl[u] = C.GG[h * NCH + n0 + u];
                    dn[u] = (dv == 0) ? *(const f32x2*)(C.DN + (size_t)(h * NCH + n0 + u) * 128 + 2 * dkp) : (f32x2){0.f, 0.f}; }
#pragma unroll
                for (int u = 0; u < SCAN_U; ++u) { *(unsigned*)(C.CP + e0 + (size_t)(n0 + u) * 32768) = pk2(c0, c1);
                    if (dv == 0) { *(f32x2*)(C.NP + (size_t)(h * NCH + n0 + u) * 128 + 2 * dkp) = (f32x2){nn0, nn1}; if (dkp == 0) C.MP[h * NCH + n0 + u] = m; }
                    const float mn = fmaxf(fl[u] + m, gl[u]); const float a = __expf(fl[u] + m - mn), bb = __expf(gl[u] - mn);
                    c0 = a * c0 + bb * d[u].x; c1 = a * c1 + bb * d[u].y; nn0 = a * nn0 + bb * dn[u].x; nn1 = a * nn1 + bb * dn[u].y; m = mn; }
            }
        }
    }
}

DI void mem_unit(const MixCtx& C, LAS unsigned char* lds, int h, int rb, int tid) {
    const int lane = tid & 63, w = __builtin_amdgcn_readfirstlane(tid >> 6), fr = lane & 15, fq = lane >> 4, wr = w >> 1, wc = w & 1, t = 16 * wr + fr;
    LAS unsigned char* QL = lds; LAS unsigned char* PL = lds + 33792; LAS unsigned char* KV = lds + 67584;
    LAS float* RMX = (LAS float*)(lds + L_MISC); LAS float* RSM = RMX + 128;
#pragma unroll
    for (int i = 0; i < 4; ++i) { const int id = tid + 512 * i, row = id >> 5, cc = id & 31;
        *(LAS u32x4*)(QL + row * ROW264 + cc * 16) = *(const u32x4*)(C.Z + (size_t)(rb * 64 + row) * ZW + ZC_XQ + h * 256 + cc * 8); }
    f32x4 s[8];
#pragma unroll
    for (int ni = 0; ni < 8; ++ni) s[ni] = (f32x4){0.f, 0.f, 0.f, 0.f};
#pragma unroll
    for (int half = 0; half < 2; ++half) {
        copy_256x128(C.KM + h * 256 + half * 128, 4096, KV, tid);
        __syncthreads();
#pragma unroll
        for (int ks = 0; ks < 4; ++ks) { const bf16x8 a = *(const LAS bf16x8*)(QL + t * ROW264 + (128 * half + 32 * ks + 8 * fq) * 2);
#pragma unroll
            for (int ni = 0; ni < 8; ++ni) { const bf16x8 bb = *(const LAS bf16x8*)(KV + (128 * wc + 16 * ni + fr) * ROW136 + (32 * ks + 8 * fq) * 2); s[ni] = mfma16(bb, a, s[ni]); } }
        __syncthreads();
    }
    float mx = -3.0e38f;
#pragma unroll
    for (int ni = 0; ni < 8; ++ni) { s[ni] = s[ni] * 0.0625f; mx = fmaxf(mx, fmaxf(fmaxf(s[ni][0], s[ni][1]), fmaxf(s[ni][2], s[ni][3]))); }
    mx = fmaxf(mx, shx(mx, 16, lane)); mx = fmaxf(mx, shx(mx, 32, lane));
    if (fq == 0) RMX[wc * 64 + t] = mx;
    copy_256x128(C.VMT + (size_t)(h * 256) * 256, 256, KV, tid);
    __syncthreads();
    mx = fmaxf(RMX[t], RMX[64 + t]);
    float sm = 0.f;
#pragma unroll
    for (int ni = 0; ni < 8; ++ni) {
#pragma unroll
        for (int r = 0; r < 4; ++r) { s[ni][r] = __expf(s[ni][r] - mx); sm += s[ni][r]; } }
    sm += shx(sm, 16, lane); sm += shx(sm, 32, lane);
    if (fq == 0) RSM[wc * 64 + t] = sm;
    __syncthreads();
    const float inv = 1.0f / (RSM[t] + RSM[64 + t]);
#pragma unroll
    for (int ni = 0; ni < 8; ++ni) { const f32x4 p = s[ni] * inv; *(LAS u32x2*)(PL + t * ROW264 + (128 * wc + 16 * ni + 4 * fq) * 2) = (u32x2){pk2(p[0], p[1]), pk2(p[2], p[3])}; }
    f32x4 o[8];
#pragma unroll
    for (int ni = 0; ni < 8; ++ni) o[ni] = (f32x4){0.f, 0.f, 0.f, 0.f};
#pragma unroll
    for (int half = 0; half < 2; ++half) {
        if (half == 1) copy_256x128(C.VMT + (size_t)(h * 256) * 256 + 128, 256, KV, tid);
        __syncthreads();
#pragma unroll
        for (int ks = 0; ks < 4; ++ks) { const bf16x8 a = *(const LAS bf16x8*)(PL + t * ROW264 + (128 * half + 32 * ks + 8 * fq) * 2);
#pragma unroll
            for (int ni = 0; ni < 8; ++ni) { const bf16x8 bb = *(const LAS bf16x8*)(KV + (128 * wc + 16 * ni + fr) * ROW136 + (32 * ks + 8 * fq) * 2); o[ni] = mfma16(bb, a, o[ni]); } }
        __syncthreads();
    }
    const size_t tok = (size_t)(rb * 64 + t);
#pragma unroll
    for (int ni = 0; ni < 8; ++ni) { const int d = 128 * wc + 16 * ni + 4 * fq; *(u32x2*)(C.OB + tok * OBW + OB_O + 2048 + h * 256 + d) = (u32x2){pk2(o[ni][0], o[ni][1]), pk2(o[ni][2], o[ni][3])}; }
}

#ifndef GEMM_ALIGN
#define GEMM_ALIGN true
#endif
#ifndef REP_PRO
#define REP_PRO 1
#endif
#ifndef REP_MIXA
#define REP_MIXA 1
#endif
#ifndef REP_SCAN
#define REP_SCAN 1
#endif
#ifndef REP_MIXB
#define REP_MIXB 1
#endif
#ifndef REP_FF1
#define REP_FF1 1
#endif
#ifndef REP_NORM
#define REP_NORM 1
#endif
#ifndef WGM_IN
#define WGM_IN PG8_WGM
#endif
#ifndef WGM_BR
#define WGM_BR PG8_WGM
#endif
#ifndef WGM_OUT
#define WGM_OUT PG8_WGM
#endif
#ifndef WGM_F1
#define WGM_F1 8
#endif
#ifndef WGM_F2
#define WGM_F2 PG8_WGM
#endif
#ifndef REP_GLAA
#define REP_GLAA 1
#endif
#ifndef REP_MEM
#define REP_MEM 1
#endif
#ifndef REP_GLAB
#define REP_GLAB 1
#endif
#ifndef REP_GATE
#define REP_GATE 1
#endif
#ifndef REP_BR
#define REP_BR 1
#endif
#ifndef GEMM_SP2
#define GEMM_SP2 true
#endif
constexpr int L_PTR = L_BARW + 256;
DI unsigned long long tab_ld(LAS unsigned char* lds, int k) {
    const unsigned long long v = *(volatile LAS unsigned long long*)(lds + L_PTR + 8 * k);
    const unsigned lo = __builtin_amdgcn_readfirstlane((unsigned)v), hi = __builtin_amdgcn_readfirstlane((unsigned)(v >> 32));
    return ((unsigned long long)hi << 32) | lo;
}
DI const float* tab_in(LAS unsigned char* lds, int k) { return (const float*)(const GAS float*)tab_ld(lds, k); }
DI unsigned char* tab_ws(LAS unsigned char* lds) { return (unsigned char*)(GAS unsigned char*)tab_ld(lds, 24); }
DI void grid_bar(LAS unsigned char* lds) {
    XcdBarrier b; b.bar = (unsigned*)(tab_ws(lds) + WS_CTL) + CW_BAR; b.x = xb_xcc_id(); b.st = (volatile LAS unsigned*)(lds + L_BARW);
    xcd_barrier(b);
}
DI void make_ctx(MixCtx& C, LAS unsigned char* lds, int l) {
    unsigned char* ws = tab_ws(lds);
    C.Z = (const bf16_t*)(ws + WS_Z); C.OB = (bf16_t*)(ws + WS_OB);
    C.wa = tab_in(lds, I_W_GLA_A) + (size_t)l * 16 * 512; C.ba = tab_in(lds, I_B_GLA_A) + l * 512; C.gla_norm = tab_in(lds, I_GLA_NORM) + l * 1024;
    C.conv_w = tab_in(lds, I_CONV_W) + (size_t)l * 4 * 1024; C.conv_b = tab_in(lds, I_CONV_B) + l * 1024; C.b_i = tab_in(lds, I_B_ML_I) + l * 4; C.b_f = tab_in(lds, I_B_ML_F) + l * 4; C.ml_norm = tab_in(lds, I_ML_NORM) + l * 1024;
    C.BG = (float*)(ws + WS_BG); C.DS = (bf16_t*)(ws + WS_DS); C.DC = (bf16_t*)(ws + WS_DC); C.SP = (bf16_t*)(ws + WS_SP); C.CP = (bf16_t*)(ws + WS_CP);
    C.DECAY = (float*)(ws + WS_SMALL + SM_DECAY); C.DN = (float*)(ws + WS_SMALL + SM_DN); C.NP = (float*)(ws + WS_SMALL + SM_NP);
    C.GG = (float*)(ws + WS_SMALL + SM_GG); C.FL = (float*)(ws + WS_SMALL + SM_FL); C.MP = (float*)(ws + WS_SMALL + SM_MP);
    C.KM = (const bf16_t*)(ws + WS_KM) + l * 1024; C.VMT = (const bf16_t*)(ws + WS_VMT) + (size_t)l * 1024 * 256;
}

__global__ void __launch_bounds__(512, 2) trunk_fwd(Params p) {
    extern __shared__ __attribute__((aligned(16))) unsigned char lds_raw[];
    LAS unsigned char* lds0 = (LAS unsigned char*)lds_raw;
    {
        LAS unsigned char* lds = lds0;
        const int tid0 = threadIdx.x;
        if (tid0 < 64) ((LAS unsigned*)(lds + L_BARW))[tid0] = 0u;
        if (tid0 < 23) *(LAS unsigned long long*)(lds + L_PTR + 8 * tid0) = (unsigned long long)p.in[tid0];
        if (tid0 == 23) *(LAS unsigned long long*)(lds + L_PTR + 8 * 23) = (unsigned long long)p.out;
        if (tid0 == 24) *(LAS unsigned long long*)(lds + L_PTR + 8 * 24) = (unsigned long long)p.ws;
        __syncthreads();
        (void)xcd_barrier_post((unsigned*)(p.ws + WS_CTL) + CW_BAR, (volatile LAS unsigned*)(lds + L_BARW));
    }
#define TID (opaque_tid())
#define LANE (opaque_tid() & 63)
#define WAVE (__builtin_amdgcn_readfirstlane(opaque_tid() >> 6))
#define GW (opaque_bx() * NWAVES + WAVE)
#define NGW (opaque_g() * NWAVES)

    for (int rep = 0; rep < REP_PRO; ++rep) {
        LAS unsigned char* lds = opaque_lds(lds0); unsigned char* ws = tab_ws(lds);
        bf16_t* WIN = (bf16_t*)(ws + WS_WIN);
        const int lane = LANE, wave = WAVE;
        LAS float* scr = (LAS float*)(lds + wave * 16640);
        constexpr int IT_IN = 64 * 117, IT_BR = 16 * 64, IT_G = 4 * 64, IT_OUT = 64 * 64, IT_F1 = 64 * 256, IT_F2 = 256 * 64, IT_MK = 64 * 16;
        constexpr int E_IN = 4 * IT_IN, E_BR = E_IN + 12 * IT_BR, E_G = E_BR + 12 * IT_G, E_OUT = E_G + 4 * IT_OUT, E_F1 = E_OUT + 4 * IT_F1, E_F2 = E_F1 + 4 * IT_F2, E_MK = E_F2 + 4 * IT_MK, E_MV = E_MK + 4 * IT_MK;
        for (int it = GW; it < E_MV; it += NGW) {
            if (it < E_IN) { const int l = it / IT_IN, r = it - l * IT_IN; transpose_item(tab_in(lds, I_W_IN) + (size_t)l * DM * IN_W, DM, IN_W, WIN + (size_t)l * ZW * PW, PW, 0, 0, true, scr, r, lane, tab_in(lds, I_NORM_MIX) + l * DM); }
            else if (it < E_BR) { const int q = it - E_IN, lj = q / IT_BR, r = q - lj * IT_BR, l = lj / 3, j = lj - 3 * l; transpose_item(tab_in(lds, I_W_BRANCH) + (size_t)lj * 1024 * DM, 1024, DM, (bf16_t*)(ws + WS_WBR) + (size_t)l * DM * OBW, OBW, OB_O + j * 1024, 0, false, scr, r, lane); }
            else if (it < E_G) { const int q = it - E_BR, lj = q / IT_G, r = q - lj * IT_G, l = lj / 3, j = lj - 3 * l; transpose_item(tab_in(lds, I_W_GATE) + (size_t)lj * 256 * DM, 256, DM, (bf16_t*)(ws + WS_WBR) + (size_t)l * DM * OBW, OBW, j * 256, 0, false, scr, r, lane); }
            else if (it < E_OUT) { const int q = it - E_G, l = q / IT_OUT, r = q - l * IT_OUT; transpose_item(tab_in(lds, I_W_OUT) + (size_t)l * DM * DM, DM, DM, (bf16_t*)(ws + WS_WOUT) + (size_t)l * DM * PW, PW, 0, 0, false, scr, r, lane); }
            else if (it < E_F1) { const int q = it - E_OUT, l = q / IT_F1, r = q - l * IT_F1; transpose_item(tab_in(lds, I_W_FF1) + (size_t)l * DM * DFF, DM, DFF, (bf16_t*)(ws + WS_W1) + (size_t)l * DFF * PW, PW, 0, 0, false, scr, r, lane, tab_in(lds, I_NORM_FFN) + l * DM); }
            else if (it < E_F2) { const int q = it - E_F1, l = q / IT_F2, r = q - l * IT_F2; transpose_item(tab_in(lds, I_W_FF2) + (size_t)l * DFF * DM, DFF, DM, (bf16_t*)(ws + WS_W2) + (size_t)l * DM * PU, PU, 0, 0, false, scr, r, lane); }
            else if (it < E_MK) { const int q = it - E_F2, l = q / IT_MK, r = q - l * IT_MK; transpose_item(tab_in(lds, I_W_MEM_K) + (size_t)l * DM * 1024, DM, 1024, (bf16_t*)(ws + WS_WMK), DM, 0, l * 1024, false, scr, r, lane); }
            else { const int q = it - E_MK, l = q / IT_MK, r = q - l * IT_MK; transpose_item(tab_in(lds, I_W_MEM_V) + (size_t)l * DM * 1024, DM, 1024, (bf16_t*)(ws + WS_WMV), DM, 0, l * 1024, false, scr, r, lane); }
        }
        constexpr int PADCH = (ZW - IN_W) * PW / 8;
        for (int i = opaque_bx() * 512 + TID; i < NL * PADCH; i += opaque_g() * 512) { const int l = i / PADCH, r = i - l * PADCH; *(u32x4*)(WIN + (size_t)l * ZW * PW + (size_t)IN_W * PW + (size_t)r * 8) = (u32x4){0u, 0u, 0u, 0u}; }
        for (int m = GW; m < SEQ; m += NGW) row_bf16_ss(tab_in(lds, I_X) + (size_t)m * DM, (bf16_t*)(ws + WS_H) + (size_t)m * PW, (u64_t*)(ws + WS_SS) + m, lane);
        for (int m = GW; m < MEML; m += NGW) rmsnorm_row<false>(tab_in(lds, I_MEM) + (size_t)m * DM, tab_in(lds, I_MEM_NORM), (bf16_t*)(ws + WS_MEMN) + (size_t)m * DM, lane);
    }
    grid_bar(opaque_lds(lds0));
    for (int l = 0; l < NL; ++l) {
        {
            LAS unsigned char* lds = opaque_lds(lds0); unsigned char* ws = tab_ws(lds);
            pg8::Gemm g{(const bf16_t*)(ws + WS_H), (const bf16_t*)(ws + WS_WIN) + (size_t)l * ZW * PW, opq(SEQ), opq(ZW), opq(DM), opq(PW), opq(PW)}; pg8::StaticOrder S; S.init(opq(SEQ), opq(ZW), opaque_g(), opaque_bx(), opq(WGM_IN)); pg8::EpiBf16<0> E{(bf16_t*)(ws + WS_Z), ZW, nullptr, (const u64_t*)(ws + WS_SS) + (size_t)(2 * l) * SEQ, (bf16_t*)(ws + WS_OB), OBW, ZC_GATE / 256};
            pg8::gemm_phase<pg8::EpiBf16<0>, pg8::StaticOrder, GEMM_ALIGN, GEMM_SP2>(lds, g, S, E);
        }
        if (l == 0) {
            const int kvc = (opaque_g() >= 256 && opaque_bx() >= 128) ? opaque_bx() - 128 : opaque_bx() + (1 << 20) * (opaque_g() >= 256 ? 1 : 0);
        {
            LAS unsigned char* lds = opaque_lds(lds0); unsigned char* ws = tab_ws(lds);
        { pg8::Gemm g{(const bf16_t*)(ws + WS_MEMN), (const bf16_t*)(ws + WS_WMK), opq(MEML), opq(DM), opq(DM), opq(DM), opq(DM)}; pg8::StaticOrder S; S.init(opq(MEML), opq(DM), opaque_g(), kvc); pg8::EpiBf16<0> E{(bf16_t*)(ws + WS_KM), DM, nullptr, nullptr, nullptr, 0, -1};
          pg8::gemm_phase<pg8::EpiBf16<0>, pg8::StaticOrder, GEMM_ALIGN, GEMM_SP2>(lds, g, S, E); }
    }
        {
            LAS unsigned char* lds = opaque_lds(lds0); unsigned char* ws = tab_ws(lds);
        { pg8::Gemm g{(const bf16_t*)(ws + WS_WMV), (const bf16_t*)(ws + WS_MEMN), opq(DM), opq(MEML), opq(DM), opq(DM), opq(DM)}; pg8::StaticOrder S; S.init(opq(DM), opq(MEML), opaque_g(), kvc - 16); pg8::EpiBf16<0> E{(bf16_t*)(ws + WS_VMT), MEML, nullptr, nullptr, nullptr, 0, -1};
          pg8::gemm_phase<pg8::EpiBf16<0>, pg8::StaticOrder, GEMM_ALIGN, GEMM_SP2>(lds, g, S, E); }
    }
        }
        grid_bar(opaque_lds(lds0));
        {
            LAS unsigned char* lds = opaque_lds(lds0); MixCtx C; make_ctx(C, lds, l); const int tid = TID;
            for (int rep = 0; rep < REP_MIXA; ++rep) {
            for (int r2 = 0; r2 < REP_GLAA; ++r2) for (int i = opaque_bx(); i < 4 * NCH; i += opaque_g()) gla_A_unit(C, lds, i >> 8, i & 255, tid);
            for (int i = opaque_bx(); i < 4 * NCH; i += opaque_g()) ml_A_unit(C, lds, i >> 8, i & 255, tid);
            for (int r2 = 0; r2 < REP_MEM; ++r2) for (int i = opaque_bx(); i < 4 * NCH; i += opaque_g()) mem_unit(C, lds, i >> 8, i & 255, tid);
            }
        }
        grid_bar(opaque_lds(lds0));
        { LAS unsigned char* lds = opaque_lds(lds0); MixCtx C; make_ctx(C, lds, l); for (int rep = 0; rep < REP_SCAN; ++rep) scan_phase(C, TID); }
        grid_bar(opaque_lds(lds0));
        {
            LAS unsigned char* lds = opaque_lds(lds0); MixCtx C; make_ctx(C, lds, l); const int tid = TID;
            for (int rep = 0; rep < REP_MIXB; ++rep) {
            for (int r2 = 0; r2 < REP_GLAB; ++r2) for (int i = opaque_bx(); i < 4 * NCH; i += opaque_g()) gla_B_unit(C, lds, i >> 8, i & 255, tid);
            for (int i = opaque_bx(); i < 4 * NCH; i += opaque_g()) ml_B_unit(C, lds, i >> 8, i & 255, tid);
            }
        }
        grid_bar(opaque_lds(lds0));
        for (int rep = 0; rep < REP_BR; ++rep) {
            LAS unsigned char* lds = opaque_lds(lds0); unsigned char* ws = tab_ws(lds);
            pg8::Gemm g{(const bf16_t*)(ws + WS_OB), (const bf16_t*)(ws + WS_WBR) + (size_t)l * DM * OBW, opq(SEQ), opq(DM), opq(OBW), opq(OBW), opq(OBW)}; pg8::BranchOrder S; S.init(opq(SEQ), opq(DM), opaque_g(), opaque_bx(), opq(WGM_BR)); pg8::EpiBranch E{(bf16_t*)(ws + WS_Y), PW, (bf16_t*)(ws + WS_GT), tab_in(lds, I_B_GATE) + (size_t)l * GTW};
            pg8::gemm_phase<pg8::EpiBranch, pg8::BranchOrder, GEMM_ALIGN, GEMM_SP2>(lds, g, S, E);
        }
        grid_bar(opaque_lds(lds0));
        {
            LAS unsigned char* lds = opaque_lds(lds0); unsigned char* ws = tab_ws(lds);
            const float* Xin = (l == 0) ? tab_in(lds, I_X) : (const float*)(ws + WS_X);
            pg8::Gemm g{(const bf16_t*)(ws + WS_Y), (const bf16_t*)(ws + WS_WOUT) + (size_t)l * DM * PW, opq(SEQ), opq(DM), opq(DM), opq(PW), opq(PW)}; pg8::StaticOrder S; S.init(opq(SEQ), opq(DM), opaque_g(), opaque_bx(), opq(WGM_OUT)); pg8::EpiResid E{Xin, (float*)(ws + WS_X), DM, (bf16_t*)(ws + WS_H), (u64_t*)(ws + WS_SS) + (size_t)(2 * l + 1) * SEQ, PW};
            pg8::gemm_phase<pg8::EpiResid, pg8::StaticOrder, GEMM_ALIGN, GEMM_SP2>(lds, g, S, E);
        }
        grid_bar(opaque_lds(lds0));
        for (int rep = 0; rep < REP_FF1; ++rep) {
            LAS unsigned char* lds = opaque_lds(lds0); unsigned char* ws = tab_ws(lds);
            pg8::Gemm g{(const bf16_t*)(ws + WS_H), (const bf16_t*)(ws + WS_W1) + (size_t)l * DFF * PW, opq(SEQ), opq(DFF), opq(DM), opq(PW), opq(PW)}; pg8::StaticOrder S; S.init(opq(SEQ), opq(DFF), opaque_g(), opaque_bx(), opq(WGM_F1)); pg8::EpiBf16<1> E{(bf16_t*)(ws + WS_U), PU, nullptr, (const u64_t*)(ws + WS_SS) + (size_t)(2 * l + 1) * SEQ, nullptr, 0, -1};
            pg8::gemm_phase<pg8::EpiBf16<1>, pg8::StaticOrder, GEMM_ALIGN, GEMM_SP2>(lds, g, S, E);
        }
        grid_bar(opaque_lds(lds0));
        {
            LAS unsigned char* lds = opaque_lds(lds0); unsigned char* ws = tab_ws(lds);
            pg8::Gemm g{(const bf16_t*)(ws + WS_U), (const bf16_t*)(ws + WS_W2) + (size_t)l * DM * PU, opq(SEQ), opq(DM), opq(DFF), opq(PU), opq(PU)}; pg8::StaticOrder S; S.init(opq(SEQ), opq(DM), opaque_g(), opaque_bx(), opq(WGM_F2)); pg8::EpiResid E{(const float*)(ws + WS_X), (float*)(ws + WS_X), DM, (bf16_t*)(ws + WS_H), (u64_t*)(ws + WS_SS) + (size_t)(2 * l + 2) * SEQ, PW};
            pg8::gemm_phase<pg8::EpiResid, pg8::StaticOrder, GEMM_ALIGN, GEMM_SP2>(lds, g, S, E);
        }
        grid_bar(opaque_lds(lds0));
    }
    {
        LAS unsigned char* lds = opaque_lds(lds0); unsigned char* ws = tab_ws(lds);
        const float* X = (const float*)(ws + WS_X); const float* gain = tab_in(lds, I_FINAL_NORM); float* out = (float*)(GAS float*)tab_ld(lds, 23); const int lane = LANE;
        const u64_t* ssf = (const u64_t*)(ws + WS_SS) + (size_t)8 * SEQ;
        for (int m = GW; m < SEQ; m += NGW) row_scale_f32(X + (size_t)m * DM, gain, ss_to_f(ssf[m]), out + (size_t)m * DM, lane);
    }
}

extern "C" void kernel_launch(void* const* d_in, const int* in_sizes, int n_in, void* d_out, int out_size, void* d_ws, size_t ws_size, hipStream_t stream) {
    static int grid = 0;
    if (grid == 0) {
        if (n_in != 23 || out_size != SEQ * DM || ws_size < WS_END) { fprintf(stderr, "kernel_launch: unexpected shapes (n_in %d out %d ws %zu, need %zu)\n", n_in, out_size, ws_size, (size_t)WS_END); grid = -1; return; }
        int dev = 0, cus = 0, per_cu = 0;
        if (hipGetDevice(&dev) != hipSuccess || hipDeviceGetAttribute(&cus, hipDeviceAttributeMultiprocessorCount, dev) != hipSuccess) { grid = -1; return; }
        if (hipFuncSetAttribute((const void*)trunk_fwd, hipFuncAttributeMaxDynamicSharedMemorySize, LDS_BYTES) != hipSuccess) { fprintf(stderr, "kernel_launch: hipFuncSetAttribute failed\n"); grid = -1; return; }
        if (hipOccupancyMaxActiveBlocksPerMultiprocessor(&per_cu, (const void*)trunk_fwd, 512, LDS_BYTES) != hipSuccess || per_cu < 1) { fprintf(stderr, "kernel_launch: occupancy query says %d\n", per_cu); (void)hipGetLastError(); }
        grid = cus;
    }
    if (grid < 0) return;
    if (hipMemsetAsync((char*)d_ws + WS_CTL, 0, CTL_ZERO_BYTES, stream) != hipSuccess) return;
    if (hipMemsetAsync((char*)d_ws + WS_SS, 0, SS_ZERO_BYTES, stream) != hipSuccess) return;
    Params p{};
    for (int i = 0; i < 23; ++i) p.in[i] = (const float*)d_in[i];
    p.out = (float*)d_out; p.ws = (unsigned char*)d_ws;
    hipLaunchKernelGGL(trunk_fwd, dim3(grid), dim3(512), LDS_BYTES, stream, p);
}
```
